# Optimizing an MI355X kernel written in HIP

```python
import jax
import jax.numpy as jnp
from jax import lax
import numpy as np

D_MODEL = 1024
BATCH = 8
SEQ = 2048
DEPTH = 2

MEM_LEN = 256
HEAD_DIM = 64
N_BRANCHES = 3
LN_EPS = 1e-5
BAND_BLOCK = 128

DIL_GROUPS = ((128, 1), (512, 4), (2048, 16))
DIL_HEADS = 4

GLA_HEADS = 4
GLA_DK = D_MODEL // 2 // GLA_HEADS
GLA_DV = D_MODEL // GLA_HEADS
GLA_RANK = 16
GLA_TAU = 16.0
GLA_CHUNK = 64

NSA_HEADS = 16
NSA_KV_GROUPS = 4
NSA_BRANCHES = 3
NSA_CMP_LEN = 32
NSA_CMP_STRIDE = 16
NSA_CMP_HIDDEN = 2 * HEAD_DIM
NSA_SEL_LEN = 64
NSA_N_SELECT = 16
NSA_WINDOW = 512
NSA_Q_BLOCK = 32

XATTN_HEADS = 4

N_EXPERTS = 32
TOP_K = 4
D_FF = D_MODEL
SWIGLU_LIMIT = 7.0
SWIGLU_ALPHA = 1.702
MOE_BLOCK = 128

DEEPNORM_ALPHA = (2 * DEPTH) ** 0.25
DEEPNORM_BETA = (8 * DEPTH) ** -0.25

A_W = len(DIL_GROUPS) * DIL_HEADS * HEAD_DIM
B_K = GLA_HEADS * GLA_DK
B_V = GLA_HEADS * GLA_DV
C_Q = NSA_HEADS * HEAD_DIM
C_KV = NSA_KV_GROUPS * HEAD_DIM
IN_WIDTHS = (A_W, A_W, A_W,
             B_K, B_K, B_V, B_V, GLA_RANK,
             C_Q, C_KV, C_KV, C_KV, C_KV, C_KV, C_KV, NSA_HEADS * NSA_BRANCHES,
             N_BRANCHES * D_MODEL)
N_IN = sum(IN_WIDTHS)

kernel_name = 'hybrid_dilated_gla_nsa_moe_deepnorm'


def layer_norm(x, g, b):
    xf = x.astype(jnp.float32)
    mu = jnp.mean(xf, axis=-1, keepdims=True)
    var = jnp.mean(jnp.square(xf - mu), axis=-1, keepdims=True)
    return ((xf - mu) * lax.rsqrt(var + LN_EPS)).astype(x.dtype) * g + b


def banded_attention(q, k, v, max_dist):
    n, seq_len, g, r, hd = q.shape
    blk = BAND_BLOCK
    n_prev = -(-max_dist // blk)
    nb = -(-seq_len // blk)
    pad = nb * blk - seq_len
    qp = jnp.pad(q, ((0, 0), (0, pad), (0, 0), (0, 0), (0, 0)))
    kv_pad = ((0, 0), (n_prev * blk, pad), (0, 0), (0, 0))
    kp = jnp.pad(k, kv_pad).reshape(n, nb + n_prev, blk, g, hd)
    vp = jnp.pad(v, kv_pad).reshape(n, nb + n_prev, blk, g, hd)
    kw = jnp.concatenate([kp[:, i:i + nb] for i in range(n_prev + 1)], axis=2)
    vw = jnp.concatenate([vp[:, i:i + nb] for i in range(n_prev + 1)], axis=2)
    width = (n_prev + 1) * blk
    qi = jnp.arange(blk)[:, None]
    kj = jnp.arange(width)[None, :]
    dist = qi + n_prev * blk - kj
    key_abs = jnp.arange(nb)[:, None, None] * blk - n_prev * blk + kj[None]
    mask = ((dist >= 0) & (dist <= max_dist))[None] & (key_abs >= 0)
    scale = hd ** -0.5

    def one_block(args):
        qb, kb, vb, mb = args
        s = jnp.einsum('nqgrd,nkgd->ngrqk', qb, kb).astype(jnp.float32) * scale
        s = jnp.where(mb, s, -jnp.inf)
        m = jnp.max(s, axis=-1, keepdims=True)
        p = jnp.exp(s - m)
        den = jnp.sum(p, axis=-1, keepdims=True)
        o = jnp.einsum('ngrqk,nkgd->nqgrd', (p / den).astype(vb.dtype), vb)
        lse = (m + jnp.log(den))[..., 0]
        return o, jnp.transpose(lse, (0, 3, 1, 2))

    qb = jnp.moveaxis(qp.reshape(n, nb, blk, g, r, hd), 1, 0)
    o, lse = lax.map(one_block, (qb, jnp.moveaxis(kw, 1, 0), jnp.moveaxis(vw, 1, 0), mask))
    o = jnp.moveaxis(o, 0, 1).reshape(n, nb * blk, g, r, hd)[:, :seq_len]
    lse = jnp.moveaxis(lse, 0, 1).reshape(n, nb * blk, g, r)[:, :seq_len]
    return o, lse


def dilated_attention(q, k, v):
    bsz, seq, _, nh, hd = q.shape
    outs, lses = [], []
    for gi, (window, dil) in enumerate(DIL_GROUPS):
        sub_len = seq // dil

        def to_sub(t):
            return t.reshape(bsz, sub_len, dil, nh, hd).transpose(0, 2, 1, 3, 4).reshape(bsz * dil, sub_len, nh, hd)

        o, lse = banded_attention(to_sub(q[:, :, gi])[:, :, :, None], to_sub(k[:, :, gi]), to_sub(v[:, :, gi]), window // dil)
        outs.append(o[:, :, :, 0].reshape(bsz, dil, sub_len, nh, hd).transpose(0, 2, 1, 3, 4).reshape(bsz, seq, nh, hd))
        lses.append(lse[..., 0].reshape(bsz, dil, sub_len, nh).transpose(0, 2, 1, 3).reshape(bsz, seq, nh))
    w = jax.nn.softmax(jnp.stack(lses), axis=0)
    return jnp.einsum('gbsh,gbshd->bshd', w.astype(q.dtype), jnp.stack(outs))


def gla_mixer(q, k, v, r, lr, w_alpha2, b_alpha, norm_g):
    bsz, seq, _ = q.shape
    nh, dk, dv, c = GLA_HEADS, GLA_DK, GLA_DV, GLA_CHUNK
    dtype = q.dtype
    log_a = jax.nn.log_sigmoid((lr @ w_alpha2 + b_alpha).astype(jnp.float32)) / GLA_TAU
    n_chunks = seq // c

    def chunks(t, width):
        return t.reshape(bsz, n_chunks, c, nh, width).transpose(1, 0, 3, 2, 4).astype(jnp.float32)

    qc = chunks(q, dk) * (dk ** -0.5)
    kc = chunks(k, dk)
    vc = chunks(v, dv)
    bc = jnp.cumsum(chunks(log_a, dk), axis=3)
    causal = jnp.tril(jnp.ones((c, c), dtype=bool))

    def step(state, inp):
        qi, ki, vi, bi = inp
        diff = bi[:, :, :, None, :] - bi[:, :, None, :, :]
        decay = jnp.exp(jnp.where(causal[:, :, None], diff, -jnp.inf))
        attn = jnp.einsum('bhic,bhjc,bhijc->bhij', qi, ki, decay)
        b_last = bi[:, :, -1:, :]
        o = attn @ vi + jnp.einsum('bhic,bhcv->bhiv', qi * jnp.exp(bi), state)
        state = jnp.exp(b_last[:, :, 0, :, None]) * state + jnp.einsum('bhjc,bhjv->bhcv', ki * jnp.exp(b_last - bi), vi)
        return state, o

    state0 = jnp.zeros((bsz, nh, dk, dv), jnp.float32)
    _, o = lax.scan(step, state0, (qc, kc, vc, bc))
    o = o.transpose(1, 0, 3, 2, 4).reshape(bsz, seq, nh, dv)
    o = o * lax.rsqrt(jnp.mean(jnp.square(o), axis=-1, keepdims=True) + LN_EPS)
    o = o.astype(dtype) * norm_g * jax.nn.silu(r).reshape(bsz, seq, nh, dv)
    return o.reshape(bsz, seq, nh * dv)


def compress_blocks(t, pe, w1, w2):
    bsz, seq, g, hd = t.shape
    n_cmp = (seq - NSA_CMP_LEN) // NSA_CMP_STRIDE + 1
    idx = jnp.arange(n_cmp)[:, None] * NSA_CMP_STRIDE + jnp.arange(NSA_CMP_LEN)[None, :]
    blocks = t[:, idx] + pe[:, None, :]
    flat = blocks.transpose(0, 1, 3, 2, 4).reshape(bsz, n_cmp, g, NSA_CMP_LEN * hd)
    return jax.nn.gelu(flat @ w1) @ w2


def nsa_selected_attention(q, k, v, sel_idx):
    bsz, seq, g, r, hd = q.shape
    n_blk = seq // NSA_SEL_LEN
    n_sel = sel_idx.shape[-1]
    kb = k.reshape(bsz, n_blk, NSA_SEL_LEN, g, hd).transpose(0, 3, 1, 2, 4)
    vb = v.reshape(bsz, n_blk, NSA_SEL_LEN, g, hd).transpose(0, 3, 1, 2, 4)
    nqb = seq // NSA_Q_BLOCK
    qx = jnp.moveaxis(q.reshape(bsz, nqb, NSA_Q_BLOCK, g, r, hd), 1, 0)
    ix = jnp.moveaxis(sel_idx.reshape(bsz, g, nqb, NSA_Q_BLOCK, n_sel), 2, 0)
    tp = jnp.arange(seq).reshape(nqb, NSA_Q_BLOCK)
    gather = jax.vmap(jax.vmap(lambda blocks, idx: blocks[idx]))
    offs = jnp.arange(NSA_SEL_LEN)
    scale = hd ** -0.5

    def one_block(args):
        qb, ib, tb = args
        kg = gather(kb, ib)
        vg = gather(vb, ib)
        s = jnp.einsum('bqgrd,bgqnld->bgqrnl', qb, kg).astype(jnp.float32) * scale
        kpos = ib[..., None] * NSA_SEL_LEN + offs
        valid = kpos <= tb[None, None, :, None, None]
        s = jnp.where(valid[:, :, :, None], s, -jnp.inf)
        p = jax.nn.softmax(s.reshape(bsz, g, NSA_Q_BLOCK, r, n_sel * NSA_SEL_LEN), axis=-1)
        p = p.reshape(bsz, g, NSA_Q_BLOCK, r, n_sel, NSA_SEL_LEN)
        return jnp.einsum('bgqrnl,bgqnld->bqgrd', p.astype(vg.dtype), vg)

    o = lax.map(one_block, (qx, ix, tp))
    return jnp.moveaxis(o, 0, 1).reshape(bsz, seq, g, r, hd)


def nsa_mixer(q, k_cmp_in, v_cmp_in, k_sel, v_sel, k_win, v_win, gate_logits,
              pe_k, w1_k, w2_k, pe_v, w1_v, w2_v):
    bsz, seq, g, r, hd = q.shape
    dtype = q.dtype
    pos = jnp.arange(seq)
    scale = hd ** -0.5
    kc = compress_blocks(k_cmp_in, pe_k, w1_k, w2_k)
    vc = compress_blocks(v_cmp_in, pe_v, w1_v, w2_v)
    n_cmp = kc.shape[1]
    cmp_start = jnp.arange(n_cmp) * NSA_CMP_STRIDE
    cvalid = (cmp_start + NSA_CMP_LEN - 1)[None, :] <= pos[:, None]
    s = jnp.einsum('bsgrd,bcgd->bgrsc', q, kc).astype(jnp.float32) * scale
    s = jnp.where(cvalid, s, -jnp.inf)
    m = jnp.max(s, axis=-1, keepdims=True)
    m = jnp.where(jnp.isfinite(m), m, 0.0)
    p = jnp.where(cvalid, jnp.exp(s - m), 0.0)
    p = p / jnp.maximum(jnp.sum(p, axis=-1, keepdims=True), 1e-30)
    o_cmp = jnp.einsum('bgrsc,bcgd->bsgrd', p.astype(dtype), vc)
    n_blk = seq // NSA_SEL_LEN
    sel_start = jnp.arange(n_blk) * NSA_SEL_LEN
    overlap = (cmp_start[:, None] < sel_start[None, :] + NSA_SEL_LEN) & (cmp_start[:, None] + NSA_CMP_LEN > sel_start[None, :])
    imp = jnp.einsum('bgrsc,cj->bgsj', p, overlap.astype(jnp.float32))
    q_blk = pos // NSA_SEL_LEN
    j = jnp.arange(n_blk)[None, :]
    forced = (j == 0) | (j == q_blk[:, None]) | (j == q_blk[:, None] - 1)
    future = j > q_blk[:, None]
    imp = jnp.where(forced, jnp.inf, jnp.where(future, -jnp.inf, imp))
    n_sel = min(NSA_N_SELECT, n_blk)
    _, sel_idx = lax.top_k(imp, n_sel)
    o_sel = nsa_selected_attention(q, k_sel, v_sel, sel_idx)
    o_win, _ = banded_attention(q, k_win, v_win, NSA_WINDOW - 1)
    gates = jax.nn.sigmoid(gate_logits).reshape(bsz, seq, g, r, NSA_BRANCHES)
    o = gates[..., 0:1] * o_cmp + gates[..., 1:2] * o_sel + gates[..., 2:3] * o_win
    return o.reshape(bsz, seq, g * r * hd)


def token_mixer(h, w_in, b_in, w_alpha2, b_alpha, gla_norm_g, cmp_pe_k, cmp_w1_k, cmp_w2_k,
                cmp_pe_v, cmp_w1_v, cmp_w2_v, w_br_a, w_br_b, w_br_c, w_o_mix):
    bsz, seq, d = h.shape
    u = h @ w_in + b_in
    split_points = np.cumsum(IN_WIDTHS)[:-1].tolist()
    (a_q, a_k, a_v, b_q, b_k, b_v, b_r, b_lr, c_q, c_kc, c_vc, c_ks, c_vs, c_kw, c_vw, c_g, m_g) = jnp.split(u, split_points, axis=-1)
    n_grp = len(DIL_GROUPS)

    def a_heads(t):
        return t.reshape(bsz, seq, n_grp, DIL_HEADS, HEAD_DIM)

    y_a = dilated_attention(a_heads(a_q), a_heads(a_k), a_heads(a_v)).reshape(bsz, seq, DIL_HEADS * HEAD_DIM)
    y_b = gla_mixer(b_q, b_k, b_v, b_r, b_lr, w_alpha2, b_alpha, gla_norm_g)

    def c_kv(t):
        return t.reshape(bsz, seq, NSA_KV_GROUPS, HEAD_DIM)

    y_c = nsa_mixer(c_q.reshape(bsz, seq, NSA_KV_GROUPS, NSA_HEADS // NSA_KV_GROUPS, HEAD_DIM),
                    c_kv(c_kc), c_kv(c_vc), c_kv(c_ks), c_kv(c_vs), c_kv(c_kw), c_kv(c_vw), c_g,
                    cmp_pe_k, cmp_w1_k, cmp_w2_k, cmp_pe_v, cmp_w1_v, cmp_w2_v)
    g = jax.nn.sigmoid(m_g).reshape(bsz, seq, N_BRANCHES, d)
    merged = g[:, :, 0] * (y_a @ w_br_a) + g[:, :, 1] * (y_b @ w_br_b) + g[:, :, 2] * (y_c @ w_br_c)
    return merged @ w_o_mix


def memory_cross_attention(x, mem, w_xq, w_xk, w_xv, w_xo):
    bsz, seq, d = x.shape
    hd = d // XATTN_HEADS
    q = (x @ w_xq).reshape(bsz, seq, XATTN_HEADS, hd)
    k = (mem @ w_xk).reshape(bsz, mem.shape[1], XATTN_HEADS, hd)
    v = (mem @ w_xv).reshape(bsz, mem.shape[1], XATTN_HEADS, hd)
    s = jnp.einsum('bshd,bmhd->bhsm', q, k).astype(jnp.float32) * (hd ** -0.5)
    p = jax.nn.softmax(s, axis=-1).astype(x.dtype)
    o = jnp.einsum('bhsm,bmhd->bshd', p, v).reshape(bsz, seq, d)
    return o @ w_xo


def clamped_swiglu(gate, up):
    gate = jnp.minimum(gate, SWIGLU_LIMIT)
    up = jnp.clip(up, -SWIGLU_LIMIT, SWIGLU_LIMIT)
    return (up + 1.0) * gate * jax.nn.sigmoid(SWIGLU_ALPHA * gate)


def moe_ffn(h, w_router, b_router, w_gu, b_gu, w_down, b_down):
    bsz, seq, d = h.shape
    t = h.reshape(-1, d)
    n_assign = t.shape[0] * TOP_K
    logits = t @ w_router + b_router
    top_logits, top_idx = lax.top_k(logits, TOP_K)
    gates = jax.nn.softmax(top_logits.astype(jnp.float32), axis=-1).astype(t.dtype)
    flat_e = top_idx.reshape(-1)
    order = jnp.argsort(flat_e)
    sorted_e = flat_e[order]
    tok_of = order // TOP_K
    counts = jnp.bincount(flat_e, length=N_EXPERTS)
    padded = (counts + MOE_BLOCK - 1) // MOE_BLOCK * MOE_BLOCK
    start = jnp.cumsum(counts) - counts
    pend = jnp.cumsum(padded)
    pstart = pend - padded
    dest = pstart[sorted_e] + (jnp.arange(n_assign) - start[sorted_e])
    n_rows = n_assign + N_EXPERTS * MOE_BLOCK
    n_blocks = n_rows // MOE_BLOCK
    buf = jnp.zeros((n_rows, d), t.dtype).at[dest].set(t[tok_of])
    block_e = jnp.minimum(jnp.searchsorted(pend, jnp.arange(n_blocks) * MOE_BLOCK, side='right'), N_EXPERTS - 1)

    def expert_block(args):
        xb, e = args
        gu = xb @ w_gu[e] + b_gu[e]
        return clamped_swiglu(gu[:, :D_FF], gu[:, D_FF:]) @ w_down[e] + b_down[e]

    out = lax.map(expert_block, (buf.reshape(n_blocks, MOE_BLOCK, d), block_e))
    y_assign = out.reshape(n_rows, d)[dest] * gates.reshape(-1)[order][:, None]
    y = jnp.zeros_like(t).at[tok_of].add(y_assign)
    return y.reshape(bsz, seq, d)


def setup_inputs(seed: int = 0) -> dict:
    key = jax.random.key(seed)
    keys = iter(jax.random.split(key, 40))

    def nrm(shape, scale):
        return jax.random.normal(next(keys), shape, jnp.float32) * scale

    dl, d, hd = DEPTH, D_MODEL, HEAD_DIM
    beta = DEEPNORM_BETA
    return {
        'x': nrm((BATCH, SEQ, d), 1.0),
        'mem': nrm((BATCH, MEM_LEN, d), 1.0),
        'ln0_g': 1.0 + nrm((d,), 0.02),
        'ln0_b': nrm((d,), 0.02),
        'w_in': nrm((dl, d, N_IN), d ** -0.5),
        'b_in': nrm((dl, N_IN), 0.02),
        'w_alpha2': nrm((dl, GLA_RANK, B_K), GLA_RANK ** -0.5),
        'b_alpha': nrm((dl, B_K), 0.1),
        'gla_norm_g': 1.0 + nrm((dl, GLA_DV), 0.02),
        'cmp_pe_k': nrm((dl, NSA_CMP_LEN, hd), 0.02),
        'cmp_w1_k': nrm((dl, NSA_CMP_LEN * hd, NSA_CMP_HIDDEN), (NSA_CMP_LEN * hd) ** -0.5),
        'cmp_w2_k': nrm((dl, NSA_CMP_HIDDEN, hd), NSA_CMP_HIDDEN ** -0.5),
        'cmp_pe_v': nrm((dl, NSA_CMP_LEN, hd), 0.02),
        'cmp_w1_v': nrm((dl, NSA_CMP_LEN * hd, NSA_CMP_HIDDEN), (NSA_CMP_LEN * hd) ** -0.5),
        'cmp_w2_v': nrm((dl, NSA_CMP_HIDDEN, hd), NSA_CMP_HIDDEN ** -0.5),
        'w_br_a': nrm((dl, DIL_HEADS * hd, d), (DIL_HEADS * hd) ** -0.5),
        'w_br_b': nrm((dl, B_V, d), B_V ** -0.5),
        'w_br_c': nrm((dl, C_Q, d), C_Q ** -0.5),
        'w_o_mix': nrm((dl, d, d), beta * d ** -0.5),
        'ln1_g': 1.0 + nrm((dl, d), 0.02),
        'ln1_b': nrm((dl, d), 0.02),
        'w_xq': nrm((dl, d, d), d ** -0.5),
        'w_xk': nrm((dl, d, d), d ** -0.5),
        'w_xv': nrm((dl, d, d), d ** -0.5),
        'w_xo': nrm((dl, d, d), beta * d ** -0.5),
        'ln2_g': 1.0 + nrm((dl, d), 0.02),
        'ln2_b': nrm((dl, d), 0.02),
        'w_router': nrm((dl, d, N_EXPERTS), d ** -0.5),
        'b_router': nrm((dl, N_EXPERTS), 0.01),
        'w_gu': nrm((dl, N_EXPERTS, d, 2 * D_FF), d ** -0.5),
        'b_gu': nrm((dl, N_EXPERTS, 2 * D_FF), 0.02),
        'w_down': nrm((dl, N_EXPERTS, D_FF, d), beta * D_FF ** -0.5),
        'b_down': nrm((dl, N_EXPERTS, d), 0.02),
        'ln3_g': 1.0 + nrm((dl, d), 0.02),
        'ln3_b': nrm((dl, d), 0.02),
    }


def reference(x, mem, ln0_g, ln0_b, w_in, b_in, w_alpha2, b_alpha, gla_norm_g,
              cmp_pe_k, cmp_w1_k, cmp_w2_k, cmp_pe_v, cmp_w1_v, cmp_w2_v,
              w_br_a, w_br_b, w_br_c, w_o_mix, ln1_g, ln1_b,
              w_xq, w_xk, w_xv, w_xo, ln2_g, ln2_b,
              w_router, b_router, w_gu, b_gu, w_down, b_down, ln3_g, ln3_b):
    alpha = DEEPNORM_ALPHA
    x = layer_norm(x, ln0_g, ln0_b)
    for li in range(DEPTH):
        mix = token_mixer(x, w_in[li], b_in[li], w_alpha2[li], b_alpha[li], gla_norm_g[li],
                          cmp_pe_k[li], cmp_w1_k[li], cmp_w2_k[li], cmp_pe_v[li], cmp_w1_v[li], cmp_w2_v[li],
                          w_br_a[li], w_br_b[li], w_br_c[li], w_o_mix[li])
        x = layer_norm(alpha * x + mix, ln1_g[li], ln1_b[li])
        xa = memory_cross_attention(x, mem, w_xq[li], w_xk[li], w_xv[li], w_xo[li])
        x = layer_norm(alpha * x + xa, ln2_g[li], ln2_b[li])
        ff = moe_ffn(x, w_router[li], b_router[li], w_gu[li], b_gu[li], w_down[li], b_down[li])
        x = layer_norm(alpha * x + ff, ln3_g[li], ln3_b[li])
    return x
```

```cpp
#ifndef CPU_TEST
#include <hip/hip_runtime.h>
#include <hip/hip_cooperative_groups.h>
#include <cstdio>
#include <cstring>
#include <cmath>
namespace cg = cooperative_groups;
#define DEV __device__ __forceinline__
#define HDI __host__ __device__ __forceinline__
#else
#include <cmath>
#include <cstdio>
#include <cstdlib>
#include <cstring>
#define DEV static inline
#define HDI static inline
#endif

#ifndef D_MODEL
#define D_MODEL 1024
#endif
#ifndef BATCH
#define BATCH 8
#endif
#ifndef MEGA
#define MEGA 1
#endif

constexpr int D = D_MODEL;
constexpr int SEQ = 2048;
constexpr int DEPTH = 2;
constexpr int MEM_LEN = 256;
constexpr int HD = 64;
constexpr int N_TOK = BATCH * SEQ;
constexpr int GLA_H = 4;
constexpr int DK = D / 2 / GLA_H;
constexpr int DV = D / GLA_H;
constexpr int GLA_RANK = 16;
constexpr int B_K = GLA_H * DK;
constexpr int B_V = GLA_H * DV;
constexpr int NSA_H = 16;
constexpr int NSA_G = 4;
constexpr int N_CMP = 127;
constexpr int CMP_HID = 128;
constexpr int N_BLK = 32;
constexpr int N_SELECT = 16;
constexpr int NSA_WIN = 512;
constexpr int XH = 4;
constexpr int XHD = D / XH;
constexpr int NE = 32;
constexpr int TOPK = 4;
constexpr int DFF = D;
constexpr float LN_EPS = 1e-5f;
constexpr float ALPHA = 1.41421356237309515f;

constexpr int OFF_AQ = 0;
constexpr int OFF_AK = 768;
constexpr int OFF_AV = 1536;
constexpr int OFF_BQ = 2304;
constexpr int OFF_BK = OFF_BQ + B_K;
constexpr int OFF_BV = OFF_BK + B_K;
constexpr int OFF_BR = OFF_BV + B_V;
constexpr int OFF_LR = OFF_BR + B_V;
constexpr int OFF_CQ = OFF_LR + GLA_RANK;
constexpr int OFF_CKC = OFF_CQ + 1024;
constexpr int OFF_CVC = OFF_CKC + 256;
constexpr int OFF_CKS = OFF_CVC + 256;
constexpr int OFF_CVS = OFF_CKS + 256;
constexpr int OFF_CKW = OFF_CVS + 256;
constexpr int OFF_CVW = OFF_CKW + 256;
constexpr int OFF_CG = OFF_CVW + 256;
constexpr int OFF_MG = OFF_CG + 48;
constexpr int N_IN = OFF_MG + 3 * D;
constexpr int N_IN_PAD = (N_IN + 255) / 256 * 256;
constexpr int MOE_ROWS = N_TOK * 4 + 32 * 256;
constexpr int CMP_ROWS_PAD = 4096;
constexpr int YLD = 256 + 1024 + 1024;

#ifdef CPU_TEST
typedef float act_t;
DEV float ldf(float v) { return v; }
DEV void stf(float* p, float v) { *p = v; }
#else
typedef unsigned short act_t;
DEV float ldf(unsigned short h) { return __uint_as_float(((unsigned)h) << 16); }
DEV float ldf(float v) { return v; }
DEV unsigned short f2bf(float f) {
  unsigned u = __float_as_uint(f);
  u += 0x7fffu + ((u >> 16) & 1u);
  return (unsigned short)(u >> 16);
}
DEV void stf(unsigned short* p, float v) { *p = f2bf(v); }
DEV void stf(float* p, float v) { *p = v; }
#endif

struct Params {
  const float *x, *mem, *ln0_g, *ln0_b, *w_in, *b_in, *w_alpha2, *b_alpha, *gla_norm_g,
      *cmp_pe_k, *cmp_w1_k, *cmp_w2_k, *cmp_pe_v, *cmp_w1_v, *cmp_w2_v,
      *w_br_a, *w_br_b, *w_br_c, *w_o_mix, *ln1_g, *ln1_b, *w_xq, *w_xk, *w_xv, *w_xo, *ln2_g, *ln2_b,
      *w_router, *b_router, *w_gu, *b_gu, *w_down, *b_down, *ln3_g, *ln3_b;
  float* out;
  float* xf;
  act_t* xb;
  act_t* u;
  float* ga;
  float* hid;
  float* kcv;
  float* opart;
  act_t* ya;
  act_t* yb;
  act_t* yc;
  float* pcmp;
  float* ocmp;
  float* impb;
  int* selb;
  act_t* merged;
  float* tmp;
  act_t* xq;
  act_t* memk;
  act_t* memv;
  float* xs;
  act_t* xo;
  float* rl;
  int* topi;
  float* topg;
  act_t* act;
  act_t* wt_in;
  act_t* wt_c1;
  act_t* wt_bra;
  act_t* wt_brb;
  act_t* wt_brc;
  act_t* wt_omix;
  act_t* wt_xq;
  act_t* wt_xk;
  act_t* wt_xv;
  act_t* wt_xo;
  act_t* wt_gu;
  act_t* wt_dn;
  act_t* membf;
  act_t* cmpA;
  float* mrg;
  int* cnt;
  int* rank;
  int* rowlist;
  act_t* xg;
  act_t* actg;
  float* yass;
  act_t* kcb;
  act_t* dilo;
  float* dill;
  unsigned* selm;
  act_t* gU;
  act_t* gS;
  act_t* gQ;
  float* gD;
  unsigned* barw;
  size_t ws_used;
};

#ifdef CPU_TEST
#define FOR_IDX(idx, total) \
  for (long long idx = (long long)(total) * tid / nthr, _e = (long long)(total) * (tid + 1) / nthr; idx < _e; ++idx)
#else
#define FOR_IDX(idx, total) for (long long idx = tid; idx < (long long)(total); idx += nthr)
#endif

DEV float sigmoidf_(float x) { return 1.0f / (1.0f + expf(-x)); }

template <class TA>
DEV float dotcol(const TA* a, const float* W, int K, long long ldw) {
  float s = 0.f;
  for (int k = 0; k < K; ++k) s += ldf(a[k]) * W[(long long)k * ldw];
  return s;
}

DEV void ph_ln(const float* src, const float* g, const float* b, float* dstf, act_t* dstb, float* dst2,
               long long tid, long long nthr) {
  FOR_IDX(n, N_TOK) {
    const float* r = src + n * D;
    float mu = 0.f;
    for (int i = 0; i < D; ++i) mu += r[i];
    mu /= D;
    float var = 0.f;
    for (int i = 0; i < D; ++i) { float d = r[i] - mu; var += d * d; }
    var /= D;
    float rs = 1.0f / sqrtf(var + LN_EPS);
    for (int i = 0; i < D; ++i) {
      float y = (r[i] - mu) * rs * g[i] + b[i];
      dstf[n * D + i] = y;
      stf(&dstb[n * D + i], y);
      if (dst2) dst2[n * D + i] = y;
    }
  }
}

DEV void ph_inproj(const Params& p, int li, long long tid, long long nthr) {
  const float* W = p.w_in + (long long)li * D * N_IN;
  const float* bias = p.b_in + (long long)li * N_IN;
  FOR_IDX(idx, (long long)N_TOK * N_IN) {
    long long n = idx / N_IN; int c = (int)(idx % N_IN);
    stf(&p.u[idx], dotcol(p.xb + n * D, W + c, D, N_IN) + bias[c]);
  }
}

DEV float gelu_tanh(float x) {
  return 0.5f * x * (1.0f + tanhf(0.7978845608028654f * (x + 0.044715f * x * x * x)));
}

constexpr int CMP_ROWS = BATCH * N_CMP * NSA_G;

template <int PARTS>
DEV void ph_pre(const Params& p, int li, long long tid, long long nthr) {
  const long long T1 = (long long)N_TOK * B_K;
  const long long T2 = (PARTS & 2) ? 2LL * CMP_ROWS * CMP_HID : 0;
  FOR_IDX(idx, T1 + T2) {
    if (idx < T1) {
      if (!(PARTS & 1)) continue;
      long long n = idx / B_K; int c = (int)(idx % B_K);
      const float* W2 = p.w_alpha2 + (long long)li * GLA_RANK * B_K;
      float z = p.b_alpha[li * B_K + c];
      for (int r = 0; r < GLA_RANK; ++r) z += ldf(p.u[n * N_IN + OFF_LR + r]) * W2[r * B_K + c];
      float ls = fminf(z, 0.f) - log1pf(expf(-fabsf(z)));
      p.ga[idx] = expf(ls * (1.0f / 16.0f));
    } else {
      long long i2 = idx - T1;
      int which = (int)(i2 / ((long long)CMP_ROWS * CMP_HID));
      long long rem = i2 % ((long long)CMP_ROWS * CMP_HID);
      int row = (int)(rem / CMP_HID), j = (int)(rem % CMP_HID);
      int g = row % NSA_G; int c = (row / NSA_G) % N_CMP; int b = row / (NSA_G * N_CMP);
      const float* pe = (which ? p.cmp_pe_v : p.cmp_pe_k) + (long long)li * 32 * HD;
      const float* w1 = (which ? p.cmp_w1_v : p.cmp_w1_k) + (long long)li * 32 * HD * CMP_HID;
      int off = (which ? OFF_CVC : OFF_CKC) + g * HD;
      float s = 0.f;
      for (int l = 0; l < 32; ++l) {
        const act_t* ur = p.u + ((long long)b * SEQ + c * 16 + l) * N_IN + off;
        for (int d = 0; d < HD; ++d) s += (ldf(ur[d]) + pe[l * HD + d]) * w1[(long long)(l * HD + d) * CMP_HID + j];
      }
      p.hid[i2] = gelu_tanh(s);
    }
  }
}

template <int PARTS>
DEV void ph_mix1(const Params& p, int li, long long tid, long long nthr) {
  const long long T1 = (long long)N_TOK * 4;
  const long long T2 = (long long)BATCH * GLA_H * DV * 4;
  const long long T3 = 2LL * CMP_ROWS * HD;
  FOR_IDX(idx, T1 + T2 + T3) {
    if (idx < T1) {
      if (!(PARTS & 1)) continue;
      long long n = idx / 4; int h = (int)(idx % 4);
      int b = (int)(n / SEQ), t = (int)(n % SEQ);
      float m = -INFINITY, l = 0.f;
      float acc[HD];
#pragma unroll
      for (int d = 0; d < HD; ++d) acc[d] = 0.f;
      for (int gi = 0; gi < 3; ++gi) {
        const int dil = gi == 0 ? 1 : (gi == 1 ? 4 : 16);
        float q[HD];
        const act_t* qp = p.u + n * N_IN + OFF_AQ + gi * 256 + h * HD;
#pragma unroll
        for (int d = 0; d < HD; ++d) q[d] = ldf(qp[d]);
        for (int mm = 0; mm <= 128; ++mm) {
          int tk = t - mm * dil;
          if (tk < 0) break;
          const act_t* kp = p.u + ((long long)b * SEQ + tk) * N_IN + OFF_AK + gi * 256 + h * HD;
          const act_t* vp = p.u + ((long long)b * SEQ + tk) * N_IN + OFF_AV + gi * 256 + h * HD;
          float s = 0.f;
#pragma unroll
          for (int d = 0; d < HD; ++d) s += q[d] * ldf(kp[d]);
          s *= 0.125f;
          float mn = fmaxf(m, s);
          float corr = expf(m - mn);
          float pp = expf(s - mn);
          l = l * corr + pp;
#pragma unroll
          for (int d = 0; d < HD; ++d) acc[d] = acc[d] * corr + pp * ldf(vp[d]);
          m = mn;
        }
      }
      float inv = 1.0f / l;
#pragma unroll
      for (int d = 0; d < HD; ++d) stf(&p.ya[n * 256 + h * HD + d], acc[d] * inv);
    } else if (idx < T1 + T2) {
      if (!(PARTS & 2)) continue;
      long long i2 = idx - T1;
      int v = (int)(i2 % DV); int cq = (int)((i2 / DV) % 4); int h = (int)((i2 / (DV * 4)) % GLA_H);
      int b = (int)(i2 / (DV * 4 * GLA_H));
      constexpr int DKQ = DK / 4;
      float st[DKQ];
#pragma unroll
      for (int c = 0; c < DKQ; ++c) st[c] = 0.f;
      const float qs = 1.0f / sqrtf((float)DK);
      for (int t = 0; t < SEQ; ++t) {
        long long n = (long long)b * SEQ + t;
        const act_t* ur = p.u + n * N_IN;
        float vt = ldf(ur[OFF_BV + h * DV + v]);
        const float* gar = p.ga + n * B_K + h * DK + cq * DKQ;
        const act_t* kr = ur + OFF_BK + h * DK + cq * DKQ;
        const act_t* qr = ur + OFF_BQ + h * DK + cq * DKQ;
        float o = 0.f;
#pragma unroll
        for (int c = 0; c < DKQ; ++c) {
          st[c] = gar[c] * st[c] + ldf(kr[c]) * vt;
          o += ldf(qr[c]) * st[c];
        }
        p.opart[((long long)cq * N_TOK + n) * B_V + h * DV + v] = o * qs;
      }
    } else {
      long long i2 = idx - T1 - T2;
      int which = (int)(i2 / ((long long)CMP_ROWS * HD));
      long long rem = i2 % ((long long)CMP_ROWS * HD);
      int row = (int)(rem / HD), d = (int)(rem % HD);
      const float* w2 = (which ? p.cmp_w2_v : p.cmp_w2_k) + (long long)li * CMP_HID * HD;
      const float* hr = p.hid + ((long long)which * CMP_ROWS + row) * CMP_HID;
      float s = 0.f;
      if (!(PARTS & 4)) continue;
      for (int j = 0; j < CMP_HID; ++j) s += hr[j] * w2[j * HD + d];
      p.kcv[i2] = s;
#ifndef CPU_TEST
      {
        const int g_ = row % NSA_G, c_ = (row / NSA_G) % N_CMP, b_ = row / (NSA_G * N_CMP);
        stf(&p.kcb[((((size_t)which * BATCH + b_) * 128 + c_) * NSA_G + g_) * 64 + d], s);
      }
#endif
    }
  }
}

template <int PARTS>
DEV void ph_nsa1(const Params& p, int li, long long tid, long long nthr) {
  const long long T1 = (long long)N_TOK * GLA_H;
  const long long T2 = (PARTS & 2) ? (long long)N_TOK * NSA_H : 0;
  FOR_IDX(idx, T1 + T2) {
    if (idx < T1) {
      long long n = idx / GLA_H; int h = (int)(idx % GLA_H);
      float ss = 0.f;
      for (int v = 0; v < DV; ++v) {
        float o = 0.f;
        for (int cq = 0; cq < 4; ++cq) o += p.opart[((long long)cq * N_TOK + n) * B_V + h * DV + v];
        ss += o * o;
      }
      float rs = 1.0f / sqrtf(ss / DV + LN_EPS);
      for (int v = 0; v < DV; ++v) {
        float o = 0.f;
        for (int cq = 0; cq < 4; ++cq) o += p.opart[((long long)cq * N_TOK + n) * B_V + h * DV + v];
        float r = ldf(p.u[n * N_IN + OFF_BR + h * DV + v]);
        float y = o * rs * p.gla_norm_g[li * DV + v] * (r * sigmoidf_(r));
        stf(&p.yb[n * B_V + h * DV + v], y);
      }
    } else {
      long long i2 = idx - T1;
      long long n = i2 / NSA_H; int hh = (int)(i2 % NSA_H);
      int b = (int)(n / SEQ), t = (int)(n % SEQ);
      int g = hh / 4;
      int nv = t >= 31 ? (t - 31) / 16 + 1 : 0;
      if (nv > N_CMP) nv = N_CMP;
      float q[HD];
      const act_t* qp = p.u + n * N_IN + OFF_CQ + hh * HD;
#pragma unroll
      for (int d = 0; d < HD; ++d) q[d] = ldf(qp[d]);
      float* prow = p.pcmp + (((long long)b * NSA_H + hh) * SEQ + t) * 128;
      float m = -INFINITY;
      for (int c = 0; c < nv; ++c) {
        const float* kp = p.kcv + (((long long)b * N_CMP + c) * NSA_G + g) * HD;
        float s = 0.f;
#pragma unroll
        for (int d = 0; d < HD; ++d) s += q[d] * kp[d];
        s *= 0.125f;
        prow[c] = s;
        m = fmaxf(m, s);
      }
      float acc[HD];
#pragma unroll
      for (int d = 0; d < HD; ++d) acc[d] = 0.f;
      float l = 0.f;
      for (int c = 0; c < nv; ++c) {
        const float* vp = p.kcv + (((long long)CMP_ROWS) + ((long long)b * N_CMP + c) * NSA_G + g) * HD;
        float pp = expf(prow[c] - m);
        l += pp;
        prow[c] = pp;
#pragma unroll
        for (int d = 0; d < HD; ++d) acc[d] += pp * vp[d];
      }
      float inv = 1.0f / fmaxf(l, 1e-30f);
      for (int c = 0; c < 128; ++c) prow[c] = c < nv ? prow[c] * inv : 0.f;
#pragma unroll
      for (int d = 0; d < HD; ++d) p.ocmp[n * 1024 + hh * HD + d] = acc[d] * inv;
    }
  }
}

DEV void ph_nsa2(const Params& p, int li, long long tid, long long nthr) {
  FOR_IDX(idx, (long long)BATCH * NSA_G * SEQ * N_BLK) {
    int j = (int)(idx % N_BLK); long long r = idx / N_BLK;
    int s = (int)(r % SEQ); int g = (int)((r / SEQ) % NSA_G); int b = (int)(r / ((long long)SEQ * NSA_G));
    int qb = s / 64;
    float imp;
    if (j == 0 || j == qb || j == qb - 1) imp = INFINITY;
    else if (j > qb) imp = -INFINITY;
    else {
      imp = 0.f;
      int c0 = 4 * j - 1; if (c0 < 0) c0 = 0;
      int c1 = 4 * j + 3; if (c1 > N_CMP - 1) c1 = N_CMP - 1;
      for (int rr = 0; rr < 4; ++rr) {
        const float* prow = p.pcmp + (((long long)b * NSA_H + g * 4 + rr) * SEQ + s) * 128;
        for (int c = c0; c <= c1; ++c) imp += prow[c];
      }
    }
    p.impb[idx] = imp;
  }
}

DEV void ph_nsa3(const Params& p, int li, long long tid, long long nthr) {
  FOR_IDX(idx, (long long)BATCH * NSA_G * SEQ * N_BLK) {
    int j = (int)(idx % N_BLK); long long r = idx / N_BLK;
    const float* ir = p.impb + r * N_BLK;
    float v = ir[j];
    int rank = 0;
    for (int jj = 0; jj < N_BLK; ++jj) {
      float w = ir[jj];
      if (w > v || (w == v && jj < j)) ++rank;
    }
    p.selb[idx] = rank < N_SELECT ? 1 : 0;
  }
}

DEV void ph_nsa4(const Params& p, int li, long long tid, long long nthr) {
  FOR_IDX(idx, (long long)N_TOK * NSA_H) {
    long long n = idx / NSA_H; int hh = (int)(idx % NSA_H);
    int b = (int)(n / SEQ), t = (int)(n % SEQ);
    int g = hh / 4;
    float q[HD];
    const act_t* qp = p.u + n * N_IN + OFF_CQ + hh * HD;
#pragma unroll
    for (int d = 0; d < HD; ++d) q[d] = ldf(qp[d]);
    float g0 = sigmoidf_(ldf(p.u[n * N_IN + OFF_CG + hh * 3 + 0]));
    float g1 = sigmoidf_(ldf(p.u[n * N_IN + OFF_CG + hh * 3 + 1]));
    float g2 = sigmoidf_(ldf(p.u[n * N_IN + OFF_CG + hh * 3 + 2]));
    float acc[HD];
    {
      float m = -INFINITY, l = 0.f;
#pragma unroll
      for (int d = 0; d < HD; ++d) acc[d] = 0.f;
      int qb = t / 64;
      const int* sr = p.selb + (((long long)b * NSA_G + g) * SEQ + t) * N_BLK;
      for (int j = 0; j <= qb; ++j) {
        if (!sr[j]) continue;
        int hi = j * 64 + 63; if (hi > t) hi = t;
        for (int tk = j * 64; tk <= hi; ++tk) {
          const act_t* kp = p.u + ((long long)b * SEQ + tk) * N_IN + OFF_CKS + g * HD;
          const act_t* vp = p.u + ((long long)b * SEQ + tk) * N_IN + OFF_CVS + g * HD;
          float s = 0.f;
#pragma unroll
          for (int d = 0; d < HD; ++d) s += q[d] * ldf(kp[d]);
          s *= 0.125f;
          float mn = fmaxf(m, s);
          float corr = expf(m - mn);
          float pp = expf(s - mn);
          l = l * corr + pp;
#pragma unroll
          for (int d = 0; d < HD; ++d) acc[d] = acc[d] * corr + pp * ldf(vp[d]);
          m = mn;
        }
      }
      float inv = 1.0f / l;
#pragma unroll
      for (int d = 0; d < HD; ++d) {
        float* oc = &p.ocmp[n * 1024 + hh * HD + d];
        *oc = g0 * (*oc) + g1 * acc[d] * inv;
      }
    }
    {
      float m = -INFINITY, l = 0.f;
#pragma unroll
      for (int d = 0; d < HD; ++d) acc[d] = 0.f;
      int lo = t - (NSA_WIN - 1); if (lo < 0) lo = 0;
      for (int tk = lo; tk <= t; ++tk) {
        const act_t* kp = p.u + ((long long)b * SEQ + tk) * N_IN + OFF_CKW + g * HD;
        const act_t* vp = p.u + ((long long)b * SEQ + tk) * N_IN + OFF_CVW + g * HD;
        float s = 0.f;
#pragma unroll
        for (int d = 0; d < HD; ++d) s += q[d] * ldf(kp[d]);
        s *= 0.125f;
        float mn = fmaxf(m, s);
        float corr = expf(m - mn);
        float pp = expf(s - mn);
        l = l * corr + pp;
#pragma unroll
        for (int d = 0; d < HD; ++d) acc[d] = acc[d] * corr + pp * ldf(vp[d]);
        m = mn;
      }
      float inv = 1.0f / l;
#pragma unroll
      for (int d = 0; d < HD; ++d)
        stf(&p.yc[n * 1024 + hh * HD + d], p.ocmp[n * 1024 + hh * HD + d] + g2 * acc[d] * inv);
    }
  }
}

DEV void ph_br(const Params& p, int li, long long tid, long long nthr) {
  const float* Wa = p.w_br_a + (long long)li * 256 * D;
  const float* Wb = p.w_br_b + (long long)li * B_V * D;
  const float* Wc = p.w_br_c + (long long)li * 1024 * D;
  FOR_IDX(idx, (long long)N_TOK * D) {
    long long n = idx / D; int d = (int)(idx % D);
    float s0 = dotcol(p.ya + n * 256, Wa + d, 256, D);
    float s1 = dotcol(p.yb + n * B_V, Wb + d, B_V, D);
    float s2 = dotcol(p.yc + n * 1024, Wc + d, 1024, D);
    const act_t* mg = p.u + n * N_IN + OFF_MG;
    float y = sigmoidf_(ldf(mg[d])) * s0 + sigmoidf_(ldf(mg[D + d])) * s1 + sigmoidf_(ldf(mg[2 * D + d])) * s2;
    stf(&p.merged[idx], y);
  }
}

DEV void ph_proj_res(const Params& p, const act_t* a, const float* W, long long tid, long long nthr) {
  FOR_IDX(idx, (long long)N_TOK * D) {
    long long n = idx / D; int d = (int)(idx % D);
    p.tmp[idx] = ALPHA * p.xf[idx] + dotcol(a + n * D, W + d, D, D);
  }
}

DEV void ph_xq(const Params& p, int li, long long tid, long long nthr) {
  const long long T1 = (long long)N_TOK * D;
  const long long T2 = 2LL * BATCH * MEM_LEN * D;
  const float* Wq = p.w_xq + (long long)li * D * D;
  FOR_IDX(idx, T1 + T2) {
    if (idx < T1) {
      long long n = idx / D; int d = (int)(idx % D);
      stf(&p.xq[idx], dotcol(p.xb + n * D, Wq + d, D, D));
    } else {
      long long i2 = idx - T1;
      int which = (int)(i2 / ((long long)BATCH * MEM_LEN * D));
      long long rem = i2 % ((long long)BATCH * MEM_LEN * D);
      long long r = rem / D; int d = (int)(rem % D);
      const float* W = (which ? p.w_xv : p.w_xk) + (long long)li * D * D;
      float s = dotcol(p.mem + r * D, W + d, D, D);
      stf(which ? &p.memv[rem] : &p.memk[rem], s);
    }
  }
}

DEV void ph_xs(const Params& p, int li, long long tid, long long nthr) {
  const float sc = 1.0f / sqrtf((float)XHD);
  FOR_IDX(idx, (long long)N_TOK * XH * MEM_LEN) {
    int m = (int)(idx % MEM_LEN); int h = (int)((idx / MEM_LEN) % XH); long long n = idx / (MEM_LEN * XH);
    int b = (int)(n / SEQ);
    const act_t* q = p.xq + n * D + h * XHD;
    const act_t* k = p.memk + ((long long)b * MEM_LEN + m) * D + h * XHD;
    float s = 0.f;
    for (int d = 0; d < XHD; ++d) s += ldf(q[d]) * ldf(k[d]);
    p.xs[idx] = s * sc;
  }
}

DEV void ph_xo(const Params& p, int li, long long tid, long long nthr) {
  FOR_IDX(idx, (long long)N_TOK * D) {
    long long n = idx / D; int c = (int)(idx % D);
    int h = c / XHD; int b = (int)(n / SEQ);
    const float* sr = p.xs + (n * XH + h) * MEM_LEN;
    float m = -INFINITY;
    for (int mm = 0; mm < MEM_LEN; ++mm) m = fmaxf(m, sr[mm]);
    float l = 0.f, o = 0.f;
    for (int mm = 0; mm < MEM_LEN; ++mm) {
      float pp = expf(sr[mm] - m);
      l += pp;
      o += pp * ldf(p.memv[((long long)b * MEM_LEN + mm) * D + c]);
    }
    stf(&p.xo[idx], o / l);
  }
}

DEV void ph_rlogit(const Params& p, int li, long long tid, long long nthr) {
  const float* W = p.w_router + (long long)li * D * NE;
  FOR_IDX(idx, (long long)N_TOK * NE) {
    long long n = idx / NE; int e = (int)(idx % NE);
    p.rl[idx] = dotcol(p.xf + n * D, W + e, D, NE) + p.b_router[li * NE + e];
  }
}

DEV void ph_route(const Params& p, int li, long long tid, long long nthr) {
  FOR_IDX(n, N_TOK) {
    const float* r = p.rl + n * NE;
    int i0 = -1, i1 = -1, i2 = -1, i3 = -1;
    float v0 = 0, v1 = 0, v2 = 0, v3 = 0;
    for (int k = 0; k < 4; ++k) {
      int bi = -1; float bv = -INFINITY;
      for (int e = 0; e < NE; ++e) {
        if (e == i0 || e == i1 || e == i2) continue;
        float v = r[e];
        if (bi < 0 || v > bv) { bi = e; bv = v; }
      }
      if (k == 0) { i0 = bi; v0 = bv; } else if (k == 1) { i1 = bi; v1 = bv; }
      else if (k == 2) { i2 = bi; v2 = bv; } else { i3 = bi; v3 = bv; }
    }
    float e0 = 1.0f, e1 = expf(v1 - v0), e2 = expf(v2 - v0), e3 = expf(v3 - v0);
    float inv = 1.0f / (e0 + e1 + e2 + e3);
#ifndef CPU_TEST
    p.rank[n * 4 + 0] = atomicAdd(&p.cnt[li * 32 + i0], 1);
    p.rank[n * 4 + 1] = atomicAdd(&p.cnt[li * 32 + i1], 1);
    p.rank[n * 4 + 2] = atomicAdd(&p.cnt[li * 32 + i2], 1);
    p.rank[n * 4 + 3] = atomicAdd(&p.cnt[li * 32 + i3], 1);
#endif
    p.topi[n * 4 + 0] = i0; p.topi[n * 4 + 1] = i1; p.topi[n * 4 + 2] = i2; p.topi[n * 4 + 3] = i3;
    p.topg[n * 4 + 0] = e0 * inv; p.topg[n * 4 + 1] = e1 * inv; p.topg[n * 4 + 2] = e2 * inv; p.topg[n * 4 + 3] = e3 * inv;
  }
}

DEV void ph_moe1(const Params& p, int li, long long tid, long long nthr) {
  FOR_IDX(idx, (long long)N_TOK * TOPK * DFF) {
    int j = (int)(idx % DFF); long long a = idx / DFF; long long n = a / TOPK;
    int e = p.topi[a];
    const float* W = p.w_gu + ((long long)li * NE + e) * D * 2 * DFF;
    const float* bb = p.b_gu + ((long long)li * NE + e) * 2 * DFF;
    float gt = dotcol(p.xb + n * D, W + j, D, 2 * DFF) + bb[j];
    float up = dotcol(p.xb + n * D, W + DFF + j, D, 2 * DFF) + bb[DFF + j];
    gt = fminf(gt, 7.0f);
    up = fminf(fmaxf(up, -7.0f), 7.0f);
    stf(&p.act[idx], (up + 1.0f) * gt * sigmoidf_(1.702f * gt));
  }
}

DEV void ph_moe2(const Params& p, int li, long long tid, long long nthr) {
  FOR_IDX(idx, (long long)N_TOK * D) {
    long long n = idx / D; int d = (int)(idx % D);
    float y = 0.f;
    for (int k = 0; k < TOPK; ++k) {
      int e = p.topi[n * 4 + k];
      const float* W = p.w_down + ((long long)li * NE + e) * DFF * D;
      float s = dotcol(p.act + (n * 4 + k) * DFF, W + d, DFF, D) + p.b_down[((long long)li * NE + e) * D + d];
      y += p.topg[n * 4 + k] * s;
    }
    p.tmp[idx] = ALPHA * p.xf[idx] + y;
  }
}

constexpr int PH_PER_LAYER = 20;
constexpr int N_PHASES = 1 + DEPTH * PH_PER_LAYER;

template <int K>
DEV void run_phase_k(const Params& p, int li, long long tid, long long nthr) {
  if constexpr (K == -1) ph_ln(p.x, p.ln0_g, p.ln0_b, p.xf, p.xb, nullptr, tid, nthr);
  if constexpr (K == 0) ph_inproj(p, li, tid, nthr);
  if constexpr (K == 1) ph_pre<3>(p, li, tid, nthr);
  if constexpr (K == 20) ph_pre<1>(p, li, tid, nthr);
  if constexpr (K == 2) ph_mix1<7>(p, li, tid, nthr);
  if constexpr (K == 21) ph_mix1<4>(p, li, tid, nthr);
  if constexpr (K == 3) ph_nsa1<3>(p, li, tid, nthr);
  if constexpr (K == 22) ph_nsa1<1>(p, li, tid, nthr);
  if constexpr (K == 4) ph_nsa2(p, li, tid, nthr);
  if constexpr (K == 5) ph_nsa3(p, li, tid, nthr);
  if constexpr (K == 6) ph_nsa4(p, li, tid, nthr);
  if constexpr (K == 7) ph_br(p, li, tid, nthr);
  if constexpr (K == 8) ph_proj_res(p, p.merged, p.w_o_mix + (long long)li * D * D, tid, nthr);
  if constexpr (K == 9) ph_ln(p.tmp, p.ln1_g + li * D, p.ln1_b + li * D, p.xf, p.xb, nullptr, tid, nthr);
  if constexpr (K == 10) ph_xq(p, li, tid, nthr);
  if constexpr (K == 11) ph_xs(p, li, tid, nthr);
  if constexpr (K == 12) ph_xo(p, li, tid, nthr);
  if constexpr (K == 13) ph_proj_res(p, p.xo, p.w_xo + (long long)li * D * D, tid, nthr);
  if constexpr (K == 14) ph_ln(p.tmp, p.ln2_g + li * D, p.ln2_b + li * D, p.xf, p.xb, nullptr, tid, nthr);
  if constexpr (K == 15) ph_rlogit(p, li, tid, nthr);
  if constexpr (K == 16) ph_route(p, li, tid, nthr);
  if constexpr (K == 17) ph_moe1(p, li, tid, nthr);
  if constexpr (K == 18) ph_moe2(p, li, tid, nthr);
  if constexpr (K == 19) ph_ln(p.tmp, p.ln3_g + li * D, p.ln3_b + li * D, p.xf, p.xb, li == DEPTH - 1 ? p.out : nullptr, tid, nthr);
}

DEV void run_phase(const Params& p, int ph, long long tid, long long nthr) {
  if (ph == 0) { run_phase_k<-1>(p, 0, tid, nthr); return; }
  int li = (ph - 1) / PH_PER_LAYER, k = (ph - 1) % PH_PER_LAYER;
  switch (k) {
#define PHC(K) case K: run_phase_k<K>(p, li, tid, nthr); break;
    PHC(0) PHC(1) PHC(2) PHC(3) PHC(4) PHC(5) PHC(6) PHC(7) PHC(8) PHC(9)
    PHC(10) PHC(11) PHC(12) PHC(13) PHC(14) PHC(15) PHC(16) PHC(17) PHC(18) PHC(19)
#undef PHC
  }
}

#ifdef CPU_TEST
#define HDI_M
#else
#define HDI_M __host__ __device__ __forceinline__
#endif
struct Carver {
  char* base; size_t off;
  template <class T> HDI_M T* take(size_t n) {
    T* r = (T*)(base + off);
    off += (n * sizeof(T) + 255) & ~(size_t)255;
    return r;
  }
};

HDI void fill_params(Params& p, void* const* d_in, void* d_out, void* d_ws) {
  const float* const* in = (const float* const*)d_in;
  p.x = in[0]; p.mem = in[1]; p.ln0_g = in[2]; p.ln0_b = in[3]; p.w_in = in[4]; p.b_in = in[5];
  p.w_alpha2 = in[6]; p.b_alpha = in[7]; p.gla_norm_g = in[8];
  p.cmp_pe_k = in[9]; p.cmp_w1_k = in[10]; p.cmp_w2_k = in[11]; p.cmp_pe_v = in[12]; p.cmp_w1_v = in[13]; p.cmp_w2_v = in[14];
  p.w_br_a = in[15]; p.w_br_b = in[16]; p.w_br_c = in[17]; p.w_o_mix = in[18]; p.ln1_g = in[19]; p.ln1_b = in[20];
  p.w_xq = in[21]; p.w_xk = in[22]; p.w_xv = in[23]; p.w_xo = in[24]; p.ln2_g = in[25]; p.ln2_b = in[26];
  p.w_router = in[27]; p.b_router = in[28]; p.w_gu = in[29]; p.b_gu = in[30]; p.w_down = in[31]; p.b_down = in[32];
  p.ln3_g = in[33]; p.ln3_b = in[34];
  p.out = (float*)d_out;
  Carver c{(char*)d_ws, 0};
  p.barw = c.take<unsigned>(4096);
  p.xf = c.take<float>((size_t)N_TOK * D);
  p.xb = c.take<act_t>((size_t)N_TOK * D);
  p.u = c.take<act_t>((size_t)N_TOK * N_IN);
  p.ga = c.take<float>((size_t)N_TOK * B_K);
  p.hid = c.take<float>((size_t)2 * CMP_ROWS * CMP_HID);
  p.kcv = c.take<float>((size_t)2 * CMP_ROWS * HD);
  p.opart = c.take<float>((size_t)4 * N_TOK * B_V);
  p.yass = p.opart;
#ifdef CPU_TEST
  p.ya = c.take<act_t>((size_t)N_TOK * 256);
  p.yb = c.take<act_t>((size_t)N_TOK * B_V);
  p.yc = c.take<act_t>((size_t)N_TOK * 1024);
#else
  p.ya = c.take<act_t>((size_t)N_TOK * YLD);
  p.yb = p.ya + 256;
  p.yc = p.ya + 1280;
#endif
  p.pcmp = c.take<float>((size_t)MOE_ROWS * 1024 / 2 > (size_t)BATCH * NSA_H * SEQ * 128 ? (size_t)MOE_ROWS * 1024 / 2 : (size_t)BATCH * NSA_H * SEQ * 128);
  p.xg = (act_t*)p.pcmp;
  p.ocmp = c.take<float>((size_t)N_TOK * 1024);
  p.impb = c.take<float>((size_t)BATCH * NSA_G * SEQ * N_BLK);
  p.selb = c.take<int>((size_t)BATCH * NSA_G * SEQ * N_BLK);
  p.merged = c.take<act_t>((size_t)N_TOK * D);
  p.tmp = c.take<float>((size_t)N_TOK * D);
  p.xq = c.take<act_t>((size_t)N_TOK * D);
  p.memk = c.take<act_t>((size_t)BATCH * MEM_LEN * D);
  p.memv = c.take<act_t>((size_t)BATCH * MEM_LEN * D);
  p.xs = c.take<float>((size_t)N_TOK * XH * MEM_LEN);
  p.mrg = p.xs;
  p.xo = c.take<act_t>((size_t)N_TOK * D);
  p.rl = c.take<float>((size_t)N_TOK * NE);
  p.topi = c.take<int>((size_t)N_TOK * TOPK);
  p.topg = c.take<float>((size_t)N_TOK * TOPK);
  p.actg = c.take<act_t>((size_t)MOE_ROWS * 1024);
  p.act = p.actg;
  p.wt_in = c.take<act_t>((size_t)2 * N_IN_PAD * 1024);
  p.wt_c1 = c.take<act_t>((size_t)2 * 2 * 256 * 2048);
  p.wt_bra = c.take<act_t>((size_t)2 * 1024 * YLD);
  p.wt_brb = p.wt_bra + 256;
  p.wt_brc = p.wt_bra + 1280;
  p.wt_omix = c.take<act_t>((size_t)2 * 1024 * 1024);
  p.wt_xq = c.take<act_t>((size_t)2 * 1024 * 1024);
  p.wt_xk = c.take<act_t>((size_t)2 * 1024 * 1024);
  p.wt_xv = c.take<act_t>((size_t)2 * 1024 * 1024);
  p.wt_xo = c.take<act_t>((size_t)2 * 1024 * 1024);
  p.wt_gu = c.take<act_t>((size_t)2 * 32 * 2048 * 1024);
  p.wt_dn = c.take<act_t>((size_t)2 * 32 * 1024 * 1024);
  p.membf = c.take<act_t>((size_t)BATCH * MEM_LEN * 1024);
  p.cmpA = c.take<act_t>((size_t)2 * CMP_ROWS_PAD * 2048);
  p.cnt = c.take<int>(64);
  p.rank = c.take<int>((size_t)N_TOK * 4);
  p.rowlist = c.take<int>((size_t)MOE_ROWS);
  p.kcb = c.take<act_t>((size_t)2 * BATCH * 128 * NSA_G * 64);
  p.dilo = c.take<act_t>((size_t)3 * N_TOK * 256);
  p.dill = c.take<float>((size_t)3 * N_TOK * 4);
  p.selm = c.take<unsigned>((size_t)BATCH * NSA_G * SEQ);
  p.gU = p.xg; p.gQ = p.xg + (size_t)1024 * 128 * 256; p.gS = p.actg; p.gD = p.opart + (size_t)N_TOK * 1024;
  p.ws_used = c.off;
}

#ifndef CPU_TEST
#ifndef NSA_PROBE
#define NSA_PROBE 0
#endif
static_assert(D == 1024 && BATCH == 8, "optimized path is written for the graded shapes");
namespace pg8 {
#define PG8_LAS __attribute__((address_space(3)))
typedef unsigned short bf16_t;
typedef short bf16x8 __attribute__((ext_vector_type(8)));
typedef float f32x4 __attribute__((ext_vector_type(4)));
typedef unsigned u32x4 __attribute__((ext_vector_type(4)));
constexpr int BM = 256, BK = 64, HALF = 128, HTB = HALF * BK * 2  , STAGE_BYTES = 8 * HTB, NXCD = 8, WGM = 8;

__host__ __device__ __forceinline__ int lds_byte(int r, int c) { const int st = (r >> 4) * 2 + (c >> 5), rr = r & 15, cc = c & 31, ob = rr * 64 + cc * 2; return st * 1024 + (ob ^ (((ob >> 9) & 1) << 5)); }
__host__ __device__ __forceinline__ void stage_rc(int b, int& R, int& C) { const int st = b / 1024, sb = b % 1024, swz = sb ^ (((sb >> 9) & 1) << 5); R = (st >> 1) * 16 + swz / 64; C = (st & 1) * 32 + (swz % 64) / 2; }
__host__ __device__ __forceinline__ int perm32(int rho) { const int n = rho >> 4, i = rho & 15; return 8 * (i >> 2) + 4 * n + (i & 3); }

struct Unit { int pm, pn; };
struct Gemm { const bf16_t* A; const bf16_t* Bt; int M, N, K; };

struct StaticOrder {
    int nM, nN, nwg, G, c;
    __host__ __device__ void init(int M, int N, int G_, int c_) { nM = M / BM; nN = N / BM; nwg = nM * nN; G = G_; c = c_; }
    __host__ __device__ bool next(int i, Unit& u) const {
        const long L = (long)i * G + c; if (L >= nwg) return false;
        int wgid = (int)L; { const int q = nwg / NXCD, r = nwg % NXCD, xcd = wgid % NXCD, off = wgid / NXCD; wgid = (xcd < r ? xcd * (q + 1) : r * (q + 1) + (xcd - r) * q) + off; }
        const int nig = WGM * nN, gid = wgid / nig, fm = gid * WGM, gsz = (nM - fm) < WGM ? (nM - fm) : WGM;
        u.pm = fm + ((wgid % nig) % gsz); u.pn = (wgid % nig) / gsz; return true;
    }
    __device__ __forceinline__ void a_ready(const Unit&) const {}
    __device__ __forceinline__ void done(const Unit&) const {}
};

__device__ __forceinline__ unsigned cvt_pk_bf16(float lo, float hi) { unsigned r; asm volatile("v_cvt_pk_bf16_f32 %0, %1, %2" : "=v"(r) : "v"(lo), "v"(hi)); return r; }

template <class Epi, class Sched, bool ALIGN_EPI = false, bool SP2 = false>
__device__ __forceinline__ void gemm_phase(PG8_LAS unsigned char* lds, const Gemm g, const Sched& S, const Epi& E, const int tid) {
    const int wid = __builtin_amdgcn_readfirstlane(tid >> 6), lane = tid & 63, wr = wid >> 2, wc = wid & 3, fr = lane & 15, fq = lane >> 4;
    const int K = g.K, nt = K / BK;
    unsigned voffA[2], voffB[2];
#pragma unroll
    for (int i = 0; i < 2; ++i) { int R, C; stage_rc(tid * 16 + i * 8192, R, C); const int Rb = Epi::PERM ? ((R & ~31) + perm32(R & 31)) : R;
        voffA[i] = (unsigned)(R * K + C) * 2u; voffB[i] = (unsigned)(Rb * K + C) * 2u; }
    const size_t kstep = (size_t)(BK * 2);
    const size_t hstep = (size_t)HALF * K * 2;
    const size_t tstep = 2 * hstep;
    const unsigned ldsw = (unsigned)wid * 1024u;
    const int aoff = lds_byte(wr * 64 + fr, fq * 8), boff = lds_byte(wc * 32 + fr, fq * 8);
#define PG8_SA(b, h) (((b) * 2 + (h)) * HTB)
#define PG8_SB(b, h) ((4 + (b) * 2 + (h)) * HTB)
#define PG8_STAGE(bufoff, gbase, voff) do { _Pragma("unroll") for (int _i = 0; _i < 2; ++_i) \
        __builtin_amdgcn_global_load_lds((const unsigned*)((const char*)(gbase) + (voff)[_i]), (PG8_LAS unsigned*)(lds + (bufoff) + ldsw + _i * 8192), 16, 0, 0); } while (0)
#define PG8_LDA(dst, b, h) do { _Pragma("unroll") for (int m = 0; m < 4; ++m) _Pragma("unroll") for (int k = 0; k < 2; ++k) dst[m][k] = *(const PG8_LAS bf16x8*)(lds + PG8_SA(b, h) + aoff + m * 2048 + k * 1024); } while (0)
#define PG8_LDB(dst, b, h) do { _Pragma("unroll") for (int n = 0; n < 2; ++n) _Pragma("unroll") for (int k = 0; k < 2; ++k) dst[n][k] = *(const PG8_LAS bf16x8*)(lds + PG8_SB(b, h) + boff + n * 2048 + k * 1024); } while (0)
#define PG8_MMA(ai, bj, At, Bt) do { __builtin_amdgcn_s_setprio(1); _Pragma("unroll") for (int m = 0; m < 4; ++m) _Pragma("unroll") for (int n = 0; n < 2; ++n) _Pragma("unroll") for (int k = 0; k < 2; ++k) \
        acc[ai][bj][m][n] = __builtin_amdgcn_mfma_f32_16x16x32_bf16(Bt[n][k], At[m][k], acc[ai][bj][m][n], 0, 0, 0); __builtin_amdgcn_s_setprio(0); } while (0)
#define PG8_WAIT_V(n) asm volatile("s_waitcnt vmcnt(" #n ")" ::: "memory")
#define PG8_WAIT_L(n) asm volatile("s_waitcnt lgkmcnt(" #n ")" ::: "memory")
#define PG8_BAR __builtin_amdgcn_s_barrier()
#define PG8_SCHED __builtin_amdgcn_sched_barrier(0)
    Unit cur, nxt; int ui = 0;
    if (!S.next(0, cur)) return;
    f32x4 acc[2][2][4][2];
#pragma unroll
    for (int a = 0; a < 2; ++a)
#pragma unroll
        for (int b = 0; b < 2; ++b)
#pragma unroll
            for (int m = 0; m < 4; ++m)
#pragma unroll
                for (int n = 0; n < 2; ++n) acc[a][b][m][n] = (f32x4){0.f, 0.f, 0.f, 0.f};
    bf16x8 At[4][2], B0[2][2], B1[2][2];
    const char* cA = (const char*)g.A + (size_t)cur.pm * tstep; const char* cB = (const char*)g.Bt + (size_t)cur.pn * tstep;
    S.a_ready(cur);
    if constexpr (SP2) {
        PG8_STAGE(PG8_SB(0, 0), cB, voffB); PG8_STAGE(PG8_SB(0, 1), cB + hstep, voffB); PG8_STAGE(PG8_SA(0, 0), cA, voffA); PG8_STAGE(PG8_SA(0, 1), cA + hstep, voffA);
        if (wr == 1) PG8_BAR;
        PG8_WAIT_V(2); PG8_BAR;
        PG8_STAGE(PG8_SB(1, 0), cB + kstep, voffB); PG8_STAGE(PG8_SA(1, 0), cA + kstep, voffA); PG8_STAGE(PG8_SB(1, 1), cB + hstep + kstep, voffB);
        PG8_WAIT_V(6); PG8_BAR;
    } else {
        PG8_STAGE(PG8_SB(0, 0), cB, voffB); PG8_STAGE(PG8_SA(0, 0), cA, voffA); PG8_STAGE(PG8_SB(0, 1), cB + hstep, voffB); PG8_STAGE(PG8_SA(0, 1), cA + hstep, voffA);
        if (wr == 1) PG8_BAR;
        PG8_WAIT_V(4); PG8_BAR;
        PG8_STAGE(PG8_SB(1, 0), cB + kstep, voffB); PG8_STAGE(PG8_SA(1, 0), cA + kstep, voffA); PG8_STAGE(PG8_SB(1, 1), cB + hstep + kstep, voffB);
        PG8_WAIT_V(6); PG8_BAR;
    }
    for (;;) {
        const bool has_next = S.next(ui + 1, nxt);
        const char* nA = has_next ? (const char*)g.A + (size_t)nxt.pm * tstep : cA; const char* nB = has_next ? (const char*)g.Bt + (size_t)nxt.pn * tstep : cB;
        for (int t = 0; t < nt; t += 2) {
            const bool last = (t == nt - 2);
            const char* a1 = cA + (size_t)(t + 1) * kstep;
            const char* a2 = last ? nA : cA + (size_t)(t + 2) * kstep; const char* b2 = last ? nB : cB + (size_t)(t + 2) * kstep;
            const char* a3 = a2 + kstep; const char* b3 = b2 + kstep;
            if (last && has_next) S.a_ready(nxt);
            E.mid(acc, cur, wr, wc, t);
            if constexpr (SP2) {
            PG8_LDB(B0, 0, 0); PG8_LDB(B1, 0, 1); PG8_SCHED; PG8_LDA(At, 0, 0); PG8_STAGE(PG8_SA(1, 1), a1 + hstep, voffA);
            PG8_WAIT_V(8); PG8_WAIT_L(0); PG8_BAR; PG8_MMA(0, 0, At, B0); PG8_MMA(0, 1, At, B1); PG8_BAR; PG8_SCHED;
            PG8_LDA(At, 0, 1); PG8_STAGE(PG8_SB(0, 0), b2, voffB); PG8_STAGE(PG8_SB(0, 1), b2 + hstep, voffB); PG8_STAGE(PG8_SA(0, 0), a2, voffA);
            PG8_WAIT_V(8); PG8_WAIT_L(0); PG8_BAR; PG8_MMA(1, 0, At, B0); PG8_MMA(1, 1, At, B1); PG8_BAR; PG8_SCHED;
            PG8_LDB(B0, 1, 0); PG8_LDB(B1, 1, 1); PG8_SCHED; PG8_LDA(At, 1, 0); PG8_STAGE(PG8_SA(0, 1), a2 + hstep, voffA);
            PG8_WAIT_V(8); PG8_WAIT_L(0); PG8_BAR; PG8_MMA(0, 0, At, B0); PG8_MMA(0, 1, At, B1); PG8_BAR; PG8_SCHED;
            PG8_LDA(At, 1, 1); PG8_STAGE(PG8_SB(1, 0), b3, voffB); PG8_STAGE(PG8_SB(1, 1), b3 + hstep, voffB); PG8_STAGE(PG8_SA(1, 0), a3, voffA);
            PG8_WAIT_V(8); PG8_WAIT_L(0); PG8_BAR; PG8_MMA(1, 0, At, B0); PG8_MMA(1, 1, At, B1); PG8_BAR; PG8_SCHED;
            } else {
            PG8_LDB(B0, 0, 0); PG8_SCHED; PG8_LDA(At, 0, 0); PG8_STAGE(PG8_SA(1, 1), a1 + hstep, voffA);
            PG8_WAIT_L(8); PG8_BAR; PG8_WAIT_L(0); PG8_MMA(0, 0, At, B0); PG8_BAR; PG8_SCHED;
            PG8_LDB(B1, 0, 1); PG8_STAGE(PG8_SB(0, 0), b2, voffB);
            PG8_BAR; PG8_WAIT_L(0); PG8_MMA(0, 1, At, B1); PG8_BAR;
            PG8_LDA(At, 0, 1); PG8_STAGE(PG8_SA(0, 0), a2, voffA);
            PG8_BAR; PG8_WAIT_L(0); PG8_MMA(1, 0, At, B0); PG8_BAR; PG8_SCHED;
            PG8_STAGE(PG8_SB(0, 1), b2 + hstep, voffB);
            PG8_WAIT_V(6); PG8_BAR; PG8_MMA(1, 1, At, B1); PG8_BAR;
            PG8_LDB(B0, 1, 0); PG8_SCHED; PG8_LDA(At, 1, 0); PG8_STAGE(PG8_SA(0, 1), a2 + hstep, voffA);
            PG8_WAIT_L(8); PG8_BAR; PG8_WAIT_L(0); PG8_MMA(0, 0, At, B0); PG8_BAR; PG8_SCHED;
            PG8_LDB(B1, 1, 1); PG8_STAGE(PG8_SB(1, 0), b3, voffB);
            PG8_BAR; PG8_WAIT_L(0); PG8_MMA(0, 1, At, B1); PG8_BAR;
            PG8_LDA(At, 1, 1); PG8_STAGE(PG8_SA(1, 0), a3, voffA);
            PG8_BAR; PG8_WAIT_L(0); PG8_MMA(1, 0, At, B0); PG8_BAR; PG8_SCHED;
            PG8_STAGE(PG8_SB(1, 1), b3 + hstep, voffB);
            PG8_WAIT_V(6); PG8_BAR; PG8_MMA(1, 1, At, B1); PG8_BAR;
            }
        }
        if constexpr (ALIGN_EPI) { if (wr == 0) PG8_BAR; }
        if constexpr (!Epi::AFTER_DRAIN) { E(acc, cur, wr, wc, fr, fq); S.done(cur); }
        if (!has_next) break;
#pragma unroll
        for (int a = 0; a < 2; ++a)
#pragma unroll
            for (int b = 0; b < 2; ++b)
#pragma unroll
                for (int m = 0; m < 4; ++m)
#pragma unroll
                    for (int n = 0; n < 2; ++n) acc[a][b][m][n] = (f32x4){0.f, 0.f, 0.f, 0.f};
        cur = nxt; cA = nA; cB = nB; ++ui;
        if constexpr (ALIGN_EPI) { if (wr == 1) PG8_BAR; }
    }
    PG8_WAIT_V(0);
    if constexpr (!ALIGN_EPI) { if (wr == 0) PG8_BAR; }
    PG8_BAR;
    if constexpr (Epi::AFTER_DRAIN) { E.fused(acc, cur, wr, wc, fr, fq, lds, wid, lane); S.done(cur); }
#undef PG8_SA
#undef PG8_SB
#undef PG8_STAGE
#undef PG8_LDA
#undef PG8_LDB
#undef PG8_MMA
#undef PG8_WAIT_V
#undef PG8_WAIT_L
#undef PG8_BAR
#undef PG8_SCHED
}
}

typedef pg8::f32x4 f32x4;
typedef pg8::bf16x8 bf16x8;
typedef unsigned u32x2 __attribute__((ext_vector_type(2)));
typedef unsigned u32x4 __attribute__((ext_vector_type(4)));
#define LAS __attribute__((address_space(3)))

constexpr int NTHREADS = 512;
constexpr int RING_BYTES = 131072;
constexpr int MISC_OFF = RING_BYTES;
constexpr int LDS_BYTES = 147456;

typedef __bf16 bf16x2_t __attribute__((ext_vector_type(2)));
typedef float f32x2_t __attribute__((ext_vector_type(2)));
DEV unsigned pk2(float lo, float hi) {
  const f32x2_t v = {lo, hi};
  return __builtin_bit_cast(unsigned, __builtin_convertvector(v, bf16x2_t));
}
DEV unsigned short f2bfh(float x) { return (unsigned short)(pk2(x, 0.f) & 0xffffu); }
DEV float wave_sum(float v, int lane) {
#pragma unroll
  for (int o = 1; o < 64; o <<= 1)
    v += __int_as_float(__builtin_amdgcn_ds_bpermute((lane ^ o) << 2, __float_as_int(v)));
  return v;
}

DEV void transpose_item(const float* W, int ldw, int dld, act_t* WT, int k0, int n0, int drow0, LAS float* scr, int lane) {
#pragma unroll 8
  for (int i = 0; i < 32; ++i) {
    const int kk = 2 * i + (lane >> 5);
    scr[kk * 33 + (lane & 31)] = W[(size_t)(k0 + kk) * ldw + n0 + (lane & 31)];
  }
  asm volatile("s_waitcnt lgkmcnt(0)" ::: "memory");
  const int c = lane & 7;
#pragma unroll
  for (int j = 0; j < 4; ++j) {
    const int n = (lane >> 3) + 8 * j;
    const LAS float* s = scr + (8 * c) * 33 + n;
    u32x4 o;
    o.x = pk2(s[0 * 33], s[1 * 33]); o.y = pk2(s[2 * 33], s[3 * 33]);
    o.z = pk2(s[4 * 33], s[5 * 33]); o.w = pk2(s[6 * 33], s[7 * 33]);
    *(u32x4*)(WT + (size_t)(drow0 + n) * dld + k0 + 8 * c) = o;
  }
  asm volatile("s_waitcnt lgkmcnt(0)" ::: "memory");
}

struct ConvDesc { const float* W; act_t* dst; int nbatch, K, N, mode; size_t dstb; int dld; };
constexpr int NCONV = 13;
DEV ConvDesc conv_desc(const Params& p, int kind) {
  const size_t SQ = (size_t)1024 * 1024;
  switch (kind) {
    case 0: return ConvDesc{p.w_gu, p.wt_gu, 64, 1024, 2048, 1, (size_t)2048 * 1024, 1024};
    case 1: return ConvDesc{p.w_down, p.wt_dn, 64, 1024, 1024, 0, SQ, 1024};
    case 2: return ConvDesc{p.w_in, p.wt_in, 2, 1024, N_IN, 0, (size_t)N_IN_PAD * 1024, 1024};
    case 3: return ConvDesc{p.cmp_w1_k, p.wt_c1, 2, 2048, 128, 0, (size_t)2 * 256 * 2048, 2048};
    case 4: return ConvDesc{p.cmp_w1_v, p.wt_c1 + (size_t)256 * 2048, 2, 2048, 128, 0, (size_t)2 * 256 * 2048, 2048};
    case 5: return ConvDesc{p.w_br_a, p.wt_bra, 2, 256, 1024, 0, (size_t)1024 * YLD, YLD};
    case 6: return ConvDesc{p.w_br_b, p.wt_brb, 2, 1024, 1024, 0, (size_t)1024 * YLD, YLD};
    case 7: return ConvDesc{p.w_br_c, p.wt_brc, 2, 1024, 1024, 0, (size_t)1024 * YLD, YLD};
    case 8: return ConvDesc{p.w_o_mix, p.wt_omix, 2, 1024, 1024, 0, SQ, 1024};
    case 9: return ConvDesc{p.w_xq, p.wt_xq, 2, 1024, 1024, 0, SQ, 1024};
    case 10: return ConvDesc{p.w_xk, p.wt_xk, 2, 1024, 1024, 0, SQ, 1024};
    case 11: return ConvDesc{p.w_xv, p.wt_xv, 2, 1024, 1024, 0, SQ, 1024};
    default: return ConvDesc{p.w_xo, p.wt_xo, 2, 1024, 1024, 0, SQ, 1024};
  }
}
DEV int conv_items(int kind) {
  switch (kind) {
    case 0: return 64 * 16 * 64;
    case 1: return 64 * 16 * 32;
    case 2: return 2 * 16 * (N_IN / 32);
    case 3: case 4: return 2 * 32 * 4;
    case 5: return 2 * 4 * 32;
    default: return 2 * 16 * 32;
  }
}
DEV void conv_all(const Params& p, int gw, int NGW, LAS float* scr, int lane) {
  int base = 0;
  for (int kind = 0; kind < NCONV; ++kind) {
    const int total = conv_items(kind);
    const ConvDesc d = conv_desc(p, kind);
    const int nblk = d.N / 32, per = nblk * (d.K / 64);
    int first = (gw - base % NGW + NGW) % NGW;
    for (int it = first; it < total; it += NGW) {
      const int bt = it / per, r = it % per, kb = r / nblk, nb = r % nblk;
      const int n0 = nb * 32;
      int drow0 = n0;
      if (d.mode == 1) { const int j = n0 & 1023; drow0 = (j >> 7) * 256 + (j & 127) + ((n0 >= 1024) ? 128 : 0); }
      transpose_item(d.W + (size_t)bt * d.K * d.N, d.N, d.dld, d.dst + (size_t)bt * d.dstb, kb * 64, n0, drow0, scr, lane);
    }
    base += total;
  }
}

template <int MODE>
DEV void ln_rows_w(const Params& p, const float* src, const float* g, const float* b, float* dstf, act_t* dstb, float* dst2,
                   int gw, int NGW, int lane) {
  for (int n = gw; n < N_TOK; n += NGW) {
    f32x4 v[4];
    float s = 0.f;
#pragma unroll
    for (int j = 0; j < 4; ++j) {
      if (MODE == 0) v[j] = ((const f32x4*)(src + (size_t)n * D))[lane + 64 * j];
      else {
        f32x4 a = ((const f32x4*)(p.xf + (size_t)n * D))[lane + 64 * j] * ALPHA;
#pragma unroll
        for (int k = 0; k < 4; ++k) a += ((const f32x4*)(p.yass + ((size_t)n * 4 + k) * D))[lane + 64 * j];
        v[j] = a;
      }
      s += (v[j].x + v[j].y) + (v[j].z + v[j].w);
    }
    const float mean = wave_sum(s, lane) * (1.f / D);
    float s2 = 0.f;
#pragma unroll
    for (int j = 0; j < 4; ++j) { v[j] = v[j] - mean; s2 += (v[j].x * v[j].x + v[j].y * v[j].y) + (v[j].z * v[j].z + v[j].w * v[j].w); }
    const float rstd = 1.f / sqrtf(wave_sum(s2, lane) * (1.f / D) + LN_EPS);
#pragma unroll
    for (int j = 0; j < 4; ++j) {
      const f32x4 gm = ((const f32x4*)g)[lane + 64 * j], bt = ((const f32x4*)b)[lane + 64 * j];
      const f32x4 y = v[j] * rstd * gm + bt;
      ((f32x4*)(dstf + (size_t)n * D))[lane + 64 * j] = y;
      u32x2 w; w.x = pk2(y.x, y.y); w.y = pk2(y.z, y.w);
      ((u32x2*)(dstb + (size_t)n * D))[lane + 64 * j] = w;
      if (dst2) ((f32x4*)(dst2 + (size_t)n * D))[lane + 64 * j] = y;
    }
  }
}

DEV void prologue(const Params& p, LAS unsigned char* lds, int wave, int lane) {
  LAS float* scr = (LAS float*)(lds + wave * 16384);
  const int gw = blockIdx.x * 8 + wave, NGW = gridDim.x * 8;
  conv_all(p, gw, NGW, scr, lane);
  const long long tid = (long long)blockIdx.x * NTHREADS + threadIdx.x, nthr = (long long)gridDim.x * NTHREADS;
  {
    const long long padw = (long long)(N_IN_PAD - N_IN) * 1024 / 8;
    for (long long i = tid; i < 2 * padw; i += nthr) {
      const int li = (int)(i / padw); const long long r = i % padw;
      ((u32x4*)(p.wt_in + ((size_t)li * N_IN_PAD + N_IN) * 1024))[r] = (u32x4){0u, 0u, 0u, 0u};
    }
    const long long padc = (long long)128 * 2048 / 8;
    for (long long i = tid; i < 4 * padc; i += nthr) {
      const int q = (int)(i / padc); const long long r = i % padc;
      ((u32x4*)(p.wt_c1 + ((size_t)q * 256 + 128) * 2048))[r] = (u32x4){0u, 0u, 0u, 0u};
    }
    if (tid < 64) p.cnt[tid] = 0;
    for (long long i = tid; i < 2LL * BATCH * NSA_G * 64; i += nthr) {
      const long long wb = i / (NSA_G * 64), r = i % (NSA_G * 64);
      p.kcb[(wb * 128 + 127) * NSA_G * 64 + r] = 0;
    }
    for (long long i = tid; i < (long long)BATCH * MEM_LEN * 1024 / 4; i += nthr) {
      const f32x4 v = ((const f32x4*)p.mem)[i];
      u32x2 w; w.x = pk2(v.x, v.y); w.y = pk2(v.z, v.w);
      ((u32x2*)p.membf)[i] = w;
    }
  }
  ln_rows_w<0>(p, p.x, p.ln0_g, p.ln0_b, p.xf, p.xb, nullptr, gw, NGW, lane);
}

struct USched {
  int nM, nN, nwg, G, c;
  int moe, nct, total; const LAS int* tile_e;
  DEV void init_static(int M, int N, int G_, int c_) { nM = M / 256; nN = N / 256; nwg = nM * nN; G = G_; c = c_; moe = 0; nct = 1; total = nwg; tile_e = nullptr; }
  DEV void init_moe(int G_, int c_, int nct_, int total_, const LAS int* te) { nM = 1; nN = 1; nwg = total_; G = G_; c = c_; moe = 1; nct = nct_; total = total_; tile_e = te; }
  DEV bool next(int i, pg8::Unit& u) const {
    const long L = (long)i * G + c; if (L >= total) return false;
    if (moe) { const int rt = (int)(L / nct), j = (int)(L % nct); u.pm = rt; u.pn = tile_e[rt] * nct + j; return true; }
    int wgid = (int)L; { const int q = nwg / 8, r = nwg % 8, xcd = wgid % 8, off = wgid / 8; wgid = (xcd < r ? xcd * (q + 1) : r * (q + 1) + (xcd - r) * q) + off; }
    const int nig = 8 * nN, gid = wgid / nig, fm = gid * 8, gsz = (nM - fm) < 8 ? (nM - fm) : 8;
    u.pm = fm + ((wgid % nig) % gsz); u.pn = (wgid % nig) / gsz; return true;
  }
  DEV void a_ready(const pg8::Unit&) const {}
  DEV void done(const pg8::Unit&) const {}
};

enum { EM_INPROJ = 0, EM_BRCAT, EM_RES, EM_BF16, EM_MOE1, EM_MOE2, EM_HID };
#define EPI_FENCE() asm volatile("" ::: "memory")
struct EpiU {
  static constexpr bool PERM = false, AFTER_DRAIN = false;
  int mode, ldc;
  act_t* ob;
  float* of;
  const act_t* ub;
  const float* f0;
  const float* f1;
  const int* il;
  const LAS int* te;
  DEV void mid(f32x4 (&acc)[2][2][4][2], const pg8::Unit& un, int wr, int wc, int t) const {
    if (mode != EM_BRCAT || (t != 4 && t != 20)) return;
    int l2;
    asm volatile("v_mbcnt_lo_u32_b32 %0, -1, 0\n\tv_mbcnt_hi_u32_b32 %0, -1, %0" : "=v"(l2));
    const int fr = l2 & 15, fq = l2 >> 4;
    const int row0 = un.pm * 256 + wr * 64 + fr, col0 = un.pn * 256 + wc * 32 + 4 * fq;
    const int goff = OFF_MG + (t == 4 ? 0 : D);
    const float L2E = -1.4426950408889634f;
#pragma unroll
    for (int ai = 0; ai < 2; ++ai)
#pragma unroll
      for (int m = 0; m < 4; ++m) {
        const int row = row0 + ai * 128 + m * 16;
#pragma unroll
        for (int bj = 0; bj < 2; ++bj)
#pragma unroll
          for (int n = 0; n < 2; ++n) {
            const int col = col0 + bj * 128 + n * 16;
            const act_t* gp = ub + (size_t)row * N_IN + goff + col;
            const u32x2 ga = *(const u32x2*)gp, gb = *(const u32x2*)(gp + D);
            const float ea0 = __builtin_amdgcn_exp2f(__uint_as_float(ga.x << 16) * L2E), ea1 = __builtin_amdgcn_exp2f(__uint_as_float(ga.x & 0xffff0000u) * L2E);
            const float ea2 = __builtin_amdgcn_exp2f(__uint_as_float(ga.y << 16) * L2E), ea3 = __builtin_amdgcn_exp2f(__uint_as_float(ga.y & 0xffff0000u) * L2E);
            const float eb0 = __builtin_amdgcn_exp2f(__uint_as_float(gb.x << 16) * L2E), eb1 = __builtin_amdgcn_exp2f(__uint_as_float(gb.x & 0xffff0000u) * L2E);
            const float eb2 = __builtin_amdgcn_exp2f(__uint_as_float(gb.y << 16) * L2E), eb3 = __builtin_amdgcn_exp2f(__uint_as_float(gb.y & 0xffff0000u) * L2E);
            f32x4& v = acc[ai][bj][m][n];
            v.x *= (1.0f + eb0) * __builtin_amdgcn_rcpf(1.0f + ea0); v.y *= (1.0f + eb1) * __builtin_amdgcn_rcpf(1.0f + ea1);
            v.z *= (1.0f + eb2) * __builtin_amdgcn_rcpf(1.0f + ea2); v.w *= (1.0f + eb3) * __builtin_amdgcn_rcpf(1.0f + ea3);
          }
        EPI_FENCE();
      }
  }
  DEV void operator()(const f32x4 (&acc)[2][2][4][2], const pg8::Unit& un, int wr, int wc, int fr, int fq) const {
    {
      int l2;
      asm volatile("v_mbcnt_lo_u32_b32 %0, -1, 0\n\tv_mbcnt_hi_u32_b32 %0, -1, %0" : "=v"(l2));
      fr = l2 & 15; fq = l2 >> 4;
    }
    const int row0 = un.pm * 256 + wr * 64 + fr;
    if (mode == EM_INPROJ) {
      const int col0 = un.pn * 256 + wc * 32 + 4 * fq;
#pragma unroll
      for (int bj = 0; bj < 2; ++bj)
#pragma unroll
        for (int n = 0; n < 2; ++n) {
          const int col = col0 + bj * 128 + n * 16;
          if (col < N_IN) {
            const f32x4 bv = *(const f32x4*)(f0 + col);
#pragma unroll
            for (int ai = 0; ai < 2; ++ai)
#pragma unroll
              for (int m = 0; m < 4; ++m) {
                const int row = row0 + ai * 128 + m * 16;
                const f32x4 v = acc[ai][bj][m][n] + bv;
                u32x2 w; w.x = pk2(v.x, v.y); w.y = pk2(v.z, v.w);
                *(u32x2*)(ob + (size_t)row * N_IN + col) = w;
              }
          }
          EPI_FENCE();
        }
    } else if (mode == EM_BRCAT) {
      const int col0 = un.pn * 256 + wc * 32 + 4 * fq;
#pragma unroll
      for (int ai = 0; ai < 2; ++ai)
#pragma unroll
        for (int m = 0; m < 4; ++m) {
          const int row = row0 + ai * 128 + m * 16;
#pragma unroll
          for (int bj = 0; bj < 2; ++bj)
#pragma unroll
            for (int n = 0; n < 2; ++n) {
              const int col = col0 + bj * 128 + n * 16;
              const u32x2 gw = *(const u32x2*)(ub + (size_t)row * N_IN + OFF_MG + 2 * D + col);
              f32x4 v = acc[ai][bj][m][n];
              v.x *= sigmoidf_(__uint_as_float(gw.x << 16)); v.y *= sigmoidf_(__uint_as_float(gw.x & 0xffff0000u));
              v.z *= sigmoidf_(__uint_as_float(gw.y << 16)); v.w *= sigmoidf_(__uint_as_float(gw.y & 0xffff0000u));
              u32x2 w; w.x = pk2(v.x, v.y); w.y = pk2(v.z, v.w);
              *(u32x2*)(ob + (size_t)row * D + col) = w;
            }
          EPI_FENCE();
        }
    } else if (mode == EM_RES) {
      const int col0 = un.pn * 256 + wc * 32 + 4 * fq;
#pragma unroll
      for (int ai = 0; ai < 2; ++ai)
#pragma unroll
        for (int m = 0; m < 4; ++m) {
          const int row = row0 + ai * 128 + m * 16;
#pragma unroll
          for (int bj = 0; bj < 2; ++bj)
#pragma unroll
            for (int n = 0; n < 2; ++n) {
              const int col = col0 + bj * 128 + n * 16;
              const f32x4 x = *(const f32x4*)(f0 + (size_t)row * D + col);
              *(f32x4*)(of + (size_t)row * D + col) = x * ALPHA + acc[ai][bj][m][n];
            }
          EPI_FENCE();
        }
    } else if (mode == EM_BF16) {
      const int col0 = un.pn * 256 + wc * 32 + 4 * fq;
#pragma unroll
      for (int ai = 0; ai < 2; ++ai)
#pragma unroll
        for (int m = 0; m < 4; ++m) {
          const int row = row0 + ai * 128 + m * 16;
#pragma unroll
          for (int bj = 0; bj < 2; ++bj)
#pragma unroll
            for (int n = 0; n < 2; ++n) {
              const int col = col0 + bj * 128 + n * 16;
              const f32x4 v = acc[ai][bj][m][n];
              u32x2 w; w.x = pk2(v.x, v.y); w.y = pk2(v.z, v.w);
              *(u32x2*)(ob + (size_t)row * ldc + col) = w;
            }
          EPI_FENCE();
        }
    } else if (mode == EM_MOE1) {
      const int e = te[un.pm], j = un.pn & 7;
#pragma unroll
      for (int n = 0; n < 2; ++n) {
        const int cj = j * 128 + wc * 32 + n * 16 + 4 * fq;
        const f32x4 bg = *(const f32x4*)(f0 + (size_t)e * 2048 + cj), bu = *(const f32x4*)(f0 + (size_t)e * 2048 + 1024 + cj);
#pragma unroll
        for (int ai = 0; ai < 2; ++ai)
#pragma unroll
          for (int m = 0; m < 4; ++m) {
            const int row = row0 + ai * 128 + m * 16;
            const f32x4 g = acc[ai][0][m][n] + bg, u = acc[ai][1][m][n] + bu;
            float o[4];
#pragma unroll
            for (int i = 0; i < 4; ++i) {
              const float gt = fminf(g[i], 7.0f), up = fminf(fmaxf(u[i], -7.0f), 7.0f);
              o[i] = (up + 1.0f) * gt * sigmoidf_(1.702f * gt);
            }
            u32x2 w; w.x = pk2(o[0], o[1]); w.y = pk2(o[2], o[3]);
            *(u32x2*)(ob + (size_t)row * 1024 + cj) = w;
          }
        EPI_FENCE();
      }
    } else if (mode == EM_MOE2) {
      const int e = te[un.pm], j = un.pn & 3;
      const int col0 = j * 256 + wc * 32 + 4 * fq;
#pragma unroll
      for (int ai = 0; ai < 2; ++ai)
#pragma unroll
        for (int m = 0; m < 4; ++m) {
          const int row = row0 + ai * 128 + m * 16;
          const int aid = il[row];
          if (aid >= 0) {
            const float gt = f1[aid];
#pragma unroll
            for (int bj = 0; bj < 2; ++bj)
#pragma unroll
              for (int n = 0; n < 2; ++n) {
                const int col = col0 + bj * 128 + n * 16;
                const f32x4 v = (acc[ai][bj][m][n] + *(const f32x4*)(f0 + (size_t)e * 1024 + col)) * gt;
                *(f32x4*)(of + (size_t)aid * 1024 + col) = v;
              }
          }
          EPI_FENCE();
        }
    } else if (mode == EM_HID) {
      const int col0 = wc * 32 + 4 * fq;
#pragma unroll
      for (int ai = 0; ai < 2; ++ai)
#pragma unroll
        for (int m = 0; m < 4; ++m) {
          const int row = row0 + ai * 128 + m * 16;
          if (row < CMP_ROWS) {
#pragma unroll
            for (int n = 0; n < 2; ++n) {
              const f32x4 a = acc[ai][0][m][n];
              f32x4 v; v.x = gelu_tanh(a.x); v.y = gelu_tanh(a.y); v.z = gelu_tanh(a.z); v.w = gelu_tanh(a.w);
              *(f32x4*)(of + (size_t)row * CMP_HID + col0 + n * 16) = v;
            }
          }
          EPI_FENCE();
        }
    }
  }
};

DEV int moe_tables(const Params& p, int li, LAS int* tab, int t32) {
  __syncthreads();
  if (t32 == 0) {
    int t = 0;
    for (int e = 0; e < NE; ++e) {
      const int c = p.cnt[li * 32 + e];
      tab[e] = t * 256; tab[32 + e] = c;
      const int nt = (c + 255) >> 8;
#pragma clang loop vectorize(disable) unroll(disable)
      for (int k = 0; k < nt; ++k) tab[128 + t + k] = e;
      t += nt;
    }
    tab[64] = t;
  }
  __syncthreads();
  return tab[64];
}

DEV void moe_prep(const Params& p, int li, LAS int* tab, int wave, int lane, int t32) {
  const int ntiles = moe_tables(p, li, tab, t32);
  const int gw = blockIdx.x * 8 + wave, NGW = gridDim.x * 8;
  for (int a = gw; a < N_TOK * 4; a += NGW) {
    const int e = p.topi[a];
    const int row = tab[e] + p.rank[a];
    if (lane == 0) p.rowlist[row] = a;
    const u32x4* src = (const u32x4*)(p.xb + (size_t)(a >> 2) * 1024);
    u32x4* dst = (u32x4*)(p.xg + (size_t)row * 1024);
    dst[lane] = src[lane];
    dst[lane + 64] = src[lane + 64];
  }
  const long long tid = (long long)blockIdx.x * NTHREADS + t32, nthr = (long long)gridDim.x * NTHREADS;
  for (long long r = tid; r < (long long)ntiles * 256; r += nthr) {
    const int e = tab[128 + (int)(r >> 8)];
    if ((int)r - tab[e] >= tab[32 + e]) p.rowlist[r] = -1;
  }
}

typedef short v4i16_t __attribute__((ext_vector_type(4)));
DEV v4i16_t tr_read(const LAS unsigned char* p) { return __builtin_amdgcn_ds_read_tr16_b64_v4i16((LAS v4i16_t*)p); }
DEV float shx(float v, int lane, int o) { return __int_as_float(__builtin_amdgcn_ds_bpermute((lane ^ o) << 2, __float_as_int(v))); }
DEV int shxi(int v, int lane, int o) { return __builtin_amdgcn_ds_bpermute((lane ^ o) << 2, v); }

constexpr int AT_ROWB = 144;
constexpr int AT_TILEB = 64 * AT_ROWB;
constexpr int AT_HALF_KV = 4 * AT_TILEB;
constexpr int AT_SLAB_OFF = 2 * AT_HALF_KV;
constexpr int AT_SLAB_WAVE = 32 * 33 * 4;
constexpr int AT_SLAB_HALF = 4 * AT_SLAB_WAVE;
constexpr int AT_XCH_OFF = AT_SLAB_OFF + 2 * AT_SLAB_HALF;
static_assert(AT_XCH_OFF + 16 <= RING_BYTES, "attention LDS map");
constexpr float SC2 = 0.125f * 1.4426950408889634f;

struct AttnState { f32x4 O[2][4]; float m[2], l[2]; };

template <bool PROB, class Job>
DEV void attn_tile(const Job& job, const LAS unsigned char* Kb, const LAS unsigned char* Vb, const bf16x8 (&qf)[2][2], AttnState& st,
                   LAS float* slab, int cur, int wih, int lane) {
  const int i15 = lane & 15, g4 = lane >> 4;
  f32x4 S[2][4];
#pragma unroll
  for (int sub = 0; sub < 2; ++sub)
#pragma unroll
    for (int t = 0; t < 4; ++t) S[sub][t] = (f32x4){0.f, 0.f, 0.f, 0.f};
#pragma unroll
  for (int t = 0; t < 4; ++t)
#pragma unroll
    for (int kk = 0; kk < 2; ++kk) {
      const bf16x8 kf = *(const LAS bf16x8*)(Kb + (16 * t + i15) * AT_ROWB + (kk * 32 + 8 * g4) * 2);
#pragma unroll
      for (int sub = 0; sub < 2; ++sub) S[sub][t] = __builtin_amdgcn_mfma_f32_16x16x32_bf16(kf, qf[sub][kk], S[sub][t], 0, 0, 0);
    }
  bf16x8 pf[2][2];
  const bool efree = job.elemfree(cur, wih);
#pragma unroll
  for (int sub = 0; sub < 2; ++sub) {
    const int row = wih * 32 + sub * 16 + i15;
    if (!efree) {
      const int mbv = job.mb(row, cur, g4);
#pragma unroll
      for (int t = 0; t < 4; ++t)
#pragma unroll
        for (int j = 0; j < 4; ++j) S[sub][t][j] = job.ok(mbv, 16 * t + j) ? S[sub][t][j] : -INFINITY;
    }
    float mx = fmaxf(fmaxf(S[sub][0][0], S[sub][0][1]), fmaxf(S[sub][0][2], S[sub][0][3]));
#pragma unroll
    for (int t = 1; t < 4; ++t) mx = fmaxf(fmaxf(mx, fmaxf(S[sub][t][0], S[sub][t][1])), fmaxf(S[sub][t][2], S[sub][t][3]));
    if (!PROB) {
      mx = fmaxf(mx, shx(mx, lane, 16));
      mx = fmaxf(mx, shx(mx, lane, 32));
      const bool rok = job.rowok(sub, cur);
      const float mcand = rok ? mx * SC2 : -INFINITY;
      const float mnew = fmaxf(st.m[sub], mcand);
      const float msafe = (mnew == -INFINITY) ? 0.f : mnew;
      const float corr = __builtin_amdgcn_exp2f(st.m[sub] - msafe);
      st.m[sub] = mnew;
      const float msub = rok ? msafe : INFINITY;
      float psum = 0.f;
#pragma unroll
      for (int t = 0; t < 4; ++t)
#pragma unroll
        for (int j = 0; j < 4; ++j) { const float pp = __builtin_amdgcn_exp2f(__builtin_fmaf(S[sub][t][j], SC2, -msub)); S[sub][t][j] = pp; psum += pp; }
      st.l[sub] = st.l[sub] * corr + psum;
      if (__builtin_amdgcn_ballot_w64(corr != 1.0f) != 0ull) {
#pragma unroll
        for (int dt = 0; dt < 4; ++dt) st.O[sub][dt] *= corr;
      }
#pragma unroll
      for (int s2 = 0; s2 < 2; ++s2) {
        u32x4 w;
        w.x = pk2(S[sub][2 * s2][0], S[sub][2 * s2][1]); w.y = pk2(S[sub][2 * s2][2], S[sub][2 * s2][3]);
        w.z = pk2(S[sub][2 * s2 + 1][0], S[sub][2 * s2 + 1][1]); w.w = pk2(S[sub][2 * s2 + 1][2], S[sub][2 * s2 + 1][3]);
        pf[sub][s2] = __builtin_bit_cast(bf16x8, w);
      }
    } else {
      const float msafe = (st.m[sub] == -INFINITY) ? 0.f : st.m[sub];
      const int q = sub * 16 + i15;
#pragma unroll
      for (int t = 0; t < 4; ++t) {
        const float p0 = __builtin_amdgcn_exp2f(__builtin_fmaf(S[sub][t][0], SC2, -msafe)) * st.l[sub], p1 = __builtin_amdgcn_exp2f(__builtin_fmaf(S[sub][t][1], SC2, -msafe)) * st.l[sub];
        const float p2 = __builtin_amdgcn_exp2f(__builtin_fmaf(S[sub][t][2], SC2, -msafe)) * st.l[sub], p3 = __builtin_amdgcn_exp2f(__builtin_fmaf(S[sub][t][3], SC2, -msafe)) * st.l[sub];
        const int jb = 16 * cur + 4 * t + g4;
        slab[q * 33 + jb] += (p0 + p1) + (p2 + p3);
        S[sub][t][3] = p3;
      }
      asm volatile("s_waitcnt lgkmcnt(0)" ::: "memory");
#pragma unroll
      for (int t = 0; t < 4; ++t) {
        const int jb = 16 * cur + 4 * t + g4 + 1;
        if (jb < 32) slab[q * 33 + jb] += S[sub][t][3];
      }
      asm volatile("s_waitcnt lgkmcnt(0)" ::: "memory");
    }
  }
  if (!PROB) {
#pragma unroll
    for (int dt = 0; dt < 4; ++dt)
#pragma unroll
      for (int s2 = 0; s2 < 2; ++s2) {
        const LAS unsigned char* vp = Vb + (32 * s2 + 4 * g4 + (i15 >> 2)) * AT_ROWB + (16 * dt + 4 * (lane & 3)) * 2;
        const v4i16_t lo = tr_read(vp), hi = tr_read(vp + 16 * AT_ROWB);
        bf16x8 vf;
        vf[0] = lo[0]; vf[1] = lo[1]; vf[2] = lo[2]; vf[3] = lo[3]; vf[4] = hi[0]; vf[5] = hi[1]; vf[6] = hi[2]; vf[7] = hi[3];
#pragma unroll
        for (int sub = 0; sub < 2; ++sub) st.O[sub][dt] = __builtin_amdgcn_mfma_f32_16x16x32_bf16(vf, pf[sub][s2], st.O[sub][dt], 0, 0, 0);
      }
  }
}

template <bool PROB, class Job>
DEV void attn_run(const Job& job, LAS unsigned char* lds, AttnState& st, int half, int hth, int wih, int lane) {
  LAS unsigned char* kvh = lds + half * AT_HALF_KV;
  LAS int* xch = (LAS int*)(lds + AT_XCH_OFF);
  LAS float* slab = (LAS float*)(lds + AT_SLAB_OFF + half * AT_SLAB_HALF + wih * AT_SLAB_WAVE);
  const int i15 = lane & 15, g4 = lane >> 4;
  unsigned rem = job.tilemask();
  if (hth == 0) xch[half] = __builtin_popcount(rem);
  bf16x8 qf[2][2];
#pragma unroll
  for (int sub = 0; sub < 2; ++sub) {
    const act_t* qr = job.qrow(wih * 32 + sub * 16 + i15);
#pragma unroll
    for (int kk = 0; kk < 2; ++kk) qf[sub][kk] = *(const bf16x8*)(qr + kk * 32 + 8 * g4);
  }
  if (!PROB) {
#pragma unroll
    for (int sub = 0; sub < 2; ++sub) {
      st.m[sub] = -INFINITY; st.l[sub] = 0.f;
#pragma unroll
      for (int dt = 0; dt < 4; ++dt) st.O[sub][dt] = (f32x4){0.f, 0.f, 0.f, 0.f};
    }
  }
  const int srow = hth >> 2, sch = hth & 3;
  u32x4 ak0, ak1, av0, av1, bk0, bk1, bv0, bv1;
#define AT_GLD(dst, ptr) asm volatile("global_load_dwordx4 %0, %1, off" : "=v"(dst) : "v"(ptr) : "memory")
#define AT_LOAD(k0, k1, v0, v1, T) do { const act_t* kr_ = job.krow(T, srow) + sch * 16; AT_GLD(k0, kr_); AT_GLD(k1, kr_ + 8); \
    if (!PROB) { const act_t* vr_ = job.vrow(T, srow) + sch * 16; AT_GLD(v0, vr_); AT_GLD(v1, vr_ + 8); } } while (0)
#define AT_WAIT(k0, k1, v0, v1, YOUNGER) do { \
    if (PROB) { if (YOUNGER) asm volatile("s_waitcnt vmcnt(2)" : "+v"(k0), "+v"(k1) :: "memory"); else asm volatile("s_waitcnt vmcnt(0)" : "+v"(k0), "+v"(k1) :: "memory"); } \
    else { if (YOUNGER) asm volatile("s_waitcnt vmcnt(4)" : "+v"(k0), "+v"(k1), "+v"(v0), "+v"(v1) :: "memory"); \
           else asm volatile("s_waitcnt vmcnt(0)" : "+v"(k0), "+v"(k1), "+v"(v0), "+v"(v1) :: "memory"); } } while (0)
#define AT_WRITE(k0, k1, v0, v1, BUF) do { LAS unsigned char* kd_ = kvh + (BUF) * AT_TILEB + srow * AT_ROWB + sch * 32; *(LAS u32x4*)kd_ = k0; *(LAS u32x4*)(kd_ + 16) = k1; \
    if (!PROB) { LAS unsigned char* vd_ = kvh + (2 + (BUF)) * AT_TILEB + srow * AT_ROWB + sch * 32; *(LAS u32x4*)vd_ = v0; *(LAS u32x4*)(vd_ + 16) = v1; } } while (0)
#define AT_NEXT(T) do { T = -1; if (rem) { T = __builtin_ctz(rem); rem &= rem - 1; } } while (0)
#define AT_BAR() do { asm volatile("s_waitcnt lgkmcnt(0)" ::: "memory"); __builtin_amdgcn_s_barrier(); asm volatile("" ::: "memory"); } while (0)
  int t0, t1;
  AT_NEXT(t0);
  asm volatile("s_waitcnt vmcnt(0)" ::: "memory");
  if (t0 >= 0) { AT_LOAD(ak0, ak1, av0, av1, t0); AT_WAIT(ak0, ak1, av0, av1, false); AT_WRITE(ak0, ak1, av0, av1, 0); }
  AT_NEXT(t1);
  if (t1 >= 0) AT_LOAD(ak0, ak1, av0, av1, t1);
  AT_BAR();
  const int niter = max(xch[0], xch[1]);
  for (int it = 0; it < niter; it += 2) {
    int t2, t3;
    AT_NEXT(t2);
    if (t2 >= 0) AT_LOAD(bk0, bk1, bv0, bv1, t2);
    if (t0 >= 0) attn_tile<PROB>(job, kvh, kvh + 2 * AT_TILEB, qf, st, slab, t0, wih, lane);
    if (t1 >= 0) { AT_WAIT(ak0, ak1, av0, av1, t2 >= 0); AT_WRITE(ak0, ak1, av0, av1, 1); }
    AT_BAR();
    if (it + 1 >= niter) break;
    AT_NEXT(t3);
    if (t3 >= 0) AT_LOAD(ak0, ak1, av0, av1, t3);
    if (t1 >= 0) attn_tile<PROB>(job, kvh + AT_TILEB, kvh + 3 * AT_TILEB, qf, st, slab, t1, wih, lane);
    if (t2 >= 0) { AT_WAIT(bk0, bk1, bv0, bv1, t3 >= 0); AT_WRITE(bk0, bk1, bv0, bv1, 0); }
    AT_BAR();
    t0 = t2; t1 = t3;
  }
#undef AT_BAR
#undef AT_WAIT
#undef AT_GLD
#undef AT_LOAD
#undef AT_WRITE
#undef AT_NEXT
  if (!PROB) {
#pragma unroll
    for (int sub = 0; sub < 2; ++sub) {
      float l = st.l[sub];
      l += shx(l, lane, 16);
      l += shx(l, lane, 32);
      const float inv = 1.0f / fmaxf(l, 1e-30f);
      st.l[sub] = l;
#pragma unroll
      for (int dt = 0; dt < 4; ++dt) st.O[sub][dt] *= inv;
    }
  }
  __syncthreads();
}

struct SelJob {
  const act_t* u; int b, g, t0; unsigned um; unsigned tm[2];
  DEV unsigned tilemask() const { return um; }
  DEV const act_t* qrow(int r) const { return u + ((size_t)b * SEQ + t0 + (r & 31)) * N_IN + OFF_CQ + (g * 4 + (r >> 5)) * 64; }
  DEV const act_t* krow(int kt, int j) const { return u + ((size_t)b * SEQ + kt * 64 + j) * N_IN + OFF_CKS + g * 64; }
  DEV const act_t* vrow(int kt, int j) const { return u + ((size_t)b * SEQ + kt * 64 + j) * N_IN + OFF_CVS + g * 64; }
  DEV int mb(int r, int kt, int g4) const { return t0 + (r & 31) - kt * 64 - 4 * g4; }
  DEV bool rowok(int sub, int kt) const { return (tm[sub] >> kt) & 1u; }
  DEV bool ok(int m, int C) const { return m >= C; }
  DEV bool elemfree(int kt, int wih) const { return kt < (t0 >> 6); }
};
struct WinJob {
  const act_t* u; int b, g, t0; unsigned um;
  DEV unsigned tilemask() const { return um; }
  DEV const act_t* qrow(int r) const { return u + ((size_t)b * SEQ + t0 + (r & 31)) * N_IN + OFF_CQ + (g * 4 + (r >> 5)) * 64; }
  DEV const act_t* krow(int kt, int j) const { return u + ((size_t)b * SEQ + kt * 64 + j) * N_IN + OFF_CKW + g * 64; }
  DEV const act_t* vrow(int kt, int j) const { return u + ((size_t)b * SEQ + kt * 64 + j) * N_IN + OFF_CVW + g * 64; }
  DEV int mb(int r, int kt, int g4) const { return t0 + (r & 31) - kt * 64 - 4 * g4; }
  DEV bool rowok(int sub, int kt) const { return true; }
  DEV bool ok(int m, int C) const { return m >= C && m < NSA_WIN + C; }
  DEV bool elemfree(int kt, int wih) const { return kt * 64 + 63 <= t0 && t0 + 31 - kt * 64 < NSA_WIN; }
};
struct CmpJob {
  const act_t* u; const act_t* kcb; const act_t* vcb; int b, g, t0; unsigned um;
  DEV unsigned tilemask() const { return um; }
  DEV const act_t* qrow(int r) const { return u + ((size_t)b * SEQ + t0 + (r & 31)) * N_IN + OFF_CQ + (g * 4 + (r >> 5)) * 64; }
  DEV const act_t* krow(int kt, int j) const { return kcb + (((size_t)b * 128 + kt * 64 + j) * NSA_G + g) * 64; }
  DEV const act_t* vrow(int kt, int j) const { return vcb + (((size_t)b * 128 + kt * 64 + j) * NSA_G + g) * 64; }
  DEV int mb(int r, int kt, int g4) const { return t0 + (r & 31) - 31 - 16 * (kt * 64 + 4 * g4); }
  DEV bool rowok(int sub, int kt) const { return true; }
  DEV bool ok(int m, int C) const { return m >= 16 * C; }
  DEV bool elemfree(int kt, int wih) const { return kt == 0 && 16 * 63 + 31 <= t0; }
};
struct DilJob {
  const act_t* u; int b, col, dil, res, l0; unsigned um;
  DEV unsigned tilemask() const { return um; }
  DEV const act_t* qrow(int r) const { return u + ((size_t)b * SEQ + (l0 + r) * dil + res) * N_IN + OFF_AQ + col; }
  DEV const act_t* krow(int kt, int j) const { return u + ((size_t)b * SEQ + (kt * 64 + j) * dil + res) * N_IN + OFF_AK + col; }
  DEV const act_t* vrow(int kt, int j) const { return u + ((size_t)b * SEQ + (kt * 64 + j) * dil + res) * N_IN + OFF_AV + col; }
  DEV int mb(int r, int kt, int g4) const { return l0 + r - kt * 64 - 4 * g4; }
  DEV bool rowok(int sub, int kt) const { return true; }
  DEV bool ok(int m, int C) const { return m >= C && m <= 128 + C; }
  DEV bool elemfree(int kt, int wih) const { return kt * 64 + 63 <= l0 + 32 * wih && l0 + 32 * wih + 31 - kt * 64 <= 128; }
};

DEV unsigned range_mask(int lo, int hi) {
  return (hi >= 31 ? 0xffffffffu : ((1u << (hi + 1)) - 1u)) & ~((1u << lo) - 1u);
}

DEV bool nsa_unit(int round, int bid, int G, int half, int& b, int& g, int& tb) {
  if ((G & 7) == 0) {
    const int nr = G >> 3, rank = bid >> 3;
    const int slot = rank * 2 + half, nslot = nr * 2;
    const int pos = (round & 1) ? (nslot - 1 - slot) : slot;
    const int lu = round * nslot + pos;
    if (lu >= 256) return false;
    b = bid & 7; g = lu & 3; tb = 63 - (lu >> 2);
    return true;
  }
  const int pos = (round & 1) ? (G - 1 - bid) : bid;
  const int pair = round * G + pos;
  if (pair >= 1024) return false;
  const int un = pair * 2 + half;
  tb = 63 - un / 32; b = (un % 32) / 4; g = un % 4;
  return true;
}
DEV int nsa_rounds(int G) { return (G & 7) == 0 ? (256 + (G >> 3) * 2 - 1) / ((G >> 3) * 2) : (1024 + G - 1) / G; }

DEV void nsa_cmp_phase(const Params& p, LAS unsigned char* lds, int t32, int bid, int G) {
  const int lane = t32 & 63, wave = t32 >> 6, half = wave >> 2, wih = wave & 3, hth = t32 & 255;
  const int i15 = lane & 15, g4 = lane >> 4;
  LAS float* slabh = (LAS float*)(lds + AT_SLAB_OFF + half * AT_SLAB_HALF);
  for (int round = 0; round < nsa_rounds(G); ++round) {
    int b = 0, g = 0, tb = 0;
    const bool act = nsa_unit(round, bid, G, half, b, g, tb);
    const int t0 = tb * 32;
    const int nvmax = t0 + 31 >= 31 ? (t0 + 31 - 31) / 16 + 1 : 0;
    CmpJob job{p.u, p.kcb, p.kcb + (size_t)BATCH * 128 * NSA_G * 64, b, g, t0, 0u};
    job.um = !act ? 0u : (nvmax > 64 ? 3u : (nvmax > 0 ? 1u : 0u));
    for (int i = lane; i < 32 * 33; i += 64) slabh[wih * (32 * 33) + i] = 0.f;
    AttnState st;
    attn_run<false>(job, lds, st, half, hth, wih, lane);
    if (act) {
#pragma unroll
      for (int sub = 0; sub < 2; ++sub) {
        const int hh = g * 4 + wih;
        const size_t n = (size_t)b * SEQ + t0 + sub * 16 + i15;
        const float g0 = sigmoidf_(ldf(p.u[n * N_IN + OFF_CG + hh * 3 + 0]));
#pragma unroll
        for (int dt = 0; dt < 4; ++dt) *(f32x4*)(p.ocmp + n * 1024 + hh * 64 + 16 * dt + 4 * g4) = st.O[sub][dt] * g0;
        st.l[sub] = 1.0f / fmaxf(st.l[sub], 1e-30f);
      }
    }
    attn_run<true>(job, lds, st, half, hth, wih, lane);
    {
      const int q = hth >> 3, j4 = (hth & 7) * 4;
      float v[4];
#pragma unroll
      for (int i = 0; i < 4; ++i) {
        float s = 0.f;
#pragma unroll
        for (int w = 0; w < 4; ++w) s += slabh[w * (32 * 33) + q * 33 + j4 + i];
        const int j = j4 + i, qb = (t0 + q) >> 6;
        if (j == 0 || j == qb || j == qb - 1) s = INFINITY;
        else if (j > qb) s = -INFINITY;
        v[i] = s;
      }
      __syncthreads();
#pragma unroll
      for (int i = 0; i < 4; ++i) slabh[q * 33 + j4 + i] = v[i];
      __syncthreads();
      unsigned bits = 0u;
#pragma unroll
      for (int i = 0; i < 4; ++i) {
        int rank = 0;
#pragma unroll 1
        for (int jj = 0; jj < 32; ++jj) { const float w = slabh[q * 33 + jj]; rank += (w > v[i] || (w == v[i] && jj < j4 + i)) ? 1 : 0; }
        if (rank < N_SELECT) bits |= 1u << (j4 + i);
      }
      bits |= (unsigned)shxi((int)bits, lane, 1);
      bits |= (unsigned)shxi((int)bits, lane, 2);
      bits |= (unsigned)shxi((int)bits, lane, 4);
      if (act && (hth & 7) == 0) p.selm[((size_t)b * NSA_G + g) * SEQ + t0 + q] = bits;
      __syncthreads();
    }
  }
}

DEV void nsa_main_phase(const Params& p, LAS unsigned char* lds, int t32, int bid, int G) {
  const int lane = t32 & 63, wave = t32 >> 6, half = wave >> 2, wih = wave & 3, hth = t32 & 255;
  const int i15 = lane & 15, g4 = lane >> 4;
  for (int round2 = 0; round2 < nsa_rounds(G) * (NSA_PROBE == 5 ? 2 : 1); ++round2) {
    const int round = (NSA_PROBE == 5) ? (round2 >> 1) : round2;
    int b = 0, g = 0, tb = 0;
    const bool act = nsa_unit(round, bid, G, half, b, g, tb);
    const int t0 = tb * 32;
    SelJob sj{p.u, b, g, t0, 0u, {0u, 0u}};
    if (act) {
      const unsigned* sm = p.selm + ((size_t)b * NSA_G + g) * SEQ + t0;
      sj.tm[0] = sm[i15]; sj.tm[1] = sm[16 + i15];
      unsigned um = sj.tm[0] | sj.tm[1];
      um |= (unsigned)shxi((int)um, lane, 1); um |= (unsigned)shxi((int)um, lane, 2);
      um |= (unsigned)shxi((int)um, lane, 4); um |= (unsigned)shxi((int)um, lane, 8);
      sj.um = um & range_mask(0, t0 >> 6);
    }
    u32x2 base[2][4];
    const int hh = g * 4 + wih;
    const size_t nrow0 = (size_t)b * SEQ + t0 + i15;
    const act_t gq10 = p.u[nrow0 * N_IN + OFF_CG + hh * 3 + 1], gq11 = p.u[(nrow0 + 16) * N_IN + OFF_CG + hh * 3 + 1];
    const act_t gq20 = p.u[nrow0 * N_IN + OFF_CG + hh * 3 + 2], gq21 = p.u[(nrow0 + 16) * N_IN + OFF_CG + hh * 3 + 2];
    {
      AttnState ss;
      attn_run<false>(sj, lds, ss, half, hth, wih, lane);
#if NSA_PROBE == 1
      attn_run<false>(sj, lds, ss, half, hth, wih, lane);
#endif
#pragma unroll
      for (int sub = 0; sub < 2; ++sub) {
        f32x4 oc[4];
#pragma unroll
        for (int dt = 0; dt < 4; ++dt) oc[dt] = *(const f32x4*)(p.ocmp + (nrow0 + 16 * sub) * 1024 + hh * 64 + 16 * dt + 4 * g4);
        const float g1 = sigmoidf_(ldf(sub ? gq11 : gq10));
#pragma unroll
        for (int dt = 0; dt < 4; ++dt) {
          const f32x4 y = ss.O[sub][dt] * g1 + oc[dt];
          base[sub][dt].x = pk2(y.x, y.y); base[sub][dt].y = pk2(y.z, y.w);
        }
      }
    }
    WinJob wj{p.u, b, g, t0, 0u};
    if (act) { const int lo = t0 - (NSA_WIN - 1) < 0 ? 0 : (t0 - (NSA_WIN - 1)) >> 6; wj.um = range_mask(lo, (t0 + 31) >> 6); }
    AttnState ws;
    attn_run<false>(wj, lds, ws, half, hth, wih, lane);
#if NSA_PROBE == 2
    attn_run<false>(wj, lds, ws, half, hth, wih, lane);
#endif
    if (act) {
#pragma unroll
      for (int sub = 0; sub < 2; ++sub) {
        const size_t n = nrow0 + 16 * sub;
        const float g2 = sigmoidf_(ldf(sub ? gq21 : gq20));
#pragma unroll
        for (int dt = 0; dt < 4; ++dt) {
          const u32x2 bw = base[sub][dt];
          f32x4 y = ws.O[sub][dt] * g2;
          y.x += __uint_as_float(bw.x << 16); y.y += __uint_as_float(bw.x & 0xffff0000u);
          y.z += __uint_as_float(bw.y << 16); y.w += __uint_as_float(bw.y & 0xffff0000u);
          u32x2 w; w.x = pk2(y.x, y.y); w.y = pk2(y.z, y.w);
          *(u32x2*)(p.yc + n * YLD + hh * 64 + 16 * dt + 4 * g4) = w;
        }
      }
    }
  }
}

DEV void dil_phase(const Params& p, LAS unsigned char* lds, int t32, int bid, int G) {
  const int lane = t32 & 63, wave = t32 >> 6, half = wave >> 2, wih = wave & 3, hth = t32 & 255;
  const int i15 = lane & 15, g4 = lane >> 4;
  const bool xm = (G & 7) == 0;
  const int npair = xm ? 96 : 768, pstep = xm ? (G >> 3) : G;
  for (int pair = xm ? (bid >> 3) : bid; pair < npair; pair += pstep) {
    const int un = pair * 2 + half;
    int gi, b, r2;
    if (xm) { b = bid & 7; gi = un / 64; r2 = un % 64; }
    else { gi = un / 512; const int r = un % 512; b = r / 64; r2 = r % 64; }
    const int dil = gi == 0 ? 1 : (gi == 1 ? 4 : 16);
    const int nlb = 16 / dil;
    const int h = r2 / 16, r3 = r2 % 16;
    const int res = r3 / nlb, lb = r3 % nlb;
    const int l0 = lb * 128;
    DilJob job{p.u, b, gi * 256 + h * 64, dil, res, l0, 0u};
    job.um = range_mask(l0 >= 128 ? (l0 - 128) >> 6 : 0, (l0 + 127) >> 6);
    AttnState st;
    attn_run<false>(job, lds, st, half, hth, wih, lane);
#pragma unroll
    for (int sub = 0; sub < 2; ++sub) {
      const int l = l0 + wih * 32 + sub * 16 + i15;
      const size_t n = (size_t)b * SEQ + l * dil + res;
#pragma unroll
      for (int dt = 0; dt < 4; ++dt) {
        const f32x4 y = st.O[sub][dt];
        u32x2 w; w.x = pk2(y.x, y.y); w.y = pk2(y.z, y.w);
        *(u32x2*)(p.dilo + ((size_t)gi * N_TOK + n) * 256 + h * 64 + 16 * dt + 4 * g4) = w;
      }
      if (g4 == 0) p.dill[((size_t)gi * N_TOK + n) * 4 + h] = st.m[sub] + __builtin_amdgcn_logf(st.l[sub]);
    }
  }
}

DEV void dil_combine(const Params& p, long long tid, long long nthr) {
  for (long long idx = tid; idx < (long long)N_TOK * 32; idx += nthr) {
    const size_t n = idx >> 5; const int c8 = (int)(idx & 31) * 8, h = c8 >> 6;
    const float l0 = p.dill[((size_t)0 * N_TOK + n) * 4 + h], l1 = p.dill[((size_t)1 * N_TOK + n) * 4 + h], l2 = p.dill[((size_t)2 * N_TOK + n) * 4 + h];
    const float mx = fmaxf(l0, fmaxf(l1, l2));
    float w0 = __builtin_amdgcn_exp2f(l0 - mx), w1 = __builtin_amdgcn_exp2f(l1 - mx), w2 = __builtin_amdgcn_exp2f(l2 - mx);
    const float inv = 1.0f / (w0 + w1 + w2);
    w0 *= inv; w1 *= inv; w2 *= inv;
    const u32x4 a = *(const u32x4*)(p.dilo + ((size_t)0 * N_TOK + n) * 256 + c8);
    const u32x4 bq = *(const u32x4*)(p.dilo + ((size_t)1 * N_TOK + n) * 256 + c8);
    const u32x4 c = *(const u32x4*)(p.dilo + ((size_t)2 * N_TOK + n) * 256 + c8);
    u32x4 o;
#pragma unroll
    for (int i = 0; i < 4; ++i) {
      const float lo = w0 * __uint_as_float(a[i] << 16) + w1 * __uint_as_float(bq[i] << 16) + w2 * __uint_as_float(c[i] << 16);
      const float hi = w0 * __uint_as_float(a[i] & 0xffff0000u) + w1 * __uint_as_float(bq[i] & 0xffff0000u) + w2 * __uint_as_float(c[i] & 0xffff0000u);
      o[i] = pk2(lo, hi);
    }
    *(u32x4*)(p.ya + n * YLD + c8) = o;
  }
}

DEV void cmpa_build(const Params& p, int li, long long tid, long long nthr) {
  for (long long idx = tid; idx < 2LL * CMP_ROWS * 256; idx += nthr) {
    const int which = (int)(idx / ((long long)CMP_ROWS * 256));
    const long long rem = idx % ((long long)CMP_ROWS * 256);
    const int row = (int)(rem >> 8), c8 = (int)(rem & 255) * 8, l = c8 >> 6, d = c8 & 63;
    const int g = row % NSA_G, c = (row / NSA_G) % N_CMP, b = row / (NSA_G * N_CMP);
    const float* pe = (which ? p.cmp_pe_v : p.cmp_pe_k) + (size_t)li * 32 * HD + l * HD + d;
    const u32x4 uv = *(const u32x4*)(p.u + ((size_t)b * SEQ + c * 16 + l) * N_IN + (which ? OFF_CVC : OFF_CKC) + g * HD + d);
    u32x4 o;
#pragma unroll
    for (int i = 0; i < 4; ++i) o[i] = pk2(__uint_as_float(uv[i] << 16) + pe[2 * i], __uint_as_float(uv[i] & 0xffff0000u) + pe[2 * i + 1]);
    *(u32x4*)(p.cmpA + ((size_t)which * CMP_ROWS_PAD + row) * 2048 + c8) = o;
  }
}

constexpr int XA_ROWB = 528;
constexpr int XA_TILEB = 32 * XA_ROWB;
static_assert(4 * XA_TILEB <= RING_BYTES, "xattn LDS map");
DEV void xattn_phase(const Params& p, LAS unsigned char* lds, int t32, int bid, int G) {
  const int lane = t32 & 63, wave = t32 >> 6, i15 = lane & 15, g4 = lane >> 4;
  const float sc2 = 0.0625f * 1.4426950408889634f;
  const bool xm = (G & 7) == 0;
  const int nun = xm ? XH * (SEQ / 128) : BATCH * XH * (SEQ / 128), ustep = xm ? (G >> 3) : G;
  for (int un = xm ? (bid >> 3) : bid; un < nun; un += ustep) {
    const int b = xm ? (bid & 7) : un / (XH * (SEQ / 128)), r = un % (XH * (SEQ / 128)), h = r / (SEQ / 128), qb = r % (SEQ / 128);
    const size_t nq = (size_t)b * SEQ + qb * 128 + wave * 16 + i15;
    bf16x8 qf[8];
#pragma unroll
    for (int kk = 0; kk < 8; ++kk) qf[kk] = *(const bf16x8*)(p.xq + nq * 1024 + h * 256 + kk * 32 + 8 * g4);
    f32x4 O[16];
#pragma unroll
    for (int dt = 0; dt < 16; ++dt) O[dt] = (f32x4){0.f, 0.f, 0.f, 0.f};
    float m = -INFINITY, l = 0.f;
    const int srow = t32 >> 4, sch = t32 & 15;
    const act_t* kbase = p.memk + ((size_t)b * MEM_LEN + srow) * 1024 + h * 256 + sch * 16;
    const act_t* vbase = p.memv + ((size_t)b * MEM_LEN + srow) * 1024 + h * 256 + sch * 16;
    u32x4 sk0 = *(const u32x4*)kbase, sk1 = *(const u32x4*)(kbase + 8), sv0 = *(const u32x4*)vbase, sv1 = *(const u32x4*)(vbase + 8);
    {
      LAS unsigned char* kd = lds + srow * XA_ROWB + sch * 32;
      *(LAS u32x4*)kd = sk0; *(LAS u32x4*)(kd + 16) = sk1;
      LAS unsigned char* vd = lds + 2 * XA_TILEB + srow * XA_ROWB + sch * 32;
      *(LAS u32x4*)vd = sv0; *(LAS u32x4*)(vd + 16) = sv1;
    }
    __syncthreads();
    for (int it = 0; it < MEM_LEN / 32; ++it) {
      if (it + 1 < MEM_LEN / 32) {
        const act_t* kr = kbase + (size_t)(it + 1) * 32 * 1024, *vr = vbase + (size_t)(it + 1) * 32 * 1024;
        sk0 = *(const u32x4*)kr; sk1 = *(const u32x4*)(kr + 8); sv0 = *(const u32x4*)vr; sv1 = *(const u32x4*)(vr + 8);
      }
      const LAS unsigned char* Kb = lds + (it & 1) * XA_TILEB;
      const LAS unsigned char* Vb = lds + (2 + (it & 1)) * XA_TILEB;
      f32x4 S[2];
      S[0] = (f32x4){0.f, 0.f, 0.f, 0.f}; S[1] = (f32x4){0.f, 0.f, 0.f, 0.f};
#pragma unroll
      for (int t = 0; t < 2; ++t)
#pragma unroll
        for (int kk = 0; kk < 8; ++kk) {
          const bf16x8 kf = *(const LAS bf16x8*)(Kb + (16 * t + i15) * XA_ROWB + (kk * 32 + 8 * g4) * 2);
          S[t] = __builtin_amdgcn_mfma_f32_16x16x32_bf16(kf, qf[kk], S[t], 0, 0, 0);
        }
      float mx = -INFINITY;
#pragma unroll
      for (int t = 0; t < 2; ++t)
#pragma unroll
        for (int j = 0; j < 4; ++j) { S[t][j] *= sc2; mx = fmaxf(mx, S[t][j]); }
      mx = fmaxf(mx, shx(mx, lane, 16));
      mx = fmaxf(mx, shx(mx, lane, 32));
      const float mnew = fmaxf(m, mx);
      const float corr = __builtin_amdgcn_exp2f(m - mnew);
      m = mnew;
      float psum = 0.f;
#pragma unroll
      for (int t = 0; t < 2; ++t)
#pragma unroll
        for (int j = 0; j < 4; ++j) { const float pp = __builtin_amdgcn_exp2f(S[t][j] - mnew); S[t][j] = pp; psum += pp; }
      l = l * corr + psum;
      u32x4 w;
      w.x = pk2(S[0][0], S[0][1]); w.y = pk2(S[0][2], S[0][3]); w.z = pk2(S[1][0], S[1][1]); w.w = pk2(S[1][2], S[1][3]);
      const bf16x8 pf = __builtin_bit_cast(bf16x8, w);
#pragma unroll
      for (int dt = 0; dt < 16; ++dt) {
        const LAS unsigned char* vp = Vb + (4 * g4 + (i15 >> 2)) * XA_ROWB + (16 * dt + 4 * (lane & 3)) * 2;
        const v4i16_t lo = tr_read(vp), hi = tr_read(vp + 16 * XA_ROWB);
        bf16x8 vf;
        vf[0] = lo[0]; vf[1] = lo[1]; vf[2] = lo[2]; vf[3] = lo[3]; vf[4] = hi[0]; vf[5] = hi[1]; vf[6] = hi[2]; vf[7] = hi[3];
        O[dt] = __builtin_amdgcn_mfma_f32_16x16x32_bf16(vf, pf, O[dt] * corr, 0, 0, 0);
      }
      if (it + 1 < MEM_LEN / 32) {
        LAS unsigned char* kd = lds + ((it + 1) & 1) * XA_TILEB + srow * XA_ROWB + sch * 32;
        *(LAS u32x4*)kd = sk0; *(LAS u32x4*)(kd + 16) = sk1;
        LAS unsigned char* vd = lds + (2 + ((it + 1) & 1)) * XA_TILEB + srow * XA_ROWB + sch * 32;
        *(LAS u32x4*)vd = sv0; *(LAS u32x4*)(vd + 16) = sv1;
      }
      __syncthreads();
    }
    l += shx(l, lane, 16);
    l += shx(l, lane, 32);
    const float inv = 1.0f / l;
#pragma unroll
    for (int dt = 0; dt < 16; ++dt) {
      const f32x4 y = O[dt] * inv;
      u32x2 w; w.x = pk2(y.x, y.y); w.y = pk2(y.z, y.w);
      *(u32x2*)(p.xo + nq * 1024 + h * 256 + 16 * dt + 4 * g4) = w;
    }
  }
}

DEV void route_phase(const Params& p, int li, int gw, int NGW, int lane) {
  const float* W = p.w_router + (size_t)li * D * NE;
  const int e = lane & 31, hf = lane >> 5;
  for (int n = gw; n < N_TOK; n += NGW) {
    const float* xr = p.xf + (size_t)n * D + hf * 512;
    const float* wr = W + (size_t)hf * 512 * NE + e;
    float a0 = 0.f, a1 = 0.f, a2 = 0.f, a3 = 0.f;
    for (int k = 0; k < 512; k += 4) {
      const f32x4 x = *(const f32x4*)(xr + k);
      a0 += x.x * wr[(size_t)k * NE]; a1 += x.y * wr[(size_t)(k + 1) * NE];
      a2 += x.z * wr[(size_t)(k + 2) * NE]; a3 += x.w * wr[(size_t)(k + 3) * NE];
    }
    float v = (a0 + a1) + (a2 + a3);
    v += shx(v, lane, 32);
    v += p.b_router[li * NE + e];
    int sel[4]; float sv[4];
    float cur = v;
#pragma unroll
    for (int k = 0; k < 4; ++k) {
      float bv = cur; int bi = e;
#pragma unroll
      for (int o = 1; o < 32; o <<= 1) {
        const float ov = shx(bv, lane, o); const int oi = shxi(bi, lane, o);
        if (ov > bv || (ov == bv && oi < bi)) { bv = ov; bi = oi; }
      }
      sel[k] = bi; sv[k] = bv;
      if (e == bi) cur = -INFINITY;
    }
    if (lane == 0) {
      const float e1 = expf(sv[1] - sv[0]), e2 = expf(sv[2] - sv[0]), e3 = expf(sv[3] - sv[0]);
      const float inv = 1.0f / (1.0f + e1 + e2 + e3);
      p.topg[n * 4 + 0] = inv; p.topg[n * 4 + 1] = e1 * inv; p.topg[n * 4 + 2] = e2 * inv; p.topg[n * 4 + 3] = e3 * inv;
#pragma unroll
      for (int k = 0; k < 4; ++k) { p.topi[n * 4 + k] = sel[k]; p.rank[n * 4 + k] = atomicAdd(&p.cnt[li * 32 + sel[k]], 1); }
    }
  }
}

DEV void kcv_phase(const Params& p, int li, long long tid, long long nthr) {
  for (long long i2 = tid; i2 < 2LL * CMP_ROWS * HD; i2 += nthr) {
    const int which = (int)(i2 / ((long long)CMP_ROWS * HD));
    const long long rem = i2 % ((long long)CMP_ROWS * HD);
    const int row = (int)(rem / HD), d = (int)(rem % HD);
    const float* w2 = (which ? p.cmp_w2_v : p.cmp_w2_k) + (size_t)li * CMP_HID * HD;
    const float* hr = p.hid + ((size_t)which * CMP_ROWS + row) * CMP_HID;
    float s = 0.f;
#pragma unroll 8
    for (int j = 0; j < CMP_HID; ++j) s += hr[j] * w2[j * HD + d];
    const int g_ = row % NSA_G, c_ = (row / NSA_G) % N_CMP, b_ = row / (NSA_G * N_CMP);
    p.kcb[((((size_t)which * BATCH + b_) * 128 + c_) * NSA_G + g_) * 64 + d] = f2bfh(s);
  }
}

constexpr int GA_QS = 272, GA_VS = 528, GA_PS = 144;
constexpr int GA_QT = 0, GA_KT = GA_QT + 64 * GA_QS, GA_KH = GA_KT + 64 * GA_QS, GA_VT = GA_KH + 64 * GA_QS, GA_PT = GA_VT + 64 * GA_VS,
              GA_LR = GA_PT + 64 * GA_PS, GA_GT = GA_LR + 64 * 16 * 4, GA_DC = GA_GT + 4 * 128 * 4, GA_END = GA_DC + 512;
static_assert(GA_END <= RING_BYTES, "GLA phase A LDS map");
constexpr int GC_SP = 0, GC_QT = GC_SP + 128 * GA_VS, GC_RED = GC_QT + 64 * GA_QS, GC_END = GC_RED + 8 * 16 * 4 * 2;
static_assert(GC_END <= RING_BYTES, "GLA phase C LDS map");

DEV void gla_a_unit(const Params& p, int li, LAS unsigned char* lds, int t32, int unit) {
  const int lane = t32 & 63, wave = t32 >> 6, i15 = lane & 15, g4 = lane >> 4;
  const int bh = unit >> 5, ci = unit & 31, b = bh >> 2, h = bh & 3;
  const int c = t32 & 127, jq = t32 >> 7;
  LAS float* LR = (LAS float*)(lds + GA_LR);
  LAS float* GT = (LAS float*)(lds + GA_GT);
  LAS float* DC = (LAS float*)(lds + GA_DC);
  const float qscale = 0.08838834764831845f;
  const size_t n0 = (size_t)b * SEQ + ci * 64;
  {
    const int e = t32 * 2, j = e >> 4, r = e & 15;
    const unsigned w = *(const unsigned*)(p.u + (n0 + j) * N_IN + OFF_LR + r);
    LR[e] = __uint_as_float(w << 16); LR[e + 1] = __uint_as_float(w & 0xffff0000u);
  }
  float wa[GLA_RANK];
#pragma unroll
  for (int r = 0; r < GLA_RANK; ++r) wa[r] = p.w_alpha2[((size_t)li * GLA_RANK + r) * B_K + h * 128 + c];
  const float ba = p.b_alpha[li * B_K + h * 128 + c];
  unsigned short qv[16], kv[16];
#pragma unroll
  for (int jj = 0; jj < 16; ++jj) {
    const act_t* ur = p.u + (n0 + jq * 16 + jj) * N_IN;
    qv[jj] = ur[OFF_BQ + h * 128 + c];
    kv[jj] = ur[OFF_BK + h * 128 + c];
  }
#pragma unroll
  for (int x = 0; x < 4; ++x) {
    const int idx = t32 + 512 * x, row = idx >> 5, ch = idx & 31;
    const u32x4 vv = *(const u32x4*)(p.u + (n0 + row) * N_IN + OFF_BV + h * 256 + ch * 8);
    *(LAS u32x4*)(lds + GA_VT + row * GA_VS + ch * 16) = vv;
  }
  __syncthreads();
  float bl[16];
  float run = 0.f;
#pragma unroll
  for (int jj = 0; jj < 16; ++jj) {
    const LAS f32x4* lr4 = (const LAS f32x4*)(LR + (jq * 16 + jj) * 16);
    float z = ba;
#pragma unroll
    for (int r4 = 0; r4 < 4; ++r4) { const f32x4 x = lr4[r4]; z += x.x * wa[4 * r4] + x.y * wa[4 * r4 + 1] + x.z * wa[4 * r4 + 2] + x.w * wa[4 * r4 + 3]; }
    const float ez = __builtin_amdgcn_exp2f(-fabsf(z) * 1.4426950408889634f);
    const float ls = (fminf(z, 0.f) - __builtin_amdgcn_logf(1.0f + ez) * 0.6931471805599453f) * (1.0f / 16.0f);
    run += ls; bl[jj] = run;
  }
  GT[jq * 128 + c] = run;
  __syncthreads();
  {
    const float g0 = GT[c], g1 = GT[128 + c], g2 = GT[256 + c], g3 = GT[384 + c];
    const float off = (jq > 0 ? g0 : 0.f) + (jq > 1 ? g1 : 0.f) + (jq > 2 ? g2 : 0.f);
    const float tot = (g0 + g1) + (g2 + g3);
    const float dtot = __builtin_amdgcn_exp2f(tot * 1.4426950408889634f);
    if (jq == 0) { DC[c] = dtot; p.gD[(size_t)unit * 128 + c] = dtot; }
#pragma unroll
    for (int jj = 0; jj < 16; ++jj) {
      const float e1 = __builtin_amdgcn_exp2f((off + bl[jj]) * 1.4426950408889634f), ie = __builtin_amdgcn_rcpf(e1);
      const float qf = __uint_as_float(((unsigned)qv[jj]) << 16), kf = __uint_as_float(((unsigned)kv[jj]) << 16);
      const int ro = (jq * 16 + jj) * GA_QS + c * 2;
      const unsigned short qt = f2bfh(qf * e1 * qscale);
      *(LAS unsigned short*)(lds + GA_QT + ro) = qt;
      p.gQ[((size_t)unit * 64 + jq * 16 + jj) * 128 + c] = qt;
      *(LAS unsigned short*)(lds + GA_KT + ro) = f2bfh(kf * ie);
      *(LAS unsigned short*)(lds + GA_KH + ro) = f2bfh(kf * ie * dtot);
    }
  }
  __syncthreads();
#pragma unroll
  for (int q = 0; q < 2; ++q) {
    const int id = wave * 2 + q, jt = id >> 2, it = id & 3;
    f32x4 a = (f32x4){0.f, 0.f, 0.f, 0.f};
#pragma unroll
    for (int kk = 0; kk < 4; ++kk) {
      const bf16x8 kf = *(const LAS bf16x8*)(lds + GA_KT + (16 * jt + i15) * GA_QS + (32 * kk + 8 * g4) * 2);
      const bf16x8 qf = *(const LAS bf16x8*)(lds + GA_QT + (16 * it + i15) * GA_QS + (32 * kk + 8 * g4) * 2);
      a = __builtin_amdgcn_mfma_f32_16x16x32_bf16(kf, qf, a, 0, 0, 0);
    }
    const int i = 16 * it + i15, j0 = 16 * jt + 4 * g4;
    u32x2 w;
    w.x = pk2(j0 <= i ? a.x : 0.f, j0 + 1 <= i ? a.y : 0.f);
    w.y = pk2(j0 + 2 <= i ? a.z : 0.f, j0 + 3 <= i ? a.w : 0.f);
    *(LAS u32x2*)(lds + GA_PT + i * GA_PS + j0 * 2) = w;
  }
  __syncthreads();
  {
    const int it = wave & 3, vt0 = (wave >> 2) * 8;
    bf16x8 pf[2];
#pragma unroll
    for (int s = 0; s < 2; ++s) pf[s] = *(const LAS bf16x8*)(lds + GA_PT + (16 * it + i15) * GA_PS + (32 * s + 8 * g4) * 2);
#pragma unroll
    for (int x = 0; x < 8; ++x) {
      const int vt = vt0 + x;
      f32x4 a = (f32x4){0.f, 0.f, 0.f, 0.f};
#pragma unroll
      for (int s = 0; s < 2; ++s) {
        const LAS unsigned char* vp = lds + GA_VT + (32 * s + 8 * g4 + (i15 >> 2)) * GA_VS + (16 * vt + 4 * (lane & 3)) * 2;
        const v4i16_t lo = tr_read(vp), hi = tr_read(vp + 4 * GA_VS);
        bf16x8 vf;
        vf[0] = lo[0]; vf[1] = lo[1]; vf[2] = lo[2]; vf[3] = lo[3]; vf[4] = hi[0]; vf[5] = hi[1]; vf[6] = hi[2]; vf[7] = hi[3];
        a = __builtin_amdgcn_mfma_f32_16x16x32_bf16(vf, pf[s], a, 0, 0, 0);
      }
      *(f32x4*)(p.opart + (n0 + 16 * it + i15) * 1024 + h * 256 + 16 * vt + 4 * g4) = a;
    }
  }
  {
    bf16x8 vf[2][2];
#pragma unroll
    for (int x = 0; x < 2; ++x)
#pragma unroll
      for (int s = 0; s < 2; ++s) {
        const LAS unsigned char* vp = lds + GA_VT + (32 * s + 8 * g4 + (i15 >> 2)) * GA_VS + (16 * (2 * wave + x) + 4 * (lane & 3)) * 2;
        const v4i16_t lo = tr_read(vp), hi = tr_read(vp + 4 * GA_VS);
        vf[x][s][0] = lo[0]; vf[x][s][1] = lo[1]; vf[x][s][2] = lo[2]; vf[x][s][3] = lo[3];
        vf[x][s][4] = hi[0]; vf[x][s][5] = hi[1]; vf[x][s][6] = hi[2]; vf[x][s][7] = hi[3];
      }
#pragma unroll
    for (int ct = 0; ct < 8; ++ct) {
      f32x4 a0 = (f32x4){0.f, 0.f, 0.f, 0.f}, a1 = (f32x4){0.f, 0.f, 0.f, 0.f};
#pragma unroll
      for (int s = 0; s < 2; ++s) {
        const LAS unsigned char* kp = lds + GA_KH + (32 * s + 8 * g4 + (i15 >> 2)) * GA_QS + (16 * ct + 4 * (lane & 3)) * 2;
        const v4i16_t lo = tr_read(kp), hi = tr_read(kp + 4 * GA_QS);
        bf16x8 kf;
        kf[0] = lo[0]; kf[1] = lo[1]; kf[2] = lo[2]; kf[3] = lo[3]; kf[4] = hi[0]; kf[5] = hi[1]; kf[6] = hi[2]; kf[7] = hi[3];
        a0 = __builtin_amdgcn_mfma_f32_16x16x32_bf16(vf[0][s], kf, a0, 0, 0, 0);
        a1 = __builtin_amdgcn_mfma_f32_16x16x32_bf16(vf[1][s], kf, a1, 0, 0, 0);
      }
      act_t* up = p.gU + ((size_t)unit * 128 + 16 * ct + i15) * 256 + 32 * wave + 4 * g4;
      u32x2 w0; w0.x = pk2(a0.x, a0.y); w0.y = pk2(a0.z, a0.w);
      u32x2 w1; w1.x = pk2(a1.x, a1.y); w1.y = pk2(a1.z, a1.w);
      *(u32x2*)up = w0; *(u32x2*)(up + 16) = w1;
    }
  }
  __syncthreads();
}

DEV void gla_scan(const Params& p, long long tid, long long nthr) {
  for (long long idx = tid; idx < 32LL * 128 * 32; idx += nthr) {
    const int v8 = (int)(idx & 31) * 8, c = (int)((idx >> 5) & 127), bh = (int)(idx >> 12);
    float s[8];
#pragma unroll
    for (int i = 0; i < 8; ++i) s[i] = 0.f;
#pragma unroll 4
    for (int ci = 0; ci < 32; ++ci) {
      const size_t unit = (size_t)bh * 32 + ci;
      const u32x4 uw = *(const u32x4*)(p.gU + (unit * 128 + c) * 256 + v8);
      const float d = p.gD[unit * 128 + c];
      u32x4 o;
#pragma unroll
      for (int i = 0; i < 4; ++i) o[i] = pk2(s[2 * i], s[2 * i + 1]);
      *(u32x4*)(p.gS + (unit * 128 + c) * 256 + v8) = o;
#pragma unroll
      for (int i = 0; i < 4; ++i) {
        s[2 * i] = s[2 * i] * d + __uint_as_float(uw[i] << 16);
        s[2 * i + 1] = s[2 * i + 1] * d + __uint_as_float(uw[i] & 0xffff0000u);
      }
    }
  }
}

DEV void gla_c_unit(const Params& p, int li, LAS unsigned char* lds, int t32, int unit) {
  const int lane = t32 & 63, wave = t32 >> 6, i15 = lane & 15, g4 = lane >> 4;
  const int bh = unit >> 5, ci = unit & 31, b = bh >> 2, h = bh & 3;
  const size_t n0 = (size_t)b * SEQ + ci * 64;
#pragma unroll
  for (int x = 0; x < 8; ++x) {
    const int idx = t32 + 512 * x, row = idx >> 5, ch = idx & 31;
    *(LAS u32x4*)(lds + GC_SP + row * GA_VS + ch * 16) = *(const u32x4*)(p.gS + ((size_t)unit * 128 + row) * 256 + ch * 8);
  }
#pragma unroll
  for (int x = 0; x < 2; ++x) {
    const int idx = t32 + 512 * x, row = idx >> 4, ch = idx & 15;
    *(LAS u32x4*)(lds + GC_QT + row * GA_QS + ch * 16) = *(const u32x4*)(p.gQ + ((size_t)unit * 64 + row) * 128 + ch * 8);
  }
  __syncthreads();
  const int it = wave & 3, vt0 = (wave >> 2) * 8;
  bf16x8 qf[4];
#pragma unroll
  for (int kk = 0; kk < 4; ++kk) qf[kk] = *(const LAS bf16x8*)(lds + GC_QT + (16 * it + i15) * GA_QS + (32 * kk + 8 * g4) * 2);
  const size_t n = n0 + 16 * it + i15;
  f32x4 o[8];
  float ss = 0.f;
#pragma unroll
  for (int x = 0; x < 8; ++x) {
    const int vt = vt0 + x;
    f32x4 a = *(const f32x4*)(p.opart + n * 1024 + h * 256 + 16 * vt + 4 * g4);
#pragma unroll
    for (int kk = 0; kk < 4; ++kk) {
      const LAS unsigned char* sp = lds + GC_SP + (32 * kk + 8 * g4 + (i15 >> 2)) * GA_VS + (16 * vt + 4 * (lane & 3)) * 2;
      const v4i16_t lo = tr_read(sp), hi = tr_read(sp + 4 * GA_VS);
      bf16x8 sf;
      sf[0] = lo[0]; sf[1] = lo[1]; sf[2] = lo[2]; sf[3] = lo[3]; sf[4] = hi[0]; sf[5] = hi[1]; sf[6] = hi[2]; sf[7] = hi[3];
      a = __builtin_amdgcn_mfma_f32_16x16x32_bf16(sf, qf[kk], a, 0, 0, 0);
    }
    o[x] = a;
    ss += (a.x * a.x + a.y * a.y) + (a.z * a.z + a.w * a.w);
  }
  ss += shx(ss, lane, 16);
  ss += shx(ss, lane, 32);
  LAS float* RED = (LAS float*)(lds + GC_RED);
  if (g4 == 0) RED[wave * 16 + i15] = ss;
  __syncthreads();
  ss += RED[(wave ^ 4) * 16 + i15];
  const float rs = 1.0f / sqrtf(ss * (1.0f / 256.0f) + LN_EPS);
#pragma unroll
  for (int x = 0; x < 8; ++x) {
    const int v = 16 * (vt0 + x) + 4 * g4;
    const f32x4 gn = *(const f32x4*)(p.gla_norm_g + li * DV + v);
    const u32x2 rw = *(const u32x2*)(p.u + n * N_IN + OFF_BR + h * 256 + v);
    const float r0 = __uint_as_float(rw.x << 16), r1 = __uint_as_float(rw.x & 0xffff0000u), r2 = __uint_as_float(rw.y << 16), r3 = __uint_as_float(rw.y & 0xffff0000u);
    u32x2 w;
    w.x = pk2(o[x].x * rs * gn.x * (r0 * sigmoidf_(r0)), o[x].y * rs * gn.y * (r1 * sigmoidf_(r1)));
    w.y = pk2(o[x].z * rs * gn.z * (r2 * sigmoidf_(r2)), o[x].w * rs * gn.w * (r3 * sigmoidf_(r3)));
    *(u32x2*)(p.yb + n * YLD + h * 256 + v) = w;
  }
  __syncthreads();
}

#define XB_TMO      128
#define XB_XCNT(j)  (256  + 64 * (j))
#define XB_XSUB(j)  (1280 + 64 * (j))
#define XB_XGEN(j)  (2304 + 64 * (j))
#define XB_TOP      3328
#define XB_TOPGEN   3392
#define XCD_BAR_WORDS 3456
#define XB_SPIN_CAP (1u << 18)

__device__ __forceinline__ unsigned xb_ld(unsigned* p)              { return __hip_atomic_load(p, __ATOMIC_RELAXED, __HIP_MEMORY_SCOPE_AGENT); }
__device__ __forceinline__ unsigned xb_add(unsigned* p, unsigned v) { return __hip_atomic_fetch_add(p, v, __ATOMIC_RELAXED, __HIP_MEMORY_SCOPE_AGENT); }
__device__ __forceinline__ unsigned xb_xcc_id() { return (unsigned)__builtin_amdgcn_s_getreg((3 << 11) | 20) & 0xFu; }
#define XB_SPIN(cond, bar) do { unsigned _sp = 0; while (cond) { __builtin_amdgcn_s_sleep(1); \
    if ((++_sp & 255u) == 0u) { if (xb_ld(&(bar)[XB_TMO])) break; if (_sp > XB_SPIN_CAP) { atomicAdd(&(bar)[XB_TMO], 1u); break; } } } } while (0)

struct XcdBarrier {
    unsigned* bar; unsigned x;
    volatile LAS unsigned* st;
};

__device__ __forceinline__ XcdBarrier xcd_barrier_post(unsigned* bar, volatile LAS unsigned* st) {
    XcdBarrier b; b.bar = bar; b.x = xb_xcc_id(); b.st = st;
    if (threadIdx.x == 0) st[2] = xb_add(&bar[XB_XCNT(b.x)], 1u);
    return b;
}
__device__ __forceinline__ void xcd_barrier_complete(unsigned* bar, unsigned x, unsigned& nloc, unsigned& nx) {
    const unsigned G = gridDim.x * gridDim.y * gridDim.z;
    unsigned sum, cnt, mine, sp = 0u;
    for (;;) {
        sum = 0u; cnt = 0u; mine = 0u;
#pragma unroll
        for (unsigned j = 0; j < 16; ++j) { const unsigned c = xb_ld(&bar[XB_XCNT(j)]); sum += c; cnt += (c > 0u) ? 1u : 0u; mine = (j == x) ? c : mine; }
        if (sum == G) break;
        __builtin_amdgcn_s_sleep(1);
        if ((++sp & 255u) == 0u) { if (xb_ld(&bar[XB_TMO])) break; if (sp > XB_SPIN_CAP) { atomicAdd(&bar[XB_TMO], 1u); break; } }
    }
    nloc = mine > 0u ? mine : 1u; nx = cnt > 0u ? cnt : 1u;
}

__device__ __forceinline__ void xcd_barrier(const XcdBarrier& b, const int t32) {
    asm volatile("s_waitcnt vmcnt(0)" ::: "memory");
    __syncthreads();
    if (t32 == 0) {
        unsigned* bar = b.bar;
        __builtin_amdgcn_s_waitcnt(0);
        unsigned nloc = b.st[0], nx = b.st[1];
        if (nloc == 0u) { xcd_barrier_complete(bar, b.x, nloc, nx); b.st[0] = nloc; b.st[1] = nx; }
        const unsigned old = xb_add(&bar[XB_XSUB(b.x)], 1u);
        const unsigned gen = old / nloc;
        if (old + 1u == (gen + 1u) * nloc) {
            __builtin_amdgcn_fence(__ATOMIC_RELEASE, "agent");
            asm volatile("s_waitcnt vmcnt(0)" ::: "memory");
            const unsigned og = xb_add(&bar[XB_TOP], 1u);
            const unsigned tg = og / nx;
            if (og + 1u == (tg + 1u) * nx) xb_add(&bar[XB_TOPGEN], 1u);
            else XB_SPIN(xb_ld(&bar[XB_TOPGEN]) == tg, bar);
            __builtin_amdgcn_fence(__ATOMIC_ACQUIRE, "agent");
            xb_add(&bar[XB_XGEN(b.x)], 1u);
            asm volatile("s_waitcnt vmcnt(0)" ::: "memory");
        } else {
            XB_SPIN(xb_ld(&bar[XB_XGEN(b.x)]) == gen, bar);
            __builtin_amdgcn_fence(__ATOMIC_ACQUIRE, "agent");
            asm volatile("s_waitcnt vmcnt(0)" ::: "memory");
        }
    }
    __syncthreads();
}

constexpr int STEPS_PER_LAYER = 25;
#ifndef PROBE_LO
#define PROBE_LO -1
#define PROBE_HI -1
#endif
#ifndef PROBE_PRO
#define PROBE_PRO 0
#endif
#ifndef NSA_PROBE
#define NSA_PROBE 0
#endif
#ifndef MULTI_LAUNCH
#define MULTI_LAUNCH 0
#endif
DEV int fresh_t32(int wave) {
  int t;
  asm volatile("v_mbcnt_lo_u32_b32 %0, -1, 0\n\tv_mbcnt_hi_u32_b32 %0, -1, %0" : "=v"(t));
  return t + wave * 64;
}
struct KArgs { void* in[35]; void* out; void* ws; };
template <bool WITH_NAIVE, bool COOP>
__global__ void __launch_bounds__(NTHREADS) k_mega(KArgs ka, int step_lo, int step_hi) {
  unsigned* const barw0 = ((unsigned*)ka.ws);
  extern __shared__ __attribute__((aligned(16))) unsigned char lds_raw[];
  LAS unsigned char* lds = (LAS unsigned char*)lds_raw;
  LAS int* tab = (LAS int*)(lds + MISC_OFF);
  const int wave = __builtin_amdgcn_readfirstlane(threadIdx.x >> 6);
  const int G = gridDim.x;
  int bid = blockIdx.x;

  LAS unsigned* miscw = (LAS unsigned*)(lds + MISC_OFF + 8192);
  if (threadIdx.x < 64) miscw[threadIdx.x] = 0u;
  __syncthreads();
  XcdBarrier xbar; xbar.bar = barw0; xbar.x = 0; xbar.st = nullptr;
  if (COOP) xbar = xcd_barrier_post(barw0, miscw + 8);
  if (step_lo < 0) {
    Params p;
    fill_params(p, ka.in, ka.out, ka.ws);
    prologue(p, lds, wave, threadIdx.x & 63);
    if (COOP) cg::this_grid().sync();
#if PROBE_PRO
    prologue(p, lds, wave, threadIdx.x & 63);
    if (COOP) cg::this_grid().sync();
#endif
    step_lo = 0;
    if (COOP) {
      bool even = (G % 8) == 0;
#pragma unroll
      for (int j = 0; j < 8; ++j) even = even && (xb_ld(&barw0[XB_XCNT(j)]) == (unsigned)(G / 8));
      __syncthreads();
      if (even) bid = __builtin_amdgcn_readfirstlane((int)(xbar.x + 8u * miscw[10]));
    }
  }
  int rep_done = 0;
  for (int step = step_lo; step < step_hi;) {
    int li = step / STEPS_PER_LAYER;
    const int k = step % STEPS_PER_LAYER;
    int nb32 = gridDim.x;
    char* wsb = (char*)ka.ws;
    asm volatile("" : "+s"(wsb));
    Params p;
    fill_params(p, ka.in, ka.out, wsb);
    asm volatile("" : "+s"(li));
    asm volatile("" : "+s"(nb32));
#define T32() fresh_t32(wave)
#define TID() ((int)(blockIdx.x * NTHREADS) + T32())
    const int nthr = nb32 * NTHREADS;
    const int gw = blockIdx.x * 8 + wave, NGW = nb32 * 8;
    const bool is_gemm = (k == 0) || (k == 2) || (k == 3) || (k == 9) || (k == 10) || (k >= 12 && k <= 14) || (k == 17) || (k == 22) || (k == 23);
    const bool sync_after = !(k == 2 || k == 7 || k == 8 || k == 12 || k == 13 || k == 16 || k == 20);
    if (is_gemm) {
      pg8::Gemm g{nullptr, nullptr, 0, 0, 0};
      USched S; S.init_static(256, 256, G, bid);
      EpiU E{0, 0, nullptr, nullptr, nullptr, nullptr, nullptr, nullptr, nullptr};
      const size_t WSQ = (size_t)1024 * 1024;
      switch (k) {
        case 0:
          g = pg8::Gemm{p.xb, p.wt_in + (size_t)li * N_IN_PAD * 1024, N_TOK, N_IN_PAD, 1024};
          S.init_static(N_TOK, N_IN_PAD, G, bid);
          E.mode = EM_INPROJ; E.ob = p.u; E.f0 = p.b_in + (size_t)li * N_IN; break;
        case 2:
          g = pg8::Gemm{p.cmpA, p.wt_c1 + (size_t)(li * 2 + 0) * 256 * 2048, CMP_ROWS_PAD, 256, 2048};
          S.init_static(CMP_ROWS_PAD, 256, G, bid);
          E.mode = EM_HID; E.of = p.hid; break;
        case 3:
          g = pg8::Gemm{p.cmpA + (size_t)CMP_ROWS_PAD * 2048, p.wt_c1 + (size_t)(li * 2 + 1) * 256 * 2048, CMP_ROWS_PAD, 256, 2048};
          S.init_static(CMP_ROWS_PAD, 256, G, (bid + G - 16) % G);
          E.mode = EM_HID; E.of = p.hid + (size_t)CMP_ROWS * CMP_HID; break;
        case 9:
          g = pg8::Gemm{p.ya, p.wt_bra + (size_t)li * 1024 * YLD, N_TOK, 1024, YLD};
          S.init_static(N_TOK, 1024, G, bid);
          E.mode = EM_BRCAT; E.ub = p.u; E.ob = p.merged; break;
        case 10:
          g = pg8::Gemm{p.merged, p.wt_omix + li * WSQ, N_TOK, 1024, 1024};
          S.init_static(N_TOK, 1024, G, bid);
          E.mode = EM_RES; E.f0 = p.xf; E.of = p.tmp; break;
        case 12:
          g = pg8::Gemm{p.xb, p.wt_xq + li * WSQ, N_TOK, 1024, 1024};
          S.init_static(N_TOK, 1024, G, bid);
          E.mode = EM_BF16; E.ob = p.xq; E.ldc = 1024; break;
        case 13:
          g = pg8::Gemm{p.membf, p.wt_xk + li * WSQ, BATCH * MEM_LEN, 1024, 1024};
          S.init_static(BATCH * MEM_LEN, 1024, G, bid);
          E.mode = EM_BF16; E.ob = p.memk; E.ldc = 1024; break;
        case 14:
          g = pg8::Gemm{p.membf, p.wt_xv + li * WSQ, BATCH * MEM_LEN, 1024, 1024};
          S.init_static(BATCH * MEM_LEN, 1024, G, (bid + 128) % G);
          E.mode = EM_BF16; E.ob = p.memv; E.ldc = 1024; break;
        case 17:
          g = pg8::Gemm{p.xo, p.wt_xo + li * WSQ, N_TOK, 1024, 1024};
          S.init_static(N_TOK, 1024, G, bid);
          E.mode = EM_RES; E.f0 = p.xf; E.of = p.tmp; break;
        case 22: {
          const int ntiles = moe_tables(p, li, tab, T32());
          g = pg8::Gemm{p.xg, p.wt_gu + (size_t)li * 32 * 2048 * 1024, MOE_ROWS, 32 * 2048, 1024};
          S.init_moe(G, bid, 8, ntiles * 8, tab + 128);
          E.mode = EM_MOE1; E.ob = p.actg; E.f0 = p.b_gu + (size_t)li * 32 * 2048; E.te = tab + 128; break; }
        default: {
          const int ntiles = moe_tables(p, li, tab, T32());
          g = pg8::Gemm{p.actg, p.wt_dn + (size_t)li * 32 * 1024 * 1024, MOE_ROWS, 32 * 1024, 1024};
          S.init_moe(G, bid, 4, ntiles * 4, tab + 128);
          E.mode = EM_MOE2; E.of = p.yass; E.f0 = p.b_down + (size_t)li * 32 * 1024; E.f1 = p.topg; E.il = p.rowlist; E.te = tab + 128; break; }
      }
      pg8::gemm_phase<EpiU, USched, true, true>(lds, g, S, E, T32());
    } else {
      switch (k) {
        case 1: cmpa_build(p, li, TID(), nthr); break;
        case 4:
          { const int t = T32(); for (int un = bid; un < 1024; un += G) gla_a_unit(p, li, lds, t, un); }
          dil_phase(p, lds, T32(), bid, G);
          kcv_phase(p, li, TID(), nthr);
          break;
        case 5: gla_scan(p, TID(), nthr); nsa_cmp_phase(p, lds, T32(), bid, G); dil_combine(p, TID(), nthr); break;
        case 6: {
          nsa_main_phase(p, lds, T32(), bid, G);
#if NSA_PROBE == 4
          nsa_main_phase(p, lds, T32(), bid, G);
#endif
          const int t = T32();
          for (int un = bid; un < 1024; un += G) gla_c_unit(p, li, lds, t, un);
#if NSA_PROBE == 3
          for (int un = bid; un < 1024; un += G) gla_c_unit(p, li, lds, t, un);
#endif
          break; }
        case 11: ln_rows_w<0>(p, p.tmp, p.ln1_g + li * D, p.ln1_b + li * D, p.xf, p.xb, nullptr, gw, NGW, T32() & 63); break;
        case 18: ln_rows_w<0>(p, p.tmp, p.ln2_g + li * D, p.ln2_b + li * D, p.xf, p.xb, nullptr, gw, NGW, T32() & 63); break;
        case 21: { const int t = T32(); moe_prep(p, li, tab, wave, t & 63, t); break; }
        case 24: ln_rows_w<1>(p, nullptr, p.ln3_g + li * D, p.ln3_b + li * D, p.xf, p.xb, li == DEPTH - 1 ? p.out : nullptr, gw, NGW, T32() & 63); break;
        case 15: xattn_phase(p, lds, T32(), bid, G); break;
        case 19: route_phase(p, li, gw, NGW, T32() & 63); break;
        default: break;
      }
    }
    if (COOP && sync_after) xcd_barrier(xbar, T32());
    if (PROBE_HI >= 0 && k == PROBE_HI && !rep_done) { rep_done = 1; step -= (PROBE_HI - PROBE_LO); }
    else { if (k == PROBE_HI) rep_done = 0; ++step; }
  }
}

extern "C" void kernel_launch(void* const* d_in, const int* in_sizes, int n_in, void* d_out, int out_size,
                              void* d_ws, size_t ws_size, hipStream_t stream) {
  Params p;
  memset(&p, 0, sizeof(p));
  fill_params(p, d_in, d_out, d_ws);
  KArgs ka;
  memset(&ka, 0, sizeof(ka));
  for (int i = 0; i < 35; ++i) ka.in[i] = d_in[i];
  ka.out = d_out; ka.ws = d_ws;
  static int grid_blocks = 0;
  if (!grid_blocks) {
    int dev = 0, cus = 0;
    hipGetDevice(&dev);
    hipDeviceGetAttribute(&cus, hipDeviceAttributeMultiprocessorCount, dev);
    hipFuncSetAttribute((const void*)k_mega<true, true>, hipFuncAttributeMaxDynamicSharedMemorySize, LDS_BYTES);
    if (p.ws_used > ws_size) fprintf(stderr, "workspace too small: need %zu have %zu\n", p.ws_used, ws_size);
    grid_blocks = cus;
  }
  hipMemsetAsync(p.barw, 0, 4096 * sizeof(unsigned), stream);
  int lo = -1, hi = DEPTH * STEPS_PER_LAYER;
  void* args[] = {&ka, &lo, &hi};
  hipError_t e = hipLaunchCooperativeKernel((void*)k_mega<true, true>, dim3(grid_blocks), dim3(NTHREADS), args, LDS_BYTES, stream);
  if (e != hipSuccess) fprintf(stderr, "cooperative launch failed: %s (grid %d)\n", hipGetErrorString(e), grid_blocks);
}
#endif
```

```cpp
#ifndef CPU_TEST
#include <hip/hip_runtime.h>
#include <hip/hip_cooperative_groups.h>
#include <cstdio>
#include <cstring>
#include <cmath>
namespace cg = cooperative_groups;
#define DEV __device__ __forceinline__
#define HDI __host__ __device__ __forceinline__
#else
#include <cmath>
#include <cstdio>
#include <cstdlib>
#include <cstring>
#define DEV static inline
#define HDI static inline
#endif

#ifndef D_MODEL
#define D_MODEL 1024
#endif
#ifndef BATCH
#define BATCH 8
#endif
#ifndef MEGA
#define MEGA 1
#endif

constexpr int D = D_MODEL;
constexpr int SEQ = 2048;
constexpr int DEPTH = 2;
constexpr int MEM_LEN = 256;
constexpr int HD = 64;
constexpr int N_TOK = BATCH * SEQ;
constexpr int GLA_H = 4;
constexpr int DK = D / 2 / GLA_H;
constexpr int DV = D / GLA_H;
constexpr int GLA_RANK = 16;
constexpr int B_K = GLA_H * DK;
constexpr int B_V = GLA_H * DV;
constexpr int NSA_H = 16;
constexpr int NSA_G = 4;
constexpr int N_CMP = 127;
constexpr int CMP_HID = 128;
constexpr int N_BLK = 32;
constexpr int N_SELECT = 16;
constexpr int NSA_WIN = 512;
constexpr int XH = 4;
constexpr int XHD = D / XH;
constexpr int NE = 32;
constexpr int TOPK = 4;
constexpr int DFF = D;
constexpr float LN_EPS = 1e-5f;
constexpr float ALPHA = 1.41421356237309515f;

constexpr int OFF_AQ = 0;
constexpr int OFF_AK = 768;
constexpr int OFF_AV = 1536;
constexpr int OFF_BQ = 2304;
constexpr int OFF_BK = OFF_BQ + B_K;
constexpr int OFF_BV = OFF_BK + B_K;
constexpr int OFF_BR = OFF_BV + B_V;
constexpr int OFF_LR = OFF_BR + B_V;
constexpr int OFF_CQ = OFF_LR + GLA_RANK;
constexpr int OFF_CKC = OFF_CQ + 1024;
constexpr int OFF_CVC = OFF_CKC + 256;
constexpr int OFF_CKS = OFF_CVC + 256;
constexpr int OFF_CVS = OFF_CKS + 256;
constexpr int OFF_CKW = OFF_CVS + 256;
constexpr int OFF_CVW = OFF_CKW + 256;
constexpr int OFF_CG = OFF_CVW + 256;
constexpr int OFF_MG = OFF_CG + 48;
constexpr int N_IN = OFF_MG + 3 * D;
constexpr int N_IN_PAD = (N_IN + 255) / 256 * 256;
constexpr int MOE_ROWS = N_TOK * 4 + 32 * 256;
constexpr int CMP_ROWS_PAD = 4096;
constexpr int YLD = 256 + 1024 + 1024;

#ifdef CPU_TEST
typedef float act_t;
DEV float ldf(float v) { return v; }
DEV void stf(float* p, float v) { *p = v; }
#else
typedef unsigned short act_t;
DEV float ldf(unsigned short h) { return __uint_as_float(((unsigned)h) << 16); }
DEV float ldf(float v) { return v; }
DEV unsigned short f2bf(float f) {
  unsigned u = __float_as_uint(f);
  u += 0x7fffu + ((u >> 16) & 1u);
  return (unsigned short)(u >> 16);
}
DEV void stf(unsigned short* p, float v) { *p = f2bf(v); }
DEV void stf(float* p, float v) { *p = v; }
#endif

struct Params {
  const float *x, *mem, *ln0_g, *ln0_b, *w_in, *b_in, *w_alpha2, *b_alpha, *gla_norm_g,
      *cmp_pe_k, *cmp_w1_k, *cmp_w2_k, *cmp_pe_v, *cmp_w1_v, *cmp_w2_v,
      *w_br_a, *w_br_b, *w_br_c, *w_o_mix, *ln1_g, *ln1_b, *w_xq, *w_xk, *w_xv, *w_xo, *ln2_g, *ln2_b,
      *w_router, *b_router, *w_gu, *b_gu, *w_down, *b_down, *ln3_g, *ln3_b;
  float* out;
  float* xf;
  act_t* xb;
  act_t* u;
  float* ga;
  float* hid;
  float* kcv;
  float* opart;
  act_t* ya;
  act_t* yb;
  act_t* yc;
  float* pcmp;
  float* ocmp;
  float* impb;
  int* selb;
  act_t* merged;
  float* tmp;
  act_t* xq;
  act_t* memk;
  act_t* memv;
  float* xs;
  act_t* xo;
  float* rl;
  int* topi;
  float* topg;
  act_t* act;
  act_t* wt_in;
  act_t* wt_c1;
  act_t* wt_bra;
  act_t* wt_brb;
  act_t* wt_brc;
  act_t* wt_omix;
  act_t* wt_xq;
  act_t* wt_xk;
  act_t* wt_xv;
  act_t* wt_xo;
  act_t* wt_gu;
  act_t* wt_dn;
  act_t* membf;
  act_t* cmpA;
  float* mrg;
  int* cnt;
  int* rank;
  int* rowlist;
  act_t* xg;
  act_t* actg;
  float* yass;
  act_t* kcb;
  act_t* dilo;
  float* dill;
  unsigned* selm;
  act_t* gU;
  act_t* gS;
  act_t* gQ;
  float* gD;
  unsigned* barw;
  size_t ws_used;
};

#ifdef CPU_TEST
#define FOR_IDX(idx, total) \
  for (long long idx = (long long)(total) * tid / nthr, _e = (long long)(total) * (tid + 1) / nthr; idx < _e; ++idx)
#else
#define FOR_IDX(idx, total) for (long long idx = tid; idx < (long long)(total); idx += nthr)
#endif

DEV float sigmoidf_(float x) { return 1.0f / (1.0f + expf(-x)); }

template <class TA>
DEV float dotcol(const TA* a, const float* W, int K, long long ldw) {
  float s = 0.f;
  for (int k = 0; k < K; ++k) s += ldf(a[k]) * W[(long long)k * ldw];
  return s;
}

DEV void ph_ln(const float* src, const float* g, const float* b, float* dstf, act_t* dstb, float* dst2,
               long long tid, long long nthr) {
  FOR_IDX(n, N_TOK) {
    const float* r = src + n * D;
    float mu = 0.f;
    for (int i = 0; i < D; ++i) mu += r[i];
    mu /= D;
    float var = 0.f;
    for (int i = 0; i < D; ++i) { float d = r[i] - mu; var += d * d; }
    var /= D;
    float rs = 1.0f / sqrtf(var + LN_EPS);
    for (int i = 0; i < D; ++i) {
      float y = (r[i] - mu) * rs * g[i] + b[i];
      dstf[n * D + i] = y;
      stf(&dstb[n * D + i], y);
      if (dst2) dst2[n * D + i] = y;
    }
  }
}

DEV void ph_inproj(const Params& p, int li, long long tid, long long nthr) {
  const float* W = p.w_in + (long long)li * D * N_IN;
  const float* bias = p.b_in + (long long)li * N_IN;
  FOR_IDX(idx, (long long)N_TOK * N_IN) {
    long long n = idx / N_IN; int c = (int)(idx % N_IN);
    stf(&p.u[idx], dotcol(p.xb + n * D, W + c, D, N_IN) + bias[c]);
  }
}

DEV float gelu_tanh(float x) {
  return 0.5f * x * (1.0f + tanhf(0.7978845608028654f * (x + 0.044715f * x * x * x)));
}

constexpr int CMP_ROWS = BATCH * N_CMP * NSA_G;

template <int PARTS>
DEV void ph_pre(const Params& p, int li, long long tid, long long nthr) {
  const long long T1 = (long long)N_TOK * B_K;
  const long long T2 = (PARTS & 2) ? 2LL * CMP_ROWS * CMP_HID : 0;
  FOR_IDX(idx, T1 + T2) {
    if (idx < T1) {
      if (!(PARTS & 1)) continue;
      long long n = idx / B_K; int c = (int)(idx % B_K);
      const float* W2 = p.w_alpha2 + (long long)li * GLA_RANK * B_K;
      float z = p.b_alpha[li * B_K + c];
      for (int r = 0; r < GLA_RANK; ++r) z += ldf(p.u[n * N_IN + OFF_LR + r]) * W2[r * B_K + c];
      float ls = fminf(z, 0.f) - log1pf(expf(-fabsf(z)));
      p.ga[idx] = expf(ls * (1.0f / 16.0f));
    } else {
      long long i2 = idx - T1;
      int which = (int)(i2 / ((long long)CMP_ROWS * CMP_HID));
      long long rem = i2 % ((long long)CMP_ROWS * CMP_HID);
      int row = (int)(rem / CMP_HID), j = (int)(rem % CMP_HID);
      int g = row % NSA_G; int c = (row / NSA_G) % N_CMP; int b = row / (NSA_G * N_CMP);
      const float* pe = (which ? p.cmp_pe_v : p.cmp_pe_k) + (long long)li * 32 * HD;
      const float* w1 = (which ? p.cmp_w1_v : p.cmp_w1_k) + (long long)li * 32 * HD * CMP_HID;
      int off = (which ? OFF_CVC : OFF_CKC) + g * HD;
      float s = 0.f;
      for (int l = 0; l < 32; ++l) {
        const act_t* ur = p.u + ((long long)b * SEQ + c * 16 + l) * N_IN + off;
        for (int d = 0; d < HD; ++d) s += (ldf(ur[d]) + pe[l * HD + d]) * w1[(long long)(l * HD + d) * CMP_HID + j];
      }
      p.hid[i2] = gelu_tanh(s);
    }
  }
}

template <int PARTS>
DEV void ph_mix1(const Params& p, int li, long long tid, long long nthr) {
  const long long T1 = (long long)N_TOK * 4;
  const long long T2 = (long long)BATCH * GLA_H * DV * 4;
  const long long T3 = 2LL * CMP_ROWS * HD;
  FOR_IDX(idx, T1 + T2 + T3) {
    if (idx < T1) {
      if (!(PARTS & 1)) continue;
      long long n = idx / 4; int h = (int)(idx % 4);
      int b = (int)(n / SEQ), t = (int)(n % SEQ);
      float m = -INFINITY, l = 0.f;
      float acc[HD];
#pragma unroll
      for (int d = 0; d < HD; ++d) acc[d] = 0.f;
      for (int gi = 0; gi < 3; ++gi) {
        const int dil = gi == 0 ? 1 : (gi == 1 ? 4 : 16);
        float q[HD];
        const act_t* qp = p.u + n * N_IN + OFF_AQ + gi * 256 + h * HD;
#pragma unroll
        for (int d = 0; d < HD; ++d) q[d] = ldf(qp[d]);
        for (int mm = 0; mm <= 128; ++mm) {
          int tk = t - mm * dil;
          if (tk < 0) break;
          const act_t* kp = p.u + ((long long)b * SEQ + tk) * N_IN + OFF_AK + gi * 256 + h * HD;
          const act_t* vp = p.u + ((long long)b * SEQ + tk) * N_IN + OFF_AV + gi * 256 + h * HD;
          float s = 0.f;
#pragma unroll
          for (int d = 0; d < HD; ++d) s += q[d] * ldf(kp[d]);
          s *= 0.125f;
          float mn = fmaxf(m, s);
          float corr = expf(m - mn);
          float pp = expf(s - mn);
          l = l * corr + pp;
#pragma unroll
          for (int d = 0; d < HD; ++d) acc[d] = acc[d] * corr + pp * ldf(vp[d]);
          m = mn;
        }
      }
      float inv = 1.0f / l;
#pragma unroll
      for (int d = 0; d < HD; ++d) stf(&p.ya[n * 256 + h * HD + d], acc[d] * inv);
    } else if (idx < T1 + T2) {
      if (!(PARTS & 2)) continue;
      long long i2 = idx - T1;
      int v = (int)(i2 % DV); int cq = (int)((i2 / DV) % 4); int h = (int)((i2 / (DV * 4)) % GLA_H);
      int b = (int)(i2 / (DV * 4 * GLA_H));
      constexpr int DKQ = DK / 4;
      float st[DKQ];
#pragma unroll
      for (int c = 0; c < DKQ; ++c) st[c] = 0.f;
      const float qs = 1.0f / sqrtf((float)DK);
      for (int t = 0; t < SEQ; ++t) {
        long long n = (long long)b * SEQ + t;
        const act_t* ur = p.u + n * N_IN;
        float vt = ldf(ur[OFF_BV + h * DV + v]);
        const float* gar = p.ga + n * B_K + h * DK + cq * DKQ;
        const act_t* kr = ur + OFF_BK + h * DK + cq * DKQ;
        const act_t* qr = ur + OFF_BQ + h * DK + cq * DKQ;
        float o = 0.f;
#pragma unroll
        for (int c = 0; c < DKQ; ++c) {
          st[c] = gar[c] * st[c] + ldf(kr[c]) * vt;
          o += ldf(qr[c]) * st[c];
        }
        p.opart[((long long)cq * N_TOK + n) * B_V + h * DV + v] = o * qs;
      }
    } else {
      long long i2 = idx - T1 - T2;
      int which = (int)(i2 / ((long long)CMP_ROWS * HD));
      long long rem = i2 % ((long long)CMP_ROWS * HD);
      int row = (int)(rem / HD), d = (int)(rem % HD);
      const float* w2 = (which ? p.cmp_w2_v : p.cmp_w2_k) + (long long)li * CMP_HID * HD;
      const float* hr = p.hid + ((long long)which * CMP_ROWS + row) * CMP_HID;
      float s = 0.f;
      if (!(PARTS & 4)) continue;
      for (int j = 0; j < CMP_HID; ++j) s += hr[j] * w2[j * HD + d];
      p.kcv[i2] = s;
#ifndef CPU_TEST
      {
        const int g_ = row % NSA_G, c_ = (row / NSA_G) % N_CMP, b_ = row / (NSA_G * N_CMP);
        stf(&p.kcb[((((size_t)which * BATCH + b_) * 128 + c_) * NSA_G + g_) * 64 + d], s);
      }
#endif
    }
  }
}

template <int PARTS>
DEV void ph_nsa1(const Params& p, int li, long long tid, long long nthr) {
  const long long T1 = (long long)N_TOK * GLA_H;
  const long long T2 = (PARTS & 2) ? (long long)N_TOK * NSA_H : 0;
  FOR_IDX(idx, T1 + T2) {
    if (idx < T1) {
      long long n = idx / GLA_H; int h = (int)(idx % GLA_H);
      float ss = 0.f;
      for (int v = 0; v < DV; ++v) {
        float o = 0.f;
        for (int cq = 0; cq < 4; ++cq) o += p.opart[((long long)cq * N_TOK + n) * B_V + h * DV + v];
        ss += o * o;
      }
      float rs = 1.0f / sqrtf(ss / DV + LN_EPS);
      for (int v = 0; v < DV; ++v) {
        float o = 0.f;
        for (int cq = 0; cq < 4; ++cq) o += p.opart[((long long)cq * N_TOK + n) * B_V + h * DV + v];
        float r = ldf(p.u[n * N_IN + OFF_BR + h * DV + v]);
        float y = o * rs * p.gla_norm_g[li * DV + v] * (r * sigmoidf_(r));
        stf(&p.yb[n * B_V + h * DV + v], y);
      }
    } else {
      long long i2 = idx - T1;
      long long n = i2 / NSA_H; int hh = (int)(i2 % NSA_H);
      int b = (int)(n / SEQ), t = (int)(n % SEQ);
      int g = hh / 4;
      int nv = t >= 31 ? (t - 31) / 16 + 1 : 0;
      if (nv > N_CMP) nv = N_CMP;
      float q[HD];
      const act_t* qp = p.u + n * N_IN + OFF_CQ + hh * HD;
#pragma unroll
      for (int d = 0; d < HD; ++d) q[d] = ldf(qp[d]);
      float* prow = p.pcmp + (((long long)b * NSA_H + hh) * SEQ + t) * 128;
      float m = -INFINITY;
      for (int c = 0; c < nv; ++c) {
        const float* kp = p.kcv + (((long long)b * N_CMP + c) * NSA_G + g) * HD;
        float s = 0.f;
#pragma unroll
        for (int d = 0; d < HD; ++d) s += q[d] * kp[d];
        s *= 0.125f;
        prow[c] = s;
        m = fmaxf(m, s);
      }
      float acc[HD];
#pragma unroll
      for (int d = 0; d < HD; ++d) acc[d] = 0.f;
      float l = 0.f;
      for (int c = 0; c < nv; ++c) {
        const float* vp = p.kcv + (((long long)CMP_ROWS) + ((long long)b * N_CMP + c) * NSA_G + g) * HD;
        float pp = expf(prow[c] - m);
        l += pp;
        prow[c] = pp;
#pragma unroll
        for (int d = 0; d < HD; ++d) acc[d] += pp * vp[d];
      }
      float inv = 1.0f / fmaxf(l, 1e-30f);
      for (int c = 0; c < 128; ++c) prow[c] = c < nv ? prow[c] * inv : 0.f;
#pragma unroll
      for (int d = 0; d < HD; ++d) p.ocmp[n * 1024 + hh * HD + d] = acc[d] * inv;
    }
  }
}

DEV void ph_nsa2(const Params& p, int li, long long tid, long long nthr) {
  FOR_IDX(idx, (long long)BATCH * NSA_G * SEQ * N_BLK) {
    int j = (int)(idx % N_BLK); long long r = idx / N_BLK;
    int s = (int)(r % SEQ); int g = (int)((r / SEQ) % NSA_G); int b = (int)(r / ((long long)SEQ * NSA_G));
    int qb = s / 64;
    float imp;
    if (j == 0 || j == qb || j == qb - 1) imp = INFINITY;
    else if (j > qb) imp = -INFINITY;
    else {
      imp = 0.f;
      int c0 = 4 * j - 1; if (c0 < 0) c0 = 0;
      int c1 = 4 * j + 3; if (c1 > N_CMP - 1) c1 = N_CMP - 1;
      for (int rr = 0; rr < 4; ++rr) {
        const float* prow = p.pcmp + (((long long)b * NSA_H + g * 4 + rr) * SEQ + s) * 128;
        for (int c = c0; c <= c1; ++c) imp += prow[c];
      }
    }
    p.impb[idx] = imp;
  }
}

DEV void ph_nsa3(const Params& p, int li, long long tid, long long nthr) {
  FOR_IDX(idx, (long long)BATCH * NSA_G * SEQ * N_BLK) {
    int j = (int)(idx % N_BLK); long long r = idx / N_BLK;
    const float* ir = p.impb + r * N_BLK;
    float v = ir[j];
    int rank = 0;
    for (int jj = 0; jj < N_BLK; ++jj) {
      float w = ir[jj];
      if (w > v || (w == v && jj < j)) ++rank;
    }
    p.selb[idx] = rank < N_SELECT ? 1 : 0;
  }
}

DEV void ph_nsa4(const Params& p, int li, long long tid, long long nthr) {
  FOR_IDX(idx, (long long)N_TOK * NSA_H) {
    long long n = idx / NSA_H; int hh = (int)(idx % NSA_H);
    int b = (int)(n / SEQ), t = (int)(n % SEQ);
    int g = hh / 4;
    float q[HD];
    const act_t* qp = p.u + n * N_IN + OFF_CQ + hh * HD;
#pragma unroll
    for (int d = 0; d < HD; ++d) q[d] = ldf(qp[d]);
    float g0 = sigmoidf_(ldf(p.u[n * N_IN + OFF_CG + hh * 3 + 0]));
    float g1 = sigmoidf_(ldf(p.u[n * N_IN + OFF_CG + hh * 3 + 1]));
    float g2 = sigmoidf_(ldf(p.u[n * N_IN + OFF_CG + hh * 3 + 2]));
    float acc[HD];
    {
      float m = -INFINITY, l = 0.f;
#pragma unroll
      for (int d = 0; d < HD; ++d) acc[d] = 0.f;
      int qb = t / 64;
      const int* sr = p.selb + (((long long)b * NSA_G + g) * SEQ + t) * N_BLK;
      for (int j = 0; j <= qb; ++j) {
        if (!sr[j]) continue;
        int hi = j * 64 + 63; if (hi > t) hi = t;
        for (int tk = j * 64; tk <= hi; ++tk) {
          const act_t* kp = p.u + ((long long)b * SEQ + tk) * N_IN + OFF_CKS + g * HD;
          const act_t* vp = p.u + ((long long)b * SEQ + tk) * N_IN + OFF_CVS + g * HD;
          float s = 0.f;
#pragma unroll
          for (int d = 0; d < HD; ++d) s += q[d] * ldf(kp[d]);
          s *= 0.125f;
          float mn = fmaxf(m, s);
          float corr = expf(m - mn);
          float pp = expf(s - mn);
          l = l * corr + pp;
#pragma unroll
          for (int d = 0; d < HD; ++d) acc[d] = acc[d] * corr + pp * ldf(vp[d]);
          m = mn;
        }
      }
      float inv = 1.0f / l;
#pragma unroll
      for (int d = 0; d < HD; ++d) {
        float* oc = &p.ocmp[n * 1024 + hh * HD + d];
        *oc = g0 * (*oc) + g1 * acc[d] * inv;
      }
    }
    {
      float m = -INFINITY, l = 0.f;
#pragma unroll
      for (int d = 0; d < HD; ++d) acc[d] = 0.f;
      int lo = t - (NSA_WIN - 1); if (lo < 0) lo = 0;
      for (int tk = lo; tk <= t; ++tk) {
        const act_t* kp = p.u + ((long long)b * SEQ + tk) * N_IN + OFF_CKW + g * HD;
        const act_t* vp = p.u + ((long long)b * SEQ + tk) * N_IN + OFF_CVW + g * HD;
        float s = 0.f;
#pragma unroll
        for (int d = 0; d < HD; ++d) s += q[d] * ldf(kp[d]);
        s *= 0.125f;
        float mn = fmaxf(m, s);
        float corr = expf(m - mn);
        float pp = expf(s - mn);
        l = l * corr + pp;
#pragma unroll
        for (int d = 0; d < HD; ++d) acc[d] = acc[d] * corr + pp * ldf(vp[d]);
        m = mn;
      }
      float inv = 1.0f / l;
#pragma unroll
      for (int d = 0; d < HD; ++d)
        stf(&p.yc[n * 1024 + hh * HD + d], p.ocmp[n * 1024 + hh * HD + d] + g2 * acc[d] * inv);
    }
  }
}

DEV void ph_br(const Params& p, int li, long long tid, long long nthr) {
  const float* Wa = p.w_br_a + (long long)li * 256 * D;
  const float* Wb = p.w_br_b + (long long)li * B_V * D;
  const float* Wc = p.w_br_c + (long long)li * 1024 * D;
  FOR_IDX(idx, (long long)N_TOK * D) {
    long long n = idx / D; int d = (int)(idx % D);
    float s0 = dotcol(p.ya + n * 256, Wa + d, 256, D);
    float s1 = dotcol(p.yb + n * B_V, Wb + d, B_V, D);
    float s2 = dotcol(p.yc + n * 1024, Wc + d, 1024, D);
    const act_t* mg = p.u + n * N_IN + OFF_MG;
    float y = sigmoidf_(ldf(mg[d])) * s0 + sigmoidf_(ldf(mg[D + d])) * s1 + sigmoidf_(ldf(mg[2 * D + d])) * s2;
    stf(&p.merged[idx], y);
  }
}

DEV void ph_proj_res(const Params& p, const act_t* a, const float* W, long long tid, long long nthr) {
  FOR_IDX(idx, (long long)N_TOK * D) {
    long long n = idx / D; int d = (int)(idx % D);
    p.tmp[idx] = ALPHA * p.xf[idx] + dotcol(a + n * D, W + d, D, D);
  }
}

DEV void ph_xq(const Params& p, int li, long long tid, long long nthr) {
  const long long T1 = (long long)N_TOK * D;
  const long long T2 = 2LL * BATCH * MEM_LEN * D;
  const float* Wq = p.w_xq + (long long)li * D * D;
  FOR_IDX(idx, T1 + T2) {
    if (idx < T1) {
      long long n = idx / D; int d = (int)(idx % D);
      stf(&p.xq[idx], dotcol(p.xb + n * D, Wq + d, D, D));
    } else {
      long long i2 = idx - T1;
      int which = (int)(i2 / ((long long)BATCH * MEM_LEN * D));
      long long rem = i2 % ((long long)BATCH * MEM_LEN * D);
      long long r = rem / D; int d = (int)(rem % D);
      const float* W = (which ? p.w_xv : p.w_xk) + (long long)li * D * D;
      float s = dotcol(p.mem + r * D, W + d, D, D);
      stf(which ? &p.memv[rem] : &p.memk[rem], s);
    }
  }
}

DEV void ph_xs(const Params& p, int li, long long tid, long long nthr) {
  const float sc = 1.0f / sqrtf((float)XHD);
  FOR_IDX(idx, (long long)N_TOK * XH * MEM_LEN) {
    int m = (int)(idx % MEM_LEN); int h = (int)((idx / MEM_LEN) % XH); long long n = idx / (MEM_LEN * XH);
    int b = (int)(n / SEQ);
    const act_t* q = p.xq + n * D + h * XHD;
    const act_t* k = p.memk + ((long long)b * MEM_LEN + m) * D + h * XHD;
    float s = 0.f;
    for (int d = 0; d < XHD; ++d) s += ldf(q[d]) * ldf(k[d]);
    p.xs[idx] = s * sc;
  }
}

DEV void ph_xo(const Params& p, int li, long long tid, long long nthr) {
  FOR_IDX(idx, (long long)N_TOK * D) {
    long long n = idx / D; int c = (int)(idx % D);
    int h = c / XHD; int b = (int)(n / SEQ);
    const float* sr = p.xs + (n * XH + h) * MEM_LEN;
    float m = -INFINITY;
    for (int mm = 0; mm < MEM_LEN; ++mm) m = fmaxf(m, sr[mm]);
    float l = 0.f, o = 0.f;
    for (int mm = 0; mm < MEM_LEN; ++mm) {
      float pp = expf(sr[mm] - m);
      l += pp;
      o += pp * ldf(p.memv[((long long)b * MEM_LEN + mm) * D + c]);
    }
    stf(&p.xo[idx], o / l);
  }
}

DEV void ph_rlogit(const Params& p, int li, long long tid, long long nthr) {
  const float* W = p.w_router + (long long)li * D * NE;
  FOR_IDX(idx, (long long)N_TOK * NE) {
    long long n = idx / NE; int e = (int)(idx % NE);
    p.rl[idx] = dotcol(p.xf + n * D, W + e, D, NE) + p.b_router[li * NE + e];
  }
}

DEV void ph_route(const Params& p, int li, long long tid, long long nthr) {
  FOR_IDX(n, N_TOK) {
    const float* r = p.rl + n * NE;
    int i0 = -1, i1 = -1, i2 = -1, i3 = -1;
    float v0 = 0, v1 = 0, v2 = 0, v3 = 0;
    for (int k = 0; k < 4; ++k) {
      int bi = -1; float bv = -INFINITY;
      for (int e = 0; e < NE; ++e) {
        if (e == i0 || e == i1 || e == i2) continue;
        float v = r[e];
        if (bi < 0 || v > bv) { bi = e; bv = v; }
      }
      if (k == 0) { i0 = bi; v0 = bv; } else if (k == 1) { i1 = bi; v1 = bv; }
      else if (k == 2) { i2 = bi; v2 = bv; } else { i3 = bi; v3 = bv; }
    }
    float e0 = 1.0f, e1 = expf(v1 - v0), e2 = expf(v2 - v0), e3 = expf(v3 - v0);
    float inv = 1.0f / (e0 + e1 + e2 + e3);
#ifndef CPU_TEST
    p.rank[n * 4 + 0] = atomicAdd(&p.cnt[li * 32 + i0], 1);
    p.rank[n * 4 + 1] = atomicAdd(&p.cnt[li * 32 + i1], 1);
    p.rank[n * 4 + 2] = atomicAdd(&p.cnt[li * 32 + i2], 1);
    p.rank[n * 4 + 3] = atomicAdd(&p.cnt[li * 32 + i3], 1);
#endif
    p.topi[n * 4 + 0] = i0; p.topi[n * 4 + 1] = i1; p.topi[n * 4 + 2] = i2; p.topi[n * 4 + 3] = i3;
    p.topg[n * 4 + 0] = e0 * inv; p.topg[n * 4 + 1] = e1 * inv; p.topg[n * 4 + 2] = e2 * inv; p.topg[n * 4 + 3] = e3 * inv;
  }
}

DEV void ph_moe1(const Params& p, int li, long long tid, long long nthr) {
  FOR_IDX(idx, (long long)N_TOK * TOPK * DFF) {
    int j = (int)(idx % DFF); long long a = idx / DFF; long long n = a / TOPK;
    int e = p.topi[a];
    const float* W = p.w_gu + ((long long)li * NE + e) * D * 2 * DFF;
    const float* bb = p.b_gu + ((long long)li * NE + e) * 2 * DFF;
    float gt = dotcol(p.xb + n * D, W + j, D, 2 * DFF) + bb[j];
    float up = dotcol(p.xb + n * D, W + DFF + j, D, 2 * DFF) + bb[DFF + j];
    gt = fminf(gt, 7.0f);
    up = fminf(fmaxf(up, -7.0f), 7.0f);
    stf(&p.act[idx], (up + 1.0f) * gt * sigmoidf_(1.702f * gt));
  }
}

DEV void ph_moe2(const Params& p, int li, long long tid, long long nthr) {
  FOR_IDX(idx, (long long)N_TOK * D) {
    long long n = idx / D; int d = (int)(idx % D);
    float y = 0.f;
    for (int k = 0; k < TOPK; ++k) {
      int e = p.topi[n * 4 + k];
      const float* W = p.w_down + ((long long)li * NE + e) * DFF * D;
      float s = dotcol(p.act + (n * 4 + k) * DFF, W + d, DFF, D) + p.b_down[((long long)li * NE + e) * D + d];
      y += p.topg[n * 4 + k] * s;
    }
    p.tmp[idx] = ALPHA * p.xf[idx] + y;
  }
}

constexpr int PH_PER_LAYER = 20;
constexpr int N_PHASES = 1 + DEPTH * PH_PER_LAYER;

template <int K>
DEV void run_phase_k(const Params& p, int li, long long tid, long long nthr) {
  if constexpr (K == -1) ph_ln(p.x, p.ln0_g, p.ln0_b, p.xf, p.xb, nullptr, tid, nthr);
  if constexpr (K == 0) ph_inproj(p, li, tid, nthr);
  if constexpr (K == 1) ph_pre<3>(p, li, tid, nthr);
  if constexpr (K == 20) ph_pre<1>(p, li, tid, nthr);
  if constexpr (K == 2) ph_mix1<7>(p, li, tid, nthr);
  if constexpr (K == 21) ph_mix1<4>(p, li, tid, nthr);
  if constexpr (K == 3) ph_nsa1<3>(p, li, tid, nthr);
  if constexpr (K == 22) ph_nsa1<1>(p, li, tid, nthr);
  if constexpr (K == 4) ph_nsa2(p, li, tid, nthr);
  if constexpr (K == 5) ph_nsa3(p, li, tid, nthr);
  if constexpr (K == 6) ph_nsa4(p, li, tid, nthr);
  if constexpr (K == 7) ph_br(p, li, tid, nthr);
  if constexpr (K == 8) ph_proj_res(p, p.merged, p.w_o_mix + (long long)li * D * D, tid, nthr);
  if constexpr (K == 9) ph_ln(p.tmp, p.ln1_g + li * D, p.ln1_b + li * D, p.xf, p.xb, nullptr, tid, nthr);
  if constexpr (K == 10) ph_xq(p, li, tid, nthr);
  if constexpr (K == 11) ph_xs(p, li, tid, nthr);
  if constexpr (K == 12) ph_xo(p, li, tid, nthr);
  if constexpr (K == 13) ph_proj_res(p, p.xo, p.w_xo + (long long)li * D * D, tid, nthr);
  if constexpr (K == 14) ph_ln(p.tmp, p.ln2_g + li * D, p.ln2_b + li * D, p.xf, p.xb, nullptr, tid, nthr);
  if constexpr (K == 15) ph_rlogit(p, li, tid, nthr);
  if constexpr (K == 16) ph_route(p, li, tid, nthr);
  if constexpr (K == 17) ph_moe1(p, li, tid, nthr);
  if constexpr (K == 18) ph_moe2(p, li, tid, nthr);
  if constexpr (K == 19) ph_ln(p.tmp, p.ln3_g + li * D, p.ln3_b + li * D, p.xf, p.xb, li == DEPTH - 1 ? p.out : nullptr, tid, nthr);
}

DEV void run_phase(const Params& p, int ph, long long tid, long long nthr) {
  if (ph == 0) { run_phase_k<-1>(p, 0, tid, nthr); return; }
  int li = (ph - 1) / PH_PER_LAYER, k = (ph - 1) % PH_PER_LAYER;
  switch (k) {
#define PHC(K) case K: run_phase_k<K>(p, li, tid, nthr); break;
    PHC(0) PHC(1) PHC(2) PHC(3) PHC(4) PHC(5) PHC(6) PHC(7) PHC(8) PHC(9)
    PHC(10) PHC(11) PHC(12) PHC(13) PHC(14) PHC(15) PHC(16) PHC(17) PHC(18) PHC(19)
#undef PHC
  }
}

#ifdef CPU_TEST
#define HDI_M
#else
#define HDI_M __host__ __device__ __forceinline__
#endif
struct Carver {
  char* base; size_t off;
  template <class T> HDI_M T* take(size_t n) {
    T* r = (T*)(base + off);
    off += (n * sizeof(T) + 255) & ~(size_t)255;
    return r;
  }
};

HDI void fill_params(Params& p, void* const* d_in, void* d_out, void* d_ws) {
  const float* const* in = (const float* const*)d_in;
  p.x = in[0]; p.mem = in[1]; p.ln0_g = in[2]; p.ln0_b = in[3]; p.w_in = in[4]; p.b_in = in[5];
  p.w_alpha2 = in[6]; p.b_alpha = in[7]; p.gla_norm_g = in[8];
  p.cmp_pe_k = in[9]; p.cmp_w1_k = in[10]; p.cmp_w2_k = in[11]; p.cmp_pe_v = in[12]; p.cmp_w1_v = in[13]; p.cmp_w2_v = in[14];
  p.w_br_a = in[15]; p.w_br_b = in[16]; p.w_br_c = in[17]; p.w_o_mix = in[18]; p.ln1_g = in[19]; p.ln1_b = in[20];
  p.w_xq = in[21]; p.w_xk = in[22]; p.w_xv = in[23]; p.w_xo = in[24]; p.ln2_g = in[25]; p.ln2_b = in[26];
  p.w_router = in[27]; p.b_router = in[28]; p.w_gu = in[29]; p.b_gu = in[30]; p.w_down = in[31]; p.b_down = in[32];
  p.ln3_g = in[33]; p.ln3_b = in[34];
  p.out = (float*)d_out;
  Carver c{(char*)d_ws, 0};
  p.barw = c.take<unsigned>(4096);
  p.xf = c.take<float>((size_t)N_TOK * D);
  p.xb = c.take<act_t>((size_t)N_TOK * D);
  p.u = c.take<act_t>((size_t)N_TOK * N_IN);
  p.ga = c.take<float>((size_t)N_TOK * B_K);
  p.hid = c.take<float>((size_t)2 * CMP_ROWS * CMP_HID);
  p.kcv = c.take<float>((size_t)2 * CMP_ROWS * HD);
  p.opart = c.take<float>((size_t)4 * N_TOK * B_V);
  p.yass = p.opart;
#ifdef CPU_TEST
  p.ya = c.take<act_t>((size_t)N_TOK * 256);
  p.yb = c.take<act_t>((size_t)N_TOK * B_V);
  p.yc = c.take<act_t>((size_t)N_TOK * 1024);
#else
  p.ya = c.take<act_t>((size_t)N_TOK * YLD);
  p.yb = p.ya + 256;
  p.yc = p.ya + 1280;
#endif
  p.pcmp = c.take<float>((size_t)MOE_ROWS * 1024 / 2 > (size_t)BATCH * NSA_H * SEQ * 128 ? (size_t)MOE_ROWS * 1024 / 2 : (size_t)BATCH * NSA_H * SEQ * 128);
  p.xg = (act_t*)p.pcmp;
  p.ocmp = c.take<float>((size_t)N_TOK * 1024);
  p.impb = c.take<float>((size_t)BATCH * NSA_G * SEQ * N_BLK);
  p.selb = c.take<int>((size_t)BATCH * NSA_G * SEQ * N_BLK);
  p.merged = c.take<act_t>((size_t)N_TOK * D);
  p.tmp = c.take<float>((size_t)N_TOK * D);
  p.xq = c.take<act_t>((size_t)N_TOK * D);
  p.memk = c.take<act_t>((size_t)BATCH * MEM_LEN * D);
  p.memv = c.take<act_t>((size_t)BATCH * MEM_LEN * D);
  p.xs = c.take<float>((size_t)N_TOK * XH * MEM_LEN);
  p.mrg = p.xs;
  p.xo = c.take<act_t>((size_t)N_TOK * D);
  p.rl = c.take<float>((size_t)N_TOK * NE);
  p.topi = c.take<int>((size_t)N_TOK * TOPK);
  p.topg = c.take<float>((size_t)N_TOK * TOPK);
  p.actg = c.take<act_t>((size_t)MOE_ROWS * 1024);
  p.act = p.actg;
  p.wt_in = c.take<act_t>((size_t)2 * N_IN_PAD * 1024);
  p.wt_c1 = c.take<act_t>((size_t)2 * 2 * 256 * 2048);
  p.wt_bra = c.take<act_t>((size_t)2 * 1024 * YLD);
  p.wt_brb = p.wt_bra + 256;
  p.wt_brc = p.wt_bra + 1280;
  p.wt_omix = c.take<act_t>((size_t)2 * 1024 * 1024);
  p.wt_xq = c.take<act_t>((size_t)2 * 1024 * 1024);
  p.wt_xk = c.take<act_t>((size_t)2 * 1024 * 1024);
  p.wt_xv = c.take<act_t>((size_t)2 * 1024 * 1024);
  p.wt_xo = c.take<act_t>((size_t)2 * 1024 * 1024);
  p.wt_gu = c.take<act_t>((size_t)2 * 32 * 2048 * 1024);
  p.wt_dn = c.take<act_t>((size_t)2 * 32 * 1024 * 1024);
  p.membf = c.take<act_t>((size_t)BATCH * MEM_LEN * 1024);
  p.cmpA = c.take<act_t>((size_t)2 * CMP_ROWS_PAD * 2048);
  p.cnt = c.take<int>(64);
  p.rank = c.take<int>((size_t)N_TOK * 4);
  p.rowlist = c.take<int>((size_t)MOE_ROWS);
  p.kcb = c.take<act_t>((size_t)2 * BATCH * 128 * NSA_G * 64);
  p.dilo = c.take<act_t>((size_t)3 * N_TOK * 256);
  p.dill = c.take<float>((size_t)3 * N_TOK * 4);
  p.selm = c.take<unsigned>((size_t)BATCH * NSA_G * SEQ);
  p.gU = p.xg; p.gQ = p.xg + (size_t)1024 * 128 * 256; p.gS = p.actg; p.gD = p.opart + (size_t)N_TOK * 1024;
  p.ws_used = c.off;
}

#ifndef CPU_TEST
#ifndef NSA_PROBE
#define NSA_PROBE 0
#endif
static_assert(D == 1024 && BATCH == 8, "optimized path is written for the graded shapes");
namespace pg8 {
#define PG8_LAS __attribute__((address_space(3)))
typedef unsigned short bf16_t;
typedef short bf16x8 __attribute__((ext_vector_type(8)));
typedef float f32x4 __attribute__((ext_vector_type(4)));
typedef unsigned u32x4 __attribute__((ext_vector_type(4)));
constexpr int BM = 256, BK = 64, HALF = 128, HTB = HALF * BK * 2  , STAGE_BYTES = 8 * HTB, NXCD = 8, WGM = 8;

__host__ __device__ __forceinline__ int lds_byte(int r, int c) { const int st = (r >> 4) * 2 + (c >> 5), rr = r & 15, cc = c & 31, ob = rr * 64 + cc * 2; return st * 1024 + (ob ^ (((ob >> 9) & 1) << 5)); }
__host__ __device__ __forceinline__ void stage_rc(int b, int& R, int& C) { const int st = b / 1024, sb = b % 1024, swz = sb ^ (((sb >> 9) & 1) << 5); R = (st >> 1) * 16 + swz / 64; C = (st & 1) * 32 + (swz % 64) / 2; }
__host__ __device__ __forceinline__ int perm32(int rho) { const int n = rho >> 4, i = rho & 15; return 8 * (i >> 2) + 4 * n + (i & 3); }

struct Unit { int pm, pn; };
struct Gemm { const bf16_t* A; const bf16_t* Bt; int M, N, K; };

struct StaticOrder {
    int nM, nN, nwg, G, c;
    __host__ __device__ void init(int M, int N, int G_, int c_) { nM = M / BM; nN = N / BM; nwg = nM * nN; G = G_; c = c_; }
    __host__ __device__ bool next(int i, Unit& u) const {
        const long L = (long)i * G + c; if (L >= nwg) return false;
        int wgid = (int)L; { const int q = nwg / NXCD, r = nwg % NXCD, xcd = wgid % NXCD, off = wgid / NXCD; wgid = (xcd < r ? xcd * (q + 1) : r * (q + 1) + (xcd - r) * q) + off; }
        const int nig = WGM * nN, gid = wgid / nig, fm = gid * WGM, gsz = (nM - fm) < WGM ? (nM - fm) : WGM;
        u.pm = fm + ((wgid % nig) % gsz); u.pn = (wgid % nig) / gsz; return true;
    }
    __device__ __forceinline__ void a_ready(const Unit&) const {}
    __device__ __forceinline__ void done(const Unit&) const {}
};

__device__ __forceinline__ unsigned cvt_pk_bf16(float lo, float hi) { unsigned r; asm volatile("v_cvt_pk_bf16_f32 %0, %1, %2" : "=v"(r) : "v"(lo), "v"(hi)); return r; }

template <class Epi, class Sched, bool ALIGN_EPI = false, bool SP2 = false>
__device__ __forceinline__ void gemm_phase(PG8_LAS unsigned char* lds, const Gemm g, const Sched& S, const Epi& E, const int tid) {
    const int wid = __builtin_amdgcn_readfirstlane(tid >> 6), lane = tid & 63, wr = wid >> 2, wc = wid & 3, fr = lane & 15, fq = lane >> 4;
    const int K = g.K, nt = K / BK;
    unsigned voffA[2], voffB[2];
#pragma unroll
    for (int i = 0; i < 2; ++i) { int R, C; stage_rc(tid * 16 + i * 8192, R, C); const int Rb = Epi::PERM ? ((R & ~31) + perm32(R & 31)) : R;
        voffA[i] = (unsigned)(R * K + C) * 2u; voffB[i] = (unsigned)(Rb * K + C) * 2u; }
    const size_t kstep = (size_t)(BK * 2);
    const size_t hstep = (size_t)HALF * K * 2;
    const size_t tstep = 2 * hstep;
    const unsigned ldsw = (unsigned)wid * 1024u;
    const int aoff = lds_byte(wr * 64 + fr, fq * 8), boff = lds_byte(wc * 32 + fr, fq * 8);
#define PG8_SA(b, h) (((b) * 2 + (h)) * HTB)
#define PG8_SB(b, h) ((4 + (b) * 2 + (h)) * HTB)
#define PG8_STAGE(bufoff, gbase, voff) do { _Pragma("unroll") for (int _i = 0; _i < 2; ++_i) \
        __builtin_amdgcn_global_load_lds((const unsigned*)((const char*)(gbase) + (voff)[_i]), (PG8_LAS unsigned*)(lds + (bufoff) + ldsw + _i * 8192), 16, 0, 0); } while (0)
#define PG8_LDA(dst, b, h) do { _Pragma("unroll") for (int m = 0; m < 4; ++m) _Pragma("unroll") for (int k = 0; k < 2; ++k) dst[m][k] = *(const PG8_LAS bf16x8*)(lds + PG8_SA(b, h) + aoff + m * 2048 + k * 1024); } while (0)
#define PG8_LDB(dst, b, h) do { _Pragma("unroll") for (int n = 0; n < 2; ++n) _Pragma("unroll") for (int k = 0; k < 2; ++k) dst[n][k] = *(const PG8_LAS bf16x8*)(lds + PG8_SB(b, h) + boff + n * 2048 + k * 1024); } while (0)
#define PG8_MMA(ai, bj, At, Bt) do { __builtin_amdgcn_s_setprio(1); _Pragma("unroll") for (int m = 0; m < 4; ++m) _Pragma("unroll") for (int n = 0; n < 2; ++n) _Pragma("unroll") for (int k = 0; k < 2; ++k) \
        acc[ai][bj][m][n] = __builtin_amdgcn_mfma_f32_16x16x32_bf16(Bt[n][k], At[m][k], acc[ai][bj][m][n], 0, 0, 0); __builtin_amdgcn_s_setprio(0); } while (0)
#define PG8_WAIT_V(n) asm volatile("s_waitcnt vmcnt(" #n ")" ::: "memory")
#define PG8_WAIT_L(n) asm volatile("s_waitcnt lgkmcnt(" #n ")" ::: "memory")
#define PG8_BAR __builtin_amdgcn_s_barrier()
#define PG8_SCHED __builtin_amdgcn_sched_barrier(0)
    Unit cur, nxt; int ui = 0;
    if (!S.next(0, cur)) return;
    f32x4 acc[2][2][4][2];
#pragma unroll
    for (int a = 0; a < 2; ++a)
#pragma unroll
        for (int b = 0; b < 2; ++b)
#pragma unroll
            for (int m = 0; m < 4; ++m)
#pragma unroll
                for (int n = 0; n < 2; ++n) acc[a][b][m][n] = (f32x4){0.f, 0.f, 0.f, 0.f};
    bf16x8 At[4][2], B0[2][2], B1[2][2];
    const char* cA = (const char*)g.A + (size_t)cur.pm * tstep; const char* cB = (const char*)g.Bt + (size_t)cur.pn * tstep;
    S.a_ready(cur);
    if constexpr (SP2) {
        PG8_STAGE(PG8_SB(0, 0), cB, voffB); PG8_STAGE(PG8_SB(0, 1), cB + hstep, voffB); PG8_STAGE(PG8_SA(0, 0), cA, voffA); PG8_STAGE(PG8_SA(0, 1), cA + hstep, voffA);
        if (wr == 1) PG8_BAR;
        PG8_WAIT_V(2); PG8_BAR;
        PG8_STAGE(PG8_SB(1, 0), cB + kstep, voffB); PG8_STAGE(PG8_SA(1, 0), cA + kstep, voffA); PG8_STAGE(PG8_SB(1, 1), cB + hstep + kstep, voffB);
        PG8_WAIT_V(6); PG8_BAR;
    } else {
        PG8_STAGE(PG8_SB(0, 0), cB, voffB); PG8_STAGE(PG8_SA(0, 0), cA, voffA); PG8_STAGE(PG8_SB(0, 1), cB + hstep, voffB); PG8_STAGE(PG8_SA(0, 1), cA + hstep, voffA);
        if (wr == 1) PG8_BAR;
        PG8_WAIT_V(4); PG8_BAR;
        PG8_STAGE(PG8_SB(1, 0), cB + kstep, voffB); PG8_STAGE(PG8_SA(1, 0), cA + kstep, voffA); PG8_STAGE(PG8_SB(1, 1), cB + hstep + kstep, voffB);
        PG8_WAIT_V(6); PG8_BAR;
    }
    for (;;) {
        const bool has_next = S.next(ui + 1, nxt);
        const char* nA = has_next ? (const char*)g.A + (size_t)nxt.pm * tstep : cA; const char* nB = has_next ? (const char*)g.Bt + (size_t)nxt.pn * tstep : cB;
        for (int t = 0; t < nt; t += 2) {
            const bool last = (t == nt - 2);
            const char* a1 = cA + (size_t)(t + 1) * kstep;
            const char* a2 = last ? nA : cA + (size_t)(t + 2) * kstep; const char* b2 = last ? nB : cB + (size_t)(t + 2) * kstep;
            const char* a3 = a2 + kstep; const char* b3 = b2 + kstep;
            if (last && has_next) S.a_ready(nxt);
            E.mid(acc, cur, wr, wc, t);
            if constexpr (SP2) {
            PG8_LDB(B0, 0, 0); PG8_LDB(B1, 0, 1); PG8_SCHED; PG8_LDA(At, 0, 0); PG8_STAGE(PG8_SA(1, 1), a1 + hstep, voffA);
            PG8_WAIT_V(8); PG8_WAIT_L(0); PG8_BAR; PG8_MMA(0, 0, At, B0); PG8_MMA(0, 1, At, B1); PG8_BAR; PG8_SCHED;
            PG8_LDA(At, 0, 1); PG8_STAGE(PG8_SB(0, 0), b2, voffB); PG8_STAGE(PG8_SB(0, 1), b2 + hstep, voffB); PG8_STAGE(PG8_SA(0, 0), a2, voffA);
            PG8_WAIT_V(8); PG8_WAIT_L(0); PG8_BAR; PG8_MMA(1, 0, At, B0); PG8_MMA(1, 1, At, B1); PG8_BAR; PG8_SCHED;
            PG8_LDB(B0, 1, 0); PG8_LDB(B1, 1, 1); PG8_SCHED; PG8_LDA(At, 1, 0); PG8_STAGE(PG8_SA(0, 1), a2 + hstep, voffA);
            PG8_WAIT_V(8); PG8_WAIT_L(0); PG8_BAR; PG8_MMA(0, 0, At, B0); PG8_MMA(0, 1, At, B1); PG8_BAR; PG8_SCHED;
            PG8_LDA(At, 1, 1); PG8_STAGE(PG8_SB(1, 0), b3, voffB); PG8_STAGE(PG8_SB(1, 1), b3 + hstep, voffB); PG8_STAGE(PG8_SA(1, 0), a3, voffA);
            PG8_WAIT_V(8); PG8_WAIT_L(0); PG8_BAR; PG8_MMA(1, 0, At, B0); PG8_MMA(1, 1, At, B1); PG8_BAR; PG8_SCHED;
            } else {
            PG8_LDB(B0, 0, 0); PG8_SCHED; PG8_LDA(At, 0, 0); PG8_STAGE(PG8_SA(1, 1), a1 + hstep, voffA);
            PG8_WAIT_L(8); PG8_BAR; PG8_WAIT_L(0); PG8_MMA(0, 0, At, B0); PG8_BAR; PG8_SCHED;
            PG8_LDB(B1, 0, 1); PG8_STAGE(PG8_SB(0, 0), b2, voffB);
            PG8_BAR; PG8_WAIT_L(0); PG8_MMA(0, 1, At, B1); PG8_BAR;
            PG8_LDA(At, 0, 1); PG8_STAGE(PG8_SA(0, 0), a2, voffA);
            PG8_BAR; PG8_WAIT_L(0); PG8_MMA(1, 0, At, B0); PG8_BAR; PG8_SCHED;
            PG8_STAGE(PG8_SB(0, 1), b2 + hstep, voffB);
            PG8_WAIT_V(6); PG8_BAR; PG8_MMA(1, 1, At, B1); PG8_BAR;
            PG8_LDB(B0, 1, 0); PG8_SCHED; PG8_LDA(At, 1, 0); PG8_STAGE(PG8_SA(0, 1), a2 + hstep, voffA);
            PG8_WAIT_L(8); PG8_BAR; PG8_WAIT_L(0); PG8_MMA(0, 0, At, B0); PG8_BAR; PG8_SCHED;
            PG8_LDB(B1, 1, 1); PG8_STAGE(PG8_SB(1, 0), b3, voffB);
            PG8_BAR; PG8_WAIT_L(0); PG8_MMA(0, 1, At, B1); PG8_BAR;
            PG8_LDA(At, 1, 1); PG8_STAGE(PG8_SA(1, 0), a3, voffA);
            PG8_BAR; PG8_WAIT_L(0); PG8_MMA(1, 0, At, B0); PG8_BAR; PG8_SCHED;
            PG8_STAGE(PG8_SB(1, 1), b3 + hstep, voffB);
            PG8_WAIT_V(6); PG8_BAR; PG8_MMA(1, 1, At, B1); PG8_BAR;
            }
        }
        if constexpr (ALIGN_EPI) { if (wr == 0) PG8_BAR; }
        if constexpr (!Epi::AFTER_DRAIN) { E(acc, cur, wr, wc, fr, fq); S.done(cur); }
        if (!has_next) break;
#pragma unroll
        for (int a = 0; a < 2; ++a)
#pragma unroll
            for (int b = 0; b < 2; ++b)
#pragma unroll
                for (int m = 0; m < 4; ++m)
#pragma unroll
                    for (int n = 0; n < 2; ++n) acc[a][b][m][n] = (f32x4){0.f, 0.f, 0.f, 0.f};
        cur = nxt; cA = nA; cB = nB; ++ui;
        if constexpr (ALIGN_EPI) { if (wr == 1) PG8_BAR; }
    }
    PG8_WAIT_V(0);
    if constexpr (!ALIGN_EPI) { if (wr == 0) PG8_BAR; }
    PG8_BAR;
    if constexpr (Epi::AFTER_DRAIN) { E.fused(acc, cur, wr, wc, fr, fq, lds, wid, lane); S.done(cur); }
#undef PG8_SA
#undef PG8_SB
#undef PG8_STAGE
#undef PG8_LDA
#undef PG8_LDB
#undef PG8_MMA
#undef PG8_WAIT_V
#undef PG8_WAIT_L
#undef PG8_BAR
#undef PG8_SCHED
}
}

typedef pg8::f32x4 f32x4;
typedef pg8::bf16x8 bf16x8;
typedef unsigned u32x2 __attribute__((ext_vector_type(2)));
typedef unsigned u32x4 __attribute__((ext_vector_type(4)));
#define LAS __attribute__((address_space(3)))

constexpr int NTHREADS = 512;
constexpr int RING_BYTES = 131072;
constexpr int MISC_OFF = RING_BYTES;
constexpr int LDS_BYTES = 147456;

typedef __bf16 bf16x2_t __attribute__((ext_vector_type(2)));
typedef float f32x2_t __attribute__((ext_vector_type(2)));
DEV unsigned pk2(float lo, float hi) {
  const f32x2_t v = {lo, hi};
  return __builtin_bit_cast(unsigned, __builtin_convertvector(v, bf16x2_t));
}
DEV unsigned short f2bfh(float x) { return (unsigned short)(pk2(x, 0.f) & 0xffffu); }
DEV float wave_sum(float v, int lane) {
#pragma unroll
  for (int o = 1; o < 64; o <<= 1)
    v += __int_as_float(__builtin_amdgcn_ds_bpermute((lane ^ o) << 2, __float_as_int(v)));
  return v;
}

DEV void transpose_item(const float* W, int ldw, int dld, act_t* WT, int k0, int n0, int drow0, LAS float* scr, int lane) {
  float wv[32];
#pragma unroll
  for (int i = 0; i < 32; ++i) wv[i] = W[(size_t)(k0 + 2 * i + (lane >> 5)) * ldw + n0 + (lane & 31)];
#pragma unroll
  for (int i = 0; i < 32; ++i) scr[(2 * i + (lane >> 5)) * 33 + (lane & 31)] = wv[i];
  asm volatile("s_waitcnt lgkmcnt(0)" ::: "memory");
  const int c = lane & 7;
#pragma unroll
  for (int j = 0; j < 4; ++j) {
    const int n = (lane >> 3) + 8 * j;
    const LAS float* s = scr + (8 * c) * 33 + n;
    u32x4 o;
    o.x = pk2(s[0 * 33], s[1 * 33]); o.y = pk2(s[2 * 33], s[3 * 33]);
    o.z = pk2(s[4 * 33], s[5 * 33]); o.w = pk2(s[6 * 33], s[7 * 33]);
    *(u32x4*)(WT + (size_t)(drow0 + n) * dld + k0 + 8 * c) = o;
  }
  asm volatile("s_waitcnt lgkmcnt(0)" ::: "memory");
}

struct ConvDesc { const float* W; act_t* dst; int nbatch, K, N, mode; size_t dstb; int dld; };
constexpr int NCONV = 13;
DEV ConvDesc conv_desc(const Params& p, int kind) {
  const size_t SQ = (size_t)1024 * 1024;
  switch (kind) {
    case 0: return ConvDesc{p.w_gu, p.wt_gu, 64, 1024, 2048, 1, (size_t)2048 * 1024, 1024};
    case 1: return ConvDesc{p.w_down, p.wt_dn, 64, 1024, 1024, 0, SQ, 1024};
    case 2: return ConvDesc{p.w_in, p.wt_in, 2, 1024, N_IN, 0, (size_t)N_IN_PAD * 1024, 1024};
    case 3: return ConvDesc{p.cmp_w1_k, p.wt_c1, 2, 2048, 128, 0, (size_t)2 * 256 * 2048, 2048};
    case 4: return ConvDesc{p.cmp_w1_v, p.wt_c1 + (size_t)256 * 2048, 2, 2048, 128, 0, (size_t)2 * 256 * 2048, 2048};
    case 5: return ConvDesc{p.w_br_a, p.wt_bra, 2, 256, 1024, 0, (size_t)1024 * YLD, YLD};
    case 6: return ConvDesc{p.w_br_b, p.wt_brb, 2, 1024, 1024, 0, (size_t)1024 * YLD, YLD};
    case 7: return ConvDesc{p.w_br_c, p.wt_brc, 2, 1024, 1024, 0, (size_t)1024 * YLD, YLD};
    case 8: return ConvDesc{p.w_o_mix, p.wt_omix, 2, 1024, 1024, 0, SQ, 1024};
    case 9: return ConvDesc{p.w_xq, p.wt_xq, 2, 1024, 1024, 0, SQ, 1024};
    case 10: return ConvDesc{p.w_xk, p.wt_xk, 2, 1024, 1024, 0, SQ, 1024};
    case 11: return ConvDesc{p.w_xv, p.wt_xv, 2, 1024, 1024, 0, SQ, 1024};
    default: return ConvDesc{p.w_xo, p.wt_xo, 2, 1024, 1024, 0, SQ, 1024};
  }
}
DEV int conv_items(int kind) {
  switch (kind) {
    case 0: return 64 * 16 * 64;
    case 1: return 64 * 16 * 32;
    case 2: return 2 * 16 * (N_IN / 32);
    case 3: case 4: return 2 * 32 * 4;
    case 5: return 2 * 4 * 32;
    default: return 2 * 16 * 32;
  }
}
DEV void conv_all(const Params& p, int gw, int NGW, LAS float* scr, int lane) {
  int base = 0;
  for (int kind = 0; kind < NCONV; ++kind) {
    const int total = conv_items(kind);
    const ConvDesc d = conv_desc(p, kind);
    const int nblk = d.N / 32, per = nblk * (d.K / 64);
    int first = (gw - base % NGW + NGW) % NGW;
    for (int it = first; it < total; it += NGW) {
      const int bt = it / per, r = it % per, kb = r / nblk, nb = r % nblk;
      const int n0 = nb * 32;
      int drow0 = n0;
      if (d.mode == 1) { const int j = n0 & 1023; drow0 = (j >> 7) * 256 + (j & 127) + ((n0 >= 1024) ? 128 : 0); }
      transpose_item(d.W + (size_t)bt * d.K * d.N, d.N, d.dld, d.dst + (size_t)bt * d.dstb, kb * 64, n0, drow0, scr, lane);
    }
    base += total;
  }
}

template <int MODE>
DEV void ln_rows_w(const Params& p, const float* src, const float* g, const float* b, float* dstf, act_t* dstb, float* dst2,
                   int gw, int NGW, int lane) {
  for (int n = gw; n < N_TOK; n += NGW) {
    f32x4 v[4];
    float s = 0.f;
#pragma unroll
    for (int j = 0; j < 4; ++j) {
      if (MODE == 0) v[j] = ((const f32x4*)(src + (size_t)n * D))[lane + 64 * j];
      else {
        f32x4 a = ((const f32x4*)(p.xf + (size_t)n * D))[lane + 64 * j] * ALPHA;
#pragma unroll
        for (int k = 0; k < 4; ++k) a += ((const f32x4*)(p.yass + ((size_t)n * 4 + k) * D))[lane + 64 * j];
        v[j] = a;
      }
      s += (v[j].x + v[j].y) + (v[j].z + v[j].w);
    }
    const float mean = wave_sum(s, lane) * (1.f / D);
    float s2 = 0.f;
#pragma unroll
    for (int j = 0; j < 4; ++j) { v[j] = v[j] - mean; s2 += (v[j].x * v[j].x + v[j].y * v[j].y) + (v[j].z * v[j].z + v[j].w * v[j].w); }
    const float rstd = 1.f / sqrtf(wave_sum(s2, lane) * (1.f / D) + LN_EPS);
#pragma unroll
    for (int j = 0; j < 4; ++j) {
      const f32x4 gm = ((const f32x4*)g)[lane + 64 * j], bt = ((const f32x4*)b)[lane + 64 * j];
      const f32x4 y = v[j] * rstd * gm + bt;
      ((f32x4*)(dstf + (size_t)n * D))[lane + 64 * j] = y;
      u32x2 w; w.x = pk2(y.x, y.y); w.y = pk2(y.z, y.w);
      ((u32x2*)(dstb + (size_t)n * D))[lane + 64 * j] = w;
      if (dst2) ((f32x4*)(dst2 + (size_t)n * D))[lane + 64 * j] = y;
    }
  }
}

DEV void prologue(const Params& p, LAS unsigned char* lds, int wave, int lane) {
  LAS float* scr = (LAS float*)(lds + wave * 16384);
  const int gw = blockIdx.x * 8 + wave, NGW = gridDim.x * 8;
  conv_all(p, gw, NGW, scr, lane);
  const long long tid = (long long)blockIdx.x * NTHREADS + threadIdx.x, nthr = (long long)gridDim.x * NTHREADS;
  {
    const long long padw = (long long)(N_IN_PAD - N_IN) * 1024 / 8;
    for (long long i = tid; i < 2 * padw; i += nthr) {
      const int li = (int)(i / padw); const long long r = i % padw;
      ((u32x4*)(p.wt_in + ((size_t)li * N_IN_PAD + N_IN) * 1024))[r] = (u32x4){0u, 0u, 0u, 0u};
    }
    const long long padc = (long long)128 * 2048 / 8;
    for (long long i = tid; i < 4 * padc; i += nthr) {
      const int q = (int)(i / padc); const long long r = i % padc;
      ((u32x4*)(p.wt_c1 + ((size_t)q * 256 + 128) * 2048))[r] = (u32x4){0u, 0u, 0u, 0u};
    }
    if (tid < 64) p.cnt[tid] = 0;
    for (long long i = tid; i < 2LL * BATCH * NSA_G * 64; i += nthr) {
      const long long wb = i / (NSA_G * 64), r = i % (NSA_G * 64);
      p.kcb[(wb * 128 + 127) * NSA_G * 64 + r] = 0;
    }
    for (long long i = tid; i < (long long)BATCH * MEM_LEN * 1024 / 4; i += nthr) {
      const f32x4 v = ((const f32x4*)p.mem)[i];
      u32x2 w; w.x = pk2(v.x, v.y); w.y = pk2(v.z, v.w);
      ((u32x2*)p.membf)[i] = w;
    }
  }
  ln_rows_w<0>(p, p.x, p.ln0_g, p.ln0_b, p.xf, p.xb, nullptr, gw, NGW, lane);
}

struct USched {
  int nM, nN, nwg, G, c;
  int moe, nct, total; const LAS int* tile_e;
  DEV void init_static(int M, int N, int G_, int c_) { nM = M / 256; nN = N / 256; nwg = nM * nN; G = G_; c = c_; moe = 0; nct = 1; total = nwg; tile_e = nullptr; }
  DEV void init_moe(int G_, int c_, int nct_, int total_, const LAS int* te) { nM = 1; nN = 1; nwg = total_; G = G_; c = c_; moe = 1; nct = nct_; total = total_; tile_e = te; }
  DEV bool next(int i, pg8::Unit& u) const {
    const long L = (long)i * G + c; if (L >= total) return false;
    if (moe) { const int rt = (int)(L / nct), j = (int)(L % nct); u.pm = rt; u.pn = tile_e[rt] * nct + j; return true; }
    int wgid = (int)L; { const int q = nwg / 8, r = nwg % 8, xcd = wgid % 8, off = wgid / 8; wgid = (xcd < r ? xcd * (q + 1) : r * (q + 1) + (xcd - r) * q) + off; }
    const int nig = 8 * nN, gid = wgid / nig, fm = gid * 8, gsz = (nM - fm) < 8 ? (nM - fm) : 8;
    u.pm = fm + ((wgid % nig) % gsz); u.pn = (wgid % nig) / gsz; return true;
  }
  DEV void a_ready(const pg8::Unit&) const {}
  DEV void done(const pg8::Unit&) const {}
};

enum { EM_INPROJ = 0, EM_BRCAT, EM_RES, EM_BF16, EM_MOE1, EM_MOE2, EM_HID };
#define EPI_FENCE() asm volatile("" ::: "memory")
struct EpiU {
  static constexpr bool PERM = false, AFTER_DRAIN = false;
  int mode, ldc;
  act_t* ob;
  float* of;
  const act_t* ub;
  const float* f0;
  const float* f1;
  const int* il;
  const LAS int* te;
  DEV void mid(f32x4 (&acc)[2][2][4][2], const pg8::Unit& un, int wr, int wc, int t) const {
    if (mode != EM_BRCAT || (t != 4 && t != 20)) return;
    int l2;
    asm volatile("v_mbcnt_lo_u32_b32 %0, -1, 0\n\tv_mbcnt_hi_u32_b32 %0, -1, %0" : "=v"(l2));
    const int fr = l2 & 15, fq = l2 >> 4;
    const int row0 = un.pm * 256 + wr * 64 + fr, col0 = un.pn * 256 + wc * 32 + 4 * fq;
    const int goff = OFF_MG + (t == 4 ? 0 : D);
    const float L2E = -1.4426950408889634f;
#pragma unroll
    for (int ai = 0; ai < 2; ++ai)
#pragma unroll
      for (int m = 0; m < 4; ++m) {
        const int row = row0 + ai * 128 + m * 16;
#pragma unroll
        for (int bj = 0; bj < 2; ++bj)
#pragma unroll
          for (int n = 0; n < 2; ++n) {
            const int col = col0 + bj * 128 + n * 16;
            const act_t* gp = ub + (size_t)row * N_IN + goff + col;
            const u32x2 ga = *(const u32x2*)gp, gb = *(const u32x2*)(gp + D);
            const float ea0 = __builtin_amdgcn_exp2f(__uint_as_float(ga.x << 16) * L2E), ea1 = __builtin_amdgcn_exp2f(__uint_as_float(ga.x & 0xffff0000u) * L2E);
            const float ea2 = __builtin_amdgcn_exp2f(__uint_as_float(ga.y << 16) * L2E), ea3 = __builtin_amdgcn_exp2f(__uint_as_float(ga.y & 0xffff0000u) * L2E);
            const float eb0 = __builtin_amdgcn_exp2f(__uint_as_float(gb.x << 16) * L2E), eb1 = __builtin_amdgcn_exp2f(__uint_as_float(gb.x & 0xffff0000u) * L2E);
            const float eb2 = __builtin_amdgcn_exp2f(__uint_as_float(gb.y << 16) * L2E), eb3 = __builtin_amdgcn_exp2f(__uint_as_float(gb.y & 0xffff0000u) * L2E);
            f32x4& v = acc[ai][bj][m][n];
            v.x *= (1.0f + eb0) * __builtin_amdgcn_rcpf(1.0f + ea0); v.y *= (1.0f + eb1) * __builtin_amdgcn_rcpf(1.0f + ea1);
            v.z *= (1.0f + eb2) * __builtin_amdgcn_rcpf(1.0f + ea2); v.w *= (1.0f + eb3) * __builtin_amdgcn_rcpf(1.0f + ea3);
          }
        EPI_FENCE();
      }
  }
  DEV void operator()(const f32x4 (&acc)[2][2][4][2], const pg8::Unit& un, int wr, int wc, int fr, int fq) const {
    {
      int l2;
      asm volatile("v_mbcnt_lo_u32_b32 %0, -1, 0\n\tv_mbcnt_hi_u32_b32 %0, -1, %0" : "=v"(l2));
      fr = l2 & 15; fq = l2 >> 4;
    }
    const int row0 = un.pm * 256 + wr * 64 + fr;
    if (mode == EM_INPROJ) {
      const int col0 = un.pn * 256 + wc * 32 + 4 * fq;
#pragma unroll
      for (int bj = 0; bj < 2; ++bj)
#pragma unroll
        for (int n = 0; n < 2; ++n) {
          const int col = col0 + bj * 128 + n * 16;
          if (col < N_IN) {
            const f32x4 bv = *(const f32x4*)(f0 + col);
#pragma unroll
            for (int ai = 0; ai < 2; ++ai)
#pragma unroll
              for (int m = 0; m < 4; ++m) {
                const int row = row0 + ai * 128 + m * 16;
                const f32x4 v = acc[ai][bj][m][n] + bv;
                u32x2 w; w.x = pk2(v.x, v.y); w.y = pk2(v.z, v.w);
                *(u32x2*)(ob + (size_t)row * N_IN + col) = w;
              }
          }
          EPI_FENCE();
        }
    } else if (mode == EM_BRCAT) {
      const int col0 = un.pn * 256 + wc * 32 + 4 * fq;
#pragma unroll
      for (int ai = 0; ai < 2; ++ai)
#pragma unroll
        for (int m = 0; m < 4; ++m) {
          const int row = row0 + ai * 128 + m * 16;
#pragma unroll
          for (int bj = 0; bj < 2; ++bj)
#pragma unroll
            for (int n = 0; n < 2; ++n) {
              const int col = col0 + bj * 128 + n * 16;
              const u32x2 gw = *(const u32x2*)(ub + (size_t)row * N_IN + OFF_MG + 2 * D + col);
              f32x4 v = acc[ai][bj][m][n];
              v.x *= sigmoidf_(__uint_as_float(gw.x << 16)); v.y *= sigmoidf_(__uint_as_float(gw.x & 0xffff0000u));
              v.z *= sigmoidf_(__uint_as_float(gw.y << 16)); v.w *= sigmoidf_(__uint_as_float(gw.y & 0xffff0000u));
              u32x2 w; w.x = pk2(v.x, v.y); w.y = pk2(v.z, v.w);
              *(u32x2*)(ob + (size_t)row * D + col) = w;
            }
          EPI_FENCE();
        }
    } else if (mode == EM_RES) {
      const int col0 = un.pn * 256 + wc * 32 + 4 * fq;
#pragma unroll
      for (int ai = 0; ai < 2; ++ai)
#pragma unroll
        for (int m = 0; m < 4; ++m) {
          const int row = row0 + ai * 128 + m * 16;
#pragma unroll
          for (int bj = 0; bj < 2; ++bj)
#pragma unroll
            for (int n = 0; n < 2; ++n) {
              const int col = col0 + bj * 128 + n * 16;
              const f32x4 x = *(const f32x4*)(f0 + (size_t)row * D + col);
              *(f32x4*)(of + (size_t)row * D + col) = x * ALPHA + acc[ai][bj][m][n];
            }
          EPI_FENCE();
        }
    } else if (mode == EM_BF16) {
      const int col0 = un.pn * 256 + wc * 32 + 4 * fq;
#pragma unroll
      for (int ai = 0; ai < 2; ++ai)
#pragma unroll
        for (int m = 0; m < 4; ++m) {
          const int row = row0 + ai * 128 + m * 16;
#pragma unroll
          for (int bj = 0; bj < 2; ++bj)
#pragma unroll
            for (int n = 0; n < 2; ++n) {
              const int col = col0 + bj * 128 + n * 16;
              const f32x4 v = acc[ai][bj][m][n];
              u32x2 w; w.x = pk2(v.x, v.y); w.y = pk2(v.z, v.w);
              *(u32x2*)(ob + (size_t)row * ldc + col) = w;
            }
          EPI_FENCE();
        }
    } else if (mode == EM_MOE1) {
      const int e = te[un.pm], j = un.pn & 7;
#pragma unroll
      for (int n = 0; n < 2; ++n) {
        const int cj = j * 128 + wc * 32 + n * 16 + 4 * fq;
        const f32x4 bg = *(const f32x4*)(f0 + (size_t)e * 2048 + cj), bu = *(const f32x4*)(f0 + (size_t)e * 2048 + 1024 + cj);
#pragma unroll
        for (int ai = 0; ai < 2; ++ai)
#pragma unroll
          for (int m = 0; m < 4; ++m) {
            const int row = row0 + ai * 128 + m * 16;
            const f32x4 g = acc[ai][0][m][n] + bg, u = acc[ai][1][m][n] + bu;
            float o[4];
#pragma unroll
            for (int i = 0; i < 4; ++i) {
              const float gt = fminf(g[i], 7.0f), up = fminf(fmaxf(u[i], -7.0f), 7.0f);
              o[i] = (up + 1.0f) * gt * sigmoidf_(1.702f * gt);
            }
            u32x2 w; w.x = pk2(o[0], o[1]); w.y = pk2(o[2], o[3]);
            *(u32x2*)(ob + (size_t)row * 1024 + cj) = w;
          }
        EPI_FENCE();
      }
    } else if (mode == EM_MOE2) {
      const int e = te[un.pm], j = un.pn & 3;
      const int col0 = j * 256 + wc * 32 + 4 * fq;
#pragma unroll
      for (int ai = 0; ai < 2; ++ai)
#pragma unroll
        for (int m = 0; m < 4; ++m) {
          const int row = row0 + ai * 128 + m * 16;
          const int aid = il[row];
          if (aid >= 0) {
            const float gt = f1[aid];
#pragma unroll
            for (int bj = 0; bj < 2; ++bj)
#pragma unroll
              for (int n = 0; n < 2; ++n) {
                const int col = col0 + bj * 128 + n * 16;
                const f32x4 v = (acc[ai][bj][m][n] + *(const f32x4*)(f0 + (size_t)e * 1024 + col)) * gt;
                *(f32x4*)(of + (size_t)aid * 1024 + col) = v;
              }
          }
          EPI_FENCE();
        }
    } else if (mode == EM_HID) {
      const int col0 = wc * 32 + 4 * fq;
#pragma unroll
      for (int ai = 0; ai < 2; ++ai)
#pragma unroll
        for (int m = 0; m < 4; ++m) {
          const int row = row0 + ai * 128 + m * 16;
          if (row < CMP_ROWS) {
#pragma unroll
            for (int n = 0; n < 2; ++n) {
              const f32x4 a = acc[ai][0][m][n];
              f32x4 v; v.x = gelu_tanh(a.x); v.y = gelu_tanh(a.y); v.z = gelu_tanh(a.z); v.w = gelu_tanh(a.w);
              *(f32x4*)(of + (size_t)row * CMP_HID + col0 + n * 16) = v;
            }
          }
          EPI_FENCE();
        }
    }
  }
};

DEV int moe_tables(const Params& p, int li, LAS int* tab, int t32) {
  __syncthreads();
  if (t32 == 0) {
    int t = 0;
    for (int e = 0; e < NE; ++e) {
      const int c = p.cnt[li * 32 + e];
      tab[e] = t * 256; tab[32 + e] = c;
      const int nt = (c + 255) >> 8;
#pragma clang loop vectorize(disable) unroll(disable)
      for (int k = 0; k < nt; ++k) tab[128 + t + k] = e;
      t += nt;
    }
    tab[64] = t;
  }
  __syncthreads();
  return tab[64];
}

DEV void moe_prep(const Params& p, int li, LAS int* tab, int wave, int lane, int t32) {
  const int ntiles = moe_tables(p, li, tab, t32);
  const int gw = blockIdx.x * 8 + wave, NGW = gridDim.x * 8;
  for (int tk = gw; tk < N_TOK; tk += NGW) {
    const u32x4* src = (const u32x4*)(p.xb + (size_t)tk * 1024);
    const u32x4 v0 = src[lane], v1 = src[lane + 64];
#pragma unroll
    for (int k = 0; k < 4; ++k) {
      const int a = tk * 4 + k;
      const int row = tab[p.topi[a]] + p.rank[a];
      if (lane == 0) p.rowlist[row] = a;
      u32x4* dst = (u32x4*)(p.xg + (size_t)row * 1024);
      dst[lane] = v0; dst[lane + 64] = v1;
    }
  }
  const long long tid = (long long)blockIdx.x * NTHREADS + t32, nthr = (long long)gridDim.x * NTHREADS;
  for (long long r = tid; r < (long long)ntiles * 256; r += nthr) {
    const int e = tab[128 + (int)(r >> 8)];
    if ((int)r - tab[e] >= tab[32 + e]) p.rowlist[r] = -1;
  }
}

typedef short v4i16_t __attribute__((ext_vector_type(4)));
DEV v4i16_t tr_read(const LAS unsigned char* p) { return __builtin_amdgcn_ds_read_tr16_b64_v4i16((LAS v4i16_t*)p); }
DEV float shx(float v, int lane, int o) { return __int_as_float(__builtin_amdgcn_ds_bpermute((lane ^ o) << 2, __float_as_int(v))); }
DEV int shxi(int v, int lane, int o) { return __builtin_amdgcn_ds_bpermute((lane ^ o) << 2, v); }

constexpr int AT_ROWB = 144;
constexpr int AT_TILEB = 64 * AT_ROWB;
constexpr int AT_HALF_KV = 4 * AT_TILEB;
constexpr int AT_SLAB_OFF = 2 * AT_HALF_KV;
constexpr int AT_SLAB_WAVE = 32 * 33 * 4;
constexpr int AT_SLAB_HALF = 4 * AT_SLAB_WAVE;
constexpr int AT_XCH_OFF = AT_SLAB_OFF + 2 * AT_SLAB_HALF;
static_assert(AT_XCH_OFF + 16 <= RING_BYTES, "attention LDS map");
constexpr float SC2 = 0.125f * 1.4426950408889634f;

struct AttnState { f32x4 O[2][4]; float m[2], l[2]; };

template <bool PROB, class Job>
DEV void attn_tile(const Job& job, const LAS unsigned char* Kb, const LAS unsigned char* Vb, const bf16x8 (&qf)[2][2], AttnState& st,
                   LAS float* slab, int cur, int wih, int lane) {
  const int i15 = lane & 15, g4 = lane >> 4;
  f32x4 S[2][4];
#pragma unroll
  for (int sub = 0; sub < 2; ++sub)
#pragma unroll
    for (int t = 0; t < 4; ++t) S[sub][t] = (f32x4){0.f, 0.f, 0.f, 0.f};
#pragma unroll
  for (int t = 0; t < 4; ++t)
#pragma unroll
    for (int kk = 0; kk < 2; ++kk) {
      const bf16x8 kf = *(const LAS bf16x8*)(Kb + (16 * t + i15) * AT_ROWB + (kk * 32 + 8 * g4) * 2);
#pragma unroll
      for (int sub = 0; sub < 2; ++sub) S[sub][t] = __builtin_amdgcn_mfma_f32_16x16x32_bf16(kf, qf[sub][kk], S[sub][t], 0, 0, 0);
    }
  bf16x8 pf[2][2];
  const bool efree = job.elemfree(cur, wih);
#pragma unroll
  for (int sub = 0; sub < 2; ++sub) {
    const int row = wih * 32 + sub * 16 + i15;
    if (!efree) {
      const int mbv = job.mb(row, cur, g4);
#pragma unroll
      for (int t = 0; t < 4; ++t)
#pragma unroll
        for (int j = 0; j < 4; ++j) S[sub][t][j] = job.ok(mbv, 16 * t + j) ? S[sub][t][j] : -INFINITY;
    }
    float mx = fmaxf(fmaxf(S[sub][0][0], S[sub][0][1]), fmaxf(S[sub][0][2], S[sub][0][3]));
#pragma unroll
    for (int t = 1; t < 4; ++t) mx = fmaxf(fmaxf(mx, fmaxf(S[sub][t][0], S[sub][t][1])), fmaxf(S[sub][t][2], S[sub][t][3]));
    if (!PROB) {
      mx = fmaxf(mx, shx(mx, lane, 16));
      mx = fmaxf(mx, shx(mx, lane, 32));
      const bool rok = job.rowok(sub, cur);
      const float mcand = rok ? mx * SC2 : -INFINITY;
      const float mnew = fmaxf(st.m[sub], mcand);
      const float msafe = (mnew == -INFINITY) ? 0.f : mnew;
      const float corr = __builtin_amdgcn_exp2f(st.m[sub] - msafe);
      st.m[sub] = mnew;
      const float msub = rok ? msafe : INFINITY;
      float psum = 0.f;
#pragma unroll
      for (int t = 0; t < 4; ++t)
#pragma unroll
        for (int j = 0; j < 4; ++j) { const float pp = __builtin_amdgcn_exp2f(__builtin_fmaf(S[sub][t][j], SC2, -msub)); S[sub][t][j] = pp; psum += pp; }
      st.l[sub] = st.l[sub] * corr + psum;
      if (__builtin_amdgcn_ballot_w64(corr != 1.0f) != 0ull) {
#pragma unroll
        for (int dt = 0; dt < 4; ++dt) st.O[sub][dt] *= corr;
      }
#pragma unroll
      for (int s2 = 0; s2 < 2; ++s2) {
        u32x4 w;
        w.x = pk2(S[sub][2 * s2][0], S[sub][2 * s2][1]); w.y = pk2(S[sub][2 * s2][2], S[sub][2 * s2][3]);
        w.z = pk2(S[sub][2 * s2 + 1][0], S[sub][2 * s2 + 1][1]); w.w = pk2(S[sub][2 * s2 + 1][2], S[sub][2 * s2 + 1][3]);
        pf[sub][s2] = __builtin_bit_cast(bf16x8, w);
      }
    } else {
      const float msafe = (st.m[sub] == -INFINITY) ? 0.f : st.m[sub];
      const int q = sub * 16 + i15;
#pragma unroll
      for (int t = 0; t < 4; ++t) {
        const float p0 = __builtin_amdgcn_exp2f(__builtin_fmaf(S[sub][t][0], SC2, -msafe)) * st.l[sub], p1 = __builtin_amdgcn_exp2f(__builtin_fmaf(S[sub][t][1], SC2, -msafe)) * st.l[sub];
        const float p2 = __builtin_amdgcn_exp2f(__builtin_fmaf(S[sub][t][2], SC2, -msafe)) * st.l[sub], p3 = __builtin_amdgcn_exp2f(__builtin_fmaf(S[sub][t][3], SC2, -msafe)) * st.l[sub];
        const int jb = 16 * cur + 4 * t + g4;
        slab[q * 33 + jb] += (p0 + p1) + (p2 + p3);
        S[sub][t][3] = p3;
      }
      asm volatile("s_waitcnt lgkmcnt(0)" ::: "memory");
#pragma unroll
      for (int t = 0; t < 4; ++t) {
        const int jb = 16 * cur + 4 * t + g4 + 1;
        if (jb < 32) slab[q * 33 + jb] += S[sub][t][3];
      }
      asm volatile("s_waitcnt lgkmcnt(0)" ::: "memory");
    }
  }
  if (!PROB) {
#pragma unroll
    for (int dt = 0; dt < 4; ++dt)
#pragma unroll
      for (int s2 = 0; s2 < 2; ++s2) {
        const LAS unsigned char* vp = Vb + (32 * s2 + 4 * g4 + (i15 >> 2)) * AT_ROWB + (16 * dt + 4 * (lane & 3)) * 2;
        const v4i16_t lo = tr_read(vp), hi = tr_read(vp + 16 * AT_ROWB);
        bf16x8 vf;
        vf[0] = lo[0]; vf[1] = lo[1]; vf[2] = lo[2]; vf[3] = lo[3]; vf[4] = hi[0]; vf[5] = hi[1]; vf[6] = hi[2]; vf[7] = hi[3];
#pragma unroll
        for (int sub = 0; sub < 2; ++sub) st.O[sub][dt] = __builtin_amdgcn_mfma_f32_16x16x32_bf16(vf, pf[sub][s2], st.O[sub][dt], 0, 0, 0);
      }
  }
}

template <bool PROB, class Job>
DEV void attn_run(const Job& job, LAS unsigned char* lds, AttnState& st, int half, int hth, int wih, int lane) {
  LAS unsigned char* kvh = lds + half * AT_HALF_KV;
  LAS int* xch = (LAS int*)(lds + AT_XCH_OFF);
  LAS float* slab = (LAS float*)(lds + AT_SLAB_OFF + half * AT_SLAB_HALF + wih * AT_SLAB_WAVE);
  const int i15 = lane & 15, g4 = lane >> 4;
  unsigned rem = job.tilemask();
  if (hth == 0) xch[half] = __builtin_popcount(rem);
  bf16x8 qf[2][2];
#pragma unroll
  for (int sub = 0; sub < 2; ++sub) {
    const act_t* qr = job.qrow(wih * 32 + sub * 16 + i15);
#pragma unroll
    for (int kk = 0; kk < 2; ++kk) qf[sub][kk] = *(const bf16x8*)(qr + kk * 32 + 8 * g4);
  }
  if (!PROB) {
#pragma unroll
    for (int sub = 0; sub < 2; ++sub) {
      st.m[sub] = -INFINITY; st.l[sub] = 0.f;
#pragma unroll
      for (int dt = 0; dt < 4; ++dt) st.O[sub][dt] = (f32x4){0.f, 0.f, 0.f, 0.f};
    }
  }
  const int srow = hth >> 2, sch = hth & 3;
  u32x4 ak0, ak1, av0, av1;
#define AT_LOAD(k0, k1, v0, v1, T) do { const act_t* kr_ = job.krow(T, srow) + sch * 16; k0 = *(const u32x4*)kr_; k1 = *(const u32x4*)(kr_ + 8); \
    if (!PROB) { const act_t* vr_ = job.vrow(T, srow) + sch * 16; v0 = *(const u32x4*)vr_; v1 = *(const u32x4*)(vr_ + 8); } } while (0)
#define AT_WRITE(k0, k1, v0, v1, BUF) do { LAS unsigned char* kd_ = kvh + (BUF) * AT_TILEB + srow * AT_ROWB + sch * 32; *(LAS u32x4*)kd_ = k0; *(LAS u32x4*)(kd_ + 16) = k1; \
    if (!PROB) { LAS unsigned char* vd_ = kvh + (2 + (BUF)) * AT_TILEB + srow * AT_ROWB + sch * 32; *(LAS u32x4*)vd_ = v0; *(LAS u32x4*)(vd_ + 16) = v1; } } while (0)
#define AT_NEXT(T) do { T = -1; if (rem) { T = __builtin_ctz(rem); rem &= rem - 1; } } while (0)
  int t0;
  AT_NEXT(t0);
  if (t0 >= 0) { AT_LOAD(ak0, ak1, av0, av1, t0); AT_WRITE(ak0, ak1, av0, av1, 0); }
  __syncthreads();
  const int niter = max(xch[0], xch[1]);
  for (int it = 0; it < niter; ++it) {
    int t1;
    AT_NEXT(t1);
    if (t1 >= 0) AT_LOAD(ak0, ak1, av0, av1, t1);
    if (t0 >= 0) attn_tile<PROB>(job, kvh + (it & 1) * AT_TILEB, kvh + (2 + (it & 1)) * AT_TILEB, qf, st, slab, t0, wih, lane);
    if (t1 >= 0) AT_WRITE(ak0, ak1, av0, av1, (it + 1) & 1);
    __syncthreads();
    t0 = t1;
  }
#undef AT_LOAD
#undef AT_WRITE
#undef AT_NEXT
  if (!PROB) {
#pragma unroll
    for (int sub = 0; sub < 2; ++sub) {
      float l = st.l[sub];
      l += shx(l, lane, 16);
      l += shx(l, lane, 32);
      const float inv = 1.0f / fmaxf(l, 1e-30f);
      st.l[sub] = l;
#pragma unroll
      for (int dt = 0; dt < 4; ++dt) st.O[sub][dt] *= inv;
    }
  }
  __syncthreads();
}

struct SelJob {
  const act_t* u; int b, g, t0; unsigned um; unsigned tm[2];
  DEV unsigned tilemask() const { return um; }
  DEV const act_t* qrow(int r) const { return u + ((size_t)b * SEQ + t0 + (r & 31)) * N_IN + OFF_CQ + (g * 4 + (r >> 5)) * 64; }
  DEV const act_t* krow(int kt, int j) const { return u + ((size_t)b * SEQ + kt * 64 + j) * N_IN + OFF_CKS + g * 64; }
  DEV const act_t* vrow(int kt, int j) const { return u + ((size_t)b * SEQ + kt * 64 + j) * N_IN + OFF_CVS + g * 64; }
  DEV int mb(int r, int kt, int g4) const { return t0 + (r & 31) - kt * 64 - 4 * g4; }
  DEV bool rowok(int sub, int kt) const { return (tm[sub] >> kt) & 1u; }
  DEV bool ok(int m, int C) const { return m >= C; }
  DEV bool elemfree(int kt, int wih) const { return kt < (t0 >> 6); }
};
struct WinJob {
  const act_t* u; int b, g, t0; unsigned um;
  DEV unsigned tilemask() const { return um; }
  DEV const act_t* qrow(int r) const { return u + ((size_t)b * SEQ + t0 + (r & 31)) * N_IN + OFF_CQ + (g * 4 + (r >> 5)) * 64; }
  DEV const act_t* krow(int kt, int j) const { return u + ((size_t)b * SEQ + kt * 64 + j) * N_IN + OFF_CKW + g * 64; }
  DEV const act_t* vrow(int kt, int j) const { return u + ((size_t)b * SEQ + kt * 64 + j) * N_IN + OFF_CVW + g * 64; }
  DEV int mb(int r, int kt, int g4) const { return t0 + (r & 31) - kt * 64 - 4 * g4; }
  DEV bool rowok(int sub, int kt) const { return true; }
  DEV bool ok(int m, int C) const { return m >= C && m < NSA_WIN + C; }
  DEV bool elemfree(int kt, int wih) const { return kt * 64 + 63 <= t0 && t0 + 31 - kt * 64 < NSA_WIN; }
};
struct CmpJob {
  const act_t* u; const act_t* kcb; const act_t* vcb; int b, g, t0; unsigned um;
  DEV unsigned tilemask() const { return um; }
  DEV const act_t* qrow(int r) const { return u + ((size_t)b * SEQ + t0 + (r & 31)) * N_IN + OFF_CQ + (g * 4 + (r >> 5)) * 64; }
  DEV const act_t* krow(int kt, int j) const { return kcb + (((size_t)b * 128 + kt * 64 + j) * NSA_G + g) * 64; }
  DEV const act_t* vrow(int kt, int j) const { return vcb + (((size_t)b * 128 + kt * 64 + j) * NSA_G + g) * 64; }
  DEV int mb(int r, int kt, int g4) const { return t0 + (r & 31) - 31 - 16 * (kt * 64 + 4 * g4); }
  DEV bool rowok(int sub, int kt) const { return true; }
  DEV bool ok(int m, int C) const { return m >= 16 * C; }
  DEV bool elemfree(int kt, int wih) const { return kt == 0 && 16 * 63 + 31 <= t0; }
};
struct DilJob {
  const act_t* u; int b, col, dil, res, l0; unsigned um;
  DEV unsigned tilemask() const { return um; }
  DEV const act_t* qrow(int r) const { return u + ((size_t)b * SEQ + (l0 + r) * dil + res) * N_IN + OFF_AQ + col; }
  DEV const act_t* krow(int kt, int j) const { return u + ((size_t)b * SEQ + (kt * 64 + j) * dil + res) * N_IN + OFF_AK + col; }
  DEV const act_t* vrow(int kt, int j) const { return u + ((size_t)b * SEQ + (kt * 64 + j) * dil + res) * N_IN + OFF_AV + col; }
  DEV int mb(int r, int kt, int g4) const { return l0 + r - kt * 64 - 4 * g4; }
  DEV bool rowok(int sub, int kt) const { return true; }
  DEV bool ok(int m, int C) const { return m >= C && m <= 128 + C; }
  DEV bool elemfree(int kt, int wih) const { return kt * 64 + 63 <= l0 + 32 * wih && l0 + 32 * wih + 31 - kt * 64 <= 128; }
};

DEV unsigned range_mask(int lo, int hi) {
  return (hi >= 31 ? 0xffffffffu : ((1u << (hi + 1)) - 1u)) & ~((1u << lo) - 1u);
}

DEV bool nsa_unit(int round, int bid, int G, int half, int& b, int& g, int& tb) {
  if ((G & 7) == 0) {
    const int nr = G >> 3, rank = bid >> 3;
    const int slot = rank * 2 + half, nslot = nr * 2;
    const int pos = (round & 1) ? (nslot - 1 - slot) : slot;
    const int lu = round * nslot + pos;
    if (lu >= 256) return false;
    b = bid & 7; g = lu & 3; tb = 63 - (lu >> 2);
    return true;
  }
  const int pos = (round & 1) ? (G - 1 - bid) : bid;
  const int pair = round * G + pos;
  if (pair >= 1024) return false;
  const int un = pair * 2 + half;
  tb = 63 - un / 32; b = (un % 32) / 4; g = un % 4;
  return true;
}
DEV int nsa_rounds(int G) { return (G & 7) == 0 ? (256 + (G >> 3) * 2 - 1) / ((G >> 3) * 2) : (1024 + G - 1) / G; }

DEV void nsa_cmp_phase(const Params& p, LAS unsigned char* lds, int t32, int bid, int G) {
  const int lane = t32 & 63, wave = t32 >> 6, half = wave >> 2, wih = wave & 3, hth = t32 & 255;
  const int i15 = lane & 15, g4 = lane >> 4;
  LAS float* slabh = (LAS float*)(lds + AT_SLAB_OFF + half * AT_SLAB_HALF);
  for (int round = 0; round < nsa_rounds(G); ++round) {
    int b = 0, g = 0, tb = 0;
    const bool act = nsa_unit(round, bid, G, half, b, g, tb);
    const int t0 = tb * 32;
    const int nvmax = t0 + 31 >= 31 ? (t0 + 31 - 31) / 16 + 1 : 0;
    CmpJob job{p.u, p.kcb, p.kcb + (size_t)BATCH * 128 * NSA_G * 64, b, g, t0, 0u};
    job.um = !act ? 0u : (nvmax > 64 ? 3u : (nvmax > 0 ? 1u : 0u));
    for (int i = lane; i < 32 * 33; i += 64) slabh[wih * (32 * 33) + i] = 0.f;
    AttnState st;
    attn_run<false>(job, lds, st, half, hth, wih, lane);
    if (act) {
#pragma unroll
      for (int sub = 0; sub < 2; ++sub) {
        const int hh = g * 4 + wih;
        const size_t n = (size_t)b * SEQ + t0 + sub * 16 + i15;
        const float g0 = sigmoidf_(ldf(p.u[n * N_IN + OFF_CG + hh * 3 + 0]));
#pragma unroll
        for (int dt = 0; dt < 4; ++dt) *(f32x4*)(p.ocmp + n * 1024 + hh * 64 + 16 * dt + 4 * g4) = st.O[sub][dt] * g0;
        st.l[sub] = 1.0f / fmaxf(st.l[sub], 1e-30f);
      }
    }
    attn_run<true>(job, lds, st, half, hth, wih, lane);
    {
      const int q = hth >> 3, j4 = (hth & 7) * 4;
      float v[4];
#pragma unroll
      for (int i = 0; i < 4; ++i) {
        float s = 0.f;
#pragma unroll
        for (int w = 0; w < 4; ++w) s += slabh[w * (32 * 33) + q * 33 + j4 + i];
        const int j = j4 + i, qb = (t0 + q) >> 6;
        if (j == 0 || j == qb || j == qb - 1) s = INFINITY;
        else if (j > qb) s = -INFINITY;
        v[i] = s;
      }
      __syncthreads();
#pragma unroll
      for (int i = 0; i < 4; ++i) slabh[q * 33 + j4 + i] = v[i];
      __syncthreads();
      unsigned bits = 0u;
#pragma unroll
      for (int i = 0; i < 4; ++i) {
        int rank = 0;
#pragma unroll 1
        for (int jj = 0; jj < 32; ++jj) { const float w = slabh[q * 33 + jj]; rank += (w > v[i] || (w == v[i] && jj < j4 + i)) ? 1 : 0; }
        if (rank < N_SELECT) bits |= 1u << (j4 + i);
      }
      bits |= (unsigned)shxi((int)bits, lane, 1);
      bits |= (unsigned)shxi((int)bits, lane, 2);
      bits |= (unsigned)shxi((int)bits, lane, 4);
      if (act && (hth & 7) == 0) p.selm[((size_t)b * NSA_G + g) * SEQ + t0 + q] = bits;
      __syncthreads();
    }
  }
}

DEV void nsa_main_phase(const Params& p, LAS unsigned char* lds, int t32, int bid, int G) {
  const int lane = t32 & 63, wave = t32 >> 6, half = wave >> 2, wih = wave & 3, hth = t32 & 255;
  const int i15 = lane & 15, g4 = lane >> 4;
  for (int round2 = 0; round2 < nsa_rounds(G) * (NSA_PROBE == 5 ? 2 : 1); ++round2) {
    const int round = (NSA_PROBE == 5) ? (round2 >> 1) : round2;
    int b = 0, g = 0, tb = 0;
    const bool act = nsa_unit(round, bid, G, half, b, g, tb);
    const int t0 = tb * 32;
    SelJob sj{p.u, b, g, t0, 0u, {0u, 0u}};
    if (act) {
      const unsigned* sm = p.selm + ((size_t)b * NSA_G + g) * SEQ + t0;
      sj.tm[0] = sm[i15]; sj.tm[1] = sm[16 + i15];
      unsigned um = sj.tm[0] | sj.tm[1];
      um |= (unsigned)shxi((int)um, lane, 1); um |= (unsigned)shxi((int)um, lane, 2);
      um |= (unsigned)shxi((int)um, lane, 4); um |= (unsigned)shxi((int)um, lane, 8);
      sj.um = um & range_mask(0, t0 >> 6);
    }
    u32x2 base[2][4];
    const int hh = g * 4 + wih;
    const size_t nrow0 = (size_t)b * SEQ + t0 + i15;
    const act_t gq10 = p.u[nrow0 * N_IN + OFF_CG + hh * 3 + 1], gq11 = p.u[(nrow0 + 16) * N_IN + OFF_CG + hh * 3 + 1];
    const act_t gq20 = p.u[nrow0 * N_IN + OFF_CG + hh * 3 + 2], gq21 = p.u[(nrow0 + 16) * N_IN + OFF_CG + hh * 3 + 2];
    {
      AttnState ss;
      attn_run<false>(sj, lds, ss, half, hth, wih, lane);
#if NSA_PROBE == 1
      attn_run<false>(sj, lds, ss, half, hth, wih, lane);
#endif
#pragma unroll
      for (int sub = 0; sub < 2; ++sub) {
        f32x4 oc[4];
#pragma unroll
        for (int dt = 0; dt < 4; ++dt) oc[dt] = *(const f32x4*)(p.ocmp + (nrow0 + 16 * sub) * 1024 + hh * 64 + 16 * dt + 4 * g4);
        const float g1 = sigmoidf_(ldf(sub ? gq11 : gq10));
#pragma unroll
        for (int dt = 0; dt < 4; ++dt) {
          const f32x4 y = ss.O[sub][dt] * g1 + oc[dt];
          base[sub][dt].x = pk2(y.x, y.y); base[sub][dt].y = pk2(y.z, y.w);
        }
      }
    }
    WinJob wj{p.u, b, g, t0, 0u};
    if (act) { const int lo = t0 - (NSA_WIN - 1) < 0 ? 0 : (t0 - (NSA_WIN - 1)) >> 6; wj.um = range_mask(lo, (t0 + 31) >> 6); }
    AttnState ws;
    attn_run<false>(wj, lds, ws, half, hth, wih, lane);
#if NSA_PROBE == 2
    attn_run<false>(wj, lds, ws, half, hth, wih, lane);
#endif
    if (act) {
#pragma unroll
      for (int sub = 0; sub < 2; ++sub) {
        const size_t n = nrow0 + 16 * sub;
        const float g2 = sigmoidf_(ldf(sub ? gq21 : gq20));
#pragma unroll
        for (int dt = 0; dt < 4; ++dt) {
          const u32x2 bw = base[sub][dt];
          f32x4 y = ws.O[sub][dt] * g2;
          y.x += __uint_as_float(bw.x << 16); y.y += __uint_as_float(bw.x & 0xffff0000u);
          y.z += __uint_as_float(bw.y << 16); y.w += __uint_as_float(bw.y & 0xffff0000u);
          u32x2 w; w.x = pk2(y.x, y.y); w.y = pk2(y.z, y.w);
          *(u32x2*)(p.yc + n * YLD + hh * 64 + 16 * dt + 4 * g4) = w;
        }
      }
    }
  }
}

DEV void dil_phase(const Params& p, LAS unsigned char* lds, int t32, int bid, int G) {
  const int lane = t32 & 63, wave = t32 >> 6, half = wave >> 2, wih = wave & 3, hth = t32 & 255;
  const int i15 = lane & 15, g4 = lane >> 4;
  const bool xm = (G & 7) == 0;
  const int npair = xm ? 96 : 768, pstep = xm ? (G >> 3) : G;
  for (int pair = xm ? (bid >> 3) : bid; pair < npair; pair += pstep) {
    const int un = pair * 2 + half;
    int gi, b, r2;
    if (xm) { b = bid & 7; gi = un / 64; r2 = un % 64; }
    else { gi = un / 512; const int r = un % 512; b = r / 64; r2 = r % 64; }
    const int dil = gi == 0 ? 1 : (gi == 1 ? 4 : 16);
    const int nlb = 16 / dil;
    const int h = r2 / 16, r3 = r2 % 16;
    const int res = r3 / nlb, lb = r3 % nlb;
    const int l0 = lb * 128;
    DilJob job{p.u, b, gi * 256 + h * 64, dil, res, l0, 0u};
    job.um = range_mask(l0 >= 128 ? (l0 - 128) >> 6 : 0, (l0 + 127) >> 6);
    AttnState st;
    attn_run<false>(job, lds, st, half, hth, wih, lane);
#pragma unroll
    for (int sub = 0; sub < 2; ++sub) {
      const int l = l0 + wih * 32 + sub * 16 + i15;
      const size_t n = (size_t)b * SEQ + l * dil + res;
#pragma unroll
      for (int dt = 0; dt < 4; ++dt) {
        const f32x4 y = st.O[sub][dt];
        u32x2 w; w.x = pk2(y.x, y.y); w.y = pk2(y.z, y.w);
        *(u32x2*)(p.dilo + ((size_t)gi * N_TOK + n) * 256 + h * 64 + 16 * dt + 4 * g4) = w;
      }
      if (g4 == 0) p.dill[((size_t)gi * N_TOK + n) * 4 + h] = st.m[sub] + __builtin_amdgcn_logf(st.l[sub]);
    }
  }
}

DEV void dil_combine(const Params& p, long long tid, long long nthr) {
  for (long long idx = tid; idx < (long long)N_TOK * 32; idx += nthr) {
    const size_t n = idx >> 5; const int c8 = (int)(idx & 31) * 8, h = c8 >> 6;
    const float l0 = p.dill[((size_t)0 * N_TOK + n) * 4 + h], l1 = p.dill[((size_t)1 * N_TOK + n) * 4 + h], l2 = p.dill[((size_t)2 * N_TOK + n) * 4 + h];
    const float mx = fmaxf(l0, fmaxf(l1, l2));
    float w0 = __builtin_amdgcn_exp2f(l0 - mx), w1 = __builtin_amdgcn_exp2f(l1 - mx), w2 = __builtin_amdgcn_exp2f(l2 - mx);
    const float inv = 1.0f / (w0 + w1 + w2);
    w0 *= inv; w1 *= inv; w2 *= inv;
    const u32x4 a = *(const u32x4*)(p.dilo + ((size_t)0 * N_TOK + n) * 256 + c8);
    const u32x4 bq = *(const u32x4*)(p.dilo + ((size_t)1 * N_TOK + n) * 256 + c8);
    const u32x4 c = *(const u32x4*)(p.dilo + ((size_t)2 * N_TOK + n) * 256 + c8);
    u32x4 o;
#pragma unroll
    for (int i = 0; i < 4; ++i) {
      const float lo = w0 * __uint_as_float(a[i] << 16) + w1 * __uint_as_float(bq[i] << 16) + w2 * __uint_as_float(c[i] << 16);
      const float hi = w0 * __uint_as_float(a[i] & 0xffff0000u) + w1 * __uint_as_float(bq[i] & 0xffff0000u) + w2 * __uint_as_float(c[i] & 0xffff0000u);
      o[i] = pk2(lo, hi);
    }
    *(u32x4*)(p.ya + n * YLD + c8) = o;
  }
}

DEV void cmpa_build(const Params& p, int li, long long tid, long long nthr) {
  for (long long idx = tid; idx < 2LL * CMP_ROWS * 256; idx += nthr) {
    const int which = (int)(idx / ((long long)CMP_ROWS * 256));
    const long long rem = idx % ((long long)CMP_ROWS * 256);
    const int row = (int)(rem >> 8), c8 = (int)(rem & 255) * 8, l = c8 >> 6, d = c8 & 63;
    const int g = row % NSA_G, c = (row / NSA_G) % N_CMP, b = row / (NSA_G * N_CMP);
    const float* pe = (which ? p.cmp_pe_v : p.cmp_pe_k) + (size_t)li * 32 * HD + l * HD + d;
    const u32x4 uv = *(const u32x4*)(p.u + ((size_t)b * SEQ + c * 16 + l) * N_IN + (which ? OFF_CVC : OFF_CKC) + g * HD + d);
    u32x4 o;
#pragma unroll
    for (int i = 0; i < 4; ++i) o[i] = pk2(__uint_as_float(uv[i] << 16) + pe[2 * i], __uint_as_float(uv[i] & 0xffff0000u) + pe[2 * i + 1]);
    *(u32x4*)(p.cmpA + ((size_t)which * CMP_ROWS_PAD + row) * 2048 + c8) = o;
  }
}

constexpr int XA_ROWB = 528;
constexpr int XA_TILEB = 32 * XA_ROWB;
static_assert(4 * XA_TILEB <= RING_BYTES, "xattn LDS map");
DEV void xattn_phase(const Params& p, LAS unsigned char* lds, int t32, int bid, int G) {
  const int lane = t32 & 63, wave = t32 >> 6, i15 = lane & 15, g4 = lane >> 4;
  const float sc2 = 0.0625f * 1.4426950408889634f;
  const bool xm = (G & 7) == 0;
  const int nun = xm ? XH * (SEQ / 128) : BATCH * XH * (SEQ / 128), ustep = xm ? (G >> 3) : G;
  for (int un = xm ? (bid >> 3) : bid; un < nun; un += ustep) {
    const int b = xm ? (bid & 7) : un / (XH * (SEQ / 128)), r = un % (XH * (SEQ / 128)), h = r / (SEQ / 128), qb = r % (SEQ / 128);
    const size_t nq = (size_t)b * SEQ + qb * 128 + wave * 16 + i15;
    bf16x8 qf[8];
#pragma unroll
    for (int kk = 0; kk < 8; ++kk) qf[kk] = *(const bf16x8*)(p.xq + nq * 1024 + h * 256 + kk * 32 + 8 * g4);
    f32x4 O[16];
#pragma unroll
    for (int dt = 0; dt < 16; ++dt) O[dt] = (f32x4){0.f, 0.f, 0.f, 0.f};
    float m = -INFINITY, l = 0.f;
    const int srow = t32 >> 4, sch = t32 & 15;
    const act_t* kbase = p.memk + ((size_t)b * MEM_LEN + srow) * 1024 + h * 256 + sch * 16;
    const act_t* vbase = p.memv + ((size_t)b * MEM_LEN + srow) * 1024 + h * 256 + sch * 16;
    u32x4 sk0 = *(const u32x4*)kbase, sk1 = *(const u32x4*)(kbase + 8), sv0 = *(const u32x4*)vbase, sv1 = *(const u32x4*)(vbase + 8);
    {
      LAS unsigned char* kd = lds + srow * XA_ROWB + sch * 32;
      *(LAS u32x4*)kd = sk0; *(LAS u32x4*)(kd + 16) = sk1;
      LAS unsigned char* vd = lds + 2 * XA_TILEB + srow * XA_ROWB + sch * 32;
      *(LAS u32x4*)vd = sv0; *(LAS u32x4*)(vd + 16) = sv1;
    }
    __syncthreads();
    for (int it = 0; it < MEM_LEN / 32; ++it) {
      if (it + 1 < MEM_LEN / 32) {
        const act_t* kr = kbase + (size_t)(it + 1) * 32 * 1024, *vr = vbase + (size_t)(it + 1) * 32 * 1024;
        sk0 = *(const u32x4*)kr; sk1 = *(const u32x4*)(kr + 8); sv0 = *(const u32x4*)vr; sv1 = *(const u32x4*)(vr + 8);
      }
      const LAS unsigned char* Kb = lds + (it & 1) * XA_TILEB;
      const LAS unsigned char* Vb = lds + (2 + (it & 1)) * XA_TILEB;
      f32x4 S[2];
      S[0] = (f32x4){0.f, 0.f, 0.f, 0.f}; S[1] = (f32x4){0.f, 0.f, 0.f, 0.f};
#pragma unroll
      for (int t = 0; t < 2; ++t)
#pragma unroll
        for (int kk = 0; kk < 8; ++kk) {
          const bf16x8 kf = *(const LAS bf16x8*)(Kb + (16 * t + i15) * XA_ROWB + (kk * 32 + 8 * g4) * 2);
          S[t] = __builtin_amdgcn_mfma_f32_16x16x32_bf16(kf, qf[kk], S[t], 0, 0, 0);
        }
      float mx = -INFINITY;
#pragma unroll
      for (int t = 0; t < 2; ++t)
#pragma unroll
        for (int j = 0; j < 4; ++j) { S[t][j] *= sc2; mx = fmaxf(mx, S[t][j]); }
      mx = fmaxf(mx, shx(mx, lane, 16));
      mx = fmaxf(mx, shx(mx, lane, 32));
      const float mnew = fmaxf(m, mx);
      const float corr = __builtin_amdgcn_exp2f(m - mnew);
      m = mnew;
      float psum = 0.f;
#pragma unroll
      for (int t = 0; t < 2; ++t)
#pragma unroll
        for (int j = 0; j < 4; ++j) { const float pp = __builtin_amdgcn_exp2f(S[t][j] - mnew); S[t][j] = pp; psum += pp; }
      l = l * corr + psum;
      u32x4 w;
      w.x = pk2(S[0][0], S[0][1]); w.y = pk2(S[0][2], S[0][3]); w.z = pk2(S[1][0], S[1][1]); w.w = pk2(S[1][2], S[1][3]);
      const bf16x8 pf = __builtin_bit_cast(bf16x8, w);
#pragma unroll
      for (int dt = 0; dt < 16; ++dt) {
        const LAS unsigned char* vp = Vb + (4 * g4 + (i15 >> 2)) * XA_ROWB + (16 * dt + 4 * (lane & 3)) * 2;
        const v4i16_t lo = tr_read(vp), hi = tr_read(vp + 16 * XA_ROWB);
        bf16x8 vf;
        vf[0] = lo[0]; vf[1] = lo[1]; vf[2] = lo[2]; vf[3] = lo[3]; vf[4] = hi[0]; vf[5] = hi[1]; vf[6] = hi[2]; vf[7] = hi[3];
        O[dt] = __builtin_amdgcn_mfma_f32_16x16x32_bf16(vf, pf, O[dt] * corr, 0, 0, 0);
      }
      if (it + 1 < MEM_LEN / 32) {
        LAS unsigned char* kd = lds + ((it + 1) & 1) * XA_TILEB + srow * XA_ROWB + sch * 32;
        *(LAS u32x4*)kd = sk0; *(LAS u32x4*)(kd + 16) = sk1;
        LAS unsigned char* vd = lds + (2 + ((it + 1) & 1)) * XA_TILEB + srow * XA_ROWB + sch * 32;
        *(LAS u32x4*)vd = sv0; *(LAS u32x4*)(vd + 16) = sv1;
      }
      __syncthreads();
    }
    l += shx(l, lane, 16);
    l += shx(l, lane, 32);
    const float inv = 1.0f / l;
#pragma unroll
    for (int dt = 0; dt < 16; ++dt) {
      const f32x4 y = O[dt] * inv;
      u32x2 w; w.x = pk2(y.x, y.y); w.y = pk2(y.z, y.w);
      *(u32x2*)(p.xo + nq * 1024 + h * 256 + 16 * dt + 4 * g4) = w;
    }
  }
}

DEV void route_phase(const Params& p, int li, int gw, int NGW, int lane) {
  const float* W = p.w_router + (size_t)li * D * NE;
  const int e = lane & 31, hf = lane >> 5;
  for (int n = gw; n < N_TOK; n += NGW) {
    const float* xr = p.xf + (size_t)n * D + hf * 512;
    const float* wr = W + (size_t)hf * 512 * NE + e;
    float a0 = 0.f, a1 = 0.f, a2 = 0.f, a3 = 0.f;
    for (int k = 0; k < 512; k += 4) {
      const f32x4 x = *(const f32x4*)(xr + k);
      a0 += x.x * wr[(size_t)k * NE]; a1 += x.y * wr[(size_t)(k + 1) * NE];
      a2 += x.z * wr[(size_t)(k + 2) * NE]; a3 += x.w * wr[(size_t)(k + 3) * NE];
    }
    float v = (a0 + a1) + (a2 + a3);
    v += shx(v, lane, 32);
    v += p.b_router[li * NE + e];
    int sel[4]; float sv[4];
    float cur = v;
#pragma unroll
    for (int k = 0; k < 4; ++k) {
      float bv = cur; int bi = e;
#pragma unroll
      for (int o = 1; o < 32; o <<= 1) {
        const float ov = shx(bv, lane, o); const int oi = shxi(bi, lane, o);
        if (ov > bv || (ov == bv && oi < bi)) { bv = ov; bi = oi; }
      }
      sel[k] = bi; sv[k] = bv;
      if (e == bi) cur = -INFINITY;
    }
    if (lane == 0) {
      const float e1 = expf(sv[1] - sv[0]), e2 = expf(sv[2] - sv[0]), e3 = expf(sv[3] - sv[0]);
      const float inv = 1.0f / (1.0f + e1 + e2 + e3);
      p.topg[n * 4 + 0] = inv; p.topg[n * 4 + 1] = e1 * inv; p.topg[n * 4 + 2] = e2 * inv; p.topg[n * 4 + 3] = e3 * inv;
#pragma unroll
      for (int k = 0; k < 4; ++k) { p.topi[n * 4 + k] = sel[k]; p.rank[n * 4 + k] = atomicAdd(&p.cnt[li * 32 + sel[k]], 1); }
    }
  }
}

DEV void kcv_phase(const Params& p, int li, long long tid, long long nthr) {
  for (long long i2 = tid; i2 < 2LL * CMP_ROWS * HD; i2 += nthr) {
    const int which = (int)(i2 / ((long long)CMP_ROWS * HD));
    const long long rem = i2 % ((long long)CMP_ROWS * HD);
    const int row = (int)(rem / HD), d = (int)(rem % HD);
    const float* w2 = (which ? p.cmp_w2_v : p.cmp_w2_k) + (size_t)li * CMP_HID * HD;
    const float* hr = p.hid + ((size_t)which * CMP_ROWS + row) * CMP_HID;
    float s = 0.f;
#pragma unroll 8
    for (int j = 0; j < CMP_HID; ++j) s += hr[j] * w2[j * HD + d];
    const int g_ = row % NSA_G, c_ = (row / NSA_G) % N_CMP, b_ = row / (NSA_G * N_CMP);
    p.kcb[((((size_t)which * BATCH + b_) * 128 + c_) * NSA_G + g_) * 64 + d] = f2bfh(s);
  }
}

constexpr int GA_QS = 272, GA_VS = 528, GA_PS = 144;
constexpr int GA_QT = 0, GA_KT = GA_QT + 64 * GA_QS, GA_KH = GA_KT + 64 * GA_QS, GA_VT = GA_KH + 64 * GA_QS, GA_PT = GA_VT + 64 * GA_VS,
              GA_LR = GA_PT + 64 * GA_PS, GA_GT = GA_LR + 64 * 16 * 4, GA_DC = GA_GT + 4 * 128 * 4, GA_END = GA_DC + 512;
static_assert(GA_END <= RING_BYTES, "GLA phase A LDS map");
constexpr int GC_SP = 0, GC_QT = GC_SP + 128 * GA_VS, GC_RED = GC_QT + 64 * GA_QS, GC_END = GC_RED + 8 * 16 * 4 * 2;
static_assert(GC_END <= RING_BYTES, "GLA phase C LDS map");

DEV void gla_a_unit(const Params& p, int li, LAS unsigned char* lds, int t32, int unit) {
  const int lane = t32 & 63, wave = t32 >> 6, i15 = lane & 15, g4 = lane >> 4;
  const int bh = unit >> 5, ci = unit & 31, b = bh >> 2, h = bh & 3;
  const int c = t32 & 127, jq = t32 >> 7;
  LAS float* LR = (LAS float*)(lds + GA_LR);
  LAS float* GT = (LAS float*)(lds + GA_GT);
  LAS float* DC = (LAS float*)(lds + GA_DC);
  const float qscale = 0.08838834764831845f;
  const size_t n0 = (size_t)b * SEQ + ci * 64;
  {
    const int e = t32 * 2, j = e >> 4, r = e & 15;
    const unsigned w = *(const unsigned*)(p.u + (n0 + j) * N_IN + OFF_LR + r);
    LR[e] = __uint_as_float(w << 16); LR[e + 1] = __uint_as_float(w & 0xffff0000u);
  }
  float wa[GLA_RANK];
#pragma unroll
  for (int r = 0; r < GLA_RANK; ++r) wa[r] = p.w_alpha2[((size_t)li * GLA_RANK + r) * B_K + h * 128 + c];
  const float ba = p.b_alpha[li * B_K + h * 128 + c];
  unsigned short qv[16], kv[16];
#pragma unroll
  for (int jj = 0; jj < 16; ++jj) {
    const act_t* ur = p.u + (n0 + jq * 16 + jj) * N_IN;
    qv[jj] = ur[OFF_BQ + h * 128 + c];
    kv[jj] = ur[OFF_BK + h * 128 + c];
  }
#pragma unroll
  for (int x = 0; x < 4; ++x) {
    const int idx = t32 + 512 * x, row = idx >> 5, ch = idx & 31;
    const u32x4 vv = *(const u32x4*)(p.u + (n0 + row) * N_IN + OFF_BV + h * 256 + ch * 8);
    *(LAS u32x4*)(lds + GA_VT + row * GA_VS + ch * 16) = vv;
  }
  __syncthreads();
  float bl[16];
  float run = 0.f;
#pragma unroll
  for (int jj = 0; jj < 16; ++jj) {
    const LAS f32x4* lr4 = (const LAS f32x4*)(LR + (jq * 16 + jj) * 16);
    float z = ba;
#pragma unroll
    for (int r4 = 0; r4 < 4; ++r4) { const f32x4 x = lr4[r4]; z += x.x * wa[4 * r4] + x.y * wa[4 * r4 + 1] + x.z * wa[4 * r4 + 2] + x.w * wa[4 * r4 + 3]; }
    const float ez = __builtin_amdgcn_exp2f(-fabsf(z) * 1.4426950408889634f);
    const float ls = (fminf(z, 0.f) - __builtin_amdgcn_logf(1.0f + ez) * 0.6931471805599453f) * (1.0f / 16.0f);
    run += ls; bl[jj] = run;
  }
  GT[jq * 128 + c] = run;
  __syncthreads();
  {
    const float g0 = GT[c], g1 = GT[128 + c], g2 = GT[256 + c], g3 = GT[384 + c];
    const float off = (jq > 0 ? g0 : 0.f) + (jq > 1 ? g1 : 0.f) + (jq > 2 ? g2 : 0.f);
    const float tot = (g0 + g1) + (g2 + g3);
    const float dtot = __builtin_amdgcn_exp2f(tot * 1.4426950408889634f);
    if (jq == 0) { DC[c] = dtot; p.gD[(size_t)unit * 128 + c] = dtot; }
#pragma unroll
    for (int jj = 0; jj < 16; ++jj) {
      const float e1 = __builtin_amdgcn_exp2f((off + bl[jj]) * 1.4426950408889634f), ie = __builtin_amdgcn_rcpf(e1);
      const float qf = __uint_as_float(((unsigned)qv[jj]) << 16), kf = __uint_as_float(((unsigned)kv[jj]) << 16);
      const int ro = (jq * 16 + jj) * GA_QS + c * 2;
      const unsigned short qt = f2bfh(qf * e1 * qscale);
      *(LAS unsigned short*)(lds + GA_QT + ro) = qt;
      p.gQ[((size_t)unit * 64 + jq * 16 + jj) * 128 + c] = qt;
      *(LAS unsigned short*)(lds + GA_KT + ro) = f2bfh(kf * ie);
      *(LAS unsigned short*)(lds + GA_KH + ro) = f2bfh(kf * ie * dtot);
    }
  }
  __syncthreads();
#pragma unroll
  for (int q = 0; q < 2; ++q) {
    const int id = wave * 2 + q, jt = id >> 2, it = id & 3;
    f32x4 a = (f32x4){0.f, 0.f, 0.f, 0.f};
#pragma unroll
    for (int kk = 0; kk < 4; ++kk) {
      const bf16x8 kf = *(const LAS bf16x8*)(lds + GA_KT + (16 * jt + i15) * GA_QS + (32 * kk + 8 * g4) * 2);
      const bf16x8 qf = *(const LAS bf16x8*)(lds + GA_QT + (16 * it + i15) * GA_QS + (32 * kk + 8 * g4) * 2);
      a = __builtin_amdgcn_mfma_f32_16x16x32_bf16(kf, qf, a, 0, 0, 0);
    }
    const int i = 16 * it + i15, j0 = 16 * jt + 4 * g4;
    u32x2 w;
    w.x = pk2(j0 <= i ? a.x : 0.f, j0 + 1 <= i ? a.y : 0.f);
    w.y = pk2(j0 + 2 <= i ? a.z : 0.f, j0 + 3 <= i ? a.w : 0.f);
    *(LAS u32x2*)(lds + GA_PT + i * GA_PS + j0 * 2) = w;
  }
  __syncthreads();
  {
    const int it = wave & 3, vt0 = (wave >> 2) * 8;
    bf16x8 pf[2];
#pragma unroll
    for (int s = 0; s < 2; ++s) pf[s] = *(const LAS bf16x8*)(lds + GA_PT + (16 * it + i15) * GA_PS + (32 * s + 8 * g4) * 2);
#pragma unroll
    for (int x = 0; x < 8; ++x) {
      const int vt = vt0 + x;
      f32x4 a = (f32x4){0.f, 0.f, 0.f, 0.f};
#pragma unroll
      for (int s = 0; s < 2; ++s) {
        const LAS unsigned char* vp = lds + GA_VT + (32 * s + 8 * g4 + (i15 >> 2)) * GA_VS + (16 * vt + 4 * (lane & 3)) * 2;
        const v4i16_t lo = tr_read(vp), hi = tr_read(vp + 4 * GA_VS);
        bf16x8 vf;
        vf[0] = lo[0]; vf[1] = lo[1]; vf[2] = lo[2]; vf[3] = lo[3]; vf[4] = hi[0]; vf[5] = hi[1]; vf[6] = hi[2]; vf[7] = hi[3];
        a = __builtin_amdgcn_mfma_f32_16x16x32_bf16(vf, pf[s], a, 0, 0, 0);
      }
      *(f32x4*)(p.opart + (n0 + 16 * it + i15) * 1024 + h * 256 + 16 * vt + 4 * g4) = a;
    }
  }
  {
    bf16x8 vf[2][2];
#pragma unroll
    for (int x = 0; x < 2; ++x)
#pragma unroll
      for (int s = 0; s < 2; ++s) {
        const LAS unsigned char* vp = lds + GA_VT + (32 * s + 8 * g4 + (i15 >> 2)) * GA_VS + (16 * (2 * wave + x) + 4 * (lane & 3)) * 2;
        const v4i16_t lo = tr_read(vp), hi = tr_read(vp + 4 * GA_VS);
        vf[x][s][0] = lo[0]; vf[x][s][1] = lo[1]; vf[x][s][2] = lo[2]; vf[x][s][3] = lo[3];
        vf[x][s][4] = hi[0]; vf[x][s][5] = hi[1]; vf[x][s][6] = hi[2]; vf[x][s][7] = hi[3];
      }
#pragma unroll
    for (int ct = 0; ct < 8; ++ct) {
      f32x4 a0 = (f32x4){0.f, 0.f, 0.f, 0.f}, a1 = (f32x4){0.f, 0.f, 0.f, 0.f};
#pragma unroll
      for (int s = 0; s < 2; ++s) {
        const LAS unsigned char* kp = lds + GA_KH + (32 * s + 8 * g4 + (i15 >> 2)) * GA_QS + (16 * ct + 4 * (lane & 3)) * 2;
        const v4i16_t lo = tr_read(kp), hi = tr_read(kp + 4 * GA_QS);
        bf16x8 kf;
        kf[0] = lo[0]; kf[1] = lo[1]; kf[2] = lo[2]; kf[3] = lo[3]; kf[4] = hi[0]; kf[5] = hi[1]; kf[6] = hi[2]; kf[7] = hi[3];
        a0 = __builtin_amdgcn_mfma_f32_16x16x32_bf16(vf[0][s], kf, a0, 0, 0, 0);
        a1 = __builtin_amdgcn_mfma_f32_16x16x32_bf16(vf[1][s], kf, a1, 0, 0, 0);
      }
      act_t* up = p.gU + ((size_t)unit * 128 + 16 * ct + i15) * 256 + 32 * wave + 4 * g4;
      u32x2 w0; w0.x = pk2(a0.x, a0.y); w0.y = pk2(a0.z, a0.w);
      u32x2 w1; w1.x = pk2(a1.x, a1.y); w1.y = pk2(a1.z, a1.w);
      *(u32x2*)up = w0; *(u32x2*)(up + 16) = w1;
    }
  }
  __syncthreads();
}

DEV void gla_scan(const Params& p, long long tid, long long nthr) {
  for (long long idx = tid; idx < 32LL * 128 * 32; idx += nthr) {
    const int v8 = (int)(idx & 31) * 8, c = (int)((idx >> 5) & 127), bh = (int)(idx >> 12);
    float s[8];
#pragma unroll
    for (int i = 0; i < 8; ++i) s[i] = 0.f;
#pragma unroll 4
    for (int ci = 0; ci < 32; ++ci) {
      const size_t unit = (size_t)bh * 32 + ci;
      const u32x4 uw = *(const u32x4*)(p.gU + (unit * 128 + c) * 256 + v8);
      const float d = p.gD[unit * 128 + c];
      u32x4 o;
#pragma unroll
      for (int i = 0; i < 4; ++i) o[i] = pk2(s[2 * i], s[2 * i + 1]);
      *(u32x4*)(p.gS + (unit * 128 + c) * 256 + v8) = o;
#pragma unroll
      for (int i = 0; i < 4; ++i) {
        s[2 * i] = s[2 * i] * d + __uint_as_float(uw[i] << 16);
        s[2 * i + 1] = s[2 * i + 1] * d + __uint_as_float(uw[i] & 0xffff0000u);
      }
    }
  }
}

DEV void gla_c_unit(const Params& p, int li, LAS unsigned char* lds, int t32, int unit) {
  const int lane = t32 & 63, wave = t32 >> 6, i15 = lane & 15, g4 = lane >> 4;
  const int bh = unit >> 5, ci = unit & 31, b = bh >> 2, h = bh & 3;
  const size_t n0 = (size_t)b * SEQ + ci * 64;
#pragma unroll
  for (int x = 0; x < 8; ++x) {
    const int idx = t32 + 512 * x, row = idx >> 5, ch = idx & 31;
    *(LAS u32x4*)(lds + GC_SP + row * GA_VS + ch * 16) = *(const u32x4*)(p.gS + ((size_t)unit * 128 + row) * 256 + ch * 8);
  }
#pragma unroll
  for (int x = 0; x < 2; ++x) {
    const int idx = t32 + 512 * x, row = idx >> 4, ch = idx & 15;
    *(LAS u32x4*)(lds + GC_QT + row * GA_QS + ch * 16) = *(const u32x4*)(p.gQ + ((size_t)unit * 64 + row) * 128 + ch * 8);
  }
  __syncthreads();
  const int it = wave & 3, vt0 = (wave >> 2) * 8;
  bf16x8 qf[4];
#pragma unroll
  for (int kk = 0; kk < 4; ++kk) qf[kk] = *(const LAS bf16x8*)(lds + GC_QT + (16 * it + i15) * GA_QS + (32 * kk + 8 * g4) * 2);
  const size_t n = n0 + 16 * it + i15;
  f32x4 o[8];
  float ss = 0.f;
#pragma unroll
  for (int x = 0; x < 8; ++x) {
    const int vt = vt0 + x;
    f32x4 a = *(const f32x4*)(p.opart + n * 1024 + h * 256 + 16 * vt + 4 * g4);
#pragma unroll
    for (int kk = 0; kk < 4; ++kk) {
      const LAS unsigned char* sp = lds + GC_SP + (32 * kk + 8 * g4 + (i15 >> 2)) * GA_VS + (16 * vt + 4 * (lane & 3)) * 2;
      const v4i16_t lo = tr_read(sp), hi = tr_read(sp + 4 * GA_VS);
      bf16x8 sf;
      sf[0] = lo[0]; sf[1] = lo[1]; sf[2] = lo[2]; sf[3] = lo[3]; sf[4] = hi[0]; sf[5] = hi[1]; sf[6] = hi[2]; sf[7] = hi[3];
      a = __builtin_amdgcn_mfma_f32_16x16x32_bf16(sf, qf[kk], a, 0, 0, 0);
    }
    o[x] = a;
    ss += (a.x * a.x + a.y * a.y) + (a.z * a.z + a.w * a.w);
  }
  ss += shx(ss, lane, 16);
  ss += shx(ss, lane, 32);
  LAS float* RED = (LAS float*)(lds + GC_RED);
  if (g4 == 0) RED[wave * 16 + i15] = ss;
  __syncthreads();
  ss += RED[(wave ^ 4) * 16 + i15];
  const float rs = 1.0f / sqrtf(ss * (1.0f / 256.0f) + LN_EPS);
#pragma unroll
  for (int x = 0; x < 8; ++x) {
    const int v = 16 * (vt0 + x) + 4 * g4;
    const f32x4 gn = *(const f32x4*)(p.gla_norm_g + li * DV + v);
    const u32x2 rw = *(const u32x2*)(p.u + n * N_IN + OFF_BR + h * 256 + v);
    const float r0 = __uint_as_float(rw.x << 16), r1 = __uint_as_float(rw.x & 0xffff0000u), r2 = __uint_as_float(rw.y << 16), r3 = __uint_as_float(rw.y & 0xffff0000u);
    u32x2 w;
    w.x = pk2(o[x].x * rs * gn.x * (r0 * sigmoidf_(r0)), o[x].y * rs * gn.y * (r1 * sigmoidf_(r1)));
    w.y = pk2(o[x].z * rs * gn.z * (r2 * sigmoidf_(r2)), o[x].w * rs * gn.w * (r3 * sigmoidf_(r3)));
    *(u32x2*)(p.yb + n * YLD + h * 256 + v) = w;
  }
  __syncthreads();
}

#define XB_TMO      128
#define XB_XCNT(j)  (256  + 64 * (j))
#define XB_XSUB(j)  (1280 + 64 * (j))
#define XB_XGEN(j)  (2304 + 64 * (j))
#define XB_TOP      3328
#define XB_TOPGEN   3392
#define XCD_BAR_WORDS 3456
#define XB_SPIN_CAP (1u << 18)

__device__ __forceinline__ unsigned xb_ld(unsigned* p)              { return __hip_atomic_load(p, __ATOMIC_RELAXED, __HIP_MEMORY_SCOPE_AGENT); }
__device__ __forceinline__ unsigned xb_add(unsigned* p, unsigned v) { return __hip_atomic_fetch_add(p, v, __ATOMIC_RELAXED, __HIP_MEMORY_SCOPE_AGENT); }
__device__ __forceinline__ unsigned xb_xcc_id() { return (unsigned)__builtin_amdgcn_s_getreg((3 << 11) | 20) & 0xFu; }
#define XB_SPIN(cond, bar) do { unsigned _sp = 0; while (cond) { __builtin_amdgcn_s_sleep(1); \
    if ((++_sp & 255u) == 0u) { if (xb_ld(&(bar)[XB_TMO])) break; if (_sp > XB_SPIN_CAP) { atomicAdd(&(bar)[XB_TMO], 1u); break; } } } } while (0)

struct XcdBarrier {
    unsigned* bar; unsigned x;
    volatile LAS unsigned* st;
};

__device__ __forceinline__ XcdBarrier xcd_barrier_post(unsigned* bar, volatile LAS unsigned* st) {
    XcdBarrier b; b.bar = bar; b.x = xb_xcc_id(); b.st = st;
    if (threadIdx.x == 0) st[2] = xb_add(&bar[XB_XCNT(b.x)], 1u);
    return b;
}
__device__ __forceinline__ void xcd_barrier_complete(unsigned* bar, unsigned x, unsigned& nloc, unsigned& nx) {
    const unsigned G = gridDim.x * gridDim.y * gridDim.z;
    unsigned sum, cnt, mine, sp = 0u;
    for (;;) {
        sum = 0u; cnt = 0u; mine = 0u;
#pragma unroll
        for (unsigned j = 0; j < 16; ++j) { const unsigned c = xb_ld(&bar[XB_XCNT(j)]); sum += c; cnt += (c > 0u) ? 1u : 0u; mine = (j == x) ? c : mine; }
        if (sum == G) break;
        __builtin_amdgcn_s_sleep(1);
        if ((++sp & 255u) == 0u) { if (xb_ld(&bar[XB_TMO])) break; if (sp > XB_SPIN_CAP) { atomicAdd(&bar[XB_TMO], 1u); break; } }
    }
    nloc = mine > 0u ? mine : 1u; nx = cnt > 0u ? cnt : 1u;
}

__device__ __forceinline__ void xcd_barrier(const XcdBarrier& b, const int t32) {
    asm volatile("s_waitcnt vmcnt(0)" ::: "memory");
    __syncthreads();
    if (t32 == 0) {
        unsigned* bar = b.bar;
        __builtin_amdgcn_s_waitcnt(0);
        unsigned nloc = b.st[0], nx = b.st[1];
        if (nloc == 0u) { xcd_barrier_complete(bar, b.x, nloc, nx); b.st[0] = nloc; b.st[1] = nx; }
        const unsigned old = xb_add(&bar[XB_XSUB(b.x)], 1u);
        const unsigned gen = old / nloc;
        if (old + 1u == (gen + 1u) * nloc) {
            __builtin_amdgcn_fence(__ATOMIC_RELEASE, "agent");
            asm volatile("s_waitcnt vmcnt(0)" ::: "memory");
            const unsigned og = xb_add(&bar[XB_TOP], 1u);
            const unsigned tg = og / nx;
            if (og + 1u == (tg + 1u) * nx) xb_add(&bar[XB_TOPGEN], 1u);
            else XB_SPIN(xb_ld(&bar[XB_TOPGEN]) == tg, bar);
            __builtin_amdgcn_fence(__ATOMIC_ACQUIRE, "agent");
            xb_add(&bar[XB_XGEN(b.x)], 1u);
            asm volatile("s_waitcnt vmcnt(0)" ::: "memory");
        } else {
            XB_SPIN(xb_ld(&bar[XB_XGEN(b.x)]) == gen, bar);
            __builtin_amdgcn_fence(__ATOMIC_ACQUIRE, "agent");
            asm volatile("s_waitcnt vmcnt(0)" ::: "memory");
        }
    }
    __syncthreads();
}

constexpr int STEPS_PER_LAYER = 25;
#ifndef PROBE_LO
#define PROBE_LO -1
#define PROBE_HI -1
#endif
#ifndef PROBE_PRO
#define PROBE_PRO 0
#endif
#ifndef NSA_PROBE
#define NSA_PROBE 0
#endif
#ifndef MULTI_LAUNCH
#define MULTI_LAUNCH 0
#endif
DEV int fresh_t32(int wave) {
  int t;
  asm volatile("v_mbcnt_lo_u32_b32 %0, -1, 0\n\tv_mbcnt_hi_u32_b32 %0, -1, %0" : "=v"(t));
  return t + wave * 64;
}
struct KArgs { void* in[35]; void* out; void* ws; };
template <bool WITH_NAIVE, bool COOP>
__global__ void __launch_bounds__(NTHREADS) k_mega(KArgs ka, int step_lo, int step_hi) {
  unsigned* const barw0 = ((unsigned*)ka.ws);
  extern __shared__ __attribute__((aligned(16))) unsigned char lds_raw[];
  LAS unsigned char* lds = (LAS unsigned char*)lds_raw;
  LAS int* tab = (LAS int*)(lds + MISC_OFF);
  const int wave = __builtin_amdgcn_readfirstlane(threadIdx.x >> 6);
  const int G = gridDim.x;
  int bid = blockIdx.x;

  LAS unsigned* miscw = (LAS unsigned*)(lds + MISC_OFF + 8192);
  if (threadIdx.x < 64) miscw[threadIdx.x] = 0u;
  __syncthreads();
  XcdBarrier xbar; xbar.bar = barw0; xbar.x = 0; xbar.st = nullptr;
  if (COOP) xbar = xcd_barrier_post(barw0, miscw + 8);
  if (step_lo < 0) {
    Params p;
    fill_params(p, ka.in, ka.out, ka.ws);
    prologue(p, lds, wave, threadIdx.x & 63);
    if (COOP) cg::this_grid().sync();
#if PROBE_PRO
    prologue(p, lds, wave, threadIdx.x & 63);
    if (COOP) cg::this_grid().sync();
#endif
    step_lo = 0;
    if (COOP) {
      bool even = (G % 8) == 0;
#pragma unroll
      for (int j = 0; j < 8; ++j) even = even && (xb_ld(&barw0[XB_XCNT(j)]) == (unsigned)(G / 8));
      __syncthreads();
      if (even) bid = __builtin_amdgcn_readfirstlane((int)(xbar.x + 8u * miscw[10]));
    }
  }
  int rep_done = 0;
  for (int step = step_lo; step < step_hi;) {
    int li = step / STEPS_PER_LAYER;
    const int k = step % STEPS_PER_LAYER;
    int nb32 = gridDim.x;
    char* wsb = (char*)ka.ws;
    asm volatile("" : "+s"(wsb));
    Params p;
    fill_params(p, ka.in, ka.out, wsb);
    asm volatile("" : "+s"(li));
    asm volatile("" : "+s"(nb32));
#define T32() fresh_t32(wave)
#define TID() ((int)(blockIdx.x * NTHREADS) + T32())
    const int nthr = nb32 * NTHREADS;
    const int gw = blockIdx.x * 8 + wave, NGW = nb32 * 8;
    const bool is_gemm = (k == 0) || (k == 2) || (k == 3) || (k == 9) || (k == 10) || (k >= 12 && k <= 14) || (k == 17) || (k == 22) || (k == 23);
    const bool sync_after = !(k == 2 || k == 7 || k == 8 || k == 12 || k == 13 || k == 16 || k == 20);
    if (is_gemm) {
      pg8::Gemm g{nullptr, nullptr, 0, 0, 0};
      USched S; S.init_static(256, 256, G, bid);
      EpiU E{0, 0, nullptr, nullptr, nullptr, nullptr, nullptr, nullptr, nullptr};
      const size_t WSQ = (size_t)1024 * 1024;
      switch (k) {
        case 0:
          g = pg8::Gemm{p.xb, p.wt_in + (size_t)li * N_IN_PAD * 1024, N_TOK, N_IN_PAD, 1024};
          S.init_static(N_TOK, N_IN_PAD, G, bid);
          E.mode = EM_INPROJ; E.ob = p.u; E.f0 = p.b_in + (size_t)li * N_IN; break;
        case 2:
          g = pg8::Gemm{p.cmpA, p.wt_c1 + (size_t)(li * 2 + 0) * 256 * 2048, CMP_ROWS_PAD, 256, 2048};
          S.init_static(CMP_ROWS_PAD, 256, G, bid);
          E.mode = EM_HID; E.of = p.hid; break;
        case 3:
          g = pg8::Gemm{p.cmpA + (size_t)CMP_ROWS_PAD * 2048, p.wt_c1 + (size_t)(li * 2 + 1) * 256 * 2048, CMP_ROWS_PAD, 256, 2048};
          S.init_static(CMP_ROWS_PAD, 256, G, (bid + G - 16) % G);
          E.mode = EM_HID; E.of = p.hid + (size_t)CMP_ROWS * CMP_HID; break;
        case 9:
          g = pg8::Gemm{p.ya, p.wt_bra + (size_t)li * 1024 * YLD, N_TOK, 1024, YLD};
          S.init_static(N_TOK, 1024, G, bid);
          E.mode = EM_BRCAT; E.ub = p.u; E.ob = p.merged; break;
        case 10:
          g = pg8::Gemm{p.merged, p.wt_omix + li * WSQ, N_TOK, 1024, 1024};
          S.init_static(N_TOK, 1024, G, bid);
          E.mode = EM_RES; E.f0 = p.xf; E.of = p.tmp; break;
        case 12:
          g = pg8::Gemm{p.xb, p.wt_xq + li * WSQ, N_TOK, 1024, 1024};
          S.init_static(N_TOK, 1024, G, bid);
          E.mode = EM_BF16; E.ob = p.xq; E.ldc = 1024; break;
        case 13:
          g = pg8::Gemm{p.membf, p.wt_xk + li * WSQ, BATCH * MEM_LEN, 1024, 1024};
          S.init_static(BATCH * MEM_LEN, 1024, G, bid);
          E.mode = EM_BF16; E.ob = p.memk; E.ldc = 1024; break;
        case 14:
          g = pg8::Gemm{p.membf, p.wt_xv + li * WSQ, BATCH * MEM_LEN, 1024, 1024};
          S.init_static(BATCH * MEM_LEN, 1024, G, (bid + 128) % G);
          E.mode = EM_BF16; E.ob = p.memv; E.ldc = 1024; break;
        case 17:
          g = pg8::Gemm{p.xo, p.wt_xo + li * WSQ, N_TOK, 1024, 1024};
          S.init_static(N_TOK, 1024, G, bid);
          E.mode = EM_RES; E.f0 = p.xf; E.of = p.tmp; break;
        case 22: {
          const int ntiles = moe_tables(p, li, tab, T32());
          g = pg8::Gemm{p.xg, p.wt_gu + (size_t)li * 32 * 2048 * 1024, MOE_ROWS, 32 * 2048, 1024};
          S.init_moe(G, bid, 8, ntiles * 8, tab + 128);
          E.mode = EM_MOE1; E.ob = p.actg; E.f0 = p.b_gu + (size_t)li * 32 * 2048; E.te = tab + 128; break; }
        default: {
          const int ntiles = moe_tables(p, li, tab, T32());
          g = pg8::Gemm{p.actg, p.wt_dn + (size_t)li * 32 * 1024 * 1024, MOE_ROWS, 32 * 1024, 1024};
          S.init_moe(G, bid, 4, ntiles * 4, tab + 128);
          E.mode = EM_MOE2; E.of = p.yass; E.f0 = p.b_down + (size_t)li * 32 * 1024; E.f1 = p.topg; E.il = p.rowlist; E.te = tab + 128; break; }
      }
      pg8::gemm_phase<EpiU, USched, true, true>(lds, g, S, E, T32());
    } else {
      switch (k) {
        case 1: cmpa_build(p, li, TID(), nthr); break;
        case 4:
          { const int t = T32(); for (int un = bid; un < 1024; un += G) gla_a_unit(p, li, lds, t, un); }
          dil_phase(p, lds, T32(), bid, G);
          kcv_phase(p, li, TID(), nthr);
          break;
        case 5: gla_scan(p, TID(), nthr); nsa_cmp_phase(p, lds, T32(), bid, G); dil_combine(p, TID(), nthr); break;
        case 6: {
          nsa_main_phase(p, lds, T32(), bid, G);
#if NSA_PROBE == 4
          nsa_main_phase(p, lds, T32(), bid, G);
#endif
          const int t = T32();
          for (int un = bid; un < 1024; un += G) gla_c_unit(p, li, lds, t, un);
#if NSA_PROBE == 3
          for (int un = bid; un < 1024; un += G) gla_c_unit(p, li, lds, t, un);
#endif
          break; }
        case 11: ln_rows_w<0>(p, p.tmp, p.ln1_g + li * D, p.ln1_b + li * D, p.xf, p.xb, nullptr, gw, NGW, T32() & 63); break;
        case 18: ln_rows_w<0>(p, p.tmp, p.ln2_g + li * D, p.ln2_b + li * D, p.xf, p.xb, nullptr, gw, NGW, T32() & 63); break;
        case 21: { const int t = T32(); moe_prep(p, li, tab, wave, t & 63, t); break; }
        case 24: ln_rows_w<1>(p, nullptr, p.ln3_g + li * D, p.ln3_b + li * D, p.xf, p.xb, li == DEPTH - 1 ? p.out : nullptr, gw, NGW, T32() & 63); break;
        case 15: xattn_phase(p, lds, T32(), bid, G); break;
        case 19: route_phase(p, li, gw, NGW, T32() & 63); break;
        default: break;
      }
    }
    if (COOP && sync_after) xcd_barrier(xbar, T32());
    if (PROBE_HI >= 0 && k == PROBE_HI && !rep_done) { rep_done = 1; step -= (PROBE_HI - PROBE_LO); }
    else { if (k == PROBE_HI) rep_done = 0; ++step; }
  }
}

extern "C" void kernel_launch(void* const* d_in, const int* in_sizes, int n_in, void* d_out, int out_size,
                              void* d_ws, size_t ws_size, hipStream_t stream) {
  Params p;
  memset(&p, 0, sizeof(p));
  fill_params(p, d_in, d_out, d_ws);
  KArgs ka;
  memset(&ka, 0, sizeof(ka));
  for (int i = 0; i < 35; ++i) ka.in[i] = d_in[i];
  ka.out = d_out; ka.ws = d_ws;
  static int grid_blocks = 0;
  if (!grid_blocks) {
    int dev = 0, cus = 0;
    hipGetDevice(&dev);
    hipDeviceGetAttribute(&cus, hipDeviceAttributeMultiprocessorCount, dev);
    hipFuncSetAttribute((const void*)k_mega<true, true>, hipFuncAttributeMaxDynamicSharedMemorySize, LDS_BYTES);
    if (p.ws_used > ws_size) fprintf(stderr, "workspace too small: need %zu have %zu\n", p.ws_used, ws_size);
    grid_blocks = cus;
  }
  hipMemsetAsync(p.barw, 0, 4096 * sizeof(unsigned), stream);
  int lo = -1, hi = DEPTH * STEPS_PER_LAYER;
  void* args[] = {&ka, &lo, &hi};
  hipError_t e = hipLaunchCooperativeKernel((void*)k_mega<true, true>, dim3(grid_blocks), dim3(NTHREADS), args, LDS_BYTES, stream);
  if (e != hipSuccess) fprintf(stderr, "cooperative launch failed: %s (grid %d)\n", hipGetErrorString(e), grid_blocks);
}
#endif
```

```cpp
#ifndef CPU_TEST
#include <hip/hip_runtime.h>
#include <hip/hip_cooperative_groups.h>
#include <cstdio>
#include <cstring>
#include <cmath>
namespace cg = cooperative_groups;
#define DEV __device__ __forceinline__
#define HDI __host__ __device__ __forceinline__
#else
#include <cmath>
#include <cstdio>
#include <cstdlib>
#include <cstring>
#define DEV static inline
#define HDI static inline
#endif

#ifndef D_MODEL
#define D_MODEL 1024
#endif
#ifndef BATCH
#define BATCH 8
#endif
#ifndef MEGA
#define MEGA 1
#endif

constexpr int D = D_MODEL;
constexpr int SEQ = 2048;
constexpr int DEPTH = 2;
constexpr int MEM_LEN = 256;
constexpr int HD = 64;
constexpr int N_TOK = BATCH * SEQ;
constexpr int GLA_H = 4;
constexpr int DK = D / 2 / GLA_H;
constexpr int DV = D / GLA_H;
constexpr int GLA_RANK = 16;
constexpr int B_K = GLA_H * DK;
constexpr int B_V = GLA_H * DV;
constexpr int NSA_H = 16;
constexpr int NSA_G = 4;
constexpr int N_CMP = 127;
constexpr int CMP_HID = 128;
constexpr int N_BLK = 32;
constexpr int N_SELECT = 16;
constexpr int NSA_WIN = 512;
constexpr int XH = 4;
constexpr int XHD = D / XH;
constexpr int NE = 32;
constexpr int TOPK = 4;
constexpr int DFF = D;
constexpr float LN_EPS = 1e-5f;
constexpr float ALPHA = 1.41421356237309515f;

constexpr int OFF_AQ = 0;
constexpr int OFF_AK = 768;
constexpr int OFF_AV = 1536;
constexpr int OFF_BQ = 2304;
constexpr int OFF_BK = OFF_BQ + B_K;
constexpr int OFF_BV = OFF_BK + B_K;
constexpr int OFF_BR = OFF_BV + B_V;
constexpr int OFF_LR = OFF_BR + B_V;
constexpr int OFF_CQ = OFF_LR + GLA_RANK;
constexpr int OFF_CKC = OFF_CQ + 1024;
constexpr int OFF_CVC = OFF_CKC + 256;
constexpr int OFF_CKS = OFF_CVC + 256;
constexpr int OFF_CVS = OFF_CKS + 256;
constexpr int OFF_CKW = OFF_CVS + 256;
constexpr int OFF_CVW = OFF_CKW + 256;
constexpr int OFF_CG = OFF_CVW + 256;
constexpr int OFF_MG = OFF_CG + 48;
constexpr int N_IN = OFF_MG + 3 * D;
constexpr int N_IN_PAD = (N_IN + 255) / 256 * 256;
constexpr int MOE_ROWS = N_TOK * 4 + 32 * 256;
constexpr int CMP_ROWS_PAD = 4096;
constexpr int YLD = 256 + 1024 + 1024;

#ifdef CPU_TEST
typedef float act_t;
DEV float ldf(float v) { return v; }
DEV void stf(float* p, float v) { *p = v; }
#else
typedef unsigned short act_t;
DEV float ldf(unsigned short h) { return __uint_as_float(((unsigned)h) << 16); }
DEV float ldf(float v) { return v; }
DEV unsigned short f2bf(float f) {
  unsigned u = __float_as_uint(f);
  u += 0x7fffu + ((u >> 16) & 1u);
  return (unsigned short)(u >> 16);
}
DEV void stf(unsigned short* p, float v) { *p = f2bf(v); }
DEV void stf(float* p, float v) { *p = v; }
#endif

struct Params {
  const float *x, *mem, *ln0_g, *ln0_b, *w_in, *b_in, *w_alpha2, *b_alpha, *gla_norm_g,
      *cmp_pe_k, *cmp_w1_k, *cmp_w2_k, *cmp_pe_v, *cmp_w1_v, *cmp_w2_v,
      *w_br_a, *w_br_b, *w_br_c, *w_o_mix, *ln1_g, *ln1_b, *w_xq, *w_xk, *w_xv, *w_xo, *ln2_g, *ln2_b,
      *w_router, *b_router, *w_gu, *b_gu, *w_down, *b_down, *ln3_g, *ln3_b;
  float* out;
  float* xf;
  act_t* xb;
  act_t* u;
  float* ga;
  float* hid;
  float* kcv;
  float* opart;
  act_t* ya;
  act_t* yb;
  act_t* yc;
  float* pcmp;
  float* ocmp;
  float* impb;
  int* selb;
  act_t* merged;
  float* tmp;
  act_t* xq;
  act_t* memk;
  act_t* memv;
  float* xs;
  act_t* xo;
  float* rl;
  int* topi;
  float* topg;
  act_t* act;
  act_t* wt_in;
  act_t* wt_c1;
  act_t* wt_bra;
  act_t* wt_brb;
  act_t* wt_brc;
  act_t* wt_omix;
  act_t* wt_xq;
  act_t* wt_xk;
  act_t* wt_xv;
  act_t* wt_xo;
  act_t* wt_gu;
  act_t* wt_dn;
  act_t* membf;
  act_t* cmpA;
  float* mrg;
  int* cnt;
  int* rank;
  int* rowlist;
  act_t* xg;
  act_t* actg;
  float* yass;
  act_t* kcb;
  act_t* dilo;
  float* dill;
  unsigned* selm;
  act_t* gU;
  act_t* gS;
  act_t* gQ;
  float* gD;
  unsigned* barw;
  size_t ws_used;
};

#ifdef CPU_TEST
#define FOR_IDX(idx, total) \
  for (long long idx = (long long)(total) * tid / nthr, _e = (long long)(total) * (tid + 1) / nthr; idx < _e; ++idx)
#else
#define FOR_IDX(idx, total) for (long long idx = tid; idx < (long long)(total); idx += nthr)
#endif

DEV float sigmoidf_(float x) { return 1.0f / (1.0f + expf(-x)); }

template <class TA>
DEV float dotcol(const TA* a, const float* W, int K, long long ldw) {
  float s = 0.f;
  for (int k = 0; k < K; ++k) s += ldf(a[k]) * W[(long long)k * ldw];
  return s;
}

DEV void ph_ln(const float* src, const float* g, const float* b, float* dstf, act_t* dstb, float* dst2,
               long long tid, long long nthr) {
  FOR_IDX(n, N_TOK) {
    const float* r = src + n * D;
    float mu = 0.f;
    for (int i = 0; i < D; ++i) mu += r[i];
    mu /= D;
    float var = 0.f;
    for (int i = 0; i < D; ++i) { float d = r[i] - mu; var += d * d; }
    var /= D;
    float rs = 1.0f / sqrtf(var + LN_EPS);
    for (int i = 0; i < D; ++i) {
      float y = (r[i] - mu) * rs * g[i] + b[i];
      dstf[n * D + i] = y;
      stf(&dstb[n * D + i], y);
      if (dst2) dst2[n * D + i] = y;
    }
  }
}

DEV void ph_inproj(const Params& p, int li, long long tid, long long nthr) {
  const float* W = p.w_in + (long long)li * D * N_IN;
  const float* bias = p.b_in + (long long)li * N_IN;
  FOR_IDX(idx, (long long)N_TOK * N_IN) {
    long long n = idx / N_IN; int c = (int)(idx % N_IN);
    stf(&p.u[idx], dotcol(p.xb + n * D, W + c, D, N_IN) + bias[c]);
  }
}

DEV float gelu_tanh(float x) {
  return 0.5f * x * (1.0f + tanhf(0.7978845608028654f * (x + 0.044715f * x * x * x)));
}

constexpr int CMP_ROWS = BATCH * N_CMP * NSA_G;

template <int PARTS>
DEV void ph_pre(const Params& p, int li, long long tid, long long nthr) {
  const long long T1 = (long long)N_TOK * B_K;
  const long long T2 = (PARTS & 2) ? 2LL * CMP_ROWS * CMP_HID : 0;
  FOR_IDX(idx, T1 + T2) {
    if (idx < T1) {
      if (!(PARTS & 1)) continue;
      long long n = idx / B_K; int c = (int)(idx % B_K);
      const float* W2 = p.w_alpha2 + (long long)li * GLA_RANK * B_K;
      float z = p.b_alpha[li * B_K + c];
      for (int r = 0; r < GLA_RANK; ++r) z += ldf(p.u[n * N_IN + OFF_LR + r]) * W2[r * B_K + c];
      float ls = fminf(z, 0.f) - log1pf(expf(-fabsf(z)));
      p.ga[idx] = expf(ls * (1.0f / 16.0f));
    } else {
      long long i2 = idx - T1;
      int which = (int)(i2 / ((long long)CMP_ROWS * CMP_HID));
      long long rem = i2 % ((long long)CMP_ROWS * CMP_HID);
      int row = (int)(rem / CMP_HID), j = (int)(rem % CMP_HID);
      int g = row % NSA_G; int c = (row / NSA_G) % N_CMP; int b = row / (NSA_G * N_CMP);
      const float* pe = (which ? p.cmp_pe_v : p.cmp_pe_k) + (long long)li * 32 * HD;
      const float* w1 = (which ? p.cmp_w1_v : p.cmp_w1_k) + (long long)li * 32 * HD * CMP_HID;
      int off = (which ? OFF_CVC : OFF_CKC) + g * HD;
      float s = 0.f;
      for (int l = 0; l < 32; ++l) {
        const act_t* ur = p.u + ((long long)b * SEQ + c * 16 + l) * N_IN + off;
        for (int d = 0; d < HD; ++d) s += (ldf(ur[d]) + pe[l * HD + d]) * w1[(long long)(l * HD + d) * CMP_HID + j];
      }
      p.hid[i2] = gelu_tanh(s);
    }
  }
}

template <int PARTS>
DEV void ph_mix1(const Params& p, int li, long long tid, long long nthr) {
  const long long T1 = (long long)N_TOK * 4;
  const long long T2 = (long long)BATCH * GLA_H * DV * 4;
  const long long T3 = 2LL * CMP_ROWS * HD;
  FOR_IDX(idx, T1 + T2 + T3) {
    if (idx < T1) {
      if (!(PARTS & 1)) continue;
      long long n = idx / 4; int h = (int)(idx % 4);
      int b = (int)(n / SEQ), t = (int)(n % SEQ);
      float m = -INFINITY, l = 0.f;
      float acc[HD];
#pragma unroll
      for (int d = 0; d < HD; ++d) acc[d] = 0.f;
      for (int gi = 0; gi < 3; ++gi) {
        const int dil = gi == 0 ? 1 : (gi == 1 ? 4 : 16);
        float q[HD];
        const act_t* qp = p.u + n * N_IN + OFF_AQ + gi * 256 + h * HD;
#pragma unroll
        for (int d = 0; d < HD; ++d) q[d] = ldf(qp[d]);
        for (int mm = 0; mm <= 128; ++mm) {
          int tk = t - mm * dil;
          if (tk < 0) break;
          const act_t* kp = p.u + ((long long)b * SEQ + tk) * N_IN + OFF_AK + gi * 256 + h * HD;
          const act_t* vp = p.u + ((long long)b * SEQ + tk) * N_IN + OFF_AV + gi * 256 + h * HD;
          float s = 0.f;
#pragma unroll
          for (int d = 0; d < HD; ++d) s += q[d] * ldf(kp[d]);
          s *= 0.125f;
          float mn = fmaxf(m, s);
          float corr = expf(m - mn);
          float pp = expf(s - mn);
          l = l * corr + pp;
#pragma unroll
          for (int d = 0; d < HD; ++d) acc[d] = acc[d] * corr + pp * ldf(vp[d]);
          m = mn;
        }
      }
      float inv = 1.0f / l;
#pragma unroll
      for (int d = 0; d < HD; ++d) stf(&p.ya[n * 256 + h * HD + d], acc[d] * inv);
    } else if (idx < T1 + T2) {
      if (!(PARTS & 2)) continue;
      long long i2 = idx - T1;
      int v = (int)(i2 % DV); int cq = (int)((i2 / DV) % 4); int h = (int)((i2 / (DV * 4)) % GLA_H);
      int b = (int)(i2 / (DV * 4 * GLA_H));
      constexpr int DKQ = DK / 4;
      float st[DKQ];
#pragma unroll
      for (int c = 0; c < DKQ; ++c) st[c] = 0.f;
      const float qs = 1.0f / sqrtf((float)DK);
      for (int t = 0; t < SEQ; ++t) {
        long long n = (long long)b * SEQ + t;
        const act_t* ur = p.u + n * N_IN;
        float vt = ldf(ur[OFF_BV + h * DV + v]);
        const float* gar = p.ga + n * B_K + h * DK + cq * DKQ;
        const act_t* kr = ur + OFF_BK + h * DK + cq * DKQ;
        const act_t* qr = ur + OFF_BQ + h * DK + cq * DKQ;
        float o = 0.f;
#pragma unroll
        for (int c = 0; c < DKQ; ++c) {
          st[c] = gar[c] * st[c] + ldf(kr[c]) * vt;
          o += ldf(qr[c]) * st[c];
        }
        p.opart[((long long)cq * N_TOK + n) * B_V + h * DV + v] = o * qs;
      }
    } else {
      long long i2 = idx - T1 - T2;
      int which = (int)(i2 / ((long long)CMP_ROWS * HD));
      long long rem = i2 % ((long long)CMP_ROWS * HD);
      int row = (int)(rem / HD), d = (int)(rem % HD);
      const float* w2 = (which ? p.cmp_w2_v : p.cmp_w2_k) + (long long)li * CMP_HID * HD;
      const float* hr = p.hid + ((long long)which * CMP_ROWS + row) * CMP_HID;
      float s = 0.f;
      if (!(PARTS & 4)) continue;
      for (int j = 0; j < CMP_HID; ++j) s += hr[j] * w2[j * HD + d];
      p.kcv[i2] = s;
#ifndef CPU_TEST
      {
        const int g_ = row % NSA_G, c_ = (row / NSA_G) % N_CMP, b_ = row / (NSA_G * N_CMP);
        stf(&p.kcb[((((size_t)which * BATCH + b_) * 128 + c_) * NSA_G + g_) * 64 + d], s);
      }
#endif
    }
  }
}

template <int PARTS>
DEV void ph_nsa1(const Params& p, int li, long long tid, long long nthr) {
  const long long T1 = (long long)N_TOK * GLA_H;
  const long long T2 = (PARTS & 2) ? (long long)N_TOK * NSA_H : 0;
  FOR_IDX(idx, T1 + T2) {
    if (idx < T1) {
      long long n = idx / GLA_H; int h = (int)(idx % GLA_H);
      float ss = 0.f;
      for (int v = 0; v < DV; ++v) {
        float o = 0.f;
        for (int cq = 0; cq < 4; ++cq) o += p.opart[((long long)cq * N_TOK + n) * B_V + h * DV + v];
        ss += o * o;
      }
      float rs = 1.0f / sqrtf(ss / DV + LN_EPS);
      for (int v = 0; v < DV; ++v) {
        float o = 0.f;
        for (int cq = 0; cq < 4; ++cq) o += p.opart[((long long)cq * N_TOK + n) * B_V + h * DV + v];
        float r = ldf(p.u[n * N_IN + OFF_BR + h * DV + v]);
        float y = o * rs * p.gla_norm_g[li * DV + v] * (r * sigmoidf_(r));
        stf(&p.yb[n * B_V + h * DV + v], y);
      }
    } else {
      long long i2 = idx - T1;
      long long n = i2 / NSA_H; int hh = (int)(i2 % NSA_H);
      int b = (int)(n / SEQ), t = (int)(n % SEQ);
      int g = hh / 4;
      int nv = t >= 31 ? (t - 31) / 16 + 1 : 0;
      if (nv > N_CMP) nv = N_CMP;
      float q[HD];
      const act_t* qp = p.u + n * N_IN + OFF_CQ + hh * HD;
#pragma unroll
      for (int d = 0; d < HD; ++d) q[d] = ldf(qp[d]);
      float* prow = p.pcmp + (((long long)b * NSA_H + hh) * SEQ + t) * 128;
      float m = -INFINITY;
      for (int c = 0; c < nv; ++c) {
        const float* kp = p.kcv + (((long long)b * N_CMP + c) * NSA_G + g) * HD;
        float s = 0.f;
#pragma unroll
        for (int d = 0; d < HD; ++d) s += q[d] * kp[d];
        s *= 0.125f;
        prow[c] = s;
        m = fmaxf(m, s);
      }
      float acc[HD];
#pragma unroll
      for (int d = 0; d < HD; ++d) acc[d] = 0.f;
      float l = 0.f;
      for (int c = 0; c < nv; ++c) {
        const float* vp = p.kcv + (((long long)CMP_ROWS) + ((long long)b * N_CMP + c) * NSA_G + g) * HD;
        float pp = expf(prow[c] - m);
        l += pp;
        prow[c] = pp;
#pragma unroll
        for (int d = 0; d < HD; ++d) acc[d] += pp * vp[d];
      }
      float inv = 1.0f / fmaxf(l, 1e-30f);
      for (int c = 0; c < 128; ++c) prow[c] = c < nv ? prow[c] * inv : 0.f;
#pragma unroll
      for (int d = 0; d < HD; ++d) p.ocmp[n * 1024 + hh * HD + d] = acc[d] * inv;
    }
  }
}

DEV void ph_nsa2(const Params& p, int li, long long tid, long long nthr) {
  FOR_IDX(idx, (long long)BATCH * NSA_G * SEQ * N_BLK) {
    int j = (int)(idx % N_BLK); long long r = idx / N_BLK;
    int s = (int)(r % SEQ); int g = (int)((r / SEQ) % NSA_G); int b = (int)(r / ((long long)SEQ * NSA_G));
    int qb = s / 64;
    float imp;
    if (j == 0 || j == qb || j == qb - 1) imp = INFINITY;
    else if (j > qb) imp = -INFINITY;
    else {
      imp = 0.f;
      int c0 = 4 * j - 1; if (c0 < 0) c0 = 0;
      int c1 = 4 * j + 3; if (c1 > N_CMP - 1) c1 = N_CMP - 1;
      for (int rr = 0; rr < 4; ++rr) {
        const float* prow = p.pcmp + (((long long)b * NSA_H + g * 4 + rr) * SEQ + s) * 128;
        for (int c = c0; c <= c1; ++c) imp += prow[c];
      }
    }
    p.impb[idx] = imp;
  }
}

DEV void ph_nsa3(const Params& p, int li, long long tid, long long nthr) {
  FOR_IDX(idx, (long long)BATCH * NSA_G * SEQ * N_BLK) {
    int j = (int)(idx % N_BLK); long long r = idx / N_BLK;
    const float* ir = p.impb + r * N_BLK;
    float v = ir[j];
    int rank = 0;
    for (int jj = 0; jj < N_BLK; ++jj) {
      float w = ir[jj];
      if (w > v || (w == v && jj < j)) ++rank;
    }
    p.selb[idx] = rank < N_SELECT ? 1 : 0;
  }
}

DEV void ph_nsa4(const Params& p, int li, long long tid, long long nthr) {
  FOR_IDX(idx, (long long)N_TOK * NSA_H) {
    long long n = idx / NSA_H; int hh = (int)(idx % NSA_H);
    int b = (int)(n / SEQ), t = (int)(n % SEQ);
    int g = hh / 4;
    float q[HD];
    const act_t* qp = p.u + n * N_IN + OFF_CQ + hh * HD;
#pragma unroll
    for (int d = 0; d < HD; ++d) q[d] = ldf(qp[d]);
    float g0 = sigmoidf_(ldf(p.u[n * N_IN + OFF_CG + hh * 3 + 0]));
    float g1 = sigmoidf_(ldf(p.u[n * N_IN + OFF_CG + hh * 3 + 1]));
    float g2 = sigmoidf_(ldf(p.u[n * N_IN + OFF_CG + hh * 3 + 2]));
    float acc[HD];
    {
      float m = -INFINITY, l = 0.f;
#pragma unroll
      for (int d = 0; d < HD; ++d) acc[d] = 0.f;
      int qb = t / 64;
      const int* sr = p.selb + (((long long)b * NSA_G + g) * SEQ + t) * N_BLK;
      for (int j = 0; j <= qb; ++j) {
        if (!sr[j]) continue;
        int hi = j * 64 + 63; if (hi > t) hi = t;
        for (int tk = j * 64; tk <= hi; ++tk) {
          const act_t* kp = p.u + ((long long)b * SEQ + tk) * N_IN + OFF_CKS + g * HD;
          const act_t* vp = p.u + ((long long)b * SEQ + tk) * N_IN + OFF_CVS + g * HD;
          float s = 0.f;
#pragma unroll
          for (int d = 0; d < HD; ++d) s += q[d] * ldf(kp[d]);
          s *= 0.125f;
          float mn = fmaxf(m, s);
          float corr = expf(m - mn);
          float pp = expf(s - mn);
          l = l * corr + pp;
#pragma unroll
          for (int d = 0; d < HD; ++d) acc[d] = acc[d] * corr + pp * ldf(vp[d]);
          m = mn;
        }
      }
      float inv = 1.0f / l;
#pragma unroll
      for (int d = 0; d < HD; ++d) {
        float* oc = &p.ocmp[n * 1024 + hh * HD + d];
        *oc = g0 * (*oc) + g1 * acc[d] * inv;
      }
    }
    {
      float m = -INFINITY, l = 0.f;
#pragma unroll
      for (int d = 0; d < HD; ++d) acc[d] = 0.f;
      int lo = t - (NSA_WIN - 1); if (lo < 0) lo = 0;
      for (int tk = lo; tk <= t; ++tk) {
        const act_t* kp = p.u + ((long long)b * SEQ + tk) * N_IN + OFF_CKW + g * HD;
        const act_t* vp = p.u + ((long long)b * SEQ + tk) * N_IN + OFF_CVW + g * HD;
        float s = 0.f;
#pragma unroll
        for (int d = 0; d < HD; ++d) s += q[d] * ldf(kp[d]);
        s *= 0.125f;
        float mn = fmaxf(m, s);
        float corr = expf(m - mn);
        float pp = expf(s - mn);
        l = l * corr + pp;
#pragma unroll
        for (int d = 0; d < HD; ++d) acc[d] = acc[d] * corr + pp * ldf(vp[d]);
        m = mn;
      }
      float inv = 1.0f / l;
#pragma unroll
      for (int d = 0; d < HD; ++d)
        stf(&p.yc[n * 1024 + hh * HD + d], p.ocmp[n * 1024 + hh * HD + d] + g2 * acc[d] * inv);
    }
  }
}

DEV void ph_br(const Params& p, int li, long long tid, long long nthr) {
  const float* Wa = p.w_br_a + (long long)li * 256 * D;
  const float* Wb = p.w_br_b + (long long)li * B_V * D;
  const float* Wc = p.w_br_c + (long long)li * 1024 * D;
  FOR_IDX(idx, (long long)N_TOK * D) {
    long long n = idx / D; int d = (int)(idx % D);
    float s0 = dotcol(p.ya + n * 256, Wa + d, 256, D);
    float s1 = dotcol(p.yb + n * B_V, Wb + d, B_V, D);
    float s2 = dotcol(p.yc + n * 1024, Wc + d, 1024, D);
    const act_t* mg = p.u + n * N_IN + OFF_MG;
    float y = sigmoidf_(ldf(mg[d])) * s0 + sigmoidf_(ldf(mg[D + d])) * s1 + sigmoidf_(ldf(mg[2 * D + d])) * s2;
    stf(&p.merged[idx], y);
  }
}

DEV void ph_proj_res(const Params& p, const act_t* a, const float* W, long long tid, long long nthr) {
  FOR_IDX(idx, (long long)N_TOK * D) {
    long long n = idx / D; int d = (int)(idx % D);
    p.tmp[idx] = ALPHA * p.xf[idx] + dotcol(a + n * D, W + d, D, D);
  }
}

DEV void ph_xq(const Params& p, int li, long long tid, long long nthr) {
  const long long T1 = (long long)N_TOK * D;
  const long long T2 = 2LL * BATCH * MEM_LEN * D;
  const float* Wq = p.w_xq + (long long)li * D * D;
  FOR_IDX(idx, T1 + T2) {
    if (idx < T1) {
      long long n = idx / D; int d = (int)(idx % D);
      stf(&p.xq[idx], dotcol(p.xb + n * D, Wq + d, D, D));
    } else {
      long long i2 = idx - T1;
      int which = (int)(i2 / ((long long)BATCH * MEM_LEN * D));
      long long rem = i2 % ((long long)BATCH * MEM_LEN * D);
      long long r = rem / D; int d = (int)(rem % D);
      const float* W = (which ? p.w_xv : p.w_xk) + (long long)li * D * D;
      float s = dotcol(p.mem + r * D, W + d, D, D);
      stf(which ? &p.memv[rem] : &p.memk[rem], s);
    }
  }
}

DEV void ph_xs(const Params& p, int li, long long tid, long long nthr) {
  const float sc = 1.0f / sqrtf((float)XHD);
  FOR_IDX(idx, (long long)N_TOK * XH * MEM_LEN) {
    int m = (int)(idx % MEM_LEN); int h = (int)((idx / MEM_LEN) % XH); long long n = idx / (MEM_LEN * XH);
    int b = (int)(n / SEQ);
    const act_t* q = p.xq + n * D + h * XHD;
    const act_t* k = p.memk + ((long long)b * MEM_LEN + m) * D + h * XHD;
    float s = 0.f;
    for (int d = 0; d < XHD; ++d) s += ldf(q[d]) * ldf(k[d]);
    p.xs[idx] = s * sc;
  }
}

DEV void ph_xo(const Params& p, int li, long long tid, long long nthr) {
  FOR_IDX(idx, (long long)N_TOK * D) {
    long long n = idx / D; int c = (int)(idx % D);
    int h = c / XHD; int b = (int)(n / SEQ);
    const float* sr = p.xs + (n * XH + h) * MEM_LEN;
    float m = -INFINITY;
    for (int mm = 0; mm < MEM_LEN; ++mm) m = fmaxf(m, sr[mm]);
    float l = 0.f, o = 0.f;
    for (int mm = 0; mm < MEM_LEN; ++mm) {
      float pp = expf(sr[mm] - m);
      l += pp;
      o += pp * ldf(p.memv[((long long)b * MEM_LEN + mm) * D + c]);
    }
    stf(&p.xo[idx], o / l);
  }
}

DEV void ph_rlogit(const Params& p, int li, long long tid, long long nthr) {
  const float* W = p.w_router + (long long)li * D * NE;
  FOR_IDX(idx, (long long)N_TOK * NE) {
    long long n = idx / NE; int e = (int)(idx % NE);
    p.rl[idx] = dotcol(p.xf + n * D, W + e, D, NE) + p.b_router[li * NE + e];
  }
}

DEV void ph_route(const Params& p, int li, long long tid, long long nthr) {
  FOR_IDX(n, N_TOK) {
    const float* r = p.rl + n * NE;
    int i0 = -1, i1 = -1, i2 = -1, i3 = -1;
    float v0 = 0, v1 = 0, v2 = 0, v3 = 0;
    for (int k = 0; k < 4; ++k) {
      int bi = -1; float bv = -INFINITY;
      for (int e = 0; e < NE; ++e) {
        if (e == i0 || e == i1 || e == i2) continue;
        float v = r[e];
        if (bi < 0 || v > bv) { bi = e; bv = v; }
      }
      if (k == 0) { i0 = bi; v0 = bv; } else if (k == 1) { i1 = bi; v1 = bv; }
      else if (k == 2) { i2 = bi; v2 = bv; } else { i3 = bi; v3 = bv; }
    }
    float e0 = 1.0f, e1 = expf(v1 - v0), e2 = expf(v2 - v0), e3 = expf(v3 - v0);
    float inv = 1.0f / (e0 + e1 + e2 + e3);
#ifndef CPU_TEST
    p.rank[n * 4 + 0] = atomicAdd(&p.cnt[li * 32 + i0], 1);
    p.rank[n * 4 + 1] = atomicAdd(&p.cnt[li * 32 + i1], 1);
    p.rank[n * 4 + 2] = atomicAdd(&p.cnt[li * 32 + i2], 1);
    p.rank[n * 4 + 3] = atomicAdd(&p.cnt[li * 32 + i3], 1);
#endif
    p.topi[n * 4 + 0] = i0; p.topi[n * 4 + 1] = i1; p.topi[n * 4 + 2] = i2; p.topi[n * 4 + 3] = i3;
    p.topg[n * 4 + 0] = e0 * inv; p.topg[n * 4 + 1] = e1 * inv; p.topg[n * 4 + 2] = e2 * inv; p.topg[n * 4 + 3] = e3 * inv;
  }
}

DEV void ph_moe1(const Params& p, int li, long long tid, long long nthr) {
  FOR_IDX(idx, (long long)N_TOK * TOPK * DFF) {
    int j = (int)(idx % DFF); long long a = idx / DFF; long long n = a / TOPK;
    int e = p.topi[a];
    const float* W = p.w_gu + ((long long)li * NE + e) * D * 2 * DFF;
    const float* bb = p.b_gu + ((long long)li * NE + e) * 2 * DFF;
    float gt = dotcol(p.xb + n * D, W + j, D, 2 * DFF) + bb[j];
    float up = dotcol(p.xb + n * D, W + DFF + j, D, 2 * DFF) + bb[DFF + j];
    gt = fminf(gt, 7.0f);
    up = fminf(fmaxf(up, -7.0f), 7.0f);
    stf(&p.act[idx], (up + 1.0f) * gt * sigmoidf_(1.702f * gt));
  }
}

DEV void ph_moe2(const Params& p, int li, long long tid, long long nthr) {
  FOR_IDX(idx, (long long)N_TOK * D) {
    long long n = idx / D; int d = (int)(idx % D);
    float y = 0.f;
    for (int k = 0; k < TOPK; ++k) {
      int e = p.topi[n * 4 + k];
      const float* W = p.w_down + ((long long)li * NE + e) * DFF * D;
      float s = dotcol(p.act + (n * 4 + k) * DFF, W + d, DFF, D) + p.b_down[((long long)li * NE + e) * D + d];
      y += p.topg[n * 4 + k] * s;
    }
    p.tmp[idx] = ALPHA * p.xf[idx] + y;
  }
}

constexpr int PH_PER_LAYER = 20;
constexpr int N_PHASES = 1 + DEPTH * PH_PER_LAYER;

template <int K>
DEV void run_phase_k(const Params& p, int li, long long tid, long long nthr) {
  if constexpr (K == -1) ph_ln(p.x, p.ln0_g, p.ln0_b, p.xf, p.xb, nullptr, tid, nthr);
  if constexpr (K == 0) ph_inproj(p, li, tid, nthr);
  if constexpr (K == 1) ph_pre<3>(p, li, tid, nthr);
  if constexpr (K == 20) ph_pre<1>(p, li, tid, nthr);
  if constexpr (K == 2) ph_mix1<7>(p, li, tid, nthr);
  if constexpr (K == 21) ph_mix1<4>(p, li, tid, nthr);
  if constexpr (K == 3) ph_nsa1<3>(p, li, tid, nthr);
  if constexpr (K == 22) ph_nsa1<1>(p, li, tid, nthr);
  if constexpr (K == 4) ph_nsa2(p, li, tid, nthr);
  if constexpr (K == 5) ph_nsa3(p, li, tid, nthr);
  if constexpr (K == 6) ph_nsa4(p, li, tid, nthr);
  if constexpr (K == 7) ph_br(p, li, tid, nthr);
  if constexpr (K == 8) ph_proj_res(p, p.merged, p.w_o_mix + (long long)li * D * D, tid, nthr);
  if constexpr (K == 9) ph_ln(p.tmp, p.ln1_g + li * D, p.ln1_b + li * D, p.xf, p.xb, nullptr, tid, nthr);
  if constexpr (K == 10) ph_xq(p, li, tid, nthr);
  if constexpr (K == 11) ph_xs(p, li, tid, nthr);
  if constexpr (K == 12) ph_xo(p, li, tid, nthr);
  if constexpr (K == 13) ph_proj_res(p, p.xo, p.w_xo + (long long)li * D * D, tid, nthr);
  if constexpr (K == 14) ph_ln(p.tmp, p.ln2_g + li * D, p.ln2_b + li * D, p.xf, p.xb, nullptr, tid, nthr);
  if constexpr (K == 15) ph_rlogit(p, li, tid, nthr);
  if constexpr (K == 16) ph_route(p, li, tid, nthr);
  if constexpr (K == 17) ph_moe1(p, li, tid, nthr);
  if constexpr (K == 18) ph_moe2(p, li, tid, nthr);
  if constexpr (K == 19) ph_ln(p.tmp, p.ln3_g + li * D, p.ln3_b + li * D, p.xf, p.xb, li == DEPTH - 1 ? p.out : nullptr, tid, nthr);
}

DEV void run_phase(const Params& p, int ph, long long tid, long long nthr) {
  if (ph == 0) { run_phase_k<-1>(p, 0, tid, nthr); return; }
  int li = (ph - 1) / PH_PER_LAYER, k = (ph - 1) % PH_PER_LAYER;
  switch (k) {
#define PHC(K) case K: run_phase_k<K>(p, li, tid, nthr); break;
    PHC(0) PHC(1) PHC(2) PHC(3) PHC(4) PHC(5) PHC(6) PHC(7) PHC(8) PHC(9)
    PHC(10) PHC(11) PHC(12) PHC(13) PHC(14) PHC(15) PHC(16) PHC(17) PHC(18) PHC(19)
#undef PHC
  }
}

#ifdef CPU_TEST
#define HDI_M
#else
#define HDI_M __host__ __device__ __forceinline__
#endif
struct Carver {
  char* base; size_t off;
  template <class T> HDI_M T* take(size_t n) {
    T* r = (T*)(base + off);
    off += (n * sizeof(T) + 255) & ~(size_t)255;
    return r;
  }
};

HDI void fill_params(Params& p, void* const* d_in, void* d_out, void* d_ws) {
  const float* const* in = (const float* const*)d_in;
  p.x = in[0]; p.mem = in[1]; p.ln0_g = in[2]; p.ln0_b = in[3]; p.w_in = in[4]; p.b_in = in[5];
  p.w_alpha2 = in[6]; p.b_alpha = in[7]; p.gla_norm_g = in[8];
  p.cmp_pe_k = in[9]; p.cmp_w1_k = in[10]; p.cmp_w2_k = in[11]; p.cmp_pe_v = in[12]; p.cmp_w1_v = in[13]; p.cmp_w2_v = in[14];
  p.w_br_a = in[15]; p.w_br_b = in[16]; p.w_br_c = in[17]; p.w_o_mix = in[18]; p.ln1_g = in[19]; p.ln1_b = in[20];
  p.w_xq = in[21]; p.w_xk = in[22]; p.w_xv = in[23]; p.w_xo = in[24]; p.ln2_g = in[25]; p.ln2_b = in[26];
  p.w_router = in[27]; p.b_router = in[28]; p.w_gu = in[29]; p.b_gu = in[30]; p.w_down = in[31]; p.b_down = in[32];
  p.ln3_g = in[33]; p.ln3_b = in[34];
  p.out = (float*)d_out;
  Carver c{(char*)d_ws, 0};
  p.barw = c.take<unsigned>(4096);
  p.xf = c.take<float>((size_t)N_TOK * D);
  p.xb = c.take<act_t>((size_t)N_TOK * D);
  p.u = c.take<act_t>((size_t)N_TOK * N_IN);
  p.ga = c.take<float>((size_t)N_TOK * B_K);
  p.hid = c.take<float>((size_t)2 * CMP_ROWS * CMP_HID);
  p.kcv = c.take<float>((size_t)2 * CMP_ROWS * HD);
  p.opart = c.take<float>((size_t)4 * N_TOK * B_V);
  p.yass = p.opart;
#ifdef CPU_TEST
  p.ya = c.take<act_t>((size_t)N_TOK * 256);
  p.yb = c.take<act_t>((size_t)N_TOK * B_V);
  p.yc = c.take<act_t>((size_t)N_TOK * 1024);
#else
  p.ya = c.take<act_t>((size_t)N_TOK * YLD);
  p.yb = p.ya + 256;
  p.yc = p.ya + 1280;
#endif
  p.pcmp = c.take<float>((size_t)MOE_ROWS * 1024 / 2 > (size_t)BATCH * NSA_H * SEQ * 128 ? (size_t)MOE_ROWS * 1024 / 2 : (size_t)BATCH * NSA_H * SEQ * 128);
  p.xg = (act_t*)p.pcmp;
  p.ocmp = c.take<float>((size_t)N_TOK * 1024);
  p.impb = c.take<float>((size_t)BATCH * NSA_G * SEQ * N_BLK);
  p.selb = c.take<int>((size_t)BATCH * NSA_G * SEQ * N_BLK);
  p.merged = c.take<act_t>((size_t)N_TOK * D);
  p.tmp = c.take<float>((size_t)N_TOK * D);
  p.xq = c.take<act_t>((size_t)N_TOK * D);
  p.memk = c.take<act_t>((size_t)BATCH * MEM_LEN * D);
  p.memv = c.take<act_t>((size_t)BATCH * MEM_LEN * D);
  p.xs = c.take<float>((size_t)N_TOK * XH * MEM_LEN);
  p.mrg = p.xs;
  p.xo = c.take<act_t>((size_t)N_TOK * D);
  p.rl = c.take<float>((size_t)N_TOK * NE);
  p.topi = c.take<int>((size_t)N_TOK * TOPK);
  p.topg = c.take<float>((size_t)N_TOK * TOPK);
  p.actg = c.take<act_t>((size_t)MOE_ROWS * 1024);
  p.act = p.actg;
  p.wt_in = c.take<act_t>((size_t)2 * N_IN_PAD * 1024);
  p.wt_c1 = c.take<act_t>((size_t)2 * 2 * 256 * 2048);
  p.wt_bra = c.take<act_t>((size_t)2 * 1024 * YLD);
  p.wt_brb = p.wt_bra + 256;
  p.wt_brc = p.wt_bra + 1280;
  p.wt_omix = c.take<act_t>((size_t)2 * 1024 * 1024);
  p.wt_xq = c.take<act_t>((size_t)2 * 1024 * 1024);
  p.wt_xk = c.take<act_t>((size_t)2 * 1024 * 1024);
  p.wt_xv = c.take<act_t>((size_t)2 * 1024 * 1024);
  p.wt_xo = c.take<act_t>((size_t)2 * 1024 * 1024);
  p.wt_gu = c.take<act_t>((size_t)2 * 32 * 2048 * 1024);
  p.wt_dn = c.take<act_t>((size_t)2 * 32 * 1024 * 1024);
  p.membf = c.take<act_t>((size_t)BATCH * MEM_LEN * 1024);
  p.cmpA = c.take<act_t>((size_t)2 * CMP_ROWS_PAD * 2048);
  p.cnt = c.take<int>(64);
  p.rank = c.take<int>((size_t)N_TOK * 4);
  p.rowlist = c.take<int>((size_t)MOE_ROWS);
  p.kcb = c.take<act_t>((size_t)2 * BATCH * 128 * NSA_G * 64);
  p.dilo = c.take<act_t>((size_t)3 * N_TOK * 256);
  p.dill = c.take<float>((size_t)3 * N_TOK * 4);
  p.selm = c.take<unsigned>((size_t)BATCH * NSA_G * SEQ);
  p.gU = p.xg; p.gQ = p.xg + (size_t)1024 * 128 * 256; p.gS = p.actg; p.gD = p.opart + (size_t)N_TOK * 1024;
  p.ws_used = c.off;
}

#ifndef CPU_TEST
#ifndef NSA_PROBE
#define NSA_PROBE 0
#endif
static_assert(D == 1024 && BATCH == 8, "optimized path is written for the graded shapes");
namespace pg8 {
#define PG8_LAS __attribute__((address_space(3)))
typedef unsigned short bf16_t;
typedef short bf16x8 __attribute__((ext_vector_type(8)));
typedef float f32x4 __attribute__((ext_vector_type(4)));
typedef unsigned u32x4 __attribute__((ext_vector_type(4)));
constexpr int BM = 256, BK = 64, HALF = 128, HTB = HALF * BK * 2  , STAGE_BYTES = 8 * HTB, NXCD = 8, WGM = 8;

__host__ __device__ __forceinline__ int lds_byte(int r, int c) { const int st = (r >> 4) * 2 + (c >> 5), rr = r & 15, cc = c & 31, ob = rr * 64 + cc * 2; return st * 1024 + (ob ^ (((ob >> 9) & 1) << 5)); }
__host__ __device__ __forceinline__ void stage_rc(int b, int& R, int& C) { const int st = b / 1024, sb = b % 1024, swz = sb ^ (((sb >> 9) & 1) << 5); R = (st >> 1) * 16 + swz / 64; C = (st & 1) * 32 + (swz % 64) / 2; }
__host__ __device__ __forceinline__ int perm32(int rho) { const int n = rho >> 4, i = rho & 15; return 8 * (i >> 2) + 4 * n + (i & 3); }

struct Unit { int pm, pn; };
struct Gemm { const bf16_t* A; const bf16_t* Bt; int M, N, K; };

struct StaticOrder {
    int nM, nN, nwg, G, c;
    __host__ __device__ void init(int M, int N, int G_, int c_) { nM = M / BM; nN = N / BM; nwg = nM * nN; G = G_; c = c_; }
    __host__ __device__ bool next(int i, Unit& u) const {
        const long L = (long)i * G + c; if (L >= nwg) return false;
        int wgid = (int)L; { const int q = nwg / NXCD, r = nwg % NXCD, xcd = wgid % NXCD, off = wgid / NXCD; wgid = (xcd < r ? xcd * (q + 1) : r * (q + 1) + (xcd - r) * q) + off; }
        const int nig = WGM * nN, gid = wgid / nig, fm = gid * WGM, gsz = (nM - fm) < WGM ? (nM - fm) : WGM;
        u.pm = fm + ((wgid % nig) % gsz); u.pn = (wgid % nig) / gsz; return true;
    }
    __device__ __forceinline__ void a_ready(const Unit&) const {}
    __device__ __forceinline__ void done(const Unit&) const {}
};

__device__ __forceinline__ unsigned cvt_pk_bf16(float lo, float hi) { unsigned r; asm volatile("v_cvt_pk_bf16_f32 %0, %1, %2" : "=v"(r) : "v"(lo), "v"(hi)); return r; }

template <class Epi, class Sched, bool ALIGN_EPI = false, bool SP2 = false>
__device__ __forceinline__ void gemm_phase(PG8_LAS unsigned char* lds, const Gemm g, const Sched& S, const Epi& E, const int tid) {
    const int wid = __builtin_amdgcn_readfirstlane(tid >> 6), lane = tid & 63, wr = wid >> 2, wc = wid & 3, fr = lane & 15, fq = lane >> 4;
    const int K = g.K, nt = K / BK;
    unsigned voffA[2], voffB[2];
#pragma unroll
    for (int i = 0; i < 2; ++i) { int R, C; stage_rc(tid * 16 + i * 8192, R, C); const int Rb = Epi::PERM ? ((R & ~31) + perm32(R & 31)) : R;
        voffA[i] = (unsigned)(R * K + C) * 2u; voffB[i] = (unsigned)(Rb * K + C) * 2u; }
    const size_t kstep = (size_t)(BK * 2);
    const size_t hstep = (size_t)HALF * K * 2;
    const size_t tstep = 2 * hstep;
    const unsigned ldsw = (unsigned)wid * 1024u;
    const int aoff = lds_byte(wr * 64 + fr, fq * 8), boff = lds_byte(wc * 32 + fr, fq * 8);
#define PG8_SA(b, h) (((b) * 2 + (h)) * HTB)
#define PG8_SB(b, h) ((4 + (b) * 2 + (h)) * HTB)
#define PG8_STAGE(bufoff, gbase, voff) do { _Pragma("unroll") for (int _i = 0; _i < 2; ++_i) \
        __builtin_amdgcn_global_load_lds((const unsigned*)((const char*)(gbase) + (voff)[_i]), (PG8_LAS unsigned*)(lds + (bufoff) + ldsw + _i * 8192), 16, 0, 0); } while (0)
#define PG8_LDA(dst, b, h) do { _Pragma("unroll") for (int m = 0; m < 4; ++m) _Pragma("unroll") for (int k = 0; k < 2; ++k) dst[m][k] = *(const PG8_LAS bf16x8*)(lds + PG8_SA(b, h) + aoff + m * 2048 + k * 1024); } while (0)
#define PG8_LDB(dst, b, h) do { _Pragma("unroll") for (int n = 0; n < 2; ++n) _Pragma("unroll") for (int k = 0; k < 2; ++k) dst[n][k] = *(const PG8_LAS bf16x8*)(lds + PG8_SB(b, h) + boff + n * 2048 + k * 1024); } while (0)
#define PG8_MMA(ai, bj, At, Bt) do { __builtin_amdgcn_s_setprio(1); _Pragma("unroll") for (int m = 0; m < 4; ++m) _Pragma("unroll") for (int n = 0; n < 2; ++n) _Pragma("unroll") for (int k = 0; k < 2; ++k) \
        acc[ai][bj][m][n] = __builtin_amdgcn_mfma_f32_16x16x32_bf16(Bt[n][k], At[m][k], acc[ai][bj][m][n], 0, 0, 0); __builtin_amdgcn_s_setprio(0); } while (0)
#define PG8_WAIT_V(n) asm volatile("s_waitcnt vmcnt(" #n ")" ::: "memory")
#define PG8_WAIT_L(n) asm volatile("s_waitcnt lgkmcnt(" #n ")" ::: "memory")
#define PG8_BAR __builtin_amdgcn_s_barrier()
#define PG8_SCHED __builtin_amdgcn_sched_barrier(0)
    Unit cur, nxt; int ui = 0;
    if (!S.next(0, cur)) return;
    f32x4 acc[2][2][4][2];
#pragma unroll
    for (int a = 0; a < 2; ++a)
#pragma unroll
        for (int b = 0; b < 2; ++b)
#pragma unroll
            for (int m = 0; m < 4; ++m)
#pragma unroll
                for (int n = 0; n < 2; ++n) acc[a][b][m][n] = (f32x4){0.f, 0.f, 0.f, 0.f};
    bf16x8 At[4][2], B0[2][2], B1[2][2];
    const char* cA = (const char*)g.A + (size_t)cur.pm * tstep; const char* cB = (const char*)g.Bt + (size_t)cur.pn * tstep;
    S.a_ready(cur);
    if constexpr (SP2) {
        PG8_STAGE(PG8_SB(0, 0), cB, voffB); PG8_STAGE(PG8_SB(0, 1), cB + hstep, voffB); PG8_STAGE(PG8_SA(0, 0), cA, voffA); PG8_STAGE(PG8_SA(0, 1), cA + hstep, voffA);
        if (wr == 1) PG8_BAR;
        PG8_WAIT_V(2); PG8_BAR;
        PG8_STAGE(PG8_SB(1, 0), cB + kstep, voffB); PG8_STAGE(PG8_SA(1, 0), cA + kstep, voffA); PG8_STAGE(PG8_SB(1, 1), cB + hstep + kstep, voffB);
        PG8_WAIT_V(6); PG8_BAR;
    } else {
        PG8_STAGE(PG8_SB(0, 0), cB, voffB); PG8_STAGE(PG8_SA(0, 0), cA, voffA); PG8_STAGE(PG8_SB(0, 1), cB + hstep, voffB); PG8_STAGE(PG8_SA(0, 1), cA + hstep, voffA);
        if (wr == 1) PG8_BAR;
        PG8_WAIT_V(4); PG8_BAR;
        PG8_STAGE(PG8_SB(1, 0), cB + kstep, voffB); PG8_STAGE(PG8_SA(1, 0), cA + kstep, voffA); PG8_STAGE(PG8_SB(1, 1), cB + hstep + kstep, voffB);
        PG8_WAIT_V(6); PG8_BAR;
    }
    for (;;) {
        const bool has_next = S.next(ui + 1, nxt);
        const char* nA = has_next ? (const char*)g.A + (size_t)nxt.pm * tstep : cA; const char* nB = has_next ? (const char*)g.Bt + (size_t)nxt.pn * tstep : cB;
        for (int t = 0; t < nt; t += 2) {
            const bool last = (t == nt - 2);
            const char* a1 = cA + (size_t)(t + 1) * kstep;
            const char* a2 = last ? nA : cA + (size_t)(t + 2) * kstep; const char* b2 = last ? nB : cB + (size_t)(t + 2) * kstep;
            const char* a3 = a2 + kstep; const char* b3 = b2 + kstep;
            if (last && has_next) S.a_ready(nxt);
            E.mid(acc, cur, wr, wc, t);
            if constexpr (SP2) {
            PG8_LDB(B0, 0, 0); PG8_LDB(B1, 0, 1); PG8_SCHED; PG8_LDA(At, 0, 0); PG8_STAGE(PG8_SA(1, 1), a1 + hstep, voffA);
            PG8_WAIT_V(8); PG8_WAIT_L(0); PG8_BAR; PG8_MMA(0, 0, At, B0); PG8_MMA(0, 1, At, B1); PG8_BAR; PG8_SCHED;
            PG8_LDA(At, 0, 1); PG8_STAGE(PG8_SB(0, 0), b2, voffB); PG8_STAGE(PG8_SB(0, 1), b2 + hstep, voffB); PG8_STAGE(PG8_SA(0, 0), a2, voffA);
            PG8_WAIT_V(8); PG8_WAIT_L(0); PG8_BAR; PG8_MMA(1, 0, At, B0); PG8_MMA(1, 1, At, B1); PG8_BAR; PG8_SCHED;
            PG8_LDB(B0, 1, 0); PG8_LDB(B1, 1, 1); PG8_SCHED; PG8_LDA(At, 1, 0); PG8_STAGE(PG8_SA(0, 1), a2 + hstep, voffA);
            PG8_WAIT_V(8); PG8_WAIT_L(0); PG8_BAR; PG8_MMA(0, 0, At, B0); PG8_MMA(0, 1, At, B1); PG8_BAR; PG8_SCHED;
            PG8_LDA(At, 1, 1); PG8_STAGE(PG8_SB(1, 0), b3, voffB); PG8_STAGE(PG8_SB(1, 1), b3 + hstep, voffB); PG8_STAGE(PG8_SA(1, 0), a3, voffA);
            PG8_WAIT_V(8); PG8_WAIT_L(0); PG8_BAR; PG8_MMA(1, 0, At, B0); PG8_MMA(1, 1, At, B1); PG8_BAR; PG8_SCHED;
            } else {
            PG8_LDB(B0, 0, 0); PG8_SCHED; PG8_LDA(At, 0, 0); PG8_STAGE(PG8_SA(1, 1), a1 + hstep, voffA);
            PG8_WAIT_L(8); PG8_BAR; PG8_WAIT_L(0); PG8_MMA(0, 0, At, B0); PG8_BAR; PG8_SCHED;
            PG8_LDB(B1, 0, 1); PG8_STAGE(PG8_SB(0, 0), b2, voffB);
            PG8_BAR; PG8_WAIT_L(0); PG8_MMA(0, 1, At, B1); PG8_BAR;
            PG8_LDA(At, 0, 1); PG8_STAGE(PG8_SA(0, 0), a2, voffA);
            PG8_BAR; PG8_WAIT_L(0); PG8_MMA(1, 0, At, B0); PG8_BAR; PG8_SCHED;
            PG8_STAGE(PG8_SB(0, 1), b2 + hstep, voffB);
            PG8_WAIT_V(6); PG8_BAR; PG8_MMA(1, 1, At, B1); PG8_BAR;
            PG8_LDB(B0, 1, 0); PG8_SCHED; PG8_LDA(At, 1, 0); PG8_STAGE(PG8_SA(0, 1), a2 + hstep, voffA);
            PG8_WAIT_L(8); PG8_BAR; PG8_WAIT_L(0); PG8_MMA(0, 0, At, B0); PG8_BAR; PG8_SCHED;
            PG8_LDB(B1, 1, 1); PG8_STAGE(PG8_SB(1, 0), b3, voffB);
            PG8_BAR; PG8_WAIT_L(0); PG8_MMA(0, 1, At, B1); PG8_BAR;
            PG8_LDA(At, 1, 1); PG8_STAGE(PG8_SA(1, 0), a3, voffA);
            PG8_BAR; PG8_WAIT_L(0); PG8_MMA(1, 0, At, B0); PG8_BAR; PG8_SCHED;
            PG8_STAGE(PG8_SB(1, 1), b3 + hstep, voffB);
            PG8_WAIT_V(6); PG8_BAR; PG8_MMA(1, 1, At, B1); PG8_BAR;
            }
        }
        if constexpr (ALIGN_EPI) { if (wr == 0) PG8_BAR; }
        if constexpr (!Epi::AFTER_DRAIN) { E(acc, cur, wr, wc, fr, fq); S.done(cur); }
        if (!has_next) break;
#pragma unroll
        for (int a = 0; a < 2; ++a)
#pragma unroll
            for (int b = 0; b < 2; ++b)
#pragma unroll
                for (int m = 0; m < 4; ++m)
#pragma unroll
                    for (int n = 0; n < 2; ++n) acc[a][b][m][n] = (f32x4){0.f, 0.f, 0.f, 0.f};
        cur = nxt; cA = nA; cB = nB; ++ui;
        if constexpr (ALIGN_EPI) { if (wr == 1) PG8_BAR; }
    }
    PG8_WAIT_V(0);
    if constexpr (!ALIGN_EPI) { if (wr == 0) PG8_BAR; }
    PG8_BAR;
    if constexpr (Epi::AFTER_DRAIN) { E.fused(acc, cur, wr, wc, fr, fq, lds, wid, lane); S.done(cur); }
#undef PG8_SA
#undef PG8_SB
#undef PG8_STAGE
#undef PG8_LDA
#undef PG8_LDB
#undef PG8_MMA
#undef PG8_WAIT_V
#undef PG8_WAIT_L
#undef PG8_BAR
#undef PG8_SCHED
}
}

typedef pg8::f32x4 f32x4;
typedef pg8::bf16x8 bf16x8;
typedef unsigned u32x2 __attribute__((ext_vector_type(2)));
typedef unsigned u32x4 __attribute__((ext_vector_type(4)));
#define LAS __attribute__((address_space(3)))

constexpr int NTHREADS = 512;
constexpr int RING_BYTES = 131072;
constexpr int MISC_OFF = RING_BYTES;
constexpr int LDS_BYTES = 147456;

typedef __bf16 bf16x2_t __attribute__((ext_vector_type(2)));
typedef float f32x2_t __attribute__((ext_vector_type(2)));
DEV unsigned pk2(float lo, float hi) {
  const f32x2_t v = {lo, hi};
  return __builtin_bit_cast(unsigned, __builtin_convertvector(v, bf16x2_t));
}
DEV unsigned short f2bfh(float x) { return (unsigned short)(pk2(x, 0.f) & 0xffffu); }
DEV float wave_sum(float v, int lane) {
#pragma unroll
  for (int o = 1; o < 64; o <<= 1)
    v += __int_as_float(__builtin_amdgcn_ds_bpermute((lane ^ o) << 2, __float_as_int(v)));
  return v;
}

DEV void transpose_item(const float* W, int ldw, int dld, act_t* WT, int k0, int n0, int drow0, LAS float* scr, int lane) {
  float wv[32];
#pragma unroll
  for (int i = 0; i < 32; ++i) wv[i] = W[(size_t)(k0 + 2 * i + (lane >> 5)) * ldw + n0 + (lane & 31)];
#pragma unroll
  for (int i = 0; i < 32; ++i) scr[(2 * i + (lane >> 5)) * 33 + (lane & 31)] = wv[i];
  asm volatile("s_waitcnt lgkmcnt(0)" ::: "memory");
  const int c = lane & 7;
#pragma unroll
  for (int j = 0; j < 4; ++j) {
    const int n = (lane >> 3) + 8 * j;
    const LAS float* s = scr + (8 * c) * 33 + n;
    u32x4 o;
    o.x = pk2(s[0 * 33], s[1 * 33]); o.y = pk2(s[2 * 33], s[3 * 33]);
    o.z = pk2(s[4 * 33], s[5 * 33]); o.w = pk2(s[6 * 33], s[7 * 33]);
    *(u32x4*)(WT + (size_t)(drow0 + n) * dld + k0 + 8 * c) = o;
  }
  asm volatile("s_waitcnt lgkmcnt(0)" ::: "memory");
}

struct ConvDesc { const float* W; act_t* dst; int nbatch, K, N, mode; size_t dstb; int dld; };
constexpr int NCONV = 13;
DEV ConvDesc conv_desc(const Params& p, int kind) {
  const size_t SQ = (size_t)1024 * 1024;
  switch (kind) {
    case 0: return ConvDesc{p.w_gu, p.wt_gu, 64, 1024, 2048, 1, (size_t)2048 * 1024, 1024};
    case 1: return ConvDesc{p.w_down, p.wt_dn, 64, 1024, 1024, 0, SQ, 1024};
    case 2: return ConvDesc{p.w_in, p.wt_in, 2, 1024, N_IN, 0, (size_t)N_IN_PAD * 1024, 1024};
    case 3: return ConvDesc{p.cmp_w1_k, p.wt_c1, 2, 2048, 128, 0, (size_t)2 * 256 * 2048, 2048};
    case 4: return ConvDesc{p.cmp_w1_v, p.wt_c1 + (size_t)256 * 2048, 2, 2048, 128, 0, (size_t)2 * 256 * 2048, 2048};
    case 5: return ConvDesc{p.w_br_a, p.wt_bra, 2, 256, 1024, 0, (size_t)1024 * YLD, YLD};
    case 6: return ConvDesc{p.w_br_b, p.wt_brb, 2, 1024, 1024, 0, (size_t)1024 * YLD, YLD};
    case 7: return ConvDesc{p.w_br_c, p.wt_brc, 2, 1024, 1024, 0, (size_t)1024 * YLD, YLD};
    case 8: return ConvDesc{p.w_o_mix, p.wt_omix, 2, 1024, 1024, 0, SQ, 1024};
    case 9: return ConvDesc{p.w_xq, p.wt_xq, 2, 1024, 1024, 0, SQ, 1024};
    case 10: return ConvDesc{p.w_xk, p.wt_xk, 2, 1024, 1024, 0, SQ, 1024};
    case 11: return ConvDesc{p.w_xv, p.wt_xv, 2, 1024, 1024, 0, SQ, 1024};
    default: return ConvDesc{p.w_xo, p.wt_xo, 2, 1024, 1024, 0, SQ, 1024};
  }
}
DEV int conv_items(int kind) {
  switch (kind) {
    case 0: return 64 * 16 * 64;
    case 1: return 64 * 16 * 32;
    case 2: return 2 * 16 * (N_IN / 32);
    case 3: case 4: return 2 * 32 * 4;
    case 5: return 2 * 4 * 32;
    default: return 2 * 16 * 32;
  }
}
DEV void conv_all(const Params& p, int gw, int NGW, LAS float* scr, int lane) {
  int base = 0;
  for (int kind = 0; kind < NCONV; ++kind) {
    const int total = conv_items(kind);
    const ConvDesc d = conv_desc(p, kind);
    const int nblk = d.N / 32, per = nblk * (d.K / 64);
    int first = (gw - base % NGW + NGW) % NGW;
    for (int it = first; it < total; it += NGW) {
      const int bt = it / per, r = it % per, kb = r / nblk, nb = r % nblk;
      const int n0 = nb * 32;
      int drow0 = n0;
      if (d.mode == 1) { const int j = n0 & 1023; drow0 = (j >> 7) * 256 + (j & 127) + ((n0 >= 1024) ? 128 : 0); }
      transpose_item(d.W + (size_t)bt * d.K * d.N, d.N, d.dld, d.dst + (size_t)bt * d.dstb, kb * 64, n0, drow0, scr, lane);
    }
    base += total;
  }
}

template <int MODE>
DEV void ln_rows_w(const Params& p, const float* src, const float* g, const float* b, float* dstf, act_t* dstb, float* dst2,
                   int gw, int NGW, int lane) {
  for (int n = gw; n < N_TOK; n += NGW) {
    f32x4 v[4];
    float s = 0.f;
#pragma unroll
    for (int j = 0; j < 4; ++j) {
      if (MODE == 0) v[j] = ((const f32x4*)(src + (size_t)n * D))[lane + 64 * j];
      else {
        f32x4 a = ((const f32x4*)(p.xf + (size_t)n * D))[lane + 64 * j] * ALPHA;
#pragma unroll
        for (int k = 0; k < 4; ++k) a += ((const f32x4*)(p.yass + ((size_t)n * 4 + k) * D))[lane + 64 * j];
        v[j] = a;
      }
      s += (v[j].x + v[j].y) + (v[j].z + v[j].w);
    }
    const float mean = wave_sum(s, lane) * (1.f / D);
    float s2 = 0.f;
#pragma unroll
    for (int j = 0; j < 4; ++j) { v[j] = v[j] - mean; s2 += (v[j].x * v[j].x + v[j].y * v[j].y) + (v[j].z * v[j].z + v[j].w * v[j].w); }
    const float rstd = 1.f / sqrtf(wave_sum(s2, lane) * (1.f / D) + LN_EPS);
#pragma unroll
    for (int j = 0; j < 4; ++j) {
      const f32x4 gm = ((const f32x4*)g)[lane + 64 * j], bt = ((const f32x4*)b)[lane + 64 * j];
      const f32x4 y = v[j] * rstd * gm + bt;
      ((f32x4*)(dstf + (size_t)n * D))[lane + 64 * j] = y;
      u32x2 w; w.x = pk2(y.x, y.y); w.y = pk2(y.z, y.w);
      ((u32x2*)(dstb + (size_t)n * D))[lane + 64 * j] = w;
      if (dst2) ((f32x4*)(dst2 + (size_t)n * D))[lane + 64 * j] = y;
    }
  }
}

DEV void prologue(const Params& p, LAS unsigned char* lds, int wave, int lane) {
  LAS float* scr = (LAS float*)(lds + wave * 16384);
  const int gw = blockIdx.x * 8 + wave, NGW = gridDim.x * 8;
  conv_all(p, gw, NGW, scr, lane);
  const long long tid = (long long)blockIdx.x * NTHREADS + threadIdx.x, nthr = (long long)gridDim.x * NTHREADS;
  {
    const long long padw = (long long)(N_IN_PAD - N_IN) * 1024 / 8;
    for (long long i = tid; i < 2 * padw; i += nthr) {
      const int li = (int)(i / padw); const long long r = i % padw;
      ((u32x4*)(p.wt_in + ((size_t)li * N_IN_PAD + N_IN) * 1024))[r] = (u32x4){0u, 0u, 0u, 0u};
    }
    const long long padc = (long long)128 * 2048 / 8;
    for (long long i = tid; i < 4 * padc; i += nthr) {
      const int q = (int)(i / padc); const long long r = i % padc;
      ((u32x4*)(p.wt_c1 + ((size_t)q * 256 + 128) * 2048))[r] = (u32x4){0u, 0u, 0u, 0u};
    }
    if (tid < 64) p.cnt[tid] = 0;
    for (long long i = tid; i < 2LL * BATCH * NSA_G * 64; i += nthr) {
      const long long wb = i / (NSA_G * 64), r = i % (NSA_G * 64);
      p.kcb[(wb * 128 + 127) * NSA_G * 64 + r] = 0;
    }
    for (long long i = tid; i < (long long)BATCH * MEM_LEN * 1024 / 4; i += nthr) {
      const f32x4 v = ((const f32x4*)p.mem)[i];
      u32x2 w; w.x = pk2(v.x, v.y); w.y = pk2(v.z, v.w);
      ((u32x2*)p.membf)[i] = w;
    }
  }
  ln_rows_w<0>(p, p.x, p.ln0_g, p.ln0_b, p.xf, p.xb, nullptr, gw, NGW, lane);
}

struct USched {
  int nM, nN, nwg, G, c;
  int moe, nct, total; const LAS int* tile_e;
  DEV void init_static(int M, int N, int G_, int c_) { nM = M / 256; nN = N / 256; nwg = nM * nN; G = G_; c = c_; moe = 0; nct = 1; total = nwg; tile_e = nullptr; }
  DEV void init_moe(int G_, int c_, int nct_, int total_, const LAS int* te) { nM = 1; nN = 1; nwg = total_; G = G_; c = c_; moe = 1; nct = nct_; total = total_; tile_e = te; }
  DEV bool next(int i, pg8::Unit& u) const {
    const long L = (long)i * G + c;
    if (!(moe && (G & 7) == 0) && L >= total) return false;
    if (moe) {
      if ((G & 7) == 0) {
        const int xcd = c & 7, rank = c >> 3, nr = G >> 3, T = total / nct;
        const int tlo = (T * xcd) >> 3, thi = (T * (xcd + 1)) >> 3;
        const int lu = i * nr + rank;
        if (lu >= (thi - tlo) * nct) return false;
        const int rt = tlo + lu / nct, j = lu % nct;
        u.pm = rt; u.pn = tile_e[rt] * nct + j; return true;
      }
      const int rt = (int)(L / nct), j = (int)(L % nct); u.pm = rt; u.pn = tile_e[rt] * nct + j; return true;
    }
    int wgid = (int)L; { const int q = nwg / 8, r = nwg % 8, xcd = wgid % 8, off = wgid / 8; wgid = (xcd < r ? xcd * (q + 1) : r * (q + 1) + (xcd - r) * q) + off; }
    const int nig = 8 * nN, gid = wgid / nig, fm = gid * 8, gsz = (nM - fm) < 8 ? (nM - fm) : 8;
    u.pm = fm + ((wgid % nig) % gsz); u.pn = (wgid % nig) / gsz; return true;
  }
  DEV void a_ready(const pg8::Unit&) const {}
  DEV void done(const pg8::Unit&) const {}
};

enum { EM_INPROJ = 0, EM_BRCAT, EM_RES, EM_BF16, EM_MOE1, EM_MOE2, EM_HID };
#define EPI_FENCE() asm volatile("" ::: "memory")
struct EpiU {
  static constexpr bool PERM = false, AFTER_DRAIN = false;
  int mode, ldc;
  act_t* ob;
  float* of;
  const act_t* ub;
  const float* f0;
  const float* f1;
  const int* il;
  const LAS int* te;
  DEV void mid(f32x4 (&acc)[2][2][4][2], const pg8::Unit& un, int wr, int wc, int t) const {
    if (mode != EM_BRCAT || (t != 4 && t != 20)) return;
    int l2;
    asm volatile("v_mbcnt_lo_u32_b32 %0, -1, 0\n\tv_mbcnt_hi_u32_b32 %0, -1, %0" : "=v"(l2));
    const int fr = l2 & 15, fq = l2 >> 4;
    const int row0 = un.pm * 256 + wr * 64 + fr, col0 = un.pn * 256 + wc * 32 + 4 * fq;
    const int goff = OFF_MG + (t == 4 ? 0 : D);
    const float L2E = -1.4426950408889634f;
#pragma unroll
    for (int ai = 0; ai < 2; ++ai)
#pragma unroll
      for (int m = 0; m < 4; ++m) {
        const int row = row0 + ai * 128 + m * 16;
#pragma unroll
        for (int bj = 0; bj < 2; ++bj)
#pragma unroll
          for (int n = 0; n < 2; ++n) {
            const int col = col0 + bj * 128 + n * 16;
            const act_t* gp = ub + (size_t)row * N_IN + goff + col;
            const u32x2 ga = *(const u32x2*)gp, gb = *(const u32x2*)(gp + D);
            const float ea0 = __builtin_amdgcn_exp2f(__uint_as_float(ga.x << 16) * L2E), ea1 = __builtin_amdgcn_exp2f(__uint_as_float(ga.x & 0xffff0000u) * L2E);
            const float ea2 = __builtin_amdgcn_exp2f(__uint_as_float(ga.y << 16) * L2E), ea3 = __builtin_amdgcn_exp2f(__uint_as_float(ga.y & 0xffff0000u) * L2E);
            const float eb0 = __builtin_amdgcn_exp2f(__uint_as_float(gb.x << 16) * L2E), eb1 = __builtin_amdgcn_exp2f(__uint_as_float(gb.x & 0xffff0000u) * L2E);
            const float eb2 = __builtin_amdgcn_exp2f(__uint_as_float(gb.y << 16) * L2E), eb3 = __builtin_amdgcn_exp2f(__uint_as_float(gb.y & 0xffff0000u) * L2E);
            f32x4& v = acc[ai][bj][m][n];
            v.x *= (1.0f + eb0) * __builtin_amdgcn_rcpf(1.0f + ea0); v.y *= (1.0f + eb1) * __builtin_amdgcn_rcpf(1.0f + ea1);
            v.z *= (1.0f + eb2) * __builtin_amdgcn_rcpf(1.0f + ea2); v.w *= (1.0f + eb3) * __builtin_amdgcn_rcpf(1.0f + ea3);
          }
        EPI_FENCE();
      }
  }
  DEV void operator()(const f32x4 (&acc)[2][2][4][2], const pg8::Unit& un, int wr, int wc, int fr, int fq) const {
    {
      int l2;
      asm volatile("v_mbcnt_lo_u32_b32 %0, -1, 0\n\tv_mbcnt_hi_u32_b32 %0, -1, %0" : "=v"(l2));
      fr = l2 & 15; fq = l2 >> 4;
    }
    const int row0 = un.pm * 256 + wr * 64 + fr;
    if (mode == EM_INPROJ) {
      const int col0 = un.pn * 256 + wc * 32 + 4 * fq;
#pragma unroll
      for (int bj = 0; bj < 2; ++bj)
#pragma unroll
        for (int n = 0; n < 2; ++n) {
          const int col = col0 + bj * 128 + n * 16;
          if (col < N_IN) {
            const f32x4 bv = *(const f32x4*)(f0 + col);
#pragma unroll
            for (int ai = 0; ai < 2; ++ai)
#pragma unroll
              for (int m = 0; m < 4; ++m) {
                const int row = row0 + ai * 128 + m * 16;
                const f32x4 v = acc[ai][bj][m][n] + bv;
                u32x2 w; w.x = pk2(v.x, v.y); w.y = pk2(v.z, v.w);
                *(u32x2*)(ob + (size_t)row * N_IN + col) = w;
              }
          }
          EPI_FENCE();
        }
    } else if (mode == EM_BRCAT) {
      const int col0 = un.pn * 256 + wc * 32 + 4 * fq;
#pragma unroll
      for (int ai = 0; ai < 2; ++ai)
#pragma unroll
        for (int m = 0; m < 4; ++m) {
          const int row = row0 + ai * 128 + m * 16;
#pragma unroll
          for (int bj = 0; bj < 2; ++bj)
#pragma unroll
            for (int n = 0; n < 2; ++n) {
              const int col = col0 + bj * 128 + n * 16;
              const u32x2 gw = *(const u32x2*)(ub + (size_t)row * N_IN + OFF_MG + 2 * D + col);
              f32x4 v = acc[ai][bj][m][n];
              v.x *= sigmoidf_(__uint_as_float(gw.x << 16)); v.y *= sigmoidf_(__uint_as_float(gw.x & 0xffff0000u));
              v.z *= sigmoidf_(__uint_as_float(gw.y << 16)); v.w *= sigmoidf_(__uint_as_float(gw.y & 0xffff0000u));
              u32x2 w; w.x = pk2(v.x, v.y); w.y = pk2(v.z, v.w);
              *(u32x2*)(ob + (size_t)row * D + col) = w;
            }
          EPI_FENCE();
        }
    } else if (mode == EM_RES) {
      const int col0 = un.pn * 256 + wc * 32 + 4 * fq;
#pragma unroll
      for (int ai = 0; ai < 2; ++ai)
#pragma unroll
        for (int m = 0; m < 4; ++m) {
          const int row = row0 + ai * 128 + m * 16;
#pragma unroll
          for (int bj = 0; bj < 2; ++bj)
#pragma unroll
            for (int n = 0; n < 2; ++n) {
              const int col = col0 + bj * 128 + n * 16;
              const f32x4 x = *(const f32x4*)(f0 + (size_t)row * D + col);
              *(f32x4*)(of + (size_t)row * D + col) = x * ALPHA + acc[ai][bj][m][n];
            }
          EPI_FENCE();
        }
    } else if (mode == EM_BF16) {
      const int col0 = un.pn * 256 + wc * 32 + 4 * fq;
#pragma unroll
      for (int ai = 0; ai < 2; ++ai)
#pragma unroll
        for (int m = 0; m < 4; ++m) {
          const int row = row0 + ai * 128 + m * 16;
#pragma unroll
          for (int bj = 0; bj < 2; ++bj)
#pragma unroll
            for (int n = 0; n < 2; ++n) {
              const int col = col0 + bj * 128 + n * 16;
              const f32x4 v = acc[ai][bj][m][n];
              u32x2 w; w.x = pk2(v.x, v.y); w.y = pk2(v.z, v.w);
              *(u32x2*)(ob + (size_t)row * ldc + col) = w;
            }
          EPI_FENCE();
        }
    } else if (mode == EM_MOE1) {
      const int e = te[un.pm], j = un.pn & 7;
#pragma unroll
      for (int n = 0; n < 2; ++n) {
        const int cj = j * 128 + wc * 32 + n * 16 + 4 * fq;
        const f32x4 bg = *(const f32x4*)(f0 + (size_t)e * 2048 + cj), bu = *(const f32x4*)(f0 + (size_t)e * 2048 + 1024 + cj);
#pragma unroll
        for (int ai = 0; ai < 2; ++ai)
#pragma unroll
          for (int m = 0; m < 4; ++m) {
            const int row = row0 + ai * 128 + m * 16;
            const f32x4 g = acc[ai][0][m][n] + bg, u = acc[ai][1][m][n] + bu;
            float o[4];
#pragma unroll
            for (int i = 0; i < 4; ++i) {
              const float gt = fminf(g[i], 7.0f), up = fminf(fmaxf(u[i], -7.0f), 7.0f);
              o[i] = (up + 1.0f) * gt * sigmoidf_(1.702f * gt);
            }
            u32x2 w; w.x = pk2(o[0], o[1]); w.y = pk2(o[2], o[3]);
            *(u32x2*)(ob + (size_t)row * 1024 + cj) = w;
          }
        EPI_FENCE();
      }
    } else if (mode == EM_MOE2) {
      const int e = te[un.pm], j = un.pn & 3;
      const int col0 = j * 256 + wc * 32 + 4 * fq;
#pragma unroll
      for (int ai = 0; ai < 2; ++ai)
#pragma unroll
        for (int m = 0; m < 4; ++m) {
          const int row = row0 + ai * 128 + m * 16;
          const int aid = il[row];
          if (aid >= 0) {
            const float gt = f1[aid];
#pragma unroll
            for (int bj = 0; bj < 2; ++bj)
#pragma unroll
              for (int n = 0; n < 2; ++n) {
                const int col = col0 + bj * 128 + n * 16;
                const f32x4 v = (acc[ai][bj][m][n] + *(const f32x4*)(f0 + (size_t)e * 1024 + col)) * gt;
                *(f32x4*)(of + (size_t)aid * 1024 + col) = v;
              }
          }
          EPI_FENCE();
        }
    } else if (mode == EM_HID) {
      const int col0 = wc * 32 + 4 * fq;
#pragma unroll
      for (int ai = 0; ai < 2; ++ai)
#pragma unroll
        for (int m = 0; m < 4; ++m) {
          const int row = row0 + ai * 128 + m * 16;
          if (row < CMP_ROWS) {
#pragma unroll
            for (int n = 0; n < 2; ++n) {
              const f32x4 a = acc[ai][0][m][n];
              f32x4 v; v.x = gelu_tanh(a.x); v.y = gelu_tanh(a.y); v.z = gelu_tanh(a.z); v.w = gelu_tanh(a.w);
              *(f32x4*)(of + (size_t)row * CMP_HID + col0 + n * 16) = v;
            }
          }
          EPI_FENCE();
        }
    }
  }
};

DEV int moe_tables(const Params& p, int li, LAS int* tab, int t32) {
  __syncthreads();
  if (t32 == 0) {
    int t = 0;
    for (int e = 0; e < NE; ++e) {
      const int c = p.cnt[li * 32 + e];
      tab[e] = t * 256; tab[32 + e] = c;
      const int nt = (c + 255) >> 8;
#pragma clang loop vectorize(disable) unroll(disable)
      for (int k = 0; k < nt; ++k) tab[128 + t + k] = e;
      t += nt;
    }
    tab[64] = t;
  }
  __syncthreads();
  return tab[64];
}

DEV void moe_prep(const Params& p, int li, LAS int* tab, int wave, int lane, int t32) {
  const int ntiles = moe_tables(p, li, tab, t32);
  const int gw = blockIdx.x * 8 + wave, NGW = gridDim.x * 8;
  for (int tk = gw; tk < N_TOK; tk += NGW) {
    const u32x4* src = (const u32x4*)(p.xb + (size_t)tk * 1024);
    const u32x4 v0 = src[lane], v1 = src[lane + 64];
#pragma unroll
    for (int k = 0; k < 4; ++k) {
      const int a = tk * 4 + k;
      const int row = tab[p.topi[a]] + p.rank[a];
      if (lane == 0) p.rowlist[row] = a;
      u32x4* dst = (u32x4*)(p.xg + (size_t)row * 1024);
      dst[lane] = v0; dst[lane + 64] = v1;
    }
  }
  const long long tid = (long long)blockIdx.x * NTHREADS + t32, nthr = (long long)gridDim.x * NTHREADS;
  for (long long r = tid; r < (long long)ntiles * 256; r += nthr) {
    const int e = tab[128 + (int)(r >> 8)];
    if ((int)r - tab[e] >= tab[32 + e]) p.rowlist[r] = -1;
  }
}

typedef short v4i16_t __attribute__((ext_vector_type(4)));
DEV v4i16_t tr_read(const LAS unsigned char* p) { return __builtin_amdgcn_ds_read_tr16_b64_v4i16((LAS v4i16_t*)p); }
DEV float shx(float v, int lane, int o) { return __int_as_float(__builtin_amdgcn_ds_bpermute((lane ^ o) << 2, __float_as_int(v))); }
DEV int shxi(int v, int lane, int o) { return __builtin_amdgcn_ds_bpermute((lane ^ o) << 2, v); }

constexpr int AT_ROWB = 144;
constexpr int AT_TILEB = 64 * AT_ROWB;
constexpr int AT_HALF_KV = 4 * AT_TILEB;
constexpr int AT_SLAB_OFF = 2 * AT_HALF_KV;
constexpr int AT_SLAB_WAVE = 32 * 33 * 4;
constexpr int AT_SLAB_HALF = 4 * AT_SLAB_WAVE;
constexpr int AT_XCH_OFF = AT_SLAB_OFF + 2 * AT_SLAB_HALF;
static_assert(AT_XCH_OFF + 16 <= RING_BYTES, "attention LDS map");
constexpr float SC2 = 0.125f * 1.4426950408889634f;

struct AttnState { f32x4 O[2][4]; float m[2], l[2]; };

template <bool PROB, class Job>
DEV void attn_tile(const Job& job, const LAS unsigned char* Kb, const LAS unsigned char* Vb, const bf16x8 (&qf)[2][2], AttnState& st,
                   LAS float* slab, int cur, int wih, int lane) {
  const int i15 = lane & 15, g4 = lane >> 4;
  f32x4 S[2][4];
#pragma unroll
  for (int sub = 0; sub < 2; ++sub)
#pragma unroll
    for (int t = 0; t < 4; ++t) S[sub][t] = (f32x4){0.f, 0.f, 0.f, 0.f};
#pragma unroll
  for (int t = 0; t < 4; ++t)
#pragma unroll
    for (int kk = 0; kk < 2; ++kk) {
      const bf16x8 kf = *(const LAS bf16x8*)(Kb + (16 * t + i15) * AT_ROWB + (kk * 32 + 8 * g4) * 2);
#pragma unroll
      for (int sub = 0; sub < 2; ++sub) S[sub][t] = __builtin_amdgcn_mfma_f32_16x16x32_bf16(kf, qf[sub][kk], S[sub][t], 0, 0, 0);
    }
  bf16x8 pf[2][2];
  const bool efree = job.elemfree(cur, wih);
#pragma unroll
  for (int sub = 0; sub < 2; ++sub) {
    const int row = wih * 32 + sub * 16 + i15;
    if (!efree) {
      const int mbv = job.mb(row, cur, g4);
#pragma unroll
      for (int t = 0; t < 4; ++t)
#pragma unroll
        for (int j = 0; j < 4; ++j) S[sub][t][j] = job.ok(mbv, 16 * t + j) ? S[sub][t][j] : -INFINITY;
    }
    float mx = fmaxf(fmaxf(S[sub][0][0], S[sub][0][1]), fmaxf(S[sub][0][2], S[sub][0][3]));
#pragma unroll
    for (int t = 1; t < 4; ++t) mx = fmaxf(fmaxf(mx, fmaxf(S[sub][t][0], S[sub][t][1])), fmaxf(S[sub][t][2], S[sub][t][3]));
    if (!PROB) {
      mx = fmaxf(mx, shx(mx, lane, 16));
      mx = fmaxf(mx, shx(mx, lane, 32));
      const bool rok = job.rowok(sub, cur);
      const float mcand = rok ? mx * SC2 : -INFINITY;
      const float mnew = fmaxf(st.m[sub], mcand);
      const float msafe = (mnew == -INFINITY) ? 0.f : mnew;
      const float corr = __builtin_amdgcn_exp2f(st.m[sub] - msafe);
      st.m[sub] = mnew;
      const float msub = rok ? msafe : INFINITY;
      float psum = 0.f;
#pragma unroll
      for (int t = 0; t < 4; ++t)
#pragma unroll
        for (int j = 0; j < 4; ++j) { const float pp = __builtin_amdgcn_exp2f(__builtin_fmaf(S[sub][t][j], SC2, -msub)); S[sub][t][j] = pp; psum += pp; }
      st.l[sub] = st.l[sub] * corr + psum;
      if (__builtin_amdgcn_ballot_w64(corr != 1.0f) != 0ull) {
#pragma unroll
        for (int dt = 0; dt < 4; ++dt) st.O[sub][dt] *= corr;
      }
#pragma unroll
      for (int s2 = 0; s2 < 2; ++s2) {
        u32x4 w;
        w.x = pk2(S[sub][2 * s2][0], S[sub][2 * s2][1]); w.y = pk2(S[sub][2 * s2][2], S[sub][2 * s2][3]);
        w.z = pk2(S[sub][2 * s2 + 1][0], S[sub][2 * s2 + 1][1]); w.w = pk2(S[sub][2 * s2 + 1][2], S[sub][2 * s2 + 1][3]);
        pf[sub][s2] = __builtin_bit_cast(bf16x8, w);
      }
    } else {
      const float msafe = (st.m[sub] == -INFINITY) ? 0.f : st.m[sub];
      const int q = sub * 16 + i15;
#pragma unroll
      for (int t = 0; t < 4; ++t) {
        const float p0 = __builtin_amdgcn_exp2f(__builtin_fmaf(S[sub][t][0], SC2, -msafe)) * st.l[sub], p1 = __builtin_amdgcn_exp2f(__builtin_fmaf(S[sub][t][1], SC2, -msafe)) * st.l[sub];
        const float p2 = __builtin_amdgcn_exp2f(__builtin_fmaf(S[sub][t][2], SC2, -msafe)) * st.l[sub], p3 = __builtin_amdgcn_exp2f(__builtin_fmaf(S[sub][t][3], SC2, -msafe)) * st.l[sub];
        const int jb = 16 * cur + 4 * t + g4;
        slab[q * 33 + jb] += (p0 + p1) + (p2 + p3);
        S[sub][t][3] = p3;
      }
      asm volatile("s_waitcnt lgkmcnt(0)" ::: "memory");
#pragma unroll
      for (int t = 0; t < 4; ++t) {
        const int jb = 16 * cur + 4 * t + g4 + 1;
        if (jb < 32) slab[q * 33 + jb] += S[sub][t][3];
      }
      asm volatile("s_waitcnt lgkmcnt(0)" ::: "memory");
    }
  }
  if (!PROB) {
#pragma unroll
    for (int dt = 0; dt < 4; ++dt)
#pragma unroll
      for (int s2 = 0; s2 < 2; ++s2) {
        const LAS unsigned char* vp = Vb + (32 * s2 + 4 * g4 + (i15 >> 2)) * AT_ROWB + (16 * dt + 4 * (lane & 3)) * 2;
        const v4i16_t lo = tr_read(vp), hi = tr_read(vp + 16 * AT_ROWB);
        bf16x8 vf;
        vf[0] = lo[0]; vf[1] = lo[1]; vf[2] = lo[2]; vf[3] = lo[3]; vf[4] = hi[0]; vf[5] = hi[1]; vf[6] = hi[2]; vf[7] = hi[3];
#pragma unroll
        for (int sub = 0; sub < 2; ++sub) st.O[sub][dt] = __builtin_amdgcn_mfma_f32_16x16x32_bf16(vf, pf[sub][s2], st.O[sub][dt], 0, 0, 0);
      }
  }
}

template <bool PROB, class Job>
DEV void attn_run(const Job& job, LAS unsigned char* lds, AttnState& st, int half, int hth, int wih, int lane) {
  LAS unsigned char* kvh = lds + half * AT_HALF_KV;
  LAS int* xch = (LAS int*)(lds + AT_XCH_OFF);
  LAS float* slab = (LAS float*)(lds + AT_SLAB_OFF + half * AT_SLAB_HALF + wih * AT_SLAB_WAVE);
  const int i15 = lane & 15, g4 = lane >> 4;
  unsigned rem = job.tilemask();
  if (hth == 0) xch[half] = __builtin_popcount(rem);
  bf16x8 qf[2][2];
#pragma unroll
  for (int sub = 0; sub < 2; ++sub) {
    const act_t* qr = job.qrow(wih * 32 + sub * 16 + i15);
#pragma unroll
    for (int kk = 0; kk < 2; ++kk) qf[sub][kk] = *(const bf16x8*)(qr + kk * 32 + 8 * g4);
  }
  if (!PROB) {
#pragma unroll
    for (int sub = 0; sub < 2; ++sub) {
      st.m[sub] = -INFINITY; st.l[sub] = 0.f;
#pragma unroll
      for (int dt = 0; dt < 4; ++dt) st.O[sub][dt] = (f32x4){0.f, 0.f, 0.f, 0.f};
    }
  }
  const int srow = hth >> 2, sch = hth & 3;
  u32x4 ak0, ak1, av0, av1;
#define AT_LOAD(k0, k1, v0, v1, T) do { const act_t* kr_ = job.krow(T, srow) + sch * 16; k0 = *(const u32x4*)kr_; k1 = *(const u32x4*)(kr_ + 8); \
    if (!PROB) { const act_t* vr_ = job.vrow(T, srow) + sch * 16; v0 = *(const u32x4*)vr_; v1 = *(const u32x4*)(vr_ + 8); } } while (0)
#define AT_WRITE(k0, k1, v0, v1, BUF) do { LAS unsigned char* kd_ = kvh + (BUF) * AT_TILEB + srow * AT_ROWB + sch * 32; *(LAS u32x4*)kd_ = k0; *(LAS u32x4*)(kd_ + 16) = k1; \
    if (!PROB) { LAS unsigned char* vd_ = kvh + (2 + (BUF)) * AT_TILEB + srow * AT_ROWB + sch * 32; *(LAS u32x4*)vd_ = v0; *(LAS u32x4*)(vd_ + 16) = v1; } } while (0)
#define AT_NEXT(T) do { T = -1; if (rem) { T = __builtin_ctz(rem); rem &= rem - 1; } } while (0)
  int t0;
  AT_NEXT(t0);
  if (t0 >= 0) { AT_LOAD(ak0, ak1, av0, av1, t0); AT_WRITE(ak0, ak1, av0, av1, 0); }
  __syncthreads();
  const int niter = max(xch[0], xch[1]);
  for (int it = 0; it < niter; ++it) {
    int t1;
    AT_NEXT(t1);
    if (t1 >= 0) AT_LOAD(ak0, ak1, av0, av1, t1);
    if (t0 >= 0) attn_tile<PROB>(job, kvh + (it & 1) * AT_TILEB, kvh + (2 + (it & 1)) * AT_TILEB, qf, st, slab, t0, wih, lane);
    if (t1 >= 0) AT_WRITE(ak0, ak1, av0, av1, (it + 1) & 1);
    __syncthreads();
    t0 = t1;
  }
#undef AT_LOAD
#undef AT_WRITE
#undef AT_NEXT
  if (!PROB) {
#pragma unroll
    for (int sub = 0; sub < 2; ++sub) {
      float l = st.l[sub];
      l += shx(l, lane, 16);
      l += shx(l, lane, 32);
      const float inv = 1.0f / fmaxf(l, 1e-30f);
      st.l[sub] = l;
#pragma unroll
      for (int dt = 0; dt < 4; ++dt) st.O[sub][dt] *= inv;
    }
  }
  __syncthreads();
}

struct SelJob {
  const act_t* u; int b, g, t0; unsigned um; unsigned tm[2];
  DEV unsigned tilemask() const { return um; }
  DEV const act_t* qrow(int r) const { return u + ((size_t)b * SEQ + t0 + (r & 31)) * N_IN + OFF_CQ + (g * 4 + (r >> 5)) * 64; }
  DEV const act_t* krow(int kt, int j) const { return u + ((size_t)b * SEQ + kt * 64 + j) * N_IN + OFF_CKS + g * 64; }
  DEV const act_t* vrow(int kt, int j) const { return u + ((size_t)b * SEQ + kt * 64 + j) * N_IN + OFF_CVS + g * 64; }
  DEV int mb(int r, int kt, int g4) const { return t0 + (r & 31) - kt * 64 - 4 * g4; }
  DEV bool rowok(int sub, int kt) const { return (tm[sub] >> kt) & 1u; }
  DEV bool ok(int m, int C) const { return m >= C; }
  DEV bool elemfree(int kt, int wih) const { return kt < (t0 >> 6); }
};
struct WinJob {
  const act_t* u; int b, g, t0; unsigned um;
  DEV unsigned tilemask() const { return um; }
  DEV const act_t* qrow(int r) const { return u + ((size_t)b * SEQ + t0 + (r & 31)) * N_IN + OFF_CQ + (g * 4 + (r >> 5)) * 64; }
  DEV const act_t* krow(int kt, int j) const { return u + ((size_t)b * SEQ + kt * 64 + j) * N_IN + OFF_CKW + g * 64; }
  DEV const act_t* vrow(int kt, int j) const { return u + ((size_t)b * SEQ + kt * 64 + j) * N_IN + OFF_CVW + g * 64; }
  DEV int mb(int r, int kt, int g4) const { return t0 + (r & 31) - kt * 64 - 4 * g4; }
  DEV bool rowok(int sub, int kt) const { return true; }
  DEV bool ok(int m, int C) const { return m >= C && m < NSA_WIN + C; }
  DEV bool elemfree(int kt, int wih) const { return kt * 64 + 63 <= t0 && t0 + 31 - kt * 64 < NSA_WIN; }
};
struct CmpJob {
  const act_t* u; const act_t* kcb; const act_t* vcb; int b, g, t0; unsigned um;
  DEV unsigned tilemask() const { return um; }
  DEV const act_t* qrow(int r) const { return u + ((size_t)b * SEQ + t0 + (r & 31)) * N_IN + OFF_CQ + (g * 4 + (r >> 5)) * 64; }
  DEV const act_t* krow(int kt, int j) const { return kcb + (((size_t)b * 128 + kt * 64 + j) * NSA_G + g) * 64; }
  DEV const act_t* vrow(int kt, int j) const { return vcb + (((size_t)b * 128 + kt * 64 + j) * NSA_G + g) * 64; }
  DEV int mb(int r, int kt, int g4) const { return t0 + (r & 31) - 31 - 16 * (kt * 64 + 4 * g4); }
  DEV bool rowok(int sub, int kt) const { return true; }
  DEV bool ok(int m, int C) const { return m >= 16 * C; }
  DEV bool elemfree(int kt, int wih) const { return kt == 0 && 16 * 63 + 31 <= t0; }
};
struct DilJob {
  const act_t* u; int b, col, dil, res, l0; unsigned um;
  DEV unsigned tilemask() const { return um; }
  DEV const act_t* qrow(int r) const { return u + ((size_t)b * SEQ + (l0 + r) * dil + res) * N_IN + OFF_AQ + col; }
  DEV const act_t* krow(int kt, int j) const { return u + ((size_t)b * SEQ + (kt * 64 + j) * dil + res) * N_IN + OFF_AK + col; }
  DEV const act_t* vrow(int kt, int j) const { return u + ((size_t)b * SEQ + (kt * 64 + j) * dil + res) * N_IN + OFF_AV + col; }
  DEV int mb(int r, int kt, int g4) const { return l0 + r - kt * 64 - 4 * g4; }
  DEV bool rowok(int sub, int kt) const { return true; }
  DEV bool ok(int m, int C) const { return m >= C && m <= 128 + C; }
  DEV bool elemfree(int kt, int wih) const { return kt * 64 + 63 <= l0 + 32 * wih && l0 + 32 * wih + 31 - kt * 64 <= 128; }
};

DEV unsigned range_mask(int lo, int hi) {
  return (hi >= 31 ? 0xffffffffu : ((1u << (hi + 1)) - 1u)) & ~((1u << lo) - 1u);
}

DEV bool nsa_unit(int round, int bid, int G, int half, int& b, int& g, int& tb) {
  if ((G & 7) == 0) {
    const int nr = G >> 3, rank = bid >> 3;
    const int slot = rank * 2 + half, nslot = nr * 2;
    const int pos = (round & 1) ? (nslot - 1 - slot) : slot;
    const int lu = round * nslot + pos;
    if (lu >= 256) return false;
    b = bid & 7; g = lu & 3; tb = 63 - (lu >> 2);
    return true;
  }
  const int pos = (round & 1) ? (G - 1 - bid) : bid;
  const int pair = round * G + pos;
  if (pair >= 1024) return false;
  const int un = pair * 2 + half;
  tb = 63 - un / 32; b = (un % 32) / 4; g = un % 4;
  return true;
}
DEV int nsa_rounds(int G) { return (G & 7) == 0 ? (256 + (G >> 3) * 2 - 1) / ((G >> 3) * 2) : (1024 + G - 1) / G; }

DEV void nsa_cmp_phase(const Params& p, LAS unsigned char* lds, int t32, int bid, int G) {
  const int lane = t32 & 63, wave = t32 >> 6, half = wave >> 2, wih = wave & 3, hth = t32 & 255;
  const int i15 = lane & 15, g4 = lane >> 4;
  LAS float* slabh = (LAS float*)(lds + AT_SLAB_OFF + half * AT_SLAB_HALF);
  for (int round = 0; round < nsa_rounds(G); ++round) {
    int b = 0, g = 0, tb = 0;
    const bool act = nsa_unit(round, bid, G, half, b, g, tb);
    const int t0 = tb * 32;
    const int nvmax = t0 + 31 >= 31 ? (t0 + 31 - 31) / 16 + 1 : 0;
    CmpJob job{p.u, p.kcb, p.kcb + (size_t)BATCH * 128 * NSA_G * 64, b, g, t0, 0u};
    job.um = !act ? 0u : (nvmax > 64 ? 3u : (nvmax > 0 ? 1u : 0u));
    for (int i = lane; i < 32 * 33; i += 64) slabh[wih * (32 * 33) + i] = 0.f;
    AttnState st;
    attn_run<false>(job, lds, st, half, hth, wih, lane);
    if (act) {
#pragma unroll
      for (int sub = 0; sub < 2; ++sub) {
        const int hh = g * 4 + wih;
        const size_t n = (size_t)b * SEQ + t0 + sub * 16 + i15;
        const float g0 = sigmoidf_(ldf(p.u[n * N_IN + OFF_CG + hh * 3 + 0]));
#pragma unroll
        for (int dt = 0; dt < 4; ++dt) *(f32x4*)(p.ocmp + n * 1024 + hh * 64 + 16 * dt + 4 * g4) = st.O[sub][dt] * g0;
        st.l[sub] = 1.0f / fmaxf(st.l[sub], 1e-30f);
      }
    }
    attn_run<true>(job, lds, st, half, hth, wih, lane);
    {
      const int q = hth >> 3, j4 = (hth & 7) * 4;
      float v[4];
#pragma unroll
      for (int i = 0; i < 4; ++i) {
        float s = 0.f;
#pragma unroll
        for (int w = 0; w < 4; ++w) s += slabh[w * (32 * 33) + q * 33 + j4 + i];
        const int j = j4 + i, qb = (t0 + q) >> 6;
        if (j == 0 || j == qb || j == qb - 1) s = INFINITY;
        else if (j > qb) s = -INFINITY;
        v[i] = s;
      }
      __syncthreads();
#pragma unroll
      for (int i = 0; i < 4; ++i) slabh[q * 33 + j4 + i] = v[i];
      __syncthreads();
      unsigned bits = 0u;
#pragma unroll
      for (int i = 0; i < 4; ++i) {
        int rank = 0;
#pragma unroll 1
        for (int jj = 0; jj < 32; ++jj) { const float w = slabh[q * 33 + jj]; rank += (w > v[i] || (w == v[i] && jj < j4 + i)) ? 1 : 0; }
        if (rank < N_SELECT) bits |= 1u << (j4 + i);
      }
      bits |= (unsigned)shxi((int)bits, lane, 1);
      bits |= (unsigned)shxi((int)bits, lane, 2);
      bits |= (unsigned)shxi((int)bits, lane, 4);
      if (act && (hth & 7) == 0) p.selm[((size_t)b * NSA_G + g) * SEQ + t0 + q] = bits;
      __syncthreads();
    }
  }
}

DEV void nsa_main_phase(const Params& p, LAS unsigned char* lds, int t32, int bid, int G) {
  const int lane = t32 & 63, wave = t32 >> 6, half = wave >> 2, wih = wave & 3, hth = t32 & 255;
  const int i15 = lane & 15, g4 = lane >> 4;
  for (int round2 = 0; round2 < nsa_rounds(G) * (NSA_PROBE == 5 ? 2 : 1); ++round2) {
    const int round = (NSA_PROBE == 5) ? (round2 >> 1) : round2;
    int b = 0, g = 0, tb = 0;
    const bool act = nsa_unit(round, bid, G, half, b, g, tb);
    const int t0 = tb * 32;
    SelJob sj{p.u, b, g, t0, 0u, {0u, 0u}};
    if (act) {
      const unsigned* sm = p.selm + ((size_t)b * NSA_G + g) * SEQ + t0;
      sj.tm[0] = sm[i15]; sj.tm[1] = sm[16 + i15];
      unsigned um = sj.tm[0] | sj.tm[1];
      um |= (unsigned)shxi((int)um, lane, 1); um |= (unsigned)shxi((int)um, lane, 2);
      um |= (unsigned)shxi((int)um, lane, 4); um |= (unsigned)shxi((int)um, lane, 8);
      sj.um = um & range_mask(0, t0 >> 6);
    }
    u32x2 base[2][4];
    const int hh = g * 4 + wih;
    const size_t nrow0 = (size_t)b * SEQ + t0 + i15;
    const act_t gq10 = p.u[nrow0 * N_IN + OFF_CG + hh * 3 + 1], gq11 = p.u[(nrow0 + 16) * N_IN + OFF_CG + hh * 3 + 1];
    const act_t gq20 = p.u[nrow0 * N_IN + OFF_CG + hh * 3 + 2], gq21 = p.u[(nrow0 + 16) * N_IN + OFF_CG + hh * 3 + 2];
    {
      AttnState ss;
      attn_run<false>(sj, lds, ss, half, hth, wih, lane);
#if NSA_PROBE == 1
      attn_run<false>(sj, lds, ss, half, hth, wih, lane);
#endif
#pragma unroll
      for (int sub = 0; sub < 2; ++sub) {
        f32x4 oc[4];
#pragma unroll
        for (int dt = 0; dt < 4; ++dt) oc[dt] = *(const f32x4*)(p.ocmp + (nrow0 + 16 * sub) * 1024 + hh * 64 + 16 * dt + 4 * g4);
        const float g1 = sigmoidf_(ldf(sub ? gq11 : gq10));
#pragma unroll
        for (int dt = 0; dt < 4; ++dt) {
          const f32x4 y = ss.O[sub][dt] * g1 + oc[dt];
          base[sub][dt].x = pk2(y.x, y.y); base[sub][dt].y = pk2(y.z, y.w);
        }
      }
    }
    WinJob wj{p.u, b, g, t0, 0u};
    if (act) { const int lo = t0 - (NSA_WIN - 1) < 0 ? 0 : (t0 - (NSA_WIN - 1)) >> 6; wj.um = range_mask(lo, (t0 + 31) >> 6); }
    AttnState ws;
    attn_run<false>(wj, lds, ws, half, hth, wih, lane);
#if NSA_PROBE == 2
    attn_run<false>(wj, lds, ws, half, hth, wih, lane);
#endif
    if (act) {
#pragma unroll
      for (int sub = 0; sub < 2; ++sub) {
        const size_t n = nrow0 + 16 * sub;
        const float g2 = sigmoidf_(ldf(sub ? gq21 : gq20));
#pragma unroll
        for (int dt = 0; dt < 4; ++dt) {
          const u32x2 bw = base[sub][dt];
          f32x4 y = ws.O[sub][dt] * g2;
          y.x += __uint_as_float(bw.x << 16); y.y += __uint_as_float(bw.x & 0xffff0000u);
          y.z += __uint_as_float(bw.y << 16); y.w += __uint_as_float(bw.y & 0xffff0000u);
          u32x2 w; w.x = pk2(y.x, y.y); w.y = pk2(y.z, y.w);
          *(u32x2*)(p.yc + n * YLD + hh * 64 + 16 * dt + 4 * g4) = w;
        }
      }
    }
  }
}

DEV void dil_phase(const Params& p, LAS unsigned char* lds, int t32, int bid, int G) {
  const int lane = t32 & 63, wave = t32 >> 6, half = wave >> 2, wih = wave & 3, hth = t32 & 255;
  const int i15 = lane & 15, g4 = lane >> 4;
  const bool xm = (G & 7) == 0;
  const int npair = xm ? 96 : 768, pstep = xm ? (G >> 3) : G;
  for (int pair = xm ? (bid >> 3) : bid; pair < npair; pair += pstep) {
    const int un = pair * 2 + half;
    int gi, b, r2;
    if (xm) { b = bid & 7; gi = un / 64; r2 = un % 64; }
    else { gi = un / 512; const int r = un % 512; b = r / 64; r2 = r % 64; }
    const int dil = gi == 0 ? 1 : (gi == 1 ? 4 : 16);
    const int nlb = 16 / dil;
    const int h = r2 / 16, r3 = r2 % 16;
    const int res = r3 / nlb, lb = r3 % nlb;
    const int l0 = lb * 128;
    DilJob job{p.u, b, gi * 256 + h * 64, dil, res, l0, 0u};
    job.um = range_mask(l0 >= 128 ? (l0 - 128) >> 6 : 0, (l0 + 127) >> 6);
    AttnState st;
    attn_run<false>(job, lds, st, half, hth, wih, lane);
#pragma unroll
    for (int sub = 0; sub < 2; ++sub) {
      const int l = l0 + wih * 32 + sub * 16 + i15;
      const size_t n = (size_t)b * SEQ + l * dil + res;
#pragma unroll
      for (int dt = 0; dt < 4; ++dt) {
        const f32x4 y = st.O[sub][dt];
        u32x2 w; w.x = pk2(y.x, y.y); w.y = pk2(y.z, y.w);
        *(u32x2*)(p.dilo + ((size_t)gi * N_TOK + n) * 256 + h * 64 + 16 * dt + 4 * g4) = w;
      }
      if (g4 == 0) p.dill[((size_t)gi * N_TOK + n) * 4 + h] = st.m[sub] + __builtin_amdgcn_logf(st.l[sub]);
    }
  }
}

DEV void dil_combine(const Params& p, long long tid, long long nthr) {
  for (long long idx = tid; idx < (long long)N_TOK * 32; idx += nthr) {
    const size_t n = idx >> 5; const int c8 = (int)(idx & 31) * 8, h = c8 >> 6;
    const float l0 = p.dill[((size_t)0 * N_TOK + n) * 4 + h], l1 = p.dill[((size_t)1 * N_TOK + n) * 4 + h], l2 = p.dill[((size_t)2 * N_TOK + n) * 4 + h];
    const float mx = fmaxf(l0, fmaxf(l1, l2));
    float w0 = __builtin_amdgcn_exp2f(l0 - mx), w1 = __builtin_amdgcn_exp2f(l1 - mx), w2 = __builtin_amdgcn_exp2f(l2 - mx);
    const float inv = 1.0f / (w0 + w1 + w2);
    w0 *= inv; w1 *= inv; w2 *= inv;
    const u32x4 a = *(const u32x4*)(p.dilo + ((size_t)0 * N_TOK + n) * 256 + c8);
    const u32x4 bq = *(const u32x4*)(p.dilo + ((size_t)1 * N_TOK + n) * 256 + c8);
    const u32x4 c = *(const u32x4*)(p.dilo + ((size_t)2 * N_TOK + n) * 256 + c8);
    u32x4 o;
#pragma unroll
    for (int i = 0; i < 4; ++i) {
      const float lo = w0 * __uint_as_float(a[i] << 16) + w1 * __uint_as_float(bq[i] << 16) + w2 * __uint_as_float(c[i] << 16);
      const float hi = w0 * __uint_as_float(a[i] & 0xffff0000u) + w1 * __uint_as_float(bq[i] & 0xffff0000u) + w2 * __uint_as_float(c[i] & 0xffff0000u);
      o[i] = pk2(lo, hi);
    }
    *(u32x4*)(p.ya + n * YLD + c8) = o;
  }
}

DEV void cmpa_build(const Params& p, int li, long long tid, long long nthr) {
  for (long long idx = tid; idx < 2LL * CMP_ROWS * 256; idx += nthr) {
    const int which = (int)(idx / ((long long)CMP_ROWS * 256));
    const long long rem = idx % ((long long)CMP_ROWS * 256);
    const int row = (int)(rem >> 8), c8 = (int)(rem & 255) * 8, l = c8 >> 6, d = c8 & 63;
    const int g = row % NSA_G, c = (row / NSA_G) % N_CMP, b = row / (NSA_G * N_CMP);
    const float* pe = (which ? p.cmp_pe_v : p.cmp_pe_k) + (size_t)li * 32 * HD + l * HD + d;
    const u32x4 uv = *(const u32x4*)(p.u + ((size_t)b * SEQ + c * 16 + l) * N_IN + (which ? OFF_CVC : OFF_CKC) + g * HD + d);
    u32x4 o;
#pragma unroll
    for (int i = 0; i < 4; ++i) o[i] = pk2(__uint_as_float(uv[i] << 16) + pe[2 * i], __uint_as_float(uv[i] & 0xffff0000u) + pe[2 * i + 1]);
    *(u32x4*)(p.cmpA + ((size_t)which * CMP_ROWS_PAD + row) * 2048 + c8) = o;
  }
}

constexpr int XA_ROWB = 528;
constexpr int XA_TILEB = 32 * XA_ROWB;
static_assert(4 * XA_TILEB <= RING_BYTES, "xattn LDS map");
DEV void xattn_phase(const Params& p, LAS unsigned char* lds, int t32, int bid, int G) {
  const int lane = t32 & 63, wave = t32 >> 6, i15 = lane & 15, g4 = lane >> 4;
  const float sc2 = 0.0625f * 1.4426950408889634f;
  const bool xm = (G & 7) == 0;
  const int nun = xm ? XH * (SEQ / 128) : BATCH * XH * (SEQ / 128), ustep = xm ? (G >> 3) : G;
  for (int un = xm ? (bid >> 3) : bid; un < nun; un += ustep) {
    const int b = xm ? (bid & 7) : un / (XH * (SEQ / 128)), r = un % (XH * (SEQ / 128)), h = r / (SEQ / 128), qb = r % (SEQ / 128);
    const size_t nq = (size_t)b * SEQ + qb * 128 + wave * 16 + i15;
    bf16x8 qf[8];
#pragma unroll
    for (int kk = 0; kk < 8; ++kk) qf[kk] = *(const bf16x8*)(p.xq + nq * 1024 + h * 256 + kk * 32 + 8 * g4);
    f32x4 O[16];
#pragma unroll
    for (int dt = 0; dt < 16; ++dt) O[dt] = (f32x4){0.f, 0.f, 0.f, 0.f};
    float m = -INFINITY, l = 0.f;
    const int srow = t32 >> 4, sch = t32 & 15;
    const act_t* kbase = p.memk + ((size_t)b * MEM_LEN + srow) * 1024 + h * 256 + sch * 16;
    const act_t* vbase = p.memv + ((size_t)b * MEM_LEN + srow) * 1024 + h * 256 + sch * 16;
    u32x4 sk0 = *(const u32x4*)kbase, sk1 = *(const u32x4*)(kbase + 8), sv0 = *(const u32x4*)vbase, sv1 = *(const u32x4*)(vbase + 8);
    {
      LAS unsigned char* kd = lds + srow * XA_ROWB + sch * 32;
      *(LAS u32x4*)kd = sk0; *(LAS u32x4*)(kd + 16) = sk1;
      LAS unsigned char* vd = lds + 2 * XA_TILEB + srow * XA_ROWB + sch * 32;
      *(LAS u32x4*)vd = sv0; *(LAS u32x4*)(vd + 16) = sv1;
    }
    __syncthreads();
    for (int it = 0; it < MEM_LEN / 32; ++it) {
      if (it + 1 < MEM_LEN / 32) {
        const act_t* kr = kbase + (size_t)(it + 1) * 32 * 1024, *vr = vbase + (size_t)(it + 1) * 32 * 1024;
        sk0 = *(const u32x4*)kr; sk1 = *(const u32x4*)(kr + 8); sv0 = *(const u32x4*)vr; sv1 = *(const u32x4*)(vr + 8);
      }
      const LAS unsigned char* Kb = lds + (it & 1) * XA_TILEB;
      const LAS unsigned char* Vb = lds + (2 + (it & 1)) * XA_TILEB;
      f32x4 S[2];
      S[0] = (f32x4){0.f, 0.f, 0.f, 0.f}; S[1] = (f32x4){0.f, 0.f, 0.f, 0.f};
#pragma unroll
      for (int t = 0; t < 2; ++t)
#pragma unroll
        for (int kk = 0; kk < 8; ++kk) {
          const bf16x8 kf = *(const LAS bf16x8*)(Kb + (16 * t + i15) * XA_ROWB + (kk * 32 + 8 * g4) * 2);
          S[t] = __builtin_amdgcn_mfma_f32_16x16x32_bf16(kf, qf[kk], S[t], 0, 0, 0);
        }
      float mx = -INFINITY;
#pragma unroll
      for (int t = 0; t < 2; ++t)
#pragma unroll
        for (int j = 0; j < 4; ++j) { S[t][j] *= sc2; mx = fmaxf(mx, S[t][j]); }
      mx = fmaxf(mx, shx(mx, lane, 16));
      mx = fmaxf(mx, shx(mx, lane, 32));
      const float mnew = fmaxf(m, mx);
      const float corr = __builtin_amdgcn_exp2f(m - mnew);
      m = mnew;
      float psum = 0.f;
#pragma unroll
      for (int t = 0; t < 2; ++t)
#pragma unroll
        for (int j = 0; j < 4; ++j) { const float pp = __builtin_amdgcn_exp2f(S[t][j] - mnew); S[t][j] = pp; psum += pp; }
      l = l * corr + psum;
      u32x4 w;
      w.x = pk2(S[0][0], S[0][1]); w.y = pk2(S[0][2], S[0][3]); w.z = pk2(S[1][0], S[1][1]); w.w = pk2(S[1][2], S[1][3]);
      const bf16x8 pf = __builtin_bit_cast(bf16x8, w);
#pragma unroll
      for (int dt = 0; dt < 16; ++dt) {
        const LAS unsigned char* vp = Vb + (4 * g4 + (i15 >> 2)) * XA_ROWB + (16 * dt + 4 * (lane & 3)) * 2;
        const v4i16_t lo = tr_read(vp), hi = tr_read(vp + 16 * XA_ROWB);
        bf16x8 vf;
        vf[0] = lo[0]; vf[1] = lo[1]; vf[2] = lo[2]; vf[3] = lo[3]; vf[4] = hi[0]; vf[5] = hi[1]; vf[6] = hi[2]; vf[7] = hi[3];
        O[dt] = __builtin_amdgcn_mfma_f32_16x16x32_bf16(vf, pf, O[dt] * corr, 0, 0, 0);
      }
      if (it + 1 < MEM_LEN / 32) {
        LAS unsigned char* kd = lds + ((it + 1) & 1) * XA_TILEB + srow * XA_ROWB + sch * 32;
        *(LAS u32x4*)kd = sk0; *(LAS u32x4*)(kd + 16) = sk1;
        LAS unsigned char* vd = lds + (2 + ((it + 1) & 1)) * XA_TILEB + srow * XA_ROWB + sch * 32;
        *(LAS u32x4*)vd = sv0; *(LAS u32x4*)(vd + 16) = sv1;
      }
      __syncthreads();
    }
    l += shx(l, lane, 16);
    l += shx(l, lane, 32);
    const float inv = 1.0f / l;
#pragma unroll
    for (int dt = 0; dt < 16; ++dt) {
      const f32x4 y = O[dt] * inv;
      u32x2 w; w.x = pk2(y.x, y.y); w.y = pk2(y.z, y.w);
      *(u32x2*)(p.xo + nq * 1024 + h * 256 + 16 * dt + 4 * g4) = w;
    }
  }
}

DEV void route_phase(const Params& p, int li, int gw, int NGW, int lane) {
  const float* W = p.w_router + (size_t)li * D * NE;
  const int e = lane & 31, hf = lane >> 5;
  for (int n = gw; n < N_TOK; n += NGW) {
    const float* xr = p.xf + (size_t)n * D + hf * 512;
    const float* wr = W + (size_t)hf * 512 * NE + e;
    float a0 = 0.f, a1 = 0.f, a2 = 0.f, a3 = 0.f;
    for (int k = 0; k < 512; k += 4) {
      const f32x4 x = *(const f32x4*)(xr + k);
      a0 += x.x * wr[(size_t)k * NE]; a1 += x.y * wr[(size_t)(k + 1) * NE];
      a2 += x.z * wr[(size_t)(k + 2) * NE]; a3 += x.w * wr[(size_t)(k + 3) * NE];
    }
    float v = (a0 + a1) + (a2 + a3);
    v += shx(v, lane, 32);
    v += p.b_router[li * NE + e];
    int sel[4]; float sv[4];
    float cur = v;
#pragma unroll
    for (int k = 0; k < 4; ++k) {
      float bv = cur; int bi = e;
#pragma unroll
      for (int o = 1; o < 32; o <<= 1) {
        const float ov = shx(bv, lane, o); const int oi = shxi(bi, lane, o);
        if (ov > bv || (ov == bv && oi < bi)) { bv = ov; bi = oi; }
      }
      sel[k] = bi; sv[k] = bv;
      if (e == bi) cur = -INFINITY;
    }
    if (lane == 0) {
      const float e1 = expf(sv[1] - sv[0]), e2 = expf(sv[2] - sv[0]), e3 = expf(sv[3] - sv[0]);
      const float inv = 1.0f / (1.0f + e1 + e2 + e3);
      p.topg[n * 4 + 0] = inv; p.topg[n * 4 + 1] = e1 * inv; p.topg[n * 4 + 2] = e2 * inv; p.topg[n * 4 + 3] = e3 * inv;
#pragma unroll
      for (int k = 0; k < 4; ++k) { p.topi[n * 4 + k] = sel[k]; p.rank[n * 4 + k] = atomicAdd(&p.cnt[li * 32 + sel[k]], 1); }
    }
  }
}

DEV void kcv_phase(const Params& p, int li, long long tid, long long nthr) {
  for (long long i2 = tid; i2 < 2LL * CMP_ROWS * HD; i2 += nthr) {
    const int which = (int)(i2 / ((long long)CMP_ROWS * HD));
    const long long rem = i2 % ((long long)CMP_ROWS * HD);
    const int row = (int)(rem / HD), d = (int)(rem % HD);
    const float* w2 = (which ? p.cmp_w2_v : p.cmp_w2_k) + (size_t)li * CMP_HID * HD;
    const float* hr = p.hid + ((size_t)which * CMP_ROWS + row) * CMP_HID;
    float s = 0.f;
#pragma unroll 8
    for (int j = 0; j < CMP_HID; ++j) s += hr[j] * w2[j * HD + d];
    const int g_ = row % NSA_G, c_ = (row / NSA_G) % N_CMP, b_ = row / (NSA_G * N_CMP);
    p.kcb[((((size_t)which * BATCH + b_) * 128 + c_) * NSA_G + g_) * 64 + d] = f2bfh(s);
  }
}

constexpr int GA_QS = 272, GA_VS = 528, GA_PS = 144;
constexpr int GA_QT = 0, GA_KT = GA_QT + 64 * GA_QS, GA_KH = GA_KT + 64 * GA_QS, GA_VT = GA_KH + 64 * GA_QS, GA_PT = GA_VT + 64 * GA_VS,
              GA_LR = GA_PT + 64 * GA_PS, GA_GT = GA_LR + 64 * 16 * 4, GA_DC = GA_GT + 4 * 128 * 4, GA_END = GA_DC + 512;
static_assert(GA_END <= RING_BYTES, "GLA phase A LDS map");
constexpr int GC_SP = 0, GC_QT = GC_SP + 128 * GA_VS, GC_RED = GC_QT + 64 * GA_QS, GC_END = GC_RED + 8 * 16 * 4 * 2;
static_assert(GC_END <= RING_BYTES, "GLA phase C LDS map");

DEV void gla_a_unit(const Params& p, int li, LAS unsigned char* lds, int t32, int unit) {
  const int lane = t32 & 63, wave = t32 >> 6, i15 = lane & 15, g4 = lane >> 4;
  const int bh = unit >> 5, ci = unit & 31, b = bh >> 2, h = bh & 3;
  const int c = t32 & 127, jq = t32 >> 7;
  LAS float* LR = (LAS float*)(lds + GA_LR);
  LAS float* GT = (LAS float*)(lds + GA_GT);
  LAS float* DC = (LAS float*)(lds + GA_DC);
  const float qscale = 0.08838834764831845f;
  const size_t n0 = (size_t)b * SEQ + ci * 64;
  {
    const int e = t32 * 2, j = e >> 4, r = e & 15;
    const unsigned w = *(const unsigned*)(p.u + (n0 + j) * N_IN + OFF_LR + r);
    LR[e] = __uint_as_float(w << 16); LR[e + 1] = __uint_as_float(w & 0xffff0000u);
  }
  float wa[GLA_RANK];
#pragma unroll
  for (int r = 0; r < GLA_RANK; ++r) wa[r] = p.w_alpha2[((size_t)li * GLA_RANK + r) * B_K + h * 128 + c];
  const float ba = p.b_alpha[li * B_K + h * 128 + c];
  unsigned short qv[16], kv[16];
#pragma unroll
  for (int jj = 0; jj < 16; ++jj) {
    const act_t* ur = p.u + (n0 + jq * 16 + jj) * N_IN;
    qv[jj] = ur[OFF_BQ + h * 128 + c];
    kv[jj] = ur[OFF_BK + h * 128 + c];
  }
#pragma unroll
  for (int x = 0; x < 4; ++x) {
    const int idx = t32 + 512 * x, row = idx >> 5, ch = idx & 31;
    const u32x4 vv = *(const u32x4*)(p.u + (n0 + row) * N_IN + OFF_BV + h * 256 + ch * 8);
    *(LAS u32x4*)(lds + GA_VT + row * GA_VS + ch * 16) = vv;
  }
  __syncthreads();
  float bl[16];
  float run = 0.f;
#pragma unroll
  for (int jj = 0; jj < 16; ++jj) {
    const LAS f32x4* lr4 = (const LAS f32x4*)(LR + (jq * 16 + jj) * 16);
    float z = ba;
#pragma unroll
    for (int r4 = 0; r4 < 4; ++r4) { const f32x4 x = lr4[r4]; z += x.x * wa[4 * r4] + x.y * wa[4 * r4 + 1] + x.z * wa[4 * r4 + 2] + x.w * wa[4 * r4 + 3]; }
    const float ez = __builtin_amdgcn_exp2f(-fabsf(z) * 1.4426950408889634f);
    const float ls = (fminf(z, 0.f) - __builtin_amdgcn_logf(1.0f + ez) * 0.6931471805599453f) * (1.0f / 16.0f);
    run += ls; bl[jj] = run;
  }
  GT[jq * 128 + c] = run;
  __syncthreads();
  {
    const float g0 = GT[c], g1 = GT[128 + c], g2 = GT[256 + c], g3 = GT[384 + c];
    const float off = (jq > 0 ? g0 : 0.f) + (jq > 1 ? g1 : 0.f) + (jq > 2 ? g2 : 0.f);
    const float tot = (g0 + g1) + (g2 + g3);
    const float dtot = __builtin_amdgcn_exp2f(tot * 1.4426950408889634f);
    if (jq == 0) { DC[c] = dtot; p.gD[(size_t)unit * 128 + c] = dtot; }
#pragma unroll
    for (int jj = 0; jj < 16; ++jj) {
      const float e1 = __builtin_amdgcn_exp2f((off + bl[jj]) * 1.4426950408889634f), ie = __builtin_amdgcn_rcpf(e1);
      const float qf = __uint_as_float(((unsigned)qv[jj]) << 16), kf = __uint_as_float(((unsigned)kv[jj]) << 16);
      const int ro = (jq * 16 + jj) * GA_QS + c * 2;
      const unsigned short qt = f2bfh(qf * e1 * qscale);
      *(LAS unsigned short*)(lds + GA_QT + ro) = qt;
      p.gQ[((size_t)unit * 64 + jq * 16 + jj) * 128 + c] = qt;
      *(LAS unsigned short*)(lds + GA_KT + ro) = f2bfh(kf * ie);
      *(LAS unsigned short*)(lds + GA_KH + ro) = f2bfh(kf * ie * dtot);
    }
  }
  __syncthreads();
#pragma unroll
  for (int q = 0; q < 2; ++q) {
    const int id = wave * 2 + q, jt = id >> 2, it = id & 3;
    f32x4 a = (f32x4){0.f, 0.f, 0.f, 0.f};
#pragma unroll
    for (int kk = 0; kk < 4; ++kk) {
      const bf16x8 kf = *(const LAS bf16x8*)(lds + GA_KT + (16 * jt + i15) * GA_QS + (32 * kk + 8 * g4) * 2);
      const bf16x8 qf = *(const LAS bf16x8*)(lds + GA_QT + (16 * it + i15) * GA_QS + (32 * kk + 8 * g4) * 2);
      a = __builtin_amdgcn_mfma_f32_16x16x32_bf16(kf, qf, a, 0, 0, 0);
    }
    const int i = 16 * it + i15, j0 = 16 * jt + 4 * g4;
    u32x2 w;
    w.x = pk2(j0 <= i ? a.x : 0.f, j0 + 1 <= i ? a.y : 0.f);
    w.y = pk2(j0 + 2 <= i ? a.z : 0.f, j0 + 3 <= i ? a.w : 0.f);
    *(LAS u32x2*)(lds + GA_PT + i * GA_PS + j0 * 2) = w;
  }
  __syncthreads();
  {
    const int it = wave & 3, vt0 = (wave >> 2) * 8;
    bf16x8 pf[2];
#pragma unroll
    for (int s = 0; s < 2; ++s) pf[s] = *(const LAS bf16x8*)(lds + GA_PT + (16 * it + i15) * GA_PS + (32 * s + 8 * g4) * 2);
#pragma unroll
    for (int x = 0; x < 8; ++x) {
      const int vt = vt0 + x;
      f32x4 a = (f32x4){0.f, 0.f, 0.f, 0.f};
#pragma unroll
      for (int s = 0; s < 2; ++s) {
        const LAS unsigned char* vp = lds + GA_VT + (32 * s + 8 * g4 + (i15 >> 2)) * GA_VS + (16 * vt + 4 * (lane & 3)) * 2;
        const v4i16_t lo = tr_read(vp), hi = tr_read(vp + 4 * GA_VS);
        bf16x8 vf;
        vf[0] = lo[0]; vf[1] = lo[1]; vf[2] = lo[2]; vf[3] = lo[3]; vf[4] = hi[0]; vf[5] = hi[1]; vf[6] = hi[2]; vf[7] = hi[3];
        a = __builtin_amdgcn_mfma_f32_16x16x32_bf16(vf, pf[s], a, 0, 0, 0);
      }
      *(f32x4*)(p.opart + (n0 + 16 * it + i15) * 1024 + h * 256 + 16 * vt + 4 * g4) = a;
    }
  }
  {
    bf16x8 vf[2][2];
#pragma unroll
    for (int x = 0; x < 2; ++x)
#pragma unroll
      for (int s = 0; s < 2; ++s) {
        const LAS unsigned char* vp = lds + GA_VT + (32 * s + 8 * g4 + (i15 >> 2)) * GA_VS + (16 * (2 * wave + x) + 4 * (lane & 3)) * 2;
        const v4i16_t lo = tr_read(vp), hi = tr_read(vp + 4 * GA_VS);
        vf[x][s][0] = lo[0]; vf[x][s][1] = lo[1]; vf[x][s][2] = lo[2]; vf[x][s][3] = lo[3];
        vf[x][s][4] = hi[0]; vf[x][s][5] = hi[1]; vf[x][s][6] = hi[2]; vf[x][s][7] = hi[3];
      }
#pragma unroll
    for (int ct = 0; ct < 8; ++ct) {
      f32x4 a0 = (f32x4){0.f, 0.f, 0.f, 0.f}, a1 = (f32x4){0.f, 0.f, 0.f, 0.f};
#pragma unroll
      for (int s = 0; s < 2; ++s) {
        const LAS unsigned char* kp = lds + GA_KH + (32 * s + 8 * g4 + (i15 >> 2)) * GA_QS + (16 * ct + 4 * (lane & 3)) * 2;
        const v4i16_t lo = tr_read(kp), hi = tr_read(kp + 4 * GA_QS);
        bf16x8 kf;
        kf[0] = lo[0]; kf[1] = lo[1]; kf[2] = lo[2]; kf[3] = lo[3]; kf[4] = hi[0]; kf[5] = hi[1]; kf[6] = hi[2]; kf[7] = hi[3];
        a0 = __builtin_amdgcn_mfma_f32_16x16x32_bf16(vf[0][s], kf, a0, 0, 0, 0);
        a1 = __builtin_amdgcn_mfma_f32_16x16x32_bf16(vf[1][s], kf, a1, 0, 0, 0);
      }
      act_t* up = p.gU + ((size_t)unit * 128 + 16 * ct + i15) * 256 + 32 * wave + 4 * g4;
      u32x2 w0; w0.x = pk2(a0.x, a0.y); w0.y = pk2(a0.z, a0.w);
      u32x2 w1; w1.x = pk2(a1.x, a1.y); w1.y = pk2(a1.z, a1.w);
      *(u32x2*)up = w0; *(u32x2*)(up + 16) = w1;
    }
  }
  __syncthreads();
}

DEV void gla_scan(const Params& p, long long tid, long long nthr) {
  for (long long idx = tid; idx < 32LL * 128 * 32; idx += nthr) {
    const int v8 = (int)(idx & 31) * 8, c = (int)((idx >> 5) & 127), bh = (int)(idx >> 12);
    float s[8];
#pragma unroll
    for (int i = 0; i < 8; ++i) s[i] = 0.f;
#pragma unroll 4
    for (int ci = 0; ci < 32; ++ci) {
      const size_t unit = (size_t)bh * 32 + ci;
      const u32x4 uw = *(const u32x4*)(p.gU + (unit * 128 + c) * 256 + v8);
      const float d = p.gD[unit * 128 + c];
      u32x4 o;
#pragma unroll
      for (int i = 0; i < 4; ++i) o[i] = pk2(s[2 * i], s[2 * i + 1]);
      *(u32x4*)(p.gS + (unit * 128 + c) * 256 + v8) = o;
#pragma unroll
      for (int i = 0; i < 4; ++i) {
        s[2 * i] = s[2 * i] * d + __uint_as_float(uw[i] << 16);
        s[2 * i + 1] = s[2 * i + 1] * d + __uint_as_float(uw[i] & 0xffff0000u);
      }
    }
  }
}

DEV void gla_c_unit(const Params& p, int li, LAS unsigned char* lds, int t32, int unit) {
  const int lane = t32 & 63, wave = t32 >> 6, i15 = lane & 15, g4 = lane >> 4;
  const int bh = unit >> 5, ci = unit & 31, b = bh >> 2, h = bh & 3;
  const size_t n0 = (size_t)b * SEQ + ci * 64;
#pragma unroll
  for (int x = 0; x < 8; ++x) {
    const int idx = t32 + 512 * x, row = idx >> 5, ch = idx & 31;
    *(LAS u32x4*)(lds + GC_SP + row * GA_VS + ch * 16) = *(const u32x4*)(p.gS + ((size_t)unit * 128 + row) * 256 + ch * 8);
  }
#pragma unroll
  for (int x = 0; x < 2; ++x) {
    const int idx = t32 + 512 * x, row = idx >> 4, ch = idx & 15;
    *(LAS u32x4*)(lds + GC_QT + row * GA_QS + ch * 16) = *(const u32x4*)(p.gQ + ((size_t)unit * 64 + row) * 128 + ch * 8);
  }
  __syncthreads();
  const int it = wave & 3, vt0 = (wave >> 2) * 8;
  bf16x8 qf[4];
#pragma unroll
  for (int kk = 0; kk < 4; ++kk) qf[kk] = *(const LAS bf16x8*)(lds + GC_QT + (16 * it + i15) * GA_QS + (32 * kk + 8 * g4) * 2);
  const size_t n = n0 + 16 * it + i15;
  f32x4 o[8];
  float ss = 0.f;
#pragma unroll
  for (int x = 0; x < 8; ++x) {
    const int vt = vt0 + x;
    f32x4 a = *(const f32x4*)(p.opart + n * 1024 + h * 256 + 16 * vt + 4 * g4);
#pragma unroll
    for (int kk = 0; kk < 4; ++kk) {
      const LAS unsigned char* sp = lds + GC_SP + (32 * kk + 8 * g4 + (i15 >> 2)) * GA_VS + (16 * vt + 4 * (lane & 3)) * 2;
      const v4i16_t lo = tr_read(sp), hi = tr_read(sp + 4 * GA_VS);
      bf16x8 sf;
      sf[0] = lo[0]; sf[1] = lo[1]; sf[2] = lo[2]; sf[3] = lo[3]; sf[4] = hi[0]; sf[5] = hi[1]; sf[6] = hi[2]; sf[7] = hi[3];
      a = __builtin_amdgcn_mfma_f32_16x16x32_bf16(sf, qf[kk], a, 0, 0, 0);
    }
    o[x] = a;
    ss += (a.x * a.x + a.y * a.y) + (a.z * a.z + a.w * a.w);
  }
  ss += shx(ss, lane, 16);
  ss += shx(ss, lane, 32);
  LAS float* RED = (LAS float*)(lds + GC_RED);
  if (g4 == 0) RED[wave * 16 + i15] = ss;
  __syncthreads();
  ss += RED[(wave ^ 4) * 16 + i15];
  const float rs = 1.0f / sqrtf(ss * (1.0f / 256.0f) + LN_EPS);
#pragma unroll
  for (int x = 0; x < 8; ++x) {
    const int v = 16 * (vt0 + x) + 4 * g4;
    const f32x4 gn = *(const f32x4*)(p.gla_norm_g + li * DV + v);
    const u32x2 rw = *(const u32x2*)(p.u + n * N_IN + OFF_BR + h * 256 + v);
    const float r0 = __uint_as_float(rw.x << 16), r1 = __uint_as_float(rw.x & 0xffff0000u), r2 = __uint_as_float(rw.y << 16), r3 = __uint_as_float(rw.y & 0xffff0000u);
    u32x2 w;
    w.x = pk2(o[x].x * rs * gn.x * (r0 * sigmoidf_(r0)), o[x].y * rs * gn.y * (r1 * sigmoidf_(r1)));
    w.y = pk2(o[x].z * rs * gn.z * (r2 * sigmoidf_(r2)), o[x].w * rs * gn.w * (r3 * sigmoidf_(r3)));
    *(u32x2*)(p.yb + n * YLD + h * 256 + v) = w;
  }
  __syncthreads();
}

#define XB_TMO      128
#define XB_XCNT(j)  (256  + 64 * (j))
#define XB_XSUB(j)  (1280 + 64 * (j))
#define XB_XGEN(j)  (2304 + 64 * (j))
#define XB_TOP      3328
#define XB_TOPGEN   3392
#define XCD_BAR_WORDS 3456
#define XB_SPIN_CAP (1u << 18)

__device__ __forceinline__ unsigned xb_ld(unsigned* p)              { return __hip_atomic_load(p, __ATOMIC_RELAXED, __HIP_MEMORY_SCOPE_AGENT); }
__device__ __forceinline__ unsigned xb_add(unsigned* p, unsigned v) { return __hip_atomic_fetch_add(p, v, __ATOMIC_RELAXED, __HIP_MEMORY_SCOPE_AGENT); }
__device__ __forceinline__ unsigned xb_xcc_id() { return (unsigned)__builtin_amdgcn_s_getreg((3 << 11) | 20) & 0xFu; }
#define XB_SPIN(cond, bar) do { unsigned _sp = 0; while (cond) { __builtin_amdgcn_s_sleep(1); \
    if ((++_sp & 255u) == 0u) { if (xb_ld(&(bar)[XB_TMO])) break; if (_sp > XB_SPIN_CAP) { atomicAdd(&(bar)[XB_TMO], 1u); break; } } } } while (0)

struct XcdBarrier {
    unsigned* bar; unsigned x;
    volatile LAS unsigned* st;
};

__device__ __forceinline__ XcdBarrier xcd_barrier_post(unsigned* bar, volatile LAS unsigned* st) {
    XcdBarrier b; b.bar = bar; b.x = xb_xcc_id(); b.st = st;
    if (threadIdx.x == 0) st[2] = xb_add(&bar[XB_XCNT(b.x)], 1u);
    return b;
}
__device__ __forceinline__ void xcd_barrier_complete(unsigned* bar, unsigned x, unsigned& nloc, unsigned& nx) {
    const unsigned G = gridDim.x * gridDim.y * gridDim.z;
    unsigned sum, cnt, mine, sp = 0u;
    for (;;) {
        sum = 0u; cnt = 0u; mine = 0u;
#pragma unroll
        for (unsigned j = 0; j < 16; ++j) { const unsigned c = xb_ld(&bar[XB_XCNT(j)]); sum += c; cnt += (c > 0u) ? 1u : 0u; mine = (j == x) ? c : mine; }
        if (sum == G) break;
        __builtin_amdgcn_s_sleep(1);
        if ((++sp & 255u) == 0u) { if (xb_ld(&bar[XB_TMO])) break; if (sp > XB_SPIN_CAP) { atomicAdd(&bar[XB_TMO], 1u); break; } }
    }
    nloc = mine > 0u ? mine : 1u; nx = cnt > 0u ? cnt : 1u;
}

__device__ __forceinline__ void xcd_barrier(const XcdBarrier& b, const int t32) {
    asm volatile("s_waitcnt vmcnt(0)" ::: "memory");
    __syncthreads();
    if (t32 == 0) {
        unsigned* bar = b.bar;
        __builtin_amdgcn_s_waitcnt(0);
        unsigned nloc = b.st[0], nx = b.st[1];
        if (nloc == 0u) { xcd_barrier_complete(bar, b.x, nloc, nx); b.st[0] = nloc; b.st[1] = nx; }
        const unsigned old = xb_add(&bar[XB_XSUB(b.x)], 1u);
        const unsigned gen = old / nloc;
        if (old + 1u == (gen + 1u) * nloc) {
            __builtin_amdgcn_fence(__ATOMIC_RELEASE, "agent");
            asm volatile("s_waitcnt vmcnt(0)" ::: "memory");
            const unsigned og = xb_add(&bar[XB_TOP], 1u);
            const unsigned tg = og / nx;
            if (og + 1u == (tg + 1u) * nx) xb_add(&bar[XB_TOPGEN], 1u);
            else XB_SPIN(xb_ld(&bar[XB_TOPGEN]) == tg, bar);
            __builtin_amdgcn_fence(__ATOMIC_ACQUIRE, "agent");
            xb_add(&bar[XB_XGEN(b.x)], 1u);
            asm volatile("s_waitcnt vmcnt(0)" ::: "memory");
        } else {
            XB_SPIN(xb_ld(&bar[XB_XGEN(b.x)]) == gen, bar);
            __builtin_amdgcn_fence(__ATOMIC_ACQUIRE, "agent");
            asm volatile("s_waitcnt vmcnt(0)" ::: "memory");
        }
    }
    __syncthreads();
}

constexpr int STEPS_PER_LAYER = 25;
#ifndef PROBE_LO
#define PROBE_LO -1
#define PROBE_HI -1
#endif
#ifndef PROBE_PRO
#define PROBE_PRO 0
#endif
#ifndef NSA_PROBE
#define NSA_PROBE 0
#endif
#ifndef MULTI_LAUNCH
#define MULTI_LAUNCH 0
#endif
DEV int fresh_t32(int wave) {
  int t;
  asm volatile("v_mbcnt_lo_u32_b32 %0, -1, 0\n\tv_mbcnt_hi_u32_b32 %0, -1, %0" : "=v"(t));
  return t + wave * 64;
}
struct KArgs { void* in[35]; void* out; void* ws; };
template <bool WITH_NAIVE, bool COOP>
__global__ void __launch_bounds__(NTHREADS) k_mega(KArgs ka, int step_lo, int step_hi) {
  unsigned* const barw0 = ((unsigned*)ka.ws);
  extern __shared__ __attribute__((aligned(16))) unsigned char lds_raw[];
  LAS unsigned char* lds = (LAS unsigned char*)lds_raw;
  LAS int* tab = (LAS int*)(lds + MISC_OFF);
  const int wave = __builtin_amdgcn_readfirstlane(threadIdx.x >> 6);
  const int G = gridDim.x;
  int bid = blockIdx.x;

  LAS unsigned* miscw = (LAS unsigned*)(lds + MISC_OFF + 8192);
  if (threadIdx.x < 64) miscw[threadIdx.x] = 0u;
  __syncthreads();
  XcdBarrier xbar; xbar.bar = barw0; xbar.x = 0; xbar.st = nullptr;
  if (COOP) xbar = xcd_barrier_post(barw0, miscw + 8);
  if (step_lo < 0) {
    Params p;
    fill_params(p, ka.in, ka.out, ka.ws);
    prologue(p, lds, wave, threadIdx.x & 63);
    if (COOP) cg::this_grid().sync();
#if PROBE_PRO
    prologue(p, lds, wave, threadIdx.x & 63);
    if (COOP) cg::this_grid().sync();
#endif
    step_lo = 0;
    if (COOP) {
      bool even = (G % 8) == 0;
#pragma unroll
      for (int j = 0; j < 8; ++j) even = even && (xb_ld(&barw0[XB_XCNT(j)]) == (unsigned)(G / 8));
      __syncthreads();
      if (even) bid = __builtin_amdgcn_readfirstlane((int)(xbar.x + 8u * miscw[10]));
    }
  }
  int rep_done = 0;
  for (int step = step_lo; step < step_hi;) {
    int li = step / STEPS_PER_LAYER;
    const int k = step % STEPS_PER_LAYER;
    int nb32 = gridDim.x;
    char* wsb = (char*)ka.ws;
    asm volatile("" : "+s"(wsb));
    Params p;
    fill_params(p, ka.in, ka.out, wsb);
    asm volatile("" : "+s"(li));
    asm volatile("" : "+s"(nb32));
#define T32() fresh_t32(wave)
#define TID() ((int)(blockIdx.x * NTHREADS) + T32())
    const int nthr = nb32 * NTHREADS;
    const int gw = blockIdx.x * 8 + wave, NGW = nb32 * 8;
    const bool is_gemm = (k == 0) || (k == 2) || (k == 3) || (k == 9) || (k == 10) || (k >= 12 && k <= 14) || (k == 17) || (k == 22) || (k == 23);
    const bool sync_after = !(k == 2 || k == 7 || k == 8 || k == 12 || k == 13 || k == 16 || k == 20);
    if (is_gemm) {
      pg8::Gemm g{nullptr, nullptr, 0, 0, 0};
      USched S; S.init_static(256, 256, G, bid);
      EpiU E{0, 0, nullptr, nullptr, nullptr, nullptr, nullptr, nullptr, nullptr};
      const size_t WSQ = (size_t)1024 * 1024;
      switch (k) {
        case 0:
          g = pg8::Gemm{p.xb, p.wt_in + (size_t)li * N_IN_PAD * 1024, N_TOK, N_IN_PAD, 1024};
          S.init_static(N_TOK, N_IN_PAD, G, bid);
          E.mode = EM_INPROJ; E.ob = p.u; E.f0 = p.b_in + (size_t)li * N_IN; break;
        case 2:
          g = pg8::Gemm{p.cmpA, p.wt_c1 + (size_t)(li * 2 + 0) * 256 * 2048, CMP_ROWS_PAD, 256, 2048};
          S.init_static(CMP_ROWS_PAD, 256, G, bid);
          E.mode = EM_HID; E.of = p.hid; break;
        case 3:
          g = pg8::Gemm{p.cmpA + (size_t)CMP_ROWS_PAD * 2048, p.wt_c1 + (size_t)(li * 2 + 1) * 256 * 2048, CMP_ROWS_PAD, 256, 2048};
          S.init_static(CMP_ROWS_PAD, 256, G, (bid + G - 16) % G);
          E.mode = EM_HID; E.of = p.hid + (size_t)CMP_ROWS * CMP_HID; break;
        case 9:
          g = pg8::Gemm{p.ya, p.wt_bra + (size_t)li * 1024 * YLD, N_TOK, 1024, YLD};
          S.init_static(N_TOK, 1024, G, bid);
          E.mode = EM_BRCAT; E.ub = p.u; E.ob = p.merged; break;
        case 10:
          g = pg8::Gemm{p.merged, p.wt_omix + li * WSQ, N_TOK, 1024, 1024};
          S.init_static(N_TOK, 1024, G, bid);
          E.mode = EM_RES; E.f0 = p.xf; E.of = p.tmp; break;
        case 12:
          g = pg8::Gemm{p.xb, p.wt_xq + li * WSQ, N_TOK, 1024, 1024};
          S.init_static(N_TOK, 1024, G, bid);
          E.mode = EM_BF16; E.ob = p.xq; E.ldc = 1024; break;
        case 13:
          g = pg8::Gemm{p.membf, p.wt_xk + li * WSQ, BATCH * MEM_LEN, 1024, 1024};
          S.init_static(BATCH * MEM_LEN, 1024, G, bid);
          E.mode = EM_BF16; E.ob = p.memk; E.ldc = 1024; break;
        case 14:
          g = pg8::Gemm{p.membf, p.wt_xv + li * WSQ, BATCH * MEM_LEN, 1024, 1024};
          S.init_static(BATCH * MEM_LEN, 1024, G, (bid + 128) % G);
          E.mode = EM_BF16; E.ob = p.memv; E.ldc = 1024; break;
        case 17:
          g = pg8::Gemm{p.xo, p.wt_xo + li * WSQ, N_TOK, 1024, 1024};
          S.init_static(N_TOK, 1024, G, bid);
          E.mode = EM_RES; E.f0 = p.xf; E.of = p.tmp; break;
        case 22: {
          const int ntiles = moe_tables(p, li, tab, T32());
          g = pg8::Gemm{p.xg, p.wt_gu + (size_t)li * 32 * 2048 * 1024, MOE_ROWS, 32 * 2048, 1024};
          S.init_moe(G, bid, 8, ntiles * 8, tab + 128);
          E.mode = EM_MOE1; E.ob = p.actg; E.f0 = p.b_gu + (size_t)li * 32 * 2048; E.te = tab + 128; break; }
        default: {
          const int ntiles = moe_tables(p, li, tab, T32());
          g = pg8::Gemm{p.actg, p.wt_dn + (size_t)li * 32 * 1024 * 1024, MOE_ROWS, 32 * 1024, 1024};
          S.init_moe(G, bid, 4, ntiles * 4, tab + 128);
          E.mode = EM_MOE2; E.of = p.yass; E.f0 = p.b_down + (size_t)li * 32 * 1024; E.f1 = p.topg; E.il = p.rowlist; E.te = tab + 128; break; }
      }
      pg8::gemm_phase<EpiU, USched, true, true>(lds, g, S, E, T32());
    } else {
      switch (k) {
        case 1: cmpa_build(p, li, TID(), nthr); break;
        case 4:
          { const int t = T32(); for (int un = bid; un < 1024; un += G) gla_a_unit(p, li, lds, t, un); }
          dil_phase(p, lds, T32(), bid, G);
          kcv_phase(p, li, TID(), nthr);
          break;
        case 5: gla_scan(p, TID(), nthr); nsa_cmp_phase(p, lds, T32(), bid, G); dil_combine(p, TID(), nthr); break;
        case 6: {
          nsa_main_phase(p, lds, T32(), bid, G);
#if NSA_PROBE == 4
          nsa_main_phase(p, lds, T32(), bid, G);
#endif
          const int t = T32();
          for (int un = bid; un < 1024; un += G) gla_c_unit(p, li, lds, t, un);
#if NSA_PROBE == 3
          for (int un = bid; un < 1024; un += G) gla_c_unit(p, li, lds, t, un);
#endif
          break; }
        case 11: ln_rows_w<0>(p, p.tmp, p.ln1_g + li * D, p.ln1_b + li * D, p.xf, p.xb, nullptr, gw, NGW, T32() & 63); break;
        case 18: ln_rows_w<0>(p, p.tmp, p.ln2_g + li * D, p.ln2_b + li * D, p.xf, p.xb, nullptr, gw, NGW, T32() & 63); break;
        case 21: { const int t = T32(); moe_prep(p, li, tab, wave, t & 63, t); break; }
        case 24: ln_rows_w<1>(p, nullptr, p.ln3_g + li * D, p.ln3_b + li * D, p.xf, p.xb, li == DEPTH - 1 ? p.out : nullptr, gw, NGW, T32() & 63); break;
        case 15: xattn_phase(p, lds, T32(), bid, G); break;
        case 19: route_phase(p, li, gw, NGW, T32() & 63); break;
        default: break;
      }
    }
    if (COOP && sync_after) xcd_barrier(xbar, T32());
    if (PROBE_HI >= 0 && k == PROBE_HI && !rep_done) { rep_done = 1; step -= (PROBE_HI - PROBE_LO); }
    else { if (k == PROBE_HI) rep_done = 0; ++step; }
  }
}

extern "C" void kernel_launch(void* const* d_in, const int* in_sizes, int n_in, void* d_out, int out_size,
                              void* d_ws, size_t ws_size, hipStream_t stream) {
  Params p;
  memset(&p, 0, sizeof(p));
  fill_params(p, d_in, d_out, d_ws);
  KArgs ka;
  memset(&ka, 0, sizeof(ka));
  for (int i = 0; i < 35; ++i) ka.in[i] = d_in[i];
  ka.out = d_out; ka.ws = d_ws;
  static int grid_blocks = 0;
  if (!grid_blocks) {
    int dev = 0, cus = 0;
    hipGetDevice(&dev);
    hipDeviceGetAttribute(&cus, hipDeviceAttributeMultiprocessorCount, dev);
    hipFuncSetAttribute((const void*)k_mega<true, true>, hipFuncAttributeMaxDynamicSharedMemorySize, LDS_BYTES);
    if (p.ws_used > ws_size) fprintf(stderr, "workspace too small: need %zu have %zu\n", p.ws_used, ws_size);
    grid_blocks = cus;
  }
  hipMemsetAsync(p.barw, 0, 4096 * sizeof(unsigned), stream);
  int lo = -1, hi = DEPTH * STEPS_PER_LAYER;
  void* args[] = {&ka, &lo, &hi};
  hipError_t e = hipLaunchCooperativeKernel((void*)k_mega<true, true>, dim3(grid_blocks), dim3(NTHREADS), args, LDS_BYTES, stream);
  if (e != hipSuccess) fprintf(stderr, "cooperative launch failed: %s (grid %d)\n", hipGetErrorString(e), grid_blocks);
}
#endif
```

```cpp
#ifndef CPU_TEST
#include <hip/hip_runtime.h>
#include <hip/hip_cooperative_groups.h>
#include <cstdio>
#include <cstring>
#include <cmath>
namespace cg = cooperative_groups;
#define DEV __device__ __forceinline__
#define HDI __host__ __device__ __forceinline__
#else
#include <cmath>
#include <cstdio>
#include <cstdlib>
#include <cstring>
#define DEV static inline
#define HDI static inline
#endif

#ifndef D_MODEL
#define D_MODEL 1024
#endif
#ifndef BATCH
#define BATCH 8
#endif
#ifndef MEGA
#define MEGA 1
#endif

constexpr int D = D_MODEL;
constexpr int SEQ = 2048;
constexpr int DEPTH = 2;
constexpr int MEM_LEN = 256;
constexpr int HD = 64;
constexpr int N_TOK = BATCH * SEQ;
constexpr int GLA_H = 4;
constexpr int DK = D / 2 / GLA_H;
constexpr int DV = D / GLA_H;
constexpr int GLA_RANK = 16;
constexpr int B_K = GLA_H * DK;
constexpr int B_V = GLA_H * DV;
constexpr int NSA_H = 16;
constexpr int NSA_G = 4;
constexpr int N_CMP = 127;
constexpr int CMP_HID = 128;
constexpr int N_BLK = 32;
constexpr int N_SELECT = 16;
constexpr int NSA_WIN = 512;
constexpr int XH = 4;
constexpr int XHD = D / XH;
constexpr int NE = 32;
constexpr int TOPK = 4;
constexpr int DFF = D;
constexpr float LN_EPS = 1e-5f;
constexpr float ALPHA = 1.41421356237309515f;

constexpr int OFF_AQ = 0;
constexpr int OFF_AK = 768;
constexpr int OFF_AV = 1536;
constexpr int OFF_BQ = 2304;
constexpr int OFF_BK = OFF_BQ + B_K;
constexpr int OFF_BV = OFF_BK + B_K;
constexpr int OFF_BR = OFF_BV + B_V;
constexpr int OFF_LR = OFF_BR + B_V;
constexpr int OFF_CQ = OFF_LR + GLA_RANK;
constexpr int OFF_CKC = OFF_CQ + 1024;
constexpr int OFF_CVC = OFF_CKC + 256;
constexpr int OFF_CKS = OFF_CVC + 256;
constexpr int OFF_CVS = OFF_CKS + 256;
constexpr int OFF_CKW = OFF_CVS + 256;
constexpr int OFF_CVW = OFF_CKW + 256;
constexpr int OFF_CG = OFF_CVW + 256;
constexpr int OFF_MG = OFF_CG + 48;
constexpr int N_IN = OFF_MG + 3 * D;
constexpr int N_IN_PAD = (N_IN + 255) / 256 * 256;
constexpr int MOE_ROWS = N_TOK * 4 + 32 * 256;
constexpr int CMP_ROWS_PAD = 4096;
constexpr int YLD = 256 + 1024 + 1024;

#ifdef CPU_TEST
typedef float act_t;
DEV float ldf(float v) { return v; }
DEV void stf(float* p, float v) { *p = v; }
#else
typedef unsigned short act_t;
DEV float ldf(unsigned short h) { return __uint_as_float(((unsigned)h) << 16); }
DEV float ldf(float v) { return v; }
DEV unsigned short f2bf(float f) {
  unsigned u = __float_as_uint(f);
  u += 0x7fffu + ((u >> 16) & 1u);
  return (unsigned short)(u >> 16);
}
DEV void stf(unsigned short* p, float v) { *p = f2bf(v); }
DEV void stf(float* p, float v) { *p = v; }
#endif

struct Params {
  const float *x, *mem, *ln0_g, *ln0_b, *w_in, *b_in, *w_alpha2, *b_alpha, *gla_norm_g,
      *cmp_pe_k, *cmp_w1_k, *cmp_w2_k, *cmp_pe_v, *cmp_w1_v, *cmp_w2_v,
      *w_br_a, *w_br_b, *w_br_c, *w_o_mix, *ln1_g, *ln1_b, *w_xq, *w_xk, *w_xv, *w_xo, *ln2_g, *ln2_b,
      *w_router, *b_router, *w_gu, *b_gu, *w_down, *b_down, *ln3_g, *ln3_b;
  float* out;
  float* xf;
  act_t* xb;
  act_t* u;
  float* ga;
  float* hid;
  float* kcv;
  float* opart;
  act_t* ya;
  act_t* yb;
  act_t* yc;
  float* pcmp;
  float* ocmp;
  float* impb;
  int* selb;
  act_t* merged;
  float* tmp;
  act_t* xq;
  act_t* memk;
  act_t* memv;
  float* xs;
  act_t* xo;
  float* rl;
  int* topi;
  float* topg;
  act_t* act;
  act_t* wt_in;
  act_t* wt_c1;
  act_t* wt_bra;
  act_t* wt_brb;
  act_t* wt_brc;
  act_t* wt_omix;
  act_t* wt_xq;
  act_t* wt_xk;
  act_t* wt_xv;
  act_t* wt_xo;
  act_t* wt_gu;
  act_t* wt_dn;
  act_t* membf;
  act_t* cmpA;
  float* mrg;
  int* cnt;
  int* rank;
  int* rowlist;
  act_t* xg;
  act_t* actg;
  float* yass;
  act_t* kcb;
  act_t* dilo;
  float* dill;
  unsigned* selm;
  act_t* gU;
  act_t* gS;
  act_t* gQ;
  float* gD;
  unsigned* barw;
  size_t ws_used;
};

#ifdef CPU_TEST
#define FOR_IDX(idx, total) \
  for (long long idx = (long long)(total) * tid / nthr, _e = (long long)(total) * (tid + 1) / nthr; idx < _e; ++idx)
#else
#define FOR_IDX(idx, total) for (long long idx = tid; idx < (long long)(total); idx += nthr)
#endif

DEV float sigmoidf_(float x) { return 1.0f / (1.0f + expf(-x)); }

template <class TA>
DEV float dotcol(const TA* a, const float* W, int K, long long ldw) {
  float s = 0.f;
  for (int k = 0; k < K; ++k) s += ldf(a[k]) * W[(long long)k * ldw];
  return s;
}

DEV void ph_ln(const float* src, const float* g, const float* b, float* dstf, act_t* dstb, float* dst2,
               long long tid, long long nthr) {
  FOR_IDX(n, N_TOK) {
    const float* r = src + n * D;
    float mu = 0.f;
    for (int i = 0; i < D; ++i) mu += r[i];
    mu /= D;
    float var = 0.f;
    for (int i = 0; i < D; ++i) { float d = r[i] - mu; var += d * d; }
    var /= D;
    float rs = 1.0f / sqrtf(var + LN_EPS);
    for (int i = 0; i < D; ++i) {
      float y = (r[i] - mu) * rs * g[i] + b[i];
      dstf[n * D + i] = y;
      stf(&dstb[n * D + i], y);
      if (dst2) dst2[n * D + i] = y;
    }
  }
}

DEV void ph_inproj(const Params& p, int li, long long tid, long long nthr) {
  const float* W = p.w_in + (long long)li * D * N_IN;
  const float* bias = p.b_in + (long long)li * N_IN;
  FOR_IDX(idx, (long long)N_TOK * N_IN) {
    long long n = idx / N_IN; int c = (int)(idx % N_IN);
    stf(&p.u[idx], dotcol(p.xb + n * D, W + c, D, N_IN) + bias[c]);
  }
}

DEV float gelu_tanh(float x) {
  return 0.5f * x * (1.0f + tanhf(0.7978845608028654f * (x + 0.044715f * x * x * x)));
}

constexpr int CMP_ROWS = BATCH * N_CMP * NSA_G;

template <int PARTS>
DEV void ph_pre(const Params& p, int li, long long tid, long long nthr) {
  const long long T1 = (long long)N_TOK * B_K;
  const long long T2 = (PARTS & 2) ? 2LL * CMP_ROWS * CMP_HID : 0;
  FOR_IDX(idx, T1 + T2) {
    if (idx < T1) {
      if (!(PARTS & 1)) continue;
      long long n = idx / B_K; int c = (int)(idx % B_K);
      const float* W2 = p.w_alpha2 + (long long)li * GLA_RANK * B_K;
      float z = p.b_alpha[li * B_K + c];
      for (int r = 0; r < GLA_RANK; ++r) z += ldf(p.u[n * N_IN + OFF_LR + r]) * W2[r * B_K + c];
      float ls = fminf(z, 0.f) - log1pf(expf(-fabsf(z)));
      p.ga[idx] = expf(ls * (1.0f / 16.0f));
    } else {
      long long i2 = idx - T1;
      int which = (int)(i2 / ((long long)CMP_ROWS * CMP_HID));
      long long rem = i2 % ((long long)CMP_ROWS * CMP_HID);
      int row = (int)(rem / CMP_HID), j = (int)(rem % CMP_HID);
      int g = row % NSA_G; int c = (row / NSA_G) % N_CMP; int b = row / (NSA_G * N_CMP);
      const float* pe = (which ? p.cmp_pe_v : p.cmp_pe_k) + (long long)li * 32 * HD;
      const float* w1 = (which ? p.cmp_w1_v : p.cmp_w1_k) + (long long)li * 32 * HD * CMP_HID;
      int off = (which ? OFF_CVC : OFF_CKC) + g * HD;
      float s = 0.f;
      for (int l = 0; l < 32; ++l) {
        const act_t* ur = p.u + ((long long)b * SEQ + c * 16 + l) * N_IN + off;
        for (int d = 0; d < HD; ++d) s += (ldf(ur[d]) + pe[l * HD + d]) * w1[(long long)(l * HD + d) * CMP_HID + j];
      }
      p.hid[i2] = gelu_tanh(s);
    }
  }
}

template <int PARTS>
DEV void ph_mix1(const Params& p, int li, long long tid, long long nthr) {
  const long long T1 = (long long)N_TOK * 4;
  const long long T2 = (long long)BATCH * GLA_H * DV * 4;
  const long long T3 = 2LL * CMP_ROWS * HD;
  FOR_IDX(idx, T1 + T2 + T3) {
    if (idx < T1) {
      if (!(PARTS & 1)) continue;
      long long n = idx / 4; int h = (int)(idx % 4);
      int b = (int)(n / SEQ), t = (int)(n % SEQ);
      float m = -INFINITY, l = 0.f;
      float acc[HD];
#pragma unroll
      for (int d = 0; d < HD; ++d) acc[d] = 0.f;
      for (int gi = 0; gi < 3; ++gi) {
        const int dil = gi == 0 ? 1 : (gi == 1 ? 4 : 16);
        float q[HD];
        const act_t* qp = p.u + n * N_IN + OFF_AQ + gi * 256 + h * HD;
#pragma unroll
        for (int d = 0; d < HD; ++d) q[d] = ldf(qp[d]);
        for (int mm = 0; mm <= 128; ++mm) {
          int tk = t - mm * dil;
          if (tk < 0) break;
          const act_t* kp = p.u + ((long long)b * SEQ + tk) * N_IN + OFF_AK + gi * 256 + h * HD;
          const act_t* vp = p.u + ((long long)b * SEQ + tk) * N_IN + OFF_AV + gi * 256 + h * HD;
          float s = 0.f;
#pragma unroll
          for (int d = 0; d < HD; ++d) s += q[d] * ldf(kp[d]);
          s *= 0.125f;
          float mn = fmaxf(m, s);
          float corr = expf(m - mn);
          float pp = expf(s - mn);
          l = l * corr + pp;
#pragma unroll
          for (int d = 0; d < HD; ++d) acc[d] = acc[d] * corr + pp * ldf(vp[d]);
          m = mn;
        }
      }
      float inv = 1.0f / l;
#pragma unroll
      for (int d = 0; d < HD; ++d) stf(&p.ya[n * 256 + h * HD + d], acc[d] * inv);
    } else if (idx < T1 + T2) {
      if (!(PARTS & 2)) continue;
      long long i2 = idx - T1;
      int v = (int)(i2 % DV); int cq = (int)((i2 / DV) % 4); int h = (int)((i2 / (DV * 4)) % GLA_H);
      int b = (int)(i2 / (DV * 4 * GLA_H));
      constexpr int DKQ = DK / 4;
      float st[DKQ];
#pragma unroll
      for (int c = 0; c < DKQ; ++c) st[c] = 0.f;
      const float qs = 1.0f / sqrtf((float)DK);
      for (int t = 0; t < SEQ; ++t) {
        long long n = (long long)b * SEQ + t;
        const act_t* ur = p.u + n * N_IN;
        float vt = ldf(ur[OFF_BV + h * DV + v]);
        const float* gar = p.ga + n * B_K + h * DK + cq * DKQ;
        const act_t* kr = ur + OFF_BK + h * DK + cq * DKQ;
        const act_t* qr = ur + OFF_BQ + h * DK + cq * DKQ;
        float o = 0.f;
#pragma unroll
        for (int c = 0; c < DKQ; ++c) {
          st[c] = gar[c] * st[c] + ldf(kr[c]) * vt;
          o += ldf(qr[c]) * st[c];
        }
        p.opart[((long long)cq * N_TOK + n) * B_V + h * DV + v] = o * qs;
      }
    } else {
      long long i2 = idx - T1 - T2;
      int which = (int)(i2 / ((long long)CMP_ROWS * HD));
      long long rem = i2 % ((long long)CMP_ROWS * HD);
      int row = (int)(rem / HD), d = (int)(rem % HD);
      const float* w2 = (which ? p.cmp_w2_v : p.cmp_w2_k) + (long long)li * CMP_HID * HD;
      const float* hr = p.hid + ((long long)which * CMP_ROWS + row) * CMP_HID;
      float s = 0.f;
      if (!(PARTS & 4)) continue;
      for (int j = 0; j < CMP_HID; ++j) s += hr[j] * w2[j * HD + d];
      p.kcv[i2] = s;
#ifndef CPU_TEST
      {
        const int g_ = row % NSA_G, c_ = (row / NSA_G) % N_CMP, b_ = row / (NSA_G * N_CMP);
        stf(&p.kcb[((((size_t)which * BATCH + b_) * 128 + c_) * NSA_G + g_) * 64 + d], s);
      }
#endif
    }
  }
}

template <int PARTS>
DEV void ph_nsa1(const Params& p, int li, long long tid, long long nthr) {
  const long long T1 = (long long)N_TOK * GLA_H;
  const long long T2 = (PARTS & 2) ? (long long)N_TOK * NSA_H : 0;
  FOR_IDX(idx, T1 + T2) {
    if (idx < T1) {
      long long n = idx / GLA_H; int h = (int)(idx % GLA_H);
      float ss = 0.f;
      for (int v = 0; v < DV; ++v) {
        float o = 0.f;
        for (int cq = 0; cq < 4; ++cq) o += p.opart[((long long)cq * N_TOK + n) * B_V + h * DV + v];
        ss += o * o;
      }
      float rs = 1.0f / sqrtf(ss / DV + LN_EPS);
      for (int v = 0; v < DV; ++v) {
        float o = 0.f;
        for (int cq = 0; cq < 4; ++cq) o += p.opart[((long long)cq * N_TOK + n) * B_V + h * DV + v];
        float r = ldf(p.u[n * N_IN + OFF_BR + h * DV + v]);
        float y = o * rs * p.gla_norm_g[li * DV + v] * (r * sigmoidf_(r));
        stf(&p.yb[n * B_V + h * DV + v], y);
      }
    } else {
      long long i2 = idx - T1;
      long long n = i2 / NSA_H; int hh = (int)(i2 % NSA_H);
      int b = (int)(n / SEQ), t = (int)(n % SEQ);
      int g = hh / 4;
      int nv = t >= 31 ? (t - 31) / 16 + 1 : 0;
      if (nv > N_CMP) nv = N_CMP;
      float q[HD];
      const act_t* qp = p.u + n * N_IN + OFF_CQ + hh * HD;
#pragma unroll
      for (int d = 0; d < HD; ++d) q[d] = ldf(qp[d]);
      float* prow = p.pcmp + (((long long)b * NSA_H + hh) * SEQ + t) * 128;
      float m = -INFINITY;
      for (int c = 0; c < nv; ++c) {
        const float* kp = p.kcv + (((long long)b * N_CMP + c) * NSA_G + g) * HD;
        float s = 0.f;
#pragma unroll
        for (int d = 0; d < HD; ++d) s += q[d] * kp[d];
        s *= 0.125f;
        prow[c] = s;
        m = fmaxf(m, s);
      }
      float acc[HD];
#pragma unroll
      for (int d = 0; d < HD; ++d) acc[d] = 0.f;
      float l = 0.f;
      for (int c = 0; c < nv; ++c) {
        const float* vp = p.kcv + (((long long)CMP_ROWS) + ((long long)b * N_CMP + c) * NSA_G + g) * HD;
        float pp = expf(prow[c] - m);
        l += pp;
        prow[c] = pp;
#pragma unroll
        for (int d = 0; d < HD; ++d) acc[d] += pp * vp[d];
      }
      float inv = 1.0f / fmaxf(l, 1e-30f);
      for (int c = 0; c < 128; ++c) prow[c] = c < nv ? prow[c] * inv : 0.f;
#pragma unroll
      for (int d = 0; d < HD; ++d) p.ocmp[n * 1024 + hh * HD + d] = acc[d] * inv;
    }
  }
}

DEV void ph_nsa2(const Params& p, int li, long long tid, long long nthr) {
  FOR_IDX(idx, (long long)BATCH * NSA_G * SEQ * N_BLK) {
    int j = (int)(idx % N_BLK); long long r = idx / N_BLK;
    int s = (int)(r % SEQ); int g = (int)((r / SEQ) % NSA_G); int b = (int)(r / ((long long)SEQ * NSA_G));
    int qb = s / 64;
    float imp;
    if (j == 0 || j == qb || j == qb - 1) imp = INFINITY;
    else if (j > qb) imp = -INFINITY;
    else {
      imp = 0.f;
      int c0 = 4 * j - 1; if (c0 < 0) c0 = 0;
      int c1 = 4 * j + 3; if (c1 > N_CMP - 1) c1 = N_CMP - 1;
      for (int rr = 0; rr < 4; ++rr) {
        const float* prow = p.pcmp + (((long long)b * NSA_H + g * 4 + rr) * SEQ + s) * 128;
        for (int c = c0; c <= c1; ++c) imp += prow[c];
      }
    }
    p.impb[idx] = imp;
  }
}

DEV void ph_nsa3(const Params& p, int li, long long tid, long long nthr) {
  FOR_IDX(idx, (long long)BATCH * NSA_G * SEQ * N_BLK) {
    int j = (int)(idx % N_BLK); long long r = idx / N_BLK;
    const float* ir = p.impb + r * N_BLK;
    float v = ir[j];
    int rank = 0;
    for (int jj = 0; jj < N_BLK; ++jj) {
      float w = ir[jj];
      if (w > v || (w == v && jj < j)) ++rank;
    }
    p.selb[idx] = rank < N_SELECT ? 1 : 0;
  }
}

DEV void ph_nsa4(const Params& p, int li, long long tid, long long nthr) {
  FOR_IDX(idx, (long long)N_TOK * NSA_H) {
    long long n = idx / NSA_H; int hh = (int)(idx % NSA_H);
    int b = (int)(n / SEQ), t = (int)(n % SEQ);
    int g = hh / 4;
    float q[HD];
    const act_t* qp = p.u + n * N_IN + OFF_CQ + hh * HD;
#pragma unroll
    for (int d = 0; d < HD; ++d) q[d] = ldf(qp[d]);
    float g0 = sigmoidf_(ldf(p.u[n * N_IN + OFF_CG + hh * 3 + 0]));
    float g1 = sigmoidf_(ldf(p.u[n * N_IN + OFF_CG + hh * 3 + 1]));
    float g2 = sigmoidf_(ldf(p.u[n * N_IN + OFF_CG + hh * 3 + 2]));
    float acc[HD];
    {
      float m = -INFINITY, l = 0.f;
#pragma unroll
      for (int d = 0; d < HD; ++d) acc[d] = 0.f;
      int qb = t / 64;
      const int* sr = p.selb + (((long long)b * NSA_G + g) * SEQ + t) * N_BLK;
      for (int j = 0; j <= qb; ++j) {
        if (!sr[j]) continue;
        int hi = j * 64 + 63; if (hi > t) hi = t;
        for (int tk = j * 64; tk <= hi; ++tk) {
          const act_t* kp = p.u + ((long long)b * SEQ + tk) * N_IN + OFF_CKS + g * HD;
          const act_t* vp = p.u + ((long long)b * SEQ + tk) * N_IN + OFF_CVS + g * HD;
          float s = 0.f;
#pragma unroll
          for (int d = 0; d < HD; ++d) s += q[d] * ldf(kp[d]);
          s *= 0.125f;
          float mn = fmaxf(m, s);
          float corr = expf(m - mn);
          float pp = expf(s - mn);
          l = l * corr + pp;
#pragma unroll
          for (int d = 0; d < HD; ++d) acc[d] = acc[d] * corr + pp * ldf(vp[d]);
          m = mn;
        }
      }
      float inv = 1.0f / l;
#pragma unroll
      for (int d = 0; d < HD; ++d) {
        float* oc = &p.ocmp[n * 1024 + hh * HD + d];
        *oc = g0 * (*oc) + g1 * acc[d] * inv;
      }
    }
    {
      float m = -INFINITY, l = 0.f;
#pragma unroll
      for (int d = 0; d < HD; ++d) acc[d] = 0.f;
      int lo = t - (NSA_WIN - 1); if (lo < 0) lo = 0;
      for (int tk = lo; tk <= t; ++tk) {
        const act_t* kp = p.u + ((long long)b * SEQ + tk) * N_IN + OFF_CKW + g * HD;
        const act_t* vp = p.u + ((long long)b * SEQ + tk) * N_IN + OFF_CVW + g * HD;
        float s = 0.f;
#pragma unroll
        for (int d = 0; d < HD; ++d) s += q[d] * ldf(kp[d]);
        s *= 0.125f;
        float mn = fmaxf(m, s);
        float corr = expf(m - mn);
        float pp = expf(s - mn);
        l = l * corr + pp;
#pragma unroll
        for (int d = 0; d < HD; ++d) acc[d] = acc[d] * corr + pp * ldf(vp[d]);
        m = mn;
      }
      float inv = 1.0f / l;
#pragma unroll
      for (int d = 0; d < HD; ++d)
        stf(&p.yc[n * 1024 + hh * HD + d], p.ocmp[n * 1024 + hh * HD + d] + g2 * acc[d] * inv);
    }
  }
}

DEV void ph_br(const Params& p, int li, long long tid, long long nthr) {
  const float* Wa = p.w_br_a + (long long)li * 256 * D;
  const float* Wb = p.w_br_b + (long long)li * B_V * D;
  const float* Wc = p.w_br_c + (long long)li * 1024 * D;
  FOR_IDX(idx, (long long)N_TOK * D) {
    long long n = idx / D; int d = (int)(idx % D);
    float s0 = dotcol(p.ya + n * 256, Wa + d, 256, D);
    float s1 = dotcol(p.yb + n * B_V, Wb + d, B_V, D);
    float s2 = dotcol(p.yc + n * 1024, Wc + d, 1024, D);
    const act_t* mg = p.u + n * N_IN + OFF_MG;
    float y = sigmoidf_(ldf(mg[d])) * s0 + sigmoidf_(ldf(mg[D + d])) * s1 + sigmoidf_(ldf(mg[2 * D + d])) * s2;
    stf(&p.merged[idx], y);
  }
}

DEV void ph_proj_res(const Params& p, const act_t* a, const float* W, long long tid, long long nthr) {
  FOR_IDX(idx, (long long)N_TOK * D) {
    long long n = idx / D; int d = (int)(idx % D);
    p.tmp[idx] = ALPHA * p.xf[idx] + dotcol(a + n * D, W + d, D, D);
  }
}

DEV void ph_xq(const Params& p, int li, long long tid, long long nthr) {
  const long long T1 = (long long)N_TOK * D;
  const long long T2 = 2LL * BATCH * MEM_LEN * D;
  const float* Wq = p.w_xq + (long long)li * D * D;
  FOR_IDX(idx, T1 + T2) {
    if (idx < T1) {
      long long n = idx / D; int d = (int)(idx % D);
      stf(&p.xq[idx], dotcol(p.xb + n * D, Wq + d, D, D));
    } else {
      long long i2 = idx - T1;
      int which = (int)(i2 / ((long long)BATCH * MEM_LEN * D));
      long long rem = i2 % ((long long)BATCH * MEM_LEN * D);
      long long r = rem / D; int d = (int)(rem % D);
      const float* W = (which ? p.w_xv : p.w_xk) + (long long)li * D * D;
      float s = dotcol(p.mem + r * D, W + d, D, D);
      stf(which ? &p.memv[rem] : &p.memk[rem], s);
    }
  }
}

DEV void ph_xs(const Params& p, int li, long long tid, long long nthr) {
  const float sc = 1.0f / sqrtf((float)XHD);
  FOR_IDX(idx, (long long)N_TOK * XH * MEM_LEN) {
    int m = (int)(idx % MEM_LEN); int h = (int)((idx / MEM_LEN) % XH); long long n = idx / (MEM_LEN * XH);
    int b = (int)(n / SEQ);
    const act_t* q = p.xq + n * D + h * XHD;
    const act_t* k = p.memk + ((long long)b * MEM_LEN + m) * D + h * XHD;
    float s = 0.f;
    for (int d = 0; d < XHD; ++d) s += ldf(q[d]) * ldf(k[d]);
    p.xs[idx] = s * sc;
  }
}

DEV void ph_xo(const Params& p, int li, long long tid, long long nthr) {
  FOR_IDX(idx, (long long)N_TOK * D) {
    long long n = idx / D; int c = (int)(idx % D);
    int h = c / XHD; int b = (int)(n / SEQ);
    const float* sr = p.xs + (n * XH + h) * MEM_LEN;
    float m = -INFINITY;
    for (int mm = 0; mm < MEM_LEN; ++mm) m = fmaxf(m, sr[mm]);
    float l = 0.f, o = 0.f;
    for (int mm = 0; mm < MEM_LEN; ++mm) {
      float pp = expf(sr[mm] - m);
      l += pp;
      o += pp * ldf(p.memv[((long long)b * MEM_LEN + mm) * D + c]);
    }
    stf(&p.xo[idx], o / l);
  }
}

DEV void ph_rlogit(const Params& p, int li, long long tid, long long nthr) {
  const float* W = p.w_router + (long long)li * D * NE;
  FOR_IDX(idx, (long long)N_TOK * NE) {
    long long n = idx / NE; int e = (int)(idx % NE);
    p.rl[idx] = dotcol(p.xf + n * D, W + e, D, NE) + p.b_router[li * NE + e];
  }
}

DEV void ph_route(const Params& p, int li, long long tid, long long nthr) {
  FOR_IDX(n, N_TOK) {
    const float* r = p.rl + n * NE;
    int i0 = -1, i1 = -1, i2 = -1, i3 = -1;
    float v0 = 0, v1 = 0, v2 = 0, v3 = 0;
    for (int k = 0; k < 4; ++k) {
      int bi = -1; float bv = -INFINITY;
      for (int e = 0; e < NE; ++e) {
        if (e == i0 || e == i1 || e == i2) continue;
        float v = r[e];
        if (bi < 0 || v > bv) { bi = e; bv = v; }
      }
      if (k == 0) { i0 = bi; v0 = bv; } else if (k == 1) { i1 = bi; v1 = bv; }
      else if (k == 2) { i2 = bi; v2 = bv; } else { i3 = bi; v3 = bv; }
    }
    float e0 = 1.0f, e1 = expf(v1 - v0), e2 = expf(v2 - v0), e3 = expf(v3 - v0);
    float inv = 1.0f / (e0 + e1 + e2 + e3);
#ifndef CPU_TEST
    p.rank[n * 4 + 0] = atomicAdd(&p.cnt[li * 32 + i0], 1);
    p.rank[n * 4 + 1] = atomicAdd(&p.cnt[li * 32 + i1], 1);
    p.rank[n * 4 + 2] = atomicAdd(&p.cnt[li * 32 + i2], 1);
    p.rank[n * 4 + 3] = atomicAdd(&p.cnt[li * 32 + i3], 1);
#endif
    p.topi[n * 4 + 0] = i0; p.topi[n * 4 + 1] = i1; p.topi[n * 4 + 2] = i2; p.topi[n * 4 + 3] = i3;
    p.topg[n * 4 + 0] = e0 * inv; p.topg[n * 4 + 1] = e1 * inv; p.topg[n * 4 + 2] = e2 * inv; p.topg[n * 4 + 3] = e3 * inv;
  }
}

DEV void ph_moe1(const Params& p, int li, long long tid, long long nthr) {
  FOR_IDX(idx, (long long)N_TOK * TOPK * DFF) {
    int j = (int)(idx % DFF); long long a = idx / DFF; long long n = a / TOPK;
    int e = p.topi[a];
    const float* W = p.w_gu + ((long long)li * NE + e) * D * 2 * DFF;
    const float* bb = p.b_gu + ((long long)li * NE + e) * 2 * DFF;
    float gt = dotcol(p.xb + n * D, W + j, D, 2 * DFF) + bb[j];
    float up = dotcol(p.xb + n * D, W + DFF + j, D, 2 * DFF) + bb[DFF + j];
    gt = fminf(gt, 7.0f);
    up = fminf(fmaxf(up, -7.0f), 7.0f);
    stf(&p.act[idx], (up + 1.0f) * gt * sigmoidf_(1.702f * gt));
  }
}

DEV void ph_moe2(const Params& p, int li, long long tid, long long nthr) {
  FOR_IDX(idx, (long long)N_TOK * D) {
    long long n = idx / D; int d = (int)(idx % D);
    float y = 0.f;
    for (int k = 0; k < TOPK; ++k) {
      int e = p.topi[n * 4 + k];
      const float* W = p.w_down + ((long long)li * NE + e) * DFF * D;
      float s = dotcol(p.act + (n * 4 + k) * DFF, W + d, DFF, D) + p.b_down[((long long)li * NE + e) * D + d];
      y += p.topg[n * 4 + k] * s;
    }
    p.tmp[idx] = ALPHA * p.xf[idx] + y;
  }
}

constexpr int PH_PER_LAYER = 20;
constexpr int N_PHASES = 1 + DEPTH * PH_PER_LAYER;

template <int K>
DEV void run_phase_k(const Params& p, int li, long long tid, long long nthr) {
  if constexpr (K == -1) ph_ln(p.x, p.ln0_g, p.ln0_b, p.xf, p.xb, nullptr, tid, nthr);
  if constexpr (K == 0) ph_inproj(p, li, tid, nthr);
  if constexpr (K == 1) ph_pre<3>(p, li, tid, nthr);
  if constexpr (K == 20) ph_pre<1>(p, li, tid, nthr);
  if constexpr (K == 2) ph_mix1<7>(p, li, tid, nthr);
  if constexpr (K == 21) ph_mix1<4>(p, li, tid, nthr);
  if constexpr (K == 3) ph_nsa1<3>(p, li, tid, nthr);
  if constexpr (K == 22) ph_nsa1<1>(p, li, tid, nthr);
  if constexpr (K == 4) ph_nsa2(p, li, tid, nthr);
  if constexpr (K == 5) ph_nsa3(p, li, tid, nthr);
  if constexpr (K == 6) ph_nsa4(p, li, tid, nthr);
  if constexpr (K == 7) ph_br(p, li, tid, nthr);
  if constexpr (K == 8) ph_proj_res(p, p.merged, p.w_o_mix + (long long)li * D * D, tid, nthr);
  if constexpr (K == 9) ph_ln(p.tmp, p.ln1_g + li * D, p.ln1_b + li * D, p.xf, p.xb, nullptr, tid, nthr);
  if constexpr (K == 10) ph_xq(p, li, tid, nthr);
  if constexpr (K == 11) ph_xs(p, li, tid, nthr);
  if constexpr (K == 12) ph_xo(p, li, tid, nthr);
  if constexpr (K == 13) ph_proj_res(p, p.xo, p.w_xo + (long long)li * D * D, tid, nthr);
  if constexpr (K == 14) ph_ln(p.tmp, p.ln2_g + li * D, p.ln2_b + li * D, p.xf, p.xb, nullptr, tid, nthr);
  if constexpr (K == 15) ph_rlogit(p, li, tid, nthr);
  if constexpr (K == 16) ph_route(p, li, tid, nthr);
  if constexpr (K == 17) ph_moe1(p, li, tid, nthr);
  if constexpr (K == 18) ph_moe2(p, li, tid, nthr);
  if constexpr (K == 19) ph_ln(p.tmp, p.ln3_g + li * D, p.ln3_b + li * D, p.xf, p.xb, li == DEPTH - 1 ? p.out : nullptr, tid, nthr);
}

DEV void run_phase(const Params& p, int ph, long long tid, long long nthr) {
  if (ph == 0) { run_phase_k<-1>(p, 0, tid, nthr); return; }
  int li = (ph - 1) / PH_PER_LAYER, k = (ph - 1) % PH_PER_LAYER;
  switch (k) {
#define PHC(K) case K: run_phase_k<K>(p, li, tid, nthr); break;
    PHC(0) PHC(1) PHC(2) PHC(3) PHC(4) PHC(5) PHC(6) PHC(7) PHC(8) PHC(9)
    PHC(10) PHC(11) PHC(12) PHC(13) PHC(14) PHC(15) PHC(16) PHC(17) PHC(18) PHC(19)
#undef PHC
  }
}

#ifdef CPU_TEST
#define HDI_M
#else
#define HDI_M __host__ __device__ __forceinline__
#endif
struct Carver {
  char* base; size_t off;
  template <class T> HDI_M T* take(size_t n) {
    T* r = (T*)(base + off);
    off += (n * sizeof(T) + 255) & ~(size_t)255;
    return r;
  }
};

HDI void fill_params(Params& p, void* const* d_in, void* d_out, void* d_ws) {
  const float* const* in = (const float* const*)d_in;
  p.x = in[0]; p.mem = in[1]; p.ln0_g = in[2]; p.ln0_b = in[3]; p.w_in = in[4]; p.b_in = in[5];
  p.w_alpha2 = in[6]; p.b_alpha = in[7]; p.gla_norm_g = in[8];
  p.cmp_pe_k = in[9]; p.cmp_w1_k = in[10]; p.cmp_w2_k = in[11]; p.cmp_pe_v = in[12]; p.cmp_w1_v = in[13]; p.cmp_w2_v = in[14];
  p.w_br_a = in[15]; p.w_br_b = in[16]; p.w_br_c = in[17]; p.w_o_mix = in[18]; p.ln1_g = in[19]; p.ln1_b = in[20];
  p.w_xq = in[21]; p.w_xk = in[22]; p.w_xv = in[23]; p.w_xo = in[24]; p.ln2_g = in[25]; p.ln2_b = in[26];
  p.w_router = in[27]; p.b_router = in[28]; p.w_gu = in[29]; p.b_gu = in[30]; p.w_down = in[31]; p.b_down = in[32];
  p.ln3_g = in[33]; p.ln3_b = in[34];
  p.out = (float*)d_out;
  Carver c{(char*)d_ws, 0};
  p.barw = c.take<unsigned>(4096);
  p.xf = c.take<float>((size_t)N_TOK * D);
  p.xb = c.take<act_t>((size_t)N_TOK * D);
  p.u = c.take<act_t>((size_t)N_TOK * N_IN);
  p.ga = c.take<float>((size_t)N_TOK * B_K);
  p.hid = c.take<float>((size_t)2 * CMP_ROWS * CMP_HID);
  p.kcv = c.take<float>((size_t)2 * CMP_ROWS * HD);
  p.opart = c.take<float>((size_t)4 * N_TOK * B_V);
  p.yass = p.opart;
#ifdef CPU_TEST
  p.ya = c.take<act_t>((size_t)N_TOK * 256);
  p.yb = c.take<act_t>((size_t)N_TOK * B_V);
  p.yc = c.take<act_t>((size_t)N_TOK * 1024);
#else
  p.ya = c.take<act_t>((size_t)N_TOK * YLD);
  p.yb = p.ya + 256;
  p.yc = p.ya + 1280;
#endif
  p.pcmp = c.take<float>((size_t)MOE_ROWS * 1024 / 2 > (size_t)BATCH * NSA_H * SEQ * 128 ? (size_t)MOE_ROWS * 1024 / 2 : (size_t)BATCH * NSA_H * SEQ * 128);
  p.xg = (act_t*)p.pcmp;
  p.ocmp = c.take<float>((size_t)N_TOK * 1024);
  p.impb = c.take<float>((size_t)BATCH * NSA_G * SEQ * N_BLK);
  p.selb = c.take<int>((size_t)BATCH * NSA_G * SEQ * N_BLK);
  p.merged = c.take<act_t>((size_t)N_TOK * D);
  p.tmp = c.take<float>((size_t)N_TOK * D);
  p.xq = c.take<act_t>((size_t)N_TOK * D);
  p.memk = c.take<act_t>((size_t)BATCH * MEM_LEN * D);
  p.memv = c.take<act_t>((size_t)BATCH * MEM_LEN * D);
  p.xs = c.take<float>((size_t)N_TOK * XH * MEM_LEN);
  p.mrg = p.xs;
  p.xo = c.take<act_t>((size_t)N_TOK * D);
  p.rl = c.take<float>((size_t)N_TOK * NE);
  p.topi = c.take<int>((size_t)N_TOK * TOPK);
  p.topg = c.take<float>((size_t)N_TOK * TOPK);
  p.actg = c.take<act_t>((size_t)MOE_ROWS * 1024);
  p.act = p.actg;
  p.wt_in = c.take<act_t>((size_t)2 * N_IN_PAD * 1024);
  p.wt_c1 = c.take<act_t>((size_t)2 * 2 * 256 * 2048);
  p.wt_bra = c.take<act_t>((size_t)2 * 1024 * YLD);
  p.wt_brb = p.wt_bra + 256;
  p.wt_brc = p.wt_bra + 1280;
  p.wt_omix = c.take<act_t>((size_t)2 * 1024 * 1024);
  p.wt_xq = c.take<act_t>((size_t)2 * 1024 * 1024);
  p.wt_xk = c.take<act_t>((size_t)2 * 1024 * 1024);
  p.wt_xv = c.take<act_t>((size_t)2 * 1024 * 1024);
  p.wt_xo = c.take<act_t>((size_t)2 * 1024 * 1024);
  p.wt_gu = c.take<act_t>((size_t)2 * 32 * 2048 * 1024);
  p.wt_dn = c.take<act_t>((size_t)2 * 32 * 1024 * 1024);
  p.membf = c.take<act_t>((size_t)BATCH * MEM_LEN * 1024);
  p.cmpA = c.take<act_t>((size_t)2 * CMP_ROWS_PAD * 2048);
  p.cnt = c.take<int>(64);
  p.rank = c.take<int>((size_t)N_TOK * 4);
  p.rowlist = c.take<int>((size_t)MOE_ROWS);
  p.kcb = c.take<act_t>((size_t)2 * BATCH * 128 * NSA_G * 64);
  p.dilo = c.take<act_t>((size_t)3 * N_TOK * 256);
  p.dill = c.take<float>((size_t)3 * N_TOK * 4);
  p.selm = c.take<unsigned>((size_t)BATCH * NSA_G * SEQ);
  p.gU = p.xg; p.gQ = p.xg + (size_t)1024 * 128 * 256; p.gS = p.actg; p.gD = p.opart + (size_t)N_TOK * 1024;
  p.ws_used = c.off;
}

#ifndef CPU_TEST
#ifndef NSA_PROBE
#define NSA_PROBE 0
#endif
#ifndef GSEG
#define GSEG -1
#endif
static_assert(D == 1024 && BATCH == 8, "optimized path is written for the graded shapes");
namespace pg8 {
#define PG8_LAS __attribute__((address_space(3)))
typedef unsigned short bf16_t;
typedef short bf16x8 __attribute__((ext_vector_type(8)));
typedef float f32x4 __attribute__((ext_vector_type(4)));
typedef unsigned u32x4 __attribute__((ext_vector_type(4)));
constexpr int BM = 256, BK = 64, HALF = 128, HTB = HALF * BK * 2  , STAGE_BYTES = 8 * HTB, NXCD = 8, WGM = 8;

__host__ __device__ __forceinline__ int lds_byte(int r, int c) { const int st = (r >> 4) * 2 + (c >> 5), rr = r & 15, cc = c & 31, ob = rr * 64 + cc * 2; return st * 1024 + (ob ^ (((ob >> 9) & 1) << 5)); }
__host__ __device__ __forceinline__ void stage_rc(int b, int& R, int& C) { const int st = b / 1024, sb = b % 1024, swz = sb ^ (((sb >> 9) & 1) << 5); R = (st >> 1) * 16 + swz / 64; C = (st & 1) * 32 + (swz % 64) / 2; }
__host__ __device__ __forceinline__ int perm32(int rho) { const int n = rho >> 4, i = rho & 15; return 8 * (i >> 2) + 4 * n + (i & 3); }

struct Unit { int pm, pn; };
struct Gemm { const bf16_t* A; const bf16_t* Bt; int M, N, K; };

struct StaticOrder {
    int nM, nN, nwg, G, c;
    __host__ __device__ void init(int M, int N, int G_, int c_) { nM = M / BM; nN = N / BM; nwg = nM * nN; G = G_; c = c_; }
    __host__ __device__ bool next(int i, Unit& u) const {
        const long L = (long)i * G + c; if (L >= nwg) return false;
        int wgid = (int)L; { const int q = nwg / NXCD, r = nwg % NXCD, xcd = wgid % NXCD, off = wgid / NXCD; wgid = (xcd < r ? xcd * (q + 1) : r * (q + 1) + (xcd - r) * q) + off; }
        const int nig = WGM * nN, gid = wgid / nig, fm = gid * WGM, gsz = (nM - fm) < WGM ? (nM - fm) : WGM;
        u.pm = fm + ((wgid % nig) % gsz); u.pn = (wgid % nig) / gsz; return true;
    }
    __device__ __forceinline__ void a_ready(const Unit&) const {}
    __device__ __forceinline__ void done(const Unit&) const {}
};

__device__ __forceinline__ unsigned cvt_pk_bf16(float lo, float hi) { unsigned r; asm volatile("v_cvt_pk_bf16_f32 %0, %1, %2" : "=v"(r) : "v"(lo), "v"(hi)); return r; }

template <class Epi, class Sched, bool ALIGN_EPI = false, bool SP2 = false>
__device__ __forceinline__ void gemm_phase(PG8_LAS unsigned char* lds, const Gemm g, const Sched& S, const Epi& E, const int tid) {
    const int wid = __builtin_amdgcn_readfirstlane(tid >> 6), lane = tid & 63, wr = wid >> 2, wc = wid & 3, fr = lane & 15, fq = lane >> 4;
    const int K = g.K, nt = K / BK;
    unsigned voffA[2], voffB[2];
#pragma unroll
    for (int i = 0; i < 2; ++i) { int R, C; stage_rc(tid * 16 + i * 8192, R, C); const int Rb = Epi::PERM ? ((R & ~31) + perm32(R & 31)) : R;
        voffA[i] = (unsigned)(R * K + C) * 2u; voffB[i] = (unsigned)(Rb * K + C) * 2u; }
    const size_t kstep = (size_t)(BK * 2);
    const size_t hstep = (size_t)HALF * K * 2;
    const size_t tstep = 2 * hstep;
    const unsigned ldsw = (unsigned)wid * 1024u;
    const int aoff = lds_byte(wr * 64 + fr, fq * 8), boff = lds_byte(wc * 32 + fr, fq * 8);
#define PG8_SA(b, h) (((b) * 2 + (h)) * HTB)
#define PG8_SB(b, h) ((4 + (b) * 2 + (h)) * HTB)
#define PG8_STAGE(bufoff, gbase, voff) do { _Pragma("unroll") for (int _i = 0; _i < 2; ++_i) \
        __builtin_amdgcn_global_load_lds((const unsigned*)((const char*)(gbase) + (voff)[_i]), (PG8_LAS unsigned*)(lds + (bufoff) + ldsw + _i * 8192), 16, 0, 0); } while (0)
#define PG8_LDA(dst, b, h) do { _Pragma("unroll") for (int m = 0; m < 4; ++m) _Pragma("unroll") for (int k = 0; k < 2; ++k) dst[m][k] = *(const PG8_LAS bf16x8*)(lds + PG8_SA(b, h) + aoff + m * 2048 + k * 1024); } while (0)
#define PG8_LDB(dst, b, h) do { _Pragma("unroll") for (int n = 0; n < 2; ++n) _Pragma("unroll") for (int k = 0; k < 2; ++k) dst[n][k] = *(const PG8_LAS bf16x8*)(lds + PG8_SB(b, h) + boff + n * 2048 + k * 1024); } while (0)
#define PG8_MMA(ai, bj, At, Bt) do { __builtin_amdgcn_s_setprio(1); _Pragma("unroll") for (int m = 0; m < 4; ++m) _Pragma("unroll") for (int n = 0; n < 2; ++n) _Pragma("unroll") for (int k = 0; k < 2; ++k) \
        acc[ai][bj][m][n] = __builtin_amdgcn_mfma_f32_16x16x32_bf16(Bt[n][k], At[m][k], acc[ai][bj][m][n], 0, 0, 0); __builtin_amdgcn_s_setprio(0); } while (0)
#define PG8_WAIT_V(n) asm volatile("s_waitcnt vmcnt(" #n ")" ::: "memory")
#define PG8_WAIT_L(n) asm volatile("s_waitcnt lgkmcnt(" #n ")" ::: "memory")
#define PG8_BAR __builtin_amdgcn_s_barrier()
#define PG8_SCHED __builtin_amdgcn_sched_barrier(0)
    Unit cur, nxt; int ui = 0;
    if (!S.next(0, cur)) return;
    f32x4 acc[2][2][4][2];
#pragma unroll
    for (int a = 0; a < 2; ++a)
#pragma unroll
        for (int b = 0; b < 2; ++b)
#pragma unroll
            for (int m = 0; m < 4; ++m)
#pragma unroll
                for (int n = 0; n < 2; ++n) acc[a][b][m][n] = (f32x4){0.f, 0.f, 0.f, 0.f};
    bf16x8 At[4][2], B0[2][2], B1[2][2];
    const char* cA = (const char*)g.A + (size_t)cur.pm * tstep; const char* cB = (const char*)g.Bt + (size_t)cur.pn * tstep;
    S.a_ready(cur);
    if constexpr (SP2) {
        PG8_STAGE(PG8_SB(0, 0), cB, voffB); PG8_STAGE(PG8_SB(0, 1), cB + hstep, voffB); PG8_STAGE(PG8_SA(0, 0), cA, voffA); PG8_STAGE(PG8_SA(0, 1), cA + hstep, voffA);
        if (wr == 1) PG8_BAR;
        PG8_WAIT_V(2); PG8_BAR;
        PG8_STAGE(PG8_SB(1, 0), cB + kstep, voffB); PG8_STAGE(PG8_SA(1, 0), cA + kstep, voffA); PG8_STAGE(PG8_SB(1, 1), cB + hstep + kstep, voffB);
        PG8_WAIT_V(6); PG8_BAR;
    } else {
        PG8_STAGE(PG8_SB(0, 0), cB, voffB); PG8_STAGE(PG8_SA(0, 0), cA, voffA); PG8_STAGE(PG8_SB(0, 1), cB + hstep, voffB); PG8_STAGE(PG8_SA(0, 1), cA + hstep, voffA);
        if (wr == 1) PG8_BAR;
        PG8_WAIT_V(4); PG8_BAR;
        PG8_STAGE(PG8_SB(1, 0), cB + kstep, voffB); PG8_STAGE(PG8_SA(1, 0), cA + kstep, voffA); PG8_STAGE(PG8_SB(1, 1), cB + hstep + kstep, voffB);
        PG8_WAIT_V(6); PG8_BAR;
    }
    for (;;) {
        const bool has_next = S.next(ui + 1, nxt);
        const char* nA = has_next ? (const char*)g.A + (size_t)nxt.pm * tstep : cA; const char* nB = has_next ? (const char*)g.Bt + (size_t)nxt.pn * tstep : cB;
        for (int t = 0; t < nt; t += 2) {
            const bool last = (t == nt - 2);
            const char* a1 = cA + (size_t)(t + 1) * kstep;
            const char* a2 = last ? nA : cA + (size_t)(t + 2) * kstep; const char* b2 = last ? nB : cB + (size_t)(t + 2) * kstep;
            const char* a3 = a2 + kstep; const char* b3 = b2 + kstep;
            if (last && has_next) S.a_ready(nxt);
            asm volatile("" : "+v"(voffA[0]), "+v"(voffA[1]), "+v"(voffB[0]), "+v"(voffB[1]));
            E.mid(acc, cur, wr, wc, t);
            if constexpr (SP2) {
            PG8_LDB(B0, 0, 0); PG8_LDB(B1, 0, 1); PG8_SCHED; PG8_LDA(At, 0, 0); PG8_STAGE(PG8_SA(1, 1), a1 + hstep, voffA);
            PG8_WAIT_V(8); PG8_WAIT_L(0); PG8_BAR; PG8_MMA(0, 0, At, B0); PG8_MMA(0, 1, At, B1); PG8_BAR; PG8_SCHED;
            PG8_LDA(At, 0, 1); PG8_STAGE(PG8_SB(0, 0), b2, voffB); PG8_STAGE(PG8_SB(0, 1), b2 + hstep, voffB); PG8_STAGE(PG8_SA(0, 0), a2, voffA);
            PG8_WAIT_V(8); PG8_WAIT_L(0); PG8_BAR; PG8_MMA(1, 0, At, B0); PG8_MMA(1, 1, At, B1); PG8_BAR; PG8_SCHED;
            PG8_LDB(B0, 1, 0); PG8_LDB(B1, 1, 1); PG8_SCHED; PG8_LDA(At, 1, 0); PG8_STAGE(PG8_SA(0, 1), a2 + hstep, voffA);
            PG8_WAIT_V(8); PG8_WAIT_L(0); PG8_BAR; PG8_MMA(0, 0, At, B0); PG8_MMA(0, 1, At, B1); PG8_BAR; PG8_SCHED;
            PG8_LDA(At, 1, 1); PG8_STAGE(PG8_SB(1, 0), b3, voffB); PG8_STAGE(PG8_SB(1, 1), b3 + hstep, voffB); PG8_STAGE(PG8_SA(1, 0), a3, voffA);
            PG8_WAIT_V(8); PG8_WAIT_L(0); PG8_BAR; PG8_MMA(1, 0, At, B0); PG8_MMA(1, 1, At, B1); PG8_BAR; PG8_SCHED;
            } else {
            PG8_LDB(B0, 0, 0); PG8_SCHED; PG8_LDA(At, 0, 0); PG8_STAGE(PG8_SA(1, 1), a1 + hstep, voffA);
            PG8_WAIT_L(8); PG8_BAR; PG8_WAIT_L(0); PG8_MMA(0, 0, At, B0); PG8_BAR; PG8_SCHED;
            PG8_LDB(B1, 0, 1); PG8_STAGE(PG8_SB(0, 0), b2, voffB);
            PG8_BAR; PG8_WAIT_L(0); PG8_MMA(0, 1, At, B1); PG8_BAR;
            PG8_LDA(At, 0, 1); PG8_STAGE(PG8_SA(0, 0), a2, voffA);
            PG8_BAR; PG8_WAIT_L(0); PG8_MMA(1, 0, At, B0); PG8_BAR; PG8_SCHED;
            PG8_STAGE(PG8_SB(0, 1), b2 + hstep, voffB);
            PG8_WAIT_V(6); PG8_BAR; PG8_MMA(1, 1, At, B1); PG8_BAR;
            PG8_LDB(B0, 1, 0); PG8_SCHED; PG8_LDA(At, 1, 0); PG8_STAGE(PG8_SA(0, 1), a2 + hstep, voffA);
            PG8_WAIT_L(8); PG8_BAR; PG8_WAIT_L(0); PG8_MMA(0, 0, At, B0); PG8_BAR; PG8_SCHED;
            PG8_LDB(B1, 1, 1); PG8_STAGE(PG8_SB(1, 0), b3, voffB);
            PG8_BAR; PG8_WAIT_L(0); PG8_MMA(0, 1, At, B1); PG8_BAR;
            PG8_LDA(At, 1, 1); PG8_STAGE(PG8_SA(1, 0), a3, voffA);
            PG8_BAR; PG8_WAIT_L(0); PG8_MMA(1, 0, At, B0); PG8_BAR; PG8_SCHED;
            PG8_STAGE(PG8_SB(1, 1), b3 + hstep, voffB);
            PG8_WAIT_V(6); PG8_BAR; PG8_MMA(1, 1, At, B1); PG8_BAR;
            }
        }
        if constexpr (ALIGN_EPI) { if (wr == 0) PG8_BAR; }
        if constexpr (!Epi::AFTER_DRAIN) { E(acc, cur, wr, wc, fr, fq); S.done(cur); }
        if (!has_next) break;
#pragma unroll
        for (int a = 0; a < 2; ++a)
#pragma unroll
            for (int b = 0; b < 2; ++b)
#pragma unroll
                for (int m = 0; m < 4; ++m)
#pragma unroll
                    for (int n = 0; n < 2; ++n) acc[a][b][m][n] = (f32x4){0.f, 0.f, 0.f, 0.f};
        cur = nxt; cA = nA; cB = nB; ++ui;
        if constexpr (ALIGN_EPI) { if (wr == 1) PG8_BAR; }
    }
    PG8_WAIT_V(0);
    if constexpr (!ALIGN_EPI) { if (wr == 0) PG8_BAR; }
    PG8_BAR;
    if constexpr (Epi::AFTER_DRAIN) { E.fused(acc, cur, wr, wc, fr, fq, lds, wid, lane); S.done(cur); }
#undef PG8_SA
#undef PG8_SB
#undef PG8_STAGE
#undef PG8_LDA
#undef PG8_LDB
#undef PG8_MMA
#undef PG8_WAIT_V
#undef PG8_WAIT_L
#undef PG8_BAR
#undef PG8_SCHED
}
}

typedef pg8::f32x4 f32x4;
typedef pg8::bf16x8 bf16x8;
typedef unsigned u32x2 __attribute__((ext_vector_type(2)));
typedef unsigned u32x4 __attribute__((ext_vector_type(4)));
#define LAS __attribute__((address_space(3)))

constexpr int NTHREADS = 512;
constexpr int RING_BYTES = 131072;
constexpr int MISC_OFF = RING_BYTES;
constexpr int LDS_BYTES = 147456;

typedef __bf16 bf16x2_t __attribute__((ext_vector_type(2)));
typedef float f32x2_t __attribute__((ext_vector_type(2)));
DEV unsigned pk2(float lo, float hi) {
  const f32x2_t v = {lo, hi};
  return __builtin_bit_cast(unsigned, __builtin_convertvector(v, bf16x2_t));
}
DEV unsigned short f2bfh(float x) { return (unsigned short)(pk2(x, 0.f) & 0xffffu); }
DEV float shx(float v, int lane, int o) { return __int_as_float(__builtin_amdgcn_ds_bpermute((lane ^ o) << 2, __float_as_int(v))); }
DEV int shxi(int v, int lane, int o) { return __builtin_amdgcn_ds_bpermute((lane ^ o) << 2, v); }
DEV float wave_sum(float v, int lane) {
#pragma unroll
  for (int o = 1; o < 64; o <<= 1)
    v += __int_as_float(__builtin_amdgcn_ds_bpermute((lane ^ o) << 2, __float_as_int(v)));
  return v;
}

DEV void transpose_item(const float* W, int ldw, int dld, act_t* WT, int k0, int n0, int drow0, LAS float* scr, int lane) {
  float wv[32];
#pragma unroll
  for (int i = 0; i < 32; ++i) wv[i] = W[(size_t)(k0 + 2 * i + (lane >> 5)) * ldw + n0 + (lane & 31)];
#pragma unroll
  for (int i = 0; i < 32; ++i) scr[(2 * i + (lane >> 5)) * 33 + (lane & 31)] = wv[i];
  asm volatile("s_waitcnt lgkmcnt(0)" ::: "memory");
  const int c = lane & 7;
#pragma unroll
  for (int j = 0; j < 4; ++j) {
    const int n = (lane >> 3) + 8 * j;
    const LAS float* s = scr + (8 * c) * 33 + n;
    u32x4 o;
    o.x = pk2(s[0 * 33], s[1 * 33]); o.y = pk2(s[2 * 33], s[3 * 33]);
    o.z = pk2(s[4 * 33], s[5 * 33]); o.w = pk2(s[6 * 33], s[7 * 33]);
    *(u32x4*)(WT + (size_t)(drow0 + n) * dld + k0 + 8 * c) = o;
  }
  asm volatile("s_waitcnt lgkmcnt(0)" ::: "memory");
}

struct ConvDesc { const float* W; act_t* dst; int nbatch, K, N, mode; size_t dstb; int dld; };
constexpr int NCONV = 13;
DEV ConvDesc conv_desc(const Params& p, int kind) {
  const size_t SQ = (size_t)1024 * 1024;
  switch (kind) {
    case 0: return ConvDesc{p.w_gu, p.wt_gu, 64, 1024, 2048, 1, (size_t)2048 * 1024, 1024};
    case 1: return ConvDesc{p.w_down, p.wt_dn, 64, 1024, 1024, 0, SQ, 1024};
    case 2: return ConvDesc{p.w_in, p.wt_in, 2, 1024, N_IN, 0, (size_t)N_IN_PAD * 1024, 1024};
    case 3: return ConvDesc{p.cmp_w1_k, p.wt_c1, 2, 2048, 128, 0, (size_t)2 * 256 * 2048, 2048};
    case 4: return ConvDesc{p.cmp_w1_v, p.wt_c1 + (size_t)256 * 2048, 2, 2048, 128, 0, (size_t)2 * 256 * 2048, 2048};
    case 5: return ConvDesc{p.w_br_a, p.wt_bra, 2, 256, 1024, 0, (size_t)1024 * YLD, YLD};
    case 6: return ConvDesc{p.w_br_b, p.wt_brb, 2, 1024, 1024, 0, (size_t)1024 * YLD, YLD};
    case 7: return ConvDesc{p.w_br_c, p.wt_brc, 2, 1024, 1024, 0, (size_t)1024 * YLD, YLD};
    case 8: return ConvDesc{p.w_o_mix, p.wt_omix, 2, 1024, 1024, 0, SQ, 1024};
    case 9: return ConvDesc{p.w_xq, p.wt_xq, 2, 1024, 1024, 0, SQ, 1024};
    case 10: return ConvDesc{p.w_xk, p.wt_xk, 2, 1024, 1024, 0, SQ, 1024};
    case 11: return ConvDesc{p.w_xv, p.wt_xv, 2, 1024, 1024, 0, SQ, 1024};
    default: return ConvDesc{p.w_xo, p.wt_xo, 2, 1024, 1024, 0, SQ, 1024};
  }
}
DEV int conv_items(int kind) {
  switch (kind) {
    case 0: return 64 * 16 * 64;
    case 1: return 64 * 16 * 32;
    case 2: return 2 * 16 * (N_IN / 32);
    case 3: case 4: return 2 * 32 * 4;
    case 5: return 2 * 4 * 32;
    default: return 2 * 16 * 32;
  }
}
DEV void conv_all(const Params& p, int gw, int NGW, LAS float* scr, int lane) {
  int base = 0;
  for (int kind = 0; kind < NCONV; ++kind) {
    const int total = conv_items(kind);
    const ConvDesc d = conv_desc(p, kind);
    const int nblk = d.N / 32, per = nblk * (d.K / 64);
    int first = (gw - base % NGW + NGW) % NGW;
    for (int it = first; it < total; it += NGW) {
      const int bt = it / per, r = it % per, kb = r / nblk, nb = r % nblk;
      const int n0 = nb * 32;
      int drow0 = n0;
      if (d.mode == 1) { const int j = n0 & 1023; drow0 = (j >> 7) * 256 + (j & 127) + ((n0 >= 1024) ? 128 : 0); }
      transpose_item(d.W + (size_t)bt * d.K * d.N, d.N, d.dld, d.dst + (size_t)bt * d.dstb, kb * 64, n0, drow0, scr, lane);
    }
    base += total;
  }
}

template <int MODE, bool SRC_BF16 = false>
DEV void ln_rows_w(const Params& p, const float* src, const float* g, const float* b, float* dstf, act_t* dstb, float* dst2,
                   int gw, int NGW, int lane) {
  for (int n0 = gw; n0 < N_TOK; n0 += 2 * NGW) {
    f32x4 v[2][4];
    float s[2] = {0.f, 0.f};
#pragma unroll
    for (int r = 0; r < 2; ++r) {
      const int n = (n0 + r * NGW < N_TOK) ? n0 + r * NGW : n0;
#pragma unroll
      for (int j = 0; j < 4; ++j) {
        if (MODE == 0) {
          if (SRC_BF16) {
            const u32x2 xw = ((const u32x2*)((const act_t*)src + (size_t)n * D))[lane + 64 * j];
            v[r][j] = (f32x4){__uint_as_float(xw.x << 16), __uint_as_float(xw.x & 0xffff0000u), __uint_as_float(xw.y << 16), __uint_as_float(xw.y & 0xffff0000u)};
          } else v[r][j] = ((const f32x4*)(src + (size_t)n * D))[lane + 64 * j];
        } else {
          f32x4 a = ((const f32x4*)(p.xf + (size_t)n * D))[lane + 64 * j] * ALPHA;
#pragma unroll
          for (int k = 0; k < 4; ++k) {
            const u32x2 yw = ((const u32x2*)((const act_t*)p.yass + ((size_t)n * 4 + k) * D))[lane + 64 * j];
            a.x += __uint_as_float(yw.x << 16); a.y += __uint_as_float(yw.x & 0xffff0000u);
            a.z += __uint_as_float(yw.y << 16); a.w += __uint_as_float(yw.y & 0xffff0000u);
          }
          v[r][j] = a;
        }
        s[r] += (v[r][j].x + v[r][j].y) + (v[r][j].z + v[r][j].w);
      }
    }
    float mean[2], s2[2] = {0.f, 0.f}, rstd[2];
#pragma unroll
    for (int o = 1; o < 64; o <<= 1) { s[0] += shx(s[0], lane, o); s[1] += shx(s[1], lane, o); }
#pragma unroll
    for (int r = 0; r < 2; ++r) {
      mean[r] = s[r] * (1.f / D);
#pragma unroll
      for (int j = 0; j < 4; ++j) { v[r][j] = v[r][j] - mean[r]; s2[r] += (v[r][j].x * v[r][j].x + v[r][j].y * v[r][j].y) + (v[r][j].z * v[r][j].z + v[r][j].w * v[r][j].w); }
    }
#pragma unroll
    for (int o = 1; o < 64; o <<= 1) { s2[0] += shx(s2[0], lane, o); s2[1] += shx(s2[1], lane, o); }
#pragma unroll
    for (int r = 0; r < 2; ++r) {
      rstd[r] = 1.f / sqrtf(s2[r] * (1.f / D) + LN_EPS);
      const int n = n0 + r * NGW;
      if (n < N_TOK) {
#pragma unroll
        for (int j = 0; j < 4; ++j) {
          const f32x4 gm = ((const f32x4*)g)[lane + 64 * j], bt = ((const f32x4*)b)[lane + 64 * j];
          const f32x4 y = v[r][j] * rstd[r] * gm + bt;
          ((f32x4*)(dstf + (size_t)n * D))[lane + 64 * j] = y;
          u32x2 w; w.x = pk2(y.x, y.y); w.y = pk2(y.z, y.w);
          ((u32x2*)(dstb + (size_t)n * D))[lane + 64 * j] = w;
          if (dst2) ((f32x4*)(dst2 + (size_t)n * D))[lane + 64 * j] = y;
        }
      }
    }
  }
}

DEV void prologue(const Params& p, LAS unsigned char* lds, int wave, int lane) {
  LAS float* scr = (LAS float*)(lds + wave * 16384);
  const int gw = blockIdx.x * 8 + wave, NGW = gridDim.x * 8;
  conv_all(p, gw, NGW, scr, lane);
  const long long tid = (long long)blockIdx.x * NTHREADS + threadIdx.x, nthr = (long long)gridDim.x * NTHREADS;
  {
    const long long padw = (long long)(N_IN_PAD - N_IN) * 1024 / 8;
    for (long long i = tid; i < 2 * padw; i += nthr) {
      const int li = (int)(i / padw); const long long r = i % padw;
      ((u32x4*)(p.wt_in + ((size_t)li * N_IN_PAD + N_IN) * 1024))[r] = (u32x4){0u, 0u, 0u, 0u};
    }
    const long long padc = (long long)128 * 2048 / 8;
    for (long long i = tid; i < 4 * padc; i += nthr) {
      const int q = (int)(i / padc); const long long r = i % padc;
      ((u32x4*)(p.wt_c1 + ((size_t)q * 256 + 128) * 2048))[r] = (u32x4){0u, 0u, 0u, 0u};
    }
    if (tid < 64) p.cnt[tid] = 0;
    for (long long i = tid; i < 2LL * BATCH * NSA_G * 64; i += nthr) {
      const long long wb = i / (NSA_G * 64), r = i % (NSA_G * 64);
      p.kcb[(wb * 128 + 127) * NSA_G * 64 + r] = 0;
    }
    for (long long i = tid; i < (long long)BATCH * MEM_LEN * 1024 / 4; i += nthr) {
      const f32x4 v = ((const f32x4*)p.mem)[i];
      u32x2 w; w.x = pk2(v.x, v.y); w.y = pk2(v.z, v.w);
      ((u32x2*)p.membf)[i] = w;
    }
  }
  ln_rows_w<0>(p, p.x, p.ln0_g, p.ln0_b, p.xf, p.xb, nullptr, gw, NGW, lane);
}

struct USched {
  int nM, nN, nwg, G, c;
  int moe, nct, total; const LAS int* tile_e;
  DEV void init_static(int M, int N, int G_, int c_) { nM = M / 256; nN = N / 256; nwg = nM * nN; G = G_; c = c_; moe = 0; nct = 1; total = nwg; tile_e = nullptr; }
  DEV void init_moe(int G_, int c_, int nct_, int total_, const LAS int* te) { nM = 1; nN = 1; nwg = total_; G = G_; c = c_; moe = 1; nct = nct_; total = total_; tile_e = te; }
  DEV bool next(int i, pg8::Unit& u) const {
    const long L = (long)i * G + c;
    if (!(moe && (G & 7) == 0) && L >= total) return false;
    if (moe) {
      if ((G & 7) == 0) {
        const int xcd = c & 7, rank = c >> 3, nr = G >> 3, T = total / nct;
        const int tlo = (T * xcd) >> 3, thi = (T * (xcd + 1)) >> 3;
        const int lu = i * nr + rank;
        if (lu >= (thi - tlo) * nct) return false;
        const int rt = tlo + lu / nct, j = lu % nct;
        u.pm = rt; u.pn = tile_e[rt] * nct + j; return true;
      }
      const int rt = (int)(L / nct), j = (int)(L % nct); u.pm = rt; u.pn = tile_e[rt] * nct + j; return true;
    }
    int wgid = (int)L; { const int q = nwg / 8, r = nwg % 8, xcd = wgid % 8, off = wgid / 8; wgid = (xcd < r ? xcd * (q + 1) : r * (q + 1) + (xcd - r) * q) + off; }
    const int nig = 8 * nN, gid = wgid / nig, fm = gid * 8, gsz = (nM - fm) < 8 ? (nM - fm) : 8;
    u.pm = fm + ((wgid % nig) % gsz); u.pn = (wgid % nig) / gsz; return true;
  }
  DEV void a_ready(const pg8::Unit&) const {}
  DEV void done(const pg8::Unit&) const {}
};

enum { EM_INPROJ = 0, EM_BRCAT, EM_RES, EM_BF16, EM_MOE1, EM_MOE2, EM_HID };
#define EPI_FENCE() asm volatile("" ::: "memory")
struct EpiU {
  static constexpr bool PERM = false, AFTER_DRAIN = false;
  int mode, ldc;
  void* q0;
  const void* q1;
  const void* q2;
  const void* q3;
  const LAS int* te;
  DEV void mid(f32x4 (&acc)[2][2][4][2], const pg8::Unit& un, int wr, int wc, int t) const {
    if (mode != EM_BRCAT || (t != 4 && t != 20)) return;
    const act_t* ub = (const act_t*)q1;
    int l2;
    asm volatile("v_mbcnt_lo_u32_b32 %0, -1, 0\n\tv_mbcnt_hi_u32_b32 %0, -1, %0" : "=v"(l2));
    const int fr = l2 & 15, fq = l2 >> 4;
    const int row0 = un.pm * 256 + wr * 64 + fr, col0 = un.pn * 256 + wc * 32 + 4 * fq;
    const int goff = OFF_MG + (t == 4 ? 0 : D);
    const float L2E = -1.4426950408889634f;
#pragma unroll
    for (int ai = 0; ai < 2; ++ai)
#pragma unroll
      for (int m = 0; m < 4; ++m) {
        const int row = row0 + ai * 128 + m * 16;
#pragma unroll
        for (int bj = 0; bj < 2; ++bj)
#pragma unroll
          for (int n = 0; n < 2; ++n) {
            const int col = col0 + bj * 128 + n * 16;
            const act_t* gp = ub + (size_t)row * N_IN + goff + col;
            const u32x2 ga = *(const u32x2*)gp, gb = *(const u32x2*)(gp + D);
            const float ea0 = __builtin_amdgcn_exp2f(__uint_as_float(ga.x << 16) * L2E), ea1 = __builtin_amdgcn_exp2f(__uint_as_float(ga.x & 0xffff0000u) * L2E);
            const float ea2 = __builtin_amdgcn_exp2f(__uint_as_float(ga.y << 16) * L2E), ea3 = __builtin_amdgcn_exp2f(__uint_as_float(ga.y & 0xffff0000u) * L2E);
            const float eb0 = __builtin_amdgcn_exp2f(__uint_as_float(gb.x << 16) * L2E), eb1 = __builtin_amdgcn_exp2f(__uint_as_float(gb.x & 0xffff0000u) * L2E);
            const float eb2 = __builtin_amdgcn_exp2f(__uint_as_float(gb.y << 16) * L2E), eb3 = __builtin_amdgcn_exp2f(__uint_as_float(gb.y & 0xffff0000u) * L2E);
            f32x4& v = acc[ai][bj][m][n];
            v.x *= (1.0f + eb0) * __builtin_amdgcn_rcpf(1.0f + ea0); v.y *= (1.0f + eb1) * __builtin_amdgcn_rcpf(1.0f + ea1);
            v.z *= (1.0f + eb2) * __builtin_amdgcn_rcpf(1.0f + ea2); v.w *= (1.0f + eb3) * __builtin_amdgcn_rcpf(1.0f + ea3);
          }
        if (m == 3) EPI_FENCE();
      }
  }
  DEV void operator()(const f32x4 (&acc)[2][2][4][2], const pg8::Unit& un, int wr, int wc, int fr, int fq) const {
    {
      int l2;
      asm volatile("v_mbcnt_lo_u32_b32 %0, -1, 0\n\tv_mbcnt_hi_u32_b32 %0, -1, %0" : "=v"(l2));
      fr = l2 & 15; fq = l2 >> 4;
    }
    const int row0 = un.pm * 256 + wr * 64 + fr;
    act_t* const ob = (act_t*)q0; float* const of = (float*)q0;
    const float* const f0 = (const float*)q1; const act_t* const ub = (const act_t*)q1;
    const float* const f1 = (const float*)q2; const int* const il = (const int*)q3;
    if (mode == EM_INPROJ) {
      const int col0 = un.pn * 256 + wc * 32 + 4 * fq;
#pragma unroll
      for (int bj = 0; bj < 2; ++bj)
#pragma unroll
        for (int n = 0; n < 2; ++n) {
          const int col = col0 + bj * 128 + n * 16;
          if (col < N_IN) {
            const f32x4 bv = *(const f32x4*)(f0 + col);
#pragma unroll
            for (int ai = 0; ai < 2; ++ai)
#pragma unroll
              for (int m = 0; m < 4; ++m) {
                const int row = row0 + ai * 128 + m * 16;
                const f32x4 v = acc[ai][bj][m][n] + bv;
                u32x2 w; w.x = pk2(v.x, v.y); w.y = pk2(v.z, v.w);
                *(u32x2*)(ob + (size_t)row * N_IN + col) = w;
              }
          }
          EPI_FENCE();
        }
    } else if (mode == EM_BRCAT) {
      const int col0 = un.pn * 256 + wc * 32 + 4 * fq;
#pragma unroll
      for (int ai = 0; ai < 2; ++ai)
#pragma unroll
        for (int m = 0; m < 4; ++m) {
          const int row = row0 + ai * 128 + m * 16;
#pragma unroll
          for (int bj = 0; bj < 2; ++bj)
#pragma unroll
            for (int n = 0; n < 2; ++n) {
              const int col = col0 + bj * 128 + n * 16;
              const u32x2 gw = *(const u32x2*)(ub + (size_t)row * N_IN + OFF_MG + 2 * D + col);
              f32x4 v = acc[ai][bj][m][n];
              v.x *= sigmoidf_(__uint_as_float(gw.x << 16)); v.y *= sigmoidf_(__uint_as_float(gw.x & 0xffff0000u));
              v.z *= sigmoidf_(__uint_as_float(gw.y << 16)); v.w *= sigmoidf_(__uint_as_float(gw.y & 0xffff0000u));
              u32x2 w; w.x = pk2(v.x, v.y); w.y = pk2(v.z, v.w);
              *(u32x2*)(ob + (size_t)row * D + col) = w;
            }
          if (m == 3) EPI_FENCE();
        }
    } else if (mode == EM_RES) {
      const int col0 = un.pn * 256 + wc * 32 + 4 * fq;
#pragma unroll
      for (int ai = 0; ai < 2; ++ai)
#pragma unroll
        for (int m = 0; m < 4; ++m) {
          const int row = row0 + ai * 128 + m * 16;
#pragma unroll
          for (int bj = 0; bj < 2; ++bj)
#pragma unroll
            for (int n = 0; n < 2; ++n) {
              const int col = col0 + bj * 128 + n * 16;
              const f32x4 x = *(const f32x4*)(f0 + (size_t)row * D + col);
              *(f32x4*)(of + (size_t)row * D + col) = x * ALPHA + acc[ai][bj][m][n];
            }
          if (m == 3) EPI_FENCE();
        }
    } else if (mode == EM_BF16) {
      const int col0 = un.pn * 256 + wc * 32 + 4 * fq;
#pragma unroll
      for (int ai = 0; ai < 2; ++ai)
#pragma unroll
        for (int m = 0; m < 4; ++m) {
          const int row = row0 + ai * 128 + m * 16;
#pragma unroll
          for (int bj = 0; bj < 2; ++bj)
#pragma unroll
            for (int n = 0; n < 2; ++n) {
              const int col = col0 + bj * 128 + n * 16;
              const f32x4 v = acc[ai][bj][m][n];
              u32x2 w; w.x = pk2(v.x, v.y); w.y = pk2(v.z, v.w);
              *(u32x2*)(ob + (size_t)row * ldc + col) = w;
            }
          EPI_FENCE();
        }
    } else if (mode == EM_MOE1) {
      const int e = te[un.pm], j = un.pn & 7;
#pragma unroll
      for (int n = 0; n < 2; ++n) {
        const int cj = j * 128 + wc * 32 + n * 16 + 4 * fq;
        const f32x4 bg = *(const f32x4*)(f0 + (size_t)e * 2048 + cj), bu = *(const f32x4*)(f0 + (size_t)e * 2048 + 1024 + cj);
#pragma unroll
        for (int ai = 0; ai < 2; ++ai)
#pragma unroll
          for (int m = 0; m < 4; ++m) {
            const int row = row0 + ai * 128 + m * 16;
            const f32x4 g = acc[ai][0][m][n] + bg, u = acc[ai][1][m][n] + bu;
            float o[4];
#pragma unroll
            for (int i = 0; i < 4; ++i) {
              const float gt = fminf(g[i], 7.0f), up = fminf(fmaxf(u[i], -7.0f), 7.0f);
              o[i] = (up + 1.0f) * gt * sigmoidf_(1.702f * gt);
            }
            u32x2 w; w.x = pk2(o[0], o[1]); w.y = pk2(o[2], o[3]);
            *(u32x2*)(ob + (size_t)row * 1024 + cj) = w;
          }
        EPI_FENCE();
      }
    } else if (mode == EM_MOE2) {
      const int e = te[un.pm], j = un.pn & 3;
      const int col0 = j * 256 + wc * 32 + 4 * fq;
#pragma unroll
      for (int ai = 0; ai < 2; ++ai)
#pragma unroll
        for (int m = 0; m < 4; ++m) {
          const int row = row0 + ai * 128 + m * 16;
          const int aid = il[row];
          if (aid >= 0) {
            const float gt = f1[aid];
#pragma unroll
            for (int bj = 0; bj < 2; ++bj)
#pragma unroll
              for (int n = 0; n < 2; ++n) {
                const int col = col0 + bj * 128 + n * 16;
                const f32x4 v = (acc[ai][bj][m][n] + *(const f32x4*)(f0 + (size_t)e * 1024 + col)) * gt;
                u32x2 w; w.x = pk2(v.x, v.y); w.y = pk2(v.z, v.w);
                *(u32x2*)(ob + (size_t)aid * 1024 + col) = w;
              }
          }
          EPI_FENCE();
        }
    } else if (mode == EM_HID) {
      const int col0 = wc * 32 + 4 * fq;
#pragma unroll
      for (int ai = 0; ai < 2; ++ai)
#pragma unroll
        for (int m = 0; m < 4; ++m) {
          const int row = row0 + ai * 128 + m * 16;
          if (row < CMP_ROWS) {
#pragma unroll
            for (int n = 0; n < 2; ++n) {
              const f32x4 a = acc[ai][0][m][n];
              f32x4 v; v.x = gelu_tanh(a.x); v.y = gelu_tanh(a.y); v.z = gelu_tanh(a.z); v.w = gelu_tanh(a.w);
              *(f32x4*)(of + (size_t)row * CMP_HID + col0 + n * 16) = v;
            }
          }
          EPI_FENCE();
        }
    }
  }
};

DEV int moe_tables(const Params& p, int li, LAS int* tab, int t32) {
  __syncthreads();
  if (t32 == 0) {
    int t = 0;
    for (int e = 0; e < NE; ++e) {
      const int c = p.cnt[li * 32 + e];
      tab[e] = t * 256; tab[32 + e] = c;
      const int nt = (c + 255) >> 8;
#pragma clang loop vectorize(disable) unroll(disable)
      for (int k = 0; k < nt; ++k) tab[128 + t + k] = e;
      t += nt;
    }
    tab[64] = t;
  }
  __syncthreads();
  return tab[64];
}

DEV void moe_prep(const Params& p, int li, LAS int* tab, int wave, int lane, int t32) {
  const int ntiles = moe_tables(p, li, tab, t32);
  const int gw = blockIdx.x * 8 + wave, NGW = gridDim.x * 8;
  for (int tk0 = gw; tk0 < N_TOK; tk0 += 4 * NGW) {
    u32x4 v0[4], v1[4]; int rowi[4][4];
#pragma unroll
    for (int q = 0; q < 4; ++q) {
      const int tk = (tk0 + q * NGW < N_TOK) ? tk0 + q * NGW : tk0;
      const u32x4* src = (const u32x4*)(p.xb + (size_t)tk * 1024);
      v0[q] = src[lane]; v1[q] = src[lane + 64];
#pragma unroll
      for (int k = 0; k < 4; ++k) rowi[q][k] = tab[p.topi[tk * 4 + k]] + p.rank[tk * 4 + k];
    }
#pragma unroll
    for (int q = 0; q < 4; ++q) {
      const int tk = tk0 + q * NGW;
      if (tk < N_TOK) {
#pragma unroll
        for (int k = 0; k < 4; ++k) {
          if (lane == 0) p.rowlist[rowi[q][k]] = tk * 4 + k;
          u32x4* dst = (u32x4*)(p.xg + (size_t)rowi[q][k] * 1024);
          dst[lane] = v0[q]; dst[lane + 64] = v1[q];
        }
      }
    }
  }
  const long long tid = (long long)blockIdx.x * NTHREADS + t32, nthr = (long long)gridDim.x * NTHREADS;
  for (long long r = tid; r < (long long)ntiles * 256; r += nthr) {
    const int e = tab[128 + (int)(r >> 8)];
    if ((int)r - tab[e] >= tab[32 + e]) p.rowlist[r] = -1;
  }
}

typedef short v4i16_t __attribute__((ext_vector_type(4)));
DEV v4i16_t tr_read(const LAS unsigned char* p) { return __builtin_amdgcn_ds_read_tr16_b64_v4i16((LAS v4i16_t*)p); }

constexpr int AT_ROWB = 144;
constexpr int AT_TILEB = 64 * AT_ROWB;
constexpr int AT_HALF_KV = 4 * AT_TILEB;
constexpr int AT_SLAB_OFF = 2 * AT_HALF_KV;
constexpr int AT_SLAB_WAVE = 32 * 33 * 4;
constexpr int AT_SLAB_HALF = 4 * AT_SLAB_WAVE;
constexpr int AT_XCH_OFF = AT_SLAB_OFF + 2 * AT_SLAB_HALF;
static_assert(AT_XCH_OFF + 16 <= RING_BYTES, "attention LDS map");
constexpr float SC2 = 0.125f * 1.4426950408889634f;

struct AttnState { f32x4 O[2][4]; float m[2], l[2]; };

template <bool PROB, class Job>
DEV void attn_tile(const Job& job, const LAS unsigned char* Kb, const LAS unsigned char* Vb, const bf16x8 (&qf)[2][2], AttnState& st,
                   LAS float* slab, int cur, int wih, int lane) {
  const int i15 = lane & 15, g4 = lane >> 4;
  f32x4 S[2][4];
#pragma unroll
  for (int sub = 0; sub < 2; ++sub)
#pragma unroll
    for (int t = 0; t < 4; ++t) S[sub][t] = (f32x4){0.f, 0.f, 0.f, 0.f};
#pragma unroll
  for (int t = 0; t < 4; ++t)
#pragma unroll
    for (int kk = 0; kk < 2; ++kk) {
      const bf16x8 kf = *(const LAS bf16x8*)(Kb + (16 * t + i15) * AT_ROWB + (kk * 32 + 8 * g4) * 2);
#pragma unroll
      for (int sub = 0; sub < 2; ++sub) S[sub][t] = __builtin_amdgcn_mfma_f32_16x16x32_bf16(kf, qf[sub][kk], S[sub][t], 0, 0, 0);
    }
  bf16x8 pf[2][2];
  const bool efree = job.elemfree(cur, wih);
#pragma unroll
  for (int sub = 0; sub < 2; ++sub) {
    const int row = wih * 32 + sub * 16 + i15;
    if (!efree) {
      const int mbv = job.mb(row, cur, g4);
#pragma unroll
      for (int t = 0; t < 4; ++t)
#pragma unroll
        for (int j = 0; j < 4; ++j) S[sub][t][j] = job.ok(mbv, 16 * t + j) ? S[sub][t][j] : -INFINITY;
    }
    float mx = fmaxf(fmaxf(S[sub][0][0], S[sub][0][1]), fmaxf(S[sub][0][2], S[sub][0][3]));
#pragma unroll
    for (int t = 1; t < 4; ++t) mx = fmaxf(fmaxf(mx, fmaxf(S[sub][t][0], S[sub][t][1])), fmaxf(S[sub][t][2], S[sub][t][3]));
    if (!PROB) {
      mx = fmaxf(mx, shx(mx, lane, 16));
      mx = fmaxf(mx, shx(mx, lane, 32));
      const bool rok = job.rowok(sub, cur);
      const float mcand = rok ? mx * SC2 : -INFINITY;
      const float mnew = fmaxf(st.m[sub], mcand);
      const float msafe = (mnew == -INFINITY) ? 0.f : mnew;
      const float corr = __builtin_amdgcn_exp2f(st.m[sub] - msafe);
      st.m[sub] = mnew;
      const float msub = rok ? msafe : INFINITY;
      float psum = 0.f;
#pragma unroll
      for (int t = 0; t < 4; ++t)
#pragma unroll
        for (int j = 0; j < 4; ++j) { const float pp = __builtin_amdgcn_exp2f(__builtin_fmaf(S[sub][t][j], SC2, -msub)); S[sub][t][j] = pp; psum += pp; }
      st.l[sub] = st.l[sub] * corr + psum;
      if (__builtin_amdgcn_ballot_w64(corr != 1.0f) != 0ull) {
#pragma unroll
        for (int dt = 0; dt < 4; ++dt) st.O[sub][dt] *= corr;
      }
#pragma unroll
      for (int s2 = 0; s2 < 2; ++s2) {
        u32x4 w;
        w.x = pk2(S[sub][2 * s2][0], S[sub][2 * s2][1]); w.y = pk2(S[sub][2 * s2][2], S[sub][2 * s2][3]);
        w.z = pk2(S[sub][2 * s2 + 1][0], S[sub][2 * s2 + 1][1]); w.w = pk2(S[sub][2 * s2 + 1][2], S[sub][2 * s2 + 1][3]);
        pf[sub][s2] = __builtin_bit_cast(bf16x8, w);
      }
    } else {
      const float msafe = (st.m[sub] == -INFINITY) ? 0.f : st.m[sub];
      const int q = sub * 16 + i15;
#pragma unroll
      for (int t = 0; t < 4; ++t) {
        const float p0 = __builtin_amdgcn_exp2f(__builtin_fmaf(S[sub][t][0], SC2, -msafe)) * st.l[sub], p1 = __builtin_amdgcn_exp2f(__builtin_fmaf(S[sub][t][1], SC2, -msafe)) * st.l[sub];
        const float p2 = __builtin_amdgcn_exp2f(__builtin_fmaf(S[sub][t][2], SC2, -msafe)) * st.l[sub], p3 = __builtin_amdgcn_exp2f(__builtin_fmaf(S[sub][t][3], SC2, -msafe)) * st.l[sub];
        const int jb = 16 * cur + 4 * t + g4;
        slab[q * 33 + jb] += (p0 + p1) + (p2 + p3);
        S[sub][t][3] = p3;
      }
      asm volatile("s_waitcnt lgkmcnt(0)" ::: "memory");
#pragma unroll
      for (int t = 0; t < 4; ++t) {
        const int jb = 16 * cur + 4 * t + g4 + 1;
        if (jb < 32) slab[q * 33 + jb] += S[sub][t][3];
      }
      asm volatile("s_waitcnt lgkmcnt(0)" ::: "memory");
    }
  }
  if (!PROB) {
#pragma unroll
    for (int dt = 0; dt < 4; ++dt)
#pragma unroll
      for (int s2 = 0; s2 < 2; ++s2) {
        const LAS unsigned char* vp = Vb + (32 * s2 + 4 * g4 + (i15 >> 2)) * AT_ROWB + (16 * dt + 4 * (lane & 3)) * 2;
        const v4i16_t lo = tr_read(vp), hi = tr_read(vp + 16 * AT_ROWB);
        bf16x8 vf;
        vf[0] = lo[0]; vf[1] = lo[1]; vf[2] = lo[2]; vf[3] = lo[3]; vf[4] = hi[0]; vf[5] = hi[1]; vf[6] = hi[2]; vf[7] = hi[3];
#pragma unroll
        for (int sub = 0; sub < 2; ++sub) st.O[sub][dt] = __builtin_amdgcn_mfma_f32_16x16x32_bf16(vf, pf[sub][s2], st.O[sub][dt], 0, 0, 0);
      }
  }
}

DEV void half_barrier(LAS unsigned* cnt, int lane) {
  asm volatile("s_waitcnt lgkmcnt(0)" ::: "memory");
  unsigned old = 0;
  if (lane == 0) old = __hip_atomic_fetch_add(cnt, 1u, __ATOMIC_RELAXED, __HIP_MEMORY_SCOPE_WORKGROUP);
  old = (unsigned)__builtin_amdgcn_readfirstlane((int)old);
  const unsigned target = (old / 4u + 1u) * 4u;
  while ((int)(__hip_atomic_load(cnt, __ATOMIC_RELAXED, __HIP_MEMORY_SCOPE_WORKGROUP) - target) < 0) __builtin_amdgcn_s_sleep(1);
  asm volatile("" ::: "memory");
}

template <bool PROB, class Job>
DEV void attn_run(const Job& job, LAS unsigned char* lds, AttnState& st, int half, int hth, int wih, int lane) {
  LAS unsigned char* kvh = lds + half * AT_HALF_KV;
  LAS unsigned* hb = (LAS unsigned*)(lds + MISC_OFF + 8192 + 128) + half * 16;
  LAS float* slab = (LAS float*)(lds + AT_SLAB_OFF + half * AT_SLAB_HALF + wih * AT_SLAB_WAVE);
  const int i15 = lane & 15, g4 = lane >> 4;
  unsigned rem = job.tilemask();
  bf16x8 qf[2][2];
#pragma unroll
  for (int sub = 0; sub < 2; ++sub) {
    const act_t* qr = job.qrow(wih * 32 + sub * 16 + i15);
#pragma unroll
    for (int kk = 0; kk < 2; ++kk) qf[sub][kk] = *(const bf16x8*)(qr + kk * 32 + 8 * g4);
  }
  if (!PROB) {
#pragma unroll
    for (int sub = 0; sub < 2; ++sub) {
      st.m[sub] = -INFINITY; st.l[sub] = 0.f;
#pragma unroll
      for (int dt = 0; dt < 4; ++dt) st.O[sub][dt] = (f32x4){0.f, 0.f, 0.f, 0.f};
    }
  }
  const int srow = hth >> 2, sch = hth & 3;
  u32x4 ak0, ak1, av0, av1;
#define AT_LOAD(k0, k1, v0, v1, T) do { const act_t* kr_ = job.krow(T, srow) + sch * 16; k0 = *(const u32x4*)kr_; k1 = *(const u32x4*)(kr_ + 8); \
    if (!PROB) { const act_t* vr_ = job.vrow(T, srow) + sch * 16; v0 = *(const u32x4*)vr_; v1 = *(const u32x4*)(vr_ + 8); } } while (0)
#define AT_WRITE(k0, k1, v0, v1, BUF) do { LAS unsigned char* kd_ = kvh + (BUF) * AT_TILEB + srow * AT_ROWB + sch * 32; *(LAS u32x4*)kd_ = k0; *(LAS u32x4*)(kd_ + 16) = k1; \
    if (!PROB) { LAS unsigned char* vd_ = kvh + (2 + (BUF)) * AT_TILEB + srow * AT_ROWB + sch * 32; *(LAS u32x4*)vd_ = v0; *(LAS u32x4*)(vd_ + 16) = v1; } } while (0)
#define AT_NEXT(T) do { T = -1; if (rem) { T = __builtin_ctz(rem); rem &= rem - 1; } } while (0)
  int t0;
  AT_NEXT(t0);
  if (t0 >= 0) { AT_LOAD(ak0, ak1, av0, av1, t0); AT_WRITE(ak0, ak1, av0, av1, 0); }
  half_barrier(hb, lane);
  for (int it = 0; t0 >= 0; ++it) {
    int t1;
    AT_NEXT(t1);
    if (t1 >= 0) AT_LOAD(ak0, ak1, av0, av1, t1);
    attn_tile<PROB>(job, kvh + (it & 1) * AT_TILEB, kvh + (2 + (it & 1)) * AT_TILEB, qf, st, slab, t0, wih, lane);
    if (t1 >= 0) AT_WRITE(ak0, ak1, av0, av1, (it + 1) & 1);
    half_barrier(hb, lane);
    t0 = t1;
  }
#undef AT_LOAD
#undef AT_WRITE
#undef AT_NEXT
  if (!PROB) {
#pragma unroll
    for (int sub = 0; sub < 2; ++sub) {
      float l = st.l[sub];
      l += shx(l, lane, 16);
      l += shx(l, lane, 32);
      const float inv = 1.0f / fmaxf(l, 1e-30f);
      st.l[sub] = l;
#pragma unroll
      for (int dt = 0; dt < 4; ++dt) st.O[sub][dt] *= inv;
    }
  }
}

struct SelJob {
  const act_t* u; int b, g, t0; unsigned um; unsigned tm[2];
  DEV unsigned tilemask() const { return um; }
  DEV const act_t* qrow(int r) const { return u + ((size_t)b * SEQ + t0 + (r & 31)) * N_IN + OFF_CQ + (g * 4 + (r >> 5)) * 64; }
  DEV const act_t* krow(int kt, int j) const { return u + ((size_t)b * SEQ + kt * 64 + j) * N_IN + OFF_CKS + g * 64; }
  DEV const act_t* vrow(int kt, int j) const { return u + ((size_t)b * SEQ + kt * 64 + j) * N_IN + OFF_CVS + g * 64; }
  DEV int mb(int r, int kt, int g4) const { return t0 + (r & 31) - kt * 64 - 4 * g4; }
  DEV bool rowok(int sub, int kt) const { return (tm[sub] >> kt) & 1u; }
  DEV bool ok(int m, int C) const { return m >= C; }
  DEV bool elemfree(int kt, int wih) const { return kt < (t0 >> 6); }
};
struct WinJob {
  const act_t* u; int b, g, t0; unsigned um;
  DEV unsigned tilemask() const { return um; }
  DEV const act_t* qrow(int r) const { return u + ((size_t)b * SEQ + t0 + (r & 31)) * N_IN + OFF_CQ + (g * 4 + (r >> 5)) * 64; }
  DEV const act_t* krow(int kt, int j) const { return u + ((size_t)b * SEQ + kt * 64 + j) * N_IN + OFF_CKW + g * 64; }
  DEV const act_t* vrow(int kt, int j) const { return u + ((size_t)b * SEQ + kt * 64 + j) * N_IN + OFF_CVW + g * 64; }
  DEV int mb(int r, int kt, int g4) const { return t0 + (r & 31) - kt * 64 - 4 * g4; }
  DEV bool rowok(int sub, int kt) const { return true; }
  DEV bool ok(int m, int C) const { return m >= C && m < NSA_WIN + C; }
  DEV bool elemfree(int kt, int wih) const { return kt * 64 + 63 <= t0 && t0 + 31 - kt * 64 < NSA_WIN; }
};
struct CmpJob {
  const act_t* u; const act_t* kcb; const act_t* vcb; int b, g, t0; unsigned um;
  DEV unsigned tilemask() const { return um; }
  DEV const act_t* qrow(int r) const { return u + ((size_t)b * SEQ + t0 + (r & 31)) * N_IN + OFF_CQ + (g * 4 + (r >> 5)) * 64; }
  DEV const act_t* krow(int kt, int j) const { return kcb + (((size_t)b * 128 + kt * 64 + j) * NSA_G + g) * 64; }
  DEV const act_t* vrow(int kt, int j) const { return vcb + (((size_t)b * 128 + kt * 64 + j) * NSA_G + g) * 64; }
  DEV int mb(int r, int kt, int g4) const { return t0 + (r & 31) - 31 - 16 * (kt * 64 + 4 * g4); }
  DEV bool rowok(int sub, int kt) const { return true; }
  DEV bool ok(int m, int C) const { return m >= 16 * C; }
  DEV bool elemfree(int kt, int wih) const { return kt == 0 && 16 * 63 + 31 <= t0; }
};
struct DilJob {
  const act_t* u; int b, col, dil, res, l0; unsigned um;
  DEV unsigned tilemask() const { return um; }
  DEV const act_t* qrow(int r) const { return u + ((size_t)b * SEQ + (l0 + r) * dil + res) * N_IN + OFF_AQ + col; }
  DEV const act_t* krow(int kt, int j) const { return u + ((size_t)b * SEQ + (kt * 64 + j) * dil + res) * N_IN + OFF_AK + col; }
  DEV const act_t* vrow(int kt, int j) const { return u + ((size_t)b * SEQ + (kt * 64 + j) * dil + res) * N_IN + OFF_AV + col; }
  DEV int mb(int r, int kt, int g4) const { return l0 + r - kt * 64 - 4 * g4; }
  DEV bool rowok(int sub, int kt) const { return true; }
  DEV bool ok(int m, int C) const { return m >= C && m <= 128 + C; }
  DEV bool elemfree(int kt, int wih) const { return kt * 64 + 63 <= l0 + 32 * wih && l0 + 32 * wih + 31 - kt * 64 <= 128; }
};

DEV unsigned range_mask(int lo, int hi) {
  return (hi >= 31 ? 0xffffffffu : ((1u << (hi + 1)) - 1u)) & ~((1u << lo) - 1u);
}

DEV bool nsa_unit(int round, int bid, int G, int half, int& b, int& g, int& tb) {
  if ((G & 7) == 0) {
    const int nr = G >> 3, rank = bid >> 3;
    const int slot = rank * 2 + half, nslot = nr * 2;
    const int pos = (round & 1) ? (nslot - 1 - slot) : slot;
    const int lu = round * nslot + pos;
    if (lu >= 256) return false;
    b = bid & 7; g = lu & 3; tb = 63 - (lu >> 2);
    return true;
  }
  const int pos = (round & 1) ? (G - 1 - bid) : bid;
  const int pair = round * G + pos;
  if (pair >= 1024) return false;
  const int un = pair * 2 + half;
  tb = 63 - un / 32; b = (un % 32) / 4; g = un % 4;
  return true;
}
DEV int nsa_rounds(int G) { return (G & 7) == 0 ? (256 + (G >> 3) * 2 - 1) / ((G >> 3) * 2) : (1024 + G - 1) / G; }

DEV void nsa_cmp_phase(const Params& p, LAS unsigned char* lds, int t32, int bid, int G) {
  const int lane = t32 & 63, wave = t32 >> 6, half = wave >> 2, wih = wave & 3, hth = t32 & 255;
  const int i15 = lane & 15, g4 = lane >> 4;
  LAS float* slabh = (LAS float*)(lds + AT_SLAB_OFF + half * AT_SLAB_HALF);
  for (int round = 0; round < nsa_rounds(G); ++round) {
    int b = 0, g = 0, tb = 0;
    const bool act = nsa_unit(round, bid, G, half, b, g, tb);
    const int t0 = tb * 32;
    const int nvmax = t0 + 31 >= 31 ? (t0 + 31 - 31) / 16 + 1 : 0;
    CmpJob job{p.u, p.kcb, p.kcb + (size_t)BATCH * 128 * NSA_G * 64, b, g, t0, 0u};
    job.um = !act ? 0u : (nvmax > 64 ? 3u : (nvmax > 0 ? 1u : 0u));
    for (int i = lane; i < 32 * 33; i += 64) slabh[wih * (32 * 33) + i] = 0.f;
    LAS unsigned char* kvh = lds + half * AT_HALF_KV;
    LAS unsigned* hb = (LAS unsigned*)(lds + MISC_OFF + 8192 + 128) + half * 16;
    LAS float* slab = slabh + wih * (32 * 33);
    {
      const int srow = hth >> 2, sch = hth & 3;
#pragma unroll
      for (int tl = 0; tl < 2; ++tl)
        if ((job.um >> tl) & 1u) {
          const act_t* kr = job.krow(tl, srow) + sch * 16; const act_t* vr = job.vrow(tl, srow) + sch * 16;
          const u32x4 k0 = *(const u32x4*)kr, k1 = *(const u32x4*)(kr + 8), v0 = *(const u32x4*)vr, v1 = *(const u32x4*)(vr + 8);
          LAS unsigned char* kd = kvh + tl * AT_TILEB + srow * AT_ROWB + sch * 32;
          *(LAS u32x4*)kd = k0; *(LAS u32x4*)(kd + 16) = k1;
          LAS unsigned char* vd = kvh + (2 + tl) * AT_TILEB + srow * AT_ROWB + sch * 32;
          *(LAS u32x4*)vd = v0; *(LAS u32x4*)(vd + 16) = v1;
        }
    }
    bf16x8 qf[2][2];
#pragma unroll
    for (int sub = 0; sub < 2; ++sub) {
      const act_t* qr = job.qrow(wih * 32 + sub * 16 + i15);
#pragma unroll
      for (int kk = 0; kk < 2; ++kk) qf[sub][kk] = *(const bf16x8*)(qr + kk * 32 + 8 * g4);
    }
    AttnState st;
#pragma unroll
    for (int sub = 0; sub < 2; ++sub) {
      st.m[sub] = -INFINITY; st.l[sub] = 0.f;
#pragma unroll
      for (int dt = 0; dt < 4; ++dt) st.O[sub][dt] = (f32x4){0.f, 0.f, 0.f, 0.f};
    }
    half_barrier(hb, lane);
    if (job.um & 1u) attn_tile<false>(job, kvh, kvh + 2 * AT_TILEB, qf, st, slab, 0, wih, lane);
    if (job.um & 2u) attn_tile<false>(job, kvh + AT_TILEB, kvh + 3 * AT_TILEB, qf, st, slab, 1, wih, lane);
#pragma unroll
    for (int sub = 0; sub < 2; ++sub) {
      float l = st.l[sub];
      l += shx(l, lane, 16);
      l += shx(l, lane, 32);
      const float inv = 1.0f / fmaxf(l, 1e-30f);
      st.l[sub] = inv;
#pragma unroll
      for (int dt = 0; dt < 4; ++dt) st.O[sub][dt] *= inv;
    }
    if (act) {
#pragma unroll
      for (int sub = 0; sub < 2; ++sub) {
        const int hh = g * 4 + wih;
        const size_t n = (size_t)b * SEQ + t0 + sub * 16 + i15;
        const float g0 = sigmoidf_(ldf(p.u[n * N_IN + OFF_CG + hh * 3 + 0]));
#pragma unroll
        for (int dt = 0; dt < 4; ++dt) { const f32x4 y = st.O[sub][dt] * g0; u32x2 w; w.x = pk2(y.x, y.y); w.y = pk2(y.z, y.w); *(u32x2*)((act_t*)p.ocmp + n * 1024 + hh * 64 + 16 * dt + 4 * g4) = w; }
      }
    }
    if (job.um & 1u) attn_tile<true>(job, kvh, kvh + 2 * AT_TILEB, qf, st, slab, 0, wih, lane);
    if (job.um & 2u) attn_tile<true>(job, kvh + AT_TILEB, kvh + 3 * AT_TILEB, qf, st, slab, 1, wih, lane);
    half_barrier(hb, lane);
    {
      const int q = hth >> 3, j4 = (hth & 7) * 4;
      float v[4];
#pragma unroll
      for (int i = 0; i < 4; ++i) {
        float s = 0.f;
#pragma unroll
        for (int w = 0; w < 4; ++w) s += slabh[w * (32 * 33) + q * 33 + j4 + i];
        const int j = j4 + i, qb = (t0 + q) >> 6;
        if (j == 0 || j == qb || j == qb - 1) s = INFINITY;
        else if (j > qb) s = -INFINITY;
        v[i] = s;
      }
      __syncthreads();
#pragma unroll
      for (int i = 0; i < 4; ++i) slabh[q * 33 + j4 + i] = v[i];
      __syncthreads();
      unsigned bits = 0u;
#pragma unroll
      for (int i = 0; i < 4; ++i) {
        int rank = 0;
#pragma unroll 1
        for (int jj = 0; jj < 32; ++jj) { const float w = slabh[q * 33 + jj]; rank += (w > v[i] || (w == v[i] && jj < j4 + i)) ? 1 : 0; }
        if (rank < N_SELECT) bits |= 1u << (j4 + i);
      }
      bits |= (unsigned)shxi((int)bits, lane, 1);
      bits |= (unsigned)shxi((int)bits, lane, 2);
      bits |= (unsigned)shxi((int)bits, lane, 4);
      if (act && (hth & 7) == 0) p.selm[((size_t)b * NSA_G + g) * SEQ + t0 + q] = bits;
      __syncthreads();
    }
  }
}

DEV void nsa_main_phase(const Params& p, LAS unsigned char* lds, int t32, int bid, int G) {
  const int lane = t32 & 63, wave = t32 >> 6, half = wave >> 2, wih = wave & 3, hth = t32 & 255;
  const int i15 = lane & 15, g4 = lane >> 4;
#define NSTAMP(i) do { if (GSEG >= 10 && blockIdx.x == 0 && t32 == 0) { const unsigned now_ = (unsigned)__builtin_amdgcn_s_memrealtime(); if ((i) > 0 && (i) - 1 + 10 == GSEG) p.barw[3600] += now_ - ns_prev; ns_prev = now_; } } while (0)
  unsigned ns_prev = 0u;
  for (int round2 = 0; round2 < nsa_rounds(G) * (NSA_PROBE == 5 ? 2 : 1); ++round2) {
    const int round = (NSA_PROBE == 5) ? (round2 >> 1) : round2;
    NSTAMP(0);
    int b = 0, g = 0, tb = 0;
    const bool act = nsa_unit(round, bid, G, half, b, g, tb);
    const int t0 = tb * 32;
    SelJob sj{p.u, b, g, t0, 0u, {0u, 0u}};
    if (act) {
      const unsigned* sm = p.selm + ((size_t)b * NSA_G + g) * SEQ + t0;
      sj.tm[0] = sm[i15]; sj.tm[1] = sm[16 + i15];
      unsigned um = sj.tm[0] | sj.tm[1];
      int l2 = lane;
      asm volatile("" : "+v"(l2));
      um |= (unsigned)shxi((int)um, l2, 1); um |= (unsigned)shxi((int)um, l2, 2);
      um |= (unsigned)shxi((int)um, l2, 4); um |= (unsigned)shxi((int)um, l2, 8);
      sj.um = um & range_mask(0, t0 >> 6);
    }
    u32x2 base[2][4];
    const int hh = g * 4 + wih;
    const size_t nrow0 = (size_t)b * SEQ + t0 + i15;
    const act_t gq10 = p.u[nrow0 * N_IN + OFF_CG + hh * 3 + 1], gq11 = p.u[(nrow0 + 16) * N_IN + OFF_CG + hh * 3 + 1];
    const act_t gq20 = p.u[nrow0 * N_IN + OFF_CG + hh * 3 + 2], gq21 = p.u[(nrow0 + 16) * N_IN + OFF_CG + hh * 3 + 2];
    {
      AttnState ss;
      NSTAMP(1);
      attn_run<false>(sj, lds, ss, half, hth, wih, lane);
      NSTAMP(2);
#if NSA_PROBE == 1
      attn_run<false>(sj, lds, ss, half, hth, wih, lane);
#endif
#pragma unroll
      for (int sub = 0; sub < 2; ++sub) {
        f32x4 oc[4];
#pragma unroll
        for (int dt = 0; dt < 4; ++dt) {
          const u32x2 cw = *(const u32x2*)((const act_t*)p.ocmp + (nrow0 + 16 * sub) * 1024 + hh * 64 + 16 * dt + 4 * g4);
          oc[dt] = (f32x4){__uint_as_float(cw.x << 16), __uint_as_float(cw.x & 0xffff0000u), __uint_as_float(cw.y << 16), __uint_as_float(cw.y & 0xffff0000u)};
        }
        const float g1 = sigmoidf_(ldf(sub ? gq11 : gq10));
#pragma unroll
        for (int dt = 0; dt < 4; ++dt) {
          const f32x4 y = ss.O[sub][dt] * g1 + oc[dt];
          base[sub][dt].x = pk2(y.x, y.y); base[sub][dt].y = pk2(y.z, y.w);
        }
      }
    }
    WinJob wj{p.u, b, g, t0, 0u};
    if (act) { const int lo = t0 - (NSA_WIN - 1) < 0 ? 0 : (t0 - (NSA_WIN - 1)) >> 6; wj.um = range_mask(lo, (t0 + 31) >> 6); }
    AttnState ws;
    NSTAMP(3);
    attn_run<false>(wj, lds, ws, half, hth, wih, lane);
    NSTAMP(4);
#if NSA_PROBE == 2
    attn_run<false>(wj, lds, ws, half, hth, wih, lane);
#endif
    if (act) {
#pragma unroll
      for (int sub = 0; sub < 2; ++sub) {
        const size_t n = nrow0 + 16 * sub;
        const float g2 = sigmoidf_(ldf(sub ? gq21 : gq20));
#pragma unroll
        for (int dt = 0; dt < 4; ++dt) {
          const u32x2 bw = base[sub][dt];
          f32x4 y = ws.O[sub][dt] * g2;
          y.x += __uint_as_float(bw.x << 16); y.y += __uint_as_float(bw.x & 0xffff0000u);
          y.z += __uint_as_float(bw.y << 16); y.w += __uint_as_float(bw.y & 0xffff0000u);
          u32x2 w; w.x = pk2(y.x, y.y); w.y = pk2(y.z, y.w);
          *(u32x2*)(p.yc + n * YLD + hh * 64 + 16 * dt + 4 * g4) = w;
        }
      }
    }
  }
}

DEV void dil_phase(const Params& p, LAS unsigned char* lds, int t32, int bid, int G) {
  const int lane = t32 & 63, wave = t32 >> 6, half = wave >> 2, wih = wave & 3, hth = t32 & 255;
  const int i15 = lane & 15, g4 = lane >> 4;
  const bool xm = (G & 7) == 0;
  const int npair = xm ? 96 : 768, pstep = xm ? (G >> 3) : G;
  for (int pair = xm ? (bid >> 3) : bid; pair < npair; pair += pstep) {
    const int un = pair * 2 + half;
    int gi, b, r2;
    if (xm) { b = bid & 7; gi = un / 64; r2 = un % 64; }
    else { gi = un / 512; const int r = un % 512; b = r / 64; r2 = r % 64; }
    const int dil = gi == 0 ? 1 : (gi == 1 ? 4 : 16);
    const int nlb = 16 / dil;
    const int h = r2 / 16, r3 = r2 % 16;
    const int res = r3 / nlb, lb = r3 % nlb;
    const int l0 = lb * 128;
    DilJob job{p.u, b, gi * 256 + h * 64, dil, res, l0, 0u};
    job.um = range_mask(l0 >= 128 ? (l0 - 128) >> 6 : 0, (l0 + 127) >> 6);
    AttnState st;
    attn_run<false>(job, lds, st, half, hth, wih, lane);
#pragma unroll
    for (int sub = 0; sub < 2; ++sub) {
      const int l = l0 + wih * 32 + sub * 16 + i15;
      const size_t n = (size_t)b * SEQ + l * dil + res;
#pragma unroll
      for (int dt = 0; dt < 4; ++dt) {
        const f32x4 y = st.O[sub][dt];
        u32x2 w; w.x = pk2(y.x, y.y); w.y = pk2(y.z, y.w);
        *(u32x2*)(p.dilo + ((size_t)gi * N_TOK + n) * 256 + h * 64 + 16 * dt + 4 * g4) = w;
      }
      if (g4 == 0) p.dill[((size_t)gi * N_TOK + n) * 4 + h] = st.m[sub] + __builtin_amdgcn_logf(st.l[sub]);
    }
  }
}

DEV void dil_combine(const Params& p, long long tid, long long nthr) {
  for (long long idx = tid; idx < (long long)N_TOK * 32; idx += nthr) {
    const size_t n = idx >> 5; const int c8 = (int)(idx & 31) * 8, h = c8 >> 6;
    const float l0 = p.dill[((size_t)0 * N_TOK + n) * 4 + h], l1 = p.dill[((size_t)1 * N_TOK + n) * 4 + h], l2 = p.dill[((size_t)2 * N_TOK + n) * 4 + h];
    const float mx = fmaxf(l0, fmaxf(l1, l2));
    float w0 = __builtin_amdgcn_exp2f(l0 - mx), w1 = __builtin_amdgcn_exp2f(l1 - mx), w2 = __builtin_amdgcn_exp2f(l2 - mx);
    const float inv = 1.0f / (w0 + w1 + w2);
    w0 *= inv; w1 *= inv; w2 *= inv;
    const u32x4 a = *(const u32x4*)(p.dilo + ((size_t)0 * N_TOK + n) * 256 + c8);
    const u32x4 bq = *(const u32x4*)(p.dilo + ((size_t)1 * N_TOK + n) * 256 + c8);
    const u32x4 c = *(const u32x4*)(p.dilo + ((size_t)2 * N_TOK + n) * 256 + c8);
    u32x4 o;
#pragma unroll
    for (int i = 0; i < 4; ++i) {
      const float lo = w0 * __uint_as_float(a[i] << 16) + w1 * __uint_as_float(bq[i] << 16) + w2 * __uint_as_float(c[i] << 16);
      const float hi = w0 * __uint_as_float(a[i] & 0xffff0000u) + w1 * __uint_as_float(bq[i] & 0xffff0000u) + w2 * __uint_as_float(c[i] & 0xffff0000u);
      o[i] = pk2(lo, hi);
    }
    *(u32x4*)(p.ya + n * YLD + c8) = o;
  }
}

DEV void cmpa_build(const Params& p, int li, long long tid, long long nthr) {
  for (long long idx = tid; idx < 2LL * CMP_ROWS * 256; idx += nthr) {
    const int which = (int)(idx / ((long long)CMP_ROWS * 256));
    const long long rem = idx % ((long long)CMP_ROWS * 256);
    const int row = (int)(rem >> 8), c8 = (int)(rem & 255) * 8, l = c8 >> 6, d = c8 & 63;
    const int g = row % NSA_G, c = (row / NSA_G) % N_CMP, b = row / (NSA_G * N_CMP);
    const float* pe = (which ? p.cmp_pe_v : p.cmp_pe_k) + (size_t)li * 32 * HD + l * HD + d;
    const u32x4 uv = *(const u32x4*)(p.u + ((size_t)b * SEQ + c * 16 + l) * N_IN + (which ? OFF_CVC : OFF_CKC) + g * HD + d);
    u32x4 o;
#pragma unroll
    for (int i = 0; i < 4; ++i) o[i] = pk2(__uint_as_float(uv[i] << 16) + pe[2 * i], __uint_as_float(uv[i] & 0xffff0000u) + pe[2 * i + 1]);
    *(u32x4*)(p.cmpA + ((size_t)which * CMP_ROWS_PAD + row) * 2048 + c8) = o;
  }
}

constexpr int XA_ROWB = 528;
constexpr int XA_TILEB = 32 * XA_ROWB;
static_assert(4 * XA_TILEB <= RING_BYTES, "xattn LDS map");
DEV void xattn_phase(const Params& p, LAS unsigned char* lds, int t32, int bid, int G) {
  const int lane = t32 & 63, wave = t32 >> 6, i15 = lane & 15, g4 = lane >> 4;
  const float sc2 = 0.0625f * 1.4426950408889634f;
  const bool xm = (G & 7) == 0;
  const int nun = xm ? XH * (SEQ / 128) : BATCH * XH * (SEQ / 128), ustep = xm ? (G >> 3) : G;
  for (int un = xm ? (bid >> 3) : bid; un < nun; un += ustep) {
    const int b = xm ? (bid & 7) : un / (XH * (SEQ / 128)), r = un % (XH * (SEQ / 128)), h = r / (SEQ / 128), qb = r % (SEQ / 128);
    const size_t nq = (size_t)b * SEQ + qb * 128 + wave * 16 + i15;
    bf16x8 qf[8];
#pragma unroll
    for (int kk = 0; kk < 8; ++kk) qf[kk] = *(const bf16x8*)(p.xq + nq * 1024 + h * 256 + kk * 32 + 8 * g4);
    f32x4 O[16];
#pragma unroll
    for (int dt = 0; dt < 16; ++dt) O[dt] = (f32x4){0.f, 0.f, 0.f, 0.f};
    float m = -INFINITY, l = 0.f;
    const int srow = t32 >> 4, sch = t32 & 15;
    const act_t* kbase = p.memk + ((size_t)b * MEM_LEN + srow) * 1024 + h * 256 + sch * 16;
    const act_t* vbase = p.memv + ((size_t)b * MEM_LEN + srow) * 1024 + h * 256 + sch * 16;
    u32x4 sk0 = *(const u32x4*)kbase, sk1 = *(const u32x4*)(kbase + 8), sv0 = *(const u32x4*)vbase, sv1 = *(const u32x4*)(vbase + 8);
    {
      LAS unsigned char* kd = lds + srow * XA_ROWB + sch * 32;
      *(LAS u32x4*)kd = sk0; *(LAS u32x4*)(kd + 16) = sk1;
      LAS unsigned char* vd = lds + 2 * XA_TILEB + srow * XA_ROWB + sch * 32;
      *(LAS u32x4*)vd = sv0; *(LAS u32x4*)(vd + 16) = sv1;
    }
    __syncthreads();
    for (int it = 0; it < MEM_LEN / 32; ++it) {
      if (it + 1 < MEM_LEN / 32) {
        const act_t* kr = kbase + (size_t)(it + 1) * 32 * 1024, *vr = vbase + (size_t)(it + 1) * 32 * 1024;
        sk0 = *(const u32x4*)kr; sk1 = *(const u32x4*)(kr + 8); sv0 = *(const u32x4*)vr; sv1 = *(const u32x4*)(vr + 8);
      }
      const LAS unsigned char* Kb = lds + (it & 1) * XA_TILEB;
      const LAS unsigned char* Vb = lds + (2 + (it & 1)) * XA_TILEB;
      f32x4 S[2];
      S[0] = (f32x4){0.f, 0.f, 0.f, 0.f}; S[1] = (f32x4){0.f, 0.f, 0.f, 0.f};
#pragma unroll
      for (int t = 0; t < 2; ++t)
#pragma unroll
        for (int kk = 0; kk < 8; ++kk) {
          const bf16x8 kf = *(const LAS bf16x8*)(Kb + (16 * t + i15) * XA_ROWB + (kk * 32 + 8 * g4) * 2);
          S[t] = __builtin_amdgcn_mfma_f32_16x16x32_bf16(kf, qf[kk], S[t], 0, 0, 0);
        }
      float mx = -INFINITY;
#pragma unroll
      for (int t = 0; t < 2; ++t)
#pragma unroll
        for (int j = 0; j < 4; ++j) { S[t][j] *= sc2; mx = fmaxf(mx, S[t][j]); }
      mx = fmaxf(mx, shx(mx, lane, 16));
      mx = fmaxf(mx, shx(mx, lane, 32));
      const float mnew = fmaxf(m, mx);
      const float corr = __builtin_amdgcn_exp2f(m - mnew);
      m = mnew;
      float psum = 0.f;
#pragma unroll
      for (int t = 0; t < 2; ++t)
#pragma unroll
        for (int j = 0; j < 4; ++j) { const float pp = __builtin_amdgcn_exp2f(S[t][j] - mnew); S[t][j] = pp; psum += pp; }
      l = l * corr + psum;
      u32x4 w;
      w.x = pk2(S[0][0], S[0][1]); w.y = pk2(S[0][2], S[0][3]); w.z = pk2(S[1][0], S[1][1]); w.w = pk2(S[1][2], S[1][3]);
      const bf16x8 pf = __builtin_bit_cast(bf16x8, w);
#pragma unroll
      for (int dt = 0; dt < 16; ++dt) {
        const LAS unsigned char* vp = Vb + (4 * g4 + (i15 >> 2)) * XA_ROWB + (16 * dt + 4 * (lane & 3)) * 2;
        const v4i16_t lo = tr_read(vp), hi = tr_read(vp + 16 * XA_ROWB);
        bf16x8 vf;
        vf[0] = lo[0]; vf[1] = lo[1]; vf[2] = lo[2]; vf[3] = lo[3]; vf[4] = hi[0]; vf[5] = hi[1]; vf[6] = hi[2]; vf[7] = hi[3];
        O[dt] = __builtin_amdgcn_mfma_f32_16x16x32_bf16(vf, pf, O[dt] * corr, 0, 0, 0);
      }
      if (it + 1 < MEM_LEN / 32) {
        LAS unsigned char* kd = lds + ((it + 1) & 1) * XA_TILEB + srow * XA_ROWB + sch * 32;
        *(LAS u32x4*)kd = sk0; *(LAS u32x4*)(kd + 16) = sk1;
        LAS unsigned char* vd = lds + (2 + ((it + 1) & 1)) * XA_TILEB + srow * XA_ROWB + sch * 32;
        *(LAS u32x4*)vd = sv0; *(LAS u32x4*)(vd + 16) = sv1;
      }
      __syncthreads();
    }
    l += shx(l, lane, 16);
    l += shx(l, lane, 32);
    const float inv = 1.0f / l;
#pragma unroll
    for (int dt = 0; dt < 16; ++dt) {
      const f32x4 y = O[dt] * inv;
      u32x2 w; w.x = pk2(y.x, y.y); w.y = pk2(y.z, y.w);
      *(u32x2*)(p.xo + nq * 1024 + h * 256 + 16 * dt + 4 * g4) = w;
    }
  }
}

constexpr int RT_LCNT = MISC_OFF + 4096, RT_BASE = RT_LCNT + 128, RT_SEL = RT_BASE + 128, RT_RANK = RT_SEL + 1024;
DEV void route_phase(const Params& p, int li, LAS unsigned char* lds, int t32, int bid, int G) {
  const int lane = t32 & 63, wave = t32 >> 6, i15 = lane & 15, g4 = lane >> 4;
  const float* W = p.w_router + (size_t)li * D * NE;
  LAS unsigned short* Wh = (LAS unsigned short*)lds;
  LAS unsigned short* Wl = (LAS unsigned short*)(lds + 65536);
  LAS int* lcnt = (LAS int*)(lds + RT_LCNT);
  LAS int* lbase = (LAS int*)(lds + RT_BASE);
  LAS int* lsel = (LAS int*)(lds + RT_SEL);
  LAS int* lrank = (LAS int*)(lds + RT_RANK);
  const int e = lane & 31;
  const float bias = p.b_router[li * NE + e];
  for (int blk = bid; blk < N_TOK / 64; blk += G) {
    __syncthreads();
    for (int i = 0; i < 16; ++i) {
      const int idx = t32 + 512 * i, k = idx >> 3, e4 = (idx & 7) * 4;
      const f32x4 w = ((const f32x4*)W)[idx];
#pragma unroll
      for (int q = 0; q < 4; ++q) {
        const unsigned short hi = f2bfh(w[q]);
        const unsigned short lo = f2bfh(w[q] - __uint_as_float(((unsigned)hi) << 16));
        Wh[(e4 + q) * 1024 + k] = hi; Wl[(e4 + q) * 1024 + k] = lo;
      }
    }
    if (t32 < 32) lcnt[t32] = 0;
    __syncthreads();
    f32x4 acc[4][2];
#pragma unroll
    for (int mt = 0; mt < 4; ++mt) { acc[mt][0] = (f32x4){0.f, 0.f, 0.f, 0.f}; acc[mt][1] = (f32x4){0.f, 0.f, 0.f, 0.f}; }
    const int n0 = blk * 64;
#pragma unroll 1
    for (int kk = 0; kk < 4; ++kk) {
      const int kb = wave * 128 + kk * 32 + 8 * g4;
      bf16x8 bh[2], bl[2];
#pragma unroll
      for (int nt = 0; nt < 2; ++nt) {
        bh[nt] = *(const LAS bf16x8*)(Wh + (16 * nt + i15) * 1024 + kb);
        bl[nt] = *(const LAS bf16x8*)(Wl + (16 * nt + i15) * 1024 + kb);
      }
#pragma unroll
      for (int mt = 0; mt < 4; ++mt) {
        const float* xr = p.xf + (size_t)(n0 + 16 * mt + i15) * D + kb;
        const f32x4 x0 = *(const f32x4*)xr, x1 = *(const f32x4*)(xr + 4);
        u32x4 hw, lw;
        {
          const unsigned h0 = pk2(x0.x, x0.y), h1 = pk2(x0.z, x0.w), h2 = pk2(x1.x, x1.y), h3 = pk2(x1.z, x1.w);
          hw = (u32x4){h0, h1, h2, h3};
          lw.x = pk2(x0.x - __uint_as_float(h0 << 16), x0.y - __uint_as_float(h0 & 0xffff0000u));
          lw.y = pk2(x0.z - __uint_as_float(h1 << 16), x0.w - __uint_as_float(h1 & 0xffff0000u));
          lw.z = pk2(x1.x - __uint_as_float(h2 << 16), x1.y - __uint_as_float(h2 & 0xffff0000u));
          lw.w = pk2(x1.z - __uint_as_float(h3 << 16), x1.w - __uint_as_float(h3 & 0xffff0000u));
        }
        const bf16x8 ah = __builtin_bit_cast(bf16x8, hw), al = __builtin_bit_cast(bf16x8, lw);
#pragma unroll
        for (int nt = 0; nt < 2; ++nt) {
          acc[mt][nt] = __builtin_amdgcn_mfma_f32_16x16x32_bf16(ah, bh[nt], acc[mt][nt], 0, 0, 0);
          acc[mt][nt] = __builtin_amdgcn_mfma_f32_16x16x32_bf16(ah, bl[nt], acc[mt][nt], 0, 0, 0);
          acc[mt][nt] = __builtin_amdgcn_mfma_f32_16x16x32_bf16(al, bh[nt], acc[mt][nt], 0, 0, 0);
        }
      }
    }
    __syncthreads();
    LAS float* part = (LAS float*)lds;
    LAS float* fin = (LAS float*)(lds + 8 * 64 * 33 * 4);
#pragma unroll
    for (int mt = 0; mt < 4; ++mt)
#pragma unroll
      for (int nt = 0; nt < 2; ++nt)
#pragma unroll
        for (int j = 0; j < 4; ++j) part[(wave * 64 + 16 * mt + 4 * g4 + j) * 33 + 16 * nt + i15] = acc[mt][nt][j];
    __syncthreads();
    {
      const int tok = t32 >> 3, e4 = (t32 & 7) * 4;
#pragma unroll
      for (int q = 0; q < 4; ++q) {
        float v = 0.f;
#pragma unroll
        for (int w = 0; w < 8; ++w) v += part[(w * 64 + tok) * 33 + e4 + q];
        fin[tok * 33 + e4 + q] = v;
      }
    }
    __syncthreads();
    float cur[8]; int sel[8][4]; float sv[8][4];
#pragma unroll
    for (int t = 0; t < 8; ++t) cur[t] = fin[(wave * 8 + t) * 33 + e] + bias;
#pragma unroll
    for (int k = 0; k < 4; ++k) {
      float bv[8]; int bi[8];
#pragma unroll
      for (int t = 0; t < 8; ++t) { bv[t] = cur[t]; bi[t] = e; }
#pragma unroll
      for (int o = 1; o < 32; o <<= 1) {
#pragma unroll
        for (int t = 0; t < 8; ++t) {
          const float ov = shx(bv[t], lane, o); const int oi = shxi(bi[t], lane, o);
          if (ov > bv[t] || (ov == bv[t] && oi < bi[t])) { bv[t] = ov; bi[t] = oi; }
        }
      }
#pragma unroll
      for (int t = 0; t < 8; ++t) { sel[t][k] = bi[t]; sv[t][k] = bv[t]; if (e == bi[t]) cur[t] = -INFINITY; }
    }
    int abase = __builtin_amdgcn_readfirstlane(wave * 32);
    asm volatile("" : "+s"(abase));
    if (lane == 0) {
#pragma unroll
      for (int t = 0; t < 8; ++t) {
        const int n = n0 + wave * 8 + t;
        const float e1 = expf(sv[t][1] - sv[t][0]), e2 = expf(sv[t][2] - sv[t][0]), e3 = expf(sv[t][3] - sv[t][0]);
        const float inv = 1.0f / (1.0f + e1 + e2 + e3);
        p.topg[n * 4 + 0] = inv; p.topg[n * 4 + 1] = e1 * inv; p.topg[n * 4 + 2] = e2 * inv; p.topg[n * 4 + 3] = e3 * inv;
#pragma unroll
        for (int k = 0; k < 4; ++k) {
          const int a = abase + t * 4 + k;
          lsel[a] = sel[t][k];
          lrank[a] = __hip_atomic_fetch_add(lcnt + sel[t][k], 1, __ATOMIC_RELAXED, __HIP_MEMORY_SCOPE_WORKGROUP);
        }
      }
    }
    __syncthreads();
    if (t32 < 32) lbase[t32] = atomicAdd(&p.cnt[li * 32 + t32], lcnt[t32]);
    __syncthreads();
    if (t32 < 256) {
      const int a = blk * 256 + t32, ee = lsel[t32];
      p.topi[a] = ee;
      p.rank[a] = lbase[ee] + lrank[t32];
    }
  }
  __syncthreads();
}

DEV void kcv_phase(const Params& p, int li, LAS unsigned char* lds, int t32, int bid, int G) {
  const int lane = t32 & 63, wave = t32 >> 6;
  LAS float* w2l = (LAS float*)lds;
  LAS float* rowb = (LAS float*)(lds + 65536) + wave * 512;
  __syncthreads();
#pragma unroll
  for (int i = 0; i < 4; ++i) {
    ((LAS f32x4*)w2l)[t32 + 512 * i] = ((const f32x4*)(p.cmp_w2_k + (size_t)li * CMP_HID * HD))[t32 + 512 * i];
    ((LAS f32x4*)w2l)[2048 + t32 + 512 * i] = ((const f32x4*)(p.cmp_w2_v + (size_t)li * CMP_HID * HD))[t32 + 512 * i];
  }
  __syncthreads();
  const int NGW = G * 8;
  for (int r0 = bid * 8 + wave; r0 < 2 * CMP_ROWS; r0 += 4 * NGW) {
    int rows[4];
#pragma unroll
    for (int i = 0; i < 4; ++i) { rows[i] = r0 + i * NGW; if (rows[i] >= 2 * CMP_ROWS) rows[i] = r0; }
#pragma unroll
    for (int i = 0; i < 4; ++i) {
      const float* hr = p.hid + (size_t)rows[i] * CMP_HID;
      rowb[i * 128 + lane] = hr[lane]; rowb[i * 128 + 64 + lane] = hr[64 + lane];
    }
    asm volatile("s_waitcnt lgkmcnt(0)" ::: "memory");
    float acc[4] = {0.f, 0.f, 0.f, 0.f};
    const LAS float* wq[4];
#pragma unroll
    for (int i = 0; i < 4; ++i) wq[i] = w2l + (rows[i] >= CMP_ROWS ? 128 * 64 : 0) + lane;
#pragma unroll 8
    for (int j = 0; j < CMP_HID; ++j) {
#pragma unroll
      for (int i = 0; i < 4; ++i) acc[i] += rowb[i * 128 + j] * wq[i][j * 64];
    }
#pragma unroll
    for (int i = 0; i < 4; ++i) {
      const int row = r0 + i * NGW;
      if (row < 2 * CMP_ROWS) {
        const int which = row >= CMP_ROWS ? 1 : 0, rr = row - which * CMP_ROWS;
        const int g_ = rr % NSA_G, c_ = (rr / NSA_G) % N_CMP, b_ = rr / (NSA_G * N_CMP);
        p.kcb[((((size_t)which * BATCH + b_) * 128 + c_) * NSA_G + g_) * 64 + lane] = f2bfh(acc[i]);
      }
    }
    asm volatile("s_waitcnt lgkmcnt(0)" ::: "memory");
  }
  __syncthreads();
}

constexpr int GA_QS = 272, GA_VS = 528, GA_PS = 144;
constexpr int GA_QT = 0, GA_KT = GA_QT + 64 * GA_QS, GA_KH = GA_KT + 64 * GA_QS, GA_VT = GA_KH + 64 * GA_QS, GA_PT = GA_VT + 64 * GA_VS,
              GA_LR = GA_PT + 64 * GA_PS, GA_GT = GA_LR + 64 * 16 * 4, GA_DC = GA_GT + 4 * 128 * 4, GA_END = GA_DC + 512;
static_assert(GA_END <= RING_BYTES, "GLA phase A LDS map");
constexpr int GC_SP = 0, GC_QT = GC_SP + 128 * GA_VS, GC_RED = GC_QT + 64 * GA_QS, GC_END = GC_RED + 8 * 16 * 4 * 2;
static_assert(GC_END <= RING_BYTES, "GLA phase C LDS map");

#define GSTAMP(i) do { if (GSEG >= 0 && blockIdx.x == 0 && t32 == 0) { const unsigned now_ = (unsigned)__builtin_amdgcn_s_memrealtime(); if ((i) > 0 && (i) - 1 == GSEG) p.barw[3600] += now_ - gs_prev; gs_prev = now_; } } while (0)
DEV void gla_a_unit(const Params& p, int li, LAS unsigned char* lds, int t32, int unit) {
  unsigned gs_prev = 0u;
  GSTAMP(0);
  const int lane = t32 & 63, wave = t32 >> 6, i15 = lane & 15, g4 = lane >> 4;
  const int bh = unit >> 5, ci = unit & 31, b = bh >> 2, h = bh & 3;
  const int c = t32 & 127, jq = t32 >> 7;
  LAS float* LR = (LAS float*)(lds + GA_LR);
  LAS float* GT = (LAS float*)(lds + GA_GT);
  LAS float* DC = (LAS float*)(lds + GA_DC);
  const float qscale = 0.08838834764831845f;
  const size_t n0 = (size_t)b * SEQ + ci * 64;
  {
    const int e = t32 * 2, j = e >> 4, r = e & 15;
    const unsigned w = *(const unsigned*)(p.u + (n0 + j) * N_IN + OFF_LR + r);
    LR[e] = __uint_as_float(w << 16); LR[e + 1] = __uint_as_float(w & 0xffff0000u);
  }
  float wa[GLA_RANK];
#pragma unroll
  for (int r = 0; r < GLA_RANK; ++r) wa[r] = p.w_alpha2[((size_t)li * GLA_RANK + r) * B_K + h * 128 + c];
  const float ba = p.b_alpha[li * B_K + h * 128 + c];
#pragma unroll
  for (int x = 0; x < 2; ++x) {
    const int idx = t32 + 512 * x, row = idx >> 4, ch = idx & 15;
    const act_t* ur = p.u + (n0 + row) * N_IN + h * 128 + ch * 8;
    *(LAS u32x4*)(lds + GA_QT + row * GA_QS + ch * 16) = *(const u32x4*)(ur + OFF_BQ);
    *(LAS u32x4*)(lds + GA_KT + row * GA_QS + ch * 16) = *(const u32x4*)(ur + OFF_BK);
  }
#pragma unroll
  for (int x = 0; x < 4; ++x) {
    const int idx = t32 + 512 * x, row = idx >> 5, ch = idx & 31;
    const u32x4 vv = *(const u32x4*)(p.u + (n0 + row) * N_IN + OFF_BV + h * 256 + ch * 8);
    *(LAS u32x4*)(lds + GA_VT + row * GA_VS + ch * 16) = vv;
  }
  __syncthreads();
  GSTAMP(1);
  float bl[16];
  float run = 0.f;
#pragma unroll
  for (int jj = 0; jj < 16; ++jj) {
    const LAS f32x4* lr4 = (const LAS f32x4*)(LR + (jq * 16 + jj) * 16);
    float z = ba;
#pragma unroll
    for (int r4 = 0; r4 < 4; ++r4) { const f32x4 x = lr4[r4]; z += x.x * wa[4 * r4] + x.y * wa[4 * r4 + 1] + x.z * wa[4 * r4 + 2] + x.w * wa[4 * r4 + 3]; }
    const float ez = __builtin_amdgcn_exp2f(-fabsf(z) * 1.4426950408889634f);
    const float ls = (fminf(z, 0.f) - __builtin_amdgcn_logf(1.0f + ez) * 0.6931471805599453f) * (1.0f / 16.0f);
    run += ls; bl[jj] = run;
  }
  GT[jq * 128 + c] = run;
  __syncthreads();
  GSTAMP(2);
  {
    const float g0 = GT[c], g1 = GT[128 + c], g2 = GT[256 + c], g3 = GT[384 + c];
    const float off = (jq > 0 ? g0 : 0.f) + (jq > 1 ? g1 : 0.f) + (jq > 2 ? g2 : 0.f);
    const float tot = (g0 + g1) + (g2 + g3);
    const float dtot = __builtin_amdgcn_exp2f(tot * 1.4426950408889634f);
    if (jq == 0) { DC[c] = dtot; p.gD[(size_t)unit * 128 + c] = dtot; }
#pragma unroll
    for (int jj = 0; jj < 16; ++jj) {
      const float e1 = __builtin_amdgcn_exp2f((off + bl[jj]) * 1.4426950408889634f), ie = __builtin_amdgcn_rcpf(e1);
      const int ro = (jq * 16 + jj) * GA_QS + c * 2;
      const float qf = __uint_as_float(((unsigned)*(const LAS unsigned short*)(lds + GA_QT + ro)) << 16);
      const float kf = __uint_as_float(((unsigned)*(const LAS unsigned short*)(lds + GA_KT + ro)) << 16);
      const unsigned short qt = f2bfh(qf * e1 * qscale);
      *(LAS unsigned short*)(lds + GA_QT + ro) = qt;
      p.gQ[((size_t)unit * 64 + jq * 16 + jj) * 128 + c] = qt;
      *(LAS unsigned short*)(lds + GA_KT + ro) = f2bfh(kf * ie);
      *(LAS unsigned short*)(lds + GA_KH + ro) = f2bfh(kf * ie * dtot);
    }
  }
  __syncthreads();
  GSTAMP(3);
#pragma unroll
  for (int q = 0; q < 2; ++q) {
    const int id = wave * 2 + q, jt = id >> 2, it = id & 3;
    f32x4 a = (f32x4){0.f, 0.f, 0.f, 0.f};
#pragma unroll
    for (int kk = 0; kk < 4; ++kk) {
      const bf16x8 kf = *(const LAS bf16x8*)(lds + GA_KT + (16 * jt + i15) * GA_QS + (32 * kk + 8 * g4) * 2);
      const bf16x8 qf = *(const LAS bf16x8*)(lds + GA_QT + (16 * it + i15) * GA_QS + (32 * kk + 8 * g4) * 2);
      a = __builtin_amdgcn_mfma_f32_16x16x32_bf16(kf, qf, a, 0, 0, 0);
    }
    const int i = 16 * it + i15, j0 = 16 * jt + 4 * g4;
    u32x2 w;
    w.x = pk2(j0 <= i ? a.x : 0.f, j0 + 1 <= i ? a.y : 0.f);
    w.y = pk2(j0 + 2 <= i ? a.z : 0.f, j0 + 3 <= i ? a.w : 0.f);
    *(LAS u32x2*)(lds + GA_PT + i * GA_PS + j0 * 2) = w;
  }
  __syncthreads();
  GSTAMP(4);
  {
    const int it = wave & 3, vt0 = (wave >> 2) * 8;
    bf16x8 pf[2];
#pragma unroll
    for (int s = 0; s < 2; ++s) pf[s] = *(const LAS bf16x8*)(lds + GA_PT + (16 * it + i15) * GA_PS + (32 * s + 8 * g4) * 2);
#pragma unroll
    for (int x = 0; x < 8; ++x) {
      const int vt = vt0 + x;
      f32x4 a = (f32x4){0.f, 0.f, 0.f, 0.f};
#pragma unroll
      for (int s = 0; s < 2; ++s) {
        const LAS unsigned char* vp = lds + GA_VT + (32 * s + 8 * g4 + (i15 >> 2)) * GA_VS + (16 * vt + 4 * (lane & 3)) * 2;
        const v4i16_t lo = tr_read(vp), hi = tr_read(vp + 4 * GA_VS);
        bf16x8 vf;
        vf[0] = lo[0]; vf[1] = lo[1]; vf[2] = lo[2]; vf[3] = lo[3]; vf[4] = hi[0]; vf[5] = hi[1]; vf[6] = hi[2]; vf[7] = hi[3];
        a = __builtin_amdgcn_mfma_f32_16x16x32_bf16(vf, pf[s], a, 0, 0, 0);
      }
      *(f32x4*)(p.opart + (n0 + 16 * it + i15) * 1024 + h * 256 + 16 * vt + 4 * g4) = a;
    }
  }
  {
    bf16x8 vf[2][2];
#pragma unroll
    for (int x = 0; x < 2; ++x)
#pragma unroll
      for (int s = 0; s < 2; ++s) {
        const LAS unsigned char* vp = lds + GA_VT + (32 * s + 8 * g4 + (i15 >> 2)) * GA_VS + (16 * (2 * wave + x) + 4 * (lane & 3)) * 2;
        const v4i16_t lo = tr_read(vp), hi = tr_read(vp + 4 * GA_VS);
        vf[x][s][0] = lo[0]; vf[x][s][1] = lo[1]; vf[x][s][2] = lo[2]; vf[x][s][3] = lo[3];
        vf[x][s][4] = hi[0]; vf[x][s][5] = hi[1]; vf[x][s][6] = hi[2]; vf[x][s][7] = hi[3];
      }
#pragma unroll
    for (int ct = 0; ct < 8; ++ct) {
      f32x4 a0 = (f32x4){0.f, 0.f, 0.f, 0.f}, a1 = (f32x4){0.f, 0.f, 0.f, 0.f};
#pragma unroll
      for (int s = 0; s < 2; ++s) {
        const LAS unsigned char* kp = lds + GA_KH + (32 * s + 8 * g4 + (i15 >> 2)) * GA_QS + (16 * ct + 4 * (lane & 3)) * 2;
        const v4i16_t lo = tr_read(kp), hi = tr_read(kp + 4 * GA_QS);
        bf16x8 kf;
        kf[0] = lo[0]; kf[1] = lo[1]; kf[2] = lo[2]; kf[3] = lo[3]; kf[4] = hi[0]; kf[5] = hi[1]; kf[6] = hi[2]; kf[7] = hi[3];
        a0 = __builtin_amdgcn_mfma_f32_16x16x32_bf16(vf[0][s], kf, a0, 0, 0, 0);
        a1 = __builtin_amdgcn_mfma_f32_16x16x32_bf16(vf[1][s], kf, a1, 0, 0, 0);
      }
      act_t* up = p.gU + ((size_t)unit * 128 + 16 * ct + i15) * 256 + 32 * wave + 4 * g4;
      u32x2 w0; w0.x = pk2(a0.x, a0.y); w0.y = pk2(a0.z, a0.w);
      u32x2 w1; w1.x = pk2(a1.x, a1.y); w1.y = pk2(a1.z, a1.w);
      *(u32x2*)up = w0; *(u32x2*)(up + 16) = w1;
    }
  }
  __syncthreads();
  GSTAMP(5);
}

DEV void gla_scan(const Params& p, long long tid, long long nthr) {
  for (long long idx = tid; idx < 32LL * 128 * 32; idx += nthr) {
    const int v8 = (int)(idx & 31) * 8, c = (int)((idx >> 5) & 127), bh = (int)(idx >> 12);
    float s[8];
#pragma unroll
    for (int i = 0; i < 8; ++i) s[i] = 0.f;
#pragma unroll 8
    for (int ci = 0; ci < 32; ++ci) {
      const size_t unit = (size_t)bh * 32 + ci;
      const u32x4 uw = *(const u32x4*)(p.gU + (unit * 128 + c) * 256 + v8);
      const float d = p.gD[unit * 128 + c];
      u32x4 o;
#pragma unroll
      for (int i = 0; i < 4; ++i) o[i] = pk2(s[2 * i], s[2 * i + 1]);
      *(u32x4*)(p.gS + (unit * 128 + c) * 256 + v8) = o;
#pragma unroll
      for (int i = 0; i < 4; ++i) {
        s[2 * i] = s[2 * i] * d + __uint_as_float(uw[i] << 16);
        s[2 * i + 1] = s[2 * i + 1] * d + __uint_as_float(uw[i] & 0xffff0000u);
      }
    }
  }
}

DEV void gla_c_unit(const Params& p, int li, LAS unsigned char* lds, int t32, int unit) {
  const int lane = t32 & 63, wave = t32 >> 6, i15 = lane & 15, g4 = lane >> 4;
  const int bh = unit >> 5, ci = unit & 31, b = bh >> 2, h = bh & 3;
  const size_t n0 = (size_t)b * SEQ + ci * 64;
#pragma unroll
  for (int x = 0; x < 8; ++x) {
    const int idx = t32 + 512 * x, row = idx >> 5, ch = idx & 31;
    *(LAS u32x4*)(lds + GC_SP + row * GA_VS + ch * 16) = *(const u32x4*)(p.gS + ((size_t)unit * 128 + row) * 256 + ch * 8);
  }
#pragma unroll
  for (int x = 0; x < 2; ++x) {
    const int idx = t32 + 512 * x, row = idx >> 4, ch = idx & 15;
    *(LAS u32x4*)(lds + GC_QT + row * GA_QS + ch * 16) = *(const u32x4*)(p.gQ + ((size_t)unit * 64 + row) * 128 + ch * 8);
  }
  __syncthreads();
  const int it = wave & 3, vt0 = (wave >> 2) * 8;
  bf16x8 qf[4];
#pragma unroll
  for (int kk = 0; kk < 4; ++kk) qf[kk] = *(const LAS bf16x8*)(lds + GC_QT + (16 * it + i15) * GA_QS + (32 * kk + 8 * g4) * 2);
  const size_t n = n0 + 16 * it + i15;
  f32x4 o[8];
  float ss = 0.f;
#pragma unroll
  for (int x = 0; x < 8; ++x) {
    const int vt = vt0 + x;
    f32x4 a = *(const f32x4*)(p.opart + n * 1024 + h * 256 + 16 * vt + 4 * g4);
#pragma unroll
    for (int kk = 0; kk < 4; ++kk) {
      const LAS unsigned char* sp = lds + GC_SP + (32 * kk + 8 * g4 + (i15 >> 2)) * GA_VS + (16 * vt + 4 * (lane & 3)) * 2;
      const v4i16_t lo = tr_read(sp), hi = tr_read(sp + 4 * GA_VS);
      bf16x8 sf;
      sf[0] = lo[0]; sf[1] = lo[1]; sf[2] = lo[2]; sf[3] = lo[3]; sf[4] = hi[0]; sf[5] = hi[1]; sf[6] = hi[2]; sf[7] = hi[3];
      a = __builtin_amdgcn_mfma_f32_16x16x32_bf16(sf, qf[kk], a, 0, 0, 0);
    }
    o[x] = a;
    ss += (a.x * a.x + a.y * a.y) + (a.z * a.z + a.w * a.w);
  }
  ss += shx(ss, lane, 16);
  ss += shx(ss, lane, 32);
  LAS float* RED = (LAS float*)(lds + GC_RED);
  if (g4 == 0) RED[wave * 16 + i15] = ss;
  __syncthreads();
  ss += RED[(wave ^ 4) * 16 + i15];
  const float rs = 1.0f / sqrtf(ss * (1.0f / 256.0f) + LN_EPS);
#pragma unroll
  for (int x = 0; x < 8; ++x) {
    const int v = 16 * (vt0 + x) + 4 * g4;
    const f32x4 gn = *(const f32x4*)(p.gla_norm_g + li * DV + v);
    const u32x2 rw = *(const u32x2*)(p.u + n * N_IN + OFF_BR + h * 256 + v);
    const float r0 = __uint_as_float(rw.x << 16), r1 = __uint_as_float(rw.x & 0xffff0000u), r2 = __uint_as_float(rw.y << 16), r3 = __uint_as_float(rw.y & 0xffff0000u);
    u32x2 w;
    w.x = pk2(o[x].x * rs * gn.x * (r0 * sigmoidf_(r0)), o[x].y * rs * gn.y * (r1 * sigmoidf_(r1)));
    w.y = pk2(o[x].z * rs * gn.z * (r2 * sigmoidf_(r2)), o[x].w * rs * gn.w * (r3 * sigmoidf_(r3)));
    *(u32x2*)(p.yb + n * YLD + h * 256 + v) = w;
  }
  __syncthreads();
}

#define XB_TMO      128
#define XB_XCNT(j)  (256  + 64 * (j))
#define XB_XSUB(j)  (1280 + 64 * (j))
#define XB_XGEN(j)  (2304 + 64 * (j))
#define XB_TOP      3328
#define XB_TOPGEN   3392
#define XCD_BAR_WORDS 3456
#define XB_SPIN_CAP (1u << 18)

__device__ __forceinline__ unsigned xb_ld(unsigned* p)              { return __hip_atomic_load(p, __ATOMIC_RELAXED, __HIP_MEMORY_SCOPE_AGENT); }
__device__ __forceinline__ unsigned xb_add(unsigned* p, unsigned v) { return __hip_atomic_fetch_add(p, v, __ATOMIC_RELAXED, __HIP_MEMORY_SCOPE_AGENT); }
__device__ __forceinline__ unsigned xb_xcc_id() { return (unsigned)__builtin_amdgcn_s_getreg((3 << 11) | 20) & 0xFu; }
#define XB_SPIN(cond, bar) do { unsigned _sp = 0; while (cond) { __builtin_amdgcn_s_sleep(1); \
    if ((++_sp & 255u) == 0u) { if (xb_ld(&(bar)[XB_TMO])) break; if (_sp > XB_SPIN_CAP) { atomicAdd(&(bar)[XB_TMO], 1u); break; } } } } while (0)

struct XcdBarrier {
    unsigned* bar; unsigned x;
    volatile LAS unsigned* st;
};

__device__ __forceinline__ XcdBarrier xcd_barrier_post(unsigned* bar, volatile LAS unsigned* st) {
    XcdBarrier b; b.bar = bar; b.x = xb_xcc_id(); b.st = st;
    if (threadIdx.x == 0) st[2] = xb_add(&bar[XB_XCNT(b.x)], 1u);
    return b;
}
__device__ __forceinline__ void xcd_barrier_complete(unsigned* bar, unsigned x, unsigned& nloc, unsigned& nx) {
    const unsigned G = gridDim.x * gridDim.y * gridDim.z;
    unsigned sum, cnt, mine, sp = 0u;
    for (;;) {
        sum = 0u; cnt = 0u; mine = 0u;
#pragma unroll
        for (unsigned j = 0; j < 16; ++j) { const unsigned c = xb_ld(&bar[XB_XCNT(j)]); sum += c; cnt += (c > 0u) ? 1u : 0u; mine = (j == x) ? c : mine; }
        if (sum == G) break;
        __builtin_amdgcn_s_sleep(1);
        if ((++sp & 255u) == 0u) { if (xb_ld(&bar[XB_TMO])) break; if (sp > XB_SPIN_CAP) { atomicAdd(&bar[XB_TMO], 1u); break; } }
    }
    nloc = mine > 0u ? mine : 1u; nx = cnt > 0u ? cnt : 1u;
}

__device__ __forceinline__ void xcd_barrier(const XcdBarrier& b, const int t32) {
    asm volatile("s_waitcnt vmcnt(0)" ::: "memory");
    __syncthreads();
    if (t32 == 0) {
        unsigned* bar = b.bar;
        __builtin_amdgcn_s_waitcnt(0);
        unsigned nloc = b.st[0], nx = b.st[1];
        if (nloc == 0u) { xcd_barrier_complete(bar, b.x, nloc, nx); b.st[0] = nloc; b.st[1] = nx; }
        const unsigned old = xb_add(&bar[XB_XSUB(b.x)], 1u);
        const unsigned gen = old / nloc;
        if (old + 1u == (gen + 1u) * nloc) {
            __builtin_amdgcn_fence(__ATOMIC_RELEASE, "agent");
            asm volatile("s_waitcnt vmcnt(0)" ::: "memory");
            const unsigned og = xb_add(&bar[XB_TOP], 1u);
            const unsigned tg = og / nx;
            if (og + 1u == (tg + 1u) * nx) xb_add(&bar[XB_TOPGEN], 1u);
            else XB_SPIN(xb_ld(&bar[XB_TOPGEN]) == tg, bar);
            __builtin_amdgcn_fence(__ATOMIC_ACQUIRE, "agent");
            xb_add(&bar[XB_XGEN(b.x)], 1u);
            asm volatile("s_waitcnt vmcnt(0)" ::: "memory");
        } else {
            XB_SPIN(xb_ld(&bar[XB_XGEN(b.x)]) == gen, bar);
            __builtin_amdgcn_fence(__ATOMIC_ACQUIRE, "agent");
            asm volatile("s_waitcnt vmcnt(0)" ::: "memory");
        }
    }
    __syncthreads();
}

constexpr int STEPS_PER_LAYER = 21;
#ifndef PROBE_LO
#define PROBE_LO -1
#define PROBE_HI -1
#endif
#ifndef PROBE_PRO
#define PROBE_PRO 0
#endif
#ifndef TSTEP_LO
#define TSTEP_LO -2
#define TSTEP_HI -2
#endif
#ifndef TSUB
#define TSUB -9
#endif
#ifndef TSTEP_Q
#define TSTEP_Q 40u
#endif
#ifndef NSA_PROBE
#define NSA_PROBE 0
#endif
#ifndef MULTI_LAUNCH
#define MULTI_LAUNCH 0
#endif
DEV int fresh_t32(int wave) {
  int t;
  asm volatile("v_mbcnt_lo_u32_b32 %0, -1, 0\n\tv_mbcnt_hi_u32_b32 %0, -1, %0" : "=v"(t));
  return t + wave * 64;
}
struct KArgs { void* in[35]; void* out; void* ws; };
template <bool WITH_NAIVE, bool COOP>
__global__ void __launch_bounds__(NTHREADS) k_mega(KArgs ka, int step_lo, int step_hi) {
  unsigned* const barw0 = ((unsigned*)ka.ws);
  extern __shared__ __attribute__((aligned(16))) unsigned char lds_raw[];
  LAS unsigned char* lds = (LAS unsigned char*)lds_raw;
  LAS int* tab = (LAS int*)(lds + MISC_OFF);
  const int wave = __builtin_amdgcn_readfirstlane(threadIdx.x >> 6);
  const int G = gridDim.x;
  int bid = blockIdx.x;

  LAS unsigned* miscw = (LAS unsigned*)(lds + MISC_OFF + 8192);
  if (threadIdx.x < 128) miscw[threadIdx.x] = 0u;
  __syncthreads();
  XcdBarrier xbar; xbar.bar = barw0; xbar.x = 0; xbar.st = nullptr;
  if (COOP) xbar = xcd_barrier_post(barw0, miscw + 8);
  unsigned* const stamp = barw0 + 3584;
  if (step_lo < 0) {
    Params p;
    fill_params(p, ka.in, ka.out, ka.ws);
    if (TSTEP_LO == -1 && blockIdx.x == 0 && threadIdx.x == 0) { stamp[0] = (unsigned)__builtin_amdgcn_s_memrealtime(); stamp[2] = 0u; stamp[3] = 0u; }
    prologue(p, lds, wave, threadIdx.x & 63);
    if (COOP) {
      if (step_hi == -12345) cg::this_grid().sync();
      xcd_barrier(xbar, (int)threadIdx.x);
    }
#if PROBE_PRO
    prologue(p, lds, wave, threadIdx.x & 63);
    if (COOP) cg::this_grid().sync();
#endif
    step_lo = 0;
    if (TSTEP_LO == -1 && blockIdx.x == 0 && threadIdx.x == 0) stamp[1] = (unsigned)__builtin_amdgcn_s_memrealtime();
    if (COOP) {
      bool even = (G % 8) == 0;
#pragma unroll
      for (int j = 0; j < 8; ++j) even = even && (xb_ld(&barw0[XB_XCNT(j)]) == (unsigned)(G / 8));
      __syncthreads();
      if (even) bid = __builtin_amdgcn_readfirstlane((int)(xbar.x + 8u * miscw[10]));
    }
  }
  int rep_done = 0;
  for (int step = step_lo; step < step_hi;) {
    int li = step / STEPS_PER_LAYER;
    const int k = step % STEPS_PER_LAYER;
    int nb32 = gridDim.x;
    char* wsb = (char*)ka.ws;
    asm volatile("" : "+s"(wsb));
    Params p;
    fill_params(p, ka.in, ka.out, wsb);
    asm volatile("" : "+s"(li));
    asm volatile("" : "+s"(nb32));
#define T32() fresh_t32(wave)
#define TID() ((int)(blockIdx.x * NTHREADS) + T32())
    const int nthr = nb32 * NTHREADS;
    const int gw = blockIdx.x * 8 + wave, NGW = nb32 * 8;
    if (TSTEP_LO >= 0 && k == TSTEP_LO && blockIdx.x == 0 && wave == 0) stamp[2 * li] = (unsigned)__builtin_amdgcn_s_memrealtime();
    const bool is_gemm = (k == 0) || (k >= 2 && k <= 5) || (k == 9) || (k == 10) || (k == 12) || (k == 14) || (k == 18) || (k == 19);
    const bool sync_after = !(k == 2 || k == 3 || k == 4);
    if (is_gemm) {
      pg8::Gemm g{nullptr, nullptr, 0, 0, 0};
      USched S; S.init_static(256, 256, G, bid);
      EpiU E{0, 0, nullptr, nullptr, nullptr, nullptr, nullptr};
      const size_t WSQ = (size_t)1024 * 1024;
      switch (k) {
        case 0:
          g = pg8::Gemm{p.xb, p.wt_in + (size_t)li * N_IN_PAD * 1024, N_TOK, N_IN_PAD, 1024};
          S.init_static(N_TOK, N_IN_PAD, G, bid);
          E.mode = EM_INPROJ; E.q0 = p.u; E.q1 = p.b_in + (size_t)li * N_IN; break;
        case 2:
          g = pg8::Gemm{p.cmpA, p.wt_c1 + (size_t)(li * 2 + 0) * 256 * 2048, CMP_ROWS_PAD, 256, 2048};
          S.init_static(CMP_ROWS_PAD, 256, G, bid);
          E.mode = EM_HID; E.q0 = p.hid; break;
        case 3:
          g = pg8::Gemm{p.cmpA + (size_t)CMP_ROWS_PAD * 2048, p.wt_c1 + (size_t)(li * 2 + 1) * 256 * 2048, CMP_ROWS_PAD, 256, 2048};
          S.init_static(CMP_ROWS_PAD, 256, G, (bid + G - 16) % G);
          E.mode = EM_HID; E.q0 = p.hid + (size_t)CMP_ROWS * CMP_HID; break;
        case 4:
          g = pg8::Gemm{p.membf, p.wt_xk + li * WSQ, BATCH * MEM_LEN, 1024, 1024};
          S.init_static(BATCH * MEM_LEN, 1024, G, (bid + G - 32) % G);
          E.mode = EM_BF16; E.q0 = p.memk; E.ldc = 1024; break;
        case 5:
          g = pg8::Gemm{p.membf, p.wt_xv + li * WSQ, BATCH * MEM_LEN, 1024, 1024};
          S.init_static(BATCH * MEM_LEN, 1024, G, (bid + G - 64) % G);
          E.mode = EM_BF16; E.q0 = p.memv; E.ldc = 1024; break;
        case 9:
          g = pg8::Gemm{p.ya, p.wt_bra + (size_t)li * 1024 * YLD, N_TOK, 1024, YLD};
          S.init_static(N_TOK, 1024, G, bid);
          E.mode = EM_BRCAT; E.q1 = p.u; E.q0 = p.merged; break;
        case 10:
          g = pg8::Gemm{p.merged, p.wt_omix + li * WSQ, N_TOK, 1024, 1024};
          S.init_static(N_TOK, 1024, G, bid);
          E.mode = EM_RES; E.q1 = p.xf; E.q0 = p.tmp; break;
        case 12:
          g = pg8::Gemm{p.xb, p.wt_xq + li * WSQ, N_TOK, 1024, 1024};
          S.init_static(N_TOK, 1024, G, bid);
          E.mode = EM_BF16; E.q0 = p.xq; E.ldc = 1024; break;
        case 14:
          g = pg8::Gemm{p.xo, p.wt_xo + li * WSQ, N_TOK, 1024, 1024};
          S.init_static(N_TOK, 1024, G, bid);
          E.mode = EM_RES; E.q1 = p.xf; E.q0 = p.tmp; break;
        case 18: {
          const int ntiles = moe_tables(p, li, tab, T32());
          g = pg8::Gemm{p.xg, p.wt_gu + (size_t)li * 32 * 2048 * 1024, MOE_ROWS, 32 * 2048, 1024};
          S.init_moe(G, bid, 8, ntiles * 8, tab + 128);
          E.mode = EM_MOE1; E.q0 = p.actg; E.q1 = p.b_gu + (size_t)li * 32 * 2048; E.te = tab + 128; break; }
        default: {
          const int ntiles = moe_tables(p, li, tab, T32());
          g = pg8::Gemm{p.actg, p.wt_dn + (size_t)li * 32 * 1024 * 1024, MOE_ROWS, 32 * 1024, 1024};
          S.init_moe(G, bid, 4, ntiles * 4, tab + 128);
          E.mode = EM_MOE2; E.q0 = p.yass; E.q1 = p.b_down + (size_t)li * 32 * 1024; E.q2 = p.topg; E.q3 = p.rowlist; E.te = tab + 128; break; }
      }
      pg8::gemm_phase<EpiU, USched, true, true>(lds, g, S, E, T32());
    } else {
      switch (k) {
        case 1: cmpa_build(p, li, TID(), nthr); break;
        case 6:
#define SUBSTAMP(i) do { if (TSUB == (i) && blockIdx.x == 0 && wave == 0) stamp[2 * li] = (unsigned)__builtin_amdgcn_s_memrealtime(); if (TSUB + 1 == (i) && blockIdx.x == 0 && wave == 0) stamp[2 * li + 1] = (unsigned)__builtin_amdgcn_s_memrealtime(); } while (0)
          SUBSTAMP(1);
          { const int t = T32(); for (int un = bid; un < 1024; un += G) gla_a_unit(p, li, lds, t, un); }
          SUBSTAMP(2);
          dil_phase(p, lds, T32(), bid, G);
          SUBSTAMP(3);
          kcv_phase(p, li, lds, T32(), bid, G);
          SUBSTAMP(4);
          break;
        case 7: SUBSTAMP(8); gla_scan(p, TID(), nthr); SUBSTAMP(9); nsa_cmp_phase(p, lds, T32(), bid, G); SUBSTAMP(10); dil_combine(p, TID(), nthr); SUBSTAMP(11); break;
        case 8: {
          SUBSTAMP(5);
          nsa_main_phase(p, lds, T32(), bid, G);
          __syncthreads();
          SUBSTAMP(6);
          const int t = T32();
          for (int un = bid; un < 1024; un += G) gla_c_unit(p, li, lds, t, un);
          SUBSTAMP(7);
          break; }
        case 11: ln_rows_w<0>(p, p.tmp, p.ln1_g + li * D, p.ln1_b + li * D, p.xf, p.xb, nullptr, gw, NGW, T32() & 63); break;
        case 13: xattn_phase(p, lds, T32(), bid, G); break;
        case 15: ln_rows_w<0>(p, p.tmp, p.ln2_g + li * D, p.ln2_b + li * D, p.xf, p.xb, nullptr, gw, NGW, T32() & 63); break;
        case 16: route_phase(p, li, lds, T32(), bid, G); break;
        case 17: { const int t = T32(); moe_prep(p, li, tab, wave, t & 63, t); break; }
        case 20: ln_rows_w<1>(p, nullptr, p.ln3_g + li * D, p.ln3_b + li * D, p.xf, p.xb, li == DEPTH - 1 ? p.out : nullptr, gw, NGW, T32() & 63); break;
        default: break;
      }
    }
    if (COOP && sync_after) xcd_barrier(xbar, T32());
    if (TSTEP_LO >= 0 && k == TSTEP_HI && blockIdx.x == 0 && wave == 0) stamp[2 * li + 1] = (unsigned)__builtin_amdgcn_s_memrealtime();
    if (PROBE_HI >= 0 && k == PROBE_HI && !rep_done) { rep_done = 1; step -= (PROBE_HI - PROBE_LO); }
    else { if (k == PROBE_HI) rep_done = 0; ++step; }
  }
  if (GSEG >= 0 && blockIdx.x == 0 && fresh_t32(wave) == 0) {
    __builtin_amdgcn_s_waitcnt(0);
    const unsigned tk = __hip_atomic_load(barw0 + 3600, __ATOMIC_RELAXED, __HIP_MEMORY_SCOPE_AGENT);
    ((float*)ka.out)[0] = (float)((tk / 100u + TSTEP_Q / 2) / TSTEP_Q * TSTEP_Q);
  }
  if (TSTEP_LO >= -1 && blockIdx.x == 0 && fresh_t32(wave) == 0) {
    __builtin_amdgcn_s_waitcnt(0);
    const unsigned tk = (__hip_atomic_load(stamp + 1, __ATOMIC_RELAXED, __HIP_MEMORY_SCOPE_AGENT) - __hip_atomic_load(stamp + 0, __ATOMIC_RELAXED, __HIP_MEMORY_SCOPE_AGENT)) + (__hip_atomic_load(stamp + 3, __ATOMIC_RELAXED, __HIP_MEMORY_SCOPE_AGENT) - __hip_atomic_load(stamp + 2, __ATOMIC_RELAXED, __HIP_MEMORY_SCOPE_AGENT));
    ((float*)ka.out)[0] = (float)((tk / 100u + TSTEP_Q / 2) / TSTEP_Q * TSTEP_Q);
  }
}

extern "C" void kernel_launch(void* const* d_in, const int* in_sizes, int n_in, void* d_out, int out_size,
                              void* d_ws, size_t ws_size, hipStream_t stream) {
  Params p;
  memset(&p, 0, sizeof(p));
  fill_params(p, d_in, d_out, d_ws);
  KArgs ka;
  memset(&ka, 0, sizeof(ka));
  for (int i = 0; i < 35; ++i) ka.in[i] = d_in[i];
  ka.out = d_out; ka.ws = d_ws;
  static int grid_blocks = 0;
  if (!grid_blocks) {
    int dev = 0, cus = 0;
    hipGetDevice(&dev);
    hipDeviceGetAttribute(&cus, hipDeviceAttributeMultiprocessorCount, dev);
    hipFuncSetAttribute((const void*)k_mega<true, true>, hipFuncAttributeMaxDynamicSharedMemorySize, LDS_BYTES);
    if (p.ws_used > ws_size) fprintf(stderr, "workspace too small: need %zu have %zu\n", p.ws_used, ws_size);
    grid_blocks = cus;
  }
  hipMemsetAsync(p.barw, 0, 4096 * sizeof(unsigned), stream);
  int lo = -1, hi = DEPTH * STEPS_PER_LAYER;
  void* args[] = {&ka, &lo, &hi};
  hipError_t e = hipLaunchCooperativeKernel((void*)k_mega<true, true>, dim3(grid_blocks), dim3(NTHREADS), args, LDS_BYTES, stream);
  if (e != hipSuccess) fprintf(stderr, "cooperative launch failed: %s (grid %d)\n", hipGetErrorString(e), grid_blocks);
}
#endif
```

```cpp
#ifndef CPU_TEST
#include <hip/hip_runtime.h>
#include <hip/hip_cooperative_groups.h>
#include <cstdio>
#include <cstring>
#include <cmath>
namespace cg = cooperative_groups;
#define DEV __device__ __forceinline__
#define HDI __host__ __device__ __forceinline__
#else
#include <cmath>
#include <cstdio>
#include <cstdlib>
#include <cstring>
#define DEV static inline
#define HDI static inline
#endif

#ifndef D_MODEL
#define D_MODEL 1024
#endif
#ifndef BATCH
#define BATCH 8
#endif
#ifndef MEGA
#define MEGA 1
#endif

constexpr int D = D_MODEL;
constexpr int SEQ = 2048;
constexpr int DEPTH = 2;
constexpr int MEM_LEN = 256;
constexpr int HD = 64;
constexpr int N_TOK = BATCH * SEQ;
constexpr int GLA_H = 4;
constexpr int DK = D / 2 / GLA_H;
constexpr int DV = D / GLA_H;
constexpr int GLA_RANK = 16;
constexpr int B_K = GLA_H * DK;
constexpr int B_V = GLA_H * DV;
constexpr int NSA_H = 16;
constexpr int NSA_G = 4;
constexpr int N_CMP = 127;
constexpr int CMP_HID = 128;
constexpr int N_BLK = 32;
constexpr int N_SELECT = 16;
constexpr int NSA_WIN = 512;
constexpr int XH = 4;
constexpr int XHD = D / XH;
constexpr int NE = 32;
constexpr int TOPK = 4;
constexpr int DFF = D;
constexpr float LN_EPS = 1e-5f;
constexpr float ALPHA = 1.41421356237309515f;

constexpr int OFF_AQ = 0;
constexpr int OFF_AK = 768;
constexpr int OFF_AV = 1536;
constexpr int OFF_BQ = 2304;
constexpr int OFF_BK = OFF_BQ + B_K;
constexpr int OFF_BV = OFF_BK + B_K;
constexpr int OFF_BR = OFF_BV + B_V;
constexpr int OFF_LR = OFF_BR + B_V;
constexpr int OFF_CQ = OFF_LR + GLA_RANK;
constexpr int OFF_CKC = OFF_CQ + 1024;
constexpr int OFF_CVC = OFF_CKC + 256;
constexpr int OFF_CKS = OFF_CVC + 256;
constexpr int OFF_CVS = OFF_CKS + 256;
constexpr int OFF_CKW = OFF_CVS + 256;
constexpr int OFF_CVW = OFF_CKW + 256;
constexpr int OFF_CG = OFF_CVW + 256;
constexpr int OFF_MG = OFF_CG + 48;
constexpr int N_IN = OFF_MG + 3 * D;
constexpr int N_IN_PAD = (N_IN + 255) / 256 * 256;
constexpr int MOE_ROWS = N_TOK * 4 + 32 * 256;
constexpr int CMP_ROWS_PAD = 4096;
constexpr int YLD = 256 + 1024 + 1024;

#ifdef CPU_TEST
typedef float act_t;
DEV float ldf(float v) { return v; }
DEV void stf(float* p, float v) { *p = v; }
#else
typedef unsigned short act_t;
DEV float ldf(unsigned short h) { return __uint_as_float(((unsigned)h) << 16); }
DEV float ldf(float v) { return v; }
DEV unsigned short f2bf(float f) {
  unsigned u = __float_as_uint(f);
  u += 0x7fffu + ((u >> 16) & 1u);
  return (unsigned short)(u >> 16);
}
DEV void stf(unsigned short* p, float v) { *p = f2bf(v); }
DEV void stf(float* p, float v) { *p = v; }
#endif

struct Params {
  const float *x, *mem, *ln0_g, *ln0_b, *w_in, *b_in, *w_alpha2, *b_alpha, *gla_norm_g,
      *cmp_pe_k, *cmp_w1_k, *cmp_w2_k, *cmp_pe_v, *cmp_w1_v, *cmp_w2_v,
      *w_br_a, *w_br_b, *w_br_c, *w_o_mix, *ln1_g, *ln1_b, *w_xq, *w_xk, *w_xv, *w_xo, *ln2_g, *ln2_b,
      *w_router, *b_router, *w_gu, *b_gu, *w_down, *b_down, *ln3_g, *ln3_b;
  float* out;
  float* xf;
  act_t* xb;
  act_t* u;
  float* ga;
  float* hid;
  float* kcv;
  float* opart;
  act_t* ya;
  act_t* yb;
  act_t* yc;
  float* pcmp;
  float* ocmp;
  float* impb;
  int* selb;
  act_t* merged;
  float* tmp;
  act_t* xq;
  act_t* memk;
  act_t* memv;
  float* xs;
  act_t* xo;
  float* rl;
  int* topi;
  float* topg;
  act_t* act;
  act_t* wt_in;
  act_t* wt_c1;
  act_t* wt_bra;
  act_t* wt_brb;
  act_t* wt_brc;
  act_t* wt_omix;
  act_t* wt_xq;
  act_t* wt_xk;
  act_t* wt_xv;
  act_t* wt_xo;
  act_t* wt_gu;
  act_t* wt_dn;
  act_t* membf;
  act_t* cmpA;
  float* mrg;
  int* cnt;
  int* rank;
  int* rowlist;
  act_t* xg;
  act_t* actg;
  float* yass;
  act_t* kcb;
  act_t* dilo;
  float* dill;
  unsigned* selm;
  act_t* gU;
  act_t* gS;
  act_t* gQ;
  float* gD;
  unsigned* barw;
  size_t ws_used;
};

#ifdef CPU_TEST
#define FOR_IDX(idx, total) \
  for (long long idx = (long long)(total) * tid / nthr, _e = (long long)(total) * (tid + 1) / nthr; idx < _e; ++idx)
#else
#define FOR_IDX(idx, total) for (long long idx = tid; idx < (long long)(total); idx += nthr)
#endif

DEV float sigmoidf_(float x) { return 1.0f / (1.0f + expf(-x)); }

template <class TA>
DEV float dotcol(const TA* a, const float* W, int K, long long ldw) {
  float s = 0.f;
  for (int k = 0; k < K; ++k) s += ldf(a[k]) * W[(long long)k * ldw];
  return s;
}

DEV void ph_ln(const float* src, const float* g, const float* b, float* dstf, act_t* dstb, float* dst2,
               long long tid, long long nthr) {
  FOR_IDX(n, N_TOK) {
    const float* r = src + n * D;
    float mu = 0.f;
    for (int i = 0; i < D; ++i) mu += r[i];
    mu /= D;
    float var = 0.f;
    for (int i = 0; i < D; ++i) { float d = r[i] - mu; var += d * d; }
    var /= D;
    float rs = 1.0f / sqrtf(var + LN_EPS);
    for (int i = 0; i < D; ++i) {
      float y = (r[i] - mu) * rs * g[i] + b[i];
      dstf[n * D + i] = y;
      stf(&dstb[n * D + i], y);
      if (dst2) dst2[n * D + i] = y;
    }
  }
}

DEV void ph_inproj(const Params& p, int li, long long tid, long long nthr) {
  const float* W = p.w_in + (long long)li * D * N_IN;
  const float* bias = p.b_in + (long long)li * N_IN;
  FOR_IDX(idx, (long long)N_TOK * N_IN) {
    long long n = idx / N_IN; int c = (int)(idx % N_IN);
    stf(&p.u[idx], dotcol(p.xb + n * D, W + c, D, N_IN) + bias[c]);
  }
}

DEV float gelu_tanh(float x) {
  return 0.5f * x * (1.0f + tanhf(0.7978845608028654f * (x + 0.044715f * x * x * x)));
}

constexpr int CMP_ROWS = BATCH * N_CMP * NSA_G;

template <int PARTS>
DEV void ph_pre(const Params& p, int li, long long tid, long long nthr) {
  const long long T1 = (long long)N_TOK * B_K;
  const long long T2 = (PARTS & 2) ? 2LL * CMP_ROWS * CMP_HID : 0;
  FOR_IDX(idx, T1 + T2) {
    if (idx < T1) {
      if (!(PARTS & 1)) continue;
      long long n = idx / B_K; int c = (int)(idx % B_K);
      const float* W2 = p.w_alpha2 + (long long)li * GLA_RANK * B_K;
      float z = p.b_alpha[li * B_K + c];
      for (int r = 0; r < GLA_RANK; ++r) z += ldf(p.u[n * N_IN + OFF_LR + r]) * W2[r * B_K + c];
      float ls = fminf(z, 0.f) - log1pf(expf(-fabsf(z)));
      p.ga[idx] = expf(ls * (1.0f / 16.0f));
    } else {
      long long i2 = idx - T1;
      int which = (int)(i2 / ((long long)CMP_ROWS * CMP_HID));
      long long rem = i2 % ((long long)CMP_ROWS * CMP_HID);
      int row = (int)(rem / CMP_HID), j = (int)(rem % CMP_HID);
      int g = row % NSA_G; int c = (row / NSA_G) % N_CMP; int b = row / (NSA_G * N_CMP);
      const float* pe = (which ? p.cmp_pe_v : p.cmp_pe_k) + (long long)li * 32 * HD;
      const float* w1 = (which ? p.cmp_w1_v : p.cmp_w1_k) + (long long)li * 32 * HD * CMP_HID;
      int off = (which ? OFF_CVC : OFF_CKC) + g * HD;
      float s = 0.f;
      for (int l = 0; l < 32; ++l) {
        const act_t* ur = p.u + ((long long)b * SEQ + c * 16 + l) * N_IN + off;
        for (int d = 0; d < HD; ++d) s += (ldf(ur[d]) + pe[l * HD + d]) * w1[(long long)(l * HD + d) * CMP_HID + j];
      }
      p.hid[i2] = gelu_tanh(s);
    }
  }
}

template <int PARTS>
DEV void ph_mix1(const Params& p, int li, long long tid, long long nthr) {
  const long long T1 = (long long)N_TOK * 4;
  const long long T2 = (long long)BATCH * GLA_H * DV * 4;
  const long long T3 = 2LL * CMP_ROWS * HD;
  FOR_IDX(idx, T1 + T2 + T3) {
    if (idx < T1) {
      if (!(PARTS & 1)) continue;
      long long n = idx / 4; int h = (int)(idx % 4);
      int b = (int)(n / SEQ), t = (int)(n % SEQ);
      float m = -INFINITY, l = 0.f;
      float acc[HD];
#pragma unroll
      for (int d = 0; d < HD; ++d) acc[d] = 0.f;
      for (int gi = 0; gi < 3; ++gi) {
        const int dil = gi == 0 ? 1 : (gi == 1 ? 4 : 16);
        float q[HD];
        const act_t* qp = p.u + n * N_IN + OFF_AQ + gi * 256 + h * HD;
#pragma unroll
        for (int d = 0; d < HD; ++d) q[d] = ldf(qp[d]);
        for (int mm = 0; mm <= 128; ++mm) {
          int tk = t - mm * dil;
          if (tk < 0) break;
          const act_t* kp = p.u + ((long long)b * SEQ + tk) * N_IN + OFF_AK + gi * 256 + h * HD;
          const act_t* vp = p.u + ((long long)b * SEQ + tk) * N_IN + OFF_AV + gi * 256 + h * HD;
          float s = 0.f;
#pragma unroll
          for (int d = 0; d < HD; ++d) s += q[d] * ldf(kp[d]);
          s *= 0.125f;
          float mn = fmaxf(m, s);
          float corr = expf(m - mn);
          float pp = expf(s - mn);
          l = l * corr + pp;
#pragma unroll
          for (int d = 0; d < HD; ++d) acc[d] = acc[d] * corr + pp * ldf(vp[d]);
          m = mn;
        }
      }
      float inv = 1.0f / l;
#pragma unroll
      for (int d = 0; d < HD; ++d) stf(&p.ya[n * 256 + h * HD + d], acc[d] * inv);
    } else if (idx < T1 + T2) {
      if (!(PARTS & 2)) continue;
      long long i2 = idx - T1;
      int v = (int)(i2 % DV); int cq = (int)((i2 / DV) % 4); int h = (int)((i2 / (DV * 4)) % GLA_H);
      int b = (int)(i2 / (DV * 4 * GLA_H));
      constexpr int DKQ = DK / 4;
      float st[DKQ];
#pragma unroll
      for (int c = 0; c < DKQ; ++c) st[c] = 0.f;
      const float qs = 1.0f / sqrtf((float)DK);
      for (int t = 0; t < SEQ; ++t) {
        long long n = (long long)b * SEQ + t;
        const act_t* ur = p.u + n * N_IN;
        float vt = ldf(ur[OFF_BV + h * DV + v]);
        const float* gar = p.ga + n * B_K + h * DK + cq * DKQ;
        const act_t* kr = ur + OFF_BK + h * DK + cq * DKQ;
        const act_t* qr = ur + OFF_BQ + h * DK + cq * DKQ;
        float o = 0.f;
#pragma unroll
        for (int c = 0; c < DKQ; ++c) {
          st[c] = gar[c] * st[c] + ldf(kr[c]) * vt;
          o += ldf(qr[c]) * st[c];
        }
        p.opart[((long long)cq * N_TOK + n) * B_V + h * DV + v] = o * qs;
      }
    } else {
      long long i2 = idx - T1 - T2;
      int which = (int)(i2 / ((long long)CMP_ROWS * HD));
      long long rem = i2 % ((long long)CMP_ROWS * HD);
      int row = (int)(rem / HD), d = (int)(rem % HD);
      const float* w2 = (which ? p.cmp_w2_v : p.cmp_w2_k) + (long long)li * CMP_HID * HD;
      const float* hr = p.hid + ((long long)which * CMP_ROWS + row) * CMP_HID;
      float s = 0.f;
      if (!(PARTS & 4)) continue;
      for (int j = 0; j < CMP_HID; ++j) s += hr[j] * w2[j * HD + d];
      p.kcv[i2] = s;
#ifndef CPU_TEST
      {
        const int g_ = row % NSA_G, c_ = (row / NSA_G) % N_CMP, b_ = row / (NSA_G * N_CMP);
        stf(&p.kcb[((((size_t)which * BATCH + b_) * 128 + c_) * NSA_G + g_) * 64 + d], s);
      }
#endif
    }
  }
}

template <int PARTS>
DEV void ph_nsa1(const Params& p, int li, long long tid, long long nthr) {
  const long long T1 = (long long)N_TOK * GLA_H;
  const long long T2 = (PARTS & 2) ? (long long)N_TOK * NSA_H : 0;
  FOR_IDX(idx, T1 + T2) {
    if (idx < T1) {
      long long n = idx / GLA_H; int h = (int)(idx % GLA_H);
      float ss = 0.f;
      for (int v = 0; v < DV; ++v) {
        float o = 0.f;
        for (int cq = 0; cq < 4; ++cq) o += p.opart[((long long)cq * N_TOK + n) * B_V + h * DV + v];
        ss += o * o;
      }
      float rs = 1.0f / sqrtf(ss / DV + LN_EPS);
      for (int v = 0; v < DV; ++v) {
        float o = 0.f;
        for (int cq = 0; cq < 4; ++cq) o += p.opart[((long long)cq * N_TOK + n) * B_V + h * DV + v];
        float r = ldf(p.u[n * N_IN + OFF_BR + h * DV + v]);
        float y = o * rs * p.gla_norm_g[li * DV + v] * (r * sigmoidf_(r));
        stf(&p.yb[n * B_V + h * DV + v], y);
      }
    } else {
      long long i2 = idx - T1;
      long long n = i2 / NSA_H; int hh = (int)(i2 % NSA_H);
      int b = (int)(n / SEQ), t = (int)(n % SEQ);
      int g = hh / 4;
      int nv = t >= 31 ? (t - 31) / 16 + 1 : 0;
      if (nv > N_CMP) nv = N_CMP;
      float q[HD];
      const act_t* qp = p.u + n * N_IN + OFF_CQ + hh * HD;
#pragma unroll
      for (int d = 0; d < HD; ++d) q[d] = ldf(qp[d]);
      float* prow = p.pcmp + (((long long)b * NSA_H + hh) * SEQ + t) * 128;
      float m = -INFINITY;
      for (int c = 0; c < nv; ++c) {
        const float* kp = p.kcv + (((long long)b * N_CMP + c) * NSA_G + g) * HD;
        float s = 0.f;
#pragma unroll
        for (int d = 0; d < HD; ++d) s += q[d] * kp[d];
        s *= 0.125f;
        prow[c] = s;
        m = fmaxf(m, s);
      }
      float acc[HD];
#pragma unroll
      for (int d = 0; d < HD; ++d) acc[d] = 0.f;
      float l = 0.f;
      for (int c = 0; c < nv; ++c) {
        const float* vp = p.kcv + (((long long)CMP_ROWS) + ((long long)b * N_CMP + c) * NSA_G + g) * HD;
        float pp = expf(prow[c] - m);
        l += pp;
        prow[c] = pp;
#pragma unroll
        for (int d = 0; d < HD; ++d) acc[d] += pp * vp[d];
      }
      float inv = 1.0f / fmaxf(l, 1e-30f);
      for (int c = 0; c < 128; ++c) prow[c] = c < nv ? prow[c] * inv : 0.f;
#pragma unroll
      for (int d = 0; d < HD; ++d) p.ocmp[n * 1024 + hh * HD + d] = acc[d] * inv;
    }
  }
}

DEV void ph_nsa2(const Params& p, int li, long long tid, long long nthr) {
  FOR_IDX(idx, (long long)BATCH * NSA_G * SEQ * N_BLK) {
    int j = (int)(idx % N_BLK); long long r = idx / N_BLK;
    int s = (int)(r % SEQ); int g = (int)((r / SEQ) % NSA_G); int b = (int)(r / ((long long)SEQ * NSA_G));
    int qb = s / 64;
    float imp;
    if (j == 0 || j == qb || j == qb - 1) imp = INFINITY;
    else if (j > qb) imp = -INFINITY;
    else {
      imp = 0.f;
      int c0 = 4 * j - 1; if (c0 < 0) c0 = 0;
      int c1 = 4 * j + 3; if (c1 > N_CMP - 1) c1 = N_CMP - 1;
      for (int rr = 0; rr < 4; ++rr) {
        const float* prow = p.pcmp + (((long long)b * NSA_H + g * 4 + rr) * SEQ + s) * 128;
        for (int c = c0; c <= c1; ++c) imp += prow[c];
      }
    }
    p.impb[idx] = imp;
  }
}

DEV void ph_nsa3(const Params& p, int li, long long tid, long long nthr) {
  FOR_IDX(idx, (long long)BATCH * NSA_G * SEQ * N_BLK) {
    int j = (int)(idx % N_BLK); long long r = idx / N_BLK;
    const float* ir = p.impb + r * N_BLK;
    float v = ir[j];
    int rank = 0;
    for (int jj = 0; jj < N_BLK; ++jj) {
      float w = ir[jj];
      if (w > v || (w == v && jj < j)) ++rank;
    }
    p.selb[idx] = rank < N_SELECT ? 1 : 0;
  }
}

DEV void ph_nsa4(const Params& p, int li, long long tid, long long nthr) {
  FOR_IDX(idx, (long long)N_TOK * NSA_H) {
    long long n = idx / NSA_H; int hh = (int)(idx % NSA_H);
    int b = (int)(n / SEQ), t = (int)(n % SEQ);
    int g = hh / 4;
    float q[HD];
    const act_t* qp = p.u + n * N_IN + OFF_CQ + hh * HD;
#pragma unroll
    for (int d = 0; d < HD; ++d) q[d] = ldf(qp[d]);
    float g0 = sigmoidf_(ldf(p.u[n * N_IN + OFF_CG + hh * 3 + 0]));
    float g1 = sigmoidf_(ldf(p.u[n * N_IN + OFF_CG + hh * 3 + 1]));
    float g2 = sigmoidf_(ldf(p.u[n * N_IN + OFF_CG + hh * 3 + 2]));
    float acc[HD];
    {
      float m = -INFINITY, l = 0.f;
#pragma unroll
      for (int d = 0; d < HD; ++d) acc[d] = 0.f;
      int qb = t / 64;
      const int* sr = p.selb + (((long long)b * NSA_G + g) * SEQ + t) * N_BLK;
      for (int j = 0; j <= qb; ++j) {
        if (!sr[j]) continue;
        int hi = j * 64 + 63; if (hi > t) hi = t;
        for (int tk = j * 64; tk <= hi; ++tk) {
          const act_t* kp = p.u + ((long long)b * SEQ + tk) * N_IN + OFF_CKS + g * HD;
          const act_t* vp = p.u + ((long long)b * SEQ + tk) * N_IN + OFF_CVS + g * HD;
          float s = 0.f;
#pragma unroll
          for (int d = 0; d < HD; ++d) s += q[d] * ldf(kp[d]);
          s *= 0.125f;
          float mn = fmaxf(m, s);
          float corr = expf(m - mn);
          float pp = expf(s - mn);
          l = l * corr + pp;
#pragma unroll
          for (int d = 0; d < HD; ++d) acc[d] = acc[d] * corr + pp * ldf(vp[d]);
          m = mn;
        }
      }
      float inv = 1.0f / l;
#pragma unroll
      for (int d = 0; d < HD; ++d) {
        float* oc = &p.ocmp[n * 1024 + hh * HD + d];
        *oc = g0 * (*oc) + g1 * acc[d] * inv;
      }
    }
    {
      float m = -INFINITY, l = 0.f;
#pragma unroll
      for (int d = 0; d < HD; ++d) acc[d] = 0.f;
      int lo = t - (NSA_WIN - 1); if (lo < 0) lo = 0;
      for (int tk = lo; tk <= t; ++tk) {
        const act_t* kp = p.u + ((long long)b * SEQ + tk) * N_IN + OFF_CKW + g * HD;
        const act_t* vp = p.u + ((long long)b * SEQ + tk) * N_IN + OFF_CVW + g * HD;
        float s = 0.f;
#pragma unroll
        for (int d = 0; d < HD; ++d) s += q[d] * ldf(kp[d]);
        s *= 0.125f;
        float mn = fmaxf(m, s);
        float corr = expf(m - mn);
        float pp = expf(s - mn);
        l = l * corr + pp;
#pragma unroll
        for (int d = 0; d < HD; ++d) acc[d] = acc[d] * corr + pp * ldf(vp[d]);
        m = mn;
      }
      float inv = 1.0f / l;
#pragma unroll
      for (int d = 0; d < HD; ++d)
        stf(&p.yc[n * 1024 + hh * HD + d], p.ocmp[n * 1024 + hh * HD + d] + g2 * acc[d] * inv);
    }
  }
}

DEV void ph_br(const Params& p, int li, long long tid, long long nthr) {
  const float* Wa = p.w_br_a + (long long)li * 256 * D;
  const float* Wb = p.w_br_b + (long long)li * B_V * D;
  const float* Wc = p.w_br_c + (long long)li * 1024 * D;
  FOR_IDX(idx, (long long)N_TOK * D) {
    long long n = idx / D; int d = (int)(idx % D);
    float s0 = dotcol(p.ya + n * 256, Wa + d, 256, D);
    float s1 = dotcol(p.yb + n * B_V, Wb + d, B_V, D);
    float s2 = dotcol(p.yc + n * 1024, Wc + d, 1024, D);
    const act_t* mg = p.u + n * N_IN + OFF_MG;
    float y = sigmoidf_(ldf(mg[d])) * s0 + sigmoidf_(ldf(mg[D + d])) * s1 + sigmoidf_(ldf(mg[2 * D + d])) * s2;
    stf(&p.merged[idx], y);
  }
}

DEV void ph_proj_res(const Params& p, const act_t* a, const float* W, long long tid, long long nthr) {
  FOR_IDX(idx, (long long)N_TOK * D) {
    long long n = idx / D; int d = (int)(idx % D);
    p.tmp[idx] = ALPHA * p.xf[idx] + dotcol(a + n * D, W + d, D, D);
  }
}

DEV void ph_xq(const Params& p, int li, long long tid, long long nthr) {
  const long long T1 = (long long)N_TOK * D;
  const long long T2 = 2LL * BATCH * MEM_LEN * D;
  const float* Wq = p.w_xq + (long long)li * D * D;
  FOR_IDX(idx, T1 + T2) {
    if (idx < T1) {
      long long n = idx / D; int d = (int)(idx % D);
      stf(&p.xq[idx], dotcol(p.xb + n * D, Wq + d, D, D));
    } else {
      long long i2 = idx - T1;
      int which = (int)(i2 / ((long long)BATCH * MEM_LEN * D));
      long long rem = i2 % ((long long)BATCH * MEM_LEN * D);
      long long r = rem / D; int d = (int)(rem % D);
      const float* W = (which ? p.w_xv : p.w_xk) + (long long)li * D * D;
      float s = dotcol(p.mem + r * D, W + d, D, D);
      stf(which ? &p.memv[rem] : &p.memk[rem], s);
    }
  }
}

DEV void ph_xs(const Params& p, int li, long long tid, long long nthr) {
  const float sc = 1.0f / sqrtf((float)XHD);
  FOR_IDX(idx, (long long)N_TOK * XH * MEM_LEN) {
    int m = (int)(idx % MEM_LEN); int h = (int)((idx / MEM_LEN) % XH); long long n = idx / (MEM_LEN * XH);
    int b = (int)(n / SEQ);
    const act_t* q = p.xq + n * D + h * XHD;
    const act_t* k = p.memk + ((long long)b * MEM_LEN + m) * D + h * XHD;
    float s = 0.f;
    for (int d = 0; d < XHD; ++d) s += ldf(q[d]) * ldf(k[d]);
    p.xs[idx] = s * sc;
  }
}

DEV void ph_xo(const Params& p, int li, long long tid, long long nthr) {
  FOR_IDX(idx, (long long)N_TOK * D) {
    long long n = idx / D; int c = (int)(idx % D);
    int h = c / XHD; int b = (int)(n / SEQ);
    const float* sr = p.xs + (n * XH + h) * MEM_LEN;
    float m = -INFINITY;
    for (int mm = 0; mm < MEM_LEN; ++mm) m = fmaxf(m, sr[mm]);
    float l = 0.f, o = 0.f;
    for (int mm = 0; mm < MEM_LEN; ++mm) {
      float pp = expf(sr[mm] - m);
      l += pp;
      o += pp * ldf(p.memv[((long long)b * MEM_LEN + mm) * D + c]);
    }
    stf(&p.xo[idx], o / l);
  }
}

DEV void ph_rlogit(const Params& p, int li, long long tid, long long nthr) {
  const float* W = p.w_router + (long long)li * D * NE;
  FOR_IDX(idx, (long long)N_TOK * NE) {
    long long n = idx / NE; int e = (int)(idx % NE);
    p.rl[idx] = dotcol(p.xf + n * D, W + e, D, NE) + p.b_router[li * NE + e];
  }
}

DEV void ph_route(const Params& p, int li, long long tid, long long nthr) {
  FOR_IDX(n, N_TOK) {
    const float* r = p.rl + n * NE;
    int i0 = -1, i1 = -1, i2 = -1, i3 = -1;
    float v0 = 0, v1 = 0, v2 = 0, v3 = 0;
    for (int k = 0; k < 4; ++k) {
      int bi = -1; float bv = -INFINITY;
      for (int e = 0; e < NE; ++e) {
        if (e == i0 || e == i1 || e == i2) continue;
        float v = r[e];
        if (bi < 0 || v > bv) { bi = e; bv = v; }
      }
      if (k == 0) { i0 = bi; v0 = bv; } else if (k == 1) { i1 = bi; v1 = bv; }
      else if (k == 2) { i2 = bi; v2 = bv; } else { i3 = bi; v3 = bv; }
    }
    float e0 = 1.0f, e1 = expf(v1 - v0), e2 = expf(v2 - v0), e3 = expf(v3 - v0);
    float inv = 1.0f / (e0 + e1 + e2 + e3);
#ifndef CPU_TEST
    p.rank[n * 4 + 0] = atomicAdd(&p.cnt[li * 32 + i0], 1);
    p.rank[n * 4 + 1] = atomicAdd(&p.cnt[li * 32 + i1], 1);
    p.rank[n * 4 + 2] = atomicAdd(&p.cnt[li * 32 + i2], 1);
    p.rank[n * 4 + 3] = atomicAdd(&p.cnt[li * 32 + i3], 1);
#endif
    p.topi[n * 4 + 0] = i0; p.topi[n * 4 + 1] = i1; p.topi[n * 4 + 2] = i2; p.topi[n * 4 + 3] = i3;
    p.topg[n * 4 + 0] = e0 * inv; p.topg[n * 4 + 1] = e1 * inv; p.topg[n * 4 + 2] = e2 * inv; p.topg[n * 4 + 3] = e3 * inv;
  }
}

DEV void ph_moe1(const Params& p, int li, long long tid, long long nthr) {
  FOR_IDX(idx, (long long)N_TOK * TOPK * DFF) {
    int j = (int)(idx % DFF); long long a = idx / DFF; long long n = a / TOPK;
    int e = p.topi[a];
    const float* W = p.w_gu + ((long long)li * NE + e) * D * 2 * DFF;
    const float* bb = p.b_gu + ((long long)li * NE + e) * 2 * DFF;
    float gt = dotcol(p.xb + n * D, W + j, D, 2 * DFF) + bb[j];
    float up = dotcol(p.xb + n * D, W + DFF + j, D, 2 * DFF) + bb[DFF + j];
    gt = fminf(gt, 7.0f);
    up = fminf(fmaxf(up, -7.0f), 7.0f);
    stf(&p.act[idx], (up + 1.0f) * gt * sigmoidf_(1.702f * gt));
  }
}

DEV void ph_moe2(const Params& p, int li, long long tid, long long nthr) {
  FOR_IDX(idx, (long long)N_TOK * D) {
    long long n = idx / D; int d = (int)(idx % D);
    float y = 0.f;
    for (int k = 0; k < TOPK; ++k) {
      int e = p.topi[n * 4 + k];
      const float* W = p.w_down + ((long long)li * NE + e) * DFF * D;
      float s = dotcol(p.act + (n * 4 + k) * DFF, W + d, DFF, D) + p.b_down[((long long)li * NE + e) * D + d];
      y += p.topg[n * 4 + k] * s;
    }
    p.tmp[idx] = ALPHA * p.xf[idx] + y;
  }
}

constexpr int PH_PER_LAYER = 20;
constexpr int N_PHASES = 1 + DEPTH * PH_PER_LAYER;

template <int K>
DEV void run_phase_k(const Params& p, int li, long long tid, long long nthr) {
  if constexpr (K == -1) ph_ln(p.x, p.ln0_g, p.ln0_b, p.xf, p.xb, nullptr, tid, nthr);
  if constexpr (K == 0) ph_inproj(p, li, tid, nthr);
  if constexpr (K == 1) ph_pre<3>(p, li, tid, nthr);
  if constexpr (K == 20) ph_pre<1>(p, li, tid, nthr);
  if constexpr (K == 2) ph_mix1<7>(p, li, tid, nthr);
  if constexpr (K == 21) ph_mix1<4>(p, li, tid, nthr);
  if constexpr (K == 3) ph_nsa1<3>(p, li, tid, nthr);
  if constexpr (K == 22) ph_nsa1<1>(p, li, tid, nthr);
  if constexpr (K == 4) ph_nsa2(p, li, tid, nthr);
  if constexpr (K == 5) ph_nsa3(p, li, tid, nthr);
  if constexpr (K == 6) ph_nsa4(p, li, tid, nthr);
  if constexpr (K == 7) ph_br(p, li, tid, nthr);
  if constexpr (K == 8) ph_proj_res(p, p.merged, p.w_o_mix + (long long)li * D * D, tid, nthr);
  if constexpr (K == 9) ph_ln(p.tmp, p.ln1_g + li * D, p.ln1_b + li * D, p.xf, p.xb, nullptr, tid, nthr);
  if constexpr (K == 10) ph_xq(p, li, tid, nthr);
  if constexpr (K == 11) ph_xs(p, li, tid, nthr);
  if constexpr (K == 12) ph_xo(p, li, tid, nthr);
  if constexpr (K == 13) ph_proj_res(p, p.xo, p.w_xo + (long long)li * D * D, tid, nthr);
  if constexpr (K == 14) ph_ln(p.tmp, p.ln2_g + li * D, p.ln2_b + li * D, p.xf, p.xb, nullptr, tid, nthr);
  if constexpr (K == 15) ph_rlogit(p, li, tid, nthr);
  if constexpr (K == 16) ph_route(p, li, tid, nthr);
  if constexpr (K == 17) ph_moe1(p, li, tid, nthr);
  if constexpr (K == 18) ph_moe2(p, li, tid, nthr);
  if constexpr (K == 19) ph_ln(p.tmp, p.ln3_g + li * D, p.ln3_b + li * D, p.xf, p.xb, li == DEPTH - 1 ? p.out : nullptr, tid, nthr);
}

DEV void run_phase(const Params& p, int ph, long long tid, long long nthr) {
  if (ph == 0) { run_phase_k<-1>(p, 0, tid, nthr); return; }
  int li = (ph - 1) / PH_PER_LAYER, k = (ph - 1) % PH_PER_LAYER;
  switch (k) {
#define PHC(K) case K: run_phase_k<K>(p, li, tid, nthr); break;
    PHC(0) PHC(1) PHC(2) PHC(3) PHC(4) PHC(5) PHC(6) PHC(7) PHC(8) PHC(9)
    PHC(10) PHC(11) PHC(12) PHC(13) PHC(14) PHC(15) PHC(16) PHC(17) PHC(18) PHC(19)
#undef PHC
  }
}

#ifdef CPU_TEST
#define HDI_M
#else
#define HDI_M __host__ __device__ __forceinline__
#endif
struct Carver {
  char* base; size_t off;
  template <class T> HDI_M T* take(size_t n) {
    T* r = (T*)(base + off);
    off += (n * sizeof(T) + 255) & ~(size_t)255;
    return r;
  }
};

HDI void fill_params(Params& p, void* const* d_in, void* d_out, void* d_ws) {
  const float* const* in = (const float* const*)d_in;
  p.x = in[0]; p.mem = in[1]; p.ln0_g = in[2]; p.ln0_b = in[3]; p.w_in = in[4]; p.b_in = in[5];
  p.w_alpha2 = in[6]; p.b_alpha = in[7]; p.gla_norm_g = in[8];
  p.cmp_pe_k = in[9]; p.cmp_w1_k = in[10]; p.cmp_w2_k = in[11]; p.cmp_pe_v = in[12]; p.cmp_w1_v = in[13]; p.cmp_w2_v = in[14];
  p.w_br_a = in[15]; p.w_br_b = in[16]; p.w_br_c = in[17]; p.w_o_mix = in[18]; p.ln1_g = in[19]; p.ln1_b = in[20];
  p.w_xq = in[21]; p.w_xk = in[22]; p.w_xv = in[23]; p.w_xo = in[24]; p.ln2_g = in[25]; p.ln2_b = in[26];
  p.w_router = in[27]; p.b_router = in[28]; p.w_gu = in[29]; p.b_gu = in[30]; p.w_down = in[31]; p.b_down = in[32];
  p.ln3_g = in[33]; p.ln3_b = in[34];
  p.out = (float*)d_out;
  Carver c{(char*)d_ws, 0};
  p.barw = c.take<unsigned>(4096);
  p.xf = c.take<float>((size_t)N_TOK * D);
  p.xb = c.take<act_t>((size_t)N_TOK * D);
  p.u = c.take<act_t>((size_t)N_TOK * N_IN);
  p.ga = c.take<float>((size_t)N_TOK * B_K);
  p.hid = c.take<float>((size_t)2 * CMP_ROWS * CMP_HID);
  p.kcv = c.take<float>((size_t)2 * CMP_ROWS * HD);
  p.opart = c.take<float>((size_t)4 * N_TOK * B_V);
  p.yass = p.opart;
#ifdef CPU_TEST
  p.ya = c.take<act_t>((size_t)N_TOK * 256);
  p.yb = c.take<act_t>((size_t)N_TOK * B_V);
  p.yc = c.take<act_t>((size_t)N_TOK * 1024);
#else
  p.ya = c.take<act_t>((size_t)N_TOK * YLD);
  p.yb = p.ya + 256;
  p.yc = p.ya + 1280;
#endif
  p.pcmp = c.take<float>((size_t)MOE_ROWS * 1024 / 2 > (size_t)BATCH * NSA_H * SEQ * 128 ? (size_t)MOE_ROWS * 1024 / 2 : (size_t)BATCH * NSA_H * SEQ * 128);
  p.xg = (act_t*)p.pcmp;
  p.ocmp = c.take<float>((size_t)N_TOK * 1024);
  p.impb = c.take<float>((size_t)BATCH * NSA_G * SEQ * N_BLK);
  p.selb = c.take<int>((size_t)BATCH * NSA_G * SEQ * N_BLK);
  p.merged = c.take<act_t>((size_t)N_TOK * D);
  p.tmp = c.take<float>((size_t)N_TOK * D);
  p.xq = c.take<act_t>((size_t)N_TOK * D);
  p.memk = c.take<act_t>((size_t)BATCH * MEM_LEN * D);
  p.memv = c.take<act_t>((size_t)BATCH * MEM_LEN * D);
  p.xs = c.take<float>((size_t)N_TOK * XH * MEM_LEN);
  p.mrg = p.xs;
  p.xo = c.take<act_t>((size_t)N_TOK * D);
  p.rl = c.take<float>((size_t)N_TOK * NE);
  p.topi = c.take<int>((size_t)N_TOK * TOPK);
  p.topg = c.take<float>((size_t)N_TOK * TOPK);
  p.actg = c.take<act_t>((size_t)MOE_ROWS * 1024);
  p.act = p.actg;
  p.wt_in = c.take<act_t>((size_t)2 * N_IN_PAD * 1024);
  p.wt_c1 = c.take<act_t>((size_t)2 * 2 * 256 * 2048);
  p.wt_bra = c.take<act_t>((size_t)2 * 1024 * YLD);
  p.wt_brb = p.wt_bra + 256;
  p.wt_brc = p.wt_bra + 1280;
  p.wt_omix = c.take<act_t>((size_t)2 * 1024 * 1024);
  p.wt_xq = c.take<act_t>((size_t)2 * 1024 * 1024);
  p.wt_xk = c.take<act_t>((size_t)2 * 1024 * 1024);
  p.wt_xv = c.take<act_t>((size_t)2 * 1024 * 1024);
  p.wt_xo = c.take<act_t>((size_t)2 * 1024 * 1024);
  p.wt_gu = c.take<act_t>((size_t)2 * 32 * 2048 * 1024);
  p.wt_dn = c.take<act_t>((size_t)2 * 32 * 1024 * 1024);
  p.membf = c.take<act_t>((size_t)BATCH * MEM_LEN * 1024);
  p.cmpA = c.take<act_t>((size_t)2 * CMP_ROWS_PAD * 2048);
  p.cnt = c.take<int>(64);
  p.rank = c.take<int>((size_t)N_TOK * 4);
  p.rowlist = c.take<int>((size_t)MOE_ROWS);
  p.kcb = c.take<act_t>((size_t)2 * BATCH * 128 * NSA_G * 64);
  p.dilo = c.take<act_t>((size_t)3 * N_TOK * 256);
  p.dill = c.take<float>((size_t)3 * N_TOK * 4);
  p.selm = c.take<unsigned>((size_t)BATCH * NSA_G * SEQ);
  p.gU = p.xg; p.gQ = p.xg + (size_t)1024 * 128 * 256; p.gS = p.actg; p.gD = p.opart + (size_t)N_TOK * 1024;
  p.ws_used = c.off;
}

#ifndef CPU_TEST
#ifndef NSA_PROBE
#define NSA_PROBE 0
#endif
#ifndef GSEG
#define GSEG -1
#endif
static_assert(D == 1024 && BATCH == 8, "optimized path is written for the graded shapes");
namespace pg8 {
#define PG8_LAS __attribute__((address_space(3)))
typedef unsigned short bf16_t;
typedef short bf16x8 __attribute__((ext_vector_type(8)));
typedef float f32x4 __attribute__((ext_vector_type(4)));
typedef unsigned u32x4 __attribute__((ext_vector_type(4)));
constexpr int BM = 256, BK = 64, HALF = 128, HTB = HALF * BK * 2  , STAGE_BYTES = 8 * HTB, NXCD = 8, WGM = 8;

__host__ __device__ __forceinline__ int lds_byte(int r, int c) { const int st = (r >> 4) * 2 + (c >> 5), rr = r & 15, cc = c & 31, ob = rr * 64 + cc * 2; return st * 1024 + (ob ^ (((ob >> 9) & 1) << 5)); }
__host__ __device__ __forceinline__ void stage_rc(int b, int& R, int& C) { const int st = b / 1024, sb = b % 1024, swz = sb ^ (((sb >> 9) & 1) << 5); R = (st >> 1) * 16 + swz / 64; C = (st & 1) * 32 + (swz % 64) / 2; }
__host__ __device__ __forceinline__ int perm32(int rho) { const int n = rho >> 4, i = rho & 15; return 8 * (i >> 2) + 4 * n + (i & 3); }

struct Unit { int pm, pn; };
struct Gemm { const bf16_t* A; const bf16_t* Bt; int M, N, K; };

struct StaticOrder {
    int nM, nN, nwg, G, c;
    __host__ __device__ void init(int M, int N, int G_, int c_) { nM = M / BM; nN = N / BM; nwg = nM * nN; G = G_; c = c_; }
    __host__ __device__ bool next(int i, Unit& u) const {
        const long L = (long)i * G + c; if (L >= nwg) return false;
        int wgid = (int)L; { const int q = nwg / NXCD, r = nwg % NXCD, xcd = wgid % NXCD, off = wgid / NXCD; wgid = (xcd < r ? xcd * (q + 1) : r * (q + 1) + (xcd - r) * q) + off; }
        const int nig = WGM * nN, gid = wgid / nig, fm = gid * WGM, gsz = (nM - fm) < WGM ? (nM - fm) : WGM;
        u.pm = fm + ((wgid % nig) % gsz); u.pn = (wgid % nig) / gsz; return true;
    }
    __device__ __forceinline__ void a_ready(const Unit&) const {}
    __device__ __forceinline__ void done(const Unit&) const {}
};

__device__ __forceinline__ unsigned cvt_pk_bf16(float lo, float hi) { unsigned r; asm volatile("v_cvt_pk_bf16_f32 %0, %1, %2" : "=v"(r) : "v"(lo), "v"(hi)); return r; }

template <class Epi, class Sched, bool ALIGN_EPI = false, bool SP2 = false>
__device__ __forceinline__ void gemm_phase(PG8_LAS unsigned char* lds, const Gemm g, const Sched& S, const Epi& E, const int tid) {
    const int wid = __builtin_amdgcn_readfirstlane(tid >> 6), lane = tid & 63, wr = wid >> 2, wc = wid & 3, fr = lane & 15, fq = lane >> 4;
    const int K = g.K, nt = K / BK;
    unsigned voffA[2], voffB[2];
#pragma unroll
    for (int i = 0; i < 2; ++i) { int R, C; stage_rc(tid * 16 + i * 8192, R, C); const int Rb = Epi::PERM ? ((R & ~31) + perm32(R & 31)) : R;
        voffA[i] = (unsigned)(R * K + C) * 2u; voffB[i] = (unsigned)(Rb * K + C) * 2u; }
    const size_t kstep = (size_t)(BK * 2);
    const size_t hstep = (size_t)HALF * K * 2;
    const size_t tstep = 2 * hstep;
    const unsigned ldsw = (unsigned)wid * 1024u;
    const int aoff = lds_byte(wr * 64 + fr, fq * 8), boff = lds_byte(wc * 32 + fr, fq * 8);
#define PG8_SA(b, h) (((b) * 2 + (h)) * HTB)
#define PG8_SB(b, h) ((4 + (b) * 2 + (h)) * HTB)
#define PG8_STAGE(bufoff, gbase, voff) do { _Pragma("unroll") for (int _i = 0; _i < 2; ++_i) \
        __builtin_amdgcn_global_load_lds((const unsigned*)((const char*)(gbase) + (voff)[_i]), (PG8_LAS unsigned*)(lds + (bufoff) + ldsw + _i * 8192), 16, 0, 0); } while (0)
#define PG8_LDA(dst, b, h) do { _Pragma("unroll") for (int m = 0; m < 4; ++m) _Pragma("unroll") for (int k = 0; k < 2; ++k) dst[m][k] = *(const PG8_LAS bf16x8*)(lds + PG8_SA(b, h) + aoff + m * 2048 + k * 1024); } while (0)
#define PG8_LDB(dst, b, h) do { _Pragma("unroll") for (int n = 0; n < 2; ++n) _Pragma("unroll") for (int k = 0; k < 2; ++k) dst[n][k] = *(const PG8_LAS bf16x8*)(lds + PG8_SB(b, h) + boff + n * 2048 + k * 1024); } while (0)
#define PG8_MMA(ai, bj, At, Bt) do { __builtin_amdgcn_s_setprio(1); _Pragma("unroll") for (int m = 0; m < 4; ++m) _Pragma("unroll") for (int n = 0; n < 2; ++n) _Pragma("unroll") for (int k = 0; k < 2; ++k) \
        acc[ai][bj][m][n] = __builtin_amdgcn_mfma_f32_16x16x32_bf16(Bt[n][k], At[m][k], acc[ai][bj][m][n], 0, 0, 0); __builtin_amdgcn_s_setprio(0); } while (0)
#define PG8_WAIT_V(n) asm volatile("s_waitcnt vmcnt(" #n ")" ::: "memory")
#define PG8_WAIT_L(n) asm volatile("s_waitcnt lgkmcnt(" #n ")" ::: "memory")
#define PG8_BAR __builtin_amdgcn_s_barrier()
#define PG8_SCHED __builtin_amdgcn_sched_barrier(0)
    Unit cur, nxt; int ui = 0;
    if (!S.next(0, cur)) return;
    f32x4 acc[2][2][4][2];
#pragma unroll
    for (int a = 0; a < 2; ++a)
#pragma unroll
        for (int b = 0; b < 2; ++b)
#pragma unroll
            for (int m = 0; m < 4; ++m)
#pragma unroll
                for (int n = 0; n < 2; ++n) acc[a][b][m][n] = (f32x4){0.f, 0.f, 0.f, 0.f};
    bf16x8 At[4][2], B0[2][2], B1[2][2];
    const char* cA = (const char*)g.A + (size_t)cur.pm * tstep; const char* cB = (const char*)g.Bt + (size_t)cur.pn * tstep;
    S.a_ready(cur);
    if constexpr (SP2) {
        PG8_STAGE(PG8_SB(0, 0), cB, voffB); PG8_STAGE(PG8_SB(0, 1), cB + hstep, voffB); PG8_STAGE(PG8_SA(0, 0), cA, voffA); PG8_STAGE(PG8_SA(0, 1), cA + hstep, voffA);
        if (wr == 1) PG8_BAR;
        PG8_WAIT_V(2); PG8_BAR;
        PG8_STAGE(PG8_SB(1, 0), cB + kstep, voffB); PG8_STAGE(PG8_SA(1, 0), cA + kstep, voffA); PG8_STAGE(PG8_SB(1, 1), cB + hstep + kstep, voffB);
        PG8_WAIT_V(6); PG8_BAR;
    } else {
        PG8_STAGE(PG8_SB(0, 0), cB, voffB); PG8_STAGE(PG8_SA(0, 0), cA, voffA); PG8_STAGE(PG8_SB(0, 1), cB + hstep, voffB); PG8_STAGE(PG8_SA(0, 1), cA + hstep, voffA);
        if (wr == 1) PG8_BAR;
        PG8_WAIT_V(4); PG8_BAR;
        PG8_STAGE(PG8_SB(1, 0), cB + kstep, voffB); PG8_STAGE(PG8_SA(1, 0), cA + kstep, voffA); PG8_STAGE(PG8_SB(1, 1), cB + hstep + kstep, voffB);
        PG8_WAIT_V(6); PG8_BAR;
    }
    for (;;) {
        const bool has_next = S.next(ui + 1, nxt);
        const char* nA = has_next ? (const char*)g.A + (size_t)nxt.pm * tstep : cA; const char* nB = has_next ? (const char*)g.Bt + (size_t)nxt.pn * tstep : cB;
        for (int t = 0; t < nt; t += 2) {
            const bool last = (t == nt - 2);
            const char* a1 = cA + (size_t)(t + 1) * kstep;
            const char* a2 = last ? nA : cA + (size_t)(t + 2) * kstep; const char* b2 = last ? nB : cB + (size_t)(t + 2) * kstep;
            const char* a3 = a2 + kstep; const char* b3 = b2 + kstep;
            if (last && has_next) S.a_ready(nxt);
            asm volatile("" : "+v"(voffA[0]), "+v"(voffA[1]), "+v"(voffB[0]), "+v"(voffB[1]));
            E.mid(acc, cur, wr, wc, t);
            if constexpr (SP2) {
            PG8_LDB(B0, 0, 0); PG8_LDB(B1, 0, 1); PG8_SCHED; PG8_LDA(At, 0, 0); PG8_STAGE(PG8_SA(1, 1), a1 + hstep, voffA);
            PG8_WAIT_V(8); PG8_WAIT_L(0); PG8_BAR; PG8_MMA(0, 0, At, B0); PG8_MMA(0, 1, At, B1); PG8_BAR; PG8_SCHED;
            PG8_LDA(At, 0, 1); PG8_STAGE(PG8_SB(0, 0), b2, voffB); PG8_STAGE(PG8_SB(0, 1), b2 + hstep, voffB); PG8_STAGE(PG8_SA(0, 0), a2, voffA);
            PG8_WAIT_V(8); PG8_WAIT_L(0); PG8_BAR; PG8_MMA(1, 0, At, B0); PG8_MMA(1, 1, At, B1); PG8_BAR; PG8_SCHED;
            PG8_LDB(B0, 1, 0); PG8_LDB(B1, 1, 1); PG8_SCHED; PG8_LDA(At, 1, 0); PG8_STAGE(PG8_SA(0, 1), a2 + hstep, voffA);
            PG8_WAIT_V(8); PG8_WAIT_L(0); PG8_BAR; PG8_MMA(0, 0, At, B0); PG8_MMA(0, 1, At, B1); PG8_BAR; PG8_SCHED;
            PG8_LDA(At, 1, 1); PG8_STAGE(PG8_SB(1, 0), b3, voffB); PG8_STAGE(PG8_SB(1, 1), b3 + hstep, voffB); PG8_STAGE(PG8_SA(1, 0), a3, voffA);
            PG8_WAIT_V(8); PG8_WAIT_L(0); PG8_BAR; PG8_MMA(1, 0, At, B0); PG8_MMA(1, 1, At, B1); PG8_BAR; PG8_SCHED;
            } else {
            PG8_LDB(B0, 0, 0); PG8_SCHED; PG8_LDA(At, 0, 0); PG8_STAGE(PG8_SA(1, 1), a1 + hstep, voffA);
            PG8_WAIT_L(8); PG8_BAR; PG8_WAIT_L(0); PG8_MMA(0, 0, At, B0); PG8_BAR; PG8_SCHED;
            PG8_LDB(B1, 0, 1); PG8_STAGE(PG8_SB(0, 0), b2, voffB);
            PG8_BAR; PG8_WAIT_L(0); PG8_MMA(0, 1, At, B1); PG8_BAR;
            PG8_LDA(At, 0, 1); PG8_STAGE(PG8_SA(0, 0), a2, voffA);
            PG8_BAR; PG8_WAIT_L(0); PG8_MMA(1, 0, At, B0); PG8_BAR; PG8_SCHED;
            PG8_STAGE(PG8_SB(0, 1), b2 + hstep, voffB);
            PG8_WAIT_V(6); PG8_BAR; PG8_MMA(1, 1, At, B1); PG8_BAR;
            PG8_LDB(B0, 1, 0); PG8_SCHED; PG8_LDA(At, 1, 0); PG8_STAGE(PG8_SA(0, 1), a2 + hstep, voffA);
            PG8_WAIT_L(8); PG8_BAR; PG8_WAIT_L(0); PG8_MMA(0, 0, At, B0); PG8_BAR; PG8_SCHED;
            PG8_LDB(B1, 1, 1); PG8_STAGE(PG8_SB(1, 0), b3, voffB);
            PG8_BAR; PG8_WAIT_L(0); PG8_MMA(0, 1, At, B1); PG8_BAR;
            PG8_LDA(At, 1, 1); PG8_STAGE(PG8_SA(1, 0), a3, voffA);
            PG8_BAR; PG8_WAIT_L(0); PG8_MMA(1, 0, At, B0); PG8_BAR; PG8_SCHED;
            PG8_STAGE(PG8_SB(1, 1), b3 + hstep, voffB);
            PG8_WAIT_V(6); PG8_BAR; PG8_MMA(1, 1, At, B1); PG8_BAR;
            }
        }
        if constexpr (ALIGN_EPI) { if (wr == 0) PG8_BAR; }
        if constexpr (!Epi::AFTER_DRAIN) { E(acc, cur, wr, wc, fr, fq); S.done(cur); }
        if (!has_next) break;
#pragma unroll
        for (int a = 0; a < 2; ++a)
#pragma unroll
            for (int b = 0; b < 2; ++b)
#pragma unroll
                for (int m = 0; m < 4; ++m)
#pragma unroll
                    for (int n = 0; n < 2; ++n) acc[a][b][m][n] = (f32x4){0.f, 0.f, 0.f, 0.f};
        cur = nxt; cA = nA; cB = nB; ++ui;
        if constexpr (ALIGN_EPI) { if (wr == 1) PG8_BAR; }
    }
    PG8_WAIT_V(0);
    if constexpr (!ALIGN_EPI) { if (wr == 0) PG8_BAR; }
    PG8_BAR;
    if constexpr (Epi::AFTER_DRAIN) { E.fused(acc, cur, wr, wc, fr, fq, lds, wid, lane); S.done(cur); }
#undef PG8_SA
#undef PG8_SB
#undef PG8_STAGE
#undef PG8_LDA
#undef PG8_LDB
#undef PG8_MMA
#undef PG8_WAIT_V
#undef PG8_WAIT_L
#undef PG8_BAR
#undef PG8_SCHED
}
}

typedef pg8::f32x4 f32x4;
typedef pg8::bf16x8 bf16x8;
typedef unsigned u32x2 __attribute__((ext_vector_type(2)));
typedef unsigned u32x4 __attribute__((ext_vector_type(4)));
#define LAS __attribute__((address_space(3)))

constexpr int NTHREADS = 512;
constexpr int RING_BYTES = 131072;
constexpr int MISC_OFF = RING_BYTES;
constexpr int LDS_BYTES = 147456;

typedef __bf16 bf16x2_t __attribute__((ext_vector_type(2)));
typedef float f32x2_t __attribute__((ext_vector_type(2)));
DEV unsigned pk2(float lo, float hi) {
  const f32x2_t v = {lo, hi};
  return __builtin_bit_cast(unsigned, __builtin_convertvector(v, bf16x2_t));
}
DEV unsigned short f2bfh(float x) { return (unsigned short)(pk2(x, 0.f) & 0xffffu); }
DEV float shx(float v, int lane, int o) { return __int_as_float(__builtin_amdgcn_ds_bpermute((lane ^ o) << 2, __float_as_int(v))); }
DEV int shxi(int v, int lane, int o) { return __builtin_amdgcn_ds_bpermute((lane ^ o) << 2, v); }
DEV float wave_sum(float v, int lane) {
#pragma unroll
  for (int o = 1; o < 64; o <<= 1)
    v += __int_as_float(__builtin_amdgcn_ds_bpermute((lane ^ o) << 2, __float_as_int(v)));
  return v;
}

DEV void transpose_item(const float* W, int ldw, int dld, act_t* WT, int k0, int n0, int drow0, LAS float* scr, int lane) {
  float wv[32];
#pragma unroll
  for (int i = 0; i < 32; ++i) wv[i] = W[(size_t)(k0 + 2 * i + (lane >> 5)) * ldw + n0 + (lane & 31)];
#pragma unroll
  for (int i = 0; i < 32; ++i) scr[(2 * i + (lane >> 5)) * 33 + (lane & 31)] = wv[i];
  asm volatile("s_waitcnt lgkmcnt(0)" ::: "memory");
  const int c = lane & 7;
#pragma unroll
  for (int j = 0; j < 4; ++j) {
    const int n = (lane >> 3) + 8 * j;
    const LAS float* s = scr + (8 * c) * 33 + n;
    u32x4 o;
    o.x = pk2(s[0 * 33], s[1 * 33]); o.y = pk2(s[2 * 33], s[3 * 33]);
    o.z = pk2(s[4 * 33], s[5 * 33]); o.w = pk2(s[6 * 33], s[7 * 33]);
    *(u32x4*)(WT + (size_t)(drow0 + n) * dld + k0 + 8 * c) = o;
  }
  asm volatile("s_waitcnt lgkmcnt(0)" ::: "memory");
}

struct ConvDesc { const float* W; act_t* dst; int nbatch, K, N, mode; size_t dstb; int dld; };
constexpr int NCONV = 13;
DEV ConvDesc conv_desc(const Params& p, int kind) {
  const size_t SQ = (size_t)1024 * 1024;
  switch (kind) {
    case 0: return ConvDesc{p.w_gu, p.wt_gu, 64, 1024, 2048, 1, (size_t)2048 * 1024, 1024};
    case 1: return ConvDesc{p.w_down, p.wt_dn, 64, 1024, 1024, 0, SQ, 1024};
    case 2: return ConvDesc{p.w_in, p.wt_in, 2, 1024, N_IN, 0, (size_t)N_IN_PAD * 1024, 1024};
    case 3: return ConvDesc{p.cmp_w1_k, p.wt_c1, 2, 2048, 128, 0, (size_t)2 * 256 * 2048, 2048};
    case 4: return ConvDesc{p.cmp_w1_v, p.wt_c1 + (size_t)256 * 2048, 2, 2048, 128, 0, (size_t)2 * 256 * 2048, 2048};
    case 5: return ConvDesc{p.w_br_a, p.wt_bra, 2, 256, 1024, 0, (size_t)1024 * YLD, YLD};
    case 6: return ConvDesc{p.w_br_b, p.wt_brb, 2, 1024, 1024, 0, (size_t)1024 * YLD, YLD};
    case 7: return ConvDesc{p.w_br_c, p.wt_brc, 2, 1024, 1024, 0, (size_t)1024 * YLD, YLD};
    case 8: return ConvDesc{p.w_o_mix, p.wt_omix, 2, 1024, 1024, 0, SQ, 1024};
    case 9: return ConvDesc{p.w_xq, p.wt_xq, 2, 1024, 1024, 0, SQ, 1024};
    case 10: return ConvDesc{p.w_xk, p.wt_xk, 2, 1024, 1024, 0, SQ, 1024};
    case 11: return ConvDesc{p.w_xv, p.wt_xv, 2, 1024, 1024, 0, SQ, 1024};
    default: return ConvDesc{p.w_xo, p.wt_xo, 2, 1024, 1024, 0, SQ, 1024};
  }
}
DEV int conv_items(int kind) {
  switch (kind) {
    case 0: return 64 * 16 * 64;
    case 1: return 64 * 16 * 32;
    case 2: return 2 * 16 * (N_IN / 32);
    case 3: case 4: return 2 * 32 * 4;
    case 5: return 2 * 4 * 32;
    default: return 2 * 16 * 32;
  }
}
DEV void conv_all(const Params& p, int gw, int NGW, LAS float* scr, int lane) {
  int base = 0;
  for (int kind = 0; kind < NCONV; ++kind) {
    const int total = conv_items(kind);
    const ConvDesc d = conv_desc(p, kind);
    const int nblk = d.N / 32, per = nblk * (d.K / 64);
    int first = (gw - base % NGW + NGW) % NGW;
    for (int it = first; it < total; it += NGW) {
      const int bt = it / per, r = it % per, kb = r / nblk, nb = r % nblk;
      const int n0 = nb * 32;
      int drow0 = n0;
      if (d.mode == 1) { const int j = n0 & 1023; drow0 = (j >> 7) * 256 + (j & 127) + ((n0 >= 1024) ? 128 : 0); }
      transpose_item(d.W + (size_t)bt * d.K * d.N, d.N, d.dld, d.dst + (size_t)bt * d.dstb, kb * 64, n0, drow0, scr, lane);
    }
    base += total;
  }
}

template <int MODE, bool SRC_BF16 = false>
DEV void ln_rows_w(const Params& p, const float* src, const float* g, const float* b, float* dstf, act_t* dstb, float* dst2,
                   int gw, int NGW, int lane) {
  for (int n0 = gw; n0 < N_TOK; n0 += 2 * NGW) {
    f32x4 v[2][4];
    float s[2] = {0.f, 0.f};
#pragma unroll
    for (int r = 0; r < 2; ++r) {
      const int n = (n0 + r * NGW < N_TOK) ? n0 + r * NGW : n0;
#pragma unroll
      for (int j = 0; j < 4; ++j) {
        if (MODE == 0) {
          if (SRC_BF16) {
            const u32x2 xw = ((const u32x2*)((const act_t*)src + (size_t)n * D))[lane + 64 * j];
            v[r][j] = (f32x4){__uint_as_float(xw.x << 16), __uint_as_float(xw.x & 0xffff0000u), __uint_as_float(xw.y << 16), __uint_as_float(xw.y & 0xffff0000u)};
          } else v[r][j] = ((const f32x4*)(src + (size_t)n * D))[lane + 64 * j];
        } else {
          f32x4 a = ((const f32x4*)(p.xf + (size_t)n * D))[lane + 64 * j] * ALPHA;
#pragma unroll
          for (int k = 0; k < 4; ++k) {
            const u32x2 yw = ((const u32x2*)((const act_t*)p.yass + ((size_t)n * 4 + k) * D))[lane + 64 * j];
            a.x += __uint_as_float(yw.x << 16); a.y += __uint_as_float(yw.x & 0xffff0000u);
            a.z += __uint_as_float(yw.y << 16); a.w += __uint_as_float(yw.y & 0xffff0000u);
          }
          v[r][j] = a;
        }
        s[r] += (v[r][j].x + v[r][j].y) + (v[r][j].z + v[r][j].w);
      }
    }
    float mean[2], s2[2] = {0.f, 0.f}, rstd[2];
#pragma unroll
    for (int o = 1; o < 64; o <<= 1) { s[0] += shx(s[0], lane, o); s[1] += shx(s[1], lane, o); }
#pragma unroll
    for (int r = 0; r < 2; ++r) {
      mean[r] = s[r] * (1.f / D);
#pragma unroll
      for (int j = 0; j < 4; ++j) { v[r][j] = v[r][j] - mean[r]; s2[r] += (v[r][j].x * v[r][j].x + v[r][j].y * v[r][j].y) + (v[r][j].z * v[r][j].z + v[r][j].w * v[r][j].w); }
    }
#pragma unroll
    for (int o = 1; o < 64; o <<= 1) { s2[0] += shx(s2[0], lane, o); s2[1] += shx(s2[1], lane, o); }
#pragma unroll
    for (int r = 0; r < 2; ++r) {
      rstd[r] = 1.f / sqrtf(s2[r] * (1.f / D) + LN_EPS);
      const int n = n0 + r * NGW;
      if (n < N_TOK) {
#pragma unroll
        for (int j = 0; j < 4; ++j) {
          const f32x4 gm = ((const f32x4*)g)[lane + 64 * j], bt = ((const f32x4*)b)[lane + 64 * j];
          const f32x4 y = v[r][j] * rstd[r] * gm + bt;
          ((f32x4*)(dstf + (size_t)n * D))[lane + 64 * j] = y;
          u32x2 w; w.x = pk2(y.x, y.y); w.y = pk2(y.z, y.w);
          ((u32x2*)(dstb + (size_t)n * D))[lane + 64 * j] = w;
          if (dst2) ((f32x4*)(dst2 + (size_t)n * D))[lane + 64 * j] = y;
        }
      }
    }
  }
}

DEV void prologue(const Params& p, LAS unsigned char* lds, int wave, int lane) {
  LAS float* scr = (LAS float*)(lds + wave * 16384);
  const int gw = blockIdx.x * 8 + wave, NGW = gridDim.x * 8;
  conv_all(p, gw, NGW, scr, lane);
  const long long tid = (long long)blockIdx.x * NTHREADS + threadIdx.x, nthr = (long long)gridDim.x * NTHREADS;
  {
    const long long padw = (long long)(N_IN_PAD - N_IN) * 1024 / 8;
    for (long long i = tid; i < 2 * padw; i += nthr) {
      const int li = (int)(i / padw); const long long r = i % padw;
      ((u32x4*)(p.wt_in + ((size_t)li * N_IN_PAD + N_IN) * 1024))[r] = (u32x4){0u, 0u, 0u, 0u};
    }
    const long long padc = (long long)128 * 2048 / 8;
    for (long long i = tid; i < 4 * padc; i += nthr) {
      const int q = (int)(i / padc); const long long r = i % padc;
      ((u32x4*)(p.wt_c1 + ((size_t)q * 256 + 128) * 2048))[r] = (u32x4){0u, 0u, 0u, 0u};
    }
    if (tid < 64) p.cnt[tid] = 0;
    for (long long i = tid; i < 2LL * BATCH * NSA_G * 64; i += nthr) {
      const long long wb = i / (NSA_G * 64), r = i % (NSA_G * 64);
      p.kcb[(wb * 128 + 127) * NSA_G * 64 + r] = 0;
    }
    for (long long i = tid; i < (long long)BATCH * MEM_LEN * 1024 / 4; i += nthr) {
      const f32x4 v = ((const f32x4*)p.mem)[i];
      u32x2 w; w.x = pk2(v.x, v.y); w.y = pk2(v.z, v.w);
      ((u32x2*)p.membf)[i] = w;
    }
  }
  ln_rows_w<0>(p, p.x, p.ln0_g, p.ln0_b, p.xf, p.xb, nullptr, gw, NGW, lane);
}

struct USched {
  int nM, nN, nwg, G, c;
  int moe, nct, total; const LAS int* tile_e;
  DEV void init_static(int M, int N, int G_, int c_) { nM = M / 256; nN = N / 256; nwg = nM * nN; G = G_; c = c_; moe = 0; nct = 1; total = nwg; tile_e = nullptr; }
  DEV void init_moe(int G_, int c_, int nct_, int total_, const LAS int* te) { nM = 1; nN = 1; nwg = total_; G = G_; c = c_; moe = 1; nct = nct_; total = total_; tile_e = te; }
  DEV bool next(int i, pg8::Unit& u) const {
    const long L = (long)i * G + c;
    if (!(moe && (G & 7) == 0) && L >= total) return false;
    if (moe) {
      if ((G & 7) == 0) {
        const int xcd = c & 7, rank = c >> 3, nr = G >> 3, T = total / nct;
        const int tlo = (T * xcd) >> 3, thi = (T * (xcd + 1)) >> 3;
        const int lu = i * nr + rank;
        if (lu >= (thi - tlo) * nct) return false;
        const int rt = tlo + lu / nct, j = lu % nct;
        u.pm = rt; u.pn = tile_e[rt] * nct + j; return true;
      }
      const int rt = (int)(L / nct), j = (int)(L % nct); u.pm = rt; u.pn = tile_e[rt] * nct + j; return true;
    }
    int wgid = (int)L; { const int q = nwg / 8, r = nwg % 8, xcd = wgid % 8, off = wgid / 8; wgid = (xcd < r ? xcd * (q + 1) : r * (q + 1) + (xcd - r) * q) + off; }
    const int nig = 8 * nN, gid = wgid / nig, fm = gid * 8, gsz = (nM - fm) < 8 ? (nM - fm) : 8;
    u.pm = fm + ((wgid % nig) % gsz); u.pn = (wgid % nig) / gsz; return true;
  }
  DEV void a_ready(const pg8::Unit&) const {}
  DEV void done(const pg8::Unit&) const {}
};

enum { EM_INPROJ = 0, EM_BRCAT, EM_RES, EM_BF16, EM_MOE1, EM_MOE2, EM_HID };
#define EPI_FENCE() asm volatile("" ::: "memory")
struct EpiU {
  static constexpr bool PERM = false, AFTER_DRAIN = false;
  int mode, ldc;
  void* q0;
  const void* q1;
  const void* q2;
  const void* q3;
  const LAS int* te;
  DEV void mid(f32x4 (&acc)[2][2][4][2], const pg8::Unit& un, int wr, int wc, int t) const {
    if (mode != EM_BRCAT || (t != 4 && t != 20)) return;
    const act_t* ub = (const act_t*)q1;
    int l2;
    asm volatile("v_mbcnt_lo_u32_b32 %0, -1, 0\n\tv_mbcnt_hi_u32_b32 %0, -1, %0" : "=v"(l2));
    const int fr = l2 & 15, fq = l2 >> 4;
    const int row0 = un.pm * 256 + wr * 64 + fr, col0 = un.pn * 256 + wc * 32 + 4 * fq;
    const int goff = OFF_MG + (t == 4 ? 0 : D);
    const float L2E = -1.4426950408889634f;
#pragma unroll
    for (int ai = 0; ai < 2; ++ai)
#pragma unroll
      for (int m = 0; m < 4; ++m) {
        const int row = row0 + ai * 128 + m * 16;
#pragma unroll
        for (int bj = 0; bj < 2; ++bj)
#pragma unroll
          for (int n = 0; n < 2; ++n) {
            const int col = col0 + bj * 128 + n * 16;
            const act_t* gp = ub + (size_t)row * N_IN + goff + col;
            const u32x2 ga = *(const u32x2*)gp, gb = *(const u32x2*)(gp + D);
            const float ea0 = __builtin_amdgcn_exp2f(__uint_as_float(ga.x << 16) * L2E), ea1 = __builtin_amdgcn_exp2f(__uint_as_float(ga.x & 0xffff0000u) * L2E);
            const float ea2 = __builtin_amdgcn_exp2f(__uint_as_float(ga.y << 16) * L2E), ea3 = __builtin_amdgcn_exp2f(__uint_as_float(ga.y & 0xffff0000u) * L2E);
            const float eb0 = __builtin_amdgcn_exp2f(__uint_as_float(gb.x << 16) * L2E), eb1 = __builtin_amdgcn_exp2f(__uint_as_float(gb.x & 0xffff0000u) * L2E);
            const float eb2 = __builtin_amdgcn_exp2f(__uint_as_float(gb.y << 16) * L2E), eb3 = __builtin_amdgcn_exp2f(__uint_as_float(gb.y & 0xffff0000u) * L2E);
            f32x4& v = acc[ai][bj][m][n];
            v.x *= (1.0f + eb0) * __builtin_amdgcn_rcpf(1.0f + ea0); v.y *= (1.0f + eb1) * __builtin_amdgcn_rcpf(1.0f + ea1);
            v.z *= (1.0f + eb2) * __builtin_amdgcn_rcpf(1.0f + ea2); v.w *= (1.0f + eb3) * __builtin_amdgcn_rcpf(1.0f + ea3);
          }
        if (m == 3) EPI_FENCE();
      }
  }
  DEV void operator()(const f32x4 (&acc)[2][2][4][2], const pg8::Unit& un, int wr, int wc, int fr, int fq) const {
    {
      int l2;
      asm volatile("v_mbcnt_lo_u32_b32 %0, -1, 0\n\tv_mbcnt_hi_u32_b32 %0, -1, %0" : "=v"(l2));
      fr = l2 & 15; fq = l2 >> 4;
    }
    const int row0 = un.pm * 256 + wr * 64 + fr;
    act_t* const ob = (act_t*)q0; float* const of = (float*)q0;
    const float* const f0 = (const float*)q1; const act_t* const ub = (const act_t*)q1;
    const float* const f1 = (const float*)q2; const int* const il = (const int*)q3;
    if (mode == EM_INPROJ) {
      const int col0 = un.pn * 256 + wc * 32 + 4 * fq;
      f32x4 bv[2][2];
#pragma unroll
      for (int bj = 0; bj < 2; ++bj)
#pragma unroll
        for (int n = 0; n < 2; ++n) { const int col = col0 + bj * 128 + n * 16; bv[bj][n] = col < N_IN ? *(const f32x4*)(f0 + col) : (f32x4){0.f, 0.f, 0.f, 0.f}; }
#pragma unroll
      for (int ai = 0; ai < 2; ++ai)
#pragma unroll
        for (int m = 0; m < 4; ++m) {
          const int row = row0 + ai * 128 + m * 16;
#pragma unroll
          for (int bj = 0; bj < 2; ++bj)
#pragma unroll
            for (int n = 0; n < 2; ++n) {
              const int col = col0 + bj * 128 + n * 16;
              if (col < N_IN) {
                const f32x4 v = acc[ai][bj][m][n] + bv[bj][n];
                u32x2 w; w.x = pk2(v.x, v.y); w.y = pk2(v.z, v.w);
                *(u32x2*)(ob + (size_t)row * N_IN + col) = w;
              }
            }
        }
    } else if (mode == EM_BRCAT) {
      const int col0 = un.pn * 256 + wc * 32 + 4 * fq;
#pragma unroll
      for (int ai = 0; ai < 2; ++ai)
#pragma unroll
        for (int m = 0; m < 4; ++m) {
          const int row = row0 + ai * 128 + m * 16;
#pragma unroll
          for (int bj = 0; bj < 2; ++bj)
#pragma unroll
            for (int n = 0; n < 2; ++n) {
              const int col = col0 + bj * 128 + n * 16;
              const u32x2 gw = *(const u32x2*)(ub + (size_t)row * N_IN + OFF_MG + 2 * D + col);
              f32x4 v = acc[ai][bj][m][n];
              v.x *= sigmoidf_(__uint_as_float(gw.x << 16)); v.y *= sigmoidf_(__uint_as_float(gw.x & 0xffff0000u));
              v.z *= sigmoidf_(__uint_as_float(gw.y << 16)); v.w *= sigmoidf_(__uint_as_float(gw.y & 0xffff0000u));
              u32x2 w; w.x = pk2(v.x, v.y); w.y = pk2(v.z, v.w);
              *(u32x2*)(ob + (size_t)row * D + col) = w;
            }
          if (m == 3) EPI_FENCE();
        }
    } else if (mode == EM_RES) {
      const int col0 = un.pn * 256 + wc * 32 + 4 * fq;
#pragma unroll
      for (int ai = 0; ai < 2; ++ai)
#pragma unroll
        for (int m = 0; m < 4; ++m) {
          const int row = row0 + ai * 128 + m * 16;
#pragma unroll
          for (int bj = 0; bj < 2; ++bj)
#pragma unroll
            for (int n = 0; n < 2; ++n) {
              const int col = col0 + bj * 128 + n * 16;
              const f32x4 x = *(const f32x4*)(f0 + (size_t)row * D + col);
              *(f32x4*)(of + (size_t)row * D + col) = x * ALPHA + acc[ai][bj][m][n];
            }
          if (m == 3) EPI_FENCE();
        }
    } else if (mode == EM_BF16) {
      const int col0 = un.pn * 256 + wc * 32 + 4 * fq;
#pragma unroll
      for (int ai = 0; ai < 2; ++ai)
#pragma unroll
        for (int m = 0; m < 4; ++m) {
          const int row = row0 + ai * 128 + m * 16;
#pragma unroll
          for (int bj = 0; bj < 2; ++bj)
#pragma unroll
            for (int n = 0; n < 2; ++n) {
              const int col = col0 + bj * 128 + n * 16;
              const f32x4 v = acc[ai][bj][m][n];
              u32x2 w; w.x = pk2(v.x, v.y); w.y = pk2(v.z, v.w);
              *(u32x2*)(ob + (size_t)row * ldc + col) = w;
            }
          EPI_FENCE();
        }
    } else if (mode == EM_MOE1) {
      const int e = te[un.pm], j = un.pn & 7;
#pragma unroll
      for (int n = 0; n < 2; ++n) {
        const int cj = j * 128 + wc * 32 + n * 16 + 4 * fq;
        const f32x4 bg = *(const f32x4*)(f0 + (size_t)e * 2048 + cj), bu = *(const f32x4*)(f0 + (size_t)e * 2048 + 1024 + cj);
#pragma unroll
        for (int ai = 0; ai < 2; ++ai)
#pragma unroll
          for (int m = 0; m < 4; ++m) {
            const int row = row0 + ai * 128 + m * 16;
            const f32x4 g = acc[ai][0][m][n] + bg, u = acc[ai][1][m][n] + bu;
            float o[4];
#pragma unroll
            for (int i = 0; i < 4; ++i) {
              const float gt = fminf(g[i], 7.0f), up = fminf(fmaxf(u[i], -7.0f), 7.0f);
              o[i] = (up + 1.0f) * gt * sigmoidf_(1.702f * gt);
            }
            u32x2 w; w.x = pk2(o[0], o[1]); w.y = pk2(o[2], o[3]);
            *(u32x2*)(ob + (size_t)row * 1024 + cj) = w;
          }
        EPI_FENCE();
      }
    } else if (mode == EM_MOE2) {
      const int e = te[un.pm], j = un.pn & 3;
      const int col0 = j * 256 + wc * 32 + 4 * fq;
      int aidv[8]; float gtv[8]; f32x4 bv[2][2];
#pragma unroll
      for (int bj = 0; bj < 2; ++bj)
#pragma unroll
        for (int n = 0; n < 2; ++n) bv[bj][n] = *(const f32x4*)(f0 + (size_t)e * 1024 + col0 + bj * 128 + n * 16);
#pragma unroll
      for (int r = 0; r < 8; ++r) aidv[r] = il[row0 + (r >> 2) * 128 + (r & 3) * 16];
#pragma unroll
      for (int r = 0; r < 8; ++r) gtv[r] = f1[aidv[r] >= 0 ? aidv[r] : 0];
#pragma unroll
      for (int r = 0; r < 8; ++r) {
        const int ai = r >> 2, m = r & 3;
        if (aidv[r] >= 0) {
#pragma unroll
          for (int bj = 0; bj < 2; ++bj)
#pragma unroll
            for (int n = 0; n < 2; ++n) {
              const int col = col0 + bj * 128 + n * 16;
              const f32x4 v = (acc[ai][bj][m][n] + bv[bj][n]) * gtv[r];
              u32x2 w; w.x = pk2(v.x, v.y); w.y = pk2(v.z, v.w);
              *(u32x2*)(ob + (size_t)aidv[r] * 1024 + col) = w;
            }
        }
      }
    } else if (mode == EM_HID) {
      const int col0 = wc * 32 + 4 * fq;
#pragma unroll
      for (int ai = 0; ai < 2; ++ai)
#pragma unroll
        for (int m = 0; m < 4; ++m) {
          const int row = row0 + ai * 128 + m * 16;
          if (row < CMP_ROWS) {
#pragma unroll
            for (int n = 0; n < 2; ++n) {
              const f32x4 a = acc[ai][0][m][n];
              f32x4 v; v.x = gelu_tanh(a.x); v.y = gelu_tanh(a.y); v.z = gelu_tanh(a.z); v.w = gelu_tanh(a.w);
              *(f32x4*)(of + (size_t)row * CMP_HID + col0 + n * 16) = v;
            }
          }
          EPI_FENCE();
        }
    }
  }
};

DEV int moe_tables(const Params& p, int li, LAS int* tab, int t32) {
  __syncthreads();
  if (t32 == 0) {
    int t = 0;
    for (int e = 0; e < NE; ++e) {
      const int c = p.cnt[li * 32 + e];
      tab[e] = t * 256; tab[32 + e] = c;
      const int nt = (c + 255) >> 8;
#pragma clang loop vectorize(disable) unroll(disable)
      for (int k = 0; k < nt; ++k) tab[128 + t + k] = e;
      t += nt;
    }
    tab[64] = t;
  }
  __syncthreads();
  return tab[64];
}

DEV void moe_prep(const Params& p, int li, LAS int* tab, int wave, int lane, int t32) {
  const int ntiles = moe_tables(p, li, tab, t32);
  const int gw = blockIdx.x * 8 + wave, NGW = gridDim.x * 8;
  for (int tk0 = gw; tk0 < N_TOK; tk0 += 4 * NGW) {
    u32x4 v0[4], v1[4]; int rowi[4][4];
#pragma unroll
    for (int q = 0; q < 4; ++q) {
      const int tk = (tk0 + q * NGW < N_TOK) ? tk0 + q * NGW : tk0;
      const u32x4* src = (const u32x4*)(p.xb + (size_t)tk * 1024);
      v0[q] = src[lane]; v1[q] = src[lane + 64];
#pragma unroll
      for (int k = 0; k < 4; ++k) rowi[q][k] = tab[p.topi[tk * 4 + k]] + p.rank[tk * 4 + k];
    }
#pragma unroll
    for (int q = 0; q < 4; ++q) {
      const int tk = tk0 + q * NGW;
      if (tk < N_TOK) {
#pragma unroll
        for (int k = 0; k < 4; ++k) {
          if (lane == 0) p.rowlist[rowi[q][k]] = tk * 4 + k;
          u32x4* dst = (u32x4*)(p.xg + (size_t)rowi[q][k] * 1024);
          dst[lane] = v0[q]; dst[lane + 64] = v1[q];
        }
      }
    }
  }
  const long long tid = (long long)blockIdx.x * NTHREADS + t32, nthr = (long long)gridDim.x * NTHREADS;
  for (long long r = tid; r < (long long)ntiles * 256; r += nthr) {
    const int e = tab[128 + (int)(r >> 8)];
    if ((int)r - tab[e] >= tab[32 + e]) p.rowlist[r] = -1;
  }
}

typedef short v4i16_t __attribute__((ext_vector_type(4)));
DEV v4i16_t tr_read(const LAS unsigned char* p) { return __builtin_amdgcn_ds_read_tr16_b64_v4i16((LAS v4i16_t*)p); }

constexpr int AT_ROWB = 144;
constexpr int AT_TILEB = 64 * AT_ROWB;
constexpr int AT_HALF_KV = 4 * AT_TILEB;
constexpr int AT_SLAB_OFF = 2 * AT_HALF_KV;
constexpr int AT_SLAB_WAVE = 32 * 33 * 4;
constexpr int AT_SLAB_HALF = 4 * AT_SLAB_WAVE;
constexpr int AT_XCH_OFF = AT_SLAB_OFF + 2 * AT_SLAB_HALF;
static_assert(AT_XCH_OFF + 16 <= RING_BYTES, "attention LDS map");
constexpr float SC2 = 0.125f * 1.4426950408889634f;

struct AttnState { f32x4 O[2][4]; float m[2], l[2]; };

template <bool PROB, class Job>
DEV void attn_tile(const Job& job, const LAS unsigned char* Kb, const LAS unsigned char* Vb, const bf16x8 (&qf)[2][2], AttnState& st,
                   LAS float* slab, int cur, int wih, int lane) {
  const int i15 = lane & 15, g4 = lane >> 4;
  f32x4 S[2][4];
#pragma unroll
  for (int sub = 0; sub < 2; ++sub)
#pragma unroll
    for (int t = 0; t < 4; ++t) S[sub][t] = (f32x4){0.f, 0.f, 0.f, 0.f};
#pragma unroll
  for (int t = 0; t < 4; ++t)
#pragma unroll
    for (int kk = 0; kk < 2; ++kk) {
      const bf16x8 kf = *(const LAS bf16x8*)(Kb + (16 * t + i15) * AT_ROWB + (kk * 32 + 8 * g4) * 2);
#pragma unroll
      for (int sub = 0; sub < 2; ++sub) S[sub][t] = __builtin_amdgcn_mfma_f32_16x16x32_bf16(kf, qf[sub][kk], S[sub][t], 0, 0, 0);
    }
  bf16x8 pf[2][2];
  const bool efree = job.elemfree(cur, wih);
#pragma unroll
  for (int sub = 0; sub < 2; ++sub) {
    const int row = wih * 32 + sub * 16 + i15;
    if (!efree) {
      const int mbv = job.mb(row, cur, g4);
#pragma unroll
      for (int t = 0; t < 4; ++t)
#pragma unroll
        for (int j = 0; j < 4; ++j) S[sub][t][j] = job.ok(mbv, 16 * t + j) ? S[sub][t][j] : -INFINITY;
    }
    float mx = fmaxf(fmaxf(S[sub][0][0], S[sub][0][1]), fmaxf(S[sub][0][2], S[sub][0][3]));
#pragma unroll
    for (int t = 1; t < 4; ++t) mx = fmaxf(fmaxf(mx, fmaxf(S[sub][t][0], S[sub][t][1])), fmaxf(S[sub][t][2], S[sub][t][3]));
    if (!PROB) {
      mx = fmaxf(mx, shx(mx, lane, 16));
      mx = fmaxf(mx, shx(mx, lane, 32));
      const bool rok = job.rowok(sub, cur);
      const float mcand = rok ? mx * SC2 : -INFINITY;
      const float mnew = fmaxf(st.m[sub], mcand);
      const float msafe = (mnew == -INFINITY) ? 0.f : mnew;
      const float corr = __builtin_amdgcn_exp2f(st.m[sub] - msafe);
      st.m[sub] = mnew;
      const float msub = rok ? msafe : INFINITY;
      float psum = 0.f;
#pragma unroll
      for (int t = 0; t < 4; ++t)
#pragma unroll
        for (int j = 0; j < 4; ++j) { const float pp = __builtin_amdgcn_exp2f(__builtin_fmaf(S[sub][t][j], SC2, -msub)); S[sub][t][j] = pp; psum += pp; }
      st.l[sub] = st.l[sub] * corr + psum;
      if (__builtin_amdgcn_ballot_w64(corr != 1.0f) != 0ull) {
#pragma unroll
        for (int dt = 0; dt < 4; ++dt) st.O[sub][dt] *= corr;
      }
#pragma unroll
      for (int s2 = 0; s2 < 2; ++s2) {
        u32x4 w;
        w.x = pk2(S[sub][2 * s2][0], S[sub][2 * s2][1]); w.y = pk2(S[sub][2 * s2][2], S[sub][2 * s2][3]);
        w.z = pk2(S[sub][2 * s2 + 1][0], S[sub][2 * s2 + 1][1]); w.w = pk2(S[sub][2 * s2 + 1][2], S[sub][2 * s2 + 1][3]);
        pf[sub][s2] = __builtin_bit_cast(bf16x8, w);
      }
    } else {
      const float msafe = (st.m[sub] == -INFINITY) ? 0.f : st.m[sub];
      const int q = sub * 16 + i15;
#pragma unroll
      for (int t = 0; t < 4; ++t) {
        const float p0 = __builtin_amdgcn_exp2f(__builtin_fmaf(S[sub][t][0], SC2, -msafe)) * st.l[sub], p1 = __builtin_amdgcn_exp2f(__builtin_fmaf(S[sub][t][1], SC2, -msafe)) * st.l[sub];
        const float p2 = __builtin_amdgcn_exp2f(__builtin_fmaf(S[sub][t][2], SC2, -msafe)) * st.l[sub], p3 = __builtin_amdgcn_exp2f(__builtin_fmaf(S[sub][t][3], SC2, -msafe)) * st.l[sub];
        const int jb = 16 * cur + 4 * t + g4;
        slab[q * 33 + jb] += (p0 + p1) + (p2 + p3);
        S[sub][t][3] = p3;
      }
      asm volatile("s_waitcnt lgkmcnt(0)" ::: "memory");
#pragma unroll
      for (int t = 0; t < 4; ++t) {
        const int jb = 16 * cur + 4 * t + g4 + 1;
        if (jb < 32) slab[q * 33 + jb] += S[sub][t][3];
      }
      asm volatile("s_waitcnt lgkmcnt(0)" ::: "memory");
    }
  }
  if (!PROB) {
#pragma unroll
    for (int dt = 0; dt < 4; ++dt)
#pragma unroll
      for (int s2 = 0; s2 < 2; ++s2) {
        const LAS unsigned char* vp = Vb + (32 * s2 + 4 * g4 + (i15 >> 2)) * AT_ROWB + (16 * dt + 4 * (lane & 3)) * 2;
        const v4i16_t lo = tr_read(vp), hi = tr_read(vp + 16 * AT_ROWB);
        bf16x8 vf;
        vf[0] = lo[0]; vf[1] = lo[1]; vf[2] = lo[2]; vf[3] = lo[3]; vf[4] = hi[0]; vf[5] = hi[1]; vf[6] = hi[2]; vf[7] = hi[3];
#pragma unroll
        for (int sub = 0; sub < 2; ++sub) st.O[sub][dt] = __builtin_amdgcn_mfma_f32_16x16x32_bf16(vf, pf[sub][s2], st.O[sub][dt], 0, 0, 0);
      }
  }
}

DEV void half_barrier(LAS unsigned* cnt, int lane) {
  asm volatile("s_waitcnt lgkmcnt(0)" ::: "memory");
  unsigned old = 0;
  if (lane == 0) old = __hip_atomic_fetch_add(cnt, 1u, __ATOMIC_RELAXED, __HIP_MEMORY_SCOPE_WORKGROUP);
  old = (unsigned)__builtin_amdgcn_readfirstlane((int)old);
  const unsigned target = (old / 4u + 1u) * 4u;
  while ((int)(__hip_atomic_load(cnt, __ATOMIC_RELAXED, __HIP_MEMORY_SCOPE_WORKGROUP) - target) < 0) __builtin_amdgcn_s_sleep(1);
  asm volatile("" ::: "memory");
}

template <bool PROB, class Job>
DEV void attn_run(const Job& job, LAS unsigned char* lds, AttnState& st, int half, int hth, int wih, int lane) {
  LAS unsigned char* kvh = lds + half * AT_HALF_KV;
  LAS unsigned* hb = (LAS unsigned*)(lds + MISC_OFF + 8192 + 128) + half * 16;
  LAS float* slab = (LAS float*)(lds + AT_SLAB_OFF + half * AT_SLAB_HALF + wih * AT_SLAB_WAVE);
  const int i15 = lane & 15, g4 = lane >> 4;
  unsigned rem = job.tilemask();
  bf16x8 qf[2][2];
#pragma unroll
  for (int sub = 0; sub < 2; ++sub) {
    const act_t* qr = job.qrow(wih * 32 + sub * 16 + i15);
#pragma unroll
    for (int kk = 0; kk < 2; ++kk) qf[sub][kk] = *(const bf16x8*)(qr + kk * 32 + 8 * g4);
  }
  if (!PROB) {
#pragma unroll
    for (int sub = 0; sub < 2; ++sub) {
      st.m[sub] = -INFINITY; st.l[sub] = 0.f;
#pragma unroll
      for (int dt = 0; dt < 4; ++dt) st.O[sub][dt] = (f32x4){0.f, 0.f, 0.f, 0.f};
    }
  }
  const int srow = hth >> 2, sch = hth & 3;
  u32x4 ak0, ak1, av0, av1;
#define AT_LOAD(k0, k1, v0, v1, T) do { const act_t* kr_ = job.krow(T, srow) + sch * 16; k0 = *(const u32x4*)kr_; k1 = *(const u32x4*)(kr_ + 8); \
    if (!PROB) { const act_t* vr_ = job.vrow(T, srow) + sch * 16; v0 = *(const u32x4*)vr_; v1 = *(const u32x4*)(vr_ + 8); } } while (0)
#define AT_WRITE(k0, k1, v0, v1, BUF) do { LAS unsigned char* kd_ = kvh + (BUF) * AT_TILEB + srow * AT_ROWB + sch * 32; *(LAS u32x4*)kd_ = k0; *(LAS u32x4*)(kd_ + 16) = k1; \
    if (!PROB) { LAS unsigned char* vd_ = kvh + (2 + (BUF)) * AT_TILEB + srow * AT_ROWB + sch * 32; *(LAS u32x4*)vd_ = v0; *(LAS u32x4*)(vd_ + 16) = v1; } } while (0)
#define AT_NEXT(T) do { T = -1; if (rem) { T = __builtin_ctz(rem); rem &= rem - 1; } } while (0)
  int t0;
  AT_NEXT(t0);
  if (t0 >= 0) { AT_LOAD(ak0, ak1, av0, av1, t0); AT_WRITE(ak0, ak1, av0, av1, 0); }
  half_barrier(hb, lane);
  for (int it = 0; t0 >= 0; ++it) {
    int t1;
    AT_NEXT(t1);
    if (t1 >= 0) AT_LOAD(ak0, ak1, av0, av1, t1);
    attn_tile<PROB>(job, kvh + (it & 1) * AT_TILEB, kvh + (2 + (it & 1)) * AT_TILEB, qf, st, slab, t0, wih, lane);
    if (t1 >= 0) AT_WRITE(ak0, ak1, av0, av1, (it + 1) & 1);
    half_barrier(hb, lane);
    t0 = t1;
  }
#undef AT_LOAD
#undef AT_WRITE
#undef AT_NEXT
  if (!PROB) {
#pragma unroll
    for (int sub = 0; sub < 2; ++sub) {
      float l = st.l[sub];
      l += shx(l, lane, 16);
      l += shx(l, lane, 32);
      const float inv = 1.0f / fmaxf(l, 1e-30f);
      st.l[sub] = l;
#pragma unroll
      for (int dt = 0; dt < 4; ++dt) st.O[sub][dt] *= inv;
    }
  }
}

struct SelJob {
  const act_t* u; int b, g, t0; unsigned um; unsigned tm[2];
  DEV unsigned tilemask() const { return um; }
  DEV const act_t* qrow(int r) const { return u + ((size_t)b * SEQ + t0 + (r & 31)) * N_IN + OFF_CQ + (g * 4 + (r >> 5)) * 64; }
  DEV const act_t* krow(int kt, int j) const { return u + ((size_t)b * SEQ + kt * 64 + j) * N_IN + OFF_CKS + g * 64; }
  DEV const act_t* vrow(int kt, int j) const { return u + ((size_t)b * SEQ + kt * 64 + j) * N_IN + OFF_CVS + g * 64; }
  DEV int mb(int r, int kt, int g4) const { return t0 + (r & 31) - kt * 64 - 4 * g4; }
  DEV bool rowok(int sub, int kt) const { return (tm[sub] >> kt) & 1u; }
  DEV bool ok(int m, int C) const { return m >= C; }
  DEV bool elemfree(int kt, int wih) const { return kt < (t0 >> 6); }
};
struct WinJob {
  const act_t* u; int b, g, t0; unsigned um;
  DEV unsigned tilemask() const { return um; }
  DEV const act_t* qrow(int r) const { return u + ((size_t)b * SEQ + t0 + (r & 31)) * N_IN + OFF_CQ + (g * 4 + (r >> 5)) * 64; }
  DEV const act_t* krow(int kt, int j) const { return u + ((size_t)b * SEQ + kt * 64 + j) * N_IN + OFF_CKW + g * 64; }
  DEV const act_t* vrow(int kt, int j) const { return u + ((size_t)b * SEQ + kt * 64 + j) * N_IN + OFF_CVW + g * 64; }
  DEV int mb(int r, int kt, int g4) const { return t0 + (r & 31) - kt * 64 - 4 * g4; }
  DEV bool rowok(int sub, int kt) const { return true; }
  DEV bool ok(int m, int C) const { return m >= C && m < NSA_WIN + C; }
  DEV bool elemfree(int kt, int wih) const { return kt * 64 + 63 <= t0 && t0 + 31 - kt * 64 < NSA_WIN; }
};
struct CmpJob {
  const act_t* u; const act_t* kcb; const act_t* vcb; int b, g, t0; unsigned um;
  DEV unsigned tilemask() const { return um; }
  DEV const act_t* qrow(int r) const { return u + ((size_t)b * SEQ + t0 + (r & 31)) * N_IN + OFF_CQ + (g * 4 + (r >> 5)) * 64; }
  DEV const act_t* krow(int kt, int j) const { return kcb + (((size_t)b * 128 + kt * 64 + j) * NSA_G + g) * 64; }
  DEV const act_t* vrow(int kt, int j) const { return vcb + (((size_t)b * 128 + kt * 64 + j) * NSA_G + g) * 64; }
  DEV int mb(int r, int kt, int g4) const { return t0 + (r & 31) - 31 - 16 * (kt * 64 + 4 * g4); }
  DEV bool rowok(int sub, int kt) const { return true; }
  DEV bool ok(int m, int C) const { return m >= 16 * C; }
  DEV bool elemfree(int kt, int wih) const { return kt == 0 && 16 * 63 + 31 <= t0; }
};
struct DilJob {
  const act_t* u; int b, col, dil, res, l0; unsigned um;
  DEV unsigned tilemask() const { return um; }
  DEV const act_t* qrow(int r) const { return u + ((size_t)b * SEQ + (l0 + r) * dil + res) * N_IN + OFF_AQ + col; }
  DEV const act_t* krow(int kt, int j) const { return u + ((size_t)b * SEQ + (kt * 64 + j) * dil + res) * N_IN + OFF_AK + col; }
  DEV const act_t* vrow(int kt, int j) const { return u + ((size_t)b * SEQ + (kt * 64 + j) * dil + res) * N_IN + OFF_AV + col; }
  DEV int mb(int r, int kt, int g4) const { return l0 + r - kt * 64 - 4 * g4; }
  DEV bool rowok(int sub, int kt) const { return true; }
  DEV bool ok(int m, int C) const { return m >= C && m <= 128 + C; }
  DEV bool elemfree(int kt, int wih) const { return kt * 64 + 63 <= l0 + 32 * wih && l0 + 32 * wih + 31 - kt * 64 <= 128; }
};

DEV unsigned range_mask(int lo, int hi) {
  return (hi >= 31 ? 0xffffffffu : ((1u << (hi + 1)) - 1u)) & ~((1u << lo) - 1u);
}

DEV bool nsa_unit(int round, int bid, int G, int half, int& b, int& g, int& tb) {
  if ((G & 7) == 0) {
    const int nr = G >> 3, rank = bid >> 3;
    const int slot = rank * 2 + half, nslot = nr * 2;
    const int pos = (round & 1) ? (nslot - 1 - slot) : slot;
    const int lu = round * nslot + pos;
    if (lu >= 256) return false;
    b = bid & 7; g = lu & 3; tb = 63 - (lu >> 2);
    return true;
  }
  const int pos = (round & 1) ? (G - 1 - bid) : bid;
  const int pair = round * G + pos;
  if (pair >= 1024) return false;
  const int un = pair * 2 + half;
  tb = 63 - un / 32; b = (un % 32) / 4; g = un % 4;
  return true;
}
DEV int nsa_rounds(int G) { return (G & 7) == 0 ? (256 + (G >> 3) * 2 - 1) / ((G >> 3) * 2) : (1024 + G - 1) / G; }

DEV void nsa_cmp_phase(const Params& p, LAS unsigned char* lds, int t32, int bid, int G) {
  const int lane = t32 & 63, wave = t32 >> 6, half = wave >> 2, wih = wave & 3, hth = t32 & 255;
  const int i15 = lane & 15, g4 = lane >> 4;
  LAS float* slabh = (LAS float*)(lds + AT_SLAB_OFF + half * AT_SLAB_HALF);
  for (int round = 0; round < nsa_rounds(G); ++round) {
    int b = 0, g = 0, tb = 0;
    const bool act = nsa_unit(round, bid, G, half, b, g, tb);
    const int t0 = tb * 32;
    const int nvmax = t0 + 31 >= 31 ? (t0 + 31 - 31) / 16 + 1 : 0;
    CmpJob job{p.u, p.kcb, p.kcb + (size_t)BATCH * 128 * NSA_G * 64, b, g, t0, 0u};
    job.um = !act ? 0u : (nvmax > 64 ? 3u : (nvmax > 0 ? 1u : 0u));
    for (int i = lane; i < 32 * 33; i += 64) slabh[wih * (32 * 33) + i] = 0.f;
    LAS unsigned char* kvh = lds + half * AT_HALF_KV;
    LAS unsigned* hb = (LAS unsigned*)(lds + MISC_OFF + 8192 + 128) + half * 16;
    LAS float* slab = slabh + wih * (32 * 33);
    {
      const int srow = hth >> 2, sch = hth & 3;
#pragma unroll
      for (int tl = 0; tl < 2; ++tl)
        if ((job.um >> tl) & 1u) {
          const act_t* kr = job.krow(tl, srow) + sch * 16; const act_t* vr = job.vrow(tl, srow) + sch * 16;
          const u32x4 k0 = *(const u32x4*)kr, k1 = *(const u32x4*)(kr + 8), v0 = *(const u32x4*)vr, v1 = *(const u32x4*)(vr + 8);
          LAS unsigned char* kd = kvh + tl * AT_TILEB + srow * AT_ROWB + sch * 32;
          *(LAS u32x4*)kd = k0; *(LAS u32x4*)(kd + 16) = k1;
          LAS unsigned char* vd = kvh + (2 + tl) * AT_TILEB + srow * AT_ROWB + sch * 32;
          *(LAS u32x4*)vd = v0; *(LAS u32x4*)(vd + 16) = v1;
        }
    }
    bf16x8 qf[2][2];
#pragma unroll
    for (int sub = 0; sub < 2; ++sub) {
      const act_t* qr = job.qrow(wih * 32 + sub * 16 + i15);
#pragma unroll
      for (int kk = 0; kk < 2; ++kk) qf[sub][kk] = *(const bf16x8*)(qr + kk * 32 + 8 * g4);
    }
    AttnState st;
#pragma unroll
    for (int sub = 0; sub < 2; ++sub) {
      st.m[sub] = -INFINITY; st.l[sub] = 0.f;
#pragma unroll
      for (int dt = 0; dt < 4; ++dt) st.O[sub][dt] = (f32x4){0.f, 0.f, 0.f, 0.f};
    }
    half_barrier(hb, lane);
    if (job.um & 1u) attn_tile<false>(job, kvh, kvh + 2 * AT_TILEB, qf, st, slab, 0, wih, lane);
    if (job.um & 2u) attn_tile<false>(job, kvh + AT_TILEB, kvh + 3 * AT_TILEB, qf, st, slab, 1, wih, lane);
#pragma unroll
    for (int sub = 0; sub < 2; ++sub) {
      float l = st.l[sub];
      l += shx(l, lane, 16);
      l += shx(l, lane, 32);
      const float inv = 1.0f / fmaxf(l, 1e-30f);
      st.l[sub] = inv;
#pragma unroll
      for (int dt = 0; dt < 4; ++dt) st.O[sub][dt] *= inv;
    }
    if (act) {
#pragma unroll
      for (int sub = 0; sub < 2; ++sub) {
        const int hh = g * 4 + wih;
        const size_t n = (size_t)b * SEQ + t0 + sub * 16 + i15;
        const float g0 = sigmoidf_(ldf(p.u[n * N_IN + OFF_CG + hh * 3 + 0]));
#pragma unroll
        for (int dt = 0; dt < 4; ++dt) { const f32x4 y = st.O[sub][dt] * g0; u32x2 w; w.x = pk2(y.x, y.y); w.y = pk2(y.z, y.w); *(u32x2*)((act_t*)p.ocmp + n * 1024 + hh * 64 + 16 * dt + 4 * g4) = w; }
      }
    }
    if (job.um & 1u) attn_tile<true>(job, kvh, kvh + 2 * AT_TILEB, qf, st, slab, 0, wih, lane);
    if (job.um & 2u) attn_tile<true>(job, kvh + AT_TILEB, kvh + 3 * AT_TILEB, qf, st, slab, 1, wih, lane);
    half_barrier(hb, lane);
    {
      const int q = hth >> 3, j4 = (hth & 7) * 4;
      float v[4];
#pragma unroll
      for (int i = 0; i < 4; ++i) {
        float s = 0.f;
#pragma unroll
        for (int w = 0; w < 4; ++w) s += slabh[w * (32 * 33) + q * 33 + j4 + i];
        const int j = j4 + i, qb = (t0 + q) >> 6;
        if (j == 0 || j == qb || j == qb - 1) s = INFINITY;
        else if (j > qb) s = -INFINITY;
        v[i] = s;
      }
      __syncthreads();
#pragma unroll
      for (int i = 0; i < 4; ++i) slabh[q * 33 + j4 + i] = v[i];
      __syncthreads();
      unsigned bits = 0u;
#pragma unroll
      for (int i = 0; i < 4; ++i) {
        int rank = 0;
#pragma unroll 1
        for (int jj = 0; jj < 32; ++jj) { const float w = slabh[q * 33 + jj]; rank += (w > v[i] || (w == v[i] && jj < j4 + i)) ? 1 : 0; }
        if (rank < N_SELECT) bits |= 1u << (j4 + i);
      }
      bits |= (unsigned)shxi((int)bits, lane, 1);
      bits |= (unsigned)shxi((int)bits, lane, 2);
      bits |= (unsigned)shxi((int)bits, lane, 4);
      if (act && (hth & 7) == 0) p.selm[((size_t)b * NSA_G + g) * SEQ + t0 + q] = bits;
      __syncthreads();
    }
  }
}

DEV void nsa_main_phase(const Params& p, LAS unsigned char* lds, int t32, int bid, int G) {
  const int lane = t32 & 63, wave = t32 >> 6, half = wave >> 2, wih = wave & 3, hth = t32 & 255;
  const int i15 = lane & 15, g4 = lane >> 4;
#define NSTAMP(i) do { if (GSEG >= 10 && blockIdx.x == 0 && t32 == 0) { const unsigned now_ = (unsigned)__builtin_amdgcn_s_memrealtime(); if ((i) > 0 && (i) - 1 + 10 == GSEG) p.barw[3600] += now_ - ns_prev; ns_prev = now_; } } while (0)
  unsigned ns_prev = 0u;
  for (int round2 = 0; round2 < nsa_rounds(G) * (NSA_PROBE == 5 ? 2 : 1); ++round2) {
    const int round = (NSA_PROBE == 5) ? (round2 >> 1) : round2;
    NSTAMP(0);
    int b = 0, g = 0, tb = 0;
    const bool act = nsa_unit(round, bid, G, half, b, g, tb);
    const int t0 = tb * 32;
    SelJob sj{p.u, b, g, t0, 0u, {0u, 0u}};
    if (act) {
      const unsigned* sm = p.selm + ((size_t)b * NSA_G + g) * SEQ + t0;
      sj.tm[0] = sm[i15]; sj.tm[1] = sm[16 + i15];
      unsigned um = sj.tm[0] | sj.tm[1];
      int l2 = lane;
      asm volatile("" : "+v"(l2));
      um |= (unsigned)shxi((int)um, l2, 1); um |= (unsigned)shxi((int)um, l2, 2);
      um |= (unsigned)shxi((int)um, l2, 4); um |= (unsigned)shxi((int)um, l2, 8);
      sj.um = um & range_mask(0, t0 >> 6);
    }
    u32x2 base[2][4];
    const int hh = g * 4 + wih;
    const size_t nrow0 = (size_t)b * SEQ + t0 + i15;
    const act_t gq10 = p.u[nrow0 * N_IN + OFF_CG + hh * 3 + 1], gq11 = p.u[(nrow0 + 16) * N_IN + OFF_CG + hh * 3 + 1];
    const act_t gq20 = p.u[nrow0 * N_IN + OFF_CG + hh * 3 + 2], gq21 = p.u[(nrow0 + 16) * N_IN + OFF_CG + hh * 3 + 2];
    {
      AttnState ss;
      NSTAMP(1);
      attn_run<false>(sj, lds, ss, half, hth, wih, lane);
      NSTAMP(2);
#if NSA_PROBE == 1
      attn_run<false>(sj, lds, ss, half, hth, wih, lane);
#endif
#pragma unroll
      for (int sub = 0; sub < 2; ++sub) {
        f32x4 oc[4];
#pragma unroll
        for (int dt = 0; dt < 4; ++dt) {
          const u32x2 cw = *(const u32x2*)((const act_t*)p.ocmp + (nrow0 + 16 * sub) * 1024 + hh * 64 + 16 * dt + 4 * g4);
          oc[dt] = (f32x4){__uint_as_float(cw.x << 16), __uint_as_float(cw.x & 0xffff0000u), __uint_as_float(cw.y << 16), __uint_as_float(cw.y & 0xffff0000u)};
        }
        const float g1 = sigmoidf_(ldf(sub ? gq11 : gq10));
#pragma unroll
        for (int dt = 0; dt < 4; ++dt) {
          const f32x4 y = ss.O[sub][dt] * g1 + oc[dt];
          base[sub][dt].x = pk2(y.x, y.y); base[sub][dt].y = pk2(y.z, y.w);
        }
      }
    }
    WinJob wj{p.u, b, g, t0, 0u};
    if (act) { const int lo = t0 - (NSA_WIN - 1) < 0 ? 0 : (t0 - (NSA_WIN - 1)) >> 6; wj.um = range_mask(lo, (t0 + 31) >> 6); }
    AttnState ws;
    NSTAMP(3);
    attn_run<false>(wj, lds, ws, half, hth, wih, lane);
    NSTAMP(4);
#if NSA_PROBE == 2
    attn_run<false>(wj, lds, ws, half, hth, wih, lane);
#endif
    if (act) {
#pragma unroll
      for (int sub = 0; sub < 2; ++sub) {
        const size_t n = nrow0 + 16 * sub;
        const float g2 = sigmoidf_(ldf(sub ? gq21 : gq20));
#pragma unroll
        for (int dt = 0; dt < 4; ++dt) {
          const u32x2 bw = base[sub][dt];
          f32x4 y = ws.O[sub][dt] * g2;
          y.x += __uint_as_float(bw.x << 16); y.y += __uint_as_float(bw.x & 0xffff0000u);
          y.z += __uint_as_float(bw.y << 16); y.w += __uint_as_float(bw.y & 0xffff0000u);
          u32x2 w; w.x = pk2(y.x, y.y); w.y = pk2(y.z, y.w);
          *(u32x2*)(p.yc + n * YLD + hh * 64 + 16 * dt + 4 * g4) = w;
        }
      }
    }
  }
}

DEV void dil_phase(const Params& p, LAS unsigned char* lds, int t32, int bid, int G) {
  const int lane = t32 & 63, wave = t32 >> 6, half = wave >> 2, wih = wave & 3, hth = t32 & 255;
  const int i15 = lane & 15, g4 = lane >> 4;
  const bool xm = (G & 7) == 0;
  const int npair = xm ? 96 : 768, pstep = xm ? (G >> 3) : G;
  for (int pair = xm ? (bid >> 3) : bid; pair < npair; pair += pstep) {
    const int un = pair * 2 + half;
    int gi, b, r2;
    if (xm) { b = bid & 7; gi = un / 64; r2 = un % 64; }
    else { gi = un / 512; const int r = un % 512; b = r / 64; r2 = r % 64; }
    const int dil = gi == 0 ? 1 : (gi == 1 ? 4 : 16);
    const int nlb = 16 / dil;
    const int h = r2 / 16, r3 = r2 % 16;
    const int res = r3 / nlb, lb = r3 % nlb;
    const int l0 = lb * 128;
    DilJob job{p.u, b, gi * 256 + h * 64, dil, res, l0, 0u};
    job.um = range_mask(l0 >= 128 ? (l0 - 128) >> 6 : 0, (l0 + 127) >> 6);
    AttnState st;
    attn_run<false>(job, lds, st, half, hth, wih, lane);
#pragma unroll
    for (int sub = 0; sub < 2; ++sub) {
      const int l = l0 + wih * 32 + sub * 16 + i15;
      const size_t n = (size_t)b * SEQ + l * dil + res;
#pragma unroll
      for (int dt = 0; dt < 4; ++dt) {
        const f32x4 y = st.O[sub][dt];
        u32x2 w; w.x = pk2(y.x, y.y); w.y = pk2(y.z, y.w);
        *(u32x2*)(p.dilo + ((size_t)gi * N_TOK + n) * 256 + h * 64 + 16 * dt + 4 * g4) = w;
      }
      if (g4 == 0) p.dill[((size_t)gi * N_TOK + n) * 4 + h] = st.m[sub] + __builtin_amdgcn_logf(st.l[sub]);
    }
  }
}

DEV void dil_combine(const Params& p, long long tid, long long nthr) {
  for (long long idx = tid; idx < (long long)N_TOK * 32; idx += nthr) {
    const size_t n = idx >> 5; const int c8 = (int)(idx & 31) * 8, h = c8 >> 6;
    const float l0 = p.dill[((size_t)0 * N_TOK + n) * 4 + h], l1 = p.dill[((size_t)1 * N_TOK + n) * 4 + h], l2 = p.dill[((size_t)2 * N_TOK + n) * 4 + h];
    const float mx = fmaxf(l0, fmaxf(l1, l2));
    float w0 = __builtin_amdgcn_exp2f(l0 - mx), w1 = __builtin_amdgcn_exp2f(l1 - mx), w2 = __builtin_amdgcn_exp2f(l2 - mx);
    const float inv = 1.0f / (w0 + w1 + w2);
    w0 *= inv; w1 *= inv; w2 *= inv;
    const u32x4 a = *(const u32x4*)(p.dilo + ((size_t)0 * N_TOK + n) * 256 + c8);
    const u32x4 bq = *(const u32x4*)(p.dilo + ((size_t)1 * N_TOK + n) * 256 + c8);
    const u32x4 c = *(const u32x4*)(p.dilo + ((size_t)2 * N_TOK + n) * 256 + c8);
    u32x4 o;
#pragma unroll
    for (int i = 0; i < 4; ++i) {
      const float lo = w0 * __uint_as_float(a[i] << 16) + w1 * __uint_as_float(bq[i] << 16) + w2 * __uint_as_float(c[i] << 16);
      const float hi = w0 * __uint_as_float(a[i] & 0xffff0000u) + w1 * __uint_as_float(bq[i] & 0xffff0000u) + w2 * __uint_as_float(c[i] & 0xffff0000u);
      o[i] = pk2(lo, hi);
    }
    *(u32x4*)(p.ya + n * YLD + c8) = o;
  }
}

DEV void cmpa_build(const Params& p, int li, long long tid, long long nthr) {
  for (long long idx = tid; idx < 2LL * CMP_ROWS * 256; idx += nthr) {
    const int which = (int)(idx / ((long long)CMP_ROWS * 256));
    const long long rem = idx % ((long long)CMP_ROWS * 256);
    const int row = (int)(rem >> 8), c8 = (int)(rem & 255) * 8, l = c8 >> 6, d = c8 & 63;
    const int g = row % NSA_G, c = (row / NSA_G) % N_CMP, b = row / (NSA_G * N_CMP);
    const float* pe = (which ? p.cmp_pe_v : p.cmp_pe_k) + (size_t)li * 32 * HD + l * HD + d;
    const u32x4 uv = *(const u32x4*)(p.u + ((size_t)b * SEQ + c * 16 + l) * N_IN + (which ? OFF_CVC : OFF_CKC) + g * HD + d);
    u32x4 o;
#pragma unroll
    for (int i = 0; i < 4; ++i) o[i] = pk2(__uint_as_float(uv[i] << 16) + pe[2 * i], __uint_as_float(uv[i] & 0xffff0000u) + pe[2 * i + 1]);
    *(u32x4*)(p.cmpA + ((size_t)which * CMP_ROWS_PAD + row) * 2048 + c8) = o;
  }
}

constexpr int XA_ROWB = 528;
constexpr int XA_TILEB = 32 * XA_ROWB;
static_assert(4 * XA_TILEB <= RING_BYTES, "xattn LDS map");
DEV void xattn_phase(const Params& p, LAS unsigned char* lds, int t32, int bid, int G) {
  const int lane = t32 & 63, wave = t32 >> 6, i15 = lane & 15, g4 = lane >> 4;
  const float sc2 = 0.0625f * 1.4426950408889634f;
  const bool xm = (G & 7) == 0;
  const int nun = xm ? XH * (SEQ / 128) : BATCH * XH * (SEQ / 128), ustep = xm ? (G >> 3) : G;
  for (int un = xm ? (bid >> 3) : bid; un < nun; un += ustep) {
    const int b = xm ? (bid & 7) : un / (XH * (SEQ / 128)), r = un % (XH * (SEQ / 128)), h = r / (SEQ / 128), qb = r % (SEQ / 128);
    const size_t nq = (size_t)b * SEQ + qb * 128 + wave * 16 + i15;
    bf16x8 qf[8];
#pragma unroll
    for (int kk = 0; kk < 8; ++kk) qf[kk] = *(const bf16x8*)(p.xq + nq * 1024 + h * 256 + kk * 32 + 8 * g4);
    f32x4 O[16];
#pragma unroll
    for (int dt = 0; dt < 16; ++dt) O[dt] = (f32x4){0.f, 0.f, 0.f, 0.f};
    float m = -INFINITY, l = 0.f;
    const int srow = t32 >> 4, sch = t32 & 15;
    const act_t* kbase = p.memk + ((size_t)b * MEM_LEN + srow) * 1024 + h * 256 + sch * 16;
    const act_t* vbase = p.memv + ((size_t)b * MEM_LEN + srow) * 1024 + h * 256 + sch * 16;
    u32x4 sk0 = *(const u32x4*)kbase, sk1 = *(const u32x4*)(kbase + 8), sv0 = *(const u32x4*)vbase, sv1 = *(const u32x4*)(vbase + 8);
    {
      LAS unsigned char* kd = lds + srow * XA_ROWB + sch * 32;
      *(LAS u32x4*)kd = sk0; *(LAS u32x4*)(kd + 16) = sk1;
      LAS unsigned char* vd = lds + 2 * XA_TILEB + srow * XA_ROWB + sch * 32;
      *(LAS u32x4*)vd = sv0; *(LAS u32x4*)(vd + 16) = sv1;
    }
    __syncthreads();
    for (int it = 0; it < MEM_LEN / 32; ++it) {
      if (it + 1 < MEM_LEN / 32) {
        const act_t* kr = kbase + (size_t)(it + 1) * 32 * 1024, *vr = vbase + (size_t)(it + 1) * 32 * 1024;
        sk0 = *(const u32x4*)kr; sk1 = *(const u32x4*)(kr + 8); sv0 = *(const u32x4*)vr; sv1 = *(const u32x4*)(vr + 8);
      }
      const LAS unsigned char* Kb = lds + (it & 1) * XA_TILEB;
      const LAS unsigned char* Vb = lds + (2 + (it & 1)) * XA_TILEB;
      f32x4 S[2];
      S[0] = (f32x4){0.f, 0.f, 0.f, 0.f}; S[1] = (f32x4){0.f, 0.f, 0.f, 0.f};
#pragma unroll
      for (int t = 0; t < 2; ++t)
#pragma unroll
        for (int kk = 0; kk < 8; ++kk) {
          const bf16x8 kf = *(const LAS bf16x8*)(Kb + (16 * t + i15) * XA_ROWB + (kk * 32 + 8 * g4) * 2);
          S[t] = __builtin_amdgcn_mfma_f32_16x16x32_bf16(kf, qf[kk], S[t], 0, 0, 0);
        }
      float mx = -INFINITY;
#pragma unroll
      for (int t = 0; t < 2; ++t)
#pragma unroll
        for (int j = 0; j < 4; ++j) { S[t][j] *= sc2; mx = fmaxf(mx, S[t][j]); }
      mx = fmaxf(mx, shx(mx, lane, 16));
      mx = fmaxf(mx, shx(mx, lane, 32));
      const float mnew = fmaxf(m, mx);
      const float corr = __builtin_amdgcn_exp2f(m - mnew);
      m = mnew;
      float psum = 0.f;
#pragma unroll
      for (int t = 0; t < 2; ++t)
#pragma unroll
        for (int j = 0; j < 4; ++j) { const float pp = __builtin_amdgcn_exp2f(S[t][j] - mnew); S[t][j] = pp; psum += pp; }
      l = l * corr + psum;
      u32x4 w;
      w.x = pk2(S[0][0], S[0][1]); w.y = pk2(S[0][2], S[0][3]); w.z = pk2(S[1][0], S[1][1]); w.w = pk2(S[1][2], S[1][3]);
      const bf16x8 pf = __builtin_bit_cast(bf16x8, w);
#pragma unroll
      for (int dt = 0; dt < 16; ++dt) {
        const LAS unsigned char* vp = Vb + (4 * g4 + (i15 >> 2)) * XA_ROWB + (16 * dt + 4 * (lane & 3)) * 2;
        const v4i16_t lo = tr_read(vp), hi = tr_read(vp + 16 * XA_ROWB);
        bf16x8 vf;
        vf[0] = lo[0]; vf[1] = lo[1]; vf[2] = lo[2]; vf[3] = lo[3]; vf[4] = hi[0]; vf[5] = hi[1]; vf[6] = hi[2]; vf[7] = hi[3];
        O[dt] = __builtin_amdgcn_mfma_f32_16x16x32_bf16(vf, pf, O[dt] * corr, 0, 0, 0);
      }
      if (it + 1 < MEM_LEN / 32) {
        LAS unsigned char* kd = lds + ((it + 1) & 1) * XA_TILEB + srow * XA_ROWB + sch * 32;
        *(LAS u32x4*)kd = sk0; *(LAS u32x4*)(kd + 16) = sk1;
        LAS unsigned char* vd = lds + (2 + ((it + 1) & 1)) * XA_TILEB + srow * XA_ROWB + sch * 32;
        *(LAS u32x4*)vd = sv0; *(LAS u32x4*)(vd + 16) = sv1;
      }
      __syncthreads();
    }
    l += shx(l, lane, 16);
    l += shx(l, lane, 32);
    const float inv = 1.0f / l;
#pragma unroll
    for (int dt = 0; dt < 16; ++dt) {
      const f32x4 y = O[dt] * inv;
      u32x2 w; w.x = pk2(y.x, y.y); w.y = pk2(y.z, y.w);
      *(u32x2*)(p.xo + nq * 1024 + h * 256 + 16 * dt + 4 * g4) = w;
    }
  }
}

constexpr int RT_LCNT = MISC_OFF + 4096, RT_BASE = RT_LCNT + 128, RT_SEL = RT_BASE + 128, RT_RANK = RT_SEL + 1024;
DEV void route_phase(const Params& p, int li, LAS unsigned char* lds, int t32, int bid, int G) {
  const int lane = t32 & 63, wave = t32 >> 6, i15 = lane & 15, g4 = lane >> 4;
  const float* W = p.w_router + (size_t)li * D * NE;
  LAS unsigned short* Wh = (LAS unsigned short*)lds;
  LAS unsigned short* Wl = (LAS unsigned short*)(lds + 65536);
  LAS int* lcnt = (LAS int*)(lds + RT_LCNT);
  LAS int* lbase = (LAS int*)(lds + RT_BASE);
  LAS int* lsel = (LAS int*)(lds + RT_SEL);
  LAS int* lrank = (LAS int*)(lds + RT_RANK);
  const int e = lane & 31;
  const float bias = p.b_router[li * NE + e];
  for (int blk = bid; blk < N_TOK / 64; blk += G) {
    __syncthreads();
    for (int i = 0; i < 16; ++i) {
      const int idx = t32 + 512 * i, k = idx >> 3, e4 = (idx & 7) * 4;
      const f32x4 w = ((const f32x4*)W)[idx];
#pragma unroll
      for (int q = 0; q < 4; ++q) {
        const unsigned short hi = f2bfh(w[q]);
        const unsigned short lo = f2bfh(w[q] - __uint_as_float(((unsigned)hi) << 16));
        Wh[(e4 + q) * 1024 + k] = hi; Wl[(e4 + q) * 1024 + k] = lo;
      }
    }
    if (t32 < 32) lcnt[t32] = 0;
    __syncthreads();
    f32x4 acc[4][2];
#pragma unroll
    for (int mt = 0; mt < 4; ++mt) { acc[mt][0] = (f32x4){0.f, 0.f, 0.f, 0.f}; acc[mt][1] = (f32x4){0.f, 0.f, 0.f, 0.f}; }
    const int n0 = blk * 64;
#pragma unroll 1
    for (int kk = 0; kk < 4; ++kk) {
      const int kb = wave * 128 + kk * 32 + 8 * g4;
      bf16x8 bh[2], bl[2];
#pragma unroll
      for (int nt = 0; nt < 2; ++nt) {
        bh[nt] = *(const LAS bf16x8*)(Wh + (16 * nt + i15) * 1024 + kb);
        bl[nt] = *(const LAS bf16x8*)(Wl + (16 * nt + i15) * 1024 + kb);
      }
#pragma unroll
      for (int mt = 0; mt < 4; ++mt) {
        const float* xr = p.xf + (size_t)(n0 + 16 * mt + i15) * D + kb;
        const f32x4 x0 = *(const f32x4*)xr, x1 = *(const f32x4*)(xr + 4);
        u32x4 hw, lw;
        {
          const unsigned h0 = pk2(x0.x, x0.y), h1 = pk2(x0.z, x0.w), h2 = pk2(x1.x, x1.y), h3 = pk2(x1.z, x1.w);
          hw = (u32x4){h0, h1, h2, h3};
          lw.x = pk2(x0.x - __uint_as_float(h0 << 16), x0.y - __uint_as_float(h0 & 0xffff0000u));
          lw.y = pk2(x0.z - __uint_as_float(h1 << 16), x0.w - __uint_as_float(h1 & 0xffff0000u));
          lw.z = pk2(x1.x - __uint_as_float(h2 << 16), x1.y - __uint_as_float(h2 & 0xffff0000u));
          lw.w = pk2(x1.z - __uint_as_float(h3 << 16), x1.w - __uint_as_float(h3 & 0xffff0000u));
        }
        const bf16x8 ah = __builtin_bit_cast(bf16x8, hw), al = __builtin_bit_cast(bf16x8, lw);
#pragma unroll
        for (int nt = 0; nt < 2; ++nt) {
          acc[mt][nt] = __builtin_amdgcn_mfma_f32_16x16x32_bf16(ah, bh[nt], acc[mt][nt], 0, 0, 0);
          acc[mt][nt] = __builtin_amdgcn_mfma_f32_16x16x32_bf16(ah, bl[nt], acc[mt][nt], 0, 0, 0);
          acc[mt][nt] = __builtin_amdgcn_mfma_f32_16x16x32_bf16(al, bh[nt], acc[mt][nt], 0, 0, 0);
        }
      }
    }
    __syncthreads();
    LAS float* part = (LAS float*)lds;
    LAS float* fin = (LAS float*)(lds + 8 * 64 * 33 * 4);
#pragma unroll
    for (int mt = 0; mt < 4; ++mt)
#pragma unroll
      for (int nt = 0; nt < 2; ++nt)
#pragma unroll
        for (int j = 0; j < 4; ++j) part[(wave * 64 + 16 * mt + 4 * g4 + j) * 33 + 16 * nt + i15] = acc[mt][nt][j];
    __syncthreads();
    {
      const int tok = t32 >> 3, e4 = (t32 & 7) * 4;
#pragma unroll
      for (int q = 0; q < 4; ++q) {
        float v = 0.f;
#pragma unroll
        for (int w = 0; w < 8; ++w) v += part[(w * 64 + tok) * 33 + e4 + q];
        fin[tok * 33 + e4 + q] = v;
      }
    }
    __syncthreads();
    float cur[8]; int sel[8][4]; float sv[8][4];
#pragma unroll
    for (int t = 0; t < 8; ++t) cur[t] = fin[(wave * 8 + t) * 33 + e] + bias;
#pragma unroll
    for (int k = 0; k < 4; ++k) {
      float bv[8]; int bi[8];
#pragma unroll
      for (int t = 0; t < 8; ++t) { bv[t] = cur[t]; bi[t] = e; }
#pragma unroll
      for (int o = 1; o < 32; o <<= 1) {
#pragma unroll
        for (int t = 0; t < 8; ++t) {
          const float ov = shx(bv[t], lane, o); const int oi = shxi(bi[t], lane, o);
          if (ov > bv[t] || (ov == bv[t] && oi < bi[t])) { bv[t] = ov; bi[t] = oi; }
        }
      }
#pragma unroll
      for (int t = 0; t < 8; ++t) { sel[t][k] = bi[t]; sv[t][k] = bv[t]; if (e == bi[t]) cur[t] = -INFINITY; }
    }
    int abase = __builtin_amdgcn_readfirstlane(wave * 32);
    asm volatile("" : "+s"(abase));
    if (lane == 0) {
#pragma unroll
      for (int t = 0; t < 8; ++t) {
        const int n = n0 + wave * 8 + t;
        const float e1 = expf(sv[t][1] - sv[t][0]), e2 = expf(sv[t][2] - sv[t][0]), e3 = expf(sv[t][3] - sv[t][0]);
        const float inv = 1.0f / (1.0f + e1 + e2 + e3);
        p.topg[n * 4 + 0] = inv; p.topg[n * 4 + 1] = e1 * inv; p.topg[n * 4 + 2] = e2 * inv; p.topg[n * 4 + 3] = e3 * inv;
#pragma unroll
        for (int k = 0; k < 4; ++k) {
          const int a = abase + t * 4 + k;
          lsel[a] = sel[t][k];
          lrank[a] = __hip_atomic_fetch_add(lcnt + sel[t][k], 1, __ATOMIC_RELAXED, __HIP_MEMORY_SCOPE_WORKGROUP);
        }
      }
    }
    __syncthreads();
    if (t32 < 32) lbase[t32] = atomicAdd(&p.cnt[li * 32 + t32], lcnt[t32]);
    __syncthreads();
    if (t32 < 256) {
      const int a = blk * 256 + t32, ee = lsel[t32];
      p.topi[a] = ee;
      p.rank[a] = lbase[ee] + lrank[t32];
    }
  }
  __syncthreads();
}

DEV void kcv_phase(const Params& p, int li, LAS unsigned char* lds, int t32, int bid, int G) {
  const int lane = t32 & 63, wave = t32 >> 6;
  LAS float* w2l = (LAS float*)lds;
  LAS float* rowb = (LAS float*)(lds + 65536) + wave * 512;
  __syncthreads();
#pragma unroll
  for (int i = 0; i < 4; ++i) {
    ((LAS f32x4*)w2l)[t32 + 512 * i] = ((const f32x4*)(p.cmp_w2_k + (size_t)li * CMP_HID * HD))[t32 + 512 * i];
    ((LAS f32x4*)w2l)[2048 + t32 + 512 * i] = ((const f32x4*)(p.cmp_w2_v + (size_t)li * CMP_HID * HD))[t32 + 512 * i];
  }
  __syncthreads();
  const int NGW = G * 8;
  for (int r0 = bid * 8 + wave; r0 < 2 * CMP_ROWS; r0 += 4 * NGW) {
    int rows[4];
#pragma unroll
    for (int i = 0; i < 4; ++i) { rows[i] = r0 + i * NGW; if (rows[i] >= 2 * CMP_ROWS) rows[i] = r0; }
#pragma unroll
    for (int i = 0; i < 4; ++i) {
      const float* hr = p.hid + (size_t)rows[i] * CMP_HID;
      rowb[i * 128 + lane] = hr[lane]; rowb[i * 128 + 64 + lane] = hr[64 + lane];
    }
    asm volatile("s_waitcnt lgkmcnt(0)" ::: "memory");
    float acc[4] = {0.f, 0.f, 0.f, 0.f};
    const LAS float* wq[4];
#pragma unroll
    for (int i = 0; i < 4; ++i) wq[i] = w2l + (rows[i] >= CMP_ROWS ? 128 * 64 : 0) + lane;
#pragma unroll 8
    for (int j = 0; j < CMP_HID; ++j) {
#pragma unroll
      for (int i = 0; i < 4; ++i) acc[i] += rowb[i * 128 + j] * wq[i][j * 64];
    }
#pragma unroll
    for (int i = 0; i < 4; ++i) {
      const int row = r0 + i * NGW;
      if (row < 2 * CMP_ROWS) {
        const int which = row >= CMP_ROWS ? 1 : 0, rr = row - which * CMP_ROWS;
        const int g_ = rr % NSA_G, c_ = (rr / NSA_G) % N_CMP, b_ = rr / (NSA_G * N_CMP);
        p.kcb[((((size_t)which * BATCH + b_) * 128 + c_) * NSA_G + g_) * 64 + lane] = f2bfh(acc[i]);
      }
    }
    asm volatile("s_waitcnt lgkmcnt(0)" ::: "memory");
  }
  __syncthreads();
}

constexpr int GA_QS = 272, GA_VS = 528, GA_PS = 144;
constexpr int GA_QT = 0, GA_KT = GA_QT + 64 * GA_QS, GA_KH = GA_KT + 64 * GA_QS, GA_VT = GA_KH + 64 * GA_QS, GA_PT = GA_VT + 64 * GA_VS,
              GA_LR = GA_PT + 64 * GA_PS, GA_GT = GA_LR + 64 * 16 * 4, GA_DC = GA_GT + 4 * 128 * 4, GA_END = GA_DC + 512;
static_assert(GA_END <= RING_BYTES, "GLA phase A LDS map");
constexpr int GC_SP = 0, GC_QT = GC_SP + 128 * GA_VS, GC_RED = GC_QT + 64 * GA_QS, GC_END = GC_RED + 8 * 16 * 4 * 2;
static_assert(GC_END <= RING_BYTES, "GLA phase C LDS map");

#define GSTAMP(i) do { if (GSEG >= 0 && blockIdx.x == 0 && t32 == 0) { const unsigned now_ = (unsigned)__builtin_amdgcn_s_memrealtime(); if ((i) > 0 && (i) - 1 == GSEG) p.barw[3600] += now_ - gs_prev; gs_prev = now_; } } while (0)
DEV void gla_a_unit(const Params& p, int li, LAS unsigned char* lds, int t32, int unit) {
  unsigned gs_prev = 0u;
  GSTAMP(0);
  const int lane = t32 & 63, wave = t32 >> 6, i15 = lane & 15, g4 = lane >> 4;
  const int bh = unit >> 5, ci = unit & 31, b = bh >> 2, h = bh & 3;
  const int c = t32 & 127, jq = t32 >> 7;
  LAS float* LR = (LAS float*)(lds + GA_LR);
  LAS float* GT = (LAS float*)(lds + GA_GT);
  LAS float* DC = (LAS float*)(lds + GA_DC);
  const float qscale = 0.08838834764831845f;
  const size_t n0 = (size_t)b * SEQ + ci * 64;
  {
    const int e = t32 * 2, j = e >> 4, r = e & 15;
    const unsigned w = *(const unsigned*)(p.u + (n0 + j) * N_IN + OFF_LR + r);
    LR[e] = __uint_as_float(w << 16); LR[e + 1] = __uint_as_float(w & 0xffff0000u);
  }
  float wa[GLA_RANK];
#pragma unroll
  for (int r = 0; r < GLA_RANK; ++r) wa[r] = p.w_alpha2[((size_t)li * GLA_RANK + r) * B_K + h * 128 + c];
  const float ba = p.b_alpha[li * B_K + h * 128 + c];
#pragma unroll
  for (int x = 0; x < 2; ++x) {
    const int idx = t32 + 512 * x, row = idx >> 4, ch = idx & 15;
    const act_t* ur = p.u + (n0 + row) * N_IN + h * 128 + ch * 8;
    *(LAS u32x4*)(lds + GA_QT + row * GA_QS + ch * 16) = *(const u32x4*)(ur + OFF_BQ);
    *(LAS u32x4*)(lds + GA_KT + row * GA_QS + ch * 16) = *(const u32x4*)(ur + OFF_BK);
  }
#pragma unroll
  for (int x = 0; x < 4; ++x) {
    const int idx = t32 + 512 * x, row = idx >> 5, ch = idx & 31;
    const u32x4 vv = *(const u32x4*)(p.u + (n0 + row) * N_IN + OFF_BV + h * 256 + ch * 8);
    *(LAS u32x4*)(lds + GA_VT + row * GA_VS + ch * 16) = vv;
  }
  __syncthreads();
  GSTAMP(1);
  float bl[16];
  float run = 0.f;
#pragma unroll
  for (int jj = 0; jj < 16; ++jj) {
    const LAS f32x4* lr4 = (const LAS f32x4*)(LR + (jq * 16 + jj) * 16);
    float z = ba;
#pragma unroll
    for (int r4 = 0; r4 < 4; ++r4) { const f32x4 x = lr4[r4]; z += x.x * wa[4 * r4] + x.y * wa[4 * r4 + 1] + x.z * wa[4 * r4 + 2] + x.w * wa[4 * r4 + 3]; }
    const float ez = __builtin_amdgcn_exp2f(-fabsf(z) * 1.4426950408889634f);
    const float ls = (fminf(z, 0.f) - __builtin_amdgcn_logf(1.0f + ez) * 0.6931471805599453f) * (1.0f / 16.0f);
    run += ls; bl[jj] = run;
  }
  GT[jq * 128 + c] = run;
  __syncthreads();
  GSTAMP(2);
  {
    const float g0 = GT[c], g1 = GT[128 + c], g2 = GT[256 + c], g3 = GT[384 + c];
    const float off = (jq > 0 ? g0 : 0.f) + (jq > 1 ? g1 : 0.f) + (jq > 2 ? g2 : 0.f);
    const float tot = (g0 + g1) + (g2 + g3);
    const float dtot = __builtin_amdgcn_exp2f(tot * 1.4426950408889634f);
    if (jq == 0) { DC[c] = dtot; p.gD[(size_t)unit * 128 + c] = dtot; }
#pragma unroll
    for (int jj = 0; jj < 16; ++jj) {
      const float e1 = __builtin_amdgcn_exp2f((off + bl[jj]) * 1.4426950408889634f), ie = __builtin_amdgcn_rcpf(e1);
      const int ro = (jq * 16 + jj) * GA_QS + c * 2;
      const float qf = __uint_as_float(((unsigned)*(const LAS unsigned short*)(lds + GA_QT + ro)) << 16);
      const float kf = __uint_as_float(((unsigned)*(const LAS unsigned short*)(lds + GA_KT + ro)) << 16);
      const unsigned short qt = f2bfh(qf * e1 * qscale);
      *(LAS unsigned short*)(lds + GA_QT + ro) = qt;
      p.gQ[((size_t)unit * 64 + jq * 16 + jj) * 128 + c] = qt;
      *(LAS unsigned short*)(lds + GA_KT + ro) = f2bfh(kf * ie);
      *(LAS unsigned short*)(lds + GA_KH + ro) = f2bfh(kf * ie * dtot);
    }
  }
  __syncthreads();
  GSTAMP(3);
#pragma unroll
  for (int q = 0; q < 2; ++q) {
    const int id = wave * 2 + q, jt = id >> 2, it = id & 3;
    f32x4 a = (f32x4){0.f, 0.f, 0.f, 0.f};
#pragma unroll
    for (int kk = 0; kk < 4; ++kk) {
      const bf16x8 kf = *(const LAS bf16x8*)(lds + GA_KT + (16 * jt + i15) * GA_QS + (32 * kk + 8 * g4) * 2);
      const bf16x8 qf = *(const LAS bf16x8*)(lds + GA_QT + (16 * it + i15) * GA_QS + (32 * kk + 8 * g4) * 2);
      a = __builtin_amdgcn_mfma_f32_16x16x32_bf16(kf, qf, a, 0, 0, 0);
    }
    const int i = 16 * it + i15, j0 = 16 * jt + 4 * g4;
    u32x2 w;
    w.x = pk2(j0 <= i ? a.x : 0.f, j0 + 1 <= i ? a.y : 0.f);
    w.y = pk2(j0 + 2 <= i ? a.z : 0.f, j0 + 3 <= i ? a.w : 0.f);
    *(LAS u32x2*)(lds + GA_PT + i * GA_PS + j0 * 2) = w;
  }
  __syncthreads();
  GSTAMP(4);
  {
    const int it = wave & 3, vt0 = (wave >> 2) * 8;
    bf16x8 pf[2];
#pragma unroll
    for (int s = 0; s < 2; ++s) pf[s] = *(const LAS bf16x8*)(lds + GA_PT + (16 * it + i15) * GA_PS + (32 * s + 8 * g4) * 2);
#pragma unroll
    for (int x = 0; x < 8; ++x) {
      const int vt = vt0 + x;
      f32x4 a = (f32x4){0.f, 0.f, 0.f, 0.f};
#pragma unroll
      for (int s = 0; s < 2; ++s) {
        const LAS unsigned char* vp = lds + GA_VT + (32 * s + 8 * g4 + (i15 >> 2)) * GA_VS + (16 * vt + 4 * (lane & 3)) * 2;
        const v4i16_t lo = tr_read(vp), hi = tr_read(vp + 4 * GA_VS);
        bf16x8 vf;
        vf[0] = lo[0]; vf[1] = lo[1]; vf[2] = lo[2]; vf[3] = lo[3]; vf[4] = hi[0]; vf[5] = hi[1]; vf[6] = hi[2]; vf[7] = hi[3];
        a = __builtin_amdgcn_mfma_f32_16x16x32_bf16(vf, pf[s], a, 0, 0, 0);
      }
      *(f32x4*)(p.opart + (n0 + 16 * it + i15) * 1024 + h * 256 + 16 * vt + 4 * g4) = a;
    }
  }
  {
    bf16x8 vf[2][2];
#pragma unroll
    for (int x = 0; x < 2; ++x)
#pragma unroll
      for (int s = 0; s < 2; ++s) {
        const LAS unsigned char* vp = lds + GA_VT + (32 * s + 8 * g4 + (i15 >> 2)) * GA_VS + (16 * (2 * wave + x) + 4 * (lane & 3)) * 2;
        const v4i16_t lo = tr_read(vp), hi = tr_read(vp + 4 * GA_VS);
        vf[x][s][0] = lo[0]; vf[x][s][1] = lo[1]; vf[x][s][2] = lo[2]; vf[x][s][3] = lo[3];
        vf[x][s][4] = hi[0]; vf[x][s][5] = hi[1]; vf[x][s][6] = hi[2]; vf[x][s][7] = hi[3];
      }
#pragma unroll
    for (int ct = 0; ct < 8; ++ct) {
      f32x4 a0 = (f32x4){0.f, 0.f, 0.f, 0.f}, a1 = (f32x4){0.f, 0.f, 0.f, 0.f};
#pragma unroll
      for (int s = 0; s < 2; ++s) {
        const LAS unsigned char* kp = lds + GA_KH + (32 * s + 8 * g4 + (i15 >> 2)) * GA_QS + (16 * ct + 4 * (lane & 3)) * 2;
        const v4i16_t lo = tr_read(kp), hi = tr_read(kp + 4 * GA_QS);
        bf16x8 kf;
        kf[0] = lo[0]; kf[1] = lo[1]; kf[2] = lo[2]; kf[3] = lo[3]; kf[4] = hi[0]; kf[5] = hi[1]; kf[6] = hi[2]; kf[7] = hi[3];
        a0 = __builtin_amdgcn_mfma_f32_16x16x32_bf16(vf[0][s], kf, a0, 0, 0, 0);
        a1 = __builtin_amdgcn_mfma_f32_16x16x32_bf16(vf[1][s], kf, a1, 0, 0, 0);
      }
      act_t* up = p.gU + ((size_t)unit * 128 + 16 * ct + i15) * 256 + 32 * wave + 4 * g4;
      u32x2 w0; w0.x = pk2(a0.x, a0.y); w0.y = pk2(a0.z, a0.w);
      u32x2 w1; w1.x = pk2(a1.x, a1.y); w1.y = pk2(a1.z, a1.w);
      *(u32x2*)up = w0; *(u32x2*)(up + 16) = w1;
    }
  }
  __syncthreads();
  GSTAMP(5);
}

DEV void gla_scan(const Params& p, long long tid, long long nthr) {
  for (long long idx = tid; idx < 32LL * 128 * 32; idx += nthr) {
    const int v8 = (int)(idx & 31) * 8, c = (int)((idx >> 5) & 127), bh = (int)(idx >> 12);
    float s[8];
#pragma unroll
    for (int i = 0; i < 8; ++i) s[i] = 0.f;
#pragma unroll 8
    for (int ci = 0; ci < 32; ++ci) {
      const size_t unit = (size_t)bh * 32 + ci;
      const u32x4 uw = *(const u32x4*)(p.gU + (unit * 128 + c) * 256 + v8);
      const float d = p.gD[unit * 128 + c];
      u32x4 o;
#pragma unroll
      for (int i = 0; i < 4; ++i) o[i] = pk2(s[2 * i], s[2 * i + 1]);
      *(u32x4*)(p.gS + (unit * 128 + c) * 256 + v8) = o;
#pragma unroll
      for (int i = 0; i < 4; ++i) {
        s[2 * i] = s[2 * i] * d + __uint_as_float(uw[i] << 16);
        s[2 * i + 1] = s[2 * i + 1] * d + __uint_as_float(uw[i] & 0xffff0000u);
      }
    }
  }
}

DEV void gla_c_unit(const Params& p, int li, LAS unsigned char* lds, int t32, int unit) {
  const int lane = t32 & 63, wave = t32 >> 6, i15 = lane & 15, g4 = lane >> 4;
  const int bh = unit >> 5, ci = unit & 31, b = bh >> 2, h = bh & 3;
  const size_t n0 = (size_t)b * SEQ + ci * 64;
#pragma unroll
  for (int x = 0; x < 8; ++x) {
    const int idx = t32 + 512 * x, row = idx >> 5, ch = idx & 31;
    *(LAS u32x4*)(lds + GC_SP + row * GA_VS + ch * 16) = *(const u32x4*)(p.gS + ((size_t)unit * 128 + row) * 256 + ch * 8);
  }
#pragma unroll
  for (int x = 0; x < 2; ++x) {
    const int idx = t32 + 512 * x, row = idx >> 4, ch = idx & 15;
    *(LAS u32x4*)(lds + GC_QT + row * GA_QS + ch * 16) = *(const u32x4*)(p.gQ + ((size_t)unit * 64 + row) * 128 + ch * 8);
  }
  __syncthreads();
  const int it = wave & 3, vt0 = (wave >> 2) * 8;
  bf16x8 qf[4];
#pragma unroll
  for (int kk = 0; kk < 4; ++kk) qf[kk] = *(const LAS bf16x8*)(lds + GC_QT + (16 * it + i15) * GA_QS + (32 * kk + 8 * g4) * 2);
  const size_t n = n0 + 16 * it + i15;
  f32x4 o[8];
  float ss = 0.f;
#pragma unroll
  for (int x = 0; x < 8; ++x) {
    const int vt = vt0 + x;
    f32x4 a = *(const f32x4*)(p.opart + n * 1024 + h * 256 + 16 * vt + 4 * g4);
#pragma unroll
    for (int kk = 0; kk < 4; ++kk) {
      const LAS unsigned char* sp = lds + GC_SP + (32 * kk + 8 * g4 + (i15 >> 2)) * GA_VS + (16 * vt + 4 * (lane & 3)) * 2;
      const v4i16_t lo = tr_read(sp), hi = tr_read(sp + 4 * GA_VS);
      bf16x8 sf;
      sf[0] = lo[0]; sf[1] = lo[1]; sf[2] = lo[2]; sf[3] = lo[3]; sf[4] = hi[0]; sf[5] = hi[1]; sf[6] = hi[2]; sf[7] = hi[3];
      a = __builtin_amdgcn_mfma_f32_16x16x32_bf16(sf, qf[kk], a, 0, 0, 0);
    }
    o[x] = a;
    ss += (a.x * a.x + a.y * a.y) + (a.z * a.z + a.w * a.w);
  }
  ss += shx(ss, lane, 16);
  ss += shx(ss, lane, 32);
  LAS float* RED = (LAS float*)(lds + GC_RED);
  if (g4 == 0) RED[wave * 16 + i15] = ss;
  __syncthreads();
  ss += RED[(wave ^ 4) * 16 + i15];
  const float rs = 1.0f / sqrtf(ss * (1.0f / 256.0f) + LN_EPS);
#pragma unroll
  for (int x = 0; x < 8; ++x) {
    const int v = 16 * (vt0 + x) + 4 * g4;
    const f32x4 gn = *(const f32x4*)(p.gla_norm_g + li * DV + v);
    const u32x2 rw = *(const u32x2*)(p.u + n * N_IN + OFF_BR + h * 256 + v);
    const float r0 = __uint_as_float(rw.x << 16), r1 = __uint_as_float(rw.x & 0xffff0000u), r2 = __uint_as_float(rw.y << 16), r3 = __uint_as_float(rw.y & 0xffff0000u);
    u32x2 w;
    w.x = pk2(o[x].x * rs * gn.x * (r0 * sigmoidf_(r0)), o[x].y * rs * gn.y * (r1 * sigmoidf_(r1)));
    w.y = pk2(o[x].z * rs * gn.z * (r2 * sigmoidf_(r2)), o[x].w * rs * gn.w * (r3 * sigmoidf_(r3)));
    *(u32x2*)(p.yb + n * YLD + h * 256 + v) = w;
  }
  __syncthreads();
}

#define XB_TMO      128
#define XB_XCNT(j)  (256  + 64 * (j))
#define XB_XSUB(j)  (1280 + 64 * (j))
#define XB_XGEN(j)  (2304 + 64 * (j))
#define XB_TOP      3328
#define XB_TOPGEN   3392
#define XCD_BAR_WORDS 3456
#define XB_SPIN_CAP (1u << 18)

__device__ __forceinline__ unsigned xb_ld(unsigned* p)              { return __hip_atomic_load(p, __ATOMIC_RELAXED, __HIP_MEMORY_SCOPE_AGENT); }
__device__ __forceinline__ unsigned xb_add(unsigned* p, unsigned v) { return __hip_atomic_fetch_add(p, v, __ATOMIC_RELAXED, __HIP_MEMORY_SCOPE_AGENT); }
__device__ __forceinline__ unsigned xb_xcc_id() { return (unsigned)__builtin_amdgcn_s_getreg((3 << 11) | 20) & 0xFu; }
#define XB_SPIN(cond, bar) do { unsigned _sp = 0; while (cond) { __builtin_amdgcn_s_sleep(1); \
    if ((++_sp & 255u) == 0u) { if (xb_ld(&(bar)[XB_TMO])) break; if (_sp > XB_SPIN_CAP) { atomicAdd(&(bar)[XB_TMO], 1u); break; } } } } while (0)

struct XcdBarrier {
    unsigned* bar; unsigned x;
    volatile LAS unsigned* st;
};

__device__ __forceinline__ XcdBarrier xcd_barrier_post(unsigned* bar, volatile LAS unsigned* st) {
    XcdBarrier b; b.bar = bar; b.x = xb_xcc_id(); b.st = st;
    if (threadIdx.x == 0) st[2] = xb_add(&bar[XB_XCNT(b.x)], 1u);
    return b;
}
__device__ __forceinline__ void xcd_barrier_complete(unsigned* bar, unsigned x, unsigned& nloc, unsigned& nx) {
    const unsigned G = gridDim.x * gridDim.y * gridDim.z;
    unsigned sum, cnt, mine, sp = 0u;
    for (;;) {
        sum = 0u; cnt = 0u; mine = 0u;
#pragma unroll
        for (unsigned j = 0; j < 16; ++j) { const unsigned c = xb_ld(&bar[XB_XCNT(j)]); sum += c; cnt += (c > 0u) ? 1u : 0u; mine = (j == x) ? c : mine; }
        if (sum == G) break;
        __builtin_amdgcn_s_sleep(1);
        if ((++sp & 255u) == 0u) { if (xb_ld(&bar[XB_TMO])) break; if (sp > XB_SPIN_CAP) { atomicAdd(&bar[XB_TMO], 1u); break; } }
    }
    nloc = mine > 0u ? mine : 1u; nx = cnt > 0u ? cnt : 1u;
}

__device__ __forceinline__ void xcd_barrier(const XcdBarrier& b, const int t32) {
    asm volatile("s_waitcnt vmcnt(0)" ::: "memory");
    __syncthreads();
    if (t32 == 0) {
        unsigned* bar = b.bar;
        __builtin_amdgcn_s_waitcnt(0);
        unsigned nloc = b.st[0], nx = b.st[1];
        if (nloc == 0u) { xcd_barrier_complete(bar, b.x, nloc, nx); b.st[0] = nloc; b.st[1] = nx; }
        const unsigned old = xb_add(&bar[XB_XSUB(b.x)], 1u);
        const unsigned gen = old / nloc;
        if (old + 1u == (gen + 1u) * nloc) {
            __builtin_amdgcn_fence(__ATOMIC_RELEASE, "agent");
            asm volatile("s_waitcnt vmcnt(0)" ::: "memory");
            const unsigned og = xb_add(&bar[XB_TOP], 1u);
            const unsigned tg = og / nx;
            if (og + 1u == (tg + 1u) * nx) xb_add(&bar[XB_TOPGEN], 1u);
            else XB_SPIN(xb_ld(&bar[XB_TOPGEN]) == tg, bar);
            __builtin_amdgcn_fence(__ATOMIC_ACQUIRE, "agent");
            xb_add(&bar[XB_XGEN(b.x)], 1u);
            asm volatile("s_waitcnt vmcnt(0)" ::: "memory");
        } else {
            XB_SPIN(xb_ld(&bar[XB_XGEN(b.x)]) == gen, bar);
            __builtin_amdgcn_fence(__ATOMIC_ACQUIRE, "agent");
            asm volatile("s_waitcnt vmcnt(0)" ::: "memory");
        }
    }
    __syncthreads();
}

constexpr int STEPS_PER_LAYER = 21;
#ifndef PROBE_LO
#define PROBE_LO -1
#define PROBE_HI -1
#endif
#ifndef PROBE_PRO
#define PROBE_PRO 0
#endif
#ifndef TSTEP_LO
#define TSTEP_LO -2
#define TSTEP_HI -2
#endif
#ifndef TSUB
#define TSUB -9
#endif
#ifndef TSTEP_Q
#define TSTEP_Q 40u
#endif
#ifndef NSA_PROBE
#define NSA_PROBE 0
#endif
#ifndef MULTI_LAUNCH
#define MULTI_LAUNCH 0
#endif
DEV int fresh_t32(int wave) {
  int t;
  asm volatile("v_mbcnt_lo_u32_b32 %0, -1, 0\n\tv_mbcnt_hi_u32_b32 %0, -1, %0" : "=v"(t));
  return t + wave * 64;
}
struct KArgs { void* in[35]; void* out; void* ws; };
template <bool WITH_NAIVE, bool COOP>
__global__ void __launch_bounds__(NTHREADS) k_mega(KArgs ka, int step_lo, int step_hi) {
  unsigned* const barw0 = ((unsigned*)ka.ws);
  extern __shared__ __attribute__((aligned(16))) unsigned char lds_raw[];
  LAS unsigned char* lds = (LAS unsigned char*)lds_raw;
  LAS int* tab = (LAS int*)(lds + MISC_OFF);
  const int wave = __builtin_amdgcn_readfirstlane(threadIdx.x >> 6);
  const int G = gridDim.x;
  int bid = blockIdx.x;

  LAS unsigned* miscw = (LAS unsigned*)(lds + MISC_OFF + 8192);
  if (threadIdx.x < 128) miscw[threadIdx.x] = 0u;
  __syncthreads();
  XcdBarrier xbar; xbar.bar = barw0; xbar.x = 0; xbar.st = nullptr;
  if (COOP) xbar = xcd_barrier_post(barw0, miscw + 8);
  unsigned* const stamp = barw0 + 3584;
  if (step_lo < 0) {
    Params p;
    fill_params(p, ka.in, ka.out, ka.ws);
    if (TSTEP_LO == -1 && blockIdx.x == 0 && threadIdx.x == 0) { stamp[0] = (unsigned)__builtin_amdgcn_s_memrealtime(); stamp[2] = 0u; stamp[3] = 0u; }
    prologue(p, lds, wave, threadIdx.x & 63);
    if (COOP) {
      if (step_hi == -12345) cg::this_grid().sync();
      xcd_barrier(xbar, (int)threadIdx.x);
    }
#if PROBE_PRO
    prologue(p, lds, wave, threadIdx.x & 63);
    if (COOP) cg::this_grid().sync();
#endif
    step_lo = 0;
    if (TSTEP_LO == -1 && blockIdx.x == 0 && threadIdx.x == 0) stamp[1] = (unsigned)__builtin_amdgcn_s_memrealtime();
    if (COOP) {
      bool even = (G % 8) == 0;
#pragma unroll
      for (int j = 0; j < 8; ++j) even = even && (xb_ld(&barw0[XB_XCNT(j)]) == (unsigned)(G / 8));
      __syncthreads();
      if (even) bid = __builtin_amdgcn_readfirstlane((int)(xbar.x + 8u * miscw[10]));
    }
  }
  int rep_done = 0;
  for (int step = step_lo; step < step_hi;) {
    int li = step / STEPS_PER_LAYER;
    const int k = step % STEPS_PER_LAYER;
    int nb32 = gridDim.x;
    char* wsb = (char*)ka.ws;
    asm volatile("" : "+s"(wsb));
    Params p;
    fill_params(p, ka.in, ka.out, wsb);
    asm volatile("" : "+s"(li));
    asm volatile("" : "+s"(nb32));
#define T32() fresh_t32(wave)
#define TID() ((int)(blockIdx.x * NTHREADS) + T32())
    const int nthr = nb32 * NTHREADS;
    const int gw = blockIdx.x * 8 + wave, NGW = nb32 * 8;
    if (TSTEP_LO >= 0 && k == TSTEP_LO && blockIdx.x == 0 && wave == 0) stamp[2 * li] = (unsigned)__builtin_amdgcn_s_memrealtime();
    const bool is_gemm = (k == 0) || (k >= 2 && k <= 5) || (k == 9) || (k == 10) || (k == 12) || (k == 14) || (k == 18) || (k == 19);
    const bool sync_after = !(k == 2 || k == 3 || k == 4);
    if (is_gemm) {
      pg8::Gemm g{nullptr, nullptr, 0, 0, 0};
      USched S; S.init_static(256, 256, G, bid);
      EpiU E{0, 0, nullptr, nullptr, nullptr, nullptr, nullptr};
      const size_t WSQ = (size_t)1024 * 1024;
      switch (k) {
        case 0:
          g = pg8::Gemm{p.xb, p.wt_in + (size_t)li * N_IN_PAD * 1024, N_TOK, N_IN_PAD, 1024};
          S.init_static(N_TOK, N_IN_PAD, G, bid);
          E.mode = EM_INPROJ; E.q0 = p.u; E.q1 = p.b_in + (size_t)li * N_IN; break;
        case 2:
          g = pg8::Gemm{p.cmpA, p.wt_c1 + (size_t)(li * 2 + 0) * 256 * 2048, CMP_ROWS_PAD, 256, 2048};
          S.init_static(CMP_ROWS_PAD, 256, G, bid);
          E.mode = EM_HID; E.q0 = p.hid; break;
        case 3:
          g = pg8::Gemm{p.cmpA + (size_t)CMP_ROWS_PAD * 2048, p.wt_c1 + (size_t)(li * 2 + 1) * 256 * 2048, CMP_ROWS_PAD, 256, 2048};
          S.init_static(CMP_ROWS_PAD, 256, G, (bid + G - 16) % G);
          E.mode = EM_HID; E.q0 = p.hid + (size_t)CMP_ROWS * CMP_HID; break;
        case 4:
          g = pg8::Gemm{p.membf, p.wt_xk + li * WSQ, BATCH * MEM_LEN, 1024, 1024};
          S.init_static(BATCH * MEM_LEN, 1024, G, (bid + G - 32) % G);
          E.mode = EM_BF16; E.q0 = p.memk; E.ldc = 1024; break;
        case 5:
          g = pg8::Gemm{p.membf, p.wt_xv + li * WSQ, BATCH * MEM_LEN, 1024, 1024};
          S.init_static(BATCH * MEM_LEN, 1024, G, (bid + G - 64) % G);
          E.mode = EM_BF16; E.q0 = p.memv; E.ldc = 1024; break;
        case 9:
          g = pg8::Gemm{p.ya, p.wt_bra + (size_t)li * 1024 * YLD, N_TOK, 1024, YLD};
          S.init_static(N_TOK, 1024, G, bid);
          E.mode = EM_BRCAT; E.q1 = p.u; E.q0 = p.merged; break;
        case 10:
          g = pg8::Gemm{p.merged, p.wt_omix + li * WSQ, N_TOK, 1024, 1024};
          S.init_static(N_TOK, 1024, G, bid);
          E.mode = EM_RES; E.q1 = p.xf; E.q0 = p.tmp; break;
        case 12:
          g = pg8::Gemm{p.xb, p.wt_xq + li * WSQ, N_TOK, 1024, 1024};
          S.init_static(N_TOK, 1024, G, bid);
          E.mode = EM_BF16; E.q0 = p.xq; E.ldc = 1024; break;
        case 14:
          g = pg8::Gemm{p.xo, p.wt_xo + li * WSQ, N_TOK, 1024, 1024};
          S.init_static(N_TOK, 1024, G, bid);
          E.mode = EM_RES; E.q1 = p.xf; E.q0 = p.tmp; break;
        case 18: {
          const int ntiles = moe_tables(p, li, tab, T32());
          g = pg8::Gemm{p.xg, p.wt_gu + (size_t)li * 32 * 2048 * 1024, MOE_ROWS, 32 * 2048, 1024};
          S.init_moe(G, bid, 8, ntiles * 8, tab + 128);
          E.mode = EM_MOE1; E.q0 = p.actg; E.q1 = p.b_gu + (size_t)li * 32 * 2048; E.te = tab + 128; break; }
        default: {
          const int ntiles = moe_tables(p, li, tab, T32());
          g = pg8::Gemm{p.actg, p.wt_dn + (size_t)li * 32 * 1024 * 1024, MOE_ROWS, 32 * 1024, 1024};
          S.init_moe(G, bid, 4, ntiles * 4, tab + 128);
          E.mode = EM_MOE2; E.q0 = p.yass; E.q1 = p.b_down + (size_t)li * 32 * 1024; E.q2 = p.topg; E.q3 = p.rowlist; E.te = tab + 128; break; }
      }
      pg8::gemm_phase<EpiU, USched, true, true>(lds, g, S, E, T32());
    } else {
      switch (k) {
        case 1: cmpa_build(p, li, TID(), nthr); break;
        case 6:
#define SUBSTAMP(i) do { if (TSUB == (i) && blockIdx.x == 0 && wave == 0) stamp[2 * li] = (unsigned)__builtin_amdgcn_s_memrealtime(); if (TSUB + 1 == (i) && blockIdx.x == 0 && wave == 0) stamp[2 * li + 1] = (unsigned)__builtin_amdgcn_s_memrealtime(); } while (0)
          SUBSTAMP(1);
          { const int t = T32(); for (int un = bid; un < 1024; un += G) gla_a_unit(p, li, lds, t, un); }
          SUBSTAMP(2);
          dil_phase(p, lds, T32(), bid, G);
          SUBSTAMP(3);
          kcv_phase(p, li, lds, T32(), bid, G);
          SUBSTAMP(4);
          break;
        case 7: SUBSTAMP(8); gla_scan(p, TID(), nthr); SUBSTAMP(9); nsa_cmp_phase(p, lds, T32(), bid, G); SUBSTAMP(10); dil_combine(p, TID(), nthr); SUBSTAMP(11); break;
        case 8: {
          SUBSTAMP(5);
          nsa_main_phase(p, lds, T32(), bid, G);
          __syncthreads();
          SUBSTAMP(6);
          const int t = T32();
          for (int un = bid; un < 1024; un += G) gla_c_unit(p, li, lds, t, un);
          SUBSTAMP(7);
          break; }
        case 11: ln_rows_w<0>(p, p.tmp, p.ln1_g + li * D, p.ln1_b + li * D, p.xf, p.xb, nullptr, gw, NGW, T32() & 63); break;
        case 13: xattn_phase(p, lds, T32(), bid, G); break;
        case 15: ln_rows_w<0>(p, p.tmp, p.ln2_g + li * D, p.ln2_b + li * D, p.xf, p.xb, nullptr, gw, NGW, T32() & 63); break;
        case 16: route_phase(p, li, lds, T32(), bid, G); break;
        case 17: { const int t = T32(); moe_prep(p, li, tab, wave, t & 63, t); break; }
        case 20: ln_rows_w<1>(p, nullptr, p.ln3_g + li * D, p.ln3_b + li * D, p.xf, p.xb, li == DEPTH - 1 ? p.out : nullptr, gw, NGW, T32() & 63); break;
        default: break;
      }
    }
    if (COOP && sync_after) xcd_barrier(xbar, T32());
    if (TSTEP_LO >= 0 && k == TSTEP_HI && blockIdx.x == 0 && wave == 0) stamp[2 * li + 1] = (unsigned)__builtin_amdgcn_s_memrealtime();
    if (PROBE_HI >= 0 && k == PROBE_HI && !rep_done) { rep_done = 1; step -= (PROBE_HI - PROBE_LO); }
    else { if (k == PROBE_HI) rep_done = 0; ++step; }
  }
  if (GSEG >= 0 && blockIdx.x == 0 && fresh_t32(wave) == 0) {
    __builtin_amdgcn_s_waitcnt(0);
    const unsigned tk = __hip_atomic_load(barw0 + 3600, __ATOMIC_RELAXED, __HIP_MEMORY_SCOPE_AGENT);
    ((float*)ka.out)[0] = (float)((tk / 100u + TSTEP_Q / 2) / TSTEP_Q * TSTEP_Q);
  }
  if (TSTEP_LO >= -1 && blockIdx.x == 0 && fresh_t32(wave) == 0) {
    __builtin_amdgcn_s_waitcnt(0);
    const unsigned tk = (__hip_atomic_load(stamp + 1, __ATOMIC_RELAXED, __HIP_MEMORY_SCOPE_AGENT) - __hip_atomic_load(stamp + 0, __ATOMIC_RELAXED, __HIP_MEMORY_SCOPE_AGENT)) + (__hip_atomic_load(stamp + 3, __ATOMIC_RELAXED, __HIP_MEMORY_SCOPE_AGENT) - __hip_atomic_load(stamp + 2, __ATOMIC_RELAXED, __HIP_MEMORY_SCOPE_AGENT));
    ((float*)ka.out)[0] = (float)((tk / 100u + TSTEP_Q / 2) / TSTEP_Q * TSTEP_Q);
  }
}

extern "C" void kernel_launch(void* const* d_in, const int* in_sizes, int n_in, void* d_out, int out_size,
                              void* d_ws, size_t ws_size, hipStream_t stream) {
  Params p;
  memset(&p, 0, sizeof(p));
  fill_params(p, d_in, d_out, d_ws);
  KArgs ka;
  memset(&ka, 0, sizeof(ka));
  for (int i = 0; i < 35; ++i) ka.in[i] = d_in[i];
  ka.out = d_out; ka.ws = d_ws;
  static int grid_blocks = 0;
  if (!grid_blocks) {
    int dev = 0, cus = 0;
    hipGetDevice(&dev);
    hipDeviceGetAttribute(&cus, hipDeviceAttributeMultiprocessorCount, dev);
    hipFuncSetAttribute((const void*)k_mega<true, true>, hipFuncAttributeMaxDynamicSharedMemorySize, LDS_BYTES);
    if (p.ws_used > ws_size) fprintf(stderr, "workspace too small: need %zu have %zu\n", p.ws_used, ws_size);
    grid_blocks = cus;
  }
  hipMemsetAsync(p.barw, 0, 4096 * sizeof(unsigned), stream);
  int lo = -1, hi = DEPTH * STEPS_PER_LAYER;
  void* args[] = {&ka, &lo, &hi};
  hipError_t e = hipLaunchCooperativeKernel((void*)k_mega<true, true>, dim3(grid_blocks), dim3(NTHREADS), args, LDS_BYTES, stream);
  if (e != hipSuccess) fprintf(stderr, "cooperative launch failed: %s (grid %d)\n", hipGetErrorString(e), grid_blocks);
}
#endif
```

```cpp
#ifndef CPU_TEST
#include <hip/hip_runtime.h>
#include <hip/hip_cooperative_groups.h>
#include <cstdio>
#include <cstring>
#include <cmath>
namespace cg = cooperative_groups;
#define DEV __device__ __forceinline__
#define HDI __host__ __device__ __forceinline__
#else
#include <cmath>
#include <cstdio>
#include <cstdlib>
#include <cstring>
#define DEV static inline
#define HDI static inline
#endif

#ifndef D_MODEL
#define D_MODEL 1024
#endif
#ifndef BATCH
#define BATCH 8
#endif
#ifndef MEGA
#define MEGA 1
#endif

constexpr int D = D_MODEL;
constexpr int SEQ = 2048;
constexpr int DEPTH = 2;
constexpr int MEM_LEN = 256;
constexpr int HD = 64;
constexpr int N_TOK = BATCH * SEQ;
constexpr int GLA_H = 4;
constexpr int DK = D / 2 / GLA_H;
constexpr int DV = D / GLA_H;
constexpr int GLA_RANK = 16;
constexpr int B_K = GLA_H * DK;
constexpr int B_V = GLA_H * DV;
constexpr int NSA_H = 16;
constexpr int NSA_G = 4;
constexpr int N_CMP = 127;
constexpr int CMP_HID = 128;
constexpr int N_BLK = 32;
constexpr int N_SELECT = 16;
constexpr int NSA_WIN = 512;
constexpr int XH = 4;
constexpr int XHD = D / XH;
constexpr int NE = 32;
constexpr int TOPK = 4;
constexpr int DFF = D;
constexpr float LN_EPS = 1e-5f;
constexpr float ALPHA = 1.41421356237309515f;

constexpr int OFF_AQ = 0;
constexpr int OFF_AK = 768;
constexpr int OFF_AV = 1536;
constexpr int OFF_BQ = 2304;
constexpr int OFF_BK = OFF_BQ + B_K;
constexpr int OFF_BV = OFF_BK + B_K;
constexpr int OFF_BR = OFF_BV + B_V;
constexpr int OFF_LR = OFF_BR + B_V;
constexpr int OFF_CQ = OFF_LR + GLA_RANK;
constexpr int OFF_CKC = OFF_CQ + 1024;
constexpr int OFF_CVC = OFF_CKC + 256;
constexpr int OFF_CKS = OFF_CVC + 256;
constexpr int OFF_CVS = OFF_CKS + 256;
constexpr int OFF_CKW = OFF_CVS + 256;
constexpr int OFF_CVW = OFF_CKW + 256;
constexpr int OFF_CG = OFF_CVW + 256;
constexpr int OFF_MG = OFF_CG + 48;
constexpr int N_IN = OFF_MG + 3 * D;
constexpr int N_IN_PAD = (N_IN + 255) / 256 * 256;
constexpr int MOE_ROWS = N_TOK * 4 + 32 * 256;
constexpr int CMP_ROWS_PAD = 4096;
constexpr int YLD = 256 + 1024 + 1024;

#ifdef CPU_TEST
typedef float act_t;
DEV float ldf(float v) { return v; }
DEV void stf(float* p, float v) { *p = v; }
#else
typedef unsigned short act_t;
DEV float ldf(unsigned short h) { return __uint_as_float(((unsigned)h) << 16); }
DEV float ldf(float v) { return v; }
DEV unsigned short f2bf(float f) {
  unsigned u = __float_as_uint(f);
  u += 0x7fffu + ((u >> 16) & 1u);
  return (unsigned short)(u >> 16);
}
DEV void stf(unsigned short* p, float v) { *p = f2bf(v); }
DEV void stf(float* p, float v) { *p = v; }
#endif

struct Params {
  const float *x, *mem, *ln0_g, *ln0_b, *w_in, *b_in, *w_alpha2, *b_alpha, *gla_norm_g,
      *cmp_pe_k, *cmp_w1_k, *cmp_w2_k, *cmp_pe_v, *cmp_w1_v, *cmp_w2_v,
      *w_br_a, *w_br_b, *w_br_c, *w_o_mix, *ln1_g, *ln1_b, *w_xq, *w_xk, *w_xv, *w_xo, *ln2_g, *ln2_b,
      *w_router, *b_router, *w_gu, *b_gu, *w_down, *b_down, *ln3_g, *ln3_b;
  float* out;
  float* xf;
  act_t* xb;
  act_t* u;
  float* ga;
  float* hid;
  float* kcv;
  float* opart;
  act_t* ya;
  act_t* yb;
  act_t* yc;
  float* pcmp;
  float* ocmp;
  float* impb;
  int* selb;
  act_t* merged;
  float* tmp;
  act_t* xq;
  act_t* memk;
  act_t* memv;
  float* xs;
  act_t* xo;
  float* rl;
  int* topi;
  float* topg;
  act_t* act;
  act_t* wt_in;
  act_t* wt_c1;
  act_t* wt_bra;
  act_t* wt_brb;
  act_t* wt_brc;
  act_t* wt_omix;
  act_t* wt_xq;
  act_t* wt_xk;
  act_t* wt_xv;
  act_t* wt_xo;
  act_t* wt_gu;
  act_t* wt_dn;
  act_t* membf;
  act_t* cmpA;
  float* mrg;
  int* cnt;
  int* rank;
  int* rowlist;
  act_t* xg;
  act_t* actg;
  float* yass;
  act_t* kcb;
  act_t* dilo;
  float* dill;
  unsigned* selm;
  act_t* gU;
  act_t* gS;
  act_t* gQ;
  float* gD;
  unsigned* barw;
  size_t ws_used;
};

#ifdef CPU_TEST
#define FOR_IDX(idx, total) \
  for (long long idx = (long long)(total) * tid / nthr, _e = (long long)(total) * (tid + 1) / nthr; idx < _e; ++idx)
#else
#define FOR_IDX(idx, total) for (long long idx = tid; idx < (long long)(total); idx += nthr)
#endif

DEV float sigmoidf_(float x) { return 1.0f / (1.0f + expf(-x)); }

template <class TA>
DEV float dotcol(const TA* a, const float* W, int K, long long ldw) {
  float s = 0.f;
  for (int k = 0; k < K; ++k) s += ldf(a[k]) * W[(long long)k * ldw];
  return s;
}

DEV void ph_ln(const float* src, const float* g, const float* b, float* dstf, act_t* dstb, float* dst2,
               long long tid, long long nthr) {
  FOR_IDX(n, N_TOK) {
    const float* r = src + n * D;
    float mu = 0.f;
    for (int i = 0; i < D; ++i) mu += r[i];
    mu /= D;
    float var = 0.f;
    for (int i = 0; i < D; ++i) { float d = r[i] - mu; var += d * d; }
    var /= D;
    float rs = 1.0f / sqrtf(var + LN_EPS);
    for (int i = 0; i < D; ++i) {
      float y = (r[i] - mu) * rs * g[i] + b[i];
      dstf[n * D + i] = y;
      stf(&dstb[n * D + i], y);
      if (dst2) dst2[n * D + i] = y;
    }
  }
}

DEV void ph_inproj(const Params& p, int li, long long tid, long long nthr) {
  const float* W = p.w_in + (long long)li * D * N_IN;
  const float* bias = p.b_in + (long long)li * N_IN;
  FOR_IDX(idx, (long long)N_TOK * N_IN) {
    long long n = idx / N_IN; int c = (int)(idx % N_IN);
    stf(&p.u[idx], dotcol(p.xb + n * D, W + c, D, N_IN) + bias[c]);
  }
}

DEV float gelu_tanh(float x) {
  return 0.5f * x * (1.0f + tanhf(0.7978845608028654f * (x + 0.044715f * x * x * x)));
}

constexpr int CMP_ROWS = BATCH * N_CMP * NSA_G;

template <int PARTS>
DEV void ph_pre(const Params& p, int li, long long tid, long long nthr) {
  const long long T1 = (long long)N_TOK * B_K;
  const long long T2 = (PARTS & 2) ? 2LL * CMP_ROWS * CMP_HID : 0;
  FOR_IDX(idx, T1 + T2) {
    if (idx < T1) {
      if (!(PARTS & 1)) continue;
      long long n = idx / B_K; int c = (int)(idx % B_K);
      const float* W2 = p.w_alpha2 + (long long)li * GLA_RANK * B_K;
      float z = p.b_alpha[li * B_K + c];
      for (int r = 0; r < GLA_RANK; ++r) z += ldf(p.u[n * N_IN + OFF_LR + r]) * W2[r * B_K + c];
      float ls = fminf(z, 0.f) - log1pf(expf(-fabsf(z)));
      p.ga[idx] = expf(ls * (1.0f / 16.0f));
    } else {
      long long i2 = idx - T1;
      int which = (int)(i2 / ((long long)CMP_ROWS * CMP_HID));
      long long rem = i2 % ((long long)CMP_ROWS * CMP_HID);
      int row = (int)(rem / CMP_HID), j = (int)(rem % CMP_HID);
      int g = row % NSA_G; int c = (row / NSA_G) % N_CMP; int b = row / (NSA_G * N_CMP);
      const float* pe = (which ? p.cmp_pe_v : p.cmp_pe_k) + (long long)li * 32 * HD;
      const float* w1 = (which ? p.cmp_w1_v : p.cmp_w1_k) + (long long)li * 32 * HD * CMP_HID;
      int off = (which ? OFF_CVC : OFF_CKC) + g * HD;
      float s = 0.f;
      for (int l = 0; l < 32; ++l) {
        const act_t* ur = p.u + ((long long)b * SEQ + c * 16 + l) * N_IN + off;
        for (int d = 0; d < HD; ++d) s += (ldf(ur[d]) + pe[l * HD + d]) * w1[(long long)(l * HD + d) * CMP_HID + j];
      }
      p.hid[i2] = gelu_tanh(s);
    }
  }
}

template <int PARTS>
DEV void ph_mix1(const Params& p, int li, long long tid, long long nthr) {
  const long long T1 = (long long)N_TOK * 4;
  const long long T2 = (long long)BATCH * GLA_H * DV * 4;
  const long long T3 = 2LL * CMP_ROWS * HD;
  FOR_IDX(idx, T1 + T2 + T3) {
    if (idx < T1) {
      if (!(PARTS & 1)) continue;
      long long n = idx / 4; int h = (int)(idx % 4);
      int b = (int)(n / SEQ), t = (int)(n % SEQ);
      float m = -INFINITY, l = 0.f;
      float acc[HD];
#pragma unroll
      for (int d = 0; d < HD; ++d) acc[d] = 0.f;
      for (int gi = 0; gi < 3; ++gi) {
        const int dil = gi == 0 ? 1 : (gi == 1 ? 4 : 16);
        float q[HD];
        const act_t* qp = p.u + n * N_IN + OFF_AQ + gi * 256 + h * HD;
#pragma unroll
        for (int d = 0; d < HD; ++d) q[d] = ldf(qp[d]);
        for (int mm = 0; mm <= 128; ++mm) {
          int tk = t - mm * dil;
          if (tk < 0) break;
          const act_t* kp = p.u + ((long long)b * SEQ + tk) * N_IN + OFF_AK + gi * 256 + h * HD;
          const act_t* vp = p.u + ((long long)b * SEQ + tk) * N_IN + OFF_AV + gi * 256 + h * HD;
          float s = 0.f;
#pragma unroll
          for (int d = 0; d < HD; ++d) s += q[d] * ldf(kp[d]);
          s *= 0.125f;
          float mn = fmaxf(m, s);
          float corr = expf(m - mn);
          float pp = expf(s - mn);
          l = l * corr + pp;
#pragma unroll
          for (int d = 0; d < HD; ++d) acc[d] = acc[d] * corr + pp * ldf(vp[d]);
          m = mn;
        }
      }
      float inv = 1.0f / l;
#pragma unroll
      for (int d = 0; d < HD; ++d) stf(&p.ya[n * 256 + h * HD + d], acc[d] * inv);
    } else if (idx < T1 + T2) {
      if (!(PARTS & 2)) continue;
      long long i2 = idx - T1;
      int v = (int)(i2 % DV); int cq = (int)((i2 / DV) % 4); int h = (int)((i2 / (DV * 4)) % GLA_H);
      int b = (int)(i2 / (DV * 4 * GLA_H));
      constexpr int DKQ = DK / 4;
      float st[DKQ];
#pragma unroll
      for (int c = 0; c < DKQ; ++c) st[c] = 0.f;
      const float qs = 1.0f / sqrtf((float)DK);
      for (int t = 0; t < SEQ; ++t) {
        long long n = (long long)b * SEQ + t;
        const act_t* ur = p.u + n * N_IN;
        float vt = ldf(ur[OFF_BV + h * DV + v]);
        const float* gar = p.ga + n * B_K + h * DK + cq * DKQ;
        const act_t* kr = ur + OFF_BK + h * DK + cq * DKQ;
        const act_t* qr = ur + OFF_BQ + h * DK + cq * DKQ;
        float o = 0.f;
#pragma unroll
        for (int c = 0; c < DKQ; ++c) {
          st[c] = gar[c] * st[c] + ldf(kr[c]) * vt;
          o += ldf(qr[c]) * st[c];
        }
        p.opart[((long long)cq * N_TOK + n) * B_V + h * DV + v] = o * qs;
      }
    } else {
      long long i2 = idx - T1 - T2;
      int which = (int)(i2 / ((long long)CMP_ROWS * HD));
      long long rem = i2 % ((long long)CMP_ROWS * HD);
      int row = (int)(rem / HD), d = (int)(rem % HD);
      const float* w2 = (which ? p.cmp_w2_v : p.cmp_w2_k) + (long long)li * CMP_HID * HD;
      const float* hr = p.hid + ((long long)which * CMP_ROWS + row) * CMP_HID;
      float s = 0.f;
      if (!(PARTS & 4)) continue;
      for (int j = 0; j < CMP_HID; ++j) s += hr[j] * w2[j * HD + d];
      p.kcv[i2] = s;
#ifndef CPU_TEST
      {
        const int g_ = row % NSA_G, c_ = (row / NSA_G) % N_CMP, b_ = row / (NSA_G * N_CMP);
        stf(&p.kcb[((((size_t)which * BATCH + b_) * 128 + c_) * NSA_G + g_) * 64 + d], s);
      }
#endif
    }
  }
}

template <int PARTS>
DEV void ph_nsa1(const Params& p, int li, long long tid, long long nthr) {
  const long long T1 = (long long)N_TOK * GLA_H;
  const long long T2 = (PARTS & 2) ? (long long)N_TOK * NSA_H : 0;
  FOR_IDX(idx, T1 + T2) {
    if (idx < T1) {
      long long n = idx / GLA_H; int h = (int)(idx % GLA_H);
      float ss = 0.f;
      for (int v = 0; v < DV; ++v) {
        float o = 0.f;
        for (int cq = 0; cq < 4; ++cq) o += p.opart[((long long)cq * N_TOK + n) * B_V + h * DV + v];
        ss += o * o;
      }
      float rs = 1.0f / sqrtf(ss / DV + LN_EPS);
      for (int v = 0; v < DV; ++v) {
        float o = 0.f;
        for (int cq = 0; cq < 4; ++cq) o += p.opart[((long long)cq * N_TOK + n) * B_V + h * DV + v];
        float r = ldf(p.u[n * N_IN + OFF_BR + h * DV + v]);
        float y = o * rs * p.gla_norm_g[li * DV + v] * (r * sigmoidf_(r));
        stf(&p.yb[n * B_V + h * DV + v], y);
      }
    } else {
      long long i2 = idx - T1;
      long long n = i2 / NSA_H; int hh = (int)(i2 % NSA_H);
      int b = (int)(n / SEQ), t = (int)(n % SEQ);
      int g = hh / 4;
      int nv = t >= 31 ? (t - 31) / 16 + 1 : 0;
      if (nv > N_CMP) nv = N_CMP;
      float q[HD];
      const act_t* qp = p.u + n * N_IN + OFF_CQ + hh * HD;
#pragma unroll
      for (int d = 0; d < HD; ++d) q[d] = ldf(qp[d]);
      float* prow = p.pcmp + (((long long)b * NSA_H + hh) * SEQ + t) * 128;
      float m = -INFINITY;
      for (int c = 0; c < nv; ++c) {
        const float* kp = p.kcv + (((long long)b * N_CMP + c) * NSA_G + g) * HD;
        float s = 0.f;
#pragma unroll
        for (int d = 0; d < HD; ++d) s += q[d] * kp[d];
        s *= 0.125f;
        prow[c] = s;
        m = fmaxf(m, s);
      }
      float acc[HD];
#pragma unroll
      for (int d = 0; d < HD; ++d) acc[d] = 0.f;
      float l = 0.f;
      for (int c = 0; c < nv; ++c) {
        const float* vp = p.kcv + (((long long)CMP_ROWS) + ((long long)b * N_CMP + c) * NSA_G + g) * HD;
        float pp = expf(prow[c] - m);
        l += pp;
        prow[c] = pp;
#pragma unroll
        for (int d = 0; d < HD; ++d) acc[d] += pp * vp[d];
      }
      float inv = 1.0f / fmaxf(l, 1e-30f);
      for (int c = 0; c < 128; ++c) prow[c] = c < nv ? prow[c] * inv : 0.f;
#pragma unroll
      for (int d = 0; d < HD; ++d) p.ocmp[n * 1024 + hh * HD + d] = acc[d] * inv;
    }
  }
}

DEV void ph_nsa2(const Params& p, int li, long long tid, long long nthr) {
  FOR_IDX(idx, (long long)BATCH * NSA_G * SEQ * N_BLK) {
    int j = (int)(idx % N_BLK); long long r = idx / N_BLK;
    int s = (int)(r % SEQ); int g = (int)((r / SEQ) % NSA_G); int b = (int)(r / ((long long)SEQ * NSA_G));
    int qb = s / 64;
    float imp;
    if (j == 0 || j == qb || j == qb - 1) imp = INFINITY;
    else if (j > qb) imp = -INFINITY;
    else {
      imp = 0.f;
      int c0 = 4 * j - 1; if (c0 < 0) c0 = 0;
      int c1 = 4 * j + 3; if (c1 > N_CMP - 1) c1 = N_CMP - 1;
      for (int rr = 0; rr < 4; ++rr) {
        const float* prow = p.pcmp + (((long long)b * NSA_H + g * 4 + rr) * SEQ + s) * 128;
        for (int c = c0; c <= c1; ++c) imp += prow[c];
      }
    }
    p.impb[idx] = imp;
  }
}

DEV void ph_nsa3(const Params& p, int li, long long tid, long long nthr) {
  FOR_IDX(idx, (long long)BATCH * NSA_G * SEQ * N_BLK) {
    int j = (int)(idx % N_BLK); long long r = idx / N_BLK;
    const float* ir = p.impb + r * N_BLK;
    float v = ir[j];
    int rank = 0;
    for (int jj = 0; jj < N_BLK; ++jj) {
      float w = ir[jj];
      if (w > v || (w == v && jj < j)) ++rank;
    }
    p.selb[idx] = rank < N_SELECT ? 1 : 0;
  }
}

DEV void ph_nsa4(const Params& p, int li, long long tid, long long nthr) {
  FOR_IDX(idx, (long long)N_TOK * NSA_H) {
    long long n = idx / NSA_H; int hh = (int)(idx % NSA_H);
    int b = (int)(n / SEQ), t = (int)(n % SEQ);
    int g = hh / 4;
    float q[HD];
    const act_t* qp = p.u + n * N_IN + OFF_CQ + hh * HD;
#pragma unroll
    for (int d = 0; d < HD; ++d) q[d] = ldf(qp[d]);
    float g0 = sigmoidf_(ldf(p.u[n * N_IN + OFF_CG + hh * 3 + 0]));
    float g1 = sigmoidf_(ldf(p.u[n * N_IN + OFF_CG + hh * 3 + 1]));
    float g2 = sigmoidf_(ldf(p.u[n * N_IN + OFF_CG + hh * 3 + 2]));
    float acc[HD];
    {
      float m = -INFINITY, l = 0.f;
#pragma unroll
      for (int d = 0; d < HD; ++d) acc[d] = 0.f;
      int qb = t / 64;
      const int* sr = p.selb + (((long long)b * NSA_G + g) * SEQ + t) * N_BLK;
      for (int j = 0; j <= qb; ++j) {
        if (!sr[j]) continue;
        int hi = j * 64 + 63; if (hi > t) hi = t;
        for (int tk = j * 64; tk <= hi; ++tk) {
          const act_t* kp = p.u + ((long long)b * SEQ + tk) * N_IN + OFF_CKS + g * HD;
          const act_t* vp = p.u + ((long long)b * SEQ + tk) * N_IN + OFF_CVS + g * HD;
          float s = 0.f;
#pragma unroll
          for (int d = 0; d < HD; ++d) s += q[d] * ldf(kp[d]);
          s *= 0.125f;
          float mn = fmaxf(m, s);
          float corr = expf(m - mn);
          float pp = expf(s - mn);
          l = l * corr + pp;
#pragma unroll
          for (int d = 0; d < HD; ++d) acc[d] = acc[d] * corr + pp * ldf(vp[d]);
          m = mn;
        }
      }
      float inv = 1.0f / l;
#pragma unroll
      for (int d = 0; d < HD; ++d) {
        float* oc = &p.ocmp[n * 1024 + hh * HD + d];
        *oc = g0 * (*oc) + g1 * acc[d] * inv;
      }
    }
    {
      float m = -INFINITY, l = 0.f;
#pragma unroll
      for (int d = 0; d < HD; ++d) acc[d] = 0.f;
      int lo = t - (NSA_WIN - 1); if (lo < 0) lo = 0;
      for (int tk = lo; tk <= t; ++tk) {
        const act_t* kp = p.u + ((long long)b * SEQ + tk) * N_IN + OFF_CKW + g * HD;
        const act_t* vp = p.u + ((long long)b * SEQ + tk) * N_IN + OFF_CVW + g * HD;
        float s = 0.f;
#pragma unroll
        for (int d = 0; d < HD; ++d) s += q[d] * ldf(kp[d]);
        s *= 0.125f;
        float mn = fmaxf(m, s);
        float corr = expf(m - mn);
        float pp = expf(s - mn);
        l = l * corr + pp;
#pragma unroll
        for (int d = 0; d < HD; ++d) acc[d] = acc[d] * corr + pp * ldf(vp[d]);
        m = mn;
      }
      float inv = 1.0f / l;
#pragma unroll
      for (int d = 0; d < HD; ++d)
        stf(&p.yc[n * 1024 + hh * HD + d], p.ocmp[n * 1024 + hh * HD + d] + g2 * acc[d] * inv);
    }
  }
}

DEV void ph_br(const Params& p, int li, long long tid, long long nthr) {
  const float* Wa = p.w_br_a + (long long)li * 256 * D;
  const float* Wb = p.w_br_b + (long long)li * B_V * D;
  const float* Wc = p.w_br_c + (long long)li * 1024 * D;
  FOR_IDX(idx, (long long)N_TOK * D) {
    long long n = idx / D; int d = (int)(idx % D);
    float s0 = dotcol(p.ya + n * 256, Wa + d, 256, D);
    float s1 = dotcol(p.yb + n * B_V, Wb + d, B_V, D);
    float s2 = dotcol(p.yc + n * 1024, Wc + d, 1024, D);
    const act_t* mg = p.u + n * N_IN + OFF_MG;
    float y = sigmoidf_(ldf(mg[d])) * s0 + sigmoidf_(ldf(mg[D + d])) * s1 + sigmoidf_(ldf(mg[2 * D + d])) * s2;
    stf(&p.merged[idx], y);
  }
}

DEV void ph_proj_res(const Params& p, const act_t* a, const float* W, long long tid, long long nthr) {
  FOR_IDX(idx, (long long)N_TOK * D) {
    long long n = idx / D; int d = (int)(idx % D);
    p.tmp[idx] = ALPHA * p.xf[idx] + dotcol(a + n * D, W + d, D, D);
  }
}

DEV void ph_xq(const Params& p, int li, long long tid, long long nthr) {
  const long long T1 = (long long)N_TOK * D;
  const long long T2 = 2LL * BATCH * MEM_LEN * D;
  const float* Wq = p.w_xq + (long long)li * D * D;
  FOR_IDX(idx, T1 + T2) {
    if (idx < T1) {
      long long n = idx / D; int d = (int)(idx % D);
      stf(&p.xq[idx], dotcol(p.xb + n * D, Wq + d, D, D));
    } else {
      long long i2 = idx - T1;
      int which = (int)(i2 / ((long long)BATCH * MEM_LEN * D));
      long long rem = i2 % ((long long)BATCH * MEM_LEN * D);
      long long r = rem / D; int d = (int)(rem % D);
      const float* W = (which ? p.w_xv : p.w_xk) + (long long)li * D * D;
      float s = dotcol(p.mem + r * D, W + d, D, D);
      stf(which ? &p.memv[rem] : &p.memk[rem], s);
    }
  }
}

DEV void ph_xs(const Params& p, int li, long long tid, long long nthr) {
  const float sc = 1.0f / sqrtf((float)XHD);
  FOR_IDX(idx, (long long)N_TOK * XH * MEM_LEN) {
    int m = (int)(idx % MEM_LEN); int h = (int)((idx / MEM_LEN) % XH); long long n = idx / (MEM_LEN * XH);
    int b = (int)(n / SEQ);
    const act_t* q = p.xq + n * D + h * XHD;
    const act_t* k = p.memk + ((long long)b * MEM_LEN + m) * D + h * XHD;
    float s = 0.f;
    for (int d = 0; d < XHD; ++d) s += ldf(q[d]) * ldf(k[d]);
    p.xs[idx] = s * sc;
  }
}

DEV void ph_xo(const Params& p, int li, long long tid, long long nthr) {
  FOR_IDX(idx, (long long)N_TOK * D) {
    long long n = idx / D; int c = (int)(idx % D);
    int h = c / XHD; int b = (int)(n / SEQ);
    const float* sr = p.xs + (n * XH + h) * MEM_LEN;
    float m = -INFINITY;
    for (int mm = 0; mm < MEM_LEN; ++mm) m = fmaxf(m, sr[mm]);
    float l = 0.f, o = 0.f;
    for (int mm = 0; mm < MEM_LEN; ++mm) {
      float pp = expf(sr[mm] - m);
      l += pp;
      o += pp * ldf(p.memv[((long long)b * MEM_LEN + mm) * D + c]);
    }
    stf(&p.xo[idx], o / l);
  }
}

DEV void ph_rlogit(const Params& p, int li, long long tid, long long nthr) {
  const float* W = p.w_router + (long long)li * D * NE;
  FOR_IDX(idx, (long long)N_TOK * NE) {
    long long n = idx / NE; int e = (int)(idx % NE);
    p.rl[idx] = dotcol(p.xf + n * D, W + e, D, NE) + p.b_router[li * NE + e];
  }
}

DEV void ph_route(const Params& p, int li, long long tid, long long nthr) {
  FOR_IDX(n, N_TOK) {
    const float* r = p.rl + n * NE;
    int i0 = -1, i1 = -1, i2 = -1, i3 = -1;
    float v0 = 0, v1 = 0, v2 = 0, v3 = 0;
    for (int k = 0; k < 4; ++k) {
      int bi = -1; float bv = -INFINITY;
      for (int e = 0; e < NE; ++e) {
        if (e == i0 || e == i1 || e == i2) continue;
        float v = r[e];
        if (bi < 0 || v > bv) { bi = e; bv = v; }
      }
      if (k == 0) { i0 = bi; v0 = bv; } else if (k == 1) { i1 = bi; v1 = bv; }
      else if (k == 2) { i2 = bi; v2 = bv; } else { i3 = bi; v3 = bv; }
    }
    float e0 = 1.0f, e1 = expf(v1 - v0), e2 = expf(v2 - v0), e3 = expf(v3 - v0);
    float inv = 1.0f / (e0 + e1 + e2 + e3);
#ifndef CPU_TEST
    p.rank[n * 4 + 0] = atomicAdd(&p.cnt[li * 32 + i0], 1);
    p.rank[n * 4 + 1] = atomicAdd(&p.cnt[li * 32 + i1], 1);
    p.rank[n * 4 + 2] = atomicAdd(&p.cnt[li * 32 + i2], 1);
    p.rank[n * 4 + 3] = atomicAdd(&p.cnt[li * 32 + i3], 1);
#endif
    p.topi[n * 4 + 0] = i0; p.topi[n * 4 + 1] = i1; p.topi[n * 4 + 2] = i2; p.topi[n * 4 + 3] = i3;
    p.topg[n * 4 + 0] = e0 * inv; p.topg[n * 4 + 1] = e1 * inv; p.topg[n * 4 + 2] = e2 * inv; p.topg[n * 4 + 3] = e3 * inv;
  }
}

DEV void ph_moe1(const Params& p, int li, long long tid, long long nthr) {
  FOR_IDX(idx, (long long)N_TOK * TOPK * DFF) {
    int j = (int)(idx % DFF); long long a = idx / DFF; long long n = a / TOPK;
    int e = p.topi[a];
    const float* W = p.w_gu + ((long long)li * NE + e) * D * 2 * DFF;
    const float* bb = p.b_gu + ((long long)li * NE + e) * 2 * DFF;
    float gt = dotcol(p.xb + n * D, W + j, D, 2 * DFF) + bb[j];
    float up = dotcol(p.xb + n * D, W + DFF + j, D, 2 * DFF) + bb[DFF + j];
    gt = fminf(gt, 7.0f);
    up = fminf(fmaxf(up, -7.0f), 7.0f);
    stf(&p.act[idx], (up + 1.0f) * gt * sigmoidf_(1.702f * gt));
  }
}

DEV void ph_moe2(const Params& p, int li, long long tid, long long nthr) {
  FOR_IDX(idx, (long long)N_TOK * D) {
    long long n = idx / D; int d = (int)(idx % D);
    float y = 0.f;
    for (int k = 0; k < TOPK; ++k) {
      int e = p.topi[n * 4 + k];
      const float* W = p.w_down + ((long long)li * NE + e) * DFF * D;
      float s = dotcol(p.act + (n * 4 + k) * DFF, W + d, DFF, D) + p.b_down[((long long)li * NE + e) * D + d];
      y += p.topg[n * 4 + k] * s;
    }
    p.tmp[idx] = ALPHA * p.xf[idx] + y;
  }
}

constexpr int PH_PER_LAYER = 20;
constexpr int N_PHASES = 1 + DEPTH * PH_PER_LAYER;

template <int K>
DEV void run_phase_k(const Params& p, int li, long long tid, long long nthr) {
  if constexpr (K == -1) ph_ln(p.x, p.ln0_g, p.ln0_b, p.xf, p.xb, nullptr, tid, nthr);
  if constexpr (K == 0) ph_inproj(p, li, tid, nthr);
  if constexpr (K == 1) ph_pre<3>(p, li, tid, nthr);
  if constexpr (K == 20) ph_pre<1>(p, li, tid, nthr);
  if constexpr (K == 2) ph_mix1<7>(p, li, tid, nthr);
  if constexpr (K == 21) ph_mix1<4>(p, li, tid, nthr);
  if constexpr (K == 3) ph_nsa1<3>(p, li, tid, nthr);
  if constexpr (K == 22) ph_nsa1<1>(p, li, tid, nthr);
  if constexpr (K == 4) ph_nsa2(p, li, tid, nthr);
  if constexpr (K == 5) ph_nsa3(p, li, tid, nthr);
  if constexpr (K == 6) ph_nsa4(p, li, tid, nthr);
  if constexpr (K == 7) ph_br(p, li, tid, nthr);
  if constexpr (K == 8) ph_proj_res(p, p.merged, p.w_o_mix + (long long)li * D * D, tid, nthr);
  if constexpr (K == 9) ph_ln(p.tmp, p.ln1_g + li * D, p.ln1_b + li * D, p.xf, p.xb, nullptr, tid, nthr);
  if constexpr (K == 10) ph_xq(p, li, tid, nthr);
  if constexpr (K == 11) ph_xs(p, li, tid, nthr);
  if constexpr (K == 12) ph_xo(p, li, tid, nthr);
  if constexpr (K == 13) ph_proj_res(p, p.xo, p.w_xo + (long long)li * D * D, tid, nthr);
  if constexpr (K == 14) ph_ln(p.tmp, p.ln2_g + li * D, p.ln2_b + li * D, p.xf, p.xb, nullptr, tid, nthr);
  if constexpr (K == 15) ph_rlogit(p, li, tid, nthr);
  if constexpr (K == 16) ph_route(p, li, tid, nthr);
  if constexpr (K == 17) ph_moe1(p, li, tid, nthr);
  if constexpr (K == 18) ph_moe2(p, li, tid, nthr);
  if constexpr (K == 19) ph_ln(p.tmp, p.ln3_g + li * D, p.ln3_b + li * D, p.xf, p.xb, li == DEPTH - 1 ? p.out : nullptr, tid, nthr);
}

DEV void run_phase(const Params& p, int ph, long long tid, long long nthr) {
  if (ph == 0) { run_phase_k<-1>(p, 0, tid, nthr); return; }
  int li = (ph - 1) / PH_PER_LAYER, k = (ph - 1) % PH_PER_LAYER;
  switch (k) {
#define PHC(K) case K: run_phase_k<K>(p, li, tid, nthr); break;
    PHC(0) PHC(1) PHC(2) PHC(3) PHC(4) PHC(5) PHC(6) PHC(7) PHC(8) PHC(9)
    PHC(10) PHC(11) PHC(12) PHC(13) PHC(14) PHC(15) PHC(16) PHC(17) PHC(18) PHC(19)
#undef PHC
  }
}

#ifdef CPU_TEST
#define HDI_M
#else
#define HDI_M __host__ __device__ __forceinline__
#endif
struct Carver {
  char* base; size_t off;
  template <class T> HDI_M T* take(size_t n) {
    T* r = (T*)(base + off);
    off += (n * sizeof(T) + 255) & ~(size_t)255;
    return r;
  }
};

HDI void fill_params(Params& p, void* const* d_in, void* d_out, void* d_ws) {
  const float* const* in = (const float* const*)d_in;
  p.x = in[0]; p.mem = in[1]; p.ln0_g = in[2]; p.ln0_b = in[3]; p.w_in = in[4]; p.b_in = in[5];
  p.w_alpha2 = in[6]; p.b_alpha = in[7]; p.gla_norm_g = in[8];
  p.cmp_pe_k = in[9]; p.cmp_w1_k = in[10]; p.cmp_w2_k = in[11]; p.cmp_pe_v = in[12]; p.cmp_w1_v = in[13]; p.cmp_w2_v = in[14];
  p.w_br_a = in[15]; p.w_br_b = in[16]; p.w_br_c = in[17]; p.w_o_mix = in[18]; p.ln1_g = in[19]; p.ln1_b = in[20];
  p.w_xq = in[21]; p.w_xk = in[22]; p.w_xv = in[23]; p.w_xo = in[24]; p.ln2_g = in[25]; p.ln2_b = in[26];
  p.w_router = in[27]; p.b_router = in[28]; p.w_gu = in[29]; p.b_gu = in[30]; p.w_down = in[31]; p.b_down = in[32];
  p.ln3_g = in[33]; p.ln3_b = in[34];
  p.out = (float*)d_out;
  Carver c{(char*)d_ws, 0};
  p.barw = c.take<unsigned>(4096);
  p.xf = c.take<float>((size_t)N_TOK * D);
  p.xb = c.take<act_t>((size_t)N_TOK * D);
  p.u = c.take<act_t>((size_t)N_TOK * N_IN);
  p.ga = c.take<float>((size_t)N_TOK * B_K);
  p.hid = c.take<float>((size_t)2 * CMP_ROWS * CMP_HID);
  p.kcv = c.take<float>((size_t)2 * CMP_ROWS * HD);
  p.opart = c.take<float>((size_t)4 * N_TOK * B_V);
  p.yass = p.opart;
#ifdef CPU_TEST
  p.ya = c.take<act_t>((size_t)N_TOK * 256);
  p.yb = c.take<act_t>((size_t)N_TOK * B_V);
  p.yc = c.take<act_t>((size_t)N_TOK * 1024);
#else
  p.ya = c.take<act_t>((size_t)N_TOK * YLD);
  p.yb = p.ya + 256;
  p.yc = p.ya + 1280;
#endif
  p.pcmp = c.take<float>((size_t)MOE_ROWS * 1024 / 2 > (size_t)BATCH * NSA_H * SEQ * 128 ? (size_t)MOE_ROWS * 1024 / 2 : (size_t)BATCH * NSA_H * SEQ * 128);
  p.xg = (act_t*)p.pcmp;
  p.ocmp = c.take<float>((size_t)N_TOK * 1024);
  p.impb = c.take<float>((size_t)BATCH * NSA_G * SEQ * N_BLK);
  p.selb = c.take<int>((size_t)BATCH * NSA_G * SEQ * N_BLK);
  p.merged = c.take<act_t>((size_t)N_TOK * D);
  p.tmp = c.take<float>((size_t)N_TOK * D);
  p.xq = c.take<act_t>((size_t)N_TOK * D);
  p.memk = c.take<act_t>((size_t)BATCH * MEM_LEN * D);
  p.memv = c.take<act_t>((size_t)BATCH * MEM_LEN * D);
  p.xs = c.take<float>((size_t)N_TOK * XH * MEM_LEN);
  p.mrg = p.xs;
  p.xo = c.take<act_t>((size_t)N_TOK * D);
  p.rl = c.take<float>((size_t)N_TOK * NE);
  p.topi = c.take<int>((size_t)N_TOK * TOPK);
  p.topg = c.take<float>((size_t)N_TOK * TOPK);
  p.actg = c.take<act_t>((size_t)MOE_ROWS * 1024);
  p.act = p.actg;
  p.wt_in = c.take<act_t>((size_t)2 * N_IN_PAD * 1024);
  p.wt_c1 = c.take<act_t>((size_t)2 * 2 * 256 * 2048);
  p.wt_bra = c.take<act_t>((size_t)2 * 1024 * YLD);
  p.wt_brb = p.wt_bra + 256;
  p.wt_brc = p.wt_bra + 1280;
  p.wt_omix = c.take<act_t>((size_t)2 * 1024 * 1024);
  p.wt_xq = c.take<act_t>((size_t)2 * 1024 * 1024);
  p.wt_xk = c.take<act_t>((size_t)2 * 1024 * 1024);
  p.wt_xv = c.take<act_t>((size_t)2 * 1024 * 1024);
  p.wt_xo = c.take<act_t>((size_t)2 * 1024 * 1024);
  p.wt_gu = c.take<act_t>((size_t)2 * 32 * 2048 * 1024);
  p.wt_dn = c.take<act_t>((size_t)2 * 32 * 1024 * 1024);
  p.membf = c.take<act_t>((size_t)BATCH * MEM_LEN * 1024);
  p.cmpA = c.take<act_t>((size_t)2 * CMP_ROWS_PAD * 2048);
  p.cnt = c.take<int>(64);
  p.rank = c.take<int>((size_t)N_TOK * 4);
  p.rowlist = c.take<int>((size_t)MOE_ROWS);
  p.kcb = c.take<act_t>((size_t)2 * BATCH * 128 * NSA_G * 64);
  p.dilo = c.take<act_t>((size_t)3 * N_TOK * 256);
  p.dill = c.take<float>((size_t)3 * N_TOK * 4);
  p.selm = c.take<unsigned>((size_t)BATCH * NSA_G * SEQ);
  p.gU = p.xg; p.gQ = p.xg + (size_t)1024 * 128 * 256; p.gS = p.actg; p.gD = p.opart + (size_t)N_TOK * 1024;
  p.ws_used = c.off;
}

#ifndef CPU_TEST
#ifndef NSA_PROBE
#define NSA_PROBE 0
#endif
#ifndef GSEG
#define GSEG -1
#endif
static_assert(D == 1024 && BATCH == 8, "optimized path is written for the graded shapes");
namespace pg8 {
#define PG8_LAS __attribute__((address_space(3)))
typedef unsigned short bf16_t;
typedef short bf16x8 __attribute__((ext_vector_type(8)));
typedef float f32x4 __attribute__((ext_vector_type(4)));
typedef unsigned u32x4 __attribute__((ext_vector_type(4)));
constexpr int BM = 256, BK = 64, HALF = 128, HTB = HALF * BK * 2  , STAGE_BYTES = 8 * HTB, NXCD = 8, WGM = 8;

__host__ __device__ __forceinline__ int lds_byte(int r, int c) { const int st = (r >> 4) * 2 + (c >> 5), rr = r & 15, cc = c & 31, ob = rr * 64 + cc * 2; return st * 1024 + (ob ^ (((ob >> 9) & 1) << 5)); }
__host__ __device__ __forceinline__ void stage_rc(int b, int& R, int& C) { const int st = b / 1024, sb = b % 1024, swz = sb ^ (((sb >> 9) & 1) << 5); R = (st >> 1) * 16 + swz / 64; C = (st & 1) * 32 + (swz % 64) / 2; }
__host__ __device__ __forceinline__ int perm32(int rho) { const int n = rho >> 4, i = rho & 15; return 8 * (i >> 2) + 4 * n + (i & 3); }

struct Unit { int pm, pn; };
struct Gemm { const bf16_t* A; const bf16_t* Bt; int M, N, K; };

struct StaticOrder {
    int nM, nN, nwg, G, c;
    __host__ __device__ void init(int M, int N, int G_, int c_) { nM = M / BM; nN = N / BM; nwg = nM * nN; G = G_; c = c_; }
    __host__ __device__ bool next(int i, Unit& u) const {
        const long L = (long)i * G + c; if (L >= nwg) return false;
        int wgid = (int)L; { const int q = nwg / NXCD, r = nwg % NXCD, xcd = wgid % NXCD, off = wgid / NXCD; wgid = (xcd < r ? xcd * (q + 1) : r * (q + 1) + (xcd - r) * q) + off; }
        const int nig = WGM * nN, gid = wgid / nig, fm = gid * WGM, gsz = (nM - fm) < WGM ? (nM - fm) : WGM;
        u.pm = fm + ((wgid % nig) % gsz); u.pn = (wgid % nig) / gsz; return true;
    }
    __device__ __forceinline__ void a_ready(const Unit&) const {}
    __device__ __forceinline__ void done(const Unit&) const {}
};

__device__ __forceinline__ unsigned cvt_pk_bf16(float lo, float hi) { unsigned r; asm volatile("v_cvt_pk_bf16_f32 %0, %1, %2" : "=v"(r) : "v"(lo), "v"(hi)); return r; }

template <class Epi, class Sched, bool ALIGN_EPI = false, bool SP2 = false>
__device__ __forceinline__ void gemm_phase(PG8_LAS unsigned char* lds, const Gemm g, const Sched& S, const Epi& E, const int tid) {
    const int wid = __builtin_amdgcn_readfirstlane(tid >> 6), lane = tid & 63, wr = wid >> 2, wc = wid & 3, fr = lane & 15, fq = lane >> 4;
    const int K = g.K, nt = K / BK;
    unsigned voffA[2], voffB[2];
#pragma unroll
    for (int i = 0; i < 2; ++i) { int R, C; stage_rc(tid * 16 + i * 8192, R, C); const int Rb = Epi::PERM ? ((R & ~31) + perm32(R & 31)) : R;
        voffA[i] = (unsigned)(R * K + C) * 2u; voffB[i] = (unsigned)(Rb * K + C) * 2u; }
    const size_t kstep = (size_t)(BK * 2);
    const size_t hstep = (size_t)HALF * K * 2;
    const size_t tstep = 2 * hstep;
    const unsigned ldsw = (unsigned)wid * 1024u;
    const int aoff = lds_byte(wr * 64 + fr, fq * 8), boff = lds_byte(wc * 32 + fr, fq * 8);
#define PG8_SA(b, h) (((b) * 2 + (h)) * HTB)
#define PG8_SB(b, h) ((4 + (b) * 2 + (h)) * HTB)
#define PG8_STAGE(bufoff, gbase, voff) do { _Pragma("unroll") for (int _i = 0; _i < 2; ++_i) \
        __builtin_amdgcn_global_load_lds((const unsigned*)((const char*)(gbase) + (voff)[_i]), (PG8_LAS unsigned*)(lds + (bufoff) + ldsw + _i * 8192), 16, 0, 0); } while (0)
#define PG8_LDA(dst, b, h) do { _Pragma("unroll") for (int m = 0; m < 4; ++m) _Pragma("unroll") for (int k = 0; k < 2; ++k) dst[m][k] = *(const PG8_LAS bf16x8*)(lds + PG8_SA(b, h) + aoff + m * 2048 + k * 1024); } while (0)
#define PG8_LDB(dst, b, h) do { _Pragma("unroll") for (int n = 0; n < 2; ++n) _Pragma("unroll") for (int k = 0; k < 2; ++k) dst[n][k] = *(const PG8_LAS bf16x8*)(lds + PG8_SB(b, h) + boff + n * 2048 + k * 1024); } while (0)
#define PG8_MMA(ai, bj, At, Bt) do { __builtin_amdgcn_s_setprio(1); _Pragma("unroll") for (int m = 0; m < 4; ++m) _Pragma("unroll") for (int n = 0; n < 2; ++n) _Pragma("unroll") for (int k = 0; k < 2; ++k) \
        acc[ai][bj][m][n] = __builtin_amdgcn_mfma_f32_16x16x32_bf16(Bt[n][k], At[m][k], acc[ai][bj][m][n], 0, 0, 0); __builtin_amdgcn_s_setprio(0); } while (0)
#define PG8_WAIT_V(n) asm volatile("s_waitcnt vmcnt(" #n ")" ::: "memory")
#define PG8_WAIT_L(n) asm volatile("s_waitcnt lgkmcnt(" #n ")" ::: "memory")
#define PG8_BAR __builtin_amdgcn_s_barrier()
#define PG8_SCHED __builtin_amdgcn_sched_barrier(0)
    Unit cur, nxt; int ui = 0;
    if (!S.next(0, cur)) return;
    f32x4 acc[2][2][4][2];
#pragma unroll
    for (int a = 0; a < 2; ++a)
#pragma unroll
        for (int b = 0; b < 2; ++b)
#pragma unroll
            for (int m = 0; m < 4; ++m)
#pragma unroll
                for (int n = 0; n < 2; ++n) acc[a][b][m][n] = (f32x4){0.f, 0.f, 0.f, 0.f};
    bf16x8 At[4][2], B0[2][2], B1[2][2];
    const char* cA = (const char*)g.A + (size_t)cur.pm * tstep; const char* cB = (const char*)g.Bt + (size_t)cur.pn * tstep;
    S.a_ready(cur);
    if constexpr (SP2) {
        PG8_STAGE(PG8_SB(0, 0), cB, voffB); PG8_STAGE(PG8_SB(0, 1), cB + hstep, voffB); PG8_STAGE(PG8_SA(0, 0), cA, voffA); PG8_STAGE(PG8_SA(0, 1), cA + hstep, voffA);
        if (wr == 1) PG8_BAR;
        PG8_WAIT_V(2); PG8_BAR;
        PG8_STAGE(PG8_SB(1, 0), cB + kstep, voffB); PG8_STAGE(PG8_SA(1, 0), cA + kstep, voffA); PG8_STAGE(PG8_SB(1, 1), cB + hstep + kstep, voffB);
        PG8_WAIT_V(6); PG8_BAR;
    } else {
        PG8_STAGE(PG8_SB(0, 0), cB, voffB); PG8_STAGE(PG8_SA(0, 0), cA, voffA); PG8_STAGE(PG8_SB(0, 1), cB + hstep, voffB); PG8_STAGE(PG8_SA(0, 1), cA + hstep, voffA);
        if (wr == 1) PG8_BAR;
        PG8_WAIT_V(4); PG8_BAR;
        PG8_STAGE(PG8_SB(1, 0), cB + kstep, voffB); PG8_STAGE(PG8_SA(1, 0), cA + kstep, voffA); PG8_STAGE(PG8_SB(1, 1), cB + hstep + kstep, voffB);
        PG8_WAIT_V(6); PG8_BAR;
    }
    for (;;) {
        const bool has_next = S.next(ui + 1, nxt);
        const char* nA = has_next ? (const char*)g.A + (size_t)nxt.pm * tstep : cA; const char* nB = has_next ? (const char*)g.Bt + (size_t)nxt.pn * tstep : cB;
        for (int t = 0; t < nt; t += 2) {
            const bool last = (t == nt - 2);
            const char* a1 = cA + (size_t)(t + 1) * kstep;
            const char* a2 = last ? nA : cA + (size_t)(t + 2) * kstep; const char* b2 = last ? nB : cB + (size_t)(t + 2) * kstep;
            const char* a3 = a2 + kstep; const char* b3 = b2 + kstep;
            if (last && has_next) S.a_ready(nxt);
            asm volatile("" : "+v"(voffA[0]), "+v"(voffA[1]), "+v"(voffB[0]), "+v"(voffB[1]));
            E.mid(acc, cur, wr, wc, t);
            if constexpr (SP2) {
            PG8_LDB(B0, 0, 0); PG8_LDB(B1, 0, 1); PG8_SCHED; PG8_LDA(At, 0, 0); PG8_STAGE(PG8_SA(1, 1), a1 + hstep, voffA);
            PG8_WAIT_V(8); PG8_WAIT_L(0); PG8_BAR; PG8_MMA(0, 0, At, B0); PG8_MMA(0, 1, At, B1); PG8_BAR; PG8_SCHED;
            PG8_LDA(At, 0, 1); PG8_STAGE(PG8_SB(0, 0), b2, voffB); PG8_STAGE(PG8_SB(0, 1), b2 + hstep, voffB); PG8_STAGE(PG8_SA(0, 0), a2, voffA);
            PG8_WAIT_V(8); PG8_WAIT_L(0); PG8_BAR; PG8_MMA(1, 0, At, B0); PG8_MMA(1, 1, At, B1); PG8_BAR; PG8_SCHED;
            PG8_LDB(B0, 1, 0); PG8_LDB(B1, 1, 1); PG8_SCHED; PG8_LDA(At, 1, 0); PG8_STAGE(PG8_SA(0, 1), a2 + hstep, voffA);
            PG8_WAIT_V(8); PG8_WAIT_L(0); PG8_BAR; PG8_MMA(0, 0, At, B0); PG8_MMA(0, 1, At, B1); PG8_BAR; PG8_SCHED;
            PG8_LDA(At, 1, 1); PG8_STAGE(PG8_SB(1, 0), b3, voffB); PG8_STAGE(PG8_SB(1, 1), b3 + hstep, voffB); PG8_STAGE(PG8_SA(1, 0), a3, voffA);
            PG8_WAIT_V(8); PG8_WAIT_L(0); PG8_BAR; PG8_MMA(1, 0, At, B0); PG8_MMA(1, 1, At, B1); PG8_BAR; PG8_SCHED;
            } else {
            PG8_LDB(B0, 0, 0); PG8_SCHED; PG8_LDA(At, 0, 0); PG8_STAGE(PG8_SA(1, 1), a1 + hstep, voffA);
            PG8_WAIT_L(8); PG8_BAR; PG8_WAIT_L(0); PG8_MMA(0, 0, At, B0); PG8_BAR; PG8_SCHED;
            PG8_LDB(B1, 0, 1); PG8_STAGE(PG8_SB(0, 0), b2, voffB);
            PG8_BAR; PG8_WAIT_L(0); PG8_MMA(0, 1, At, B1); PG8_BAR;
            PG8_LDA(At, 0, 1); PG8_STAGE(PG8_SA(0, 0), a2, voffA);
            PG8_BAR; PG8_WAIT_L(0); PG8_MMA(1, 0, At, B0); PG8_BAR; PG8_SCHED;
            PG8_STAGE(PG8_SB(0, 1), b2 + hstep, voffB);
            PG8_WAIT_V(6); PG8_BAR; PG8_MMA(1, 1, At, B1); PG8_BAR;
            PG8_LDB(B0, 1, 0); PG8_SCHED; PG8_LDA(At, 1, 0); PG8_STAGE(PG8_SA(0, 1), a2 + hstep, voffA);
            PG8_WAIT_L(8); PG8_BAR; PG8_WAIT_L(0); PG8_MMA(0, 0, At, B0); PG8_BAR; PG8_SCHED;
            PG8_LDB(B1, 1, 1); PG8_STAGE(PG8_SB(1, 0), b3, voffB);
            PG8_BAR; PG8_WAIT_L(0); PG8_MMA(0, 1, At, B1); PG8_BAR;
            PG8_LDA(At, 1, 1); PG8_STAGE(PG8_SA(1, 0), a3, voffA);
            PG8_BAR; PG8_WAIT_L(0); PG8_MMA(1, 0, At, B0); PG8_BAR; PG8_SCHED;
            PG8_STAGE(PG8_SB(1, 1), b3 + hstep, voffB);
            PG8_WAIT_V(6); PG8_BAR; PG8_MMA(1, 1, At, B1); PG8_BAR;
            }
        }
        if constexpr (ALIGN_EPI) { if (wr == 0) PG8_BAR; }
        if constexpr (!Epi::AFTER_DRAIN) { E(acc, cur, wr, wc, fr, fq); S.done(cur); }
        if (!has_next) break;
#pragma unroll
        for (int a = 0; a < 2; ++a)
#pragma unroll
            for (int b = 0; b < 2; ++b)
#pragma unroll
                for (int m = 0; m < 4; ++m)
#pragma unroll
                    for (int n = 0; n < 2; ++n) acc[a][b][m][n] = (f32x4){0.f, 0.f, 0.f, 0.f};
        cur = nxt; cA = nA; cB = nB; ++ui;
        if constexpr (ALIGN_EPI) { if (wr == 1) PG8_BAR; }
    }
    PG8_WAIT_V(0);
    if constexpr (!ALIGN_EPI) { if (wr == 0) PG8_BAR; }
    PG8_BAR;
    if constexpr (Epi::AFTER_DRAIN) { E.fused(acc, cur, wr, wc, fr, fq, lds, wid, lane); S.done(cur); }
#undef PG8_SA
#undef PG8_SB
#undef PG8_STAGE
#undef PG8_LDA
#undef PG8_LDB
#undef PG8_MMA
#undef PG8_WAIT_V
#undef PG8_WAIT_L
#undef PG8_BAR
#undef PG8_SCHED
}
}

typedef pg8::f32x4 f32x4;
typedef pg8::bf16x8 bf16x8;
typedef unsigned u32x2 __attribute__((ext_vector_type(2)));
typedef unsigned u32x4 __attribute__((ext_vector_type(4)));
#define LAS __attribute__((address_space(3)))

constexpr int NTHREADS = 512;
constexpr int RING_BYTES = 131072;
constexpr int MISC_OFF = RING_BYTES;
constexpr int LDS_BYTES = 147456;

typedef __bf16 bf16x2_t __attribute__((ext_vector_type(2)));
typedef float f32x2_t __attribute__((ext_vector_type(2)));
DEV unsigned pk2(float lo, float hi) {
  const f32x2_t v = {lo, hi};
  return __builtin_bit_cast(unsigned, __builtin_convertvector(v, bf16x2_t));
}
DEV unsigned short f2bfh(float x) { return (unsigned short)(pk2(x, 0.f) & 0xffffu); }
DEV float shx(float v, int lane, int o) { return __int_as_float(__builtin_amdgcn_ds_bpermute((lane ^ o) << 2, __float_as_int(v))); }
DEV int shxi(int v, int lane, int o) { return __builtin_amdgcn_ds_bpermute((lane ^ o) << 2, v); }
DEV float wave_sum(float v, int lane) {
#pragma unroll
  for (int o = 1; o < 64; o <<= 1)
    v += __int_as_float(__builtin_amdgcn_ds_bpermute((lane ^ o) << 2, __float_as_int(v)));
  return v;
}

DEV void transpose_item(const float* W, int ldw, int dld, act_t* WT, int k0, int n0, int drow0, LAS float* scr, int lane) {
  float wv[32];
#pragma unroll
  for (int i = 0; i < 32; ++i) wv[i] = W[(size_t)(k0 + 2 * i + (lane >> 5)) * ldw + n0 + (lane & 31)];
#pragma unroll
  for (int i = 0; i < 32; ++i) scr[(2 * i + (lane >> 5)) * 33 + (lane & 31)] = wv[i];
  asm volatile("s_waitcnt lgkmcnt(0)" ::: "memory");
  const int c = lane & 7;
#pragma unroll
  for (int j = 0; j < 4; ++j) {
    const int n = (lane >> 3) + 8 * j;
    const LAS float* s = scr + (8 * c) * 33 + n;
    u32x4 o;
    o.x = pk2(s[0 * 33], s[1 * 33]); o.y = pk2(s[2 * 33], s[3 * 33]);
    o.z = pk2(s[4 * 33], s[5 * 33]); o.w = pk2(s[6 * 33], s[7 * 33]);
    *(u32x4*)(WT + (size_t)(drow0 + n) * dld + k0 + 8 * c) = o;
  }
  asm volatile("s_waitcnt lgkmcnt(0)" ::: "memory");
}

struct ConvDesc { const float* W; act_t* dst; int nbatch, K, N, mode; size_t dstb; int dld; };
constexpr int NCONV = 13;
DEV ConvDesc conv_desc(const Params& p, int kind) {
  const size_t SQ = (size_t)1024 * 1024;
  switch (kind) {
    case 0: return ConvDesc{p.w_gu, p.wt_gu, 64, 1024, 2048, 1, (size_t)2048 * 1024, 1024};
    case 1: return ConvDesc{p.w_down, p.wt_dn, 64, 1024, 1024, 0, SQ, 1024};
    case 2: return ConvDesc{p.w_in, p.wt_in, 2, 1024, N_IN, 0, (size_t)N_IN_PAD * 1024, 1024};
    case 3: return ConvDesc{p.cmp_w1_k, p.wt_c1, 2, 2048, 128, 0, (size_t)2 * 256 * 2048, 2048};
    case 4: return ConvDesc{p.cmp_w1_v, p.wt_c1 + (size_t)256 * 2048, 2, 2048, 128, 0, (size_t)2 * 256 * 2048, 2048};
    case 5: return ConvDesc{p.w_br_a, p.wt_bra, 2, 256, 1024, 0, (size_t)1024 * YLD, YLD};
    case 6: return ConvDesc{p.w_br_b, p.wt_brb, 2, 1024, 1024, 0, (size_t)1024 * YLD, YLD};
    case 7: return ConvDesc{p.w_br_c, p.wt_brc, 2, 1024, 1024, 0, (size_t)1024 * YLD, YLD};
    case 8: return ConvDesc{p.w_o_mix, p.wt_omix, 2, 1024, 1024, 0, SQ, 1024};
    case 9: return ConvDesc{p.w_xq, p.wt_xq, 2, 1024, 1024, 0, SQ, 1024};
    case 10: return ConvDesc{p.w_xk, p.wt_xk, 2, 1024, 1024, 0, SQ, 1024};
    case 11: return ConvDesc{p.w_xv, p.wt_xv, 2, 1024, 1024, 0, SQ, 1024};
    default: return ConvDesc{p.w_xo, p.wt_xo, 2, 1024, 1024, 0, SQ, 1024};
  }
}
DEV int conv_items(int kind) {
  switch (kind) {
    case 0: return 64 * 16 * 64;
    case 1: return 64 * 16 * 32;
    case 2: return 2 * 16 * (N_IN / 32);
    case 3: case 4: return 2 * 32 * 4;
    case 5: return 2 * 4 * 32;
    default: return 2 * 16 * 32;
  }
}
DEV void conv_all(const Params& p, int gw, int NGW, LAS float* scr, int lane) {
  int base = 0;
  for (int kind = 0; kind < NCONV; ++kind) {
    const int total = conv_items(kind);
    const ConvDesc d = conv_desc(p, kind);
    const int nblk = d.N / 32, per = nblk * (d.K / 64);
    int first = (gw - base % NGW + NGW) % NGW;
    for (int it = first; it < total; it += NGW) {
      const int bt = it / per, r = it % per, kb = r / nblk, nb = r % nblk;
      const int n0 = nb * 32;
      int drow0 = n0;
      if (d.mode == 1) { const int j = n0 & 1023; drow0 = (j >> 7) * 256 + (j & 127) + ((n0 >= 1024) ? 128 : 0); }
      transpose_item(d.W + (size_t)bt * d.K * d.N, d.N, d.dld, d.dst + (size_t)bt * d.dstb, kb * 64, n0, drow0, scr, lane);
    }
    base += total;
  }
}

template <int MODE, bool SRC_BF16 = false>
DEV void ln_rows_w(const Params& p, const float* src, const float* g, const float* b, float* dstf, act_t* dstb, float* dst2,
                   int gw, int NGW, int lane) {
  for (int n0 = gw; n0 < N_TOK; n0 += 2 * NGW) {
    f32x4 v[2][4];
    float s[2] = {0.f, 0.f};
#pragma unroll
    for (int r = 0; r < 2; ++r) {
      const int n = (n0 + r * NGW < N_TOK) ? n0 + r * NGW : n0;
#pragma unroll
      for (int j = 0; j < 4; ++j) {
        if (MODE == 0) {
          if (SRC_BF16) {
            const u32x2 xw = ((const u32x2*)((const act_t*)src + (size_t)n * D))[lane + 64 * j];
            v[r][j] = (f32x4){__uint_as_float(xw.x << 16), __uint_as_float(xw.x & 0xffff0000u), __uint_as_float(xw.y << 16), __uint_as_float(xw.y & 0xffff0000u)};
          } else v[r][j] = ((const f32x4*)(src + (size_t)n * D))[lane + 64 * j];
        } else {
          f32x4 a = ((const f32x4*)(p.xf + (size_t)n * D))[lane + 64 * j] * ALPHA;
#pragma unroll
          for (int k = 0; k < 4; ++k) {
            const u32x2 yw = ((const u32x2*)((const act_t*)p.yass + ((size_t)n * 4 + k) * D))[lane + 64 * j];
            a.x += __uint_as_float(yw.x << 16); a.y += __uint_as_float(yw.x & 0xffff0000u);
            a.z += __uint_as_float(yw.y << 16); a.w += __uint_as_float(yw.y & 0xffff0000u);
          }
          v[r][j] = a;
        }
        s[r] += (v[r][j].x + v[r][j].y) + (v[r][j].z + v[r][j].w);
      }
    }
    float mean[2], s2[2] = {0.f, 0.f}, rstd[2];
#pragma unroll
    for (int o = 1; o < 64; o <<= 1) { s[0] += shx(s[0], lane, o); s[1] += shx(s[1], lane, o); }
#pragma unroll
    for (int r = 0; r < 2; ++r) {
      mean[r] = s[r] * (1.f / D);
#pragma unroll
      for (int j = 0; j < 4; ++j) { v[r][j] = v[r][j] - mean[r]; s2[r] += (v[r][j].x * v[r][j].x + v[r][j].y * v[r][j].y) + (v[r][j].z * v[r][j].z + v[r][j].w * v[r][j].w); }
    }
#pragma unroll
    for (int o = 1; o < 64; o <<= 1) { s2[0] += shx(s2[0], lane, o); s2[1] += shx(s2[1], lane, o); }
#pragma unroll
    for (int r = 0; r < 2; ++r) {
      rstd[r] = 1.f / sqrtf(s2[r] * (1.f / D) + LN_EPS);
      const int n = n0 + r * NGW;
      if (n < N_TOK) {
#pragma unroll
        for (int j = 0; j < 4; ++j) {
          const f32x4 gm = ((const f32x4*)g)[lane + 64 * j], bt = ((const f32x4*)b)[lane + 64 * j];
          const f32x4 y = v[r][j] * rstd[r] * gm + bt;
          ((f32x4*)(dstf + (size_t)n * D))[lane + 64 * j] = y;
          u32x2 w; w.x = pk2(y.x, y.y); w.y = pk2(y.z, y.w);
          ((u32x2*)(dstb + (size_t)n * D))[lane + 64 * j] = w;
          if (dst2) ((f32x4*)(dst2 + (size_t)n * D))[lane + 64 * j] = y;
        }
      }
    }
  }
}

DEV void prologue(const Params& p, LAS unsigned char* lds, int wave, int lane) {
  LAS float* scr = (LAS float*)(lds + wave * 16384);
  const int gw = blockIdx.x * 8 + wave, NGW = gridDim.x * 8;
  conv_all(p, gw, NGW, scr, lane);
  const long long tid = (long long)blockIdx.x * NTHREADS + threadIdx.x, nthr = (long long)gridDim.x * NTHREADS;
  {
    const long long padw = (long long)(N_IN_PAD - N_IN) * 1024 / 8;
    for (long long i = tid; i < 2 * padw; i += nthr) {
      const int li = (int)(i / padw); const long long r = i % padw;
      ((u32x4*)(p.wt_in + ((size_t)li * N_IN_PAD + N_IN) * 1024))[r] = (u32x4){0u, 0u, 0u, 0u};
    }
    const long long padc = (long long)128 * 2048 / 8;
    for (long long i = tid; i < 4 * padc; i += nthr) {
      const int q = (int)(i / padc); const long long r = i % padc;
      ((u32x4*)(p.wt_c1 + ((size_t)q * 256 + 128) * 2048))[r] = (u32x4){0u, 0u, 0u, 0u};
    }
    if (tid < 64) p.cnt[tid] = 0;
    for (long long i = tid; i < 2LL * BATCH * NSA_G * 64; i += nthr) {
      const long long wb = i / (NSA_G * 64), r = i % (NSA_G * 64);
      p.kcb[(wb * 128 + 127) * NSA_G * 64 + r] = 0;
    }
    for (long long i = tid; i < (long long)BATCH * MEM_LEN * 1024 / 4; i += nthr) {
      const f32x4 v = ((const f32x4*)p.mem)[i];
      u32x2 w; w.x = pk2(v.x, v.y); w.y = pk2(v.z, v.w);
      ((u32x2*)p.membf)[i] = w;
    }
  }
  ln_rows_w<0>(p, p.x, p.ln0_g, p.ln0_b, p.xf, p.xb, nullptr, gw, NGW, lane);
}

struct USched {
  int nM, nN, nwg, G, c;
  int moe, nct, total; const LAS int* tile_e;
  DEV void init_static(int M, int N, int G_, int c_) { nM = M / 256; nN = N / 256; nwg = nM * nN; G = G_; c = c_; moe = 0; nct = 1; total = nwg; tile_e = nullptr; }
  DEV void init_moe(int G_, int c_, int nct_, int total_, const LAS int* te) { nM = 1; nN = 1; nwg = total_; G = G_; c = c_; moe = 1; nct = nct_; total = total_; tile_e = te; }
  DEV bool next(int i, pg8::Unit& u) const {
    const long L = (long)i * G + c;
    if (!(moe && (G & 7) == 0) && L >= total) return false;
    if (moe) {
      if ((G & 7) == 0) {
        const int xcd = c & 7, rank = c >> 3, nr = G >> 3, T = total / nct;
        const int tlo = (T * xcd) >> 3, thi = (T * (xcd + 1)) >> 3;
        const int lu = i * nr + rank;
        if (lu >= (thi - tlo) * nct) return false;
        const int rt = tlo + lu / nct, j = lu % nct;
        u.pm = rt; u.pn = tile_e[rt] * nct + j; return true;
      }
      const int rt = (int)(L / nct), j = (int)(L % nct); u.pm = rt; u.pn = tile_e[rt] * nct + j; return true;
    }
    int wgid = (int)L; { const int q = nwg / 8, r = nwg % 8, xcd = wgid % 8, off = wgid / 8; wgid = (xcd < r ? xcd * (q + 1) : r * (q + 1) + (xcd - r) * q) + off; }
    const int nig = 8 * nN, gid = wgid / nig, fm = gid * 8, gsz = (nM - fm) < 8 ? (nM - fm) : 8;
    u.pm = fm + ((wgid % nig) % gsz); u.pn = (wgid % nig) / gsz; return true;
  }
  DEV void a_ready(const pg8::Unit&) const {}
  DEV void done(const pg8::Unit&) const {}
};

enum { EM_INPROJ = 0, EM_BRCAT, EM_RES, EM_BF16, EM_MOE1, EM_MOE2, EM_HID };
#define EPI_FENCE() asm volatile("" ::: "memory")
struct EpiU {
  static constexpr bool PERM = false, AFTER_DRAIN = false;
  int mode, ldc;
  void* q0;
  const void* q1;
  const void* q2;
  const void* q3;
  const LAS int* te;
  DEV void mid(f32x4 (&acc)[2][2][4][2], const pg8::Unit& un, int wr, int wc, int t) const {
    if (mode != EM_BRCAT || (t != 4 && t != 20)) return;
    const act_t* ub = (const act_t*)q1;
    int l2;
    asm volatile("v_mbcnt_lo_u32_b32 %0, -1, 0\n\tv_mbcnt_hi_u32_b32 %0, -1, %0" : "=v"(l2));
    const int fr = l2 & 15, fq = l2 >> 4;
    const int row0 = un.pm * 256 + wr * 64 + fr, col0 = un.pn * 256 + wc * 32 + 4 * fq;
    const int goff = OFF_MG + (t == 4 ? 0 : D);
    const float L2E = -1.4426950408889634f;
#pragma unroll
    for (int ai = 0; ai < 2; ++ai)
#pragma unroll
      for (int m = 0; m < 4; ++m) {
        const int row = row0 + ai * 128 + m * 16;
#pragma unroll
        for (int bj = 0; bj < 2; ++bj)
#pragma unroll
          for (int n = 0; n < 2; ++n) {
            const int col = col0 + bj * 128 + n * 16;
            const act_t* gp = ub + (size_t)row * N_IN + goff + col;
            const u32x2 ga = *(const u32x2*)gp, gb = *(const u32x2*)(gp + D);
            const float ea0 = __builtin_amdgcn_exp2f(__uint_as_float(ga.x << 16) * L2E), ea1 = __builtin_amdgcn_exp2f(__uint_as_float(ga.x & 0xffff0000u) * L2E);
            const float ea2 = __builtin_amdgcn_exp2f(__uint_as_float(ga.y << 16) * L2E), ea3 = __builtin_amdgcn_exp2f(__uint_as_float(ga.y & 0xffff0000u) * L2E);
            const float eb0 = __builtin_amdgcn_exp2f(__uint_as_float(gb.x << 16) * L2E), eb1 = __builtin_amdgcn_exp2f(__uint_as_float(gb.x & 0xffff0000u) * L2E);
            const float eb2 = __builtin_amdgcn_exp2f(__uint_as_float(gb.y << 16) * L2E), eb3 = __builtin_amdgcn_exp2f(__uint_as_float(gb.y & 0xffff0000u) * L2E);
            f32x4& v = acc[ai][bj][m][n];
            v.x *= (1.0f + eb0) * __builtin_amdgcn_rcpf(1.0f + ea0); v.y *= (1.0f + eb1) * __builtin_amdgcn_rcpf(1.0f + ea1);
            v.z *= (1.0f + eb2) * __builtin_amdgcn_rcpf(1.0f + ea2); v.w *= (1.0f + eb3) * __builtin_amdgcn_rcpf(1.0f + ea3);
          }
        if (m == 3) EPI_FENCE();
      }
  }
  DEV void operator()(const f32x4 (&acc)[2][2][4][2], const pg8::Unit& un, int wr, int wc, int fr, int fq) const {
    {
      int l2;
      asm volatile("v_mbcnt_lo_u32_b32 %0, -1, 0\n\tv_mbcnt_hi_u32_b32 %0, -1, %0" : "=v"(l2));
      fr = l2 & 15; fq = l2 >> 4;
    }
    const int row0 = un.pm * 256 + wr * 64 + fr;
    act_t* const ob = (act_t*)q0; float* const of = (float*)q0;
    const float* const f0 = (const float*)q1; const act_t* const ub = (const act_t*)q1;
    const float* const f1 = (const float*)q2; const int* const il = (const int*)q3;
    if (mode == EM_INPROJ) {
      const int col0 = un.pn * 256 + wc * 32 + 4 * fq;
      f32x4 bv[2][2];
#pragma unroll
      for (int bj = 0; bj < 2; ++bj)
#pragma unroll
        for (int n = 0; n < 2; ++n) { const int col = col0 + bj * 128 + n * 16; bv[bj][n] = col < N_IN ? *(const f32x4*)(f0 + col) : (f32x4){0.f, 0.f, 0.f, 0.f}; }
#pragma unroll
      for (int ai = 0; ai < 2; ++ai)
#pragma unroll
        for (int m = 0; m < 4; ++m) {
          const int row = row0 + ai * 128 + m * 16;
#pragma unroll
          for (int bj = 0; bj < 2; ++bj)
#pragma unroll
            for (int n = 0; n < 2; ++n) {
              const int col = col0 + bj * 128 + n * 16;
              if (col < N_IN) {
                const f32x4 v = acc[ai][bj][m][n] + bv[bj][n];
                u32x2 w; w.x = pk2(v.x, v.y); w.y = pk2(v.z, v.w);
                *(u32x2*)(ob + (size_t)row * N_IN + col) = w;
              }
            }
        }
    } else if (mode == EM_BRCAT) {
      const int col0 = un.pn * 256 + wc * 32 + 4 * fq;
#pragma unroll
      for (int ai = 0; ai < 2; ++ai)
#pragma unroll
        for (int m = 0; m < 4; ++m) {
          const int row = row0 + ai * 128 + m * 16;
#pragma unroll
          for (int bj = 0; bj < 2; ++bj)
#pragma unroll
            for (int n = 0; n < 2; ++n) {
              const int col = col0 + bj * 128 + n * 16;
              const u32x2 gw = *(const u32x2*)(ub + (size_t)row * N_IN + OFF_MG + 2 * D + col);
              f32x4 v = acc[ai][bj][m][n];
              v.x *= sigmoidf_(__uint_as_float(gw.x << 16)); v.y *= sigmoidf_(__uint_as_float(gw.x & 0xffff0000u));
              v.z *= sigmoidf_(__uint_as_float(gw.y << 16)); v.w *= sigmoidf_(__uint_as_float(gw.y & 0xffff0000u));
              u32x2 w; w.x = pk2(v.x, v.y); w.y = pk2(v.z, v.w);
              *(u32x2*)(ob + (size_t)row * D + col) = w;
            }
          if (m == 3) EPI_FENCE();
        }
    } else if (mode == EM_RES) {
      const int col0 = un.pn * 256 + wc * 32 + 4 * fq;
#pragma unroll
      for (int ai = 0; ai < 2; ++ai)
#pragma unroll
        for (int m = 0; m < 4; ++m) {
          const int row = row0 + ai * 128 + m * 16;
#pragma unroll
          for (int bj = 0; bj < 2; ++bj)
#pragma unroll
            for (int n = 0; n < 2; ++n) {
              const int col = col0 + bj * 128 + n * 16;
              const f32x4 x = *(const f32x4*)(f0 + (size_t)row * D + col);
              *(f32x4*)(of + (size_t)row * D + col) = x * ALPHA + acc[ai][bj][m][n];
            }
          if (m == 3) EPI_FENCE();
        }
    } else if (mode == EM_BF16) {
      const int col0 = un.pn * 256 + wc * 32 + 4 * fq;
#pragma unroll
      for (int ai = 0; ai < 2; ++ai)
#pragma unroll
        for (int m = 0; m < 4; ++m) {
          const int row = row0 + ai * 128 + m * 16;
#pragma unroll
          for (int bj = 0; bj < 2; ++bj)
#pragma unroll
            for (int n = 0; n < 2; ++n) {
              const int col = col0 + bj * 128 + n * 16;
              const f32x4 v = acc[ai][bj][m][n];
              u32x2 w; w.x = pk2(v.x, v.y); w.y = pk2(v.z, v.w);
              *(u32x2*)(ob + (size_t)row * ldc + col) = w;
            }
          EPI_FENCE();
        }
    } else if (mode == EM_MOE1) {
      const int e = te[un.pm], j = un.pn & 7;
      f32x4 bg[2], bu[2];
#pragma unroll
      for (int n = 0; n < 2; ++n) {
        const int cj = j * 128 + wc * 32 + n * 16 + 4 * fq;
        bg[n] = *(const f32x4*)(f0 + (size_t)e * 2048 + cj); bu[n] = *(const f32x4*)(f0 + (size_t)e * 2048 + 1024 + cj);
      }
#pragma unroll
      for (int ai = 0; ai < 2; ++ai)
#pragma unroll
        for (int m = 0; m < 4; ++m) {
          const int row = row0 + ai * 128 + m * 16;
#pragma unroll
          for (int n = 0; n < 2; ++n) {
            const int cj = j * 128 + wc * 32 + n * 16 + 4 * fq;
            const f32x4 g = acc[ai][0][m][n] + bg[n], u = acc[ai][1][m][n] + bu[n];
            float o[4];
#pragma unroll
            for (int i = 0; i < 4; ++i) {
              const float gt = fminf(g[i], 7.0f), up = fminf(fmaxf(u[i], -7.0f), 7.0f);
              o[i] = (up + 1.0f) * gt * __builtin_amdgcn_rcpf(1.0f + __builtin_amdgcn_exp2f(-1.702f * 1.4426950408889634f * gt));
            }
            u32x2 w; w.x = pk2(o[0], o[1]); w.y = pk2(o[2], o[3]);
            *(u32x2*)(ob + (size_t)row * 1024 + cj) = w;
          }
        }
    } else if (mode == EM_MOE2) {
      const int e = te[un.pm], j = un.pn & 3;
      const int col0 = j * 256 + wc * 32 + 4 * fq;
      int aidv[8]; float gtv[8]; f32x4 bv[2][2];
#pragma unroll
      for (int bj = 0; bj < 2; ++bj)
#pragma unroll
        for (int n = 0; n < 2; ++n) bv[bj][n] = *(const f32x4*)(f0 + (size_t)e * 1024 + col0 + bj * 128 + n * 16);
#pragma unroll
      for (int r = 0; r < 8; ++r) aidv[r] = il[row0 + (r >> 2) * 128 + (r & 3) * 16];
#pragma unroll
      for (int r = 0; r < 8; ++r) gtv[r] = f1[aidv[r] >= 0 ? aidv[r] : 0];
#pragma unroll
      for (int r = 0; r < 8; ++r) {
        const int ai = r >> 2, m = r & 3;
        if (aidv[r] >= 0) {
#pragma unroll
          for (int bj = 0; bj < 2; ++bj)
#pragma unroll
            for (int n = 0; n < 2; ++n) {
              const int col = col0 + bj * 128 + n * 16;
              const f32x4 v = (acc[ai][bj][m][n] + bv[bj][n]) * gtv[r];
              u32x2 w; w.x = pk2(v.x, v.y); w.y = pk2(v.z, v.w);
              *(u32x2*)(ob + (size_t)aidv[r] * 1024 + col) = w;
            }
        }
      }
    } else if (mode == EM_HID) {
      const int col0 = wc * 32 + 4 * fq;
#pragma unroll
      for (int ai = 0; ai < 2; ++ai)
#pragma unroll
        for (int m = 0; m < 4; ++m) {
          const int row = row0 + ai * 128 + m * 16;
          if (row < CMP_ROWS) {
#pragma unroll
            for (int n = 0; n < 2; ++n) {
              const f32x4 a = acc[ai][0][m][n];
              f32x4 v; v.x = gelu_tanh(a.x); v.y = gelu_tanh(a.y); v.z = gelu_tanh(a.z); v.w = gelu_tanh(a.w);
              *(f32x4*)(of + (size_t)row * CMP_HID + col0 + n * 16) = v;
            }
          }
          EPI_FENCE();
        }
    }
  }
};

DEV int moe_tables(const Params& p, int li, LAS int* tab, int t32) {
  __syncthreads();
  if (t32 == 0) {
    int t = 0;
    for (int e = 0; e < NE; ++e) {
      const int c = p.cnt[li * 32 + e];
      tab[e] = t * 256; tab[32 + e] = c;
      const int nt = (c + 255) >> 8;
#pragma clang loop vectorize(disable) unroll(disable)
      for (int k = 0; k < nt; ++k) tab[128 + t + k] = e;
      t += nt;
    }
    tab[64] = t;
  }
  __syncthreads();
  return tab[64];
}

DEV void moe_prep(const Params& p, int li, LAS int* tab, int wave, int lane, int t32) {
  const int ntiles = moe_tables(p, li, tab, t32);
  const int gw = blockIdx.x * 8 + wave, NGW = gridDim.x * 8;
  for (int tk0 = gw; tk0 < N_TOK; tk0 += 4 * NGW) {
    u32x4 v0[4], v1[4]; int rowi[4][4];
#pragma unroll
    for (int q = 0; q < 4; ++q) {
      const int tk = (tk0 + q * NGW < N_TOK) ? tk0 + q * NGW : tk0;
      const u32x4* src = (const u32x4*)(p.xb + (size_t)tk * 1024);
      v0[q] = src[lane]; v1[q] = src[lane + 64];
#pragma unroll
      for (int k = 0; k < 4; ++k) rowi[q][k] = tab[p.topi[tk * 4 + k]] + p.rank[tk * 4 + k];
    }
#pragma unroll
    for (int q = 0; q < 4; ++q) {
      const int tk = tk0 + q * NGW;
      if (tk < N_TOK) {
#pragma unroll
        for (int k = 0; k < 4; ++k) {
          if (lane == 0) p.rowlist[rowi[q][k]] = tk * 4 + k;
          u32x4* dst = (u32x4*)(p.xg + (size_t)rowi[q][k] * 1024);
          dst[lane] = v0[q]; dst[lane + 64] = v1[q];
        }
      }
    }
  }
  const long long tid = (long long)blockIdx.x * NTHREADS + t32, nthr = (long long)gridDim.x * NTHREADS;
  for (long long r = tid; r < (long long)ntiles * 256; r += nthr) {
    const int e = tab[128 + (int)(r >> 8)];
    if ((int)r - tab[e] >= tab[32 + e]) p.rowlist[r] = -1;
  }
}

typedef short v4i16_t __attribute__((ext_vector_type(4)));
DEV v4i16_t tr_read(const LAS unsigned char* p) { return __builtin_amdgcn_ds_read_tr16_b64_v4i16((LAS v4i16_t*)p); }

constexpr int AT_ROWB = 144;
constexpr int AT_TILEB = 64 * AT_ROWB;
constexpr int AT_HALF_KV = 4 * AT_TILEB;
constexpr int AT_SLAB_OFF = 2 * AT_HALF_KV;
constexpr int AT_SLAB_WAVE = 32 * 33 * 4;
constexpr int AT_SLAB_HALF = 4 * AT_SLAB_WAVE;
constexpr int AT_XCH_OFF = AT_SLAB_OFF + 2 * AT_SLAB_HALF;
static_assert(AT_XCH_OFF + 16 <= RING_BYTES, "attention LDS map");
constexpr float SC2 = 0.125f * 1.4426950408889634f;

struct AttnState { f32x4 O[2][4]; float m[2], l[2]; };

template <bool PROB, class Job>
DEV void attn_tile(const Job& job, const LAS unsigned char* Kb, const LAS unsigned char* Vb, const bf16x8 (&qf)[2][2], AttnState& st,
                   LAS float* slab, int cur, int wih, int lane) {
  const int i15 = lane & 15, g4 = lane >> 4;
  f32x4 S[2][4];
#pragma unroll
  for (int sub = 0; sub < 2; ++sub)
#pragma unroll
    for (int t = 0; t < 4; ++t) S[sub][t] = (f32x4){0.f, 0.f, 0.f, 0.f};
#pragma unroll
  for (int t = 0; t < 4; ++t)
#pragma unroll
    for (int kk = 0; kk < 2; ++kk) {
      const bf16x8 kf = *(const LAS bf16x8*)(Kb + (16 * t + i15) * AT_ROWB + (kk * 32 + 8 * g4) * 2);
#pragma unroll
      for (int sub = 0; sub < 2; ++sub) S[sub][t] = __builtin_amdgcn_mfma_f32_16x16x32_bf16(kf, qf[sub][kk], S[sub][t], 0, 0, 0);
    }
  bf16x8 pf[2][2];
  const bool efree = job.elemfree(cur, wih);
#pragma unroll
  for (int sub = 0; sub < 2; ++sub) {
    const int row = wih * 32 + sub * 16 + i15;
    if (!efree) {
      const int mbv = job.mb(row, cur, g4);
#pragma unroll
      for (int t = 0; t < 4; ++t)
#pragma unroll
        for (int j = 0; j < 4; ++j) S[sub][t][j] = job.ok(mbv, 16 * t + j) ? S[sub][t][j] : -INFINITY;
    }
    float mx = fmaxf(fmaxf(S[sub][0][0], S[sub][0][1]), fmaxf(S[sub][0][2], S[sub][0][3]));
#pragma unroll
    for (int t = 1; t < 4; ++t) mx = fmaxf(fmaxf(mx, fmaxf(S[sub][t][0], S[sub][t][1])), fmaxf(S[sub][t][2], S[sub][t][3]));
    if (!PROB) {
      mx = fmaxf(mx, shx(mx, lane, 16));
      mx = fmaxf(mx, shx(mx, lane, 32));
      const bool rok = job.rowok(sub, cur);
      const float mcand = rok ? mx * SC2 : -INFINITY;
      const float mnew = fmaxf(st.m[sub], mcand);
      const float msafe = (mnew == -INFINITY) ? 0.f : mnew;
      const float corr = __builtin_amdgcn_exp2f(st.m[sub] - msafe);
      st.m[sub] = mnew;
      const float msub = rok ? msafe : INFINITY;
      float psum = 0.f;
#pragma unroll
      for (int t = 0; t < 4; ++t)
#pragma unroll
        for (int j = 0; j < 4; ++j) { const float pp = __builtin_amdgcn_exp2f(__builtin_fmaf(S[sub][t][j], SC2, -msub)); S[sub][t][j] = pp; psum += pp; }
      st.l[sub] = st.l[sub] * corr + psum;
      if (__builtin_amdgcn_ballot_w64(corr != 1.0f) != 0ull) {
#pragma unroll
        for (int dt = 0; dt < 4; ++dt) st.O[sub][dt] *= corr;
      }
#pragma unroll
      for (int s2 = 0; s2 < 2; ++s2) {
        u32x4 w;
        w.x = pk2(S[sub][2 * s2][0], S[sub][2 * s2][1]); w.y = pk2(S[sub][2 * s2][2], S[sub][2 * s2][3]);
        w.z = pk2(S[sub][2 * s2 + 1][0], S[sub][2 * s2 + 1][1]); w.w = pk2(S[sub][2 * s2 + 1][2], S[sub][2 * s2 + 1][3]);
        pf[sub][s2] = __builtin_bit_cast(bf16x8, w);
      }
    } else {
      const float msafe = (st.m[sub] == -INFINITY) ? 0.f : st.m[sub];
      const int q = sub * 16 + i15;
#pragma unroll
      for (int t = 0; t < 4; ++t) {
        const float p0 = __builtin_amdgcn_exp2f(__builtin_fmaf(S[sub][t][0], SC2, -msafe)) * st.l[sub], p1 = __builtin_amdgcn_exp2f(__builtin_fmaf(S[sub][t][1], SC2, -msafe)) * st.l[sub];
        const float p2 = __builtin_amdgcn_exp2f(__builtin_fmaf(S[sub][t][2], SC2, -msafe)) * st.l[sub], p3 = __builtin_amdgcn_exp2f(__builtin_fmaf(S[sub][t][3], SC2, -msafe)) * st.l[sub];
        const int jb = 16 * cur + 4 * t + g4;
        slab[q * 33 + jb] += (p0 + p1) + (p2 + p3);
        S[sub][t][3] = p3;
      }
      asm volatile("s_waitcnt lgkmcnt(0)" ::: "memory");
#pragma unroll
      for (int t = 0; t < 4; ++t) {
        const int jb = 16 * cur + 4 * t + g4 + 1;
        if (jb < 32) slab[q * 33 + jb] += S[sub][t][3];
      }
      asm volatile("s_waitcnt lgkmcnt(0)" ::: "memory");
    }
  }
  if (!PROB) {
#pragma unroll
    for (int dt = 0; dt < 4; ++dt)
#pragma unroll
      for (int s2 = 0; s2 < 2; ++s2) {
        const LAS unsigned char* vp = Vb + (32 * s2 + 4 * g4 + (i15 >> 2)) * AT_ROWB + (16 * dt + 4 * (lane & 3)) * 2;
        const v4i16_t lo = tr_read(vp), hi = tr_read(vp + 16 * AT_ROWB);
        bf16x8 vf;
        vf[0] = lo[0]; vf[1] = lo[1]; vf[2] = lo[2]; vf[3] = lo[3]; vf[4] = hi[0]; vf[5] = hi[1]; vf[6] = hi[2]; vf[7] = hi[3];
#pragma unroll
        for (int sub = 0; sub < 2; ++sub) st.O[sub][dt] = __builtin_amdgcn_mfma_f32_16x16x32_bf16(vf, pf[sub][s2], st.O[sub][dt], 0, 0, 0);
      }
  }
}

DEV void half_barrier(LAS unsigned* cnt, int lane) {
  asm volatile("s_waitcnt lgkmcnt(0)" ::: "memory");
  unsigned old = 0;
  if (lane == 0) old = __hip_atomic_fetch_add(cnt, 1u, __ATOMIC_RELAXED, __HIP_MEMORY_SCOPE_WORKGROUP);
  old = (unsigned)__builtin_amdgcn_readfirstlane((int)old);
  const unsigned target = (old / 4u + 1u) * 4u;
  while ((int)(__hip_atomic_load(cnt, __ATOMIC_RELAXED, __HIP_MEMORY_SCOPE_WORKGROUP) - target) < 0) __builtin_amdgcn_s_sleep(1);
  asm volatile("" ::: "memory");
}

template <bool PROB, class Job>
DEV void attn_run(const Job& job, LAS unsigned char* lds, AttnState& st, int half, int hth, int wih, int lane) {
  LAS unsigned char* kvh = lds + half * AT_HALF_KV;
  LAS unsigned* hb = (LAS unsigned*)(lds + MISC_OFF + 8192 + 128) + half * 16;
  LAS float* slab = (LAS float*)(lds + AT_SLAB_OFF + half * AT_SLAB_HALF + wih * AT_SLAB_WAVE);
  const int i15 = lane & 15, g4 = lane >> 4;
  unsigned rem = job.tilemask();
  bf16x8 qf[2][2];
#pragma unroll
  for (int sub = 0; sub < 2; ++sub) {
    const act_t* qr = job.qrow(wih * 32 + sub * 16 + i15);
#pragma unroll
    for (int kk = 0; kk < 2; ++kk) qf[sub][kk] = *(const bf16x8*)(qr + kk * 32 + 8 * g4);
  }
  if (!PROB) {
#pragma unroll
    for (int sub = 0; sub < 2; ++sub) {
      st.m[sub] = -INFINITY; st.l[sub] = 0.f;
#pragma unroll
      for (int dt = 0; dt < 4; ++dt) st.O[sub][dt] = (f32x4){0.f, 0.f, 0.f, 0.f};
    }
  }
  const int srow = hth >> 2, sch = hth & 3;
  u32x4 ak0, ak1, av0, av1;
#define AT_LOAD(k0, k1, v0, v1, T) do { const act_t* kr_ = job.krow(T, srow) + sch * 16; k0 = *(const u32x4*)kr_; k1 = *(const u32x4*)(kr_ + 8); \
    if (!PROB) { const act_t* vr_ = job.vrow(T, srow) + sch * 16; v0 = *(const u32x4*)vr_; v1 = *(const u32x4*)(vr_ + 8); } } while (0)
#define AT_WRITE(k0, k1, v0, v1, BUF) do { LAS unsigned char* kd_ = kvh + (BUF) * AT_TILEB + srow * AT_ROWB + sch * 32; *(LAS u32x4*)kd_ = k0; *(LAS u32x4*)(kd_ + 16) = k1; \
    if (!PROB) { LAS unsigned char* vd_ = kvh + (2 + (BUF)) * AT_TILEB + srow * AT_ROWB + sch * 32; *(LAS u32x4*)vd_ = v0; *(LAS u32x4*)(vd_ + 16) = v1; } } while (0)
#define AT_NEXT(T) do { T = -1; if (rem) { T = __builtin_ctz(rem); rem &= rem - 1; } } while (0)
  int t0;
  AT_NEXT(t0);
  if (t0 >= 0) { AT_LOAD(ak0, ak1, av0, av1, t0); AT_WRITE(ak0, ak1, av0, av1, 0); }
  half_barrier(hb, lane);
  for (int it = 0; t0 >= 0; ++it) {
    int t1;
    AT_NEXT(t1);
    if (t1 >= 0) AT_LOAD(ak0, ak1, av0, av1, t1);
    attn_tile<PROB>(job, kvh + (it & 1) * AT_TILEB, kvh + (2 + (it & 1)) * AT_TILEB, qf, st, slab, t0, wih, lane);
    if (t1 >= 0) AT_WRITE(ak0, ak1, av0, av1, (it + 1) & 1);
    half_barrier(hb, lane);
    t0 = t1;
  }
#undef AT_LOAD
#undef AT_WRITE
#undef AT_NEXT
  if (!PROB) {
#pragma unroll
    for (int sub = 0; sub < 2; ++sub) {
      float l = st.l[sub];
      l += shx(l, lane, 16);
      l += shx(l, lane, 32);
      const float inv = 1.0f / fmaxf(l, 1e-30f);
      st.l[sub] = l;
#pragma unroll
      for (int dt = 0; dt < 4; ++dt) st.O[sub][dt] *= inv;
    }
  }
}

struct SelJob {
  const act_t* u; int b, g, t0; unsigned um; unsigned tm[2];
  DEV unsigned tilemask() const { return um; }
  DEV const act_t* qrow(int r) const { return u + ((size_t)b * SEQ + t0 + (r & 31)) * N_IN + OFF_CQ + (g * 4 + (r >> 5)) * 64; }
  DEV const act_t* krow(int kt, int j) const { return u + ((size_t)b * SEQ + kt * 64 + j) * N_IN + OFF_CKS + g * 64; }
  DEV const act_t* vrow(int kt, int j) const { return u + ((size_t)b * SEQ + kt * 64 + j) * N_IN + OFF_CVS + g * 64; }
  DEV int mb(int r, int kt, int g4) const { return t0 + (r & 31) - kt * 64 - 4 * g4; }
  DEV bool rowok(int sub, int kt) const { return (tm[sub] >> kt) & 1u; }
  DEV bool ok(int m, int C) const { return m >= C; }
  DEV bool elemfree(int kt, int wih) const { return kt < (t0 >> 6); }
};
struct WinJob {
  const act_t* u; int b, g, t0; unsigned um;
  DEV unsigned tilemask() const { return um; }
  DEV const act_t* qrow(int r) const { return u + ((size_t)b * SEQ + t0 + (r & 31)) * N_IN + OFF_CQ + (g * 4 + (r >> 5)) * 64; }
  DEV const act_t* krow(int kt, int j) const { return u + ((size_t)b * SEQ + kt * 64 + j) * N_IN + OFF_CKW + g * 64; }
  DEV const act_t* vrow(int kt, int j) const { return u + ((size_t)b * SEQ + kt * 64 + j) * N_IN + OFF_CVW + g * 64; }
  DEV int mb(int r, int kt, int g4) const { return t0 + (r & 31) - kt * 64 - 4 * g4; }
  DEV bool rowok(int sub, int kt) const { return true; }
  DEV bool ok(int m, int C) const { return m >= C && m < NSA_WIN + C; }
  DEV bool elemfree(int kt, int wih) const { return kt * 64 + 63 <= t0 && t0 + 31 - kt * 64 < NSA_WIN; }
};
struct CmpJob {
  const act_t* u; const act_t* kcb; const act_t* vcb; int b, g, t0; unsigned um;
  DEV unsigned tilemask() const { return um; }
  DEV const act_t* qrow(int r) const { return u + ((size_t)b * SEQ + t0 + (r & 31)) * N_IN + OFF_CQ + (g * 4 + (r >> 5)) * 64; }
  DEV const act_t* krow(int kt, int j) const { return kcb + (((size_t)b * 128 + kt * 64 + j) * NSA_G + g) * 64; }
  DEV const act_t* vrow(int kt, int j) const { return vcb + (((size_t)b * 128 + kt * 64 + j) * NSA_G + g) * 64; }
  DEV int mb(int r, int kt, int g4) const { return t0 + (r & 31) - 31 - 16 * (kt * 64 + 4 * g4); }
  DEV bool rowok(int sub, int kt) const { return true; }
  DEV bool ok(int m, int C) const { return m >= 16 * C; }
  DEV bool elemfree(int kt, int wih) const { return kt == 0 && 16 * 63 + 31 <= t0; }
};
struct DilJob {
  const act_t* u; int b, col, dil, res, l0; unsigned um;
  DEV unsigned tilemask() const { return um; }
  DEV const act_t* qrow(int r) const { return u + ((size_t)b * SEQ + (l0 + r) * dil + res) * N_IN + OFF_AQ + col; }
  DEV const act_t* krow(int kt, int j) const { return u + ((size_t)b * SEQ + (kt * 64 + j) * dil + res) * N_IN + OFF_AK + col; }
  DEV const act_t* vrow(int kt, int j) const { return u + ((size_t)b * SEQ + (kt * 64 + j) * dil + res) * N_IN + OFF_AV + col; }
  DEV int mb(int r, int kt, int g4) const { return l0 + r - kt * 64 - 4 * g4; }
  DEV bool rowok(int sub, int kt) const { return true; }
  DEV bool ok(int m, int C) const { return m >= C && m <= 128 + C; }
  DEV bool elemfree(int kt, int wih) const { return kt * 64 + 63 <= l0 + 32 * wih && l0 + 32 * wih + 31 - kt * 64 <= 128; }
};

DEV unsigned range_mask(int lo, int hi) {
  return (hi >= 31 ? 0xffffffffu : ((1u << (hi + 1)) - 1u)) & ~((1u << lo) - 1u);
}

DEV bool nsa_unit(int round, int bid, int G, int half, int& b, int& g, int& tb) {
  if ((G & 7) == 0) {
    const int nr = G >> 3, rank = bid >> 3;
    const int slot = rank * 2 + half, nslot = nr * 2;
    const int pos = (round & 1) ? (nslot - 1 - slot) : slot;
    const int lu = round * nslot + pos;
    if (lu >= 256) return false;
    b = bid & 7; g = lu & 3; tb = 63 - (lu >> 2);
    return true;
  }
  const int pos = (round & 1) ? (G - 1 - bid) : bid;
  const int pair = round * G + pos;
  if (pair >= 1024) return false;
  const int un = pair * 2 + half;
  tb = 63 - un / 32; b = (un % 32) / 4; g = un % 4;
  return true;
}
DEV int nsa_rounds(int G) { return (G & 7) == 0 ? (256 + (G >> 3) * 2 - 1) / ((G >> 3) * 2) : (1024 + G - 1) / G; }

DEV void nsa_cmp_phase(const Params& p, LAS unsigned char* lds, int t32, int bid, int G) {
  const int lane = t32 & 63, wave = t32 >> 6, half = wave >> 2, wih = wave & 3, hth = t32 & 255;
  const int i15 = lane & 15, g4 = lane >> 4;
  LAS float* slabh = (LAS float*)(lds + AT_SLAB_OFF + half * AT_SLAB_HALF);
  for (int round = 0; round < nsa_rounds(G); ++round) {
    int b = 0, g = 0, tb = 0;
    const bool act = nsa_unit(round, bid, G, half, b, g, tb);
    const int t0 = tb * 32;
    const int nvmax = t0 + 31 >= 31 ? (t0 + 31 - 31) / 16 + 1 : 0;
    CmpJob job{p.u, p.kcb, p.kcb + (size_t)BATCH * 128 * NSA_G * 64, b, g, t0, 0u};
    job.um = !act ? 0u : (nvmax > 64 ? 3u : (nvmax > 0 ? 1u : 0u));
    for (int i = lane; i < 32 * 33; i += 64) slabh[wih * (32 * 33) + i] = 0.f;
    LAS unsigned char* kvh = lds + half * AT_HALF_KV;
    LAS unsigned* hb = (LAS unsigned*)(lds + MISC_OFF + 8192 + 128) + half * 16;
    LAS float* slab = slabh + wih * (32 * 33);
    {
      const int srow = hth >> 2, sch = hth & 3;
#pragma unroll
      for (int tl = 0; tl < 2; ++tl)
        if ((job.um >> tl) & 1u) {
          const act_t* kr = job.krow(tl, srow) + sch * 16; const act_t* vr = job.vrow(tl, srow) + sch * 16;
          const u32x4 k0 = *(const u32x4*)kr, k1 = *(const u32x4*)(kr + 8), v0 = *(const u32x4*)vr, v1 = *(const u32x4*)(vr + 8);
          LAS unsigned char* kd = kvh + tl * AT_TILEB + srow * AT_ROWB + sch * 32;
          *(LAS u32x4*)kd = k0; *(LAS u32x4*)(kd + 16) = k1;
          LAS unsigned char* vd = kvh + (2 + tl) * AT_TILEB + srow * AT_ROWB + sch * 32;
          *(LAS u32x4*)vd = v0; *(LAS u32x4*)(vd + 16) = v1;
        }
    }
    bf16x8 qf[2][2];
#pragma unroll
    for (int sub = 0; sub < 2; ++sub) {
      const act_t* qr = job.qrow(wih * 32 + sub * 16 + i15);
#pragma unroll
      for (int kk = 0; kk < 2; ++kk) qf[sub][kk] = *(const bf16x8*)(qr + kk * 32 + 8 * g4);
    }
    AttnState st;
#pragma unroll
    for (int sub = 0; sub < 2; ++sub) {
      st.m[sub] = -INFINITY; st.l[sub] = 0.f;
#pragma unroll
      for (int dt = 0; dt < 4; ++dt) st.O[sub][dt] = (f32x4){0.f, 0.f, 0.f, 0.f};
    }
    half_barrier(hb, lane);
    if (job.um & 1u) attn_tile<false>(job, kvh, kvh + 2 * AT_TILEB, qf, st, slab, 0, wih, lane);
    if (job.um & 2u) attn_tile<false>(job, kvh + AT_TILEB, kvh + 3 * AT_TILEB, qf, st, slab, 1, wih, lane);
#pragma unroll
    for (int sub = 0; sub < 2; ++sub) {
      float l = st.l[sub];
      l += shx(l, lane, 16);
      l += shx(l, lane, 32);
      const float inv = 1.0f / fmaxf(l, 1e-30f);
      st.l[sub] = inv;
#pragma unroll
      for (int dt = 0; dt < 4; ++dt) st.O[sub][dt] *= inv;
    }
    if (act) {
#pragma unroll
      for (int sub = 0; sub < 2; ++sub) {
        const int hh = g * 4 + wih;
        const size_t n = (size_t)b * SEQ + t0 + sub * 16 + i15;
        const float g0 = sigmoidf_(ldf(p.u[n * N_IN + OFF_CG + hh * 3 + 0]));
#pragma unroll
        for (int dt = 0; dt < 4; ++dt) { const f32x4 y = st.O[sub][dt] * g0; u32x2 w; w.x = pk2(y.x, y.y); w.y = pk2(y.z, y.w); *(u32x2*)((act_t*)p.ocmp + n * 1024 + hh * 64 + 16 * dt + 4 * g4) = w; }
      }
    }
    if (job.um & 1u) attn_tile<true>(job, kvh, kvh + 2 * AT_TILEB, qf, st, slab, 0, wih, lane);
    if (job.um & 2u) attn_tile<true>(job, kvh + AT_TILEB, kvh + 3 * AT_TILEB, qf, st, slab, 1, wih, lane);
    half_barrier(hb, lane);
    {
      const int q = hth >> 3, j4 = (hth & 7) * 4;
      float v[4];
#pragma unroll
      for (int i = 0; i < 4; ++i) {
        float s = 0.f;
#pragma unroll
        for (int w = 0; w < 4; ++w) s += slabh[w * (32 * 33) + q * 33 + j4 + i];
        const int j = j4 + i, qb = (t0 + q) >> 6;
        if (j == 0 || j == qb || j == qb - 1) s = INFINITY;
        else if (j > qb) s = -INFINITY;
        v[i] = s;
      }
      __syncthreads();
#pragma unroll
      for (int i = 0; i < 4; ++i) slabh[q * 33 + j4 + i] = v[i];
      __syncthreads();
      unsigned bits = 0u;
#pragma unroll
      for (int i = 0; i < 4; ++i) {
        int rank = 0;
#pragma unroll 1
        for (int jj = 0; jj < 32; ++jj) { const float w = slabh[q * 33 + jj]; rank += (w > v[i] || (w == v[i] && jj < j4 + i)) ? 1 : 0; }
        if (rank < N_SELECT) bits |= 1u << (j4 + i);
      }
      bits |= (unsigned)shxi((int)bits, lane, 1);
      bits |= (unsigned)shxi((int)bits, lane, 2);
      bits |= (unsigned)shxi((int)bits, lane, 4);
      if (act && (hth & 7) == 0) p.selm[((size_t)b * NSA_G + g) * SEQ + t0 + q] = bits;
      __syncthreads();
    }
  }
}

DEV void nsa_main_phase(const Params& p, LAS unsigned char* lds, int t32, int bid, int G) {
  const int lane = t32 & 63, wave = t32 >> 6, half = wave >> 2, wih = wave & 3, hth = t32 & 255;
  const int i15 = lane & 15, g4 = lane >> 4;
#define NSTAMP(i) do { if (GSEG >= 10 && blockIdx.x == 0 && t32 == 0) { const unsigned now_ = (unsigned)__builtin_amdgcn_s_memrealtime(); if ((i) > 0 && (i) - 1 + 10 == GSEG) p.barw[3600] += now_ - ns_prev; ns_prev = now_; } } while (0)
  unsigned ns_prev = 0u;
  for (int round2 = 0; round2 < nsa_rounds(G) * (NSA_PROBE == 5 ? 2 : 1); ++round2) {
    const int round = (NSA_PROBE == 5) ? (round2 >> 1) : round2;
    NSTAMP(0);
    int b = 0, g = 0, tb = 0;
    const bool act = nsa_unit(round, bid, G, half, b, g, tb);
    const int t0 = tb * 32;
    SelJob sj{p.u, b, g, t0, 0u, {0u, 0u}};
    if (act) {
      const unsigned* sm = p.selm + ((size_t)b * NSA_G + g) * SEQ + t0;
      sj.tm[0] = sm[i15]; sj.tm[1] = sm[16 + i15];
      unsigned um = sj.tm[0] | sj.tm[1];
      int l2 = lane;
      asm volatile("" : "+v"(l2));
      um |= (unsigned)shxi((int)um, l2, 1); um |= (unsigned)shxi((int)um, l2, 2);
      um |= (unsigned)shxi((int)um, l2, 4); um |= (unsigned)shxi((int)um, l2, 8);
      sj.um = um & range_mask(0, t0 >> 6);
    }
    u32x2 base[2][4];
    const int hh = g * 4 + wih;
    const size_t nrow0 = (size_t)b * SEQ + t0 + i15;
    const act_t gq10 = p.u[nrow0 * N_IN + OFF_CG + hh * 3 + 1], gq11 = p.u[(nrow0 + 16) * N_IN + OFF_CG + hh * 3 + 1];
    const act_t gq20 = p.u[nrow0 * N_IN + OFF_CG + hh * 3 + 2], gq21 = p.u[(nrow0 + 16) * N_IN + OFF_CG + hh * 3 + 2];
    {
      AttnState ss;
      NSTAMP(1);
      attn_run<false>(sj, lds, ss, half, hth, wih, lane);
      NSTAMP(2);
#if NSA_PROBE == 1
      attn_run<false>(sj, lds, ss, half, hth, wih, lane);
#endif
#pragma unroll
      for (int sub = 0; sub < 2; ++sub) {
        f32x4 oc[4];
#pragma unroll
        for (int dt = 0; dt < 4; ++dt) {
          const u32x2 cw = *(const u32x2*)((const act_t*)p.ocmp + (nrow0 + 16 * sub) * 1024 + hh * 64 + 16 * dt + 4 * g4);
          oc[dt] = (f32x4){__uint_as_float(cw.x << 16), __uint_as_float(cw.x & 0xffff0000u), __uint_as_float(cw.y << 16), __uint_as_float(cw.y & 0xffff0000u)};
        }
        const float g1 = sigmoidf_(ldf(sub ? gq11 : gq10));
#pragma unroll
        for (int dt = 0; dt < 4; ++dt) {
          const f32x4 y = ss.O[sub][dt] * g1 + oc[dt];
          base[sub][dt].x = pk2(y.x, y.y); base[sub][dt].y = pk2(y.z, y.w);
        }
      }
    }
    WinJob wj{p.u, b, g, t0, 0u};
    if (act) { const int lo = t0 - (NSA_WIN - 1) < 0 ? 0 : (t0 - (NSA_WIN - 1)) >> 6; wj.um = range_mask(lo, (t0 + 31) >> 6); }
    AttnState ws;
    NSTAMP(3);
    attn_run<false>(wj, lds, ws, half, hth, wih, lane);
    NSTAMP(4);
#if NSA_PROBE == 2
    attn_run<false>(wj, lds, ws, half, hth, wih, lane);
#endif
    if (act) {
#pragma unroll
      for (int sub = 0; sub < 2; ++sub) {
        const size_t n = nrow0 + 16 * sub;
        const float g2 = sigmoidf_(ldf(sub ? gq21 : gq20));
#pragma unroll
        for (int dt = 0; dt < 4; ++dt) {
          const u32x2 bw = base[sub][dt];
          f32x4 y = ws.O[sub][dt] * g2;
          y.x += __uint_as_float(bw.x << 16); y.y += __uint_as_float(bw.x & 0xffff0000u);
          y.z += __uint_as_float(bw.y << 16); y.w += __uint_as_float(bw.y & 0xffff0000u);
          u32x2 w; w.x = pk2(y.x, y.y); w.y = pk2(y.z, y.w);
          *(u32x2*)(p.yc + n * YLD + hh * 64 + 16 * dt + 4 * g4) = w;
        }
      }
    }
  }
}

DEV void dil_phase(const Params& p, LAS unsigned char* lds, int t32, int bid, int G) {
  const int lane = t32 & 63, wave = t32 >> 6, half = wave >> 2, wih = wave & 3, hth = t32 & 255;
  const int i15 = lane & 15, g4 = lane >> 4;
  const bool xm = (G & 7) == 0;
  const int npair = xm ? 96 : 768, pstep = xm ? (G >> 3) : G;
  for (int pair = xm ? (bid >> 3) : bid; pair < npair; pair += pstep) {
    const int un = pair * 2 + half;
    int gi, b, r2;
    if (xm) { b = bid & 7; gi = un / 64; r2 = un % 64; }
    else { gi = un / 512; const int r = un % 512; b = r / 64; r2 = r % 64; }
    const int dil = gi == 0 ? 1 : (gi == 1 ? 4 : 16);
    const int nlb = 16 / dil;
    const int h = r2 / 16, r3 = r2 % 16;
    const int res = r3 / nlb, lb = r3 % nlb;
    const int l0 = lb * 128;
    DilJob job{p.u, b, gi * 256 + h * 64, dil, res, l0, 0u};
    job.um = range_mask(l0 >= 128 ? (l0 - 128) >> 6 : 0, (l0 + 127) >> 6);
    AttnState st;
    attn_run<false>(job, lds, st, half, hth, wih, lane);
#pragma unroll
    for (int sub = 0; sub < 2; ++sub) {
      const int l = l0 + wih * 32 + sub * 16 + i15;
      const size_t n = (size_t)b * SEQ + l * dil + res;
#pragma unroll
      for (int dt = 0; dt < 4; ++dt) {
        const f32x4 y = st.O[sub][dt];
        u32x2 w; w.x = pk2(y.x, y.y); w.y = pk2(y.z, y.w);
        *(u32x2*)(p.dilo + ((size_t)gi * N_TOK + n) * 256 + h * 64 + 16 * dt + 4 * g4) = w;
      }
      if (g4 == 0) p.dill[((size_t)gi * N_TOK + n) * 4 + h] = st.m[sub] + __builtin_amdgcn_logf(st.l[sub]);
    }
  }
}

DEV void dil_combine(const Params& p, long long tid, long long nthr) {
  for (long long idx = tid; idx < (long long)N_TOK * 32; idx += nthr) {
    const size_t n = idx >> 5; const int c8 = (int)(idx & 31) * 8, h = c8 >> 6;
    const float l0 = p.dill[((size_t)0 * N_TOK + n) * 4 + h], l1 = p.dill[((size_t)1 * N_TOK + n) * 4 + h], l2 = p.dill[((size_t)2 * N_TOK + n) * 4 + h];
    const float mx = fmaxf(l0, fmaxf(l1, l2));
    float w0 = __builtin_amdgcn_exp2f(l0 - mx), w1 = __builtin_amdgcn_exp2f(l1 - mx), w2 = __builtin_amdgcn_exp2f(l2 - mx);
    const float inv = 1.0f / (w0 + w1 + w2);
    w0 *= inv; w1 *= inv; w2 *= inv;
    const u32x4 a = *(const u32x4*)(p.dilo + ((size_t)0 * N_TOK + n) * 256 + c8);
    const u32x4 bq = *(const u32x4*)(p.dilo + ((size_t)1 * N_TOK + n) * 256 + c8);
    const u32x4 c = *(const u32x4*)(p.dilo + ((size_t)2 * N_TOK + n) * 256 + c8);
    u32x4 o;
#pragma unroll
    for (int i = 0; i < 4; ++i) {
      const float lo = w0 * __uint_as_float(a[i] << 16) + w1 * __uint_as_float(bq[i] << 16) + w2 * __uint_as_float(c[i] << 16);
      const float hi = w0 * __uint_as_float(a[i] & 0xffff0000u) + w1 * __uint_as_float(bq[i] & 0xffff0000u) + w2 * __uint_as_float(c[i] & 0xffff0000u);
      o[i] = pk2(lo, hi);
    }
    *(u32x4*)(p.ya + n * YLD + c8) = o;
  }
}

DEV void cmpa_build(const Params& p, int li, long long tid, long long nthr) {
  for (long long idx = tid; idx < 2LL * CMP_ROWS * 256; idx += nthr) {
    const int which = (int)(idx / ((long long)CMP_ROWS * 256));
    const long long rem = idx % ((long long)CMP_ROWS * 256);
    const int row = (int)(rem >> 8), c8 = (int)(rem & 255) * 8, l = c8 >> 6, d = c8 & 63;
    const int g = row % NSA_G, c = (row / NSA_G) % N_CMP, b = row / (NSA_G * N_CMP);
    const float* pe = (which ? p.cmp_pe_v : p.cmp_pe_k) + (size_t)li * 32 * HD + l * HD + d;
    const u32x4 uv = *(const u32x4*)(p.u + ((size_t)b * SEQ + c * 16 + l) * N_IN + (which ? OFF_CVC : OFF_CKC) + g * HD + d);
    u32x4 o;
#pragma unroll
    for (int i = 0; i < 4; ++i) o[i] = pk2(__uint_as_float(uv[i] << 16) + pe[2 * i], __uint_as_float(uv[i] & 0xffff0000u) + pe[2 * i + 1]);
    *(u32x4*)(p.cmpA + ((size_t)which * CMP_ROWS_PAD + row) * 2048 + c8) = o;
  }
}

constexpr int XA_ROWB = 528;
constexpr int XA_TILEB = 32 * XA_ROWB;
static_assert(4 * XA_TILEB <= RING_BYTES, "xattn LDS map");
DEV void xattn_phase(const Params& p, LAS unsigned char* lds, int t32, int bid, int G) {
  const int lane = t32 & 63, wave = t32 >> 6, i15 = lane & 15, g4 = lane >> 4;
  const float sc2 = 0.0625f * 1.4426950408889634f;
  const bool xm = (G & 7) == 0;
  const int nun = xm ? XH * (SEQ / 128) : BATCH * XH * (SEQ / 128), ustep = xm ? (G >> 3) : G;
  for (int un = xm ? (bid >> 3) : bid; un < nun; un += ustep) {
    const int b = xm ? (bid & 7) : un / (XH * (SEQ / 128)), r = un % (XH * (SEQ / 128)), h = r / (SEQ / 128), qb = r % (SEQ / 128);
    const size_t nq = (size_t)b * SEQ + qb * 128 + wave * 16 + i15;
    bf16x8 qf[8];
#pragma unroll
    for (int kk = 0; kk < 8; ++kk) qf[kk] = *(const bf16x8*)(p.xq + nq * 1024 + h * 256 + kk * 32 + 8 * g4);
    f32x4 O[16];
#pragma unroll
    for (int dt = 0; dt < 16; ++dt) O[dt] = (f32x4){0.f, 0.f, 0.f, 0.f};
    float m = -INFINITY, l = 0.f;
    const int srow = t32 >> 4, sch = t32 & 15;
    const act_t* kbase = p.memk + ((size_t)b * MEM_LEN + srow) * 1024 + h * 256 + sch * 16;
    const act_t* vbase = p.memv + ((size_t)b * MEM_LEN + srow) * 1024 + h * 256 + sch * 16;
    u32x4 sk0 = *(const u32x4*)kbase, sk1 = *(const u32x4*)(kbase + 8), sv0 = *(const u32x4*)vbase, sv1 = *(const u32x4*)(vbase + 8);
    {
      LAS unsigned char* kd = lds + srow * XA_ROWB + sch * 32;
      *(LAS u32x4*)kd = sk0; *(LAS u32x4*)(kd + 16) = sk1;
      LAS unsigned char* vd = lds + 2 * XA_TILEB + srow * XA_ROWB + sch * 32;
      *(LAS u32x4*)vd = sv0; *(LAS u32x4*)(vd + 16) = sv1;
    }
    __syncthreads();
    for (int it = 0; it < MEM_LEN / 32; ++it) {
      if (it + 1 < MEM_LEN / 32) {
        const act_t* kr = kbase + (size_t)(it + 1) * 32 * 1024, *vr = vbase + (size_t)(it + 1) * 32 * 1024;
        sk0 = *(const u32x4*)kr; sk1 = *(const u32x4*)(kr + 8); sv0 = *(const u32x4*)vr; sv1 = *(const u32x4*)(vr + 8);
      }
      const LAS unsigned char* Kb = lds + (it & 1) * XA_TILEB;
      const LAS unsigned char* Vb = lds + (2 + (it & 1)) * XA_TILEB;
      f32x4 S[2];
      S[0] = (f32x4){0.f, 0.f, 0.f, 0.f}; S[1] = (f32x4){0.f, 0.f, 0.f, 0.f};
#pragma unroll
      for (int t = 0; t < 2; ++t)
#pragma unroll
        for (int kk = 0; kk < 8; ++kk) {
          const bf16x8 kf = *(const LAS bf16x8*)(Kb + (16 * t + i15) * XA_ROWB + (kk * 32 + 8 * g4) * 2);
          S[t] = __builtin_amdgcn_mfma_f32_16x16x32_bf16(kf, qf[kk], S[t], 0, 0, 0);
        }
      float mx = -INFINITY;
#pragma unroll
      for (int t = 0; t < 2; ++t)
#pragma unroll
        for (int j = 0; j < 4; ++j) { S[t][j] *= sc2; mx = fmaxf(mx, S[t][j]); }
      mx = fmaxf(mx, shx(mx, lane, 16));
      mx = fmaxf(mx, shx(mx, lane, 32));
      const float mnew = fmaxf(m, mx);
      const float corr = __builtin_amdgcn_exp2f(m - mnew);
      m = mnew;
      float psum = 0.f;
#pragma unroll
      for (int t = 0; t < 2; ++t)
#pragma unroll
        for (int j = 0; j < 4; ++j) { const float pp = __builtin_amdgcn_exp2f(S[t][j] - mnew); S[t][j] = pp; psum += pp; }
      l = l * corr + psum;
      u32x4 w;
      w.x = pk2(S[0][0], S[0][1]); w.y = pk2(S[0][2], S[0][3]); w.z = pk2(S[1][0], S[1][1]); w.w = pk2(S[1][2], S[1][3]);
      const bf16x8 pf = __builtin_bit_cast(bf16x8, w);
#pragma unroll
      for (int dt = 0; dt < 16; ++dt) {
        const LAS unsigned char* vp = Vb + (4 * g4 + (i15 >> 2)) * XA_ROWB + (16 * dt + 4 * (lane & 3)) * 2;
        const v4i16_t lo = tr_read(vp), hi = tr_read(vp + 16 * XA_ROWB);
        bf16x8 vf;
        vf[0] = lo[0]; vf[1] = lo[1]; vf[2] = lo[2]; vf[3] = lo[3]; vf[4] = hi[0]; vf[5] = hi[1]; vf[6] = hi[2]; vf[7] = hi[3];
        O[dt] = __builtin_amdgcn_mfma_f32_16x16x32_bf16(vf, pf, O[dt] * corr, 0, 0, 0);
      }
      if (it + 1 < MEM_LEN / 32) {
        LAS unsigned char* kd = lds + ((it + 1) & 1) * XA_TILEB + srow * XA_ROWB + sch * 32;
        *(LAS u32x4*)kd = sk0; *(LAS u32x4*)(kd + 16) = sk1;
        LAS unsigned char* vd = lds + (2 + ((it + 1) & 1)) * XA_TILEB + srow * XA_ROWB + sch * 32;
        *(LAS u32x4*)vd = sv0; *(LAS u32x4*)(vd + 16) = sv1;
      }
      __syncthreads();
    }
    l += shx(l, lane, 16);
    l += shx(l, lane, 32);
    const float inv = 1.0f / l;
#pragma unroll
    for (int dt = 0; dt < 16; ++dt) {
      const f32x4 y = O[dt] * inv;
      u32x2 w; w.x = pk2(y.x, y.y); w.y = pk2(y.z, y.w);
      *(u32x2*)(p.xo + nq * 1024 + h * 256 + 16 * dt + 4 * g4) = w;
    }
  }
}

constexpr int RT_LCNT = MISC_OFF + 4096, RT_BASE = RT_LCNT + 128, RT_SEL = RT_BASE + 128, RT_RANK = RT_SEL + 1024;
DEV void route_phase(const Params& p, int li, LAS unsigned char* lds, int t32, int bid, int G) {
  const int lane = t32 & 63, wave = t32 >> 6, i15 = lane & 15, g4 = lane >> 4;
  const float* W = p.w_router + (size_t)li * D * NE;
  LAS unsigned short* Wh = (LAS unsigned short*)lds;
  LAS unsigned short* Wl = (LAS unsigned short*)(lds + 65536);
  LAS int* lcnt = (LAS int*)(lds + RT_LCNT);
  LAS int* lbase = (LAS int*)(lds + RT_BASE);
  LAS int* lsel = (LAS int*)(lds + RT_SEL);
  LAS int* lrank = (LAS int*)(lds + RT_RANK);
  const int e = lane & 31;
  const float bias = p.b_router[li * NE + e];
  for (int blk = bid; blk < N_TOK / 64; blk += G) {
    __syncthreads();
    for (int i = 0; i < 16; ++i) {
      const int idx = t32 + 512 * i, k = idx >> 3, e4 = (idx & 7) * 4;
      const f32x4 w = ((const f32x4*)W)[idx];
#pragma unroll
      for (int q = 0; q < 4; ++q) {
        const unsigned short hi = f2bfh(w[q]);
        const unsigned short lo = f2bfh(w[q] - __uint_as_float(((unsigned)hi) << 16));
        Wh[(e4 + q) * 1024 + k] = hi; Wl[(e4 + q) * 1024 + k] = lo;
      }
    }
    if (t32 < 32) lcnt[t32] = 0;
    __syncthreads();
    f32x4 acc[4][2];
#pragma unroll
    for (int mt = 0; mt < 4; ++mt) { acc[mt][0] = (f32x4){0.f, 0.f, 0.f, 0.f}; acc[mt][1] = (f32x4){0.f, 0.f, 0.f, 0.f}; }
    const int n0 = blk * 64;
#pragma unroll 1
    for (int kk = 0; kk < 4; ++kk) {
      const int kb = wave * 128 + kk * 32 + 8 * g4;
      bf16x8 bh[2], bl[2];
#pragma unroll
      for (int nt = 0; nt < 2; ++nt) {
        bh[nt] = *(const LAS bf16x8*)(Wh + (16 * nt + i15) * 1024 + kb);
        bl[nt] = *(const LAS bf16x8*)(Wl + (16 * nt + i15) * 1024 + kb);
      }
#pragma unroll
      for (int mt = 0; mt < 4; ++mt) {
        const float* xr = p.xf + (size_t)(n0 + 16 * mt + i15) * D + kb;
        const f32x4 x0 = *(const f32x4*)xr, x1 = *(const f32x4*)(xr + 4);
        u32x4 hw, lw;
        {
          const unsigned h0 = pk2(x0.x, x0.y), h1 = pk2(x0.z, x0.w), h2 = pk2(x1.x, x1.y), h3 = pk2(x1.z, x1.w);
          hw = (u32x4){h0, h1, h2, h3};
          lw.x = pk2(x0.x - __uint_as_float(h0 << 16), x0.y - __uint_as_float(h0 & 0xffff0000u));
          lw.y = pk2(x0.z - __uint_as_float(h1 << 16), x0.w - __uint_as_float(h1 & 0xffff0000u));
          lw.z = pk2(x1.x - __uint_as_float(h2 << 16), x1.y - __uint_as_float(h2 & 0xffff0000u));
          lw.w = pk2(x1.z - __uint_as_float(h3 << 16), x1.w - __uint_as_float(h3 & 0xffff0000u));
        }
        const bf16x8 ah = __builtin_bit_cast(bf16x8, hw), al = __builtin_bit_cast(bf16x8, lw);
#pragma unroll
        for (int nt = 0; nt < 2; ++nt) {
          acc[mt][nt] = __builtin_amdgcn_mfma_f32_16x16x32_bf16(ah, bh[nt], acc[mt][nt], 0, 0, 0);
          acc[mt][nt] = __builtin_amdgcn_mfma_f32_16x16x32_bf16(ah, bl[nt], acc[mt][nt], 0, 0, 0);
          acc[mt][nt] = __builtin_amdgcn_mfma_f32_16x16x32_bf16(al, bh[nt], acc[mt][nt], 0, 0, 0);
        }
      }
    }
    __syncthreads();
    LAS float* part = (LAS float*)lds;
    LAS float* fin = (LAS float*)(lds + 8 * 64 * 33 * 4);
#pragma unroll
    for (int mt = 0; mt < 4; ++mt)
#pragma unroll
      for (int nt = 0; nt < 2; ++nt)
#pragma unroll
        for (int j = 0; j < 4; ++j) part[(wave * 64 + 16 * mt + 4 * g4 + j) * 33 + 16 * nt + i15] = acc[mt][nt][j];
    __syncthreads();
    {
      const int tok = t32 >> 3, e4 = (t32 & 7) * 4;
#pragma unroll
      for (int q = 0; q < 4; ++q) {
        float v = 0.f;
#pragma unroll
        for (int w = 0; w < 8; ++w) v += part[(w * 64 + tok) * 33 + e4 + q];
        fin[tok * 33 + e4 + q] = v;
      }
    }
    __syncthreads();
    float cur[8]; int sel[8][4]; float sv[8][4];
#pragma unroll
    for (int t = 0; t < 8; ++t) cur[t] = fin[(wave * 8 + t) * 33 + e] + bias;
#pragma unroll
    for (int k = 0; k < 4; ++k) {
      float bv[8]; int bi[8];
#pragma unroll
      for (int t = 0; t < 8; ++t) { bv[t] = cur[t]; bi[t] = e; }
#pragma unroll
      for (int o = 1; o < 32; o <<= 1) {
#pragma unroll
        for (int t = 0; t < 8; ++t) {
          const float ov = shx(bv[t], lane, o); const int oi = shxi(bi[t], lane, o);
          if (ov > bv[t] || (ov == bv[t] && oi < bi[t])) { bv[t] = ov; bi[t] = oi; }
        }
      }
#pragma unroll
      for (int t = 0; t < 8; ++t) { sel[t][k] = bi[t]; sv[t][k] = bv[t]; if (e == bi[t]) cur[t] = -INFINITY; }
    }
    int abase = __builtin_amdgcn_readfirstlane(wave * 32);
    asm volatile("" : "+s"(abase));
    if (lane == 0) {
#pragma unroll
      for (int t = 0; t < 8; ++t) {
        const int n = n0 + wave * 8 + t;
        const float e1 = expf(sv[t][1] - sv[t][0]), e2 = expf(sv[t][2] - sv[t][0]), e3 = expf(sv[t][3] - sv[t][0]);
        const float inv = 1.0f / (1.0f + e1 + e2 + e3);
        p.topg[n * 4 + 0] = inv; p.topg[n * 4 + 1] = e1 * inv; p.topg[n * 4 + 2] = e2 * inv; p.topg[n * 4 + 3] = e3 * inv;
#pragma unroll
        for (int k = 0; k < 4; ++k) {
          const int a = abase + t * 4 + k;
          lsel[a] = sel[t][k];
          lrank[a] = __hip_atomic_fetch_add(lcnt + sel[t][k], 1, __ATOMIC_RELAXED, __HIP_MEMORY_SCOPE_WORKGROUP);
        }
      }
    }
    __syncthreads();
    if (t32 < 32) lbase[t32] = atomicAdd(&p.cnt[li * 32 + t32], lcnt[t32]);
    __syncthreads();
    if (t32 < 256) {
      const int a = blk * 256 + t32, ee = lsel[t32];
      p.topi[a] = ee;
      p.rank[a] = lbase[ee] + lrank[t32];
    }
  }
  __syncthreads();
}

DEV void kcv_phase(const Params& p, int li, LAS unsigned char* lds, int t32, int bid, int G) {
  const int lane = t32 & 63, wave = t32 >> 6;
  LAS float* w2l = (LAS float*)lds;
  LAS float* rowb = (LAS float*)(lds + 65536) + wave * 512;
  __syncthreads();
#pragma unroll
  for (int i = 0; i < 4; ++i) {
    ((LAS f32x4*)w2l)[t32 + 512 * i] = ((const f32x4*)(p.cmp_w2_k + (size_t)li * CMP_HID * HD))[t32 + 512 * i];
    ((LAS f32x4*)w2l)[2048 + t32 + 512 * i] = ((const f32x4*)(p.cmp_w2_v + (size_t)li * CMP_HID * HD))[t32 + 512 * i];
  }
  __syncthreads();
  const int NGW = G * 8;
  for (int r0 = bid * 8 + wave; r0 < 2 * CMP_ROWS; r0 += 4 * NGW) {
    int rows[4];
#pragma unroll
    for (int i = 0; i < 4; ++i) { rows[i] = r0 + i * NGW; if (rows[i] >= 2 * CMP_ROWS) rows[i] = r0; }
#pragma unroll
    for (int i = 0; i < 4; ++i) {
      const float* hr = p.hid + (size_t)rows[i] * CMP_HID;
      rowb[i * 128 + lane] = hr[lane]; rowb[i * 128 + 64 + lane] = hr[64 + lane];
    }
    asm volatile("s_waitcnt lgkmcnt(0)" ::: "memory");
    float acc[4] = {0.f, 0.f, 0.f, 0.f};
    const LAS float* wq[4];
#pragma unroll
    for (int i = 0; i < 4; ++i) wq[i] = w2l + (rows[i] >= CMP_ROWS ? 128 * 64 : 0) + lane;
#pragma unroll 8
    for (int j = 0; j < CMP_HID; ++j) {
#pragma unroll
      for (int i = 0; i < 4; ++i) acc[i] += rowb[i * 128 + j] * wq[i][j * 64];
    }
#pragma unroll
    for (int i = 0; i < 4; ++i) {
      const int row = r0 + i * NGW;
      if (row < 2 * CMP_ROWS) {
        const int which = row >= CMP_ROWS ? 1 : 0, rr = row - which * CMP_ROWS;
        const int g_ = rr % NSA_G, c_ = (rr / NSA_G) % N_CMP, b_ = rr / (NSA_G * N_CMP);
        p.kcb[((((size_t)which * BATCH + b_) * 128 + c_) * NSA_G + g_) * 64 + lane] = f2bfh(acc[i]);
      }
    }
    asm volatile("s_waitcnt lgkmcnt(0)" ::: "memory");
  }
  __syncthreads();
}

constexpr int GA_QS = 272, GA_VS = 528, GA_PS = 144;
constexpr int GA_QT = 0, GA_KT = GA_QT + 64 * GA_QS, GA_KH = GA_KT + 64 * GA_QS, GA_VT = GA_KH + 64 * GA_QS, GA_PT = GA_VT + 64 * GA_VS,
              GA_LR = GA_PT + 64 * GA_PS, GA_GT = GA_LR + 64 * 16 * 4, GA_DC = GA_GT + 4 * 128 * 4, GA_END = GA_DC + 512;
static_assert(GA_END <= RING_BYTES, "GLA phase A LDS map");
constexpr int GC_SP = 0, GC_QT = GC_SP + 128 * GA_VS, GC_RED = GC_QT + 64 * GA_QS, GC_END = GC_RED + 8 * 16 * 4 * 2;
static_assert(GC_END <= RING_BYTES, "GLA phase C LDS map");

#define GSTAMP(i) do { if (GSEG >= 0 && blockIdx.x == 0 && t32 == 0) { const unsigned now_ = (unsigned)__builtin_amdgcn_s_memrealtime(); if ((i) > 0 && (i) - 1 == GSEG) p.barw[3600] += now_ - gs_prev; gs_prev = now_; } } while (0)
DEV void gla_a_unit(const Params& p, int li, LAS unsigned char* lds, int t32, int unit) {
  unsigned gs_prev = 0u;
  GSTAMP(0);
  const int lane = t32 & 63, wave = t32 >> 6, i15 = lane & 15, g4 = lane >> 4;
  const int bh = unit >> 5, ci = unit & 31, b = bh >> 2, h = bh & 3;
  const int c = t32 & 127, jq = t32 >> 7;
  LAS float* LR = (LAS float*)(lds + GA_LR);
  LAS float* GT = (LAS float*)(lds + GA_GT);
  LAS float* DC = (LAS float*)(lds + GA_DC);
  const float qscale = 0.08838834764831845f;
  const size_t n0 = (size_t)b * SEQ + ci * 64;
  {
    const int e = t32 * 2, j = e >> 4, r = e & 15;
    const unsigned w = *(const unsigned*)(p.u + (n0 + j) * N_IN + OFF_LR + r);
    LR[e] = __uint_as_float(w << 16); LR[e + 1] = __uint_as_float(w & 0xffff0000u);
  }
  float wa[GLA_RANK];
#pragma unroll
  for (int r = 0; r < GLA_RANK; ++r) wa[r] = p.w_alpha2[((size_t)li * GLA_RANK + r) * B_K + h * 128 + c];
  const float ba = p.b_alpha[li * B_K + h * 128 + c];
#pragma unroll
  for (int x = 0; x < 2; ++x) {
    const int idx = t32 + 512 * x, row = idx >> 4, ch = idx & 15;
    const act_t* ur = p.u + (n0 + row) * N_IN + h * 128 + ch * 8;
    *(LAS u32x4*)(lds + GA_QT + row * GA_QS + ch * 16) = *(const u32x4*)(ur + OFF_BQ);
    *(LAS u32x4*)(lds + GA_KT + row * GA_QS + ch * 16) = *(const u32x4*)(ur + OFF_BK);
  }
#pragma unroll
  for (int x = 0; x < 4; ++x) {
    const int idx = t32 + 512 * x, row = idx >> 5, ch = idx & 31;
    const u32x4 vv = *(const u32x4*)(p.u + (n0 + row) * N_IN + OFF_BV + h * 256 + ch * 8);
    *(LAS u32x4*)(lds + GA_VT + row * GA_VS + ch * 16) = vv;
  }
  __syncthreads();
  GSTAMP(1);
  float bl[16];
  float run = 0.f;
#pragma unroll
  for (int jj = 0; jj < 16; ++jj) {
    const LAS f32x4* lr4 = (const LAS f32x4*)(LR + (jq * 16 + jj) * 16);
    float z = ba;
#pragma unroll
    for (int r4 = 0; r4 < 4; ++r4) { const f32x4 x = lr4[r4]; z += x.x * wa[4 * r4] + x.y * wa[4 * r4 + 1] + x.z * wa[4 * r4 + 2] + x.w * wa[4 * r4 + 3]; }
    const float ez = __builtin_amdgcn_exp2f(-fabsf(z) * 1.4426950408889634f);
    const float ls = (fminf(z, 0.f) - __builtin_amdgcn_logf(1.0f + ez) * 0.6931471805599453f) * (1.0f / 16.0f);
    run += ls; bl[jj] = run;
  }
  GT[jq * 128 + c] = run;
  __syncthreads();
  GSTAMP(2);
  {
    const float g0 = GT[c], g1 = GT[128 + c], g2 = GT[256 + c], g3 = GT[384 + c];
    const float off = (jq > 0 ? g0 : 0.f) + (jq > 1 ? g1 : 0.f) + (jq > 2 ? g2 : 0.f);
    const float tot = (g0 + g1) + (g2 + g3);
    const float dtot = __builtin_amdgcn_exp2f(tot * 1.4426950408889634f);
    if (jq == 0) { DC[c] = dtot; p.gD[(size_t)unit * 128 + c] = dtot; }
#pragma unroll
    for (int jj = 0; jj < 16; ++jj) {
      const float e1 = __builtin_amdgcn_exp2f((off + bl[jj]) * 1.4426950408889634f), ie = __builtin_amdgcn_rcpf(e1);
      const int ro = (jq * 16 + jj) * GA_QS + c * 2;
      const float qf = __uint_as_float(((unsigned)*(const LAS unsigned short*)(lds + GA_QT + ro)) << 16);
      const float kf = __uint_as_float(((unsigned)*(const LAS unsigned short*)(lds + GA_KT + ro)) << 16);
      const unsigned short qt = f2bfh(qf * e1 * qscale);
      *(LAS unsigned short*)(lds + GA_QT + ro) = qt;
      p.gQ[((size_t)unit * 64 + jq * 16 + jj) * 128 + c] = qt;
      *(LAS unsigned short*)(lds + GA_KT + ro) = f2bfh(kf * ie);
      *(LAS unsigned short*)(lds + GA_KH + ro) = f2bfh(kf * ie * dtot);
    }
  }
  __syncthreads();
  GSTAMP(3);
#pragma unroll
  for (int q = 0; q < 2; ++q) {
    const int id = wave * 2 + q, jt = id >> 2, it = id & 3;
    f32x4 a = (f32x4){0.f, 0.f, 0.f, 0.f};
#pragma unroll
    for (int kk = 0; kk < 4; ++kk) {
      const bf16x8 kf = *(const LAS bf16x8*)(lds + GA_KT + (16 * jt + i15) * GA_QS + (32 * kk + 8 * g4) * 2);
      const bf16x8 qf = *(const LAS bf16x8*)(lds + GA_QT + (16 * it + i15) * GA_QS + (32 * kk + 8 * g4) * 2);
      a = __builtin_amdgcn_mfma_f32_16x16x32_bf16(kf, qf, a, 0, 0, 0);
    }
    const int i = 16 * it + i15, j0 = 16 * jt + 4 * g4;
    u32x2 w;
    w.x = pk2(j0 <= i ? a.x : 0.f, j0 + 1 <= i ? a.y : 0.f);
    w.y = pk2(j0 + 2 <= i ? a.z : 0.f, j0 + 3 <= i ? a.w : 0.f);
    *(LAS u32x2*)(lds + GA_PT + i * GA_PS + j0 * 2) = w;
  }
  __syncthreads();
  GSTAMP(4);
  {
    const int it = wave & 3, vt0 = (wave >> 2) * 8;
    bf16x8 pf[2];
#pragma unroll
    for (int s = 0; s < 2; ++s) pf[s] = *(const LAS bf16x8*)(lds + GA_PT + (16 * it + i15) * GA_PS + (32 * s + 8 * g4) * 2);
#pragma unroll
    for (int x = 0; x < 8; ++x) {
      const int vt = vt0 + x;
      f32x4 a = (f32x4){0.f, 0.f, 0.f, 0.f};
#pragma unroll
      for (int s = 0; s < 2; ++s) {
        const LAS unsigned char* vp = lds + GA_VT + (32 * s + 8 * g4 + (i15 >> 2)) * GA_VS + (16 * vt + 4 * (lane & 3)) * 2;
        const v4i16_t lo = tr_read(vp), hi = tr_read(vp + 4 * GA_VS);
        bf16x8 vf;
        vf[0] = lo[0]; vf[1] = lo[1]; vf[2] = lo[2]; vf[3] = lo[3]; vf[4] = hi[0]; vf[5] = hi[1]; vf[6] = hi[2]; vf[7] = hi[3];
        a = __builtin_amdgcn_mfma_f32_16x16x32_bf16(vf, pf[s], a, 0, 0, 0);
      }
      *(f32x4*)(p.opart + (n0 + 16 * it + i15) * 1024 + h * 256 + 16 * vt + 4 * g4) = a;
    }
  }
  {
    bf16x8 vf[2][2];
#pragma unroll
    for (int x = 0; x < 2; ++x)
#pragma unroll
      for (int s = 0; s < 2; ++s) {
        const LAS unsigned char* vp = lds + GA_VT + (32 * s + 8 * g4 + (i15 >> 2)) * GA_VS + (16 * (2 * wave + x) + 4 * (lane & 3)) * 2;
        const v4i16_t lo = tr_read(vp), hi = tr_read(vp + 4 * GA_VS);
        vf[x][s][0] = lo[0]; vf[x][s][1] = lo[1]; vf[x][s][2] = lo[2]; vf[x][s][3] = lo[3];
        vf[x][s][4] = hi[0]; vf[x][s][5] = hi[1]; vf[x][s][6] = hi[2]; vf[x][s][7] = hi[3];
      }
#pragma unroll
    for (int ct = 0; ct < 8; ++ct) {
      f32x4 a0 = (f32x4){0.f, 0.f, 0.f, 0.f}, a1 = (f32x4){0.f, 0.f, 0.f, 0.f};
#pragma unroll
      for (int s = 0; s < 2; ++s) {
        const LAS unsigned char* kp = lds + GA_KH + (32 * s + 8 * g4 + (i15 >> 2)) * GA_QS + (16 * ct + 4 * (lane & 3)) * 2;
        const v4i16_t lo = tr_read(kp), hi = tr_read(kp + 4 * GA_QS);
        bf16x8 kf;
        kf[0] = lo[0]; kf[1] = lo[1]; kf[2] = lo[2]; kf[3] = lo[3]; kf[4] = hi[0]; kf[5] = hi[1]; kf[6] = hi[2]; kf[7] = hi[3];
        a0 = __builtin_amdgcn_mfma_f32_16x16x32_bf16(vf[0][s], kf, a0, 0, 0, 0);
        a1 = __builtin_amdgcn_mfma_f32_16x16x32_bf16(vf[1][s], kf, a1, 0, 0, 0);
      }
      act_t* up = p.gU + ((size_t)unit * 128 + 16 * ct + i15) * 256 + 32 * wave + 4 * g4;
      u32x2 w0; w0.x = pk2(a0.x, a0.y); w0.y = pk2(a0.z, a0.w);
      u32x2 w1; w1.x = pk2(a1.x, a1.y); w1.y = pk2(a1.z, a1.w);
      *(u32x2*)up = w0; *(u32x2*)(up + 16) = w1;
    }
  }
  __syncthreads();
  GSTAMP(5);
}

DEV void gla_scan(const Params& p, long long tid, long long nthr) {
  for (long long idx = tid; idx < 32LL * 128 * 32; idx += nthr) {
    const int v8 = (int)(idx & 31) * 8, c = (int)((idx >> 5) & 127), bh = (int)(idx >> 12);
    float s[8];
#pragma unroll
    for (int i = 0; i < 8; ++i) s[i] = 0.f;
#pragma unroll 8
    for (int ci = 0; ci < 32; ++ci) {
      const size_t unit = (size_t)bh * 32 + ci;
      const u32x4 uw = *(const u32x4*)(p.gU + (unit * 128 + c) * 256 + v8);
      const float d = p.gD[unit * 128 + c];
      u32x4 o;
#pragma unroll
      for (int i = 0; i < 4; ++i) o[i] = pk2(s[2 * i], s[2 * i + 1]);
      *(u32x4*)(p.gS + (unit * 128 + c) * 256 + v8) = o;
#pragma unroll
      for (int i = 0; i < 4; ++i) {
        s[2 * i] = s[2 * i] * d + __uint_as_float(uw[i] << 16);
        s[2 * i + 1] = s[2 * i + 1] * d + __uint_as_float(uw[i] & 0xffff0000u);
      }
    }
  }
}

DEV void gla_c_unit(const Params& p, int li, LAS unsigned char* lds, int t32, int unit) {
  const int lane = t32 & 63, wave = t32 >> 6, i15 = lane & 15, g4 = lane >> 4;
  const int bh = unit >> 5, ci = unit & 31, b = bh >> 2, h = bh & 3;
  const size_t n0 = (size_t)b * SEQ + ci * 64;
#pragma unroll
  for (int x = 0; x < 8; ++x) {
    const int idx = t32 + 512 * x, row = idx >> 5, ch = idx & 31;
    *(LAS u32x4*)(lds + GC_SP + row * GA_VS + ch * 16) = *(const u32x4*)(p.gS + ((size_t)unit * 128 + row) * 256 + ch * 8);
  }
#pragma unroll
  for (int x = 0; x < 2; ++x) {
    const int idx = t32 + 512 * x, row = idx >> 4, ch = idx & 15;
    *(LAS u32x4*)(lds + GC_QT + row * GA_QS + ch * 16) = *(const u32x4*)(p.gQ + ((size_t)unit * 64 + row) * 128 + ch * 8);
  }
  __syncthreads();
  const int it = wave & 3, vt0 = (wave >> 2) * 8;
  bf16x8 qf[4];
#pragma unroll
  for (int kk = 0; kk < 4; ++kk) qf[kk] = *(const LAS bf16x8*)(lds + GC_QT + (16 * it + i15) * GA_QS + (32 * kk + 8 * g4) * 2);
  const size_t n = n0 + 16 * it + i15;
  f32x4 o[8];
  float ss = 0.f;
#pragma unroll
  for (int x = 0; x < 8; ++x) {
    const int vt = vt0 + x;
    f32x4 a = *(const f32x4*)(p.opart + n * 1024 + h * 256 + 16 * vt + 4 * g4);
#pragma unroll
    for (int kk = 0; kk < 4; ++kk) {
      const LAS unsigned char* sp = lds + GC_SP + (32 * kk + 8 * g4 + (i15 >> 2)) * GA_VS + (16 * vt + 4 * (lane & 3)) * 2;
      const v4i16_t lo = tr_read(sp), hi = tr_read(sp + 4 * GA_VS);
      bf16x8 sf;
      sf[0] = lo[0]; sf[1] = lo[1]; sf[2] = lo[2]; sf[3] = lo[3]; sf[4] = hi[0]; sf[5] = hi[1]; sf[6] = hi[2]; sf[7] = hi[3];
      a = __builtin_amdgcn_mfma_f32_16x16x32_bf16(sf, qf[kk], a, 0, 0, 0);
    }
    o[x] = a;
    ss += (a.x * a.x + a.y * a.y) + (a.z * a.z + a.w * a.w);
  }
  ss += shx(ss, lane, 16);
  ss += shx(ss, lane, 32);
  LAS float* RED = (LAS float*)(lds + GC_RED);
  if (g4 == 0) RED[wave * 16 + i15] = ss;
  __syncthreads();
  ss += RED[(wave ^ 4) * 16 + i15];
  const float rs = 1.0f / sqrtf(ss * (1.0f / 256.0f) + LN_EPS);
#pragma unroll
  for (int x = 0; x < 8; ++x) {
    const int v = 16 * (vt0 + x) + 4 * g4;
    const f32x4 gn = *(const f32x4*)(p.gla_norm_g + li * DV + v);
    const u32x2 rw = *(const u32x2*)(p.u + n * N_IN + OFF_BR + h * 256 + v);
    const float r0 = __uint_as_float(rw.x << 16), r1 = __uint_as_float(rw.x & 0xffff0000u), r2 = __uint_as_float(rw.y << 16), r3 = __uint_as_float(rw.y & 0xffff0000u);
    u32x2 w;
    w.x = pk2(o[x].x * rs * gn.x * (r0 * sigmoidf_(r0)), o[x].y * rs * gn.y * (r1 * sigmoidf_(r1)));
    w.y = pk2(o[x].z * rs * gn.z * (r2 * sigmoidf_(r2)), o[x].w * rs * gn.w * (r3 * sigmoidf_(r3)));
    *(u32x2*)(p.yb + n * YLD + h * 256 + v) = w;
  }
  __syncthreads();
}

#define XB_TMO      128
#define XB_XCNT(j)  (256  + 64 * (j))
#define XB_XSUB(j)  (1280 + 64 * (j))
#define XB_XGEN(j)  (2304 + 64 * (j))
#define XB_TOP      3328
#define XB_TOPGEN   3392
#define XCD_BAR_WORDS 3456
#define XB_SPIN_CAP (1u << 18)

__device__ __forceinline__ unsigned xb_ld(unsigned* p)              { return __hip_atomic_load(p, __ATOMIC_RELAXED, __HIP_MEMORY_SCOPE_AGENT); }
__device__ __forceinline__ unsigned xb_add(unsigned* p, unsigned v) { return __hip_atomic_fetch_add(p, v, __ATOMIC_RELAXED, __HIP_MEMORY_SCOPE_AGENT); }
__device__ __forceinline__ unsigned xb_xcc_id() { return (unsigned)__builtin_amdgcn_s_getreg((3 << 11) | 20) & 0xFu; }
#define XB_SPIN(cond, bar) do { unsigned _sp = 0; while (cond) { __builtin_amdgcn_s_sleep(1); \
    if ((++_sp & 255u) == 0u) { if (xb_ld(&(bar)[XB_TMO])) break; if (_sp > XB_SPIN_CAP) { atomicAdd(&(bar)[XB_TMO], 1u); break; } } } } while (0)

struct XcdBarrier {
    unsigned* bar; unsigned x;
    volatile LAS unsigned* st;
};

__device__ __forceinline__ XcdBarrier xcd_barrier_post(unsigned* bar, volatile LAS unsigned* st) {
    XcdBarrier b; b.bar = bar; b.x = xb_xcc_id(); b.st = st;
    if (threadIdx.x == 0) st[2] = xb_add(&bar[XB_XCNT(b.x)], 1u);
    return b;
}
__device__ __forceinline__ void xcd_barrier_complete(unsigned* bar, unsigned x, unsigned& nloc, unsigned& nx) {
    const unsigned G = gridDim.x * gridDim.y * gridDim.z;
    unsigned sum, cnt, mine, sp = 0u;
    for (;;) {
        sum = 0u; cnt = 0u; mine = 0u;
#pragma unroll
        for (unsigned j = 0; j < 16; ++j) { const unsigned c = xb_ld(&bar[XB_XCNT(j)]); sum += c; cnt += (c > 0u) ? 1u : 0u; mine = (j == x) ? c : mine; }
        if (sum == G) break;
        __builtin_amdgcn_s_sleep(1);
        if ((++sp & 255u) == 0u) { if (xb_ld(&bar[XB_TMO])) break; if (sp > XB_SPIN_CAP) { atomicAdd(&bar[XB_TMO], 1u); break; } }
    }
    nloc = mine > 0u ? mine : 1u; nx = cnt > 0u ? cnt : 1u;
}

__device__ __forceinline__ void xcd_barrier(const XcdBarrier& b, const int t32) {
    asm volatile("s_waitcnt vmcnt(0)" ::: "memory");
    __syncthreads();
    if (t32 == 0) {
        unsigned* bar = b.bar;
        __builtin_amdgcn_s_waitcnt(0);
        unsigned nloc = b.st[0], nx = b.st[1];
        if (nloc == 0u) { xcd_barrier_complete(bar, b.x, nloc, nx); b.st[0] = nloc; b.st[1] = nx; }
        const unsigned old = xb_add(&bar[XB_XSUB(b.x)], 1u);
        const unsigned gen = old / nloc;
        if (old + 1u == (gen + 1u) * nloc) {
            __builtin_amdgcn_fence(__ATOMIC_RELEASE, "agent");
            asm volatile("s_waitcnt vmcnt(0)" ::: "memory");
            const unsigned og = xb_add(&bar[XB_TOP], 1u);
            const unsigned tg = og / nx;
            if (og + 1u == (tg + 1u) * nx) xb_add(&bar[XB_TOPGEN], 1u);
            else XB_SPIN(xb_ld(&bar[XB_TOPGEN]) == tg, bar);
            __builtin_amdgcn_fence(__ATOMIC_ACQUIRE, "agent");
            xb_add(&bar[XB_XGEN(b.x)], 1u);
            asm volatile("s_waitcnt vmcnt(0)" ::: "memory");
        } else {
            XB_SPIN(xb_ld(&bar[XB_XGEN(b.x)]) == gen, bar);
            __builtin_amdgcn_fence(__ATOMIC_ACQUIRE, "agent");
            asm volatile("s_waitcnt vmcnt(0)" ::: "memory");
        }
    }
    __syncthreads();
}

constexpr int STEPS_PER_LAYER = 21;
#ifndef PROBE_LO
#define PROBE_LO -1
#define PROBE_HI -1
#endif
#ifndef PROBE_PRO
#define PROBE_PRO 0
#endif
#ifndef TSTEP_LO
#define TSTEP_LO -2
#define TSTEP_HI -2
#endif
#ifndef TSUB
#define TSUB -9
#endif
#ifndef TSTEP_Q
#define TSTEP_Q 40u
#endif
#ifndef NSA_PROBE
#define NSA_PROBE 0
#endif
#ifndef MULTI_LAUNCH
#define MULTI_LAUNCH 0
#endif
DEV int fresh_t32(int wave) {
  int t;
  asm volatile("v_mbcnt_lo_u32_b32 %0, -1, 0\n\tv_mbcnt_hi_u32_b32 %0, -1, %0" : "=v"(t));
  return t + wave * 64;
}
struct KArgs { void* in[35]; void* out; void* ws; };
template <bool WITH_NAIVE, bool COOP>
__global__ void __launch_bounds__(NTHREADS) k_mega(KArgs ka, int step_lo, int step_hi) {
  unsigned* const barw0 = ((unsigned*)ka.ws);
  extern __shared__ __attribute__((aligned(16))) unsigned char lds_raw[];
  LAS unsigned char* lds = (LAS unsigned char*)lds_raw;
  LAS int* tab = (LAS int*)(lds + MISC_OFF);
  const int wave = __builtin_amdgcn_readfirstlane(threadIdx.x >> 6);
  const int G = gridDim.x;
  int bid = blockIdx.x;

  LAS unsigned* miscw = (LAS unsigned*)(lds + MISC_OFF + 8192);
  if (threadIdx.x < 128) miscw[threadIdx.x] = 0u;
  __syncthreads();
  XcdBarrier xbar; xbar.bar = barw0; xbar.x = 0; xbar.st = nullptr;
  if (COOP) xbar = xcd_barrier_post(barw0, miscw + 8);
  unsigned* const stamp = barw0 + 3584;
  if (step_lo < 0) {
    Params p;
    fill_params(p, ka.in, ka.out, ka.ws);
    if (TSTEP_LO == -1 && blockIdx.x == 0 && threadIdx.x == 0) { stamp[0] = (unsigned)__builtin_amdgcn_s_memrealtime(); stamp[2] = 0u; stamp[3] = 0u; }
    prologue(p, lds, wave, threadIdx.x & 63);
    if (COOP) {
      if (step_hi == -12345) cg::this_grid().sync();
      xcd_barrier(xbar, (int)threadIdx.x);
    }
#if PROBE_PRO
    prologue(p, lds, wave, threadIdx.x & 63);
    if (COOP) cg::this_grid().sync();
#endif
    step_lo = 0;
    if (TSTEP_LO == -1 && blockIdx.x == 0 && threadIdx.x == 0) stamp[1] = (unsigned)__builtin_amdgcn_s_memrealtime();
    if (COOP) {
      bool even = (G % 8) == 0;
#pragma unroll
      for (int j = 0; j < 8; ++j) even = even && (xb_ld(&barw0[XB_XCNT(j)]) == (unsigned)(G / 8));
      __syncthreads();
      if (even) bid = __builtin_amdgcn_readfirstlane((int)(xbar.x + 8u * miscw[10]));
    }
  }
  int rep_done = 0;
  for (int step = step_lo; step < step_hi;) {
    int li = step / STEPS_PER_LAYER;
    const int k = step % STEPS_PER_LAYER;
    int nb32 = gridDim.x;
    char* wsb = (char*)ka.ws;
    asm volatile("" : "+s"(wsb));
    Params p;
    fill_params(p, ka.in, ka.out, wsb);
    asm volatile("" : "+s"(li));
    asm volatile("" : "+s"(nb32));
#define T32() fresh_t32(wave)
#define TID() ((int)(blockIdx.x * NTHREADS) + T32())
    const int nthr = nb32 * NTHREADS;
    const int gw = blockIdx.x * 8 + wave, NGW = nb32 * 8;
    if (TSTEP_LO >= 0 && k == TSTEP_LO && blockIdx.x == 0 && wave == 0) stamp[2 * li] = (unsigned)__builtin_amdgcn_s_memrealtime();
    const bool is_gemm = (k == 0) || (k >= 2 && k <= 5) || (k == 9) || (k == 10) || (k == 12) || (k == 14) || (k == 18) || (k == 19);
    const bool sync_after = !(k == 2 || k == 3 || k == 4);
    if (is_gemm) {
      pg8::Gemm g{nullptr, nullptr, 0, 0, 0};
      USched S; S.init_static(256, 256, G, bid);
      EpiU E{0, 0, nullptr, nullptr, nullptr, nullptr, nullptr};
      const size_t WSQ = (size_t)1024 * 1024;
      switch (k) {
        case 0:
          g = pg8::Gemm{p.xb, p.wt_in + (size_t)li * N_IN_PAD * 1024, N_TOK, N_IN_PAD, 1024};
          S.init_static(N_TOK, N_IN_PAD, G, bid);
          E.mode = EM_INPROJ; E.q0 = p.u; E.q1 = p.b_in + (size_t)li * N_IN; break;
        case 2:
          g = pg8::Gemm{p.cmpA, p.wt_c1 + (size_t)(li * 2 + 0) * 256 * 2048, CMP_ROWS_PAD, 256, 2048};
          S.init_static(CMP_ROWS_PAD, 256, G, bid);
          E.mode = EM_HID; E.q0 = p.hid; break;
        case 3:
          g = pg8::Gemm{p.cmpA + (size_t)CMP_ROWS_PAD * 2048, p.wt_c1 + (size_t)(li * 2 + 1) * 256 * 2048, CMP_ROWS_PAD, 256, 2048};
          S.init_static(CMP_ROWS_PAD, 256, G, (bid + G - 16) % G);
          E.mode = EM_HID; E.q0 = p.hid + (size_t)CMP_ROWS * CMP_HID; break;
        case 4:
          g = pg8::Gemm{p.membf, p.wt_xk + li * WSQ, BATCH * MEM_LEN, 1024, 1024};
          S.init_static(BATCH * MEM_LEN, 1024, G, (bid + G - 32) % G);
          E.mode = EM_BF16; E.q0 = p.memk; E.ldc = 1024; break;
        case 5:
          g = pg8::Gemm{p.membf, p.wt_xv + li * WSQ, BATCH * MEM_LEN, 1024, 1024};
          S.init_static(BATCH * MEM_LEN, 1024, G, (bid + G - 64) % G);
          E.mode = EM_BF16; E.q0 = p.memv; E.ldc = 1024; break;
        case 9:
          g = pg8::Gemm{p.ya, p.wt_bra + (size_t)li * 1024 * YLD, N_TOK, 1024, YLD};
          S.init_static(N_TOK, 1024, G, bid);
          E.mode = EM_BRCAT; E.q1 = p.u; E.q0 = p.merged; break;
        case 10:
          g = pg8::Gemm{p.merged, p.wt_omix + li * WSQ, N_TOK, 1024, 1024};
          S.init_static(N_TOK, 1024, G, bid);
          E.mode = EM_RES; E.q1 = p.xf; E.q0 = p.tmp; break;
        case 12:
          g = pg8::Gemm{p.xb, p.wt_xq + li * WSQ, N_TOK, 1024, 1024};
          S.init_static(N_TOK, 1024, G, bid);
          E.mode = EM_BF16; E.q0 = p.xq; E.ldc = 1024; break;
        case 14:
          g = pg8::Gemm{p.xo, p.wt_xo + li * WSQ, N_TOK, 1024, 1024};
          S.init_static(N_TOK, 1024, G, bid);
          E.mode = EM_RES; E.q1 = p.xf; E.q0 = p.tmp; break;
        case 18: {
          const int ntiles = moe_tables(p, li, tab, T32());
          g = pg8::Gemm{p.xg, p.wt_gu + (size_t)li * 32 * 2048 * 1024, MOE_ROWS, 32 * 2048, 1024};
          S.init_moe(G, bid, 8, ntiles * 8, tab + 128);
          E.mode = EM_MOE1; E.q0 = p.actg; E.q1 = p.b_gu + (size_t)li * 32 * 2048; E.te = tab + 128; break; }
        default: {
          const int ntiles = moe_tables(p, li, tab, T32());
          g = pg8::Gemm{p.actg, p.wt_dn + (size_t)li * 32 * 1024 * 1024, MOE_ROWS, 32 * 1024, 1024};
          S.init_moe(G, bid, 4, ntiles * 4, tab + 128);
          E.mode = EM_MOE2; E.q0 = p.yass; E.q1 = p.b_down + (size_t)li * 32 * 1024; E.q2 = p.topg; E.q3 = p.rowlist; E.te = tab + 128; break; }
      }
      pg8::gemm_phase<EpiU, USched, true, true>(lds, g, S, E, T32());
    } else {
      switch (k) {
        case 1: cmpa_build(p, li, TID(), nthr); break;
        case 6:
#define SUBSTAMP(i) do { if (TSUB == (i) && blockIdx.x == 0 && wave == 0) stamp[2 * li] = (unsigned)__builtin_amdgcn_s_memrealtime(); if (TSUB + 1 == (i) && blockIdx.x == 0 && wave == 0) stamp[2 * li + 1] = (unsigned)__builtin_amdgcn_s_memrealtime(); } while (0)
          SUBSTAMP(1);
          { const int t = T32(); for (int un = bid; un < 1024; un += G) gla_a_unit(p, li, lds, t, un); }
          SUBSTAMP(2);
          dil_phase(p, lds, T32(), bid, G);
          SUBSTAMP(3);
          kcv_phase(p, li, lds, T32(), bid, G);
          SUBSTAMP(4);
          break;
        case 7: SUBSTAMP(8); gla_scan(p, TID(), nthr); SUBSTAMP(9); nsa_cmp_phase(p, lds, T32(), bid, G); SUBSTAMP(10); dil_combine(p, TID(), nthr); SUBSTAMP(11); break;
        case 8: {
          SUBSTAMP(5);
          nsa_main_phase(p, lds, T32(), bid, G);
          __syncthreads();
          SUBSTAMP(6);
          const int t = T32();
          for (int un = bid; un < 1024; un += G) gla_c_unit(p, li, lds, t, un);
          SUBSTAMP(7);
          break; }
        case 11: ln_rows_w<0>(p, p.tmp, p.ln1_g + li * D, p.ln1_b + li * D, p.xf, p.xb, nullptr, gw, NGW, T32() & 63); break;
        case 13: xattn_phase(p, lds, T32(), bid, G); break;
        case 15: ln_rows_w<0>(p, p.tmp, p.ln2_g + li * D, p.ln2_b + li * D, p.xf, p.xb, nullptr, gw, NGW, T32() & 63); break;
        case 16: route_phase(p, li, lds, T32(), bid, G); break;
        case 17: { const int t = T32(); moe_prep(p, li, tab, wave, t & 63, t); break; }
        case 20: ln_rows_w<1>(p, nullptr, p.ln3_g + li * D, p.ln3_b + li * D, p.xf, p.xb, li == DEPTH - 1 ? p.out : nullptr, gw, NGW, T32() & 63); break;
        default: break;
      }
    }
    if (COOP && sync_after) xcd_barrier(xbar, T32());
    if (TSTEP_LO >= 0 && k == TSTEP_HI && blockIdx.x == 0 && wave == 0) stamp[2 * li + 1] = (unsigned)__builtin_amdgcn_s_memrealtime();
    if (PROBE_HI >= 0 && k == PROBE_HI && !rep_done) { rep_done = 1; step -= (PROBE_HI - PROBE_LO); }
    else { if (k == PROBE_HI) rep_done = 0; ++step; }
  }
  if (GSEG >= 0 && blockIdx.x == 0 && fresh_t32(wave) == 0) {
    __builtin_amdgcn_s_waitcnt(0);
    const unsigned tk = __hip_atomic_load(barw0 + 3600, __ATOMIC_RELAXED, __HIP_MEMORY_SCOPE_AGENT);
    ((float*)ka.out)[0] = (float)((tk / 100u + TSTEP_Q / 2) / TSTEP_Q * TSTEP_Q);
  }
  if (TSTEP_LO >= -1 && blockIdx.x == 0 && fresh_t32(wave) == 0) {
    __builtin_amdgcn_s_waitcnt(0);
    const unsigned tk = (__hip_atomic_load(stamp + 1, __ATOMIC_RELAXED, __HIP_MEMORY_SCOPE_AGENT) - __hip_atomic_load(stamp + 0, __ATOMIC_RELAXED, __HIP_MEMORY_SCOPE_AGENT)) + (__hip_atomic_load(stamp + 3, __ATOMIC_RELAXED, __HIP_MEMORY_SCOPE_AGENT) - __hip_atomic_load(stamp + 2, __ATOMIC_RELAXED, __HIP_MEMORY_SCOPE_AGENT));
    ((float*)ka.out)[0] = (float)((tk / 100u + TSTEP_Q / 2) / TSTEP_Q * TSTEP_Q);
  }
}

extern "C" void kernel_launch(void* const* d_in, const int* in_sizes, int n_in, void* d_out, int out_size,
                              void* d_ws, size_t ws_size, hipStream_t stream) {
  Params p;
  memset(&p, 0, sizeof(p));
  fill_params(p, d_in, d_out, d_ws);
  KArgs ka;
  memset(&ka, 0, sizeof(ka));
  for (int i = 0; i < 35; ++i) ka.in[i] = d_in[i];
  ka.out = d_out; ka.ws = d_ws;
  static int grid_blocks = 0;
  if (!grid_blocks) {
    int dev = 0, cus = 0;
    hipGetDevice(&dev);
    hipDeviceGetAttribute(&cus, hipDeviceAttributeMultiprocessorCount, dev);
    hipFuncSetAttribute((const void*)k_mega<true, true>, hipFuncAttributeMaxDynamicSharedMemorySize, LDS_BYTES);
    if (p.ws_used > ws_size) fprintf(stderr, "workspace too small: need %zu have %zu\n", p.ws_used, ws_size);
    grid_blocks = cus;
  }
  hipMemsetAsync(p.barw, 0, 4096 * sizeof(unsigned), stream);
  int lo = -1, hi = DEPTH * STEPS_PER_LAYER;
  void* args[] = {&ka, &lo, &hi};
  hipError_t e = hipLaunchCooperativeKernel((void*)k_mega<true, true>, dim3(grid_blocks), dim3(NTHREADS), args, LDS_BYTES, stream);
  if (e != hipSuccess) fprintf(stderr, "cooperative launch failed: %s (grid %d)\n", hipGetErrorString(e), grid_blocks);
}
#endif
```

```cpp
#ifndef CPU_TEST
#include <hip/hip_runtime.h>
#include <hip/hip_cooperative_groups.h>
#include <cstdio>
#include <cstring>
#include <cmath>
namespace cg = cooperative_groups;
#define DEV __device__ __forceinline__
#define HDI __host__ __device__ __forceinline__
#else
#include <cmath>
#include <cstdio>
#include <cstdlib>
#include <cstring>
#define DEV static inline
#define HDI static inline
#endif

#ifndef D_MODEL
#define D_MODEL 1024
#endif
#ifndef BATCH
#define BATCH 8
#endif
#ifndef MEGA
#define MEGA 1
#endif

constexpr int D = D_MODEL;
constexpr int SEQ = 2048;
constexpr int DEPTH = 2;
constexpr int MEM_LEN = 256;
constexpr int HD = 64;
constexpr int N_TOK = BATCH * SEQ;
constexpr int GLA_H = 4;
constexpr int DK = D / 2 / GLA_H;
constexpr int DV = D / GLA_H;
constexpr int GLA_RANK = 16;
constexpr int B_K = GLA_H * DK;
constexpr int B_V = GLA_H * DV;
constexpr int NSA_H = 16;
constexpr int NSA_G = 4;
constexpr int N_CMP = 127;
constexpr int CMP_HID = 128;
constexpr int N_BLK = 32;
constexpr int N_SELECT = 16;
constexpr int NSA_WIN = 512;
constexpr int XH = 4;
constexpr int XHD = D / XH;
constexpr int NE = 32;
constexpr int TOPK = 4;
constexpr int DFF = D;
constexpr float LN_EPS = 1e-5f;
constexpr float ALPHA = 1.41421356237309515f;

constexpr int OFF_AQ = 0;
constexpr int OFF_AK = 768;
constexpr int OFF_AV = 1536;
constexpr int OFF_BQ = 2304;
constexpr int OFF_BK = OFF_BQ + B_K;
constexpr int OFF_BV = OFF_BK + B_K;
constexpr int OFF_BR = OFF_BV + B_V;
constexpr int OFF_LR = OFF_BR + B_V;
constexpr int OFF_CQ = OFF_LR + GLA_RANK;
constexpr int OFF_CKC = OFF_CQ + 1024;
constexpr int OFF_CVC = OFF_CKC + 256;
constexpr int OFF_CKS = OFF_CVC + 256;
constexpr int OFF_CVS = OFF_CKS + 256;
constexpr int OFF_CKW = OFF_CVS + 256;
constexpr int OFF_CVW = OFF_CKW + 256;
constexpr int OFF_CG = OFF_CVW + 256;
constexpr int OFF_MG = OFF_CG + 48;
constexpr int N_IN = OFF_MG + 3 * D;
constexpr int N_IN_PAD = (N_IN + 255) / 256 * 256;
constexpr int MOE_ROWS = N_TOK * 4 + 32 * 256;
constexpr int CMP_ROWS_PAD = 4096;
constexpr int YLD = 256 + 1024 + 1024;

#ifdef CPU_TEST
typedef float act_t;
DEV float ldf(float v) { return v; }
DEV void stf(float* p, float v) { *p = v; }
#else
typedef unsigned short act_t;
DEV float ldf(unsigned short h) { return __uint_as_float(((unsigned)h) << 16); }
DEV float ldf(float v) { return v; }
DEV unsigned short f2bf(float f) {
  unsigned u = __float_as_uint(f);
  u += 0x7fffu + ((u >> 16) & 1u);
  return (unsigned short)(u >> 16);
}
DEV void stf(unsigned short* p, float v) { *p = f2bf(v); }
DEV void stf(float* p, float v) { *p = v; }
#endif

struct Params {
  const float *x, *mem, *ln0_g, *ln0_b, *w_in, *b_in, *w_alpha2, *b_alpha, *gla_norm_g,
      *cmp_pe_k, *cmp_w1_k, *cmp_w2_k, *cmp_pe_v, *cmp_w1_v, *cmp_w2_v,
      *w_br_a, *w_br_b, *w_br_c, *w_o_mix, *ln1_g, *ln1_b, *w_xq, *w_xk, *w_xv, *w_xo, *ln2_g, *ln2_b,
      *w_router, *b_router, *w_gu, *b_gu, *w_down, *b_down, *ln3_g, *ln3_b;
  float* out;
  float* xf;
  act_t* xb;
  act_t* u;
  float* ga;
  float* hid;
  float* kcv;
  float* opart;
  act_t* ya;
  act_t* yb;
  act_t* yc;
  float* pcmp;
  float* ocmp;
  float* impb;
  int* selb;
  act_t* merged;
  float* tmp;
  act_t* xq;
  act_t* memk;
  act_t* memv;
  float* xs;
  act_t* xo;
  float* rl;
  int* topi;
  float* topg;
  act_t* act;
  act_t* wt_in;
  act_t* wt_c1;
  act_t* wt_bra;
  act_t* wt_brb;
  act_t* wt_brc;
  act_t* wt_omix;
  act_t* wt_xq;
  act_t* wt_xk;
  act_t* wt_xv;
  act_t* wt_xo;
  act_t* wt_gu;
  act_t* wt_dn;
  act_t* membf;
  act_t* cmpA;
  float* mrg;
  int* cnt;
  int* rank;
  int* rowlist;
  act_t* xg;
  act_t* actg;
  float* yass;
  act_t* kcb;
  act_t* dilo;
  float* dill;
  unsigned* selm;
  act_t* gU;
  act_t* gS;
  act_t* gQ;
  float* gD;
  unsigned* barw;
  size_t ws_used;
};

#ifdef CPU_TEST
#define FOR_IDX(idx, total) \
  for (long long idx = (long long)(total) * tid / nthr, _e = (long long)(total) * (tid + 1) / nthr; idx < _e; ++idx)
#else
#define FOR_IDX(idx, total) for (long long idx = tid; idx < (long long)(total); idx += nthr)
#endif

DEV float sigmoidf_(float x) { return 1.0f / (1.0f + expf(-x)); }

template <class TA>
DEV float dotcol(const TA* a, const float* W, int K, long long ldw) {
  float s = 0.f;
  for (int k = 0; k < K; ++k) s += ldf(a[k]) * W[(long long)k * ldw];
  return s;
}

DEV void ph_ln(const float* src, const float* g, const float* b, float* dstf, act_t* dstb, float* dst2,
               long long tid, long long nthr) {
  FOR_IDX(n, N_TOK) {
    const float* r = src + n * D;
    float mu = 0.f;
    for (int i = 0; i < D; ++i) mu += r[i];
    mu /= D;
    float var = 0.f;
    for (int i = 0; i < D; ++i) { float d = r[i] - mu; var += d * d; }
    var /= D;
    float rs = 1.0f / sqrtf(var + LN_EPS);
    for (int i = 0; i < D; ++i) {
      float y = (r[i] - mu) * rs * g[i] + b[i];
      dstf[n * D + i] = y;
      stf(&dstb[n * D + i], y);
      if (dst2) dst2[n * D + i] = y;
    }
  }
}

DEV void ph_inproj(const Params& p, int li, long long tid, long long nthr) {
  const float* W = p.w_in + (long long)li * D * N_IN;
  const float* bias = p.b_in + (long long)li * N_IN;
  FOR_IDX(idx, (long long)N_TOK * N_IN) {
    long long n = idx / N_IN; int c = (int)(idx % N_IN);
    stf(&p.u[idx], dotcol(p.xb + n * D, W + c, D, N_IN) + bias[c]);
  }
}

DEV float gelu_tanh(float x) {
  return 0.5f * x * (1.0f + tanhf(0.7978845608028654f * (x + 0.044715f * x * x * x)));
}

constexpr int CMP_ROWS = BATCH * N_CMP * NSA_G;

template <int PARTS>
DEV void ph_pre(const Params& p, int li, long long tid, long long nthr) {
  const long long T1 = (long long)N_TOK * B_K;
  const long long T2 = (PARTS & 2) ? 2LL * CMP_ROWS * CMP_HID : 0;
  FOR_IDX(idx, T1 + T2) {
    if (idx < T1) {
      if (!(PARTS & 1)) continue;
      long long n = idx / B_K; int c = (int)(idx % B_K);
      const float* W2 = p.w_alpha2 + (long long)li * GLA_RANK * B_K;
      float z = p.b_alpha[li * B_K + c];
      for (int r = 0; r < GLA_RANK; ++r) z += ldf(p.u[n * N_IN + OFF_LR + r]) * W2[r * B_K + c];
      float ls = fminf(z, 0.f) - log1pf(expf(-fabsf(z)));
      p.ga[idx] = expf(ls * (1.0f / 16.0f));
    } else {
      long long i2 = idx - T1;
      int which = (int)(i2 / ((long long)CMP_ROWS * CMP_HID));
      long long rem = i2 % ((long long)CMP_ROWS * CMP_HID);
      int row = (int)(rem / CMP_HID), j = (int)(rem % CMP_HID);
      int g = row % NSA_G; int c = (row / NSA_G) % N_CMP; int b = row / (NSA_G * N_CMP);
      const float* pe = (which ? p.cmp_pe_v : p.cmp_pe_k) + (long long)li * 32 * HD;
      const float* w1 = (which ? p.cmp_w1_v : p.cmp_w1_k) + (long long)li * 32 * HD * CMP_HID;
      int off = (which ? OFF_CVC : OFF_CKC) + g * HD;
      float s = 0.f;
      for (int l = 0; l < 32; ++l) {
        const act_t* ur = p.u + ((long long)b * SEQ + c * 16 + l) * N_IN + off;
        for (int d = 0; d < HD; ++d) s += (ldf(ur[d]) + pe[l * HD + d]) * w1[(long long)(l * HD + d) * CMP_HID + j];
      }
      p.hid[i2] = gelu_tanh(s);
    }
  }
}

template <int PARTS>
DEV void ph_mix1(const Params& p, int li, long long tid, long long nthr) {
  const long long T1 = (long long)N_TOK * 4;
  const long long T2 = (long long)BATCH * GLA_H * DV * 4;
  const long long T3 = 2LL * CMP_ROWS * HD;
  FOR_IDX(idx, T1 + T2 + T3) {
    if (idx < T1) {
      if (!(PARTS & 1)) continue;
      long long n = idx / 4; int h = (int)(idx % 4);
      int b = (int)(n / SEQ), t = (int)(n % SEQ);
      float m = -INFINITY, l = 0.f;
      float acc[HD];
#pragma unroll
      for (int d = 0; d < HD; ++d) acc[d] = 0.f;
      for (int gi = 0; gi < 3; ++gi) {
        const int dil = gi == 0 ? 1 : (gi == 1 ? 4 : 16);
        float q[HD];
        const act_t* qp = p.u + n * N_IN + OFF_AQ + gi * 256 + h * HD;
#pragma unroll
        for (int d = 0; d < HD; ++d) q[d] = ldf(qp[d]);
        for (int mm = 0; mm <= 128; ++mm) {
          int tk = t - mm * dil;
          if (tk < 0) break;
          const act_t* kp = p.u + ((long long)b * SEQ + tk) * N_IN + OFF_AK + gi * 256 + h * HD;
          const act_t* vp = p.u + ((long long)b * SEQ + tk) * N_IN + OFF_AV + gi * 256 + h * HD;
          float s = 0.f;
#pragma unroll
          for (int d = 0; d < HD; ++d) s += q[d] * ldf(kp[d]);
          s *= 0.125f;
          float mn = fmaxf(m, s);
          float corr = expf(m - mn);
          float pp = expf(s - mn);
          l = l * corr + pp;
#pragma unroll
          for (int d = 0; d < HD; ++d) acc[d] = acc[d] * corr + pp * ldf(vp[d]);
          m = mn;
        }
      }
      float inv = 1.0f / l;
#pragma unroll
      for (int d = 0; d < HD; ++d) stf(&p.ya[n * 256 + h * HD + d], acc[d] * inv);
    } else if (idx < T1 + T2) {
      if (!(PARTS & 2)) continue;
      long long i2 = idx - T1;
      int v = (int)(i2 % DV); int cq = (int)((i2 / DV) % 4); int h = (int)((i2 / (DV * 4)) % GLA_H);
      int b = (int)(i2 / (DV * 4 * GLA_H));
      constexpr int DKQ = DK / 4;
      float st[DKQ];
#pragma unroll
      for (int c = 0; c < DKQ; ++c) st[c] = 0.f;
      const float qs = 1.0f / sqrtf((float)DK);
      for (int t = 0; t < SEQ; ++t) {
        long long n = (long long)b * SEQ + t;
        const act_t* ur = p.u + n * N_IN;
        float vt = ldf(ur[OFF_BV + h * DV + v]);
        const float* gar = p.ga + n * B_K + h * DK + cq * DKQ;
        const act_t* kr = ur + OFF_BK + h * DK + cq * DKQ;
        const act_t* qr = ur + OFF_BQ + h * DK + cq * DKQ;
        float o = 0.f;
#pragma unroll
        for (int c = 0; c < DKQ; ++c) {
          st[c] = gar[c] * st[c] + ldf(kr[c]) * vt;
          o += ldf(qr[c]) * st[c];
        }
        p.opart[((long long)cq * N_TOK + n) * B_V + h * DV + v] = o * qs;
      }
    } else {
      long long i2 = idx - T1 - T2;
      int which = (int)(i2 / ((long long)CMP_ROWS * HD));
      long long rem = i2 % ((long long)CMP_ROWS * HD);
      int row = (int)(rem / HD), d = (int)(rem % HD);
      const float* w2 = (which ? p.cmp_w2_v : p.cmp_w2_k) + (long long)li * CMP_HID * HD;
      const float* hr = p.hid + ((long long)which * CMP_ROWS + row) * CMP_HID;
      float s = 0.f;
      if (!(PARTS & 4)) continue;
      for (int j = 0; j < CMP_HID; ++j) s += hr[j] * w2[j * HD + d];
      p.kcv[i2] = s;
#ifndef CPU_TEST
      {
        const int g_ = row % NSA_G, c_ = (row / NSA_G) % N_CMP, b_ = row / (NSA_G * N_CMP);
        stf(&p.kcb[((((size_t)which * BATCH + b_) * 128 + c_) * NSA_G + g_) * 64 + d], s);
      }
#endif
    }
  }
}

template <int PARTS>
DEV void ph_nsa1(const Params& p, int li, long long tid, long long nthr) {
  const long long T1 = (long long)N_TOK * GLA_H;
  const long long T2 = (PARTS & 2) ? (long long)N_TOK * NSA_H : 0;
  FOR_IDX(idx, T1 + T2) {
    if (idx < T1) {
      long long n = idx / GLA_H; int h = (int)(idx % GLA_H);
      float ss = 0.f;
      for (int v = 0; v < DV; ++v) {
        float o = 0.f;
        for (int cq = 0; cq < 4; ++cq) o += p.opart[((long long)cq * N_TOK + n) * B_V + h * DV + v];
        ss += o * o;
      }
      float rs = 1.0f / sqrtf(ss / DV + LN_EPS);
      for (int v = 0; v < DV; ++v) {
        float o = 0.f;
        for (int cq = 0; cq < 4; ++cq) o += p.opart[((long long)cq * N_TOK + n) * B_V + h * DV + v];
        float r = ldf(p.u[n * N_IN + OFF_BR + h * DV + v]);
        float y = o * rs * p.gla_norm_g[li * DV + v] * (r * sigmoidf_(r));
        stf(&p.yb[n * B_V + h * DV + v], y);
      }
    } else {
      long long i2 = idx - T1;
      long long n = i2 / NSA_H; int hh = (int)(i2 % NSA_H);
      int b = (int)(n / SEQ), t = (int)(n % SEQ);
      int g = hh / 4;
      int nv = t >= 31 ? (t - 31) / 16 + 1 : 0;
      if (nv > N_CMP) nv = N_CMP;
      float q[HD];
      const act_t* qp = p.u + n * N_IN + OFF_CQ + hh * HD;
#pragma unroll
      for (int d = 0; d < HD; ++d) q[d] = ldf(qp[d]);
      float* prow = p.pcmp + (((long long)b * NSA_H + hh) * SEQ + t) * 128;
      float m = -INFINITY;
      for (int c = 0; c < nv; ++c) {
        const float* kp = p.kcv + (((long long)b * N_CMP + c) * NSA_G + g) * HD;
        float s = 0.f;
#pragma unroll
        for (int d = 0; d < HD; ++d) s += q[d] * kp[d];
        s *= 0.125f;
        prow[c] = s;
        m = fmaxf(m, s);
      }
      float acc[HD];
#pragma unroll
      for (int d = 0; d < HD; ++d) acc[d] = 0.f;
      float l = 0.f;
      for (int c = 0; c < nv; ++c) {
        const float* vp = p.kcv + (((long long)CMP_ROWS) + ((long long)b * N_CMP + c) * NSA_G + g) * HD;
        float pp = expf(prow[c] - m);
        l += pp;
        prow[c] = pp;
#pragma unroll
        for (int d = 0; d < HD; ++d) acc[d] += pp * vp[d];
      }
      float inv = 1.0f / fmaxf(l, 1e-30f);
      for (int c = 0; c < 128; ++c) prow[c] = c < nv ? prow[c] * inv : 0.f;
#pragma unroll
      for (int d = 0; d < HD; ++d) p.ocmp[n * 1024 + hh * HD + d] = acc[d] * inv;
    }
  }
}

DEV void ph_nsa2(const Params& p, int li, long long tid, long long nthr) {
  FOR_IDX(idx, (long long)BATCH * NSA_G * SEQ * N_BLK) {
    int j = (int)(idx % N_BLK); long long r = idx / N_BLK;
    int s = (int)(r % SEQ); int g = (int)((r / SEQ) % NSA_G); int b = (int)(r / ((long long)SEQ * NSA_G));
    int qb = s / 64;
    float imp;
    if (j == 0 || j == qb || j == qb - 1) imp = INFINITY;
    else if (j > qb) imp = -INFINITY;
    else {
      imp = 0.f;
      int c0 = 4 * j - 1; if (c0 < 0) c0 = 0;
      int c1 = 4 * j + 3; if (c1 > N_CMP - 1) c1 = N_CMP - 1;
      for (int rr = 0; rr < 4; ++rr) {
        const float* prow = p.pcmp + (((long long)b * NSA_H + g * 4 + rr) * SEQ + s) * 128;
        for (int c = c0; c <= c1; ++c) imp += prow[c];
      }
    }
    p.impb[idx] = imp;
  }
}

DEV void ph_nsa3(const Params& p, int li, long long tid, long long nthr) {
  FOR_IDX(idx, (long long)BATCH * NSA_G * SEQ * N_BLK) {
    int j = (int)(idx % N_BLK); long long r = idx / N_BLK;
    const float* ir = p.impb + r * N_BLK;
    float v = ir[j];
    int rank = 0;
    for (int jj = 0; jj < N_BLK; ++jj) {
      float w = ir[jj];
      if (w > v || (w == v && jj < j)) ++rank;
    }
    p.selb[idx] = rank < N_SELECT ? 1 : 0;
  }
}

DEV void ph_nsa4(const Params& p, int li, long long tid, long long nthr) {
  FOR_IDX(idx, (long long)N_TOK * NSA_H) {
    long long n = idx / NSA_H; int hh = (int)(idx % NSA_H);
    int b = (int)(n / SEQ), t = (int)(n % SEQ);
    int g = hh / 4;
    float q[HD];
    const act_t* qp = p.u + n * N_IN + OFF_CQ + hh * HD;
#pragma unroll
    for (int d = 0; d < HD; ++d) q[d] = ldf(qp[d]);
    float g0 = sigmoidf_(ldf(p.u[n * N_IN + OFF_CG + hh * 3 + 0]));
    float g1 = sigmoidf_(ldf(p.u[n * N_IN + OFF_CG + hh * 3 + 1]));
    float g2 = sigmoidf_(ldf(p.u[n * N_IN + OFF_CG + hh * 3 + 2]));
    float acc[HD];
    {
      float m = -INFINITY, l = 0.f;
#pragma unroll
      for (int d = 0; d < HD; ++d) acc[d] = 0.f;
      int qb = t / 64;
      const int* sr = p.selb + (((long long)b * NSA_G + g) * SEQ + t) * N_BLK;
      for (int j = 0; j <= qb; ++j) {
        if (!sr[j]) continue;
        int hi = j * 64 + 63; if (hi > t) hi = t;
        for (int tk = j * 64; tk <= hi; ++tk) {
          const act_t* kp = p.u + ((long long)b * SEQ + tk) * N_IN + OFF_CKS + g * HD;
          const act_t* vp = p.u + ((long long)b * SEQ + tk) * N_IN + OFF_CVS + g * HD;
          float s = 0.f;
#pragma unroll
          for (int d = 0; d < HD; ++d) s += q[d] * ldf(kp[d]);
          s *= 0.125f;
          float mn = fmaxf(m, s);
          float corr = expf(m - mn);
          float pp = expf(s - mn);
          l = l * corr + pp;
#pragma unroll
          for (int d = 0; d < HD; ++d) acc[d] = acc[d] * corr + pp * ldf(vp[d]);
          m = mn;
        }
      }
      float inv = 1.0f / l;
#pragma unroll
      for (int d = 0; d < HD; ++d) {
        float* oc = &p.ocmp[n * 1024 + hh * HD + d];
        *oc = g0 * (*oc) + g1 * acc[d] * inv;
      }
    }
    {
      float m = -INFINITY, l = 0.f;
#pragma unroll
      for (int d = 0; d < HD; ++d) acc[d] = 0.f;
      int lo = t - (NSA_WIN - 1); if (lo < 0) lo = 0;
      for (int tk = lo; tk <= t; ++tk) {
        const act_t* kp = p.u + ((long long)b * SEQ + tk) * N_IN + OFF_CKW + g * HD;
        const act_t* vp = p.u + ((long long)b * SEQ + tk) * N_IN + OFF_CVW + g * HD;
        float s = 0.f;
#pragma unroll
        for (int d = 0; d < HD; ++d) s += q[d] * ldf(kp[d]);
        s *= 0.125f;
        float mn = fmaxf(m, s);
        float corr = expf(m - mn);
        float pp = expf(s - mn);
        l = l * corr + pp;
#pragma unroll
        for (int d = 0; d < HD; ++d) acc[d] = acc[d] * corr + pp * ldf(vp[d]);
        m = mn;
      }
      float inv = 1.0f / l;
#pragma unroll
      for (int d = 0; d < HD; ++d)
        stf(&p.yc[n * 1024 + hh * HD + d], p.ocmp[n * 1024 + hh * HD + d] + g2 * acc[d] * inv);
    }
  }
}

DEV void ph_br(const Params& p, int li, long long tid, long long nthr) {
  const float* Wa = p.w_br_a + (long long)li * 256 * D;
  const float* Wb = p.w_br_b + (long long)li * B_V * D;
  const float* Wc = p.w_br_c + (long long)li * 1024 * D;
  FOR_IDX(idx, (long long)N_TOK * D) {
    long long n = idx / D; int d = (int)(idx % D);
    float s0 = dotcol(p.ya + n * 256, Wa + d, 256, D);
    float s1 = dotcol(p.yb + n * B_V, Wb + d, B_V, D);
    float s2 = dotcol(p.yc + n * 1024, Wc + d, 1024, D);
    const act_t* mg = p.u + n * N_IN + OFF_MG;
    float y = sigmoidf_(ldf(mg[d])) * s0 + sigmoidf_(ldf(mg[D + d])) * s1 + sigmoidf_(ldf(mg[2 * D + d])) * s2;
    stf(&p.merged[idx], y);
  }
}

DEV void ph_proj_res(const Params& p, const act_t* a, const float* W, long long tid, long long nthr) {
  FOR_IDX(idx, (long long)N_TOK * D) {
    long long n = idx / D; int d = (int)(idx % D);
    p.tmp[idx] = ALPHA * p.xf[idx] + dotcol(a + n * D, W + d, D, D);
  }
}

DEV void ph_xq(const Params& p, int li, long long tid, long long nthr) {
  const long long T1 = (long long)N_TOK * D;
  const long long T2 = 2LL * BATCH * MEM_LEN * D;
  const float* Wq = p.w_xq + (long long)li * D * D;
  FOR_IDX(idx, T1 + T2) {
    if (idx < T1) {
      long long n = idx / D; int d = (int)(idx % D);
      stf(&p.xq[idx], dotcol(p.xb + n * D, Wq + d, D, D));
    } else {
      long long i2 = idx - T1;
      int which = (int)(i2 / ((long long)BATCH * MEM_LEN * D));
      long long rem = i2 % ((long long)BATCH * MEM_LEN * D);
      long long r = rem / D; int d = (int)(rem % D);
      const float* W = (which ? p.w_xv : p.w_xk) + (long long)li * D * D;
      float s = dotcol(p.mem + r * D, W + d, D, D);
      stf(which ? &p.memv[rem] : &p.memk[rem], s);
    }
  }
}

DEV void ph_xs(const Params& p, int li, long long tid, long long nthr) {
  const float sc = 1.0f / sqrtf((float)XHD);
  FOR_IDX(idx, (long long)N_TOK * XH * MEM_LEN) {
    int m = (int)(idx % MEM_LEN); int h = (int)((idx / MEM_LEN) % XH); long long n = idx / (MEM_LEN * XH);
    int b = (int)(n / SEQ);
    const act_t* q = p.xq + n * D + h * XHD;
    const act_t* k = p.memk + ((long long)b * MEM_LEN + m) * D + h * XHD;
    float s = 0.f;
    for (int d = 0; d < XHD; ++d) s += ldf(q[d]) * ldf(k[d]);
    p.xs[idx] = s * sc;
  }
}

DEV void ph_xo(const Params& p, int li, long long tid, long long nthr) {
  FOR_IDX(idx, (long long)N_TOK * D) {
    long long n = idx / D; int c = (int)(idx % D);
    int h = c / XHD; int b = (int)(n / SEQ);
    const float* sr = p.xs + (n * XH + h) * MEM_LEN;
    float m = -INFINITY;
    for (int mm = 0; mm < MEM_LEN; ++mm) m = fmaxf(m, sr[mm]);
    float l = 0.f, o = 0.f;
    for (int mm = 0; mm < MEM_LEN; ++mm) {
      float pp = expf(sr[mm] - m);
      l += pp;
      o += pp * ldf(p.memv[((long long)b * MEM_LEN + mm) * D + c]);
    }
    stf(&p.xo[idx], o / l);
  }
}

DEV void ph_rlogit(const Params& p, int li, long long tid, long long nthr) {
  const float* W = p.w_router + (long long)li * D * NE;
  FOR_IDX(idx, (long long)N_TOK * NE) {
    long long n = idx / NE; int e = (int)(idx % NE);
    p.rl[idx] = dotcol(p.xf + n * D, W + e, D, NE) + p.b_router[li * NE + e];
  }
}

DEV void ph_route(const Params& p, int li, long long tid, long long nthr) {
  FOR_IDX(n, N_TOK) {
    const float* r = p.rl + n * NE;
    int i0 = -1, i1 = -1, i2 = -1, i3 = -1;
    float v0 = 0, v1 = 0, v2 = 0, v3 = 0;
    for (int k = 0; k < 4; ++k) {
      int bi = -1; float bv = -INFINITY;
      for (int e = 0; e < NE; ++e) {
        if (e == i0 || e == i1 || e == i2) continue;
        float v = r[e];
        if (bi < 0 || v > bv) { bi = e; bv = v; }
      }
      if (k == 0) { i0 = bi; v0 = bv; } else if (k == 1) { i1 = bi; v1 = bv; }
      else if (k == 2) { i2 = bi; v2 = bv; } else { i3 = bi; v3 = bv; }
    }
    float e0 = 1.0f, e1 = expf(v1 - v0), e2 = expf(v2 - v0), e3 = expf(v3 - v0);
    float inv = 1.0f / (e0 + e1 + e2 + e3);
#ifndef CPU_TEST
    p.rank[n * 4 + 0] = atomicAdd(&p.cnt[li * 32 + i0], 1);
    p.rank[n * 4 + 1] = atomicAdd(&p.cnt[li * 32 + i1], 1);
    p.rank[n * 4 + 2] = atomicAdd(&p.cnt[li * 32 + i2], 1);
    p.rank[n * 4 + 3] = atomicAdd(&p.cnt[li * 32 + i3], 1);
#endif
    p.topi[n * 4 + 0] = i0; p.topi[n * 4 + 1] = i1; p.topi[n * 4 + 2] = i2; p.topi[n * 4 + 3] = i3;
    p.topg[n * 4 + 0] = e0 * inv; p.topg[n * 4 + 1] = e1 * inv; p.topg[n * 4 + 2] = e2 * inv; p.topg[n * 4 + 3] = e3 * inv;
  }
}

DEV void ph_moe1(const Params& p, int li, long long tid, long long nthr) {
  FOR_IDX(idx, (long long)N_TOK * TOPK * DFF) {
    int j = (int)(idx % DFF); long long a = idx / DFF; long long n = a / TOPK;
    int e = p.topi[a];
    const float* W = p.w_gu + ((long long)li * NE + e) * D * 2 * DFF;
    const float* bb = p.b_gu + ((long long)li * NE + e) * 2 * DFF;
    float gt = dotcol(p.xb + n * D, W + j, D, 2 * DFF) + bb[j];
    float up = dotcol(p.xb + n * D, W + DFF + j, D, 2 * DFF) + bb[DFF + j];
    gt = fminf(gt, 7.0f);
    up = fminf(fmaxf(up, -7.0f), 7.0f);
    stf(&p.act[idx], (up + 1.0f) * gt * sigmoidf_(1.702f * gt));
  }
}

DEV void ph_moe2(const Params& p, int li, long long tid, long long nthr) {
  FOR_IDX(idx, (long long)N_TOK * D) {
    long long n = idx / D; int d = (int)(idx % D);
    float y = 0.f;
    for (int k = 0; k < TOPK; ++k) {
      int e = p.topi[n * 4 + k];
      const float* W = p.w_down + ((long long)li * NE + e) * DFF * D;
      float s = dotcol(p.act + (n * 4 + k) * DFF, W + d, DFF, D) + p.b_down[((long long)li * NE + e) * D + d];
      y += p.topg[n * 4 + k] * s;
    }
    p.tmp[idx] = ALPHA * p.xf[idx] + y;
  }
}

constexpr int PH_PER_LAYER = 20;
constexpr int N_PHASES = 1 + DEPTH * PH_PER_LAYER;

template <int K>
DEV void run_phase_k(const Params& p, int li, long long tid, long long nthr) {
  if constexpr (K == -1) ph_ln(p.x, p.ln0_g, p.ln0_b, p.xf, p.xb, nullptr, tid, nthr);
  if constexpr (K == 0) ph_inproj(p, li, tid, nthr);
  if constexpr (K == 1) ph_pre<3>(p, li, tid, nthr);
  if constexpr (K == 20) ph_pre<1>(p, li, tid, nthr);
  if constexpr (K == 2) ph_mix1<7>(p, li, tid, nthr);
  if constexpr (K == 21) ph_mix1<4>(p, li, tid, nthr);
  if constexpr (K == 3) ph_nsa1<3>(p, li, tid, nthr);
  if constexpr (K == 22) ph_nsa1<1>(p, li, tid, nthr);
  if constexpr (K == 4) ph_nsa2(p, li, tid, nthr);
  if constexpr (K == 5) ph_nsa3(p, li, tid, nthr);
  if constexpr (K == 6) ph_nsa4(p, li, tid, nthr);
  if constexpr (K == 7) ph_br(p, li, tid, nthr);
  if constexpr (K == 8) ph_proj_res(p, p.merged, p.w_o_mix + (long long)li * D * D, tid, nthr);
  if constexpr (K == 9) ph_ln(p.tmp, p.ln1_g + li * D, p.ln1_b + li * D, p.xf, p.xb, nullptr, tid, nthr);
  if constexpr (K == 10) ph_xq(p, li, tid, nthr);
  if constexpr (K == 11) ph_xs(p, li, tid, nthr);
  if constexpr (K == 12) ph_xo(p, li, tid, nthr);
  if constexpr (K == 13) ph_proj_res(p, p.xo, p.w_xo + (long long)li * D * D, tid, nthr);
  if constexpr (K == 14) ph_ln(p.tmp, p.ln2_g + li * D, p.ln2_b + li * D, p.xf, p.xb, nullptr, tid, nthr);
  if constexpr (K == 15) ph_rlogit(p, li, tid, nthr);
  if constexpr (K == 16) ph_route(p, li, tid, nthr);
  if constexpr (K == 17) ph_moe1(p, li, tid, nthr);
  if constexpr (K == 18) ph_moe2(p, li, tid, nthr);
  if constexpr (K == 19) ph_ln(p.tmp, p.ln3_g + li * D, p.ln3_b + li * D, p.xf, p.xb, li == DEPTH - 1 ? p.out : nullptr, tid, nthr);
}

DEV void run_phase(const Params& p, int ph, long long tid, long long nthr) {
  if (ph == 0) { run_phase_k<-1>(p, 0, tid, nthr); return; }
  int li = (ph - 1) / PH_PER_LAYER, k = (ph - 1) % PH_PER_LAYER;
  switch (k) {
#define PHC(K) case K: run_phase_k<K>(p, li, tid, nthr); break;
    PHC(0) PHC(1) PHC(2) PHC(3) PHC(4) PHC(5) PHC(6) PHC(7) PHC(8) PHC(9)
    PHC(10) PHC(11) PHC(12) PHC(13) PHC(14) PHC(15) PHC(16) PHC(17) PHC(18) PHC(19)
#undef PHC
  }
}

#ifdef CPU_TEST
#define HDI_M
#else
#define HDI_M __host__ __device__ __forceinline__
#endif
struct Carver {
  char* base; size_t off;
  template <class T> HDI_M T* take(size_t n) {
    T* r = (T*)(base + off);
    off += (n * sizeof(T) + 255) & ~(size_t)255;
    return r;
  }
};

HDI void fill_params(Params& p, void* const* d_in, void* d_out, void* d_ws) {
  const float* const* in = (const float* const*)d_in;
  p.x = in[0]; p.mem = in[1]; p.ln0_g = in[2]; p.ln0_b = in[3]; p.w_in = in[4]; p.b_in = in[5];
  p.w_alpha2 = in[6]; p.b_alpha = in[7]; p.gla_norm_g = in[8];
  p.cmp_pe_k = in[9]; p.cmp_w1_k = in[10]; p.cmp_w2_k = in[11]; p.cmp_pe_v = in[12]; p.cmp_w1_v = in[13]; p.cmp_w2_v = in[14];
  p.w_br_a = in[15]; p.w_br_b = in[16]; p.w_br_c = in[17]; p.w_o_mix = in[18]; p.ln1_g = in[19]; p.ln1_b = in[20];
  p.w_xq = in[21]; p.w_xk = in[22]; p.w_xv = in[23]; p.w_xo = in[24]; p.ln2_g = in[25]; p.ln2_b = in[26];
  p.w_router = in[27]; p.b_router = in[28]; p.w_gu = in[29]; p.b_gu = in[30]; p.w_down = in[31]; p.b_down = in[32];
  p.ln3_g = in[33]; p.ln3_b = in[34];
  p.out = (float*)d_out;
  Carver c{(char*)d_ws, 0};
  p.barw = c.take<unsigned>(4096);
  p.xf = c.take<float>((size_t)N_TOK * D);
  p.xb = c.take<act_t>((size_t)N_TOK * D);
  p.u = c.take<act_t>((size_t)N_TOK * N_IN);
  p.ga = c.take<float>((size_t)N_TOK * B_K);
  p.hid = c.take<float>((size_t)2 * CMP_ROWS * CMP_HID);
  p.kcv = c.take<float>((size_t)2 * CMP_ROWS * HD);
  p.opart = c.take<float>((size_t)4 * N_TOK * B_V);
  p.yass = p.opart;
#ifdef CPU_TEST
  p.ya = c.take<act_t>((size_t)N_TOK * 256);
  p.yb = c.take<act_t>((size_t)N_TOK * B_V);
  p.yc = c.take<act_t>((size_t)N_TOK * 1024);
#else
  p.ya = c.take<act_t>((size_t)N_TOK * YLD);
  p.yb = p.ya + 256;
  p.yc = p.ya + 1280;
#endif
  p.pcmp = c.take<float>((size_t)MOE_ROWS * 1024 / 2 > (size_t)BATCH * NSA_H * SEQ * 128 ? (size_t)MOE_ROWS * 1024 / 2 : (size_t)BATCH * NSA_H * SEQ * 128);
  p.xg = (act_t*)p.pcmp;
  p.ocmp = c.take<float>((size_t)N_TOK * 1024);
  p.impb = c.take<float>((size_t)BATCH * NSA_G * SEQ * N_BLK);
  p.selb = c.take<int>((size_t)BATCH * NSA_G * SEQ * N_BLK);
  p.merged = c.take<act_t>((size_t)N_TOK * D);
  p.tmp = c.take<float>((size_t)N_TOK * D);
  p.xq = c.take<act_t>((size_t)N_TOK * D);
  p.memk = c.take<act_t>((size_t)BATCH * MEM_LEN * D);
  p.memv = c.take<act_t>((size_t)BATCH * MEM_LEN * D);
  p.xs = c.take<float>((size_t)N_TOK * XH * MEM_LEN);
  p.mrg = p.xs;
  p.xo = c.take<act_t>((size_t)N_TOK * D);
  p.rl = c.take<float>((size_t)N_TOK * NE);
  p.topi = c.take<int>((size_t)N_TOK * TOPK);
  p.topg = c.take<float>((size_t)N_TOK * TOPK);
  p.actg = c.take<act_t>((size_t)MOE_ROWS * 1024);
  p.act = p.actg;
  p.wt_in = c.take<act_t>((size_t)2 * N_IN_PAD * 1024);
  p.wt_c1 = c.take<act_t>((size_t)2 * 2 * 256 * 2048);
  p.wt_bra = c.take<act_t>((size_t)2 * 1024 * YLD);
  p.wt_brb = p.wt_bra + 256;
  p.wt_brc = p.wt_bra + 1280;
  p.wt_omix = c.take<act_t>((size_t)2 * 1024 * 1024);
  p.wt_xq = c.take<act_t>((size_t)2 * 1024 * 1024);
  p.wt_xk = c.take<act_t>((size_t)2 * 1024 * 1024);
  p.wt_xv = c.take<act_t>((size_t)2 * 1024 * 1024);
  p.wt_xo = c.take<act_t>((size_t)2 * 1024 * 1024);
  p.wt_gu = c.take<act_t>((size_t)2 * 32 * 2048 * 1024);
  p.wt_dn = c.take<act_t>((size_t)2 * 32 * 1024 * 1024);
  p.membf = c.take<act_t>((size_t)BATCH * MEM_LEN * 1024);
  p.cmpA = c.take<act_t>((size_t)2 * CMP_ROWS_PAD * 2048);
  p.cnt = c.take<int>(64);
  p.rank = c.take<int>((size_t)N_TOK * 4);
  p.rowlist = c.take<int>((size_t)MOE_ROWS);
  p.kcb = c.take<act_t>((size_t)2 * BATCH * 128 * NSA_G * 64);
  p.dilo = c.take<act_t>((size_t)3 * N_TOK * 256);
  p.dill = c.take<float>((size_t)3 * N_TOK * 4);
  p.selm = c.take<unsigned>((size_t)BATCH * NSA_G * SEQ);
  p.gU = p.xg; p.gQ = p.xg + (size_t)1024 * 128 * 256; p.gS = p.actg; p.gD = p.opart + (size_t)N_TOK * 1024;
  p.ws_used = c.off;
}

#ifndef CPU_TEST
#ifndef NSA_PROBE
#define NSA_PROBE 0
#endif
#ifndef GSEG
#define GSEG -1
#endif
static_assert(D == 1024 && BATCH == 8, "optimized path is written for the graded shapes");
namespace pg8 {
#define PG8_LAS __attribute__((address_space(3)))
typedef unsigned short bf16_t;
typedef short bf16x8 __attribute__((ext_vector_type(8)));
typedef float f32x4 __attribute__((ext_vector_type(4)));
typedef unsigned u32x4 __attribute__((ext_vector_type(4)));
constexpr int BM = 256, BK = 64, HALF = 128, HTB = HALF * BK * 2  , STAGE_BYTES = 8 * HTB, NXCD = 8, WGM = 8;

__host__ __device__ __forceinline__ int lds_byte(int r, int c) { const int st = (r >> 4) * 2 + (c >> 5), rr = r & 15, cc = c & 31, ob = rr * 64 + cc * 2; return st * 1024 + (ob ^ (((ob >> 9) & 1) << 5)); }
__host__ __device__ __forceinline__ void stage_rc(int b, int& R, int& C) { const int st = b / 1024, sb = b % 1024, swz = sb ^ (((sb >> 9) & 1) << 5); R = (st >> 1) * 16 + swz / 64; C = (st & 1) * 32 + (swz % 64) / 2; }
__host__ __device__ __forceinline__ int perm32(int rho) { const int n = rho >> 4, i = rho & 15; return 8 * (i >> 2) + 4 * n + (i & 3); }

struct Unit { int pm, pn; };
struct Gemm { const bf16_t* A; const bf16_t* Bt; int M, N, K; };

struct StaticOrder {
    int nM, nN, nwg, G, c;
    __host__ __device__ void init(int M, int N, int G_, int c_) { nM = M / BM; nN = N / BM; nwg = nM * nN; G = G_; c = c_; }
    __host__ __device__ bool next(int i, Unit& u) const {
        const long L = (long)i * G + c; if (L >= nwg) return false;
        int wgid = (int)L; { const int q = nwg / NXCD, r = nwg % NXCD, xcd = wgid % NXCD, off = wgid / NXCD; wgid = (xcd < r ? xcd * (q + 1) : r * (q + 1) + (xcd - r) * q) + off; }
        const int nig = WGM * nN, gid = wgid / nig, fm = gid * WGM, gsz = (nM - fm) < WGM ? (nM - fm) : WGM;
        u.pm = fm + ((wgid % nig) % gsz); u.pn = (wgid % nig) / gsz; return true;
    }
    __device__ __forceinline__ void a_ready(const Unit&) const {}
    __device__ __forceinline__ void done(const Unit&) const {}
};

__device__ __forceinline__ unsigned cvt_pk_bf16(float lo, float hi) { unsigned r; asm volatile("v_cvt_pk_bf16_f32 %0, %1, %2" : "=v"(r) : "v"(lo), "v"(hi)); return r; }

template <class Epi, class Sched, bool ALIGN_EPI = false, bool SP2 = false>
__device__ __forceinline__ void gemm_phase(PG8_LAS unsigned char* lds, const Gemm g, const Sched& S, const Epi& E, const int tid) {
    const int wid = __builtin_amdgcn_readfirstlane(tid >> 6), lane = tid & 63, wr = wid >> 2, wc = wid & 3, fr = lane & 15, fq = lane >> 4;
    const int K = g.K, nt = K / BK;
    unsigned voffA[2], voffB[2];
#pragma unroll
    for (int i = 0; i < 2; ++i) { int R, C; stage_rc(tid * 16 + i * 8192, R, C); const int Rb = Epi::PERM ? ((R & ~31) + perm32(R & 31)) : R;
        voffA[i] = (unsigned)(R * K + C) * 2u; voffB[i] = (unsigned)(Rb * K + C) * 2u; }
    const size_t kstep = (size_t)(BK * 2);
    const size_t hstep = (size_t)HALF * K * 2;
    const size_t tstep = 2 * hstep;
    const unsigned ldsw = (unsigned)wid * 1024u;
    const int aoff = lds_byte(wr * 64 + fr, fq * 8), boff = lds_byte(wc * 32 + fr, fq * 8);
#define PG8_SA(b, h) (((b) * 2 + (h)) * HTB)
#define PG8_SB(b, h) ((4 + (b) * 2 + (h)) * HTB)
#define PG8_STAGE(bufoff, gbase, voff) do { _Pragma("unroll") for (int _i = 0; _i < 2; ++_i) \
        __builtin_amdgcn_global_load_lds((const unsigned*)((const char*)(gbase) + (voff)[_i]), (PG8_LAS unsigned*)(lds + (bufoff) + ldsw + _i * 8192), 16, 0, 0); } while (0)
#define PG8_LDA(dst, b, h) do { _Pragma("unroll") for (int m = 0; m < 4; ++m) _Pragma("unroll") for (int k = 0; k < 2; ++k) dst[m][k] = *(const PG8_LAS bf16x8*)(lds + PG8_SA(b, h) + aoff + m * 2048 + k * 1024); } while (0)
#define PG8_LDB(dst, b, h) do { _Pragma("unroll") for (int n = 0; n < 2; ++n) _Pragma("unroll") for (int k = 0; k < 2; ++k) dst[n][k] = *(const PG8_LAS bf16x8*)(lds + PG8_SB(b, h) + boff + n * 2048 + k * 1024); } while (0)
#define PG8_MMA(ai, bj, At, Bt) do { __builtin_amdgcn_s_setprio(1); _Pragma("unroll") for (int m = 0; m < 4; ++m) _Pragma("unroll") for (int n = 0; n < 2; ++n) _Pragma("unroll") for (int k = 0; k < 2; ++k) \
        acc[ai][bj][m][n] = __builtin_amdgcn_mfma_f32_16x16x32_bf16(Bt[n][k], At[m][k], acc[ai][bj][m][n], 0, 0, 0); __builtin_amdgcn_s_setprio(0); } while (0)
#define PG8_WAIT_V(n) asm volatile("s_waitcnt vmcnt(" #n ")" ::: "memory")
#define PG8_WAIT_L(n) asm volatile("s_waitcnt lgkmcnt(" #n ")" ::: "memory")
#define PG8_BAR __builtin_amdgcn_s_barrier()
#define PG8_SCHED __builtin_amdgcn_sched_barrier(0)
    Unit cur, nxt; int ui = 0;
    if (!S.next(0, cur)) return;
    f32x4 acc[2][2][4][2];
#pragma unroll
    for (int a = 0; a < 2; ++a)
#pragma unroll
        for (int b = 0; b < 2; ++b)
#pragma unroll
            for (int m = 0; m < 4; ++m)
#pragma unroll
                for (int n = 0; n < 2; ++n) acc[a][b][m][n] = (f32x4){0.f, 0.f, 0.f, 0.f};
    bf16x8 At[4][2], B0[2][2], B1[2][2];
    const char* cA = (const char*)g.A + (size_t)cur.pm * tstep; const char* cB = (const char*)g.Bt + (size_t)cur.pn * tstep;
    S.a_ready(cur);
    if constexpr (SP2) {
        PG8_STAGE(PG8_SB(0, 0), cB, voffB); PG8_STAGE(PG8_SB(0, 1), cB + hstep, voffB); PG8_STAGE(PG8_SA(0, 0), cA, voffA); PG8_STAGE(PG8_SA(0, 1), cA + hstep, voffA);
        if (wr == 1) PG8_BAR;
        PG8_WAIT_V(2); PG8_BAR;
        PG8_STAGE(PG8_SB(1, 0), cB + kstep, voffB); PG8_STAGE(PG8_SA(1, 0), cA + kstep, voffA); PG8_STAGE(PG8_SB(1, 1), cB + hstep + kstep, voffB);
        PG8_WAIT_V(6); PG8_BAR;
    } else {
        PG8_STAGE(PG8_SB(0, 0), cB, voffB); PG8_STAGE(PG8_SA(0, 0), cA, voffA); PG8_STAGE(PG8_SB(0, 1), cB + hstep, voffB); PG8_STAGE(PG8_SA(0, 1), cA + hstep, voffA);
        if (wr == 1) PG8_BAR;
        PG8_WAIT_V(4); PG8_BAR;
        PG8_STAGE(PG8_SB(1, 0), cB + kstep, voffB); PG8_STAGE(PG8_SA(1, 0), cA + kstep, voffA); PG8_STAGE(PG8_SB(1, 1), cB + hstep + kstep, voffB);
        PG8_WAIT_V(6); PG8_BAR;
    }
    for (;;) {
        const bool has_next = S.next(ui + 1, nxt);
        const char* nA = has_next ? (const char*)g.A + (size_t)nxt.pm * tstep : cA; const char* nB = has_next ? (const char*)g.Bt + (size_t)nxt.pn * tstep : cB;
        for (int t = 0; t < nt; t += 2) {
            const bool last = (t == nt - 2);
            const char* a1 = cA + (size_t)(t + 1) * kstep;
            const char* a2 = last ? nA : cA + (size_t)(t + 2) * kstep; const char* b2 = last ? nB : cB + (size_t)(t + 2) * kstep;
            const char* a3 = a2 + kstep; const char* b3 = b2 + kstep;
            if (last && has_next) S.a_ready(nxt);
            asm volatile("" : "+v"(voffA[0]), "+v"(voffA[1]), "+v"(voffB[0]), "+v"(voffB[1]));
            E.mid(acc, cur, wr, wc, t);
            if constexpr (SP2) {
            PG8_LDB(B0, 0, 0); PG8_LDB(B1, 0, 1); PG8_SCHED; PG8_LDA(At, 0, 0); PG8_STAGE(PG8_SA(1, 1), a1 + hstep, voffA);
            PG8_WAIT_V(8); PG8_WAIT_L(0); PG8_BAR; PG8_MMA(0, 0, At, B0); PG8_MMA(0, 1, At, B1); PG8_BAR; PG8_SCHED;
            PG8_LDA(At, 0, 1); PG8_STAGE(PG8_SB(0, 0), b2, voffB); PG8_STAGE(PG8_SB(0, 1), b2 + hstep, voffB); PG8_STAGE(PG8_SA(0, 0), a2, voffA);
            PG8_WAIT_V(8); PG8_WAIT_L(0); PG8_BAR; PG8_MMA(1, 0, At, B0); PG8_MMA(1, 1, At, B1); PG8_BAR; PG8_SCHED;
            PG8_LDB(B0, 1, 0); PG8_LDB(B1, 1, 1); PG8_SCHED; PG8_LDA(At, 1, 0); PG8_STAGE(PG8_SA(0, 1), a2 + hstep, voffA);
            PG8_WAIT_V(8); PG8_WAIT_L(0); PG8_BAR; PG8_MMA(0, 0, At, B0); PG8_MMA(0, 1, At, B1); PG8_BAR; PG8_SCHED;
            PG8_LDA(At, 1, 1); PG8_STAGE(PG8_SB(1, 0), b3, voffB); PG8_STAGE(PG8_SB(1, 1), b3 + hstep, voffB); PG8_STAGE(PG8_SA(1, 0), a3, voffA);
            PG8_WAIT_V(8); PG8_WAIT_L(0); PG8_BAR; PG8_MMA(1, 0, At, B0); PG8_MMA(1, 1, At, B1); PG8_BAR; PG8_SCHED;
            } else {
            PG8_LDB(B0, 0, 0); PG8_SCHED; PG8_LDA(At, 0, 0); PG8_STAGE(PG8_SA(1, 1), a1 + hstep, voffA);
            PG8_WAIT_L(8); PG8_BAR; PG8_WAIT_L(0); PG8_MMA(0, 0, At, B0); PG8_BAR; PG8_SCHED;
            PG8_LDB(B1, 0, 1); PG8_STAGE(PG8_SB(0, 0), b2, voffB);
            PG8_BAR; PG8_WAIT_L(0); PG8_MMA(0, 1, At, B1); PG8_BAR;
            PG8_LDA(At, 0, 1); PG8_STAGE(PG8_SA(0, 0), a2, voffA);
            PG8_BAR; PG8_WAIT_L(0); PG8_MMA(1, 0, At, B0); PG8_BAR; PG8_SCHED;
            PG8_STAGE(PG8_SB(0, 1), b2 + hstep, voffB);
            PG8_WAIT_V(6); PG8_BAR; PG8_MMA(1, 1, At, B1); PG8_BAR;
            PG8_LDB(B0, 1, 0); PG8_SCHED; PG8_LDA(At, 1, 0); PG8_STAGE(PG8_SA(0, 1), a2 + hstep, voffA);
            PG8_WAIT_L(8); PG8_BAR; PG8_WAIT_L(0); PG8_MMA(0, 0, At, B0); PG8_BAR; PG8_SCHED;
            PG8_LDB(B1, 1, 1); PG8_STAGE(PG8_SB(1, 0), b3, voffB);
            PG8_BAR; PG8_WAIT_L(0); PG8_MMA(0, 1, At, B1); PG8_BAR;
            PG8_LDA(At, 1, 1); PG8_STAGE(PG8_SA(1, 0), a3, voffA);
            PG8_BAR; PG8_WAIT_L(0); PG8_MMA(1, 0, At, B0); PG8_BAR; PG8_SCHED;
            PG8_STAGE(PG8_SB(1, 1), b3 + hstep, voffB);
            PG8_WAIT_V(6); PG8_BAR; PG8_MMA(1, 1, At, B1); PG8_BAR;
            }
        }
        if constexpr (ALIGN_EPI) { if (wr == 0) PG8_BAR; }
        if constexpr (!Epi::AFTER_DRAIN) { E(acc, cur, wr, wc, fr, fq); S.done(cur); }
        if (!has_next) break;
#pragma unroll
        for (int a = 0; a < 2; ++a)
#pragma unroll
            for (int b = 0; b < 2; ++b)
#pragma unroll
                for (int m = 0; m < 4; ++m)
#pragma unroll
                    for (int n = 0; n < 2; ++n) acc[a][b][m][n] = (f32x4){0.f, 0.f, 0.f, 0.f};
        cur = nxt; cA = nA; cB = nB; ++ui;
        if constexpr (ALIGN_EPI) { if (wr == 1) PG8_BAR; }
    }
    PG8_WAIT_V(0);
    if constexpr (!ALIGN_EPI) { if (wr == 0) PG8_BAR; }
    PG8_BAR;
    if constexpr (Epi::AFTER_DRAIN) { E.fused(acc, cur, wr, wc, fr, fq, lds, wid, lane); S.done(cur); }
#undef PG8_SA
#undef PG8_SB
#undef PG8_STAGE
#undef PG8_LDA
#undef PG8_LDB
#undef PG8_MMA
#undef PG8_WAIT_V
#undef PG8_WAIT_L
#undef PG8_BAR
#undef PG8_SCHED
}
}

typedef pg8::f32x4 f32x4;
typedef pg8::bf16x8 bf16x8;
typedef unsigned u32x2 __attribute__((ext_vector_type(2)));
typedef unsigned u32x4 __attribute__((ext_vector_type(4)));
#define LAS __attribute__((address_space(3)))

constexpr int NTHREADS = 512;
constexpr int RING_BYTES = 131072;
constexpr int MISC_OFF = RING_BYTES;
constexpr int LDS_BYTES = 147456;

typedef __bf16 bf16x2_t __attribute__((ext_vector_type(2)));
typedef float f32x2_t __attribute__((ext_vector_type(2)));
DEV unsigned pk2(float lo, float hi) {
  const f32x2_t v = {lo, hi};
  return __builtin_bit_cast(unsigned, __builtin_convertvector(v, bf16x2_t));
}
DEV unsigned short f2bfh(float x) { return (unsigned short)(pk2(x, 0.f) & 0xffffu); }
DEV float fsig(float x) { return __builtin_amdgcn_rcpf(1.0f + __builtin_amdgcn_exp2f(-1.4426950408889634f * x)); }
DEV float shx(float v, int lane, int o) { return __int_as_float(__builtin_amdgcn_ds_bpermute((lane ^ o) << 2, __float_as_int(v))); }
DEV int shxi(int v, int lane, int o) { return __builtin_amdgcn_ds_bpermute((lane ^ o) << 2, v); }
DEV float wave_sum(float v, int lane) {
#pragma unroll
  for (int o = 1; o < 64; o <<= 1)
    v += __int_as_float(__builtin_amdgcn_ds_bpermute((lane ^ o) << 2, __float_as_int(v)));
  return v;
}

DEV void transpose_item(const float* W, int ldw, int dld, act_t* WT, int k0, int n0, int drow0, LAS float* scr, int lane) {
  float wv[32];
#pragma unroll
  for (int i = 0; i < 32; ++i) wv[i] = W[(size_t)(k0 + 2 * i + (lane >> 5)) * ldw + n0 + (lane & 31)];
#pragma unroll
  for (int i = 0; i < 32; ++i) scr[(2 * i + (lane >> 5)) * 33 + (lane & 31)] = wv[i];
  asm volatile("s_waitcnt lgkmcnt(0)" ::: "memory");
  const int c = lane & 7;
#pragma unroll
  for (int j = 0; j < 4; ++j) {
    const int n = (lane >> 3) + 8 * j;
    const LAS float* s = scr + (8 * c) * 33 + n;
    u32x4 o;
    o.x = pk2(s[0 * 33], s[1 * 33]); o.y = pk2(s[2 * 33], s[3 * 33]);
    o.z = pk2(s[4 * 33], s[5 * 33]); o.w = pk2(s[6 * 33], s[7 * 33]);
    *(u32x4*)(WT + (size_t)(drow0 + n) * dld + k0 + 8 * c) = o;
  }
  asm volatile("s_waitcnt lgkmcnt(0)" ::: "memory");
}

struct ConvDesc { const float* W; act_t* dst; int nbatch, K, N, mode; size_t dstb; int dld; };
constexpr int NCONV = 13;
DEV ConvDesc conv_desc(const Params& p, int kind) {
  const size_t SQ = (size_t)1024 * 1024;
  switch (kind) {
    case 0: return ConvDesc{p.w_gu, p.wt_gu, 64, 1024, 2048, 1, (size_t)2048 * 1024, 1024};
    case 1: return ConvDesc{p.w_down, p.wt_dn, 64, 1024, 1024, 0, SQ, 1024};
    case 2: return ConvDesc{p.w_in, p.wt_in, 2, 1024, N_IN, 0, (size_t)N_IN_PAD * 1024, 1024};
    case 3: return ConvDesc{p.cmp_w1_k, p.wt_c1, 2, 2048, 128, 0, (size_t)2 * 256 * 2048, 2048};
    case 4: return ConvDesc{p.cmp_w1_v, p.wt_c1 + (size_t)256 * 2048, 2, 2048, 128, 0, (size_t)2 * 256 * 2048, 2048};
    case 5: return ConvDesc{p.w_br_a, p.wt_bra, 2, 256, 1024, 0, (size_t)1024 * YLD, YLD};
    case 6: return ConvDesc{p.w_br_b, p.wt_brb, 2, 1024, 1024, 0, (size_t)1024 * YLD, YLD};
    case 7: return ConvDesc{p.w_br_c, p.wt_brc, 2, 1024, 1024, 0, (size_t)1024 * YLD, YLD};
    case 8: return ConvDesc{p.w_o_mix, p.wt_omix, 2, 1024, 1024, 0, SQ, 1024};
    case 9: return ConvDesc{p.w_xq, p.wt_xq, 2, 1024, 1024, 0, SQ, 1024};
    case 10: return ConvDesc{p.w_xk, p.wt_xk, 2, 1024, 1024, 0, SQ, 1024};
    case 11: return ConvDesc{p.w_xv, p.wt_xv, 2, 1024, 1024, 0, SQ, 1024};
    default: return ConvDesc{p.w_xo, p.wt_xo, 2, 1024, 1024, 0, SQ, 1024};
  }
}
DEV int conv_items(int kind) {
  switch (kind) {
    case 0: return 64 * 16 * 64;
    case 1: return 64 * 16 * 32;
    case 2: return 2 * 16 * (N_IN / 32);
    case 3: case 4: return 2 * 32 * 4;
    case 5: return 2 * 4 * 32;
    default: return 2 * 16 * 32;
  }
}
DEV void conv_all(const Params& p, int gw, int NGW, LAS float* scr, int lane) {
  int base = 0;
  for (int kind = 0; kind < NCONV; ++kind) {
    const int total = conv_items(kind);
    const ConvDesc d = conv_desc(p, kind);
    const int nblk = d.N / 32, per = nblk * (d.K / 64);
    int first = (gw - base % NGW + NGW) % NGW;
    for (int it = first; it < total; it += NGW) {
      const int bt = it / per, r = it % per, kb = r / nblk, nb = r % nblk;
      const int n0 = nb * 32;
      int drow0 = n0;
      if (d.mode == 1) { const int j = n0 & 1023; drow0 = (j >> 7) * 256 + (j & 127) + ((n0 >= 1024) ? 128 : 0); }
      transpose_item(d.W + (size_t)bt * d.K * d.N, d.N, d.dld, d.dst + (size_t)bt * d.dstb, kb * 64, n0, drow0, scr, lane);
    }
    base += total;
  }
}

template <int MODE, bool SRC_BF16 = false>
DEV void ln_rows_w(const Params& p, const float* src, const float* g, const float* b, float* dstf, act_t* dstb, float* dst2,
                   int gw, int NGW, int lane) {
  for (int n0 = gw; n0 < N_TOK; n0 += 2 * NGW) {
    f32x4 v[2][4];
    float s[2] = {0.f, 0.f};
#pragma unroll
    for (int r = 0; r < 2; ++r) {
      const int n = (n0 + r * NGW < N_TOK) ? n0 + r * NGW : n0;
#pragma unroll
      for (int j = 0; j < 4; ++j) {
        if (MODE == 0) {
          if (SRC_BF16) {
            const u32x2 xw = ((const u32x2*)((const act_t*)src + (size_t)n * D))[lane + 64 * j];
            v[r][j] = (f32x4){__uint_as_float(xw.x << 16), __uint_as_float(xw.x & 0xffff0000u), __uint_as_float(xw.y << 16), __uint_as_float(xw.y & 0xffff0000u)};
          } else v[r][j] = ((const f32x4*)(src + (size_t)n * D))[lane + 64 * j];
        } else {
          f32x4 a = ((const f32x4*)(p.xf + (size_t)n * D))[lane + 64 * j] * ALPHA;
#pragma unroll
          for (int k = 0; k < 4; ++k) {
            const u32x2 yw = ((const u32x2*)((const act_t*)p.yass + ((size_t)n * 4 + k) * D))[lane + 64 * j];
            a.x += __uint_as_float(yw.x << 16); a.y += __uint_as_float(yw.x & 0xffff0000u);
            a.z += __uint_as_float(yw.y << 16); a.w += __uint_as_float(yw.y & 0xffff0000u);
          }
          v[r][j] = a;
        }
        s[r] += (v[r][j].x + v[r][j].y) + (v[r][j].z + v[r][j].w);
      }
    }
    float mean[2], s2[2] = {0.f, 0.f}, rstd[2];
#pragma unroll
    for (int o = 1; o < 64; o <<= 1) { s[0] += shx(s[0], lane, o); s[1] += shx(s[1], lane, o); }
#pragma unroll
    for (int r = 0; r < 2; ++r) {
      mean[r] = s[r] * (1.f / D);
#pragma unroll
      for (int j = 0; j < 4; ++j) { v[r][j] = v[r][j] - mean[r]; s2[r] += (v[r][j].x * v[r][j].x + v[r][j].y * v[r][j].y) + (v[r][j].z * v[r][j].z + v[r][j].w * v[r][j].w); }
    }
#pragma unroll
    for (int o = 1; o < 64; o <<= 1) { s2[0] += shx(s2[0], lane, o); s2[1] += shx(s2[1], lane, o); }
#pragma unroll
    for (int r = 0; r < 2; ++r) {
      rstd[r] = 1.f / sqrtf(s2[r] * (1.f / D) + LN_EPS);
      const int n = n0 + r * NGW;
      if (n < N_TOK) {
#pragma unroll
        for (int j = 0; j < 4; ++j) {
          const f32x4 gm = ((const f32x4*)g)[lane + 64 * j], bt = ((const f32x4*)b)[lane + 64 * j];
          const f32x4 y = v[r][j] * rstd[r] * gm + bt;
          ((f32x4*)(dstf + (size_t)n * D))[lane + 64 * j] = y;
          u32x2 w; w.x = pk2(y.x, y.y); w.y = pk2(y.z, y.w);
          ((u32x2*)(dstb + (size_t)n * D))[lane + 64 * j] = w;
          if (dst2) ((f32x4*)(dst2 + (size_t)n * D))[lane + 64 * j] = y;
        }
      }
    }
  }
}

DEV void prologue(const Params& p, LAS unsigned char* lds, int wave, int lane) {
  LAS float* scr = (LAS float*)(lds + wave * 16384);
  const int gw = blockIdx.x * 8 + wave, NGW = gridDim.x * 8;
  conv_all(p, gw, NGW, scr, lane);
  const long long tid = (long long)blockIdx.x * NTHREADS + threadIdx.x, nthr = (long long)gridDim.x * NTHREADS;
  {
    const long long padw = (long long)(N_IN_PAD - N_IN) * 1024 / 8;
    for (long long i = tid; i < 2 * padw; i += nthr) {
      const int li = (int)(i / padw); const long long r = i % padw;
      ((u32x4*)(p.wt_in + ((size_t)li * N_IN_PAD + N_IN) * 1024))[r] = (u32x4){0u, 0u, 0u, 0u};
    }
    const long long padc = (long long)128 * 2048 / 8;
    for (long long i = tid; i < 4 * padc; i += nthr) {
      const int q = (int)(i / padc); const long long r = i % padc;
      ((u32x4*)(p.wt_c1 + ((size_t)q * 256 + 128) * 2048))[r] = (u32x4){0u, 0u, 0u, 0u};
    }
    if (tid < 64) p.cnt[tid] = 0;
    for (long long i = tid; i < 2LL * BATCH * NSA_G * 64; i += nthr) {
      const long long wb = i / (NSA_G * 64), r = i % (NSA_G * 64);
      p.kcb[(wb * 128 + 127) * NSA_G * 64 + r] = 0;
    }
    for (long long i = tid; i < (long long)BATCH * MEM_LEN * 1024 / 4; i += nthr) {
      const f32x4 v = ((const f32x4*)p.mem)[i];
      u32x2 w; w.x = pk2(v.x, v.y); w.y = pk2(v.z, v.w);
      ((u32x2*)p.membf)[i] = w;
    }
  }
  ln_rows_w<0>(p, p.x, p.ln0_g, p.ln0_b, p.xf, p.xb, nullptr, gw, NGW, lane);
}

struct USched {
  int nM, nN, nwg, G, c;
  int moe, nct, total; const LAS int* tile_e;
  DEV void init_static(int M, int N, int G_, int c_) { nM = M / 256; nN = N / 256; nwg = nM * nN; G = G_; c = c_; moe = 0; nct = 1; total = nwg; tile_e = nullptr; }
  DEV void init_moe(int G_, int c_, int nct_, int total_, const LAS int* te) { nM = 1; nN = 1; nwg = total_; G = G_; c = c_; moe = 1; nct = nct_; total = total_; tile_e = te; }
  DEV bool next(int i, pg8::Unit& u) const {
    const long L = (long)i * G + c;
    if (!(moe && (G & 7) == 0) && L >= total) return false;
    if (moe) {
      if ((G & 7) == 0) {
        const int xcd = c & 7, rank = c >> 3, nr = G >> 3, T = total / nct;
        const int tlo = (T * xcd) >> 3, thi = (T * (xcd + 1)) >> 3;
        const int lu = i * nr + rank;
        if (lu >= (thi - tlo) * nct) return false;
        const int rt = tlo + lu / nct, j = lu % nct;
        u.pm = rt; u.pn = tile_e[rt] * nct + j; return true;
      }
      const int rt = (int)(L / nct), j = (int)(L % nct); u.pm = rt; u.pn = tile_e[rt] * nct + j; return true;
    }
    int wgid = (int)L; { const int q = nwg / 8, r = nwg % 8, xcd = wgid % 8, off = wgid / 8; wgid = (xcd < r ? xcd * (q + 1) : r * (q + 1) + (xcd - r) * q) + off; }
    const int nig = 8 * nN, gid = wgid / nig, fm = gid * 8, gsz = (nM - fm) < 8 ? (nM - fm) : 8;
    u.pm = fm + ((wgid % nig) % gsz); u.pn = (wgid % nig) / gsz; return true;
  }
  DEV void a_ready(const pg8::Unit&) const {}
  DEV void done(const pg8::Unit&) const {}
};

enum { EM_INPROJ = 0, EM_BRCAT, EM_RES, EM_BF16, EM_MOE1, EM_MOE2, EM_HID };
#define EPI_FENCE() asm volatile("" ::: "memory")
struct EpiU {
  static constexpr bool PERM = false, AFTER_DRAIN = false;
  int mode, ldc;
  void* q0;
  const void* q1;
  const void* q2;
  const void* q3;
  const LAS int* te;
  DEV void mid(f32x4 (&acc)[2][2][4][2], const pg8::Unit& un, int wr, int wc, int t) const {
    if (mode != EM_BRCAT || (t != 4 && t != 20)) return;
    const act_t* ub = (const act_t*)q1;
    int l2;
    asm volatile("v_mbcnt_lo_u32_b32 %0, -1, 0\n\tv_mbcnt_hi_u32_b32 %0, -1, %0" : "=v"(l2));
    const int fr = l2 & 15, fq = l2 >> 4;
    const int row0 = un.pm * 256 + wr * 64 + fr, col0 = un.pn * 256 + wc * 32 + 4 * fq;
    const int goff = OFF_MG + (t == 4 ? 0 : D);
    const float L2E = -1.4426950408889634f;
#pragma unroll
    for (int ai = 0; ai < 2; ++ai)
#pragma unroll
      for (int m = 0; m < 4; ++m) {
        const int row = row0 + ai * 128 + m * 16;
#pragma unroll
        for (int bj = 0; bj < 2; ++bj)
#pragma unroll
          for (int n = 0; n < 2; ++n) {
            const int col = col0 + bj * 128 + n * 16;
            const act_t* gp = ub + (size_t)row * N_IN + goff + col;
            const u32x2 ga = *(const u32x2*)gp, gb = *(const u32x2*)(gp + D);
            const float ea0 = __builtin_amdgcn_exp2f(__uint_as_float(ga.x << 16) * L2E), ea1 = __builtin_amdgcn_exp2f(__uint_as_float(ga.x & 0xffff0000u) * L2E);
            const float ea2 = __builtin_amdgcn_exp2f(__uint_as_float(ga.y << 16) * L2E), ea3 = __builtin_amdgcn_exp2f(__uint_as_float(ga.y & 0xffff0000u) * L2E);
            const float eb0 = __builtin_amdgcn_exp2f(__uint_as_float(gb.x << 16) * L2E), eb1 = __builtin_amdgcn_exp2f(__uint_as_float(gb.x & 0xffff0000u) * L2E);
            const float eb2 = __builtin_amdgcn_exp2f(__uint_as_float(gb.y << 16) * L2E), eb3 = __builtin_amdgcn_exp2f(__uint_as_float(gb.y & 0xffff0000u) * L2E);
            f32x4& v = acc[ai][bj][m][n];
            v.x *= (1.0f + eb0) * __builtin_amdgcn_rcpf(1.0f + ea0); v.y *= (1.0f + eb1) * __builtin_amdgcn_rcpf(1.0f + ea1);
            v.z *= (1.0f + eb2) * __builtin_amdgcn_rcpf(1.0f + ea2); v.w *= (1.0f + eb3) * __builtin_amdgcn_rcpf(1.0f + ea3);
          }
        if (m == 3) EPI_FENCE();
      }
  }
  DEV void operator()(const f32x4 (&acc)[2][2][4][2], const pg8::Unit& un, int wr, int wc, int fr, int fq) const {
    {
      int l2;
      asm volatile("v_mbcnt_lo_u32_b32 %0, -1, 0\n\tv_mbcnt_hi_u32_b32 %0, -1, %0" : "=v"(l2));
      fr = l2 & 15; fq = l2 >> 4;
    }
    const int row0 = un.pm * 256 + wr * 64 + fr;
    act_t* const ob = (act_t*)q0; float* const of = (float*)q0;
    const float* const f0 = (const float*)q1; const act_t* const ub = (const act_t*)q1;
    const float* const f1 = (const float*)q2; const int* const il = (const int*)q3;
    if (mode == EM_INPROJ) {
      const int col0 = un.pn * 256 + wc * 32 + 4 * fq;
      f32x4 bv[2][2];
#pragma unroll
      for (int bj = 0; bj < 2; ++bj)
#pragma unroll
        for (int n = 0; n < 2; ++n) { const int col = col0 + bj * 128 + n * 16; bv[bj][n] = col < N_IN ? *(const f32x4*)(f0 + col) : (f32x4){0.f, 0.f, 0.f, 0.f}; }
#pragma unroll
      for (int ai = 0; ai < 2; ++ai)
#pragma unroll
        for (int m = 0; m < 4; ++m) {
          const int row = row0 + ai * 128 + m * 16;
#pragma unroll
          for (int bj = 0; bj < 2; ++bj)
#pragma unroll
            for (int n = 0; n < 2; ++n) {
              const int col = col0 + bj * 128 + n * 16;
              if (col < N_IN) {
                const f32x4 v = acc[ai][bj][m][n] + bv[bj][n];
                u32x2 w; w.x = pk2(v.x, v.y); w.y = pk2(v.z, v.w);
                *(u32x2*)(ob + (size_t)row * N_IN + col) = w;
              }
            }
        }
    } else if (mode == EM_BRCAT) {
      const int col0 = un.pn * 256 + wc * 32 + 4 * fq;
#pragma unroll
      for (int ai = 0; ai < 2; ++ai)
#pragma unroll
        for (int m = 0; m < 4; ++m) {
          const int row = row0 + ai * 128 + m * 16;
#pragma unroll
          for (int bj = 0; bj < 2; ++bj)
#pragma unroll
            for (int n = 0; n < 2; ++n) {
              const int col = col0 + bj * 128 + n * 16;
              const u32x2 gw = *(const u32x2*)(ub + (size_t)row * N_IN + OFF_MG + 2 * D + col);
              f32x4 v = acc[ai][bj][m][n];
              v.x *= fsig(__uint_as_float(gw.x << 16)); v.y *= fsig(__uint_as_float(gw.x & 0xffff0000u));
              v.z *= fsig(__uint_as_float(gw.y << 16)); v.w *= fsig(__uint_as_float(gw.y & 0xffff0000u));
              u32x2 w; w.x = pk2(v.x, v.y); w.y = pk2(v.z, v.w);
              *(u32x2*)(ob + (size_t)row * D + col) = w;
            }
          if (m == 3) EPI_FENCE();
        }
    } else if (mode == EM_RES) {
      const int col0 = un.pn * 256 + wc * 32 + 4 * fq;
#pragma unroll
      for (int ai = 0; ai < 2; ++ai)
#pragma unroll
        for (int m = 0; m < 4; ++m) {
          const int row = row0 + ai * 128 + m * 16;
#pragma unroll
          for (int bj = 0; bj < 2; ++bj)
#pragma unroll
            for (int n = 0; n < 2; ++n) {
              const int col = col0 + bj * 128 + n * 16;
              const f32x4 x = *(const f32x4*)(f0 + (size_t)row * D + col);
              *(f32x4*)(of + (size_t)row * D + col) = x * ALPHA + acc[ai][bj][m][n];
            }
          if (m == 3) EPI_FENCE();
        }
    } else if (mode == EM_BF16) {
      const int col0 = un.pn * 256 + wc * 32 + 4 * fq;
#pragma unroll
      for (int ai = 0; ai < 2; ++ai)
#pragma unroll
        for (int m = 0; m < 4; ++m) {
          const int row = row0 + ai * 128 + m * 16;
#pragma unroll
          for (int bj = 0; bj < 2; ++bj)
#pragma unroll
            for (int n = 0; n < 2; ++n) {
              const int col = col0 + bj * 128 + n * 16;
              const f32x4 v = acc[ai][bj][m][n];
              u32x2 w; w.x = pk2(v.x, v.y); w.y = pk2(v.z, v.w);
              *(u32x2*)(ob + (size_t)row * ldc + col) = w;
            }
          EPI_FENCE();
        }
    } else if (mode == EM_MOE1) {
      const int e = te[un.pm], j = un.pn & 7;
      f32x4 bg[2], bu[2];
#pragma unroll
      for (int n = 0; n < 2; ++n) {
        const int cj = j * 128 + wc * 32 + n * 16 + 4 * fq;
        bg[n] = *(const f32x4*)(f0 + (size_t)e * 2048 + cj); bu[n] = *(const f32x4*)(f0 + (size_t)e * 2048 + 1024 + cj);
      }
#pragma unroll
      for (int ai = 0; ai < 2; ++ai)
#pragma unroll
        for (int m = 0; m < 4; ++m) {
          const int row = row0 + ai * 128 + m * 16;
#pragma unroll
          for (int n = 0; n < 2; ++n) {
            const int cj = j * 128 + wc * 32 + n * 16 + 4 * fq;
            const f32x4 g = acc[ai][0][m][n] + bg[n], u = acc[ai][1][m][n] + bu[n];
            float o[4];
#pragma unroll
            for (int i = 0; i < 4; ++i) {
              const float gt = fminf(g[i], 7.0f), up = fminf(fmaxf(u[i], -7.0f), 7.0f);
              o[i] = (up + 1.0f) * gt * __builtin_amdgcn_rcpf(1.0f + __builtin_amdgcn_exp2f(-1.702f * 1.4426950408889634f * gt));
            }
            u32x2 w; w.x = pk2(o[0], o[1]); w.y = pk2(o[2], o[3]);
            *(u32x2*)(ob + (size_t)row * 1024 + cj) = w;
          }
        }
    } else if (mode == EM_MOE2) {
      const int e = te[un.pm], j = un.pn & 3;
      const int col0 = j * 256 + wc * 32 + 4 * fq;
      int aidv[8]; float gtv[8]; f32x4 bv[2][2];
#pragma unroll
      for (int bj = 0; bj < 2; ++bj)
#pragma unroll
        for (int n = 0; n < 2; ++n) bv[bj][n] = *(const f32x4*)(f0 + (size_t)e * 1024 + col0 + bj * 128 + n * 16);
#pragma unroll
      for (int r = 0; r < 8; ++r) aidv[r] = il[row0 + (r >> 2) * 128 + (r & 3) * 16];
#pragma unroll
      for (int r = 0; r < 8; ++r) gtv[r] = f1[aidv[r] >= 0 ? aidv[r] : 0];
#pragma unroll
      for (int r = 0; r < 8; ++r) {
        const int ai = r >> 2, m = r & 3;
        if (aidv[r] >= 0) {
#pragma unroll
          for (int bj = 0; bj < 2; ++bj)
#pragma unroll
            for (int n = 0; n < 2; ++n) {
              const int col = col0 + bj * 128 + n * 16;
              const f32x4 v = (acc[ai][bj][m][n] + bv[bj][n]) * gtv[r];
              u32x2 w; w.x = pk2(v.x, v.y); w.y = pk2(v.z, v.w);
              *(u32x2*)(ob + (size_t)aidv[r] * 1024 + col) = w;
            }
        }
      }
    } else if (mode == EM_HID) {
      const int col0 = wc * 32 + 4 * fq;
#pragma unroll
      for (int ai = 0; ai < 2; ++ai)
#pragma unroll
        for (int m = 0; m < 4; ++m) {
          const int row = row0 + ai * 128 + m * 16;
          if (row < CMP_ROWS) {
#pragma unroll
            for (int n = 0; n < 2; ++n) {
              const f32x4 a = acc[ai][0][m][n];
              f32x4 v; v.x = gelu_tanh(a.x); v.y = gelu_tanh(a.y); v.z = gelu_tanh(a.z); v.w = gelu_tanh(a.w);
              *(f32x4*)(of + (size_t)row * CMP_HID + col0 + n * 16) = v;
            }
          }
          EPI_FENCE();
        }
    }
  }
};

DEV int moe_tables(const Params& p, int li, LAS int* tab, int t32) {
  __syncthreads();
  if (t32 == 0) {
    int t = 0;
    for (int e = 0; e < NE; ++e) {
      const int c = p.cnt[li * 32 + e];
      tab[e] = t * 256; tab[32 + e] = c;
      const int nt = (c + 255) >> 8;
#pragma clang loop vectorize(disable) unroll(disable)
      for (int k = 0; k < nt; ++k) tab[128 + t + k] = e;
      t += nt;
    }
    tab[64] = t;
  }
  __syncthreads();
  return tab[64];
}

DEV void moe_prep(const Params& p, int li, LAS int* tab, int wave, int lane, int t32) {
  const int ntiles = moe_tables(p, li, tab, t32);
  const int gw = blockIdx.x * 8 + wave, NGW = gridDim.x * 8;
  for (int tk0 = gw; tk0 < N_TOK; tk0 += 4 * NGW) {
    u32x4 v0[4], v1[4]; int rowi[4][4];
#pragma unroll
    for (int q = 0; q < 4; ++q) {
      const int tk = (tk0 + q * NGW < N_TOK) ? tk0 + q * NGW : tk0;
      const u32x4* src = (const u32x4*)(p.xb + (size_t)tk * 1024);
      v0[q] = src[lane]; v1[q] = src[lane + 64];
#pragma unroll
      for (int k = 0; k < 4; ++k) rowi[q][k] = tab[p.topi[tk * 4 + k]] + p.rank[tk * 4 + k];
    }
#pragma unroll
    for (int q = 0; q < 4; ++q) {
      const int tk = tk0 + q * NGW;
      if (tk < N_TOK) {
#pragma unroll
        for (int k = 0; k < 4; ++k) {
          if (lane == 0) p.rowlist[rowi[q][k]] = tk * 4 + k;
          u32x4* dst = (u32x4*)(p.xg + (size_t)rowi[q][k] * 1024);
          dst[lane] = v0[q]; dst[lane + 64] = v1[q];
        }
      }
    }
  }
  const long long tid = (long long)blockIdx.x * NTHREADS + t32, nthr = (long long)gridDim.x * NTHREADS;
  for (long long r = tid; r < (long long)ntiles * 256; r += nthr) {
    const int e = tab[128 + (int)(r >> 8)];
    if ((int)r - tab[e] >= tab[32 + e]) p.rowlist[r] = -1;
  }
}

typedef short v4i16_t __attribute__((ext_vector_type(4)));
DEV v4i16_t tr_read(const LAS unsigned char* p) { return __builtin_amdgcn_ds_read_tr16_b64_v4i16((LAS v4i16_t*)p); }

constexpr int AT_ROWB = 144;
constexpr int AT_TILEB = 64 * AT_ROWB;
constexpr int AT_HALF_KV = 4 * AT_TILEB;
constexpr int AT_SLAB_OFF = 2 * AT_HALF_KV;
constexpr int AT_SLAB_WAVE = 32 * 33 * 4;
constexpr int AT_SLAB_HALF = 4 * AT_SLAB_WAVE;
constexpr int AT_XCH_OFF = AT_SLAB_OFF + 2 * AT_SLAB_HALF;
static_assert(AT_XCH_OFF + 16 <= RING_BYTES, "attention LDS map");
constexpr float SC2 = 0.125f * 1.4426950408889634f;

struct AttnState { f32x4 O[2][4]; float m[2], l[2]; };

template <bool PROB, class Job>
DEV void attn_tile(const Job& job, const LAS unsigned char* Kb, const LAS unsigned char* Vb, const bf16x8 (&qf)[2][2], AttnState& st,
                   LAS float* slab, int cur, int wih, int lane) {
  const int i15 = lane & 15, g4 = lane >> 4;
  f32x4 S[2][4];
#pragma unroll
  for (int sub = 0; sub < 2; ++sub)
#pragma unroll
    for (int t = 0; t < 4; ++t) S[sub][t] = (f32x4){0.f, 0.f, 0.f, 0.f};
#pragma unroll
  for (int t = 0; t < 4; ++t)
#pragma unroll
    for (int kk = 0; kk < 2; ++kk) {
      const bf16x8 kf = *(const LAS bf16x8*)(Kb + (16 * t + i15) * AT_ROWB + (kk * 32 + 8 * g4) * 2);
#pragma unroll
      for (int sub = 0; sub < 2; ++sub) S[sub][t] = __builtin_amdgcn_mfma_f32_16x16x32_bf16(kf, qf[sub][kk], S[sub][t], 0, 0, 0);
    }
  bf16x8 pf[2][2];
  const bool efree = job.elemfree(cur, wih);
#pragma unroll
  for (int sub = 0; sub < 2; ++sub) {
    const int row = wih * 32 + sub * 16 + i15;
    if (!efree) {
      const int mbv = job.mb(row, cur, g4);
#pragma unroll
      for (int t = 0; t < 4; ++t)
#pragma unroll
        for (int j = 0; j < 4; ++j) S[sub][t][j] = job.ok(mbv, 16 * t + j) ? S[sub][t][j] : -INFINITY;
    }
    float mx = fmaxf(fmaxf(S[sub][0][0], S[sub][0][1]), fmaxf(S[sub][0][2], S[sub][0][3]));
#pragma unroll
    for (int t = 1; t < 4; ++t) mx = fmaxf(fmaxf(mx, fmaxf(S[sub][t][0], S[sub][t][1])), fmaxf(S[sub][t][2], S[sub][t][3]));
    if (!PROB) {
      mx = fmaxf(mx, shx(mx, lane, 16));
      mx = fmaxf(mx, shx(mx, lane, 32));
      const bool rok = job.rowok(sub, cur);
      const float mcand = rok ? mx * SC2 : -INFINITY;
      const float mnew = fmaxf(st.m[sub], mcand);
      const float msafe = (mnew == -INFINITY) ? 0.f : mnew;
      const float corr = __builtin_amdgcn_exp2f(st.m[sub] - msafe);
      st.m[sub] = mnew;
      const float msub = rok ? msafe : INFINITY;
      float psum = 0.f;
#pragma unroll
      for (int t = 0; t < 4; ++t)
#pragma unroll
        for (int j = 0; j < 4; ++j) { const float pp = __builtin_amdgcn_exp2f(__builtin_fmaf(S[sub][t][j], SC2, -msub)); S[sub][t][j] = pp; psum += pp; }
      st.l[sub] = st.l[sub] * corr + psum;
      if (__builtin_amdgcn_ballot_w64(corr != 1.0f) != 0ull) {
#pragma unroll
        for (int dt = 0; dt < 4; ++dt) st.O[sub][dt] *= corr;
      }
#pragma unroll
      for (int s2 = 0; s2 < 2; ++s2) {
        u32x4 w;
        w.x = pk2(S[sub][2 * s2][0], S[sub][2 * s2][1]); w.y = pk2(S[sub][2 * s2][2], S[sub][2 * s2][3]);
        w.z = pk2(S[sub][2 * s2 + 1][0], S[sub][2 * s2 + 1][1]); w.w = pk2(S[sub][2 * s2 + 1][2], S[sub][2 * s2 + 1][3]);
        pf[sub][s2] = __builtin_bit_cast(bf16x8, w);
      }
    } else {
      const float msafe = (st.m[sub] == -INFINITY) ? 0.f : st.m[sub];
      const int q = sub * 16 + i15;
#pragma unroll
      for (int t = 0; t < 4; ++t) {
        const float p0 = __builtin_amdgcn_exp2f(__builtin_fmaf(S[sub][t][0], SC2, -msafe)) * st.l[sub], p1 = __builtin_amdgcn_exp2f(__builtin_fmaf(S[sub][t][1], SC2, -msafe)) * st.l[sub];
        const float p2 = __builtin_amdgcn_exp2f(__builtin_fmaf(S[sub][t][2], SC2, -msafe)) * st.l[sub], p3 = __builtin_amdgcn_exp2f(__builtin_fmaf(S[sub][t][3], SC2, -msafe)) * st.l[sub];
        const int jb = 16 * cur + 4 * t + g4;
        slab[q * 33 + jb] += (p0 + p1) + (p2 + p3);
        S[sub][t][3] = p3;
      }
      asm volatile("s_waitcnt lgkmcnt(0)" ::: "memory");
#pragma unroll
      for (int t = 0; t < 4; ++t) {
        const int jb = 16 * cur + 4 * t + g4 + 1;
        if (jb < 32) slab[q * 33 + jb] += S[sub][t][3];
      }
      asm volatile("s_waitcnt lgkmcnt(0)" ::: "memory");
    }
  }
  if (!PROB) {
#pragma unroll
    for (int dt = 0; dt < 4; ++dt)
#pragma unroll
      for (int s2 = 0; s2 < 2; ++s2) {
        const LAS unsigned char* vp = Vb + (32 * s2 + 4 * g4 + (i15 >> 2)) * AT_ROWB + (16 * dt + 4 * (lane & 3)) * 2;
        const v4i16_t lo = tr_read(vp), hi = tr_read(vp + 16 * AT_ROWB);
        bf16x8 vf;
        vf[0] = lo[0]; vf[1] = lo[1]; vf[2] = lo[2]; vf[3] = lo[3]; vf[4] = hi[0]; vf[5] = hi[1]; vf[6] = hi[2]; vf[7] = hi[3];
#pragma unroll
        for (int sub = 0; sub < 2; ++sub) st.O[sub][dt] = __builtin_amdgcn_mfma_f32_16x16x32_bf16(vf, pf[sub][s2], st.O[sub][dt], 0, 0, 0);
      }
  }
}

DEV void half_barrier(LAS unsigned* cnt, int lane) {
  asm volatile("s_waitcnt lgkmcnt(0)" ::: "memory");
  unsigned old = 0;
  if (lane == 0) old = __hip_atomic_fetch_add(cnt, 1u, __ATOMIC_RELAXED, __HIP_MEMORY_SCOPE_WORKGROUP);
  old = (unsigned)__builtin_amdgcn_readfirstlane((int)old);
  const unsigned target = (old / 4u + 1u) * 4u;
  while ((int)(__hip_atomic_load(cnt, __ATOMIC_RELAXED, __HIP_MEMORY_SCOPE_WORKGROUP) - target) < 0) __builtin_amdgcn_s_sleep(1);
  asm volatile("" ::: "memory");
}

template <bool PROB, class Job>
DEV void attn_run(const Job& job, LAS unsigned char* lds, AttnState& st, int half, int hth, int wih, int lane) {
  LAS unsigned char* kvh = lds + half * AT_HALF_KV;
  LAS unsigned* hb = (LAS unsigned*)(lds + MISC_OFF + 8192 + 128) + half * 16;
  LAS float* slab = (LAS float*)(lds + AT_SLAB_OFF + half * AT_SLAB_HALF + wih * AT_SLAB_WAVE);
  const int i15 = lane & 15, g4 = lane >> 4;
  unsigned rem = job.tilemask();
  bf16x8 qf[2][2];
#pragma unroll
  for (int sub = 0; sub < 2; ++sub) {
    const act_t* qr = job.qrow(wih * 32 + sub * 16 + i15);
#pragma unroll
    for (int kk = 0; kk < 2; ++kk) qf[sub][kk] = *(const bf16x8*)(qr + kk * 32 + 8 * g4);
  }
  if (!PROB) {
#pragma unroll
    for (int sub = 0; sub < 2; ++sub) {
      st.m[sub] = -INFINITY; st.l[sub] = 0.f;
#pragma unroll
      for (int dt = 0; dt < 4; ++dt) st.O[sub][dt] = (f32x4){0.f, 0.f, 0.f, 0.f};
    }
  }
  const int srow = hth >> 2, sch = hth & 3;
  u32x4 ak0, ak1, av0, av1;
#define AT_LOAD(k0, k1, v0, v1, T) do { const act_t* kr_ = job.krow(T, srow) + sch * 16; k0 = *(const u32x4*)kr_; k1 = *(const u32x4*)(kr_ + 8); \
    if (!PROB) { const act_t* vr_ = job.vrow(T, srow) + sch * 16; v0 = *(const u32x4*)vr_; v1 = *(const u32x4*)(vr_ + 8); } } while (0)
#define AT_WRITE(k0, k1, v0, v1, BUF) do { LAS unsigned char* kd_ = kvh + (BUF) * AT_TILEB + srow * AT_ROWB + sch * 32; *(LAS u32x4*)kd_ = k0; *(LAS u32x4*)(kd_ + 16) = k1; \
    if (!PROB) { LAS unsigned char* vd_ = kvh + (2 + (BUF)) * AT_TILEB + srow * AT_ROWB + sch * 32; *(LAS u32x4*)vd_ = v0; *(LAS u32x4*)(vd_ + 16) = v1; } } while (0)
#define AT_NEXT(T) do { T = -1; if (rem) { T = __builtin_ctz(rem); rem &= rem - 1; } } while (0)
  int t0;
  AT_NEXT(t0);
  if (t0 >= 0) { AT_LOAD(ak0, ak1, av0, av1, t0); AT_WRITE(ak0, ak1, av0, av1, 0); }
  half_barrier(hb, lane);
  for (int it = 0; t0 >= 0; ++it) {
    int t1;
    AT_NEXT(t1);
    if (t1 >= 0) AT_LOAD(ak0, ak1, av0, av1, t1);
    attn_tile<PROB>(job, kvh + (it & 1) * AT_TILEB, kvh + (2 + (it & 1)) * AT_TILEB, qf, st, slab, t0, wih, lane);
    if (t1 >= 0) AT_WRITE(ak0, ak1, av0, av1, (it + 1) & 1);
    half_barrier(hb, lane);
    t0 = t1;
  }
#undef AT_LOAD
#undef AT_WRITE
#undef AT_NEXT
  if (!PROB) {
#pragma unroll
    for (int sub = 0; sub < 2; ++sub) {
      float l = st.l[sub];
      l += shx(l, lane, 16);
      l += shx(l, lane, 32);
      const float inv = 1.0f / fmaxf(l, 1e-30f);
      st.l[sub] = l;
#pragma unroll
      for (int dt = 0; dt < 4; ++dt) st.O[sub][dt] *= inv;
    }
  }
}

struct SelJob {
  const act_t* u; int b, g, t0; unsigned um; unsigned tm[2];
  DEV unsigned tilemask() const { return um; }
  DEV const act_t* qrow(int r) const { return u + ((size_t)b * SEQ + t0 + (r & 31)) * N_IN + OFF_CQ + (g * 4 + (r >> 5)) * 64; }
  DEV const act_t* krow(int kt, int j) const { return u + ((size_t)b * SEQ + kt * 64 + j) * N_IN + OFF_CKS + g * 64; }
  DEV const act_t* vrow(int kt, int j) const { return u + ((size_t)b * SEQ + kt * 64 + j) * N_IN + OFF_CVS + g * 64; }
  DEV int mb(int r, int kt, int g4) const { return t0 + (r & 31) - kt * 64 - 4 * g4; }
  DEV bool rowok(int sub, int kt) const { return (tm[sub] >> kt) & 1u; }
  DEV bool ok(int m, int C) const { return m >= C; }
  DEV bool elemfree(int kt, int wih) const { return kt < (t0 >> 6); }
};
struct WinJob {
  const act_t* u; int b, g, t0; unsigned um;
  DEV unsigned tilemask() const { return um; }
  DEV const act_t* qrow(int r) const { return u + ((size_t)b * SEQ + t0 + (r & 31)) * N_IN + OFF_CQ + (g * 4 + (r >> 5)) * 64; }
  DEV const act_t* krow(int kt, int j) const { return u + ((size_t)b * SEQ + kt * 64 + j) * N_IN + OFF_CKW + g * 64; }
  DEV const act_t* vrow(int kt, int j) const { return u + ((size_t)b * SEQ + kt * 64 + j) * N_IN + OFF_CVW + g * 64; }
  DEV int mb(int r, int kt, int g4) const { return t0 + (r & 31) - kt * 64 - 4 * g4; }
  DEV bool rowok(int sub, int kt) const { return true; }
  DEV bool ok(int m, int C) const { return m >= C && m < NSA_WIN + C; }
  DEV bool elemfree(int kt, int wih) const { return kt * 64 + 63 <= t0 && t0 + 31 - kt * 64 < NSA_WIN; }
};
struct CmpJob {
  const act_t* u; const act_t* kcb; const act_t* vcb; int b, g, t0; unsigned um;
  DEV unsigned tilemask() const { return um; }
  DEV const act_t* qrow(int r) const { return u + ((size_t)b * SEQ + t0 + (r & 31)) * N_IN + OFF_CQ + (g * 4 + (r >> 5)) * 64; }
  DEV const act_t* krow(int kt, int j) const { return kcb + (((size_t)b * 128 + kt * 64 + j) * NSA_G + g) * 64; }
  DEV const act_t* vrow(int kt, int j) const { return vcb + (((size_t)b * 128 + kt * 64 + j) * NSA_G + g) * 64; }
  DEV int mb(int r, int kt, int g4) const { return t0 + (r & 31) - 31 - 16 * (kt * 64 + 4 * g4); }
  DEV bool rowok(int sub, int kt) const { return true; }
  DEV bool ok(int m, int C) const { return m >= 16 * C; }
  DEV bool elemfree(int kt, int wih) const { return kt == 0 && 16 * 63 + 31 <= t0; }
};
struct DilJob {
  const act_t* u; int b, col, dil, res, l0; unsigned um;
  DEV unsigned tilemask() const { return um; }
  DEV const act_t* qrow(int r) const { return u + ((size_t)b * SEQ + (l0 + r) * dil + res) * N_IN + OFF_AQ + col; }
  DEV const act_t* krow(int kt, int j) const { return u + ((size_t)b * SEQ + (kt * 64 + j) * dil + res) * N_IN + OFF_AK + col; }
  DEV const act_t* vrow(int kt, int j) const { return u + ((size_t)b * SEQ + (kt * 64 + j) * dil + res) * N_IN + OFF_AV + col; }
  DEV int mb(int r, int kt, int g4) const { return l0 + r - kt * 64 - 4 * g4; }
  DEV bool rowok(int sub, int kt) const { return true; }
  DEV bool ok(int m, int C) const { return m >= C && m <= 128 + C; }
  DEV bool elemfree(int kt, int wih) const { return kt * 64 + 63 <= l0 + 32 * wih && l0 + 32 * wih + 31 - kt * 64 <= 128; }
};

DEV unsigned range_mask(int lo, int hi) {
  return (hi >= 31 ? 0xffffffffu : ((1u << (hi + 1)) - 1u)) & ~((1u << lo) - 1u);
}

DEV bool nsa_unit(int round, int bid, int G, int half, int& b, int& g, int& tb) {
  if ((G & 7) == 0) {
    const int nr = G >> 3, rank = bid >> 3;
    const int slot = rank * 2 + half, nslot = nr * 2;
    const int pos = (round & 1) ? (nslot - 1 - slot) : slot;
    const int lu = round * nslot + pos;
    if (lu >= 256) return false;
    b = bid & 7; g = lu & 3; tb = 63 - (lu >> 2);
    return true;
  }
  const int pos = (round & 1) ? (G - 1 - bid) : bid;
  const int pair = round * G + pos;
  if (pair >= 1024) return false;
  const int un = pair * 2 + half;
  tb = 63 - un / 32; b = (un % 32) / 4; g = un % 4;
  return true;
}
DEV int nsa_rounds(int G) { return (G & 7) == 0 ? (256 + (G >> 3) * 2 - 1) / ((G >> 3) * 2) : (1024 + G - 1) / G; }

DEV void nsa_cmp_phase(const Params& p, LAS unsigned char* lds, int t32, int bid, int G) {
  const int lane = t32 & 63, wave = t32 >> 6, half = wave >> 2, wih = wave & 3, hth = t32 & 255;
  const int i15 = lane & 15, g4 = lane >> 4;
  LAS float* slabh = (LAS float*)(lds + AT_SLAB_OFF + half * AT_SLAB_HALF);
  for (int round = 0; round < nsa_rounds(G); ++round) {
    int b = 0, g = 0, tb = 0;
    const bool act = nsa_unit(round, bid, G, half, b, g, tb);
    const int t0 = tb * 32;
    const int nvmax = t0 + 31 >= 31 ? (t0 + 31 - 31) / 16 + 1 : 0;
    CmpJob job{p.u, p.kcb, p.kcb + (size_t)BATCH * 128 * NSA_G * 64, b, g, t0, 0u};
    job.um = !act ? 0u : (nvmax > 64 ? 3u : (nvmax > 0 ? 1u : 0u));
    for (int i = lane; i < 32 * 33; i += 64) slabh[wih * (32 * 33) + i] = 0.f;
    LAS unsigned char* kvh = lds + half * AT_HALF_KV;
    LAS unsigned* hb = (LAS unsigned*)(lds + MISC_OFF + 8192 + 128) + half * 16;
    LAS float* slab = slabh + wih * (32 * 33);
    {
      const int srow = hth >> 2, sch = hth & 3;
#pragma unroll
      for (int tl = 0; tl < 2; ++tl)
        if ((job.um >> tl) & 1u) {
          const act_t* kr = job.krow(tl, srow) + sch * 16; const act_t* vr = job.vrow(tl, srow) + sch * 16;
          const u32x4 k0 = *(const u32x4*)kr, k1 = *(const u32x4*)(kr + 8), v0 = *(const u32x4*)vr, v1 = *(const u32x4*)(vr + 8);
          LAS unsigned char* kd = kvh + tl * AT_TILEB + srow * AT_ROWB + sch * 32;
          *(LAS u32x4*)kd = k0; *(LAS u32x4*)(kd + 16) = k1;
          LAS unsigned char* vd = kvh + (2 + tl) * AT_TILEB + srow * AT_ROWB + sch * 32;
          *(LAS u32x4*)vd = v0; *(LAS u32x4*)(vd + 16) = v1;
        }
    }
    bf16x8 qf[2][2];
#pragma unroll
    for (int sub = 0; sub < 2; ++sub) {
      const act_t* qr = job.qrow(wih * 32 + sub * 16 + i15);
#pragma unroll
      for (int kk = 0; kk < 2; ++kk) qf[sub][kk] = *(const bf16x8*)(qr + kk * 32 + 8 * g4);
    }
    AttnState st;
#pragma unroll
    for (int sub = 0; sub < 2; ++sub) {
      st.m[sub] = -INFINITY; st.l[sub] = 0.f;
#pragma unroll
      for (int dt = 0; dt < 4; ++dt) st.O[sub][dt] = (f32x4){0.f, 0.f, 0.f, 0.f};
    }
    half_barrier(hb, lane);
    if (job.um & 1u) attn_tile<false>(job, kvh, kvh + 2 * AT_TILEB, qf, st, slab, 0, wih, lane);
    if (job.um & 2u) attn_tile<false>(job, kvh + AT_TILEB, kvh + 3 * AT_TILEB, qf, st, slab, 1, wih, lane);
#pragma unroll
    for (int sub = 0; sub < 2; ++sub) {
      float l = st.l[sub];
      l += shx(l, lane, 16);
      l += shx(l, lane, 32);
      const float inv = 1.0f / fmaxf(l, 1e-30f);
      st.l[sub] = inv;
#pragma unroll
      for (int dt = 0; dt < 4; ++dt) st.O[sub][dt] *= inv;
    }
    if (act) {
#pragma unroll
      for (int sub = 0; sub < 2; ++sub) {
        const int hh = g * 4 + wih;
        const size_t n = (size_t)b * SEQ + t0 + sub * 16 + i15;
        const float g0 = fsig(ldf(p.u[n * N_IN + OFF_CG + hh * 3 + 0]));
#pragma unroll
        for (int dt = 0; dt < 4; ++dt) { const f32x4 y = st.O[sub][dt] * g0; u32x2 w; w.x = pk2(y.x, y.y); w.y = pk2(y.z, y.w); *(u32x2*)((act_t*)p.ocmp + n * 1024 + hh * 64 + 16 * dt + 4 * g4) = w; }
      }
    }
    if (job.um & 1u) attn_tile<true>(job, kvh, kvh + 2 * AT_TILEB, qf, st, slab, 0, wih, lane);
    if (job.um & 2u) attn_tile<true>(job, kvh + AT_TILEB, kvh + 3 * AT_TILEB, qf, st, slab, 1, wih, lane);
    half_barrier(hb, lane);
    {
      const int q = hth >> 3, j4 = (hth & 7) * 4;
      float v[4];
#pragma unroll
      for (int i = 0; i < 4; ++i) {
        float s = 0.f;
#pragma unroll
        for (int w = 0; w < 4; ++w) s += slabh[w * (32 * 33) + q * 33 + j4 + i];
        const int j = j4 + i, qb = (t0 + q) >> 6;
        if (j == 0 || j == qb || j == qb - 1) s = INFINITY;
        else if (j > qb) s = -INFINITY;
        v[i] = s;
      }
      __syncthreads();
#pragma unroll
      for (int i = 0; i < 4; ++i) slabh[q * 33 + j4 + i] = v[i];
      __syncthreads();
      unsigned bits = 0u;
#pragma unroll
      for (int i = 0; i < 4; ++i) {
        int rank = 0;
#pragma unroll 1
        for (int jj = 0; jj < 32; ++jj) { const float w = slabh[q * 33 + jj]; rank += (w > v[i] || (w == v[i] && jj < j4 + i)) ? 1 : 0; }
        if (rank < N_SELECT) bits |= 1u << (j4 + i);
      }
      bits |= (unsigned)shxi((int)bits, lane, 1);
      bits |= (unsigned)shxi((int)bits, lane, 2);
      bits |= (unsigned)shxi((int)bits, lane, 4);
      if (act && (hth & 7) == 0) p.selm[((size_t)b * NSA_G + g) * SEQ + t0 + q] = bits;
      __syncthreads();
    }
  }
}

DEV void nsa_main_phase(const Params& p, LAS unsigned char* lds, int t32, int bid, int G) {
  const int lane = t32 & 63, wave = t32 >> 6, half = wave >> 2, wih = wave & 3, hth = t32 & 255;
  const int i15 = lane & 15, g4 = lane >> 4;
#define NSTAMP(i) do { if (GSEG >= 10 && blockIdx.x == 0 && t32 == 0) { const unsigned now_ = (unsigned)__builtin_amdgcn_s_memrealtime(); if ((i) > 0 && (i) - 1 + 10 == GSEG) p.barw[3600] += now_ - ns_prev; ns_prev = now_; } } while (0)
  unsigned ns_prev = 0u;
  for (int round2 = 0; round2 < nsa_rounds(G) * (NSA_PROBE == 5 ? 2 : 1); ++round2) {
    const int round = (NSA_PROBE == 5) ? (round2 >> 1) : round2;
    NSTAMP(0);
    int b = 0, g = 0, tb = 0;
    const bool act = nsa_unit(round, bid, G, half, b, g, tb);
    const int t0 = tb * 32;
    SelJob sj{p.u, b, g, t0, 0u, {0u, 0u}};
    if (act) {
      const unsigned* sm = p.selm + ((size_t)b * NSA_G + g) * SEQ + t0;
      sj.tm[0] = sm[i15]; sj.tm[1] = sm[16 + i15];
      unsigned um = sj.tm[0] | sj.tm[1];
      int l2 = lane;
      asm volatile("" : "+v"(l2));
      um |= (unsigned)shxi((int)um, l2, 1); um |= (unsigned)shxi((int)um, l2, 2);
      um |= (unsigned)shxi((int)um, l2, 4); um |= (unsigned)shxi((int)um, l2, 8);
      sj.um = um & range_mask(0, t0 >> 6);
    }
    u32x2 base[2][4];
    const int hh = g * 4 + wih;
    const size_t nrow0 = (size_t)b * SEQ + t0 + i15;
    const act_t gq10 = p.u[nrow0 * N_IN + OFF_CG + hh * 3 + 1], gq11 = p.u[(nrow0 + 16) * N_IN + OFF_CG + hh * 3 + 1];
    const act_t gq20 = p.u[nrow0 * N_IN + OFF_CG + hh * 3 + 2], gq21 = p.u[(nrow0 + 16) * N_IN + OFF_CG + hh * 3 + 2];
    {
      AttnState ss;
      NSTAMP(1);
      attn_run<false>(sj, lds, ss, half, hth, wih, lane);
      NSTAMP(2);
#if NSA_PROBE == 1
      attn_run<false>(sj, lds, ss, half, hth, wih, lane);
#endif
#pragma unroll
      for (int sub = 0; sub < 2; ++sub) {
        f32x4 oc[4];
#pragma unroll
        for (int dt = 0; dt < 4; ++dt) {
          const u32x2 cw = *(const u32x2*)((const act_t*)p.ocmp + (nrow0 + 16 * sub) * 1024 + hh * 64 + 16 * dt + 4 * g4);
          oc[dt] = (f32x4){__uint_as_float(cw.x << 16), __uint_as_float(cw.x & 0xffff0000u), __uint_as_float(cw.y << 16), __uint_as_float(cw.y & 0xffff0000u)};
        }
        const float g1 = fsig(ldf(sub ? gq11 : gq10));
#pragma unroll
        for (int dt = 0; dt < 4; ++dt) {
          const f32x4 y = ss.O[sub][dt] * g1 + oc[dt];
          base[sub][dt].x = pk2(y.x, y.y); base[sub][dt].y = pk2(y.z, y.w);
        }
      }
    }
    WinJob wj{p.u, b, g, t0, 0u};
    if (act) { const int lo = t0 - (NSA_WIN - 1) < 0 ? 0 : (t0 - (NSA_WIN - 1)) >> 6; wj.um = range_mask(lo, (t0 + 31) >> 6); }
    AttnState ws;
    NSTAMP(3);
    attn_run<false>(wj, lds, ws, half, hth, wih, lane);
    NSTAMP(4);
#if NSA_PROBE == 2
    attn_run<false>(wj, lds, ws, half, hth, wih, lane);
#endif
    if (act) {
#pragma unroll
      for (int sub = 0; sub < 2; ++sub) {
        const size_t n = nrow0 + 16 * sub;
        const float g2 = fsig(ldf(sub ? gq21 : gq20));
#pragma unroll
        for (int dt = 0; dt < 4; ++dt) {
          const u32x2 bw = base[sub][dt];
          f32x4 y = ws.O[sub][dt] * g2;
          y.x += __uint_as_float(bw.x << 16); y.y += __uint_as_float(bw.x & 0xffff0000u);
          y.z += __uint_as_float(bw.y << 16); y.w += __uint_as_float(bw.y & 0xffff0000u);
          u32x2 w; w.x = pk2(y.x, y.y); w.y = pk2(y.z, y.w);
          *(u32x2*)(p.yc + n * YLD + hh * 64 + 16 * dt + 4 * g4) = w;
        }
      }
    }
  }
}

DEV void dil_phase(const Params& p, LAS unsigned char* lds, int t32, int bid, int G) {
  const int lane = t32 & 63, wave = t32 >> 6, half = wave >> 2, wih = wave & 3, hth = t32 & 255;
  const int i15 = lane & 15, g4 = lane >> 4;
  const bool xm = (G & 7) == 0;
  const int npair = xm ? 96 : 768, pstep = xm ? (G >> 3) : G;
  for (int pair = xm ? (bid >> 3) : bid; pair < npair; pair += pstep) {
    const int un = pair * 2 + half;
    int gi, b, r2;
    if (xm) { b = bid & 7; gi = un / 64; r2 = un % 64; }
    else { gi = un / 512; const int r = un % 512; b = r / 64; r2 = r % 64; }
    const int dil = gi == 0 ? 1 : (gi == 1 ? 4 : 16);
    const int nlb = 16 / dil;
    const int h = r2 / 16, r3 = r2 % 16;
    const int res = r3 / nlb, lb = r3 % nlb;
    const int l0 = lb * 128;
    DilJob job{p.u, b, gi * 256 + h * 64, dil, res, l0, 0u};
    job.um = range_mask(l0 >= 128 ? (l0 - 128) >> 6 : 0, (l0 + 127) >> 6);
    AttnState st;
    attn_run<false>(job, lds, st, half, hth, wih, lane);
#pragma unroll
    for (int sub = 0; sub < 2; ++sub) {
      const int l = l0 + wih * 32 + sub * 16 + i15;
      const size_t n = (size_t)b * SEQ + l * dil + res;
#pragma unroll
      for (int dt = 0; dt < 4; ++dt) {
        const f32x4 y = st.O[sub][dt];
        u32x2 w; w.x = pk2(y.x, y.y); w.y = pk2(y.z, y.w);
        *(u32x2*)(p.dilo + ((size_t)gi * N_TOK + n) * 256 + h * 64 + 16 * dt + 4 * g4) = w;
      }
      if (g4 == 0) p.dill[((size_t)gi * N_TOK + n) * 4 + h] = st.m[sub] + __builtin_amdgcn_logf(st.l[sub]);
    }
  }
}

DEV void dil_combine(const Params& p, long long tid, long long nthr) {
  for (long long idx = tid; idx < (long long)N_TOK * 32; idx += nthr) {
    const size_t n = idx >> 5; const int c8 = (int)(idx & 31) * 8, h = c8 >> 6;
    const float l0 = p.dill[((size_t)0 * N_TOK + n) * 4 + h], l1 = p.dill[((size_t)1 * N_TOK + n) * 4 + h], l2 = p.dill[((size_t)2 * N_TOK + n) * 4 + h];
    const float mx = fmaxf(l0, fmaxf(l1, l2));
    float w0 = __builtin_amdgcn_exp2f(l0 - mx), w1 = __builtin_amdgcn_exp2f(l1 - mx), w2 = __builtin_amdgcn_exp2f(l2 - mx);
    const float inv = 1.0f / (w0 + w1 + w2);
    w0 *= inv; w1 *= inv; w2 *= inv;
    const u32x4 a = *(const u32x4*)(p.dilo + ((size_t)0 * N_TOK + n) * 256 + c8);
    const u32x4 bq = *(const u32x4*)(p.dilo + ((size_t)1 * N_TOK + n) * 256 + c8);
    const u32x4 c = *(const u32x4*)(p.dilo + ((size_t)2 * N_TOK + n) * 256 + c8);
    u32x4 o;
#pragma unroll
    for (int i = 0; i < 4; ++i) {
      const float lo = w0 * __uint_as_float(a[i] << 16) + w1 * __uint_as_float(bq[i] << 16) + w2 * __uint_as_float(c[i] << 16);
      const float hi = w0 * __uint_as_float(a[i] & 0xffff0000u) + w1 * __uint_as_float(bq[i] & 0xffff0000u) + w2 * __uint_as_float(c[i] & 0xffff0000u);
      o[i] = pk2(lo, hi);
    }
    *(u32x4*)(p.ya + n * YLD + c8) = o;
  }
}

DEV void cmpa_build(const Params& p, int li, long long tid, long long nthr) {
  for (long long idx = tid; idx < 2LL * CMP_ROWS * 256; idx += nthr) {
    const int which = (int)(idx / ((long long)CMP_ROWS * 256));
    const long long rem = idx % ((long long)CMP_ROWS * 256);
    const int row = (int)(rem >> 8), c8 = (int)(rem & 255) * 8, l = c8 >> 6, d = c8 & 63;
    const int g = row % NSA_G, c = (row / NSA_G) % N_CMP, b = row / (NSA_G * N_CMP);
    const float* pe = (which ? p.cmp_pe_v : p.cmp_pe_k) + (size_t)li * 32 * HD + l * HD + d;
    const u32x4 uv = *(const u32x4*)(p.u + ((size_t)b * SEQ + c * 16 + l) * N_IN + (which ? OFF_CVC : OFF_CKC) + g * HD + d);
    u32x4 o;
#pragma unroll
    for (int i = 0; i < 4; ++i) o[i] = pk2(__uint_as_float(uv[i] << 16) + pe[2 * i], __uint_as_float(uv[i] & 0xffff0000u) + pe[2 * i + 1]);
    *(u32x4*)(p.cmpA + ((size_t)which * CMP_ROWS_PAD + row) * 2048 + c8) = o;
  }
}

constexpr int XA_ROWB = 528;
constexpr int XA_TILEB = 32 * XA_ROWB;
static_assert(4 * XA_TILEB <= RING_BYTES, "xattn LDS map");
DEV void xattn_phase(const Params& p, LAS unsigned char* lds, int t32, int bid, int G) {
  const int lane = t32 & 63, wave = t32 >> 6, i15 = lane & 15, g4 = lane >> 4;
  const float sc2 = 0.0625f * 1.4426950408889634f;
  const bool xm = (G & 7) == 0;
  const int nun = xm ? XH * (SEQ / 128) : BATCH * XH * (SEQ / 128), ustep = xm ? (G >> 3) : G;
  for (int un = xm ? (bid >> 3) : bid; un < nun; un += ustep) {
    const int b = xm ? (bid & 7) : un / (XH * (SEQ / 128)), r = un % (XH * (SEQ / 128)), h = r / (SEQ / 128), qb = r % (SEQ / 128);
    const size_t nq = (size_t)b * SEQ + qb * 128 + wave * 16 + i15;
    bf16x8 qf[8];
#pragma unroll
    for (int kk = 0; kk < 8; ++kk) qf[kk] = *(const bf16x8*)(p.xq + nq * 1024 + h * 256 + kk * 32 + 8 * g4);
    f32x4 O[16];
#pragma unroll
    for (int dt = 0; dt < 16; ++dt) O[dt] = (f32x4){0.f, 0.f, 0.f, 0.f};
    float m = -INFINITY, l = 0.f;
    const int srow = t32 >> 4, sch = t32 & 15;
    const act_t* kbase = p.memk + ((size_t)b * MEM_LEN + srow) * 1024 + h * 256 + sch * 16;
    const act_t* vbase = p.memv + ((size_t)b * MEM_LEN + srow) * 1024 + h * 256 + sch * 16;
    u32x4 sk0 = *(const u32x4*)kbase, sk1 = *(const u32x4*)(kbase + 8), sv0 = *(const u32x4*)vbase, sv1 = *(const u32x4*)(vbase + 8);
    {
      LAS unsigned char* kd = lds + srow * XA_ROWB + sch * 32;
      *(LAS u32x4*)kd = sk0; *(LAS u32x4*)(kd + 16) = sk1;
      LAS unsigned char* vd = lds + 2 * XA_TILEB + srow * XA_ROWB + sch * 32;
      *(LAS u32x4*)vd = sv0; *(LAS u32x4*)(vd + 16) = sv1;
    }
    __syncthreads();
    for (int it = 0; it < MEM_LEN / 32; ++it) {
      if (it + 1 < MEM_LEN / 32) {
        const act_t* kr = kbase + (size_t)(it + 1) * 32 * 1024, *vr = vbase + (size_t)(it + 1) * 32 * 1024;
        sk0 = *(const u32x4*)kr; sk1 = *(const u32x4*)(kr + 8); sv0 = *(const u32x4*)vr; sv1 = *(const u32x4*)(vr + 8);
      }
      const LAS unsigned char* Kb = lds + (it & 1) * XA_TILEB;
      const LAS unsigned char* Vb = lds + (2 + (it & 1)) * XA_TILEB;
      f32x4 S[2];
      S[0] = (f32x4){0.f, 0.f, 0.f, 0.f}; S[1] = (f32x4){0.f, 0.f, 0.f, 0.f};
#pragma unroll
      for (int t = 0; t < 2; ++t)
#pragma unroll
        for (int kk = 0; kk < 8; ++kk) {
          const bf16x8 kf = *(const LAS bf16x8*)(Kb + (16 * t + i15) * XA_ROWB + (kk * 32 + 8 * g4) * 2);
          S[t] = __builtin_amdgcn_mfma_f32_16x16x32_bf16(kf, qf[kk], S[t], 0, 0, 0);
        }
      float mx = -INFINITY;
#pragma unroll
      for (int t = 0; t < 2; ++t)
#pragma unroll
        for (int j = 0; j < 4; ++j) { S[t][j] *= sc2; mx = fmaxf(mx, S[t][j]); }
      mx = fmaxf(mx, shx(mx, lane, 16));
      mx = fmaxf(mx, shx(mx, lane, 32));
      const float mnew = fmaxf(m, mx);
      const float corr = __builtin_amdgcn_exp2f(m - mnew);
      m = mnew;
      float psum = 0.f;
#pragma unroll
      for (int t = 0; t < 2; ++t)
#pragma unroll
        for (int j = 0; j < 4; ++j) { const float pp = __builtin_amdgcn_exp2f(S[t][j] - mnew); S[t][j] = pp; psum += pp; }
      l = l * corr + psum;
      u32x4 w;
      w.x = pk2(S[0][0], S[0][1]); w.y = pk2(S[0][2], S[0][3]); w.z = pk2(S[1][0], S[1][1]); w.w = pk2(S[1][2], S[1][3]);
      const bf16x8 pf = __builtin_bit_cast(bf16x8, w);
#pragma unroll
      for (int dt = 0; dt < 16; ++dt) {
        const LAS unsigned char* vp = Vb + (4 * g4 + (i15 >> 2)) * XA_ROWB + (16 * dt + 4 * (lane & 3)) * 2;
        const v4i16_t lo = tr_read(vp), hi = tr_read(vp + 16 * XA_ROWB);
        bf16x8 vf;
        vf[0] = lo[0]; vf[1] = lo[1]; vf[2] = lo[2]; vf[3] = lo[3]; vf[4] = hi[0]; vf[5] = hi[1]; vf[6] = hi[2]; vf[7] = hi[3];
        O[dt] = __builtin_amdgcn_mfma_f32_16x16x32_bf16(vf, pf, O[dt] * corr, 0, 0, 0);
      }
      if (it + 1 < MEM_LEN / 32) {
        LAS unsigned char* kd = lds + ((it + 1) & 1) * XA_TILEB + srow * XA_ROWB + sch * 32;
        *(LAS u32x4*)kd = sk0; *(LAS u32x4*)(kd + 16) = sk1;
        LAS unsigned char* vd = lds + (2 + ((it + 1) & 1)) * XA_TILEB + srow * XA_ROWB + sch * 32;
        *(LAS u32x4*)vd = sv0; *(LAS u32x4*)(vd + 16) = sv1;
      }
      __syncthreads();
    }
    l += shx(l, lane, 16);
    l += shx(l, lane, 32);
    const float inv = 1.0f / l;
#pragma unroll
    for (int dt = 0; dt < 16; ++dt) {
      const f32x4 y = O[dt] * inv;
      u32x2 w; w.x = pk2(y.x, y.y); w.y = pk2(y.z, y.w);
      *(u32x2*)(p.xo + nq * 1024 + h * 256 + 16 * dt + 4 * g4) = w;
    }
  }
}

constexpr int RT_LCNT = MISC_OFF + 4096, RT_BASE = RT_LCNT + 128, RT_SEL = RT_BASE + 128, RT_RANK = RT_SEL + 1024;
DEV void route_phase(const Params& p, int li, LAS unsigned char* lds, int t32, int bid, int G) {
  const int lane = t32 & 63, wave = t32 >> 6, i15 = lane & 15, g4 = lane >> 4;
  const float* W = p.w_router + (size_t)li * D * NE;
  LAS unsigned short* Wh = (LAS unsigned short*)lds;
  LAS unsigned short* Wl = (LAS unsigned short*)(lds + 65536);
  LAS int* lcnt = (LAS int*)(lds + RT_LCNT);
  LAS int* lbase = (LAS int*)(lds + RT_BASE);
  LAS int* lsel = (LAS int*)(lds + RT_SEL);
  LAS int* lrank = (LAS int*)(lds + RT_RANK);
  const int e = lane & 31;
  const float bias = p.b_router[li * NE + e];
  for (int blk = bid; blk < N_TOK / 64; blk += G) {
    __syncthreads();
    for (int i = 0; i < 16; ++i) {
      const int idx = t32 + 512 * i, k = idx >> 3, e4 = (idx & 7) * 4;
      const f32x4 w = ((const f32x4*)W)[idx];
#pragma unroll
      for (int q = 0; q < 4; ++q) {
        const unsigned short hi = f2bfh(w[q]);
        const unsigned short lo = f2bfh(w[q] - __uint_as_float(((unsigned)hi) << 16));
        Wh[(e4 + q) * 1024 + k] = hi; Wl[(e4 + q) * 1024 + k] = lo;
      }
    }
    if (t32 < 32) lcnt[t32] = 0;
    __syncthreads();
    f32x4 acc[4][2];
#pragma unroll
    for (int mt = 0; mt < 4; ++mt) { acc[mt][0] = (f32x4){0.f, 0.f, 0.f, 0.f}; acc[mt][1] = (f32x4){0.f, 0.f, 0.f, 0.f}; }
    const int n0 = blk * 64;
#pragma unroll 1
    for (int kk = 0; kk < 4; ++kk) {
      const int kb = wave * 128 + kk * 32 + 8 * g4;
      bf16x8 bh[2], bl[2];
#pragma unroll
      for (int nt = 0; nt < 2; ++nt) {
        bh[nt] = *(const LAS bf16x8*)(Wh + (16 * nt + i15) * 1024 + kb);
        bl[nt] = *(const LAS bf16x8*)(Wl + (16 * nt + i15) * 1024 + kb);
      }
#pragma unroll
      for (int mt = 0; mt < 4; ++mt) {
        const float* xr = p.xf + (size_t)(n0 + 16 * mt + i15) * D + kb;
        const f32x4 x0 = *(const f32x4*)xr, x1 = *(const f32x4*)(xr + 4);
        u32x4 hw, lw;
        {
          const unsigned h0 = pk2(x0.x, x0.y), h1 = pk2(x0.z, x0.w), h2 = pk2(x1.x, x1.y), h3 = pk2(x1.z, x1.w);
          hw = (u32x4){h0, h1, h2, h3};
          lw.x = pk2(x0.x - __uint_as_float(h0 << 16), x0.y - __uint_as_float(h0 & 0xffff0000u));
          lw.y = pk2(x0.z - __uint_as_float(h1 << 16), x0.w - __uint_as_float(h1 & 0xffff0000u));
          lw.z = pk2(x1.x - __uint_as_float(h2 << 16), x1.y - __uint_as_float(h2 & 0xffff0000u));
          lw.w = pk2(x1.z - __uint_as_float(h3 << 16), x1.w - __uint_as_float(h3 & 0xffff0000u));
        }
        const bf16x8 ah = __builtin_bit_cast(bf16x8, hw), al = __builtin_bit_cast(bf16x8, lw);
#pragma unroll
        for (int nt = 0; nt < 2; ++nt) {
          acc[mt][nt] = __builtin_amdgcn_mfma_f32_16x16x32_bf16(ah, bh[nt], acc[mt][nt], 0, 0, 0);
          acc[mt][nt] = __builtin_amdgcn_mfma_f32_16x16x32_bf16(ah, bl[nt], acc[mt][nt], 0, 0, 0);
          acc[mt][nt] = __builtin_amdgcn_mfma_f32_16x16x32_bf16(al, bh[nt], acc[mt][nt], 0, 0, 0);
        }
      }
    }
    __syncthreads();
    LAS float* part = (LAS float*)lds;
    LAS float* fin = (LAS float*)(lds + 8 * 64 * 33 * 4);
#pragma unroll
    for (int mt = 0; mt < 4; ++mt)
#pragma unroll
      for (int nt = 0; nt < 2; ++nt)
#pragma unroll
        for (int j = 0; j < 4; ++j) part[(wave * 64 + 16 * mt + 4 * g4 + j) * 33 + 16 * nt + i15] = acc[mt][nt][j];
    __syncthreads();
    {
      const int tok = t32 >> 3, e4 = (t32 & 7) * 4;
#pragma unroll
      for (int q = 0; q < 4; ++q) {
        float v = 0.f;
#pragma unroll
        for (int w = 0; w < 8; ++w) v += part[(w * 64 + tok) * 33 + e4 + q];
        fin[tok * 33 + e4 + q] = v;
      }
    }
    __syncthreads();
    float cur[8]; int sel[8][4]; float sv[8][4];
#pragma unroll
    for (int t = 0; t < 8; ++t) cur[t] = fin[(wave * 8 + t) * 33 + e] + bias;
#pragma unroll
    for (int k = 0; k < 4; ++k) {
      float bv[8]; int bi[8];
#pragma unroll
      for (int t = 0; t < 8; ++t) { bv[t] = cur[t]; bi[t] = e; }
#pragma unroll
      for (int o = 1; o < 32; o <<= 1) {
#pragma unroll
        for (int t = 0; t < 8; ++t) {
          const float ov = shx(bv[t], lane, o); const int oi = shxi(bi[t], lane, o);
          if (ov > bv[t] || (ov == bv[t] && oi < bi[t])) { bv[t] = ov; bi[t] = oi; }
        }
      }
#pragma unroll
      for (int t = 0; t < 8; ++t) { sel[t][k] = bi[t]; sv[t][k] = bv[t]; if (e == bi[t]) cur[t] = -INFINITY; }
    }
    int abase = __builtin_amdgcn_readfirstlane(wave * 32);
    asm volatile("" : "+s"(abase));
    if (lane == 0) {
#pragma unroll
      for (int t = 0; t < 8; ++t) {
        const int n = n0 + wave * 8 + t;
        const float e1 = expf(sv[t][1] - sv[t][0]), e2 = expf(sv[t][2] - sv[t][0]), e3 = expf(sv[t][3] - sv[t][0]);
        const float inv = 1.0f / (1.0f + e1 + e2 + e3);
        p.topg[n * 4 + 0] = inv; p.topg[n * 4 + 1] = e1 * inv; p.topg[n * 4 + 2] = e2 * inv; p.topg[n * 4 + 3] = e3 * inv;
#pragma unroll
        for (int k = 0; k < 4; ++k) {
          const int a = abase + t * 4 + k;
          lsel[a] = sel[t][k];
          lrank[a] = __hip_atomic_fetch_add(lcnt + sel[t][k], 1, __ATOMIC_RELAXED, __HIP_MEMORY_SCOPE_WORKGROUP);
        }
      }
    }
    __syncthreads();
    if (t32 < 32) lbase[t32] = atomicAdd(&p.cnt[li * 32 + t32], lcnt[t32]);
    __syncthreads();
    if (t32 < 256) {
      const int a = blk * 256 + t32, ee = lsel[t32];
      p.topi[a] = ee;
      p.rank[a] = lbase[ee] + lrank[t32];
    }
  }
  __syncthreads();
}

DEV void kcv_phase(const Params& p, int li, LAS unsigned char* lds, int t32, int bid, int G) {
  const int lane = t32 & 63, wave = t32 >> 6;
  LAS float* w2l = (LAS float*)lds;
  LAS float* rowb = (LAS float*)(lds + 65536) + wave * 512;
  __syncthreads();
#pragma unroll
  for (int i = 0; i < 4; ++i) {
    ((LAS f32x4*)w2l)[t32 + 512 * i] = ((const f32x4*)(p.cmp_w2_k + (size_t)li * CMP_HID * HD))[t32 + 512 * i];
    ((LAS f32x4*)w2l)[2048 + t32 + 512 * i] = ((const f32x4*)(p.cmp_w2_v + (size_t)li * CMP_HID * HD))[t32 + 512 * i];
  }
  __syncthreads();
  const int NGW = G * 8;
  for (int r0 = bid * 8 + wave; r0 < 2 * CMP_ROWS; r0 += 4 * NGW) {
    int rows[4];
#pragma unroll
    for (int i = 0; i < 4; ++i) { rows[i] = r0 + i * NGW; if (rows[i] >= 2 * CMP_ROWS) rows[i] = r0; }
#pragma unroll
    for (int i = 0; i < 4; ++i) {
      const float* hr = p.hid + (size_t)rows[i] * CMP_HID;
      rowb[i * 128 + lane] = hr[lane]; rowb[i * 128 + 64 + lane] = hr[64 + lane];
    }
    asm volatile("s_waitcnt lgkmcnt(0)" ::: "memory");
    float acc[4] = {0.f, 0.f, 0.f, 0.f};
    const LAS float* wq[4];
#pragma unroll
    for (int i = 0; i < 4; ++i) wq[i] = w2l + (rows[i] >= CMP_ROWS ? 128 * 64 : 0) + lane;
#pragma unroll 8
    for (int j = 0; j < CMP_HID; ++j) {
#pragma unroll
      for (int i = 0; i < 4; ++i) acc[i] += rowb[i * 128 + j] * wq[i][j * 64];
    }
#pragma unroll
    for (int i = 0; i < 4; ++i) {
      const int row = r0 + i * NGW;
      if (row < 2 * CMP_ROWS) {
        const int which = row >= CMP_ROWS ? 1 : 0, rr = row - which * CMP_ROWS;
        const int g_ = rr % NSA_G, c_ = (rr / NSA_G) % N_CMP, b_ = rr / (NSA_G * N_CMP);
        p.kcb[((((size_t)which * BATCH + b_) * 128 + c_) * NSA_G + g_) * 64 + lane] = f2bfh(acc[i]);
      }
    }
    asm volatile("s_waitcnt lgkmcnt(0)" ::: "memory");
  }
  __syncthreads();
}

constexpr int GA_QS = 272, GA_VS = 528, GA_PS = 144;
constexpr int GA_QT = 0, GA_KT = GA_QT + 64 * GA_QS, GA_KH = GA_KT + 64 * GA_QS, GA_VT = GA_KH + 64 * GA_QS, GA_PT = GA_VT + 64 * GA_VS,
              GA_LR = GA_PT + 64 * GA_PS, GA_GT = GA_LR + 64 * 16 * 4, GA_DC = GA_GT + 4 * 128 * 4, GA_END = GA_DC + 512;
static_assert(GA_END <= RING_BYTES, "GLA phase A LDS map");
constexpr int GC_SP = 0, GC_QT = GC_SP + 128 * GA_VS, GC_RED = GC_QT + 64 * GA_QS, GC_END = GC_RED + 8 * 16 * 4 * 2;
static_assert(GC_END <= RING_BYTES, "GLA phase C LDS map");

#define GSTAMP(i) do { if (GSEG >= 0 && blockIdx.x == 0 && t32 == 0) { const unsigned now_ = (unsigned)__builtin_amdgcn_s_memrealtime(); if ((i) > 0 && (i) - 1 == GSEG) p.barw[3600] += now_ - gs_prev; gs_prev = now_; } } while (0)
DEV void gla_a_unit(const Params& p, int li, LAS unsigned char* lds, int t32, int unit) {
  unsigned gs_prev = 0u;
  GSTAMP(0);
  const int lane = t32 & 63, wave = t32 >> 6, i15 = lane & 15, g4 = lane >> 4;
  const int bh = unit >> 5, ci = unit & 31, b = bh >> 2, h = bh & 3;
  const int c = t32 & 127, jq = t32 >> 7;
  LAS float* LR = (LAS float*)(lds + GA_LR);
  LAS float* GT = (LAS float*)(lds + GA_GT);
  LAS float* DC = (LAS float*)(lds + GA_DC);
  const float qscale = 0.08838834764831845f;
  const size_t n0 = (size_t)b * SEQ + ci * 64;
  {
    const int e = t32 * 2, j = e >> 4, r = e & 15;
    const unsigned w = *(const unsigned*)(p.u + (n0 + j) * N_IN + OFF_LR + r);
    LR[e] = __uint_as_float(w << 16); LR[e + 1] = __uint_as_float(w & 0xffff0000u);
  }
  float wa[GLA_RANK];
#pragma unroll
  for (int r = 0; r < GLA_RANK; ++r) wa[r] = p.w_alpha2[((size_t)li * GLA_RANK + r) * B_K + h * 128 + c];
  const float ba = p.b_alpha[li * B_K + h * 128 + c];
#pragma unroll
  for (int x = 0; x < 2; ++x) {
    const int idx = t32 + 512 * x, row = idx >> 4, ch = idx & 15;
    const act_t* ur = p.u + (n0 + row) * N_IN + h * 128 + ch * 8;
    *(LAS u32x4*)(lds + GA_QT + row * GA_QS + ch * 16) = *(const u32x4*)(ur + OFF_BQ);
    *(LAS u32x4*)(lds + GA_KT + row * GA_QS + ch * 16) = *(const u32x4*)(ur + OFF_BK);
  }
#pragma unroll
  for (int x = 0; x < 4; ++x) {
    const int idx = t32 + 512 * x, row = idx >> 5, ch = idx & 31;
    const u32x4 vv = *(const u32x4*)(p.u + (n0 + row) * N_IN + OFF_BV + h * 256 + ch * 8);
    *(LAS u32x4*)(lds + GA_VT + row * GA_VS + ch * 16) = vv;
  }
  __syncthreads();
  GSTAMP(1);
  float bl[16];
  float run = 0.f;
#pragma unroll
  for (int jj = 0; jj < 16; ++jj) {
    const LAS f32x4* lr4 = (const LAS f32x4*)(LR + (jq * 16 + jj) * 16);
    float z = ba;
#pragma unroll
    for (int r4 = 0; r4 < 4; ++r4) { const f32x4 x = lr4[r4]; z += x.x * wa[4 * r4] + x.y * wa[4 * r4 + 1] + x.z * wa[4 * r4 + 2] + x.w * wa[4 * r4 + 3]; }
    const float ez = __builtin_amdgcn_exp2f(-fabsf(z) * 1.4426950408889634f);
    const float ls = (fminf(z, 0.f) - __builtin_amdgcn_logf(1.0f + ez) * 0.6931471805599453f) * (1.0f / 16.0f);
    run += ls; bl[jj] = run;
  }
  GT[jq * 128 + c] = run;
  __syncthreads();
  GSTAMP(2);
  {
    const float g0 = GT[c], g1 = GT[128 + c], g2 = GT[256 + c], g3 = GT[384 + c];
    const float off = (jq > 0 ? g0 : 0.f) + (jq > 1 ? g1 : 0.f) + (jq > 2 ? g2 : 0.f);
    const float tot = (g0 + g1) + (g2 + g3);
    const float dtot = __builtin_amdgcn_exp2f(tot * 1.4426950408889634f);
    if (jq == 0) { DC[c] = dtot; p.gD[(size_t)unit * 128 + c] = dtot; }
#pragma unroll
    for (int jj = 0; jj < 16; ++jj) {
      const float e1 = __builtin_amdgcn_exp2f((off + bl[jj]) * 1.4426950408889634f), ie = __builtin_amdgcn_rcpf(e1);
      const int ro = (jq * 16 + jj) * GA_QS + c * 2;
      const float qf = __uint_as_float(((unsigned)*(const LAS unsigned short*)(lds + GA_QT + ro)) << 16);
      const float kf = __uint_as_float(((unsigned)*(const LAS unsigned short*)(lds + GA_KT + ro)) << 16);
      const unsigned short qt = f2bfh(qf * e1 * qscale);
      *(LAS unsigned short*)(lds + GA_QT + ro) = qt;
      p.gQ[((size_t)unit * 64 + jq * 16 + jj) * 128 + c] = qt;
      *(LAS unsigned short*)(lds + GA_KT + ro) = f2bfh(kf * ie);
      *(LAS unsigned short*)(lds + GA_KH + ro) = f2bfh(kf * ie * dtot);
    }
  }
  __syncthreads();
  GSTAMP(3);
#pragma unroll
  for (int q = 0; q < 2; ++q) {
    const int id = wave * 2 + q, jt = id >> 2, it = id & 3;
    f32x4 a = (f32x4){0.f, 0.f, 0.f, 0.f};
#pragma unroll
    for (int kk = 0; kk < 4; ++kk) {
      const bf16x8 kf = *(const LAS bf16x8*)(lds + GA_KT + (16 * jt + i15) * GA_QS + (32 * kk + 8 * g4) * 2);
      const bf16x8 qf = *(const LAS bf16x8*)(lds + GA_QT + (16 * it + i15) * GA_QS + (32 * kk + 8 * g4) * 2);
      a = __builtin_amdgcn_mfma_f32_16x16x32_bf16(kf, qf, a, 0, 0, 0);
    }
    const int i = 16 * it + i15, j0 = 16 * jt + 4 * g4;
    u32x2 w;
    w.x = pk2(j0 <= i ? a.x : 0.f, j0 + 1 <= i ? a.y : 0.f);
    w.y = pk2(j0 + 2 <= i ? a.z : 0.f, j0 + 3 <= i ? a.w : 0.f);
    *(LAS u32x2*)(lds + GA_PT + i * GA_PS + j0 * 2) = w;
  }
  __syncthreads();
  GSTAMP(4);
  {
    const int it = wave & 3, vt0 = (wave >> 2) * 8;
    bf16x8 pf[2];
#pragma unroll
    for (int s = 0; s < 2; ++s) pf[s] = *(const LAS bf16x8*)(lds + GA_PT + (16 * it + i15) * GA_PS + (32 * s + 8 * g4) * 2);
#pragma unroll
    for (int x = 0; x < 8; ++x) {
      const int vt = vt0 + x;
      f32x4 a = (f32x4){0.f, 0.f, 0.f, 0.f};
#pragma unroll
      for (int s = 0; s < 2; ++s) {
        const LAS unsigned char* vp = lds + GA_VT + (32 * s + 8 * g4 + (i15 >> 2)) * GA_VS + (16 * vt + 4 * (lane & 3)) * 2;
        const v4i16_t lo = tr_read(vp), hi = tr_read(vp + 4 * GA_VS);
        bf16x8 vf;
        vf[0] = lo[0]; vf[1] = lo[1]; vf[2] = lo[2]; vf[3] = lo[3]; vf[4] = hi[0]; vf[5] = hi[1]; vf[6] = hi[2]; vf[7] = hi[3];
        a = __builtin_amdgcn_mfma_f32_16x16x32_bf16(vf, pf[s], a, 0, 0, 0);
      }
      *(f32x4*)(p.opart + (n0 + 16 * it + i15) * 1024 + h * 256 + 16 * vt + 4 * g4) = a;
    }
  }
  {
    bf16x8 vf[2][2];
#pragma unroll
    for (int x = 0; x < 2; ++x)
#pragma unroll
      for (int s = 0; s < 2; ++s) {
        const LAS unsigned char* vp = lds + GA_VT + (32 * s + 8 * g4 + (i15 >> 2)) * GA_VS + (16 * (2 * wave + x) + 4 * (lane & 3)) * 2;
        const v4i16_t lo = tr_read(vp), hi = tr_read(vp + 4 * GA_VS);
        vf[x][s][0] = lo[0]; vf[x][s][1] = lo[1]; vf[x][s][2] = lo[2]; vf[x][s][3] = lo[3];
        vf[x][s][4] = hi[0]; vf[x][s][5] = hi[1]; vf[x][s][6] = hi[2]; vf[x][s][7] = hi[3];
      }
#pragma unroll
    for (int ct = 0; ct < 8; ++ct) {
      f32x4 a0 = (f32x4){0.f, 0.f, 0.f, 0.f}, a1 = (f32x4){0.f, 0.f, 0.f, 0.f};
#pragma unroll
      for (int s = 0; s < 2; ++s) {
        const LAS unsigned char* kp = lds + GA_KH + (32 * s + 8 * g4 + (i15 >> 2)) * GA_QS + (16 * ct + 4 * (lane & 3)) * 2;
        const v4i16_t lo = tr_read(kp), hi = tr_read(kp + 4 * GA_QS);
        bf16x8 kf;
        kf[0] = lo[0]; kf[1] = lo[1]; kf[2] = lo[2]; kf[3] = lo[3]; kf[4] = hi[0]; kf[5] = hi[1]; kf[6] = hi[2]; kf[7] = hi[3];
        a0 = __builtin_amdgcn_mfma_f32_16x16x32_bf16(vf[0][s], kf, a0, 0, 0, 0);
        a1 = __builtin_amdgcn_mfma_f32_16x16x32_bf16(vf[1][s], kf, a1, 0, 0, 0);
      }
      act_t* up = p.gU + ((size_t)unit * 128 + 16 * ct + i15) * 256 + 32 * wave + 4 * g4;
      u32x2 w0; w0.x = pk2(a0.x, a0.y); w0.y = pk2(a0.z, a0.w);
      u32x2 w1; w1.x = pk2(a1.x, a1.y); w1.y = pk2(a1.z, a1.w);
      *(u32x2*)up = w0; *(u32x2*)(up + 16) = w1;
    }
  }
  __syncthreads();
  GSTAMP(5);
}

DEV void gla_scan(const Params& p, long long tid, long long nthr) {
  for (long long idx = tid; idx < 32LL * 128 * 32; idx += nthr) {
    const int v8 = (int)(idx & 31) * 8, c = (int)((idx >> 5) & 127), bh = (int)(idx >> 12);
    float s[8];
#pragma unroll
    for (int i = 0; i < 8; ++i) s[i] = 0.f;
#pragma unroll 8
    for (int ci = 0; ci < 32; ++ci) {
      const size_t unit = (size_t)bh * 32 + ci;
      const u32x4 uw = *(const u32x4*)(p.gU + (unit * 128 + c) * 256 + v8);
      const float d = p.gD[unit * 128 + c];
      u32x4 o;
#pragma unroll
      for (int i = 0; i < 4; ++i) o[i] = pk2(s[2 * i], s[2 * i + 1]);
      *(u32x4*)(p.gS + (unit * 128 + c) * 256 + v8) = o;
#pragma unroll
      for (int i = 0; i < 4; ++i) {
        s[2 * i] = s[2 * i] * d + __uint_as_float(uw[i] << 16);
        s[2 * i + 1] = s[2 * i + 1] * d + __uint_as_float(uw[i] & 0xffff0000u);
      }
    }
  }
}

DEV void gla_c_unit(const Params& p, int li, LAS unsigned char* lds, int t32, int unit) {
  const int lane = t32 & 63, wave = t32 >> 6, i15 = lane & 15, g4 = lane >> 4;
  const int bh = unit >> 5, ci = unit & 31, b = bh >> 2, h = bh & 3;
  const size_t n0 = (size_t)b * SEQ + ci * 64;
#pragma unroll
  for (int x = 0; x < 8; ++x) {
    const int idx = t32 + 512 * x, row = idx >> 5, ch = idx & 31;
    *(LAS u32x4*)(lds + GC_SP + row * GA_VS + ch * 16) = *(const u32x4*)(p.gS + ((size_t)unit * 128 + row) * 256 + ch * 8);
  }
#pragma unroll
  for (int x = 0; x < 2; ++x) {
    const int idx = t32 + 512 * x, row = idx >> 4, ch = idx & 15;
    *(LAS u32x4*)(lds + GC_QT + row * GA_QS + ch * 16) = *(const u32x4*)(p.gQ + ((size_t)unit * 64 + row) * 128 + ch * 8);
  }
  __syncthreads();
  const int it = wave & 3, vt0 = (wave >> 2) * 8;
  bf16x8 qf[4];
#pragma unroll
  for (int kk = 0; kk < 4; ++kk) qf[kk] = *(const LAS bf16x8*)(lds + GC_QT + (16 * it + i15) * GA_QS + (32 * kk + 8 * g4) * 2);
  const size_t n = n0 + 16 * it + i15;
  f32x4 o[8];
  float ss = 0.f;
#pragma unroll
  for (int x = 0; x < 8; ++x) {
    const int vt = vt0 + x;
    f32x4 a = *(const f32x4*)(p.opart + n * 1024 + h * 256 + 16 * vt + 4 * g4);
#pragma unroll
    for (int kk = 0; kk < 4; ++kk) {
      const LAS unsigned char* sp = lds + GC_SP + (32 * kk + 8 * g4 + (i15 >> 2)) * GA_VS + (16 * vt + 4 * (lane & 3)) * 2;
      const v4i16_t lo = tr_read(sp), hi = tr_read(sp + 4 * GA_VS);
      bf16x8 sf;
      sf[0] = lo[0]; sf[1] = lo[1]; sf[2] = lo[2]; sf[3] = lo[3]; sf[4] = hi[0]; sf[5] = hi[1]; sf[6] = hi[2]; sf[7] = hi[3];
      a = __builtin_amdgcn_mfma_f32_16x16x32_bf16(sf, qf[kk], a, 0, 0, 0);
    }
    o[x] = a;
    ss += (a.x * a.x + a.y * a.y) + (a.z * a.z + a.w * a.w);
  }
  ss += shx(ss, lane, 16);
  ss += shx(ss, lane, 32);
  LAS float* RED = (LAS float*)(lds + GC_RED);
  if (g4 == 0) RED[wave * 16 + i15] = ss;
  __syncthreads();
  ss += RED[(wave ^ 4) * 16 + i15];
  const float rs = 1.0f / sqrtf(ss * (1.0f / 256.0f) + LN_EPS);
#pragma unroll
  for (int x = 0; x < 8; ++x) {
    const int v = 16 * (vt0 + x) + 4 * g4;
    const f32x4 gn = *(const f32x4*)(p.gla_norm_g + li * DV + v);
    const u32x2 rw = *(const u32x2*)(p.u + n * N_IN + OFF_BR + h * 256 + v);
    const float r0 = __uint_as_float(rw.x << 16), r1 = __uint_as_float(rw.x & 0xffff0000u), r2 = __uint_as_float(rw.y << 16), r3 = __uint_as_float(rw.y & 0xffff0000u);
    u32x2 w;
    w.x = pk2(o[x].x * rs * gn.x * (r0 * fsig(r0)), o[x].y * rs * gn.y * (r1 * fsig(r1)));
    w.y = pk2(o[x].z * rs * gn.z * (r2 * fsig(r2)), o[x].w * rs * gn.w * (r3 * fsig(r3)));
    *(u32x2*)(p.yb + n * YLD + h * 256 + v) = w;
  }
  __syncthreads();
}

#define XB_TMO      128
#define XB_XCNT(j)  (256  + 64 * (j))
#define XB_XSUB(j)  (1280 + 64 * (j))
#define XB_XGEN(j)  (2304 + 64 * (j))
#define XB_TOP      3328
#define XB_TOPGEN   3392
#define XCD_BAR_WORDS 3456
#define XB_SPIN_CAP (1u << 18)

__device__ __forceinline__ unsigned xb_ld(unsigned* p)              { return __hip_atomic_load(p, __ATOMIC_RELAXED, __HIP_MEMORY_SCOPE_AGENT); }
__device__ __forceinline__ unsigned xb_add(unsigned* p, unsigned v) { return __hip_atomic_fetch_add(p, v, __ATOMIC_RELAXED, __HIP_MEMORY_SCOPE_AGENT); }
__device__ __forceinline__ unsigned xb_xcc_id() { return (unsigned)__builtin_amdgcn_s_getreg((3 << 11) | 20) & 0xFu; }
#define XB_SPIN(cond, bar) do { unsigned _sp = 0; while (cond) { __builtin_amdgcn_s_sleep(1); \
    if ((++_sp & 255u) == 0u) { if (xb_ld(&(bar)[XB_TMO])) break; if (_sp > XB_SPIN_CAP) { atomicAdd(&(bar)[XB_TMO], 1u); break; } } } } while (0)

struct XcdBarrier {
    unsigned* bar; unsigned x;
    volatile LAS unsigned* st;
};

__device__ __forceinline__ XcdBarrier xcd_barrier_post(unsigned* bar, volatile LAS unsigned* st) {
    XcdBarrier b; b.bar = bar; b.x = xb_xcc_id(); b.st = st;
    if (threadIdx.x == 0) st[2] = xb_add(&bar[XB_XCNT(b.x)], 1u);
    return b;
}
__device__ __forceinline__ void xcd_barrier_complete(unsigned* bar, unsigned x, unsigned& nloc, unsigned& nx) {
    const unsigned G = gridDim.x * gridDim.y * gridDim.z;
    unsigned sum, cnt, mine, sp = 0u;
    for (;;) {
        sum = 0u; cnt = 0u; mine = 0u;
#pragma unroll
        for (unsigned j = 0; j < 16; ++j) { const unsigned c = xb_ld(&bar[XB_XCNT(j)]); sum += c; cnt += (c > 0u) ? 1u : 0u; mine = (j == x) ? c : mine; }
        if (sum == G) break;
        __builtin_amdgcn_s_sleep(1);
        if ((++sp & 255u) == 0u) { if (xb_ld(&bar[XB_TMO])) break; if (sp > XB_SPIN_CAP) { atomicAdd(&bar[XB_TMO], 1u); break; } }
    }
    nloc = mine > 0u ? mine : 1u; nx = cnt > 0u ? cnt : 1u;
}

__device__ __forceinline__ void xcd_barrier(const XcdBarrier& b, const int t32) {
    asm volatile("s_waitcnt vmcnt(0)" ::: "memory");
    __syncthreads();
    if (t32 == 0) {
        unsigned* bar = b.bar;
        __builtin_amdgcn_s_waitcnt(0);
        unsigned nloc = b.st[0], nx = b.st[1];
        if (nloc == 0u) { xcd_barrier_complete(bar, b.x, nloc, nx); b.st[0] = nloc; b.st[1] = nx; }
        const unsigned old = xb_add(&bar[XB_XSUB(b.x)], 1u);
        const unsigned gen = old / nloc;
        if (old + 1u == (gen + 1u) * nloc) {
            __builtin_amdgcn_fence(__ATOMIC_RELEASE, "agent");
            asm volatile("s_waitcnt vmcnt(0)" ::: "memory");
            const unsigned og = xb_add(&bar[XB_TOP], 1u);
            const unsigned tg = og / nx;
            if (og + 1u == (tg + 1u) * nx) xb_add(&bar[XB_TOPGEN], 1u);
            else XB_SPIN(xb_ld(&bar[XB_TOPGEN]) == tg, bar);
            __builtin_amdgcn_fence(__ATOMIC_ACQUIRE, "agent");
            xb_add(&bar[XB_XGEN(b.x)], 1u);
            asm volatile("s_waitcnt vmcnt(0)" ::: "memory");
        } else {
            XB_SPIN(xb_ld(&bar[XB_XGEN(b.x)]) == gen, bar);
            __builtin_amdgcn_fence(__ATOMIC_ACQUIRE, "agent");
            asm volatile("s_waitcnt vmcnt(0)" ::: "memory");
        }
    }
    __syncthreads();
}

constexpr int STEPS_PER_LAYER = 21;
#ifndef PROBE_LO
#define PROBE_LO -1
#define PROBE_HI -1
#endif
#ifndef PROBE_PRO
#define PROBE_PRO 0
#endif
#ifndef TSTEP_LO
#define TSTEP_LO -2
#define TSTEP_HI -2
#endif
#ifndef TSUB
#define TSUB -9
#endif
#ifndef TSTEP_Q
#define TSTEP_Q 40u
#endif
#ifndef NSA_PROBE
#define NSA_PROBE 0
#endif
#ifndef MULTI_LAUNCH
#define MULTI_LAUNCH 0
#endif
DEV int fresh_t32(int wave) {
  int t;
  asm volatile("v_mbcnt_lo_u32_b32 %0, -1, 0\n\tv_mbcnt_hi_u32_b32 %0, -1, %0" : "=v"(t));
  return t + wave * 64;
}
struct KArgs { void* in[35]; void* out; void* ws; };
template <bool WITH_NAIVE, bool COOP>
__global__ void __launch_bounds__(NTHREADS) k_mega(KArgs ka, int step_lo, int step_hi) {
  unsigned* const barw0 = ((unsigned*)ka.ws);
  extern __shared__ __attribute__((aligned(16))) unsigned char lds_raw[];
  LAS unsigned char* lds = (LAS unsigned char*)lds_raw;
  LAS int* tab = (LAS int*)(lds + MISC_OFF);
  const int wave = __builtin_amdgcn_readfirstlane(threadIdx.x >> 6);
  const int G = gridDim.x;
  int bid = blockIdx.x;

  LAS unsigned* miscw = (LAS unsigned*)(lds + MISC_OFF + 8192);
  if (threadIdx.x < 128) miscw[threadIdx.x] = 0u;
  __syncthreads();
  XcdBarrier xbar; xbar.bar = barw0; xbar.x = 0; xbar.st = nullptr;
  if (COOP) xbar = xcd_barrier_post(barw0, miscw + 8);
  unsigned* const stamp = barw0 + 3584;
  if (step_lo < 0) {
    Params p;
    fill_params(p, ka.in, ka.out, ka.ws);
    if (TSTEP_LO == -1 && blockIdx.x == 0 && threadIdx.x == 0) { stamp[0] = (unsigned)__builtin_amdgcn_s_memrealtime(); stamp[2] = 0u; stamp[3] = 0u; }
    prologue(p, lds, wave, threadIdx.x & 63);
    if (COOP) {
      if (step_hi == -12345) cg::this_grid().sync();
      xcd_barrier(xbar, (int)threadIdx.x);
    }
#if PROBE_PRO
    prologue(p, lds, wave, threadIdx.x & 63);
    if (COOP) cg::this_grid().sync();
#endif
    step_lo = 0;
    if (TSTEP_LO == -1 && blockIdx.x == 0 && threadIdx.x == 0) stamp[1] = (unsigned)__builtin_amdgcn_s_memrealtime();
    if (COOP) {
      bool even = (G % 8) == 0;
#pragma unroll
      for (int j = 0; j < 8; ++j) even = even && (xb_ld(&barw0[XB_XCNT(j)]) == (unsigned)(G / 8));
      __syncthreads();
      if (even) bid = __builtin_amdgcn_readfirstlane((int)(xbar.x + 8u * miscw[10]));
    }
  }
  int rep_done = 0;
  for (int step = step_lo; step < step_hi;) {
    int li = step / STEPS_PER_LAYER;
    const int k = step % STEPS_PER_LAYER;
    int nb32 = gridDim.x;
    char* wsb = (char*)ka.ws;
    asm volatile("" : "+s"(wsb));
    Params p;
    fill_params(p, ka.in, ka.out, wsb);
    asm volatile("" : "+s"(li));
    asm volatile("" : "+s"(nb32));
#define T32() fresh_t32(wave)
#define TID() ((int)(blockIdx.x * NTHREADS) + T32())
    const int nthr = nb32 * NTHREADS;
    const int gw = blockIdx.x * 8 + wave, NGW = nb32 * 8;
    if (TSTEP_LO >= 0 && k == TSTEP_LO && blockIdx.x == 0 && wave == 0) stamp[2 * li] = (unsigned)__builtin_amdgcn_s_memrealtime();
    const bool is_gemm = (k == 0) || (k >= 2 && k <= 5) || (k == 9) || (k == 10) || (k == 12) || (k == 14) || (k == 18) || (k == 19);
    const bool sync_after = !(k == 2 || k == 3 || k == 4);
    if (is_gemm) {
      pg8::Gemm g{nullptr, nullptr, 0, 0, 0};
      USched S; S.init_static(256, 256, G, bid);
      EpiU E{0, 0, nullptr, nullptr, nullptr, nullptr, nullptr};
      const size_t WSQ = (size_t)1024 * 1024;
      switch (k) {
        case 0:
          g = pg8::Gemm{p.xb, p.wt_in + (size_t)li * N_IN_PAD * 1024, N_TOK, N_IN_PAD, 1024};
          S.init_static(N_TOK, N_IN_PAD, G, bid);
          E.mode = EM_INPROJ; E.q0 = p.u; E.q1 = p.b_in + (size_t)li * N_IN; break;
        case 2:
          g = pg8::Gemm{p.cmpA, p.wt_c1 + (size_t)(li * 2 + 0) * 256 * 2048, CMP_ROWS_PAD, 256, 2048};
          S.init_static(CMP_ROWS_PAD, 256, G, bid);
          E.mode = EM_HID; E.q0 = p.hid; break;
        case 3:
          g = pg8::Gemm{p.cmpA + (size_t)CMP_ROWS_PAD * 2048, p.wt_c1 + (size_t)(li * 2 + 1) * 256 * 2048, CMP_ROWS_PAD, 256, 2048};
          S.init_static(CMP_ROWS_PAD, 256, G, (bid + G - 16) % G);
          E.mode = EM_HID; E.q0 = p.hid + (size_t)CMP_ROWS * CMP_HID; break;
        case 4:
          g = pg8::Gemm{p.membf, p.wt_xk + li * WSQ, BATCH * MEM_LEN, 1024, 1024};
          S.init_static(BATCH * MEM_LEN, 1024, G, (bid + G - 32) % G);
          E.mode = EM_BF16; E.q0 = p.memk; E.ldc = 1024; break;
        case 5:
          g = pg8::Gemm{p.membf, p.wt_xv + li * WSQ, BATCH * MEM_LEN, 1024, 1024};
          S.init_static(BATCH * MEM_LEN, 1024, G, (bid + G - 64) % G);
          E.mode = EM_BF16; E.q0 = p.memv; E.ldc = 1024; break;
        case 9:
          g = pg8::Gemm{p.ya, p.wt_bra + (size_t)li * 1024 * YLD, N_TOK, 1024, YLD};
          S.init_static(N_TOK, 1024, G, bid);
          E.mode = EM_BRCAT; E.q1 = p.u; E.q0 = p.merged; break;
        case 10:
          g = pg8::Gemm{p.merged, p.wt_omix + li * WSQ, N_TOK, 1024, 1024};
          S.init_static(N_TOK, 1024, G, bid);
          E.mode = EM_RES; E.q1 = p.xf; E.q0 = p.tmp; break;
        case 12:
          g = pg8::Gemm{p.xb, p.wt_xq + li * WSQ, N_TOK, 1024, 1024};
          S.init_static(N_TOK, 1024, G, bid);
          E.mode = EM_BF16; E.q0 = p.xq; E.ldc = 1024; break;
        case 14:
          g = pg8::Gemm{p.xo, p.wt_xo + li * WSQ, N_TOK, 1024, 1024};
          S.init_static(N_TOK, 1024, G, bid);
          E.mode = EM_RES; E.q1 = p.xf; E.q0 = p.tmp; break;
        case 18: {
          const int ntiles = moe_tables(p, li, tab, T32());
          g = pg8::Gemm{p.xg, p.wt_gu + (size_t)li * 32 * 2048 * 1024, MOE_ROWS, 32 * 2048, 1024};
          S.init_moe(G, bid, 8, ntiles * 8, tab + 128);
          E.mode = EM_MOE1; E.q0 = p.actg; E.q1 = p.b_gu + (size_t)li * 32 * 2048; E.te = tab + 128; break; }
        default: {
          const int ntiles = moe_tables(p, li, tab, T32());
          g = pg8::Gemm{p.actg, p.wt_dn + (size_t)li * 32 * 1024 * 1024, MOE_ROWS, 32 * 1024, 1024};
          S.init_moe(G, bid, 4, ntiles * 4, tab + 128);
          E.mode = EM_MOE2; E.q0 = p.yass; E.q1 = p.b_down + (size_t)li * 32 * 1024; E.q2 = p.topg; E.q3 = p.rowlist; E.te = tab + 128; break; }
      }
      pg8::gemm_phase<EpiU, USched, true, true>(lds, g, S, E, T32());
    } else {
      switch (k) {
        case 1: cmpa_build(p, li, TID(), nthr); break;
        case 6:
#define SUBSTAMP(i) do { if (TSUB == (i) && blockIdx.x == 0 && wave == 0) stamp[2 * li] = (unsigned)__builtin_amdgcn_s_memrealtime(); if (TSUB + 1 == (i) && blockIdx.x == 0 && wave == 0) stamp[2 * li + 1] = (unsigned)__builtin_amdgcn_s_memrealtime(); } while (0)
          SUBSTAMP(1);
          { const int t = T32(); for (int un = bid; un < 1024; un += G) gla_a_unit(p, li, lds, t, un); }
          SUBSTAMP(2);
          dil_phase(p, lds, T32(), bid, G);
          SUBSTAMP(3);
          kcv_phase(p, li, lds, T32(), bid, G);
          SUBSTAMP(4);
          break;
        case 7: SUBSTAMP(8); gla_scan(p, TID(), nthr); SUBSTAMP(9); nsa_cmp_phase(p, lds, T32(), bid, G); SUBSTAMP(10); dil_combine(p, TID(), nthr); SUBSTAMP(11); break;
        case 8: {
          SUBSTAMP(5);
          nsa_main_phase(p, lds, T32(), bid, G);
          __syncthreads();
          SUBSTAMP(6);
          const int t = T32();
          for (int un = bid; un < 1024; un += G) gla_c_unit(p, li, lds, t, un);
          SUBSTAMP(7);
          break; }
        case 11: ln_rows_w<0>(p, p.tmp, p.ln1_g + li * D, p.ln1_b + li * D, p.xf, p.xb, nullptr, gw, NGW, T32() & 63); break;
        case 13: xattn_phase(p, lds, T32(), bid, G); break;
        case 15: ln_rows_w<0>(p, p.tmp, p.ln2_g + li * D, p.ln2_b + li * D, p.xf, p.xb, nullptr, gw, NGW, T32() & 63); break;
        case 16: route_phase(p, li, lds, T32(), bid, G); break;
        case 17: { const int t = T32(); moe_prep(p, li, tab, wave, t & 63, t); break; }
        case 20: ln_rows_w<1>(p, nullptr, p.ln3_g + li * D, p.ln3_b + li * D, p.xf, p.xb, li == DEPTH - 1 ? p.out : nullptr, gw, NGW, T32() & 63); break;
        default: break;
      }
    }
    if (COOP && sync_after) xcd_barrier(xbar, T32());
    if (TSTEP_LO >= 0 && k == TSTEP_HI && blockIdx.x == 0 && wave == 0) stamp[2 * li + 1] = (unsigned)__builtin_amdgcn_s_memrealtime();
    if (PROBE_HI >= 0 && k == PROBE_HI && !rep_done) { rep_done = 1; step -= (PROBE_HI - PROBE_LO); }
    else { if (k == PROBE_HI) rep_done = 0; ++step; }
  }
  if (GSEG >= 0 && blockIdx.x == 0 && fresh_t32(wave) == 0) {
    __builtin_amdgcn_s_waitcnt(0);
    const unsigned tk = __hip_atomic_load(barw0 + 3600, __ATOMIC_RELAXED, __HIP_MEMORY_SCOPE_AGENT);
    ((float*)ka.out)[0] = (float)((tk / 100u + TSTEP_Q / 2) / TSTEP_Q * TSTEP_Q);
  }
  if (TSTEP_LO >= -1 && blockIdx.x == 0 && fresh_t32(wave) == 0) {
    __builtin_amdgcn_s_waitcnt(0);
    const unsigned tk = (__hip_atomic_load(stamp + 1, __ATOMIC_RELAXED, __HIP_MEMORY_SCOPE_AGENT) - __hip_atomic_load(stamp + 0, __ATOMIC_RELAXED, __HIP_MEMORY_SCOPE_AGENT)) + (__hip_atomic_load(stamp + 3, __ATOMIC_RELAXED, __HIP_MEMORY_SCOPE_AGENT) - __hip_atomic_load(stamp + 2, __ATOMIC_RELAXED, __HIP_MEMORY_SCOPE_AGENT));
    ((float*)ka.out)[0] = (float)((tk / 100u + TSTEP_Q / 2) / TSTEP_Q * TSTEP_Q);
  }
}

extern "C" void kernel_launch(void* const* d_in, const int* in_sizes, int n_in, void* d_out, int out_size,
                              void* d_ws, size_t ws_size, hipStream_t stream) {
  Params p;
  memset(&p, 0, sizeof(p));
  fill_params(p, d_in, d_out, d_ws);
  KArgs ka;
  memset(&ka, 0, sizeof(ka));
  for (int i = 0; i < 35; ++i) ka.in[i] = d_in[i];
  ka.out = d_out; ka.ws = d_ws;
  static int grid_blocks = 0;
  if (!grid_blocks) {
    int dev = 0, cus = 0;
    hipGetDevice(&dev);
    hipDeviceGetAttribute(&cus, hipDeviceAttributeMultiprocessorCount, dev);
    hipFuncSetAttribute((const void*)k_mega<true, true>, hipFuncAttributeMaxDynamicSharedMemorySize, LDS_BYTES);
    if (p.ws_used > ws_size) fprintf(stderr, "workspace too small: need %zu have %zu\n", p.ws_used, ws_size);
    grid_blocks = cus;
  }
  hipMemsetAsync(p.barw, 0, 4096 * sizeof(unsigned), stream);
  int lo = -1, hi = DEPTH * STEPS_PER_LAYER;
  void* args[] = {&ka, &lo, &hi};
  hipError_t e = hipLaunchCooperativeKernel((void*)k_mega<true, true>, dim3(grid_blocks), dim3(NTHREADS), args, LDS_BYTES, stream);
  if (e != hipSuccess) fprintf(stderr, "cooperative launch failed: %s (grid %d)\n", hipGetErrorString(e), grid_blocks);
}
#endif
```

```cpp
#ifndef CPU_TEST
#include <hip/hip_runtime.h>
#include <hip/hip_cooperative_groups.h>
#include <cstdio>
#include <cstring>
#include <cmath>
namespace cg = cooperative_groups;
#define DEV __device__ __forceinline__
#define HDI __host__ __device__ __forceinline__
#else
#include <cmath>
#include <cstdio>
#include <cstdlib>
#include <cstring>
#define DEV static inline
#define HDI static inline
#endif

#ifndef D_MODEL
#define D_MODEL 1024
#endif
#ifndef BATCH
#define BATCH 8
#endif
#ifndef MEGA
#define MEGA 1
#endif

constexpr int D = D_MODEL;
constexpr int SEQ = 2048;
constexpr int DEPTH = 2;
constexpr int MEM_LEN = 256;
constexpr int HD = 64;
constexpr int N_TOK = BATCH * SEQ;
constexpr int GLA_H = 4;
constexpr int DK = D / 2 / GLA_H;
constexpr int DV = D / GLA_H;
constexpr int GLA_RANK = 16;
constexpr int B_K = GLA_H * DK;
constexpr int B_V = GLA_H * DV;
constexpr int NSA_H = 16;
constexpr int NSA_G = 4;
constexpr int N_CMP = 127;
constexpr int CMP_HID = 128;
constexpr int N_BLK = 32;
constexpr int N_SELECT = 16;
constexpr int NSA_WIN = 512;
constexpr int XH = 4;
constexpr int XHD = D / XH;
constexpr int NE = 32;
constexpr int TOPK = 4;
constexpr int DFF = D;
constexpr float LN_EPS = 1e-5f;
constexpr float ALPHA = 1.41421356237309515f;

constexpr int OFF_AQ = 0;
constexpr int OFF_AK = 768;
constexpr int OFF_AV = 1536;
constexpr int OFF_BQ = 2304;
constexpr int OFF_BK = OFF_BQ + B_K;
constexpr int OFF_BV = OFF_BK + B_K;
constexpr int OFF_BR = OFF_BV + B_V;
constexpr int OFF_LR = OFF_BR + B_V;
constexpr int OFF_CQ = OFF_LR + GLA_RANK;
constexpr int OFF_CKC = OFF_CQ + 1024;
constexpr int OFF_CVC = OFF_CKC + 256;
constexpr int OFF_CKS = OFF_CVC + 256;
constexpr int OFF_CVS = OFF_CKS + 256;
constexpr int OFF_CKW = OFF_CVS + 256;
constexpr int OFF_CVW = OFF_CKW + 256;
constexpr int OFF_CG = OFF_CVW + 256;
constexpr int OFF_MG = OFF_CG + 48;
constexpr int N_IN = OFF_MG + 3 * D;
constexpr int N_IN_PAD = (N_IN + 255) / 256 * 256;
constexpr int MOE_ROWS = N_TOK * 4 + 32 * 256;
constexpr int CMP_ROWS_PAD = 4096;
constexpr int YLD = 256 + 1024 + 1024;

#ifdef CPU_TEST
typedef float act_t;
DEV float ldf(float v) { return v; }
DEV void stf(float* p, float v) { *p = v; }
#else
typedef unsigned short act_t;
DEV float ldf(unsigned short h) { return __uint_as_float(((unsigned)h) << 16); }
DEV float ldf(float v) { return v; }
DEV unsigned short f2bf(float f) {
  unsigned u = __float_as_uint(f);
  u += 0x7fffu + ((u >> 16) & 1u);
  return (unsigned short)(u >> 16);
}
DEV void stf(unsigned short* p, float v) { *p = f2bf(v); }
DEV void stf(float* p, float v) { *p = v; }
#endif

struct Params {
  const float *x, *mem, *ln0_g, *ln0_b, *w_in, *b_in, *w_alpha2, *b_alpha, *gla_norm_g,
      *cmp_pe_k, *cmp_w1_k, *cmp_w2_k, *cmp_pe_v, *cmp_w1_v, *cmp_w2_v,
      *w_br_a, *w_br_b, *w_br_c, *w_o_mix, *ln1_g, *ln1_b, *w_xq, *w_xk, *w_xv, *w_xo, *ln2_g, *ln2_b,
      *w_router, *b_router, *w_gu, *b_gu, *w_down, *b_down, *ln3_g, *ln3_b;
  float* out;
  float* xf;
  act_t* xb;
  act_t* u;
  float* ga;
  float* hid;
  float* kcv;
  float* opart;
  act_t* ya;
  act_t* yb;
  act_t* yc;
  float* pcmp;
  float* ocmp;
  float* impb;
  int* selb;
  act_t* merged;
  float* tmp;
  act_t* xq;
  act_t* memk;
  act_t* memv;
  float* xs;
  act_t* xo;
  float* rl;
  int* topi;
  float* topg;
  act_t* act;
  act_t* wt_in;
  act_t* wt_c1;
  act_t* wt_bra;
  act_t* wt_brb;
  act_t* wt_brc;
  act_t* wt_omix;
  act_t* wt_xq;
  act_t* wt_xk;
  act_t* wt_xv;
  act_t* wt_xo;
  act_t* wt_gu;
  act_t* wt_dn;
  act_t* membf;
  act_t* cmpA;
  float* mrg;
  int* cnt;
  int* rank;
  int* rowlist;
  act_t* xg;
  act_t* actg;
  float* yass;
  act_t* kcb;
  act_t* dilo;
  float* dill;
  unsigned* selm;
  act_t* gU;
  act_t* gS;
  act_t* gQ;
  float* gD;
  unsigned* barw;
  size_t ws_used;
};

#ifdef CPU_TEST
#define FOR_IDX(idx, total) \
  for (long long idx = (long long)(total) * tid / nthr, _e = (long long)(total) * (tid + 1) / nthr; idx < _e; ++idx)
#else
#define FOR_IDX(idx, total) for (long long idx = tid; idx < (long long)(total); idx += nthr)
#endif

DEV float sigmoidf_(float x) { return 1.0f / (1.0f + expf(-x)); }

template <class TA>
DEV float dotcol(const TA* a, const float* W, int K, long long ldw) {
  float s = 0.f;
  for (int k = 0; k < K; ++k) s += ldf(a[k]) * W[(long long)k * ldw];
  return s;
}

DEV void ph_ln(const float* src, const float* g, const float* b, float* dstf, act_t* dstb, float* dst2,
               long long tid, long long nthr) {
  FOR_IDX(n, N_TOK) {
    const float* r = src + n * D;
    float mu = 0.f;
    for (int i = 0; i < D; ++i) mu += r[i];
    mu /= D;
    float var = 0.f;
    for (int i = 0; i < D; ++i) { float d = r[i] - mu; var += d * d; }
    var /= D;
    float rs = 1.0f / sqrtf(var + LN_EPS);
    for (int i = 0; i < D; ++i) {
      float y = (r[i] - mu) * rs * g[i] + b[i];
      dstf[n * D + i] = y;
      stf(&dstb[n * D + i], y);
      if (dst2) dst2[n * D + i] = y;
    }
  }
}

DEV void ph_inproj(const Params& p, int li, long long tid, long long nthr) {
  const float* W = p.w_in + (long long)li * D * N_IN;
  const float* bias = p.b_in + (long long)li * N_IN;
  FOR_IDX(idx, (long long)N_TOK * N_IN) {
    long long n = idx / N_IN; int c = (int)(idx % N_IN);
    stf(&p.u[idx], dotcol(p.xb + n * D, W + c, D, N_IN) + bias[c]);
  }
}

DEV float gelu_tanh(float x) {
  return 0.5f * x * (1.0f + tanhf(0.7978845608028654f * (x + 0.044715f * x * x * x)));
}

constexpr int CMP_ROWS = BATCH * N_CMP * NSA_G;

template <int PARTS>
DEV void ph_pre(const Params& p, int li, long long tid, long long nthr) {
  const long long T1 = (long long)N_TOK * B_K;
  const long long T2 = (PARTS & 2) ? 2LL * CMP_ROWS * CMP_HID : 0;
  FOR_IDX(idx, T1 + T2) {
    if (idx < T1) {
      if (!(PARTS & 1)) continue;
      long long n = idx / B_K; int c = (int)(idx % B_K);
      const float* W2 = p.w_alpha2 + (long long)li * GLA_RANK * B_K;
      float z = p.b_alpha[li * B_K + c];
      for (int r = 0; r < GLA_RANK; ++r) z += ldf(p.u[n * N_IN + OFF_LR + r]) * W2[r * B_K + c];
      float ls = fminf(z, 0.f) - log1pf(expf(-fabsf(z)));
      p.ga[idx] = expf(ls * (1.0f / 16.0f));
    } else {
      long long i2 = idx - T1;
      int which = (int)(i2 / ((long long)CMP_ROWS * CMP_HID));
      long long rem = i2 % ((long long)CMP_ROWS * CMP_HID);
      int row = (int)(rem / CMP_HID), j = (int)(rem % CMP_HID);
      int g = row % NSA_G; int c = (row / NSA_G) % N_CMP; int b = row / (NSA_G * N_CMP);
      const float* pe = (which ? p.cmp_pe_v : p.cmp_pe_k) + (long long)li * 32 * HD;
      const float* w1 = (which ? p.cmp_w1_v : p.cmp_w1_k) + (long long)li * 32 * HD * CMP_HID;
      int off = (which ? OFF_CVC : OFF_CKC) + g * HD;
      float s = 0.f;
      for (int l = 0; l < 32; ++l) {
        const act_t* ur = p.u + ((long long)b * SEQ + c * 16 + l) * N_IN + off;
        for (int d = 0; d < HD; ++d) s += (ldf(ur[d]) + pe[l * HD + d]) * w1[(long long)(l * HD + d) * CMP_HID + j];
      }
      p.hid[i2] = gelu_tanh(s);
    }
  }
}

template <int PARTS>
DEV void ph_mix1(const Params& p, int li, long long tid, long long nthr) {
  const long long T1 = (long long)N_TOK * 4;
  const long long T2 = (long long)BATCH * GLA_H * DV * 4;
  const long long T3 = 2LL * CMP_ROWS * HD;
  FOR_IDX(idx, T1 + T2 + T3) {
    if (idx < T1) {
      if (!(PARTS & 1)) continue;
      long long n = idx / 4; int h = (int)(idx % 4);
      int b = (int)(n / SEQ), t = (int)(n % SEQ);
      float m = -INFINITY, l = 0.f;
      float acc[HD];
#pragma unroll
      for (int d = 0; d < HD; ++d) acc[d] = 0.f;
      for (int gi = 0; gi < 3; ++gi) {
        const int dil = gi == 0 ? 1 : (gi == 1 ? 4 : 16);
        float q[HD];
        const act_t* qp = p.u + n * N_IN + OFF_AQ + gi * 256 + h * HD;
#pragma unroll
        for (int d = 0; d < HD; ++d) q[d] = ldf(qp[d]);
        for (int mm = 0; mm <= 128; ++mm) {
          int tk = t - mm * dil;
          if (tk < 0) break;
          const act_t* kp = p.u + ((long long)b * SEQ + tk) * N_IN + OFF_AK + gi * 256 + h * HD;
          const act_t* vp = p.u + ((long long)b * SEQ + tk) * N_IN + OFF_AV + gi * 256 + h * HD;
          float s = 0.f;
#pragma unroll
          for (int d = 0; d < HD; ++d) s += q[d] * ldf(kp[d]);
          s *= 0.125f;
          float mn = fmaxf(m, s);
          float corr = expf(m - mn);
          float pp = expf(s - mn);
          l = l * corr + pp;
#pragma unroll
          for (int d = 0; d < HD; ++d) acc[d] = acc[d] * corr + pp * ldf(vp[d]);
          m = mn;
        }
      }
      float inv = 1.0f / l;
#pragma unroll
      for (int d = 0; d < HD; ++d) stf(&p.ya[n * 256 + h * HD + d], acc[d] * inv);
    } else if (idx < T1 + T2) {
      if (!(PARTS & 2)) continue;
      long long i2 = idx - T1;
      int v = (int)(i2 % DV); int cq = (int)((i2 / DV) % 4); int h = (int)((i2 / (DV * 4)) % GLA_H);
      int b = (int)(i2 / (DV * 4 * GLA_H));
      constexpr int DKQ = DK / 4;
      float st[DKQ];
#pragma unroll
      for (int c = 0; c < DKQ; ++c) st[c] = 0.f;
      const float qs = 1.0f / sqrtf((float)DK);
      for (int t = 0; t < SEQ; ++t) {
        long long n = (long long)b * SEQ + t;
        const act_t* ur = p.u + n * N_IN;
        float vt = ldf(ur[OFF_BV + h * DV + v]);
        const float* gar = p.ga + n * B_K + h * DK + cq * DKQ;
        const act_t* kr = ur + OFF_BK + h * DK + cq * DKQ;
        const act_t* qr = ur + OFF_BQ + h * DK + cq * DKQ;
        float o = 0.f;
#pragma unroll
        for (int c = 0; c < DKQ; ++c) {
          st[c] = gar[c] * st[c] + ldf(kr[c]) * vt;
          o += ldf(qr[c]) * st[c];
        }
        p.opart[((long long)cq * N_TOK + n) * B_V + h * DV + v] = o * qs;
      }
    } else {
      long long i2 = idx - T1 - T2;
      int which = (int)(i2 / ((long long)CMP_ROWS * HD));
      long long rem = i2 % ((long long)CMP_ROWS * HD);
      int row = (int)(rem / HD), d = (int)(rem % HD);
      const float* w2 = (which ? p.cmp_w2_v : p.cmp_w2_k) + (long long)li * CMP_HID * HD;
      const float* hr = p.hid + ((long long)which * CMP_ROWS + row) * CMP_HID;
      float s = 0.f;
      if (!(PARTS & 4)) continue;
      for (int j = 0; j < CMP_HID; ++j) s += hr[j] * w2[j * HD + d];
      p.kcv[i2] = s;
#ifndef CPU_TEST
      {
        const int g_ = row % NSA_G, c_ = (row / NSA_G) % N_CMP, b_ = row / (NSA_G * N_CMP);
        stf(&p.kcb[((((size_t)which * BATCH + b_) * 128 + c_) * NSA_G + g_) * 64 + d], s);
      }
#endif
    }
  }
}

template <int PARTS>
DEV void ph_nsa1(const Params& p, int li, long long tid, long long nthr) {
  const long long T1 = (long long)N_TOK * GLA_H;
  const long long T2 = (PARTS & 2) ? (long long)N_TOK * NSA_H : 0;
  FOR_IDX(idx, T1 + T2) {
    if (idx < T1) {
      long long n = idx / GLA_H; int h = (int)(idx % GLA_H);
      float ss = 0.f;
      for (int v = 0; v < DV; ++v) {
        float o = 0.f;
        for (int cq = 0; cq < 4; ++cq) o += p.opart[((long long)cq * N_TOK + n) * B_V + h * DV + v];
        ss += o * o;
      }
      float rs = 1.0f / sqrtf(ss / DV + LN_EPS);
      for (int v = 0; v < DV; ++v) {
        float o = 0.f;
        for (int cq = 0; cq < 4; ++cq) o += p.opart[((long long)cq * N_TOK + n) * B_V + h * DV + v];
        float r = ldf(p.u[n * N_IN + OFF_BR + h * DV + v]);
        float y = o * rs * p.gla_norm_g[li * DV + v] * (r * sigmoidf_(r));
        stf(&p.yb[n * B_V + h * DV + v], y);
      }
    } else {
      long long i2 = idx - T1;
      long long n = i2 / NSA_H; int hh = (int)(i2 % NSA_H);
      int b = (int)(n / SEQ), t = (int)(n % SEQ);
      int g = hh / 4;
      int nv = t >= 31 ? (t - 31) / 16 + 1 : 0;
      if (nv > N_CMP) nv = N_CMP;
      float q[HD];
      const act_t* qp = p.u + n * N_IN + OFF_CQ + hh * HD;
#pragma unroll
      for (int d = 0; d < HD; ++d) q[d] = ldf(qp[d]);
      float* prow = p.pcmp + (((long long)b * NSA_H + hh) * SEQ + t) * 128;
      float m = -INFINITY;
      for (int c = 0; c < nv; ++c) {
        const float* kp = p.kcv + (((long long)b * N_CMP + c) * NSA_G + g) * HD;
        float s = 0.f;
#pragma unroll
        for (int d = 0; d < HD; ++d) s += q[d] * kp[d];
        s *= 0.125f;
        prow[c] = s;
        m = fmaxf(m, s);
      }
      float acc[HD];
#pragma unroll
      for (int d = 0; d < HD; ++d) acc[d] = 0.f;
      float l = 0.f;
      for (int c = 0; c < nv; ++c) {
        const float* vp = p.kcv + (((long long)CMP_ROWS) + ((long long)b * N_CMP + c) * NSA_G + g) * HD;
        float pp = expf(prow[c] - m);
        l += pp;
        prow[c] = pp;
#pragma unroll
        for (int d = 0; d < HD; ++d) acc[d] += pp * vp[d];
      }
      float inv = 1.0f / fmaxf(l, 1e-30f);
      for (int c = 0; c < 128; ++c) prow[c] = c < nv ? prow[c] * inv : 0.f;
#pragma unroll
      for (int d = 0; d < HD; ++d) p.ocmp[n * 1024 + hh * HD + d] = acc[d] * inv;
    }
  }
}

DEV void ph_nsa2(const Params& p, int li, long long tid, long long nthr) {
  FOR_IDX(idx, (long long)BATCH * NSA_G * SEQ * N_BLK) {
    int j = (int)(idx % N_BLK); long long r = idx / N_BLK;
    int s = (int)(r % SEQ); int g = (int)((r / SEQ) % NSA_G); int b = (int)(r / ((long long)SEQ * NSA_G));
    int qb = s / 64;
    float imp;
    if (j == 0 || j == qb || j == qb - 1) imp = INFINITY;
    else if (j > qb) imp = -INFINITY;
    else {
      imp = 0.f;
      int c0 = 4 * j - 1; if (c0 < 0) c0 = 0;
      int c1 = 4 * j + 3; if (c1 > N_CMP - 1) c1 = N_CMP - 1;
      for (int rr = 0; rr < 4; ++rr) {
        const float* prow = p.pcmp + (((long long)b * NSA_H + g * 4 + rr) * SEQ + s) * 128;
        for (int c = c0; c <= c1; ++c) imp += prow[c];
      }
    }
    p.impb[idx] = imp;
  }
}

DEV void ph_nsa3(const Params& p, int li, long long tid, long long nthr) {
  FOR_IDX(idx, (long long)BATCH * NSA_G * SEQ * N_BLK) {
    int j = (int)(idx % N_BLK); long long r = idx / N_BLK;
    const float* ir = p.impb + r * N_BLK;
    float v = ir[j];
    int rank = 0;
    for (int jj = 0; jj < N_BLK; ++jj) {
      float w = ir[jj];
      if (w > v || (w == v && jj < j)) ++rank;
    }
    p.selb[idx] = rank < N_SELECT ? 1 : 0;
  }
}

DEV void ph_nsa4(const Params& p, int li, long long tid, long long nthr) {
  FOR_IDX(idx, (long long)N_TOK * NSA_H) {
    long long n = idx / NSA_H; int hh = (int)(idx % NSA_H);
    int b = (int)(n / SEQ), t = (int)(n % SEQ);
    int g = hh / 4;
    float q[HD];
    const act_t* qp = p.u + n * N_IN + OFF_CQ + hh * HD;
#pragma unroll
    for (int d = 0; d < HD; ++d) q[d] = ldf(qp[d]);
    float g0 = sigmoidf_(ldf(p.u[n * N_IN + OFF_CG + hh * 3 + 0]));
    float g1 = sigmoidf_(ldf(p.u[n * N_IN + OFF_CG + hh * 3 + 1]));
    float g2 = sigmoidf_(ldf(p.u[n * N_IN + OFF_CG + hh * 3 + 2]));
    float acc[HD];
    {
      float m = -INFINITY, l = 0.f;
#pragma unroll
      for (int d = 0; d < HD; ++d) acc[d] = 0.f;
      int qb = t / 64;
      const int* sr = p.selb + (((long long)b * NSA_G + g) * SEQ + t) * N_BLK;
      for (int j = 0; j <= qb; ++j) {
        if (!sr[j]) continue;
        int hi = j * 64 + 63; if (hi > t) hi = t;
        for (int tk = j * 64; tk <= hi; ++tk) {
          const act_t* kp = p.u + ((long long)b * SEQ + tk) * N_IN + OFF_CKS + g * HD;
          const act_t* vp = p.u + ((long long)b * SEQ + tk) * N_IN + OFF_CVS + g * HD;
          float s = 0.f;
#pragma unroll
          for (int d = 0; d < HD; ++d) s += q[d] * ldf(kp[d]);
          s *= 0.125f;
          float mn = fmaxf(m, s);
          float corr = expf(m - mn);
          float pp = expf(s - mn);
          l = l * corr + pp;
#pragma unroll
          for (int d = 0; d < HD; ++d) acc[d] = acc[d] * corr + pp * ldf(vp[d]);
          m = mn;
        }
      }
      float inv = 1.0f / l;
#pragma unroll
      for (int d = 0; d < HD; ++d) {
        float* oc = &p.ocmp[n * 1024 + hh * HD + d];
        *oc = g0 * (*oc) + g1 * acc[d] * inv;
      }
    }
    {
      float m = -INFINITY, l = 0.f;
#pragma unroll
      for (int d = 0; d < HD; ++d) acc[d] = 0.f;
      int lo = t - (NSA_WIN - 1); if (lo < 0) lo = 0;
      for (int tk = lo; tk <= t; ++tk) {
        const act_t* kp = p.u + ((long long)b * SEQ + tk) * N_IN + OFF_CKW + g * HD;
        const act_t* vp = p.u + ((long long)b * SEQ + tk) * N_IN + OFF_CVW + g * HD;
        float s = 0.f;
#pragma unroll
        for (int d = 0; d < HD; ++d) s += q[d] * ldf(kp[d]);
        s *= 0.125f;
        float mn = fmaxf(m, s);
        float corr = expf(m - mn);
        float pp = expf(s - mn);
        l = l * corr + pp;
#pragma unroll
        for (int d = 0; d < HD; ++d) acc[d] = acc[d] * corr + pp * ldf(vp[d]);
        m = mn;
      }
      float inv = 1.0f / l;
#pragma unroll
      for (int d = 0; d < HD; ++d)
        stf(&p.yc[n * 1024 + hh * HD + d], p.ocmp[n * 1024 + hh * HD + d] + g2 * acc[d] * inv);
    }
  }
}

DEV void ph_br(const Params& p, int li, long long tid, long long nthr) {
  const float* Wa = p.w_br_a + (long long)li * 256 * D;
  const float* Wb = p.w_br_b + (long long)li * B_V * D;
  const float* Wc = p.w_br_c + (long long)li * 1024 * D;
  FOR_IDX(idx, (long long)N_TOK * D) {
    long long n = idx / D; int d = (int)(idx % D);
    float s0 = dotcol(p.ya + n * 256, Wa + d, 256, D);
    float s1 = dotcol(p.yb + n * B_V, Wb + d, B_V, D);
    float s2 = dotcol(p.yc + n * 1024, Wc + d, 1024, D);
    const act_t* mg = p.u + n * N_IN + OFF_MG;
    float y = sigmoidf_(ldf(mg[d])) * s0 + sigmoidf_(ldf(mg[D + d])) * s1 + sigmoidf_(ldf(mg[2 * D + d])) * s2;
    stf(&p.merged[idx], y);
  }
}

DEV void ph_proj_res(const Params& p, const act_t* a, const float* W, long long tid, long long nthr) {
  FOR_IDX(idx, (long long)N_TOK * D) {
    long long n = idx / D; int d = (int)(idx % D);
    p.tmp[idx] = ALPHA * p.xf[idx] + dotcol(a + n * D, W + d, D, D);
  }
}

DEV void ph_xq(const Params& p, int li, long long tid, long long nthr) {
  const long long T1 = (long long)N_TOK * D;
  const long long T2 = 2LL * BATCH * MEM_LEN * D;
  const float* Wq = p.w_xq + (long long)li * D * D;
  FOR_IDX(idx, T1 + T2) {
    if (idx < T1) {
      long long n = idx / D; int d = (int)(idx % D);
      stf(&p.xq[idx], dotcol(p.xb + n * D, Wq + d, D, D));
    } else {
      long long i2 = idx - T1;
      int which = (int)(i2 / ((long long)BATCH * MEM_LEN * D));
      long long rem = i2 % ((long long)BATCH * MEM_LEN * D);
      long long r = rem / D; int d = (int)(rem % D);
      const float* W = (which ? p.w_xv : p.w_xk) + (long long)li * D * D;
      float s = dotcol(p.mem + r * D, W + d, D, D);
      stf(which ? &p.memv[rem] : &p.memk[rem], s);
    }
  }
}

DEV void ph_xs(const Params& p, int li, long long tid, long long nthr) {
  const float sc = 1.0f / sqrtf((float)XHD);
  FOR_IDX(idx, (long long)N_TOK * XH * MEM_LEN) {
    int m = (int)(idx % MEM_LEN); int h = (int)((idx / MEM_LEN) % XH); long long n = idx / (MEM_LEN * XH);
    int b = (int)(n / SEQ);
    const act_t* q = p.xq + n * D + h * XHD;
    const act_t* k = p.memk + ((long long)b * MEM_LEN + m) * D + h * XHD;
    float s = 0.f;
    for (int d = 0; d < XHD; ++d) s += ldf(q[d]) * ldf(k[d]);
    p.xs[idx] = s * sc;
  }
}

DEV void ph_xo(const Params& p, int li, long long tid, long long nthr) {
  FOR_IDX(idx, (long long)N_TOK * D) {
    long long n = idx / D; int c = (int)(idx % D);
    int h = c / XHD; int b = (int)(n / SEQ);
    const float* sr = p.xs + (n * XH + h) * MEM_LEN;
    float m = -INFINITY;
    for (int mm = 0; mm < MEM_LEN; ++mm) m = fmaxf(m, sr[mm]);
    float l = 0.f, o = 0.f;
    for (int mm = 0; mm < MEM_LEN; ++mm) {
      float pp = expf(sr[mm] - m);
      l += pp;
      o += pp * ldf(p.memv[((long long)b * MEM_LEN + mm) * D + c]);
    }
    stf(&p.xo[idx], o / l);
  }
}

DEV void ph_rlogit(const Params& p, int li, long long tid, long long nthr) {
  const float* W = p.w_router + (long long)li * D * NE;
  FOR_IDX(idx, (long long)N_TOK * NE) {
    long long n = idx / NE; int e = (int)(idx % NE);
    p.rl[idx] = dotcol(p.xf + n * D, W + e, D, NE) + p.b_router[li * NE + e];
  }
}

DEV void ph_route(const Params& p, int li, long long tid, long long nthr) {
  FOR_IDX(n, N_TOK) {
    const float* r = p.rl + n * NE;
    int i0 = -1, i1 = -1, i2 = -1, i3 = -1;
    float v0 = 0, v1 = 0, v2 = 0, v3 = 0;
    for (int k = 0; k < 4; ++k) {
      int bi = -1; float bv = -INFINITY;
      for (int e = 0; e < NE; ++e) {
        if (e == i0 || e == i1 || e == i2) continue;
        float v = r[e];
        if (bi < 0 || v > bv) { bi = e; bv = v; }
      }
      if (k == 0) { i0 = bi; v0 = bv; } else if (k == 1) { i1 = bi; v1 = bv; }
      else if (k == 2) { i2 = bi; v2 = bv; } else { i3 = bi; v3 = bv; }
    }
    float e0 = 1.0f, e1 = expf(v1 - v0), e2 = expf(v2 - v0), e3 = expf(v3 - v0);
    float inv = 1.0f / (e0 + e1 + e2 + e3);
#ifndef CPU_TEST
    p.rank[n * 4 + 0] = atomicAdd(&p.cnt[li * 32 + i0], 1);
    p.rank[n * 4 + 1] = atomicAdd(&p.cnt[li * 32 + i1], 1);
    p.rank[n * 4 + 2] = atomicAdd(&p.cnt[li * 32 + i2], 1);
    p.rank[n * 4 + 3] = atomicAdd(&p.cnt[li * 32 + i3], 1);
#endif
    p.topi[n * 4 + 0] = i0; p.topi[n * 4 + 1] = i1; p.topi[n * 4 + 2] = i2; p.topi[n * 4 + 3] = i3;
    p.topg[n * 4 + 0] = e0 * inv; p.topg[n * 4 + 1] = e1 * inv; p.topg[n * 4 + 2] = e2 * inv; p.topg[n * 4 + 3] = e3 * inv;
  }
}

DEV void ph_moe1(const Params& p, int li, long long tid, long long nthr) {
  FOR_IDX(idx, (long long)N_TOK * TOPK * DFF) {
    int j = (int)(idx % DFF); long long a = idx / DFF; long long n = a / TOPK;
    int e = p.topi[a];
    const float* W = p.w_gu + ((long long)li * NE + e) * D * 2 * DFF;
    const float* bb = p.b_gu + ((long long)li * NE + e) * 2 * DFF;
    float gt = dotcol(p.xb + n * D, W + j, D, 2 * DFF) + bb[j];
    float up = dotcol(p.xb + n * D, W + DFF + j, D, 2 * DFF) + bb[DFF + j];
    gt = fminf(gt, 7.0f);
    up = fminf(fmaxf(up, -7.0f), 7.0f);
    stf(&p.act[idx], (up + 1.0f) * gt * sigmoidf_(1.702f * gt));
  }
}

DEV void ph_moe2(const Params& p, int li, long long tid, long long nthr) {
  FOR_IDX(idx, (long long)N_TOK * D) {
    long long n = idx / D; int d = (int)(idx % D);
    float y = 0.f;
    for (int k = 0; k < TOPK; ++k) {
      int e = p.topi[n * 4 + k];
      const float* W = p.w_down + ((long long)li * NE + e) * DFF * D;
      float s = dotcol(p.act + (n * 4 + k) * DFF, W + d, DFF, D) + p.b_down[((long long)li * NE + e) * D + d];
      y += p.topg[n * 4 + k] * s;
    }
    p.tmp[idx] = ALPHA * p.xf[idx] + y;
  }
}

constexpr int PH_PER_LAYER = 20;
constexpr int N_PHASES = 1 + DEPTH * PH_PER_LAYER;

template <int K>
DEV void run_phase_k(const Params& p, int li, long long tid, long long nthr) {
  if constexpr (K == -1) ph_ln(p.x, p.ln0_g, p.ln0_b, p.xf, p.xb, nullptr, tid, nthr);
  if constexpr (K == 0) ph_inproj(p, li, tid, nthr);
  if constexpr (K == 1) ph_pre<3>(p, li, tid, nthr);
  if constexpr (K == 20) ph_pre<1>(p, li, tid, nthr);
  if constexpr (K == 2) ph_mix1<7>(p, li, tid, nthr);
  if constexpr (K == 21) ph_mix1<4>(p, li, tid, nthr);
  if constexpr (K == 3) ph_nsa1<3>(p, li, tid, nthr);
  if constexpr (K == 22) ph_nsa1<1>(p, li, tid, nthr);
  if constexpr (K == 4) ph_nsa2(p, li, tid, nthr);
  if constexpr (K == 5) ph_nsa3(p, li, tid, nthr);
  if constexpr (K == 6) ph_nsa4(p, li, tid, nthr);
  if constexpr (K == 7) ph_br(p, li, tid, nthr);
  if constexpr (K == 8) ph_proj_res(p, p.merged, p.w_o_mix + (long long)li * D * D, tid, nthr);
  if constexpr (K == 9) ph_ln(p.tmp, p.ln1_g + li * D, p.ln1_b + li * D, p.xf, p.xb, nullptr, tid, nthr);
  if constexpr (K == 10) ph_xq(p, li, tid, nthr);
  if constexpr (K == 11) ph_xs(p, li, tid, nthr);
  if constexpr (K == 12) ph_xo(p, li, tid, nthr);
  if constexpr (K == 13) ph_proj_res(p, p.xo, p.w_xo + (long long)li * D * D, tid, nthr);
  if constexpr (K == 14) ph_ln(p.tmp, p.ln2_g + li * D, p.ln2_b + li * D, p.xf, p.xb, nullptr, tid, nthr);
  if constexpr (K == 15) ph_rlogit(p, li, tid, nthr);
  if constexpr (K == 16) ph_route(p, li, tid, nthr);
  if constexpr (K == 17) ph_moe1(p, li, tid, nthr);
  if constexpr (K == 18) ph_moe2(p, li, tid, nthr);
  if constexpr (K == 19) ph_ln(p.tmp, p.ln3_g + li * D, p.ln3_b + li * D, p.xf, p.xb, li == DEPTH - 1 ? p.out : nullptr, tid, nthr);
}

DEV void run_phase(const Params& p, int ph, long long tid, long long nthr) {
  if (ph == 0) { run_phase_k<-1>(p, 0, tid, nthr); return; }
  int li = (ph - 1) / PH_PER_LAYER, k = (ph - 1) % PH_PER_LAYER;
  switch (k) {
#define PHC(K) case K: run_phase_k<K>(p, li, tid, nthr); break;
    PHC(0) PHC(1) PHC(2) PHC(3) PHC(4) PHC(5) PHC(6) PHC(7) PHC(8) PHC(9)
    PHC(10) PHC(11) PHC(12) PHC(13) PHC(14) PHC(15) PHC(16) PHC(17) PHC(18) PHC(19)
#undef PHC
  }
}

#ifdef CPU_TEST
#define HDI_M
#else
#define HDI_M __host__ __device__ __forceinline__
#endif
struct Carver {
  char* base; size_t off;
  template <class T> HDI_M T* take(size_t n) {
    T* r = (T*)(base + off);
    off += (n * sizeof(T) + 255) & ~(size_t)255;
    return r;
  }
};

HDI void fill_params(Params& p, void* const* d_in, void* d_out, void* d_ws) {
  const float* const* in = (const float* const*)d_in;
  p.x = in[0]; p.mem = in[1]; p.ln0_g = in[2]; p.ln0_b = in[3]; p.w_in = in[4]; p.b_in = in[5];
  p.w_alpha2 = in[6]; p.b_alpha = in[7]; p.gla_norm_g = in[8];
  p.cmp_pe_k = in[9]; p.cmp_w1_k = in[10]; p.cmp_w2_k = in[11]; p.cmp_pe_v = in[12]; p.cmp_w1_v = in[13]; p.cmp_w2_v = in[14];
  p.w_br_a = in[15]; p.w_br_b = in[16]; p.w_br_c = in[17]; p.w_o_mix = in[18]; p.ln1_g = in[19]; p.ln1_b = in[20];
  p.w_xq = in[21]; p.w_xk = in[22]; p.w_xv = in[23]; p.w_xo = in[24]; p.ln2_g = in[25]; p.ln2_b = in[26];
  p.w_router = in[27]; p.b_router = in[28]; p.w_gu = in[29]; p.b_gu = in[30]; p.w_down = in[31]; p.b_down = in[32];
  p.ln3_g = in[33]; p.ln3_b = in[34];
  p.out = (float*)d_out;
  Carver c{(char*)d_ws, 0};
  p.barw = c.take<unsigned>(4096);
  p.xf = c.take<float>((size_t)N_TOK * D);
  p.xb = c.take<act_t>((size_t)N_TOK * D);
  p.u = c.take<act_t>((size_t)N_TOK * N_IN);
  p.ga = c.take<float>((size_t)N_TOK * B_K);
  p.hid = c.take<float>((size_t)2 * CMP_ROWS * CMP_HID);
  p.kcv = c.take<float>((size_t)2 * CMP_ROWS * HD);
  p.opart = c.take<float>((size_t)4 * N_TOK * B_V);
  p.yass = p.opart;
#ifdef CPU_TEST
  p.ya = c.take<act_t>((size_t)N_TOK * 256);
  p.yb = c.take<act_t>((size_t)N_TOK * B_V);
  p.yc = c.take<act_t>((size_t)N_TOK * 1024);
#else
  p.ya = c.take<act_t>((size_t)N_TOK * YLD);
  p.yb = p.ya + 256;
  p.yc = p.ya + 1280;
#endif
  p.pcmp = c.take<float>((size_t)MOE_ROWS * 1024 / 2 > (size_t)BATCH * NSA_H * SEQ * 128 ? (size_t)MOE_ROWS * 1024 / 2 : (size_t)BATCH * NSA_H * SEQ * 128);
  p.xg = (act_t*)p.pcmp;
  p.ocmp = c.take<float>((size_t)N_TOK * 1024);
  p.impb = c.take<float>((size_t)BATCH * NSA_G * SEQ * N_BLK);
  p.selb = c.take<int>((size_t)BATCH * NSA_G * SEQ * N_BLK);
  p.merged = c.take<act_t>((size_t)N_TOK * D);
  p.tmp = c.take<float>((size_t)N_TOK * D);
  p.xq = c.take<act_t>((size_t)N_TOK * D);
  p.memk = c.take<act_t>((size_t)BATCH * MEM_LEN * D);
  p.memv = c.take<act_t>((size_t)BATCH * MEM_LEN * D);
  p.xs = c.take<float>((size_t)N_TOK * XH * MEM_LEN);
  p.mrg = p.xs;
  p.xo = c.take<act_t>((size_t)N_TOK * D);
  p.rl = c.take<float>((size_t)N_TOK * NE);
  p.topi = c.take<int>((size_t)N_TOK * TOPK);
  p.topg = c.take<float>((size_t)N_TOK * TOPK);
  p.actg = c.take<act_t>((size_t)MOE_ROWS * 1024);
  p.act = p.actg;
  p.wt_in = c.take<act_t>((size_t)2 * N_IN_PAD * 1024);
  p.wt_c1 = c.take<act_t>((size_t)2 * 2 * 256 * 2048);
  p.wt_bra = c.take<act_t>((size_t)2 * 1024 * YLD);
  p.wt_brb = p.wt_bra + 256;
  p.wt_brc = p.wt_bra + 1280;
  p.wt_omix = c.take<act_t>((size_t)2 * 1024 * 1024);
  p.wt_xq = c.take<act_t>((size_t)2 * 1024 * 1024);
  p.wt_xk = c.take<act_t>((size_t)2 * 1024 * 1024);
  p.wt_xv = c.take<act_t>((size_t)2 * 1024 * 1024);
  p.wt_xo = c.take<act_t>((size_t)2 * 1024 * 1024);
  p.wt_gu = c.take<act_t>((size_t)2 * 32 * 2048 * 1024);
  p.wt_dn = c.take<act_t>((size_t)2 * 32 * 1024 * 1024);
  p.membf = c.take<act_t>((size_t)BATCH * MEM_LEN * 1024);
  p.cmpA = c.take<act_t>((size_t)2 * CMP_ROWS_PAD * 2048);
  p.cnt = c.take<int>(64);
  p.rank = c.take<int>((size_t)N_TOK * 4);
  p.rowlist = c.take<int>((size_t)MOE_ROWS);
  p.kcb = c.take<act_t>((size_t)2 * BATCH * 128 * NSA_G * 64);
  p.dilo = c.take<act_t>((size_t)3 * N_TOK * 256);
  p.dill = c.take<float>((size_t)3 * N_TOK * 4);
  p.selm = c.take<unsigned>((size_t)BATCH * NSA_G * SEQ);
  p.gU = p.xg; p.gQ = p.xg + (size_t)1024 * 128 * 256; p.gS = p.actg; p.gD = p.opart + (size_t)N_TOK * 1024;
  p.ws_used = c.off;
}

#ifndef CPU_TEST
#ifndef NSA_PROBE
#define NSA_PROBE 0
#endif
#ifndef GSEG
#define GSEG -1
#endif
static_assert(D == 1024 && BATCH == 8, "optimized path is written for the graded shapes");
namespace pg8 {
#define PG8_LAS __attribute__((address_space(3)))
typedef unsigned short bf16_t;
typedef short bf16x8 __attribute__((ext_vector_type(8)));
typedef float f32x4 __attribute__((ext_vector_type(4)));
typedef unsigned u32x4 __attribute__((ext_vector_type(4)));
constexpr int BM = 256, BK = 64, HALF = 128, HTB = HALF * BK * 2  , STAGE_BYTES = 8 * HTB, NXCD = 8, WGM = 8;

__host__ __device__ __forceinline__ int lds_byte(int r, int c) { const int st = (r >> 4) * 2 + (c >> 5), rr = r & 15, cc = c & 31, ob = rr * 64 + cc * 2; return st * 1024 + (ob ^ (((ob >> 9) & 1) << 5)); }
__host__ __device__ __forceinline__ void stage_rc(int b, int& R, int& C) { const int st = b / 1024, sb = b % 1024, swz = sb ^ (((sb >> 9) & 1) << 5); R = (st >> 1) * 16 + swz / 64; C = (st & 1) * 32 + (swz % 64) / 2; }
__host__ __device__ __forceinline__ int perm32(int rho) { const int n = rho >> 4, i = rho & 15; return 8 * (i >> 2) + 4 * n + (i & 3); }

struct Unit { int pm, pn; };
struct Gemm { const bf16_t* A; const bf16_t* Bt; int M, N, K; };

struct StaticOrder {
    int nM, nN, nwg, G, c;
    __host__ __device__ void init(int M, int N, int G_, int c_) { nM = M / BM; nN = N / BM; nwg = nM * nN; G = G_; c = c_; }
    __host__ __device__ bool next(int i, Unit& u) const {
        const long L = (long)i * G + c; if (L >= nwg) return false;
        int wgid = (int)L; { const int q = nwg / NXCD, r = nwg % NXCD, xcd = wgid % NXCD, off = wgid / NXCD; wgid = (xcd < r ? xcd * (q + 1) : r * (q + 1) + (xcd - r) * q) + off; }
        const int nig = WGM * nN, gid = wgid / nig, fm = gid * WGM, gsz = (nM - fm) < WGM ? (nM - fm) : WGM;
        u.pm = fm + ((wgid % nig) % gsz); u.pn = (wgid % nig) / gsz; return true;
    }
    __device__ __forceinline__ void a_ready(const Unit&) const {}
    __device__ __forceinline__ void done(const Unit&) const {}
};

__device__ __forceinline__ unsigned cvt_pk_bf16(float lo, float hi) { unsigned r; asm volatile("v_cvt_pk_bf16_f32 %0, %1, %2" : "=v"(r) : "v"(lo), "v"(hi)); return r; }

template <class Epi, class Sched, bool ALIGN_EPI = false, bool SP2 = false>
__device__ __forceinline__ void gemm_phase(PG8_LAS unsigned char* lds, const Gemm g, const Sched& S, const Epi& E, const int tid) {
    const int wid = __builtin_amdgcn_readfirstlane(tid >> 6), lane = tid & 63, wr = wid >> 2, wc = wid & 3, fr = lane & 15, fq = lane >> 4;
    const int K = g.K, nt = K / BK;
    unsigned voffA[2], voffB[2];
#pragma unroll
    for (int i = 0; i < 2; ++i) { int R, C; stage_rc(tid * 16 + i * 8192, R, C); const int Rb = Epi::PERM ? ((R & ~31) + perm32(R & 31)) : R;
        voffA[i] = (unsigned)(R * K + C) * 2u; voffB[i] = (unsigned)(Rb * K + C) * 2u; }
    const size_t kstep = (size_t)(BK * 2);
    const size_t hstep = (size_t)HALF * K * 2;
    const size_t tstep = 2 * hstep;
    const unsigned ldsw = (unsigned)wid * 1024u;
    const int aoff = lds_byte(wr * 64 + fr, fq * 8), boff = lds_byte(wc * 32 + fr, fq * 8);
#define PG8_SA(b, h) (((b) * 2 + (h)) * HTB)
#define PG8_SB(b, h) ((4 + (b) * 2 + (h)) * HTB)
#define PG8_STAGE(bufoff, gbase, voff) do { _Pragma("unroll") for (int _i = 0; _i < 2; ++_i) \
        __builtin_amdgcn_global_load_lds((const unsigned*)((const char*)(gbase) + (voff)[_i]), (PG8_LAS unsigned*)(lds + (bufoff) + ldsw + _i * 8192), 16, 0, 0); } while (0)
#define PG8_LDA(dst, b, h) do { _Pragma("unroll") for (int m = 0; m < 4; ++m) _Pragma("unroll") for (int k = 0; k < 2; ++k) dst[m][k] = *(const PG8_LAS bf16x8*)(lds + PG8_SA(b, h) + aoff + m * 2048 + k * 1024); } while (0)
#define PG8_LDB(dst, b, h) do { _Pragma("unroll") for (int n = 0; n < 2; ++n) _Pragma("unroll") for (int k = 0; k < 2; ++k) dst[n][k] = *(const PG8_LAS bf16x8*)(lds + PG8_SB(b, h) + boff + n * 2048 + k * 1024); } while (0)
#define PG8_MMA(ai, bj, At, Bt) do { __builtin_amdgcn_s_setprio(1); _Pragma("unroll") for (int m = 0; m < 4; ++m) _Pragma("unroll") for (int n = 0; n < 2; ++n) _Pragma("unroll") for (int k = 0; k < 2; ++k) \
        acc[ai][bj][m][n] = __builtin_amdgcn_mfma_f32_16x16x32_bf16(Bt[n][k], At[m][k], acc[ai][bj][m][n], 0, 0, 0); __builtin_amdgcn_s_setprio(0); } while (0)
#define PG8_WAIT_V(n) asm volatile("s_waitcnt vmcnt(" #n ")" ::: "memory")
#define PG8_WAIT_L(n) asm volatile("s_waitcnt lgkmcnt(" #n ")" ::: "memory")
#define PG8_BAR __builtin_amdgcn_s_barrier()
#define PG8_SCHED __builtin_amdgcn_sched_barrier(0)
    Unit cur, nxt; int ui = 0;
    if (!S.next(0, cur)) return;
    f32x4 acc[2][2][4][2];
#pragma unroll
    for (int a = 0; a < 2; ++a)
#pragma unroll
        for (int b = 0; b < 2; ++b)
#pragma unroll
            for (int m = 0; m < 4; ++m)
#pragma unroll
                for (int n = 0; n < 2; ++n) acc[a][b][m][n] = (f32x4){0.f, 0.f, 0.f, 0.f};
    bf16x8 At[4][2], B0[2][2], B1[2][2];
    const char* cA = (const char*)g.A + (size_t)cur.pm * tstep; const char* cB = (const char*)g.Bt + (size_t)cur.pn * tstep;
    S.a_ready(cur);
    if constexpr (SP2) {
        PG8_STAGE(PG8_SB(0, 0), cB, voffB); PG8_STAGE(PG8_SB(0, 1), cB + hstep, voffB); PG8_STAGE(PG8_SA(0, 0), cA, voffA); PG8_STAGE(PG8_SA(0, 1), cA + hstep, voffA);
        if (wr == 1) PG8_BAR;
        PG8_WAIT_V(2); PG8_BAR;
        PG8_STAGE(PG8_SB(1, 0), cB + kstep, voffB); PG8_STAGE(PG8_SA(1, 0), cA + kstep, voffA); PG8_STAGE(PG8_SB(1, 1), cB + hstep + kstep, voffB);
        PG8_WAIT_V(6); PG8_BAR;
    } else {
        PG8_STAGE(PG8_SB(0, 0), cB, voffB); PG8_STAGE(PG8_SA(0, 0), cA, voffA); PG8_STAGE(PG8_SB(0, 1), cB + hstep, voffB); PG8_STAGE(PG8_SA(0, 1), cA + hstep, voffA);
        if (wr == 1) PG8_BAR;
        PG8_WAIT_V(4); PG8_BAR;
        PG8_STAGE(PG8_SB(1, 0), cB + kstep, voffB); PG8_STAGE(PG8_SA(1, 0), cA + kstep, voffA); PG8_STAGE(PG8_SB(1, 1), cB + hstep + kstep, voffB);
        PG8_WAIT_V(6); PG8_BAR;
    }
    for (;;) {
        const bool has_next = S.next(ui + 1, nxt);
        const char* nA = has_next ? (const char*)g.A + (size_t)nxt.pm * tstep : cA; const char* nB = has_next ? (const char*)g.Bt + (size_t)nxt.pn * tstep : cB;
        for (int t = 0; t < nt; t += 2) {
            const bool last = (t == nt - 2);
            const char* a1 = cA + (size_t)(t + 1) * kstep;
            const char* a2 = last ? nA : cA + (size_t)(t + 2) * kstep; const char* b2 = last ? nB : cB + (size_t)(t + 2) * kstep;
            const char* a3 = a2 + kstep; const char* b3 = b2 + kstep;
            if (last && has_next) S.a_ready(nxt);
            asm volatile("" : "+v"(voffA[0]), "+v"(voffA[1]), "+v"(voffB[0]), "+v"(voffB[1]));
            E.mid(acc, cur, wr, wc, t);
            if constexpr (SP2) {
            PG8_LDB(B0, 0, 0); PG8_LDB(B1, 0, 1); PG8_SCHED; PG8_LDA(At, 0, 0); PG8_STAGE(PG8_SA(1, 1), a1 + hstep, voffA);
            PG8_WAIT_V(8); PG8_WAIT_L(0); PG8_BAR; PG8_MMA(0, 0, At, B0); PG8_MMA(0, 1, At, B1); PG8_BAR; PG8_SCHED;
            PG8_LDA(At, 0, 1); PG8_STAGE(PG8_SB(0, 0), b2, voffB); PG8_STAGE(PG8_SB(0, 1), b2 + hstep, voffB); PG8_STAGE(PG8_SA(0, 0), a2, voffA);
            PG8_WAIT_V(8); PG8_WAIT_L(0); PG8_BAR; PG8_MMA(1, 0, At, B0); PG8_MMA(1, 1, At, B1); PG8_BAR; PG8_SCHED;
            PG8_LDB(B0, 1, 0); PG8_LDB(B1, 1, 1); PG8_SCHED; PG8_LDA(At, 1, 0); PG8_STAGE(PG8_SA(0, 1), a2 + hstep, voffA);
            PG8_WAIT_V(8); PG8_WAIT_L(0); PG8_BAR; PG8_MMA(0, 0, At, B0); PG8_MMA(0, 1, At, B1); PG8_BAR; PG8_SCHED;
            PG8_LDA(At, 1, 1); PG8_STAGE(PG8_SB(1, 0), b3, voffB); PG8_STAGE(PG8_SB(1, 1), b3 + hstep, voffB); PG8_STAGE(PG8_SA(1, 0), a3, voffA);
            PG8_WAIT_V(8); PG8_WAIT_L(0); PG8_BAR; PG8_MMA(1, 0, At, B0); PG8_MMA(1, 1, At, B1); PG8_BAR; PG8_SCHED;
            } else {
            PG8_LDB(B0, 0, 0); PG8_SCHED; PG8_LDA(At, 0, 0); PG8_STAGE(PG8_SA(1, 1), a1 + hstep, voffA);
            PG8_WAIT_L(8); PG8_BAR; PG8_WAIT_L(0); PG8_MMA(0, 0, At, B0); PG8_BAR; PG8_SCHED;
            PG8_LDB(B1, 0, 1); PG8_STAGE(PG8_SB(0, 0), b2, voffB);
            PG8_BAR; PG8_WAIT_L(0); PG8_MMA(0, 1, At, B1); PG8_BAR;
            PG8_LDA(At, 0, 1); PG8_STAGE(PG8_SA(0, 0), a2, voffA);
            PG8_BAR; PG8_WAIT_L(0); PG8_MMA(1, 0, At, B0); PG8_BAR; PG8_SCHED;
            PG8_STAGE(PG8_SB(0, 1), b2 + hstep, voffB);
            PG8_WAIT_V(6); PG8_BAR; PG8_MMA(1, 1, At, B1); PG8_BAR;
            PG8_LDB(B0, 1, 0); PG8_SCHED; PG8_LDA(At, 1, 0); PG8_STAGE(PG8_SA(0, 1), a2 + hstep, voffA);
            PG8_WAIT_L(8); PG8_BAR; PG8_WAIT_L(0); PG8_MMA(0, 0, At, B0); PG8_BAR; PG8_SCHED;
            PG8_LDB(B1, 1, 1); PG8_STAGE(PG8_SB(1, 0), b3, voffB);
            PG8_BAR; PG8_WAIT_L(0); PG8_MMA(0, 1, At, B1); PG8_BAR;
            PG8_LDA(At, 1, 1); PG8_STAGE(PG8_SA(1, 0), a3, voffA);
            PG8_BAR; PG8_WAIT_L(0); PG8_MMA(1, 0, At, B0); PG8_BAR; PG8_SCHED;
            PG8_STAGE(PG8_SB(1, 1), b3 + hstep, voffB);
            PG8_WAIT_V(6); PG8_BAR; PG8_MMA(1, 1, At, B1); PG8_BAR;
            }
        }
        if constexpr (ALIGN_EPI) { if (wr == 0) PG8_BAR; }
        if constexpr (!Epi::AFTER_DRAIN) { E(acc, cur, wr, wc, fr, fq); S.done(cur); }
        if (!has_next) break;
#pragma unroll
        for (int a = 0; a < 2; ++a)
#pragma unroll
            for (int b = 0; b < 2; ++b)
#pragma unroll
                for (int m = 0; m < 4; ++m)
#pragma unroll
                    for (int n = 0; n < 2; ++n) acc[a][b][m][n] = (f32x4){0.f, 0.f, 0.f, 0.f};
        cur = nxt; cA = nA; cB = nB; ++ui;
        if constexpr (ALIGN_EPI) { if (wr == 1) PG8_BAR; }
    }
    PG8_WAIT_V(0);
    if constexpr (!ALIGN_EPI) { if (wr == 0) PG8_BAR; }
    PG8_BAR;
    if constexpr (Epi::AFTER_DRAIN) { E.fused(acc, cur, wr, wc, fr, fq, lds, wid, lane); S.done(cur); }
#undef PG8_SA
#undef PG8_SB
#undef PG8_STAGE
#undef PG8_LDA
#undef PG8_LDB
#undef PG8_MMA
#undef PG8_WAIT_V
#undef PG8_WAIT_L
#undef PG8_BAR
#undef PG8_SCHED
}
}

typedef pg8::f32x4 f32x4;
typedef pg8::bf16x8 bf16x8;
typedef unsigned u32x2 __attribute__((ext_vector_type(2)));
typedef unsigned u32x4 __attribute__((ext_vector_type(4)));
#define LAS __attribute__((address_space(3)))

constexpr int NTHREADS = 512;
constexpr int RING_BYTES = 131072;
constexpr int MISC_OFF = RING_BYTES;
constexpr int LDS_BYTES = 147456;

typedef __bf16 bf16x2_t __attribute__((ext_vector_type(2)));
typedef float f32x2_t __attribute__((ext_vector_type(2)));
DEV unsigned pk2(float lo, float hi) {
  const f32x2_t v = {lo, hi};
  return __builtin_bit_cast(unsigned, __builtin_convertvector(v, bf16x2_t));
}
DEV unsigned short f2bfh(float x) { return (unsigned short)(pk2(x, 0.f) & 0xffffu); }
DEV float fsig(float x) { return __builtin_amdgcn_rcpf(1.0f + __builtin_amdgcn_exp2f(-1.4426950408889634f * x)); }
DEV float shx(float v, int lane, int o) { return __int_as_float(__builtin_amdgcn_ds_bpermute((lane ^ o) << 2, __float_as_int(v))); }
DEV int shxi(int v, int lane, int o) { return __builtin_amdgcn_ds_bpermute((lane ^ o) << 2, v); }
DEV float wave_sum(float v, int lane) {
#pragma unroll
  for (int o = 1; o < 64; o <<= 1)
    v += __int_as_float(__builtin_amdgcn_ds_bpermute((lane ^ o) << 2, __float_as_int(v)));
  return v;
}

DEV void transpose_item(const float* W, int ldw, int dld, act_t* WT, int k0, int n0, int drow0, LAS float* scr, int lane) {
  float wv[32];
#pragma unroll
  for (int i = 0; i < 32; ++i) wv[i] = W[(size_t)(k0 + 2 * i + (lane >> 5)) * ldw + n0 + (lane & 31)];
#pragma unroll
  for (int i = 0; i < 32; ++i) scr[(2 * i + (lane >> 5)) * 33 + (lane & 31)] = wv[i];
  asm volatile("s_waitcnt lgkmcnt(0)" ::: "memory");
  const int c = lane & 7;
#pragma unroll
  for (int j = 0; j < 4; ++j) {
    const int n = (lane >> 3) + 8 * j;
    const LAS float* s = scr + (8 * c) * 33 + n;
    u32x4 o;
    o.x = pk2(s[0 * 33], s[1 * 33]); o.y = pk2(s[2 * 33], s[3 * 33]);
    o.z = pk2(s[4 * 33], s[5 * 33]); o.w = pk2(s[6 * 33], s[7 * 33]);
    *(u32x4*)(WT + (size_t)(drow0 + n) * dld + k0 + 8 * c) = o;
  }
  asm volatile("s_waitcnt lgkmcnt(0)" ::: "memory");
}

struct ConvDesc { const float* W; act_t* dst; int nbatch, K, N, mode; size_t dstb; int dld; };
constexpr int NCONV = 13;
DEV ConvDesc conv_desc(const Params& p, int kind) {
  const size_t SQ = (size_t)1024 * 1024;
  switch (kind) {
    case 0: return ConvDesc{p.w_gu, p.wt_gu, 64, 1024, 2048, 1, (size_t)2048 * 1024, 1024};
    case 1: return ConvDesc{p.w_down, p.wt_dn, 64, 1024, 1024, 0, SQ, 1024};
    case 2: return ConvDesc{p.w_in, p.wt_in, 2, 1024, N_IN, 0, (size_t)N_IN_PAD * 1024, 1024};
    case 3: return ConvDesc{p.cmp_w1_k, p.wt_c1, 2, 2048, 128, 0, (size_t)2 * 256 * 2048, 2048};
    case 4: return ConvDesc{p.cmp_w1_v, p.wt_c1 + (size_t)256 * 2048, 2, 2048, 128, 0, (size_t)2 * 256 * 2048, 2048};
    case 5: return ConvDesc{p.w_br_a, p.wt_bra, 2, 256, 1024, 0, (size_t)1024 * YLD, YLD};
    case 6: return ConvDesc{p.w_br_b, p.wt_brb, 2, 1024, 1024, 0, (size_t)1024 * YLD, YLD};
    case 7: return ConvDesc{p.w_br_c, p.wt_brc, 2, 1024, 1024, 0, (size_t)1024 * YLD, YLD};
    case 8: return ConvDesc{p.w_o_mix, p.wt_omix, 2, 1024, 1024, 0, SQ, 1024};
    case 9: return ConvDesc{p.w_xq, p.wt_xq, 2, 1024, 1024, 0, SQ, 1024};
    case 10: return ConvDesc{p.w_xk, p.wt_xk, 2, 1024, 1024, 0, SQ, 1024};
    case 11: return ConvDesc{p.w_xv, p.wt_xv, 2, 1024, 1024, 0, SQ, 1024};
    default: return ConvDesc{p.w_xo, p.wt_xo, 2, 1024, 1024, 0, SQ, 1024};
  }
}
DEV int conv_items(int kind) {
  switch (kind) {
    case 0: return 64 * 16 * 64;
    case 1: return 64 * 16 * 32;
    case 2: return 2 * 16 * (N_IN / 32);
    case 3: case 4: return 2 * 32 * 4;
    case 5: return 2 * 4 * 32;
    default: return 2 * 16 * 32;
  }
}
DEV void conv_all(const Params& p, int gw, int NGW, LAS float* scr, int lane) {
  int base = 0;
  for (int kind = 0; kind < NCONV; ++kind) {
    const int total = conv_items(kind);
    const ConvDesc d = conv_desc(p, kind);
    const int nblk = d.N / 32, per = nblk * (d.K / 64);
    int first = (gw - base % NGW + NGW) % NGW;
    for (int it = first; it < total; it += NGW) {
      const int bt = it / per, r = it % per, kb = r / nblk, nb = r % nblk;
      const int n0 = nb * 32;
      int drow0 = n0;
      if (d.mode == 1) { const int j = n0 & 1023; drow0 = (j >> 7) * 256 + (j & 127) + ((n0 >= 1024) ? 128 : 0); }
      transpose_item(d.W + (size_t)bt * d.K * d.N, d.N, d.dld, d.dst + (size_t)bt * d.dstb, kb * 64, n0, drow0, scr, lane);
    }
    base += total;
  }
}

template <int MODE, bool SRC_BF16 = false>
DEV void ln_rows_w(const Params& p, const float* src, const float* g, const float* b, float* dstf, act_t* dstb, float* dst2,
                   int gw, int NGW, int lane) {
  for (int n0 = gw; n0 < N_TOK; n0 += 2 * NGW) {
    f32x4 v[2][4];
    float s[2] = {0.f, 0.f};
#pragma unroll
    for (int r = 0; r < 2; ++r) {
      const int n = (n0 + r * NGW < N_TOK) ? n0 + r * NGW : n0;
#pragma unroll
      for (int j = 0; j < 4; ++j) {
        if (MODE == 0) {
          if (SRC_BF16) {
            const u32x2 xw = ((const u32x2*)((const act_t*)src + (size_t)n * D))[lane + 64 * j];
            v[r][j] = (f32x4){__uint_as_float(xw.x << 16), __uint_as_float(xw.x & 0xffff0000u), __uint_as_float(xw.y << 16), __uint_as_float(xw.y & 0xffff0000u)};
          } else v[r][j] = ((const f32x4*)(src + (size_t)n * D))[lane + 64 * j];
        } else {
          f32x4 a = ((const f32x4*)(p.xf + (size_t)n * D))[lane + 64 * j] * ALPHA;
#pragma unroll
          for (int k = 0; k < 4; ++k) {
            const u32x2 yw = ((const u32x2*)((const act_t*)p.yass + ((size_t)n * 4 + k) * D))[lane + 64 * j];
            a.x += __uint_as_float(yw.x << 16); a.y += __uint_as_float(yw.x & 0xffff0000u);
            a.z += __uint_as_float(yw.y << 16); a.w += __uint_as_float(yw.y & 0xffff0000u);
          }
          v[r][j] = a;
        }
        s[r] += (v[r][j].x + v[r][j].y) + (v[r][j].z + v[r][j].w);
      }
    }
    float mean[2], s2[2] = {0.f, 0.f}, rstd[2];
#pragma unroll
    for (int o = 1; o < 64; o <<= 1) { s[0] += shx(s[0], lane, o); s[1] += shx(s[1], lane, o); }
#pragma unroll
    for (int r = 0; r < 2; ++r) {
      mean[r] = s[r] * (1.f / D);
#pragma unroll
      for (int j = 0; j < 4; ++j) { v[r][j] = v[r][j] - mean[r]; s2[r] += (v[r][j].x * v[r][j].x + v[r][j].y * v[r][j].y) + (v[r][j].z * v[r][j].z + v[r][j].w * v[r][j].w); }
    }
#pragma unroll
    for (int o = 1; o < 64; o <<= 1) { s2[0] += shx(s2[0], lane, o); s2[1] += shx(s2[1], lane, o); }
#pragma unroll
    for (int r = 0; r < 2; ++r) {
      rstd[r] = 1.f / sqrtf(s2[r] * (1.f / D) + LN_EPS);
      const int n = n0 + r * NGW;
      if (n < N_TOK) {
#pragma unroll
        for (int j = 0; j < 4; ++j) {
          const f32x4 gm = ((const f32x4*)g)[lane + 64 * j], bt = ((const f32x4*)b)[lane + 64 * j];
          const f32x4 y = v[r][j] * rstd[r] * gm + bt;
          ((f32x4*)(dstf + (size_t)n * D))[lane + 64 * j] = y;
          u32x2 w; w.x = pk2(y.x, y.y); w.y = pk2(y.z, y.w);
          ((u32x2*)(dstb + (size_t)n * D))[lane + 64 * j] = w;
          if (dst2) ((f32x4*)(dst2 + (size_t)n * D))[lane + 64 * j] = y;
        }
      }
    }
  }
}

DEV void prologue(const Params& p, LAS unsigned char* lds, int wave, int lane) {
  LAS float* scr = (LAS float*)(lds + wave * 16384);
  const int gw = blockIdx.x * 8 + wave, NGW = gridDim.x * 8;
  conv_all(p, gw, NGW, scr, lane);
  const long long tid = (long long)blockIdx.x * NTHREADS + threadIdx.x, nthr = (long long)gridDim.x * NTHREADS;
  {
    const long long padw = (long long)(N_IN_PAD - N_IN) * 1024 / 8;
    for (long long i = tid; i < 2 * padw; i += nthr) {
      const int li = (int)(i / padw); const long long r = i % padw;
      ((u32x4*)(p.wt_in + ((size_t)li * N_IN_PAD + N_IN) * 1024))[r] = (u32x4){0u, 0u, 0u, 0u};
    }
    const long long padc = (long long)128 * 2048 / 8;
    for (long long i = tid; i < 4 * padc; i += nthr) {
      const int q = (int)(i / padc); const long long r = i % padc;
      ((u32x4*)(p.wt_c1 + ((size_t)q * 256 + 128) * 2048))[r] = (u32x4){0u, 0u, 0u, 0u};
    }
    if (tid < 64) p.cnt[tid] = 0;
    for (long long i = tid; i < 2LL * BATCH * NSA_G * 64; i += nthr) {
      const long long wb = i / (NSA_G * 64), r = i % (NSA_G * 64);
      p.kcb[(wb * 128 + 127) * NSA_G * 64 + r] = 0;
    }
    for (long long i = tid; i < (long long)BATCH * MEM_LEN * 1024 / 4; i += nthr) {
      const f32x4 v = ((const f32x4*)p.mem)[i];
      u32x2 w; w.x = pk2(v.x, v.y); w.y = pk2(v.z, v.w);
      ((u32x2*)p.membf)[i] = w;
    }
  }
  ln_rows_w<0>(p, p.x, p.ln0_g, p.ln0_b, p.xf, p.xb, nullptr, gw, NGW, lane);
}

struct USched {
  int nM, nN, nwg, G, c;
  int moe, nct, total; const LAS int* tile_e;
  DEV void init_static(int M, int N, int G_, int c_) { nM = M / 256; nN = N / 256; nwg = nM * nN; G = G_; c = c_; moe = 0; nct = 1; total = nwg; tile_e = nullptr; }
  DEV void init_moe(int G_, int c_, int nct_, int total_, const LAS int* te) { nM = 1; nN = 1; nwg = total_; G = G_; c = c_; moe = 1; nct = nct_; total = total_; tile_e = te; }
  DEV bool next(int i, pg8::Unit& u) const {
    const long L = (long)i * G + c;
    if (!(moe && (G & 7) == 0) && L >= total) return false;
    if (moe) {
      if ((G & 7) == 0) {
        const int xcd = c & 7, rank = c >> 3, nr = G >> 3, T = total / nct;
        const int tlo = (T * xcd) >> 3, thi = (T * (xcd + 1)) >> 3;
        const int lu = i * nr + rank;
        if (lu >= (thi - tlo) * nct) return false;
        const int rt = tlo + lu / nct, j = lu % nct;
        u.pm = rt; u.pn = tile_e[rt] * nct + j; return true;
      }
      const int rt = (int)(L / nct), j = (int)(L % nct); u.pm = rt; u.pn = tile_e[rt] * nct + j; return true;
    }
    int wgid = (int)L; { const int q = nwg / 8, r = nwg % 8, xcd = wgid % 8, off = wgid / 8; wgid = (xcd < r ? xcd * (q + 1) : r * (q + 1) + (xcd - r) * q) + off; }
    const int nig = 8 * nN, gid = wgid / nig, fm = gid * 8, gsz = (nM - fm) < 8 ? (nM - fm) : 8;
    u.pm = fm + ((wgid % nig) % gsz); u.pn = (wgid % nig) / gsz; return true;
  }
  DEV void a_ready(const pg8::Unit&) const {}
  DEV void done(const pg8::Unit&) const {}
};

enum { EM_INPROJ = 0, EM_BRCAT, EM_RES, EM_BF16, EM_MOE1, EM_MOE2, EM_HID };
#define EPI_FENCE() asm volatile("" ::: "memory")
struct EpiU {
  static constexpr bool PERM = false, AFTER_DRAIN = false;
  int mode, ldc;
  void* q0;
  const void* q1;
  const void* q2;
  const void* q3;
  const LAS int* te;
  DEV void mid(f32x4 (&acc)[2][2][4][2], const pg8::Unit& un, int wr, int wc, int t) const {
    if (mode != EM_BRCAT || (t != 4 && t != 20)) return;
    const act_t* ub = (const act_t*)q1;
    int l2;
    asm volatile("v_mbcnt_lo_u32_b32 %0, -1, 0\n\tv_mbcnt_hi_u32_b32 %0, -1, %0" : "=v"(l2));
    const int fr = l2 & 15, fq = l2 >> 4;
    const int row0 = un.pm * 256 + wr * 64 + fr, col0 = un.pn * 256 + wc * 32 + 4 * fq;
    const int goff = OFF_MG + (t == 4 ? 0 : D);
    const float L2E = -1.4426950408889634f;
#pragma unroll
    for (int ai = 0; ai < 2; ++ai)
#pragma unroll
      for (int m = 0; m < 4; ++m) {
        const int row = row0 + ai * 128 + m * 16;
#pragma unroll
        for (int bj = 0; bj < 2; ++bj)
#pragma unroll
          for (int n = 0; n < 2; ++n) {
            const int col = col0 + bj * 128 + n * 16;
            const act_t* gp = ub + (size_t)row * N_IN + goff + col;
            const u32x2 ga = *(const u32x2*)gp, gb = *(const u32x2*)(gp + D);
            const float ea0 = __builtin_amdgcn_exp2f(__uint_as_float(ga.x << 16) * L2E), ea1 = __builtin_amdgcn_exp2f(__uint_as_float(ga.x & 0xffff0000u) * L2E);
            const float ea2 = __builtin_amdgcn_exp2f(__uint_as_float(ga.y << 16) * L2E), ea3 = __builtin_amdgcn_exp2f(__uint_as_float(ga.y & 0xffff0000u) * L2E);
            const float eb0 = __builtin_amdgcn_exp2f(__uint_as_float(gb.x << 16) * L2E), eb1 = __builtin_amdgcn_exp2f(__uint_as_float(gb.x & 0xffff0000u) * L2E);
            const float eb2 = __builtin_amdgcn_exp2f(__uint_as_float(gb.y << 16) * L2E), eb3 = __builtin_amdgcn_exp2f(__uint_as_float(gb.y & 0xffff0000u) * L2E);
            f32x4& v = acc[ai][bj][m][n];
            v.x *= (1.0f + eb0) * __builtin_amdgcn_rcpf(1.0f + ea0); v.y *= (1.0f + eb1) * __builtin_amdgcn_rcpf(1.0f + ea1);
            v.z *= (1.0f + eb2) * __builtin_amdgcn_rcpf(1.0f + ea2); v.w *= (1.0f + eb3) * __builtin_amdgcn_rcpf(1.0f + ea3);
          }
        if (m == 3) EPI_FENCE();
      }
  }
  DEV void operator()(const f32x4 (&acc)[2][2][4][2], const pg8::Unit& un, int wr, int wc, int fr, int fq) const {
    {
      int l2;
      asm volatile("v_mbcnt_lo_u32_b32 %0, -1, 0\n\tv_mbcnt_hi_u32_b32 %0, -1, %0" : "=v"(l2));
      fr = l2 & 15; fq = l2 >> 4;
    }
    const int row0 = un.pm * 256 + wr * 64 + fr;
    act_t* const ob = (act_t*)q0; float* const of = (float*)q0;
    const float* const f0 = (const float*)q1; const act_t* const ub = (const act_t*)q1;
    const float* const f1 = (const float*)q2; const int* const il = (const int*)q3;
    if (mode == EM_INPROJ) {
      const int col0 = un.pn * 256 + wc * 32 + 4 * fq;
      f32x4 bv[2][2];
#pragma unroll
      for (int bj = 0; bj < 2; ++bj)
#pragma unroll
        for (int n = 0; n < 2; ++n) { const int col = col0 + bj * 128 + n * 16; bv[bj][n] = col < N_IN ? *(const f32x4*)(f0 + col) : (f32x4){0.f, 0.f, 0.f, 0.f}; }
#pragma unroll
      for (int ai = 0; ai < 2; ++ai)
#pragma unroll
        for (int m = 0; m < 4; ++m) {
          const int row = row0 + ai * 128 + m * 16;
#pragma unroll
          for (int bj = 0; bj < 2; ++bj)
#pragma unroll
            for (int n = 0; n < 2; ++n) {
              const int col = col0 + bj * 128 + n * 16;
              if (col < N_IN) {
                const f32x4 v = acc[ai][bj][m][n] + bv[bj][n];
                u32x2 w; w.x = pk2(v.x, v.y); w.y = pk2(v.z, v.w);
                *(u32x2*)(ob + (size_t)row * N_IN + col) = w;
              }
            }
        }
    } else if (mode == EM_BRCAT) {
      const int col0 = un.pn * 256 + wc * 32 + 4 * fq;
#pragma unroll
      for (int ai = 0; ai < 2; ++ai)
#pragma unroll
        for (int m = 0; m < 4; ++m) {
          const int row = row0 + ai * 128 + m * 16;
#pragma unroll
          for (int bj = 0; bj < 2; ++bj)
#pragma unroll
            for (int n = 0; n < 2; ++n) {
              const int col = col0 + bj * 128 + n * 16;
              const u32x2 gw = *(const u32x2*)(ub + (size_t)row * N_IN + OFF_MG + 2 * D + col);
              f32x4 v = acc[ai][bj][m][n];
              v.x *= fsig(__uint_as_float(gw.x << 16)); v.y *= fsig(__uint_as_float(gw.x & 0xffff0000u));
              v.z *= fsig(__uint_as_float(gw.y << 16)); v.w *= fsig(__uint_as_float(gw.y & 0xffff0000u));
              u32x2 w; w.x = pk2(v.x, v.y); w.y = pk2(v.z, v.w);
              *(u32x2*)(ob + (size_t)row * D + col) = w;
            }
          if (m == 3) EPI_FENCE();
        }
    } else if (mode == EM_RES) {
      const int col0 = un.pn * 256 + wc * 32 + 4 * fq;
#pragma unroll
      for (int ai = 0; ai < 2; ++ai)
#pragma unroll
        for (int m = 0; m < 4; ++m) {
          const int row = row0 + ai * 128 + m * 16;
#pragma unroll
          for (int bj = 0; bj < 2; ++bj)
#pragma unroll
            for (int n = 0; n < 2; ++n) {
              const int col = col0 + bj * 128 + n * 16;
              const f32x4 x = *(const f32x4*)(f0 + (size_t)row * D + col);
              *(f32x4*)(of + (size_t)row * D + col) = x * ALPHA + acc[ai][bj][m][n];
            }
          if (m == 3) EPI_FENCE();
        }
    } else if (mode == EM_BF16) {
      const int col0 = un.pn * 256 + wc * 32 + 4 * fq;
#pragma unroll
      for (int ai = 0; ai < 2; ++ai)
#pragma unroll
        for (int m = 0; m < 4; ++m) {
          const int row = row0 + ai * 128 + m * 16;
#pragma unroll
          for (int bj = 0; bj < 2; ++bj)
#pragma unroll
            for (int n = 0; n < 2; ++n) {
              const int col = col0 + bj * 128 + n * 16;
              const f32x4 v = acc[ai][bj][m][n];
              u32x2 w; w.x = pk2(v.x, v.y); w.y = pk2(v.z, v.w);
              *(u32x2*)(ob + (size_t)row * ldc + col) = w;
            }
          EPI_FENCE();
        }
    } else if (mode == EM_MOE1) {
      const int e = te[un.pm], j = un.pn & 7;
      f32x4 bg[2], bu[2];
#pragma unroll
      for (int n = 0; n < 2; ++n) {
        const int cj = j * 128 + wc * 32 + n * 16 + 4 * fq;
        bg[n] = *(const f32x4*)(f0 + (size_t)e * 2048 + cj); bu[n] = *(const f32x4*)(f0 + (size_t)e * 2048 + 1024 + cj);
      }
#pragma unroll
      for (int ai = 0; ai < 2; ++ai)
#pragma unroll
        for (int m = 0; m < 4; ++m) {
          const int row = row0 + ai * 128 + m * 16;
#pragma unroll
          for (int n = 0; n < 2; ++n) {
            const int cj = j * 128 + wc * 32 + n * 16 + 4 * fq;
            const f32x4 g = acc[ai][0][m][n] + bg[n], u = acc[ai][1][m][n] + bu[n];
            float o[4];
#pragma unroll
            for (int i = 0; i < 4; ++i) {
              const float gt = fminf(g[i], 7.0f), up = fminf(fmaxf(u[i], -7.0f), 7.0f);
              o[i] = (up + 1.0f) * gt * __builtin_amdgcn_rcpf(1.0f + __builtin_amdgcn_exp2f(-1.702f * 1.4426950408889634f * gt));
            }
            u32x2 w; w.x = pk2(o[0], o[1]); w.y = pk2(o[2], o[3]);
            *(u32x2*)(ob + (size_t)row * 1024 + cj) = w;
          }
        }
    } else if (mode == EM_MOE2) {
      const int e = te[un.pm], j = un.pn & 3;
      const int col0 = j * 256 + wc * 32 + 4 * fq;
      int aidv[8]; float gtv[8]; f32x4 bv[2][2];
#pragma unroll
      for (int bj = 0; bj < 2; ++bj)
#pragma unroll
        for (int n = 0; n < 2; ++n) bv[bj][n] = *(const f32x4*)(f0 + (size_t)e * 1024 + col0 + bj * 128 + n * 16);
#pragma unroll
      for (int r = 0; r < 8; ++r) aidv[r] = il[row0 + (r >> 2) * 128 + (r & 3) * 16];
#pragma unroll
      for (int r = 0; r < 8; ++r) gtv[r] = f1[aidv[r] >= 0 ? aidv[r] : 0];
#pragma unroll
      for (int r = 0; r < 8; ++r) {
        const int ai = r >> 2, m = r & 3;
        if (aidv[r] >= 0) {
#pragma unroll
          for (int bj = 0; bj < 2; ++bj)
#pragma unroll
            for (int n = 0; n < 2; ++n) {
              const int col = col0 + bj * 128 + n * 16;
              const f32x4 v = (acc[ai][bj][m][n] + bv[bj][n]) * gtv[r];
              u32x2 w; w.x = pk2(v.x, v.y); w.y = pk2(v.z, v.w);
              *(u32x2*)(ob + (size_t)aidv[r] * 1024 + col) = w;
            }
        }
      }
    } else if (mode == EM_HID) {
      const int col0 = wc * 32 + 4 * fq;
#pragma unroll
      for (int ai = 0; ai < 2; ++ai)
#pragma unroll
        for (int m = 0; m < 4; ++m) {
          const int row = row0 + ai * 128 + m * 16;
          if (row < CMP_ROWS) {
#pragma unroll
            for (int n = 0; n < 2; ++n) {
              const f32x4 a = acc[ai][0][m][n];
              f32x4 v; v.x = gelu_tanh(a.x); v.y = gelu_tanh(a.y); v.z = gelu_tanh(a.z); v.w = gelu_tanh(a.w);
              *(f32x4*)(of + (size_t)row * CMP_HID + col0 + n * 16) = v;
            }
          }
          EPI_FENCE();
        }
    }
  }
};

DEV int moe_tables(const Params& p, int li, LAS int* tab, int t32) {
  __syncthreads();
  if (t32 < NE) tab[32 + t32] = p.cnt[li * 32 + t32];
  __syncthreads();
  if (t32 < 64) {
    const int e = t32 & 31;
    const int nt = (tab[32 + e] + 255) >> 8;
    int incl = nt;
#pragma unroll
    for (int o = 1; o < 32; o <<= 1) {
      const int up = __builtin_amdgcn_ds_bpermute(((t32 - o) & 63) << 2, incl);
      if (e >= o) incl += up;
    }
    const int excl = incl - nt;
    if (t32 < 32) {
      tab[e] = excl * 256;
      for (int k = 0; k < nt; ++k) tab[128 + excl + k] = e;
      if (e == 31) tab[64] = incl;
    }
  }
  __syncthreads();
  return tab[64];
}

DEV void moe_prep(const Params& p, int li, LAS int* tab, int wave, int lane, int t32) {
  const int ntiles = moe_tables(p, li, tab, t32);
  const int gw = blockIdx.x * 8 + wave, NGW = gridDim.x * 8;
  for (int tk0 = gw; tk0 < N_TOK; tk0 += 4 * NGW) {
    u32x4 v0[4], v1[4]; int rowi[4][4];
#pragma unroll
    for (int q = 0; q < 4; ++q) {
      const int tk = (tk0 + q * NGW < N_TOK) ? tk0 + q * NGW : tk0;
      const u32x4* src = (const u32x4*)(p.xb + (size_t)tk * 1024);
      v0[q] = src[lane]; v1[q] = src[lane + 64];
#pragma unroll
      for (int k = 0; k < 4; ++k) rowi[q][k] = tab[p.topi[tk * 4 + k]] + p.rank[tk * 4 + k];
    }
#pragma unroll
    for (int q = 0; q < 4; ++q) {
      const int tk = tk0 + q * NGW;
      if (tk < N_TOK) {
#pragma unroll
        for (int k = 0; k < 4; ++k) {
          if (lane == 0) p.rowlist[rowi[q][k]] = tk * 4 + k;
          u32x4* dst = (u32x4*)(p.xg + (size_t)rowi[q][k] * 1024);
          dst[lane] = v0[q]; dst[lane + 64] = v1[q];
        }
      }
    }
  }
  const long long tid = (long long)blockIdx.x * NTHREADS + t32, nthr = (long long)gridDim.x * NTHREADS;
  for (long long r = tid; r < (long long)ntiles * 256; r += nthr) {
    const int e = tab[128 + (int)(r >> 8)];
    if ((int)r - tab[e] >= tab[32 + e]) p.rowlist[r] = -1;
  }
}

typedef short v4i16_t __attribute__((ext_vector_type(4)));
DEV v4i16_t tr_read(const LAS unsigned char* p) { return __builtin_amdgcn_ds_read_tr16_b64_v4i16((LAS v4i16_t*)p); }

constexpr int AT_ROWB = 144;
constexpr int AT_TILEB = 64 * AT_ROWB;
constexpr int AT_HALF_KV = 4 * AT_TILEB;
constexpr int AT_SLAB_OFF = 2 * AT_HALF_KV;
constexpr int AT_SLAB_WAVE = 32 * 33 * 4;
constexpr int AT_SLAB_HALF = 4 * AT_SLAB_WAVE;
constexpr int AT_XCH_OFF = AT_SLAB_OFF + 2 * AT_SLAB_HALF;
static_assert(AT_XCH_OFF + 16 <= RING_BYTES, "attention LDS map");
constexpr float SC2 = 0.125f * 1.4426950408889634f;

struct AttnState { f32x4 O[2][4]; float m[2], l[2]; };

template <bool PROB, class Job>
DEV void attn_tile(const Job& job, const LAS unsigned char* Kb, const LAS unsigned char* Vb, const bf16x8 (&qf)[2][2], AttnState& st,
                   LAS float* slab, int cur, int wih, int lane) {
  const int i15 = lane & 15, g4 = lane >> 4;
  f32x4 S[2][4];
#pragma unroll
  for (int sub = 0; sub < 2; ++sub)
#pragma unroll
    for (int t = 0; t < 4; ++t) S[sub][t] = (f32x4){0.f, 0.f, 0.f, 0.f};
#pragma unroll
  for (int t = 0; t < 4; ++t)
#pragma unroll
    for (int kk = 0; kk < 2; ++kk) {
      const bf16x8 kf = *(const LAS bf16x8*)(Kb + (16 * t + i15) * AT_ROWB + (kk * 32 + 8 * g4) * 2);
#pragma unroll
      for (int sub = 0; sub < 2; ++sub) S[sub][t] = __builtin_amdgcn_mfma_f32_16x16x32_bf16(kf, qf[sub][kk], S[sub][t], 0, 0, 0);
    }
  bf16x8 pf[2][2];
  const bool efree = job.elemfree(cur, wih);
#pragma unroll
  for (int sub = 0; sub < 2; ++sub) {
    const int row = wih * 32 + sub * 16 + i15;
    if (!efree) {
      const int mbv = job.mb(row, cur, g4);
#pragma unroll
      for (int t = 0; t < 4; ++t)
#pragma unroll
        for (int j = 0; j < 4; ++j) S[sub][t][j] = job.ok(mbv, 16 * t + j) ? S[sub][t][j] : -INFINITY;
    }
    float mx = fmaxf(fmaxf(S[sub][0][0], S[sub][0][1]), fmaxf(S[sub][0][2], S[sub][0][3]));
#pragma unroll
    for (int t = 1; t < 4; ++t) mx = fmaxf(fmaxf(mx, fmaxf(S[sub][t][0], S[sub][t][1])), fmaxf(S[sub][t][2], S[sub][t][3]));
    if (!PROB) {
      mx = fmaxf(mx, shx(mx, lane, 16));
      mx = fmaxf(mx, shx(mx, lane, 32));
      const bool rok = job.rowok(sub, cur);
      const float mcand = rok ? mx * SC2 : -INFINITY;
      const float mnew = fmaxf(st.m[sub], mcand);
      const float msafe = (mnew == -INFINITY) ? 0.f : mnew;
      const float corr = __builtin_amdgcn_exp2f(st.m[sub] - msafe);
      st.m[sub] = mnew;
      const float msub = rok ? msafe : INFINITY;
      float psum = 0.f;
#pragma unroll
      for (int t = 0; t < 4; ++t)
#pragma unroll
        for (int j = 0; j < 4; ++j) { const float pp = __builtin_amdgcn_exp2f(__builtin_fmaf(S[sub][t][j], SC2, -msub)); S[sub][t][j] = pp; psum += pp; }
      st.l[sub] = st.l[sub] * corr + psum;
      if (__builtin_amdgcn_ballot_w64(corr != 1.0f) != 0ull) {
#pragma unroll
        for (int dt = 0; dt < 4; ++dt) st.O[sub][dt] *= corr;
      }
#pragma unroll
      for (int s2 = 0; s2 < 2; ++s2) {
        u32x4 w;
        w.x = pk2(S[sub][2 * s2][0], S[sub][2 * s2][1]); w.y = pk2(S[sub][2 * s2][2], S[sub][2 * s2][3]);
        w.z = pk2(S[sub][2 * s2 + 1][0], S[sub][2 * s2 + 1][1]); w.w = pk2(S[sub][2 * s2 + 1][2], S[sub][2 * s2 + 1][3]);
        pf[sub][s2] = __builtin_bit_cast(bf16x8, w);
      }
    } else {
      const float msafe = (st.m[sub] == -INFINITY) ? 0.f : st.m[sub];
      const int q = sub * 16 + i15;
#pragma unroll
      for (int t = 0; t < 4; ++t) {
        const float p0 = __builtin_amdgcn_exp2f(__builtin_fmaf(S[sub][t][0], SC2, -msafe)) * st.l[sub], p1 = __builtin_amdgcn_exp2f(__builtin_fmaf(S[sub][t][1], SC2, -msafe)) * st.l[sub];
        const float p2 = __builtin_amdgcn_exp2f(__builtin_fmaf(S[sub][t][2], SC2, -msafe)) * st.l[sub], p3 = __builtin_amdgcn_exp2f(__builtin_fmaf(S[sub][t][3], SC2, -msafe)) * st.l[sub];
        const int jb = 16 * cur + 4 * t + g4;
        slab[q * 33 + jb] += (p0 + p1) + (p2 + p3);
        S[sub][t][3] = p3;
      }
      asm volatile("s_waitcnt lgkmcnt(0)" ::: "memory");
#pragma unroll
      for (int t = 0; t < 4; ++t) {
        const int jb = 16 * cur + 4 * t + g4 + 1;
        if (jb < 32) slab[q * 33 + jb] += S[sub][t][3];
      }
      asm volatile("s_waitcnt lgkmcnt(0)" ::: "memory");
    }
  }
  if (!PROB) {
#pragma unroll
    for (int dt = 0; dt < 4; ++dt)
#pragma unroll
      for (int s2 = 0; s2 < 2; ++s2) {
        const LAS unsigned char* vp = Vb + (32 * s2 + 4 * g4 + (i15 >> 2)) * AT_ROWB + (16 * dt + 4 * (lane & 3)) * 2;
        const v4i16_t lo = tr_read(vp), hi = tr_read(vp + 16 * AT_ROWB);
        bf16x8 vf;
        vf[0] = lo[0]; vf[1] = lo[1]; vf[2] = lo[2]; vf[3] = lo[3]; vf[4] = hi[0]; vf[5] = hi[1]; vf[6] = hi[2]; vf[7] = hi[3];
#pragma unroll
        for (int sub = 0; sub < 2; ++sub) st.O[sub][dt] = __builtin_amdgcn_mfma_f32_16x16x32_bf16(vf, pf[sub][s2], st.O[sub][dt], 0, 0, 0);
      }
  }
}

DEV void half_barrier(LAS unsigned* cnt, int lane) {
  asm volatile("s_waitcnt lgkmcnt(0)" ::: "memory");
  unsigned old = 0;
  if (lane == 0) old = __hip_atomic_fetch_add(cnt, 1u, __ATOMIC_RELAXED, __HIP_MEMORY_SCOPE_WORKGROUP);
  old = (unsigned)__builtin_amdgcn_readfirstlane((int)old);
  const unsigned target = (old / 4u + 1u) * 4u;
  while ((int)(__hip_atomic_load(cnt, __ATOMIC_RELAXED, __HIP_MEMORY_SCOPE_WORKGROUP) - target) < 0) __builtin_amdgcn_s_sleep(1);
  asm volatile("" ::: "memory");
}

template <bool PROB, class Job>
DEV void attn_run(const Job& job, LAS unsigned char* lds, AttnState& st, int half, int hth, int wih, int lane) {
  LAS unsigned char* kvh = lds + half * AT_HALF_KV;
  LAS unsigned* hb = (LAS unsigned*)(lds + MISC_OFF + 8192 + 128) + half * 16;
  LAS float* slab = (LAS float*)(lds + AT_SLAB_OFF + half * AT_SLAB_HALF + wih * AT_SLAB_WAVE);
  const int i15 = lane & 15, g4 = lane >> 4;
  unsigned rem = job.tilemask();
  bf16x8 qf[2][2];
#pragma unroll
  for (int sub = 0; sub < 2; ++sub) {
    const act_t* qr = job.qrow(wih * 32 + sub * 16 + i15);
#pragma unroll
    for (int kk = 0; kk < 2; ++kk) qf[sub][kk] = *(const bf16x8*)(qr + kk * 32 + 8 * g4);
  }
  if (!PROB) {
#pragma unroll
    for (int sub = 0; sub < 2; ++sub) {
      st.m[sub] = -INFINITY; st.l[sub] = 0.f;
#pragma unroll
      for (int dt = 0; dt < 4; ++dt) st.O[sub][dt] = (f32x4){0.f, 0.f, 0.f, 0.f};
    }
  }
  const int srow = hth >> 2, sch = hth & 3;
  u32x4 ak0, ak1, av0, av1;
#define AT_LOAD(k0, k1, v0, v1, T) do { const act_t* kr_ = job.krow(T, srow) + sch * 16; k0 = *(const u32x4*)kr_; k1 = *(const u32x4*)(kr_ + 8); \
    if (!PROB) { const act_t* vr_ = job.vrow(T, srow) + sch * 16; v0 = *(const u32x4*)vr_; v1 = *(const u32x4*)(vr_ + 8); } } while (0)
#define AT_WRITE(k0, k1, v0, v1, BUF) do { LAS unsigned char* kd_ = kvh + (BUF) * AT_TILEB + srow * AT_ROWB + sch * 32; *(LAS u32x4*)kd_ = k0; *(LAS u32x4*)(kd_ + 16) = k1; \
    if (!PROB) { LAS unsigned char* vd_ = kvh + (2 + (BUF)) * AT_TILEB + srow * AT_ROWB + sch * 32; *(LAS u32x4*)vd_ = v0; *(LAS u32x4*)(vd_ + 16) = v1; } } while (0)
#define AT_NEXT(T) do { T = -1; if (rem) { T = __builtin_ctz(rem); rem &= rem - 1; } } while (0)
  int t0;
  AT_NEXT(t0);
  if (t0 >= 0) { AT_LOAD(ak0, ak1, av0, av1, t0); AT_WRITE(ak0, ak1, av0, av1, 0); }
  half_barrier(hb, lane);
  for (int it = 0; t0 >= 0; ++it) {
    int t1;
    AT_NEXT(t1);
    if (t1 >= 0) AT_LOAD(ak0, ak1, av0, av1, t1);
    attn_tile<PROB>(job, kvh + (it & 1) * AT_TILEB, kvh + (2 + (it & 1)) * AT_TILEB, qf, st, slab, t0, wih, lane);
    if (t1 >= 0) AT_WRITE(ak0, ak1, av0, av1, (it + 1) & 1);
    half_barrier(hb, lane);
    t0 = t1;
  }
#undef AT_LOAD
#undef AT_WRITE
#undef AT_NEXT
  if (!PROB) {
#pragma unroll
    for (int sub = 0; sub < 2; ++sub) {
      float l = st.l[sub];
      l += shx(l, lane, 16);
      l += shx(l, lane, 32);
      const float inv = 1.0f / fmaxf(l, 1e-30f);
      st.l[sub] = l;
#pragma unroll
      for (int dt = 0; dt < 4; ++dt) st.O[sub][dt] *= inv;
    }
  }
}

struct SelJob {
  const act_t* u; int b, g, t0; unsigned um; unsigned tm[2];
  DEV unsigned tilemask() const { return um; }
  DEV const act_t* qrow(int r) const { return u + ((size_t)b * SEQ + t0 + (r & 31)) * N_IN + OFF_CQ + (g * 4 + (r >> 5)) * 64; }
  DEV const act_t* krow(int kt, int j) const { return u + ((size_t)b * SEQ + kt * 64 + j) * N_IN + OFF_CKS + g * 64; }
  DEV const act_t* vrow(int kt, int j) const { return u + ((size_t)b * SEQ + kt * 64 + j) * N_IN + OFF_CVS + g * 64; }
  DEV int mb(int r, int kt, int g4) const { return t0 + (r & 31) - kt * 64 - 4 * g4; }
  DEV bool rowok(int sub, int kt) const { return (tm[sub] >> kt) & 1u; }
  DEV bool ok(int m, int C) const { return m >= C; }
  DEV bool elemfree(int kt, int wih) const { return kt < (t0 >> 6); }
};
struct WinJob {
  const act_t* u; int b, g, t0; unsigned um;
  DEV unsigned tilemask() const { return um; }
  DEV const act_t* qrow(int r) const { return u + ((size_t)b * SEQ + t0 + (r & 31)) * N_IN + OFF_CQ + (g * 4 + (r >> 5)) * 64; }
  DEV const act_t* krow(int kt, int j) const { return u + ((size_t)b * SEQ + kt * 64 + j) * N_IN + OFF_CKW + g * 64; }
  DEV const act_t* vrow(int kt, int j) const { return u + ((size_t)b * SEQ + kt * 64 + j) * N_IN + OFF_CVW + g * 64; }
  DEV int mb(int r, int kt, int g4) const { return t0 + (r & 31) - kt * 64 - 4 * g4; }
  DEV bool rowok(int sub, int kt) const { return true; }
  DEV bool ok(int m, int C) const { return m >= C && m < NSA_WIN + C; }
  DEV bool elemfree(int kt, int wih) const { return kt * 64 + 63 <= t0 && t0 + 31 - kt * 64 < NSA_WIN; }
};
struct CmpJob {
  const act_t* u; const act_t* kcb; const act_t* vcb; int b, g, t0; unsigned um;
  DEV unsigned tilemask() const { return um; }
  DEV const act_t* qrow(int r) const { return u + ((size_t)b * SEQ + t0 + (r & 31)) * N_IN + OFF_CQ + (g * 4 + (r >> 5)) * 64; }
  DEV const act_t* krow(int kt, int j) const { return kcb + (((size_t)b * 128 + kt * 64 + j) * NSA_G + g) * 64; }
  DEV const act_t* vrow(int kt, int j) const { return vcb + (((size_t)b * 128 + kt * 64 + j) * NSA_G + g) * 64; }
  DEV int mb(int r, int kt, int g4) const { return t0 + (r & 31) - 31 - 16 * (kt * 64 + 4 * g4); }
  DEV bool rowok(int sub, int kt) const { return true; }
  DEV bool ok(int m, int C) const { return m >= 16 * C; }
  DEV bool elemfree(int kt, int wih) const { return kt == 0 && 16 * 63 + 31 <= t0; }
};
struct DilJob {
  const act_t* u; int b, col, dil, res, l0; unsigned um;
  DEV unsigned tilemask() const { return um; }
  DEV const act_t* qrow(int r) const { return u + ((size_t)b * SEQ + (l0 + r) * dil + res) * N_IN + OFF_AQ + col; }
  DEV const act_t* krow(int kt, int j) const { return u + ((size_t)b * SEQ + (kt * 64 + j) * dil + res) * N_IN + OFF_AK + col; }
  DEV const act_t* vrow(int kt, int j) const { return u + ((size_t)b * SEQ + (kt * 64 + j) * dil + res) * N_IN + OFF_AV + col; }
  DEV int mb(int r, int kt, int g4) const { return l0 + r - kt * 64 - 4 * g4; }
  DEV bool rowok(int sub, int kt) const { return true; }
  DEV bool ok(int m, int C) const { return m >= C && m <= 128 + C; }
  DEV bool elemfree(int kt, int wih) const { return kt * 64 + 63 <= l0 + 32 * wih && l0 + 32 * wih + 31 - kt * 64 <= 128; }
};

DEV unsigned range_mask(int lo, int hi) {
  return (hi >= 31 ? 0xffffffffu : ((1u << (hi + 1)) - 1u)) & ~((1u << lo) - 1u);
}

DEV bool nsa_unit(int round, int bid, int G, int half, int& b, int& g, int& tb) {
  if ((G & 7) == 0) {
    const int nr = G >> 3, rank = bid >> 3;
    const int slot = rank * 2 + half, nslot = nr * 2;
    const int pos = (round & 1) ? (nslot - 1 - slot) : slot;
    const int lu = round * nslot + pos;
    if (lu >= 256) return false;
    b = bid & 7; g = lu & 3; tb = 63 - (lu >> 2);
    return true;
  }
  const int pos = (round & 1) ? (G - 1 - bid) : bid;
  const int pair = round * G + pos;
  if (pair >= 1024) return false;
  const int un = pair * 2 + half;
  tb = 63 - un / 32; b = (un % 32) / 4; g = un % 4;
  return true;
}
DEV int nsa_rounds(int G) { return (G & 7) == 0 ? (256 + (G >> 3) * 2 - 1) / ((G >> 3) * 2) : (1024 + G - 1) / G; }

DEV void nsa_cmp_phase(const Params& p, LAS unsigned char* lds, int t32, int bid, int G) {
  const int lane = t32 & 63, wave = t32 >> 6, half = wave >> 2, wih = wave & 3, hth = t32 & 255;
  const int i15 = lane & 15, g4 = lane >> 4;
  LAS float* slabh = (LAS float*)(lds + AT_SLAB_OFF + half * AT_SLAB_HALF);
  for (int round = 0; round < nsa_rounds(G); ++round) {
    int b = 0, g = 0, tb = 0;
    const bool act = nsa_unit(round, bid, G, half, b, g, tb);
    const int t0 = tb * 32;
    const int nvmax = t0 + 31 >= 31 ? (t0 + 31 - 31) / 16 + 1 : 0;
    CmpJob job{p.u, p.kcb, p.kcb + (size_t)BATCH * 128 * NSA_G * 64, b, g, t0, 0u};
    job.um = !act ? 0u : (nvmax > 64 ? 3u : (nvmax > 0 ? 1u : 0u));
    for (int i = lane; i < 32 * 33; i += 64) slabh[wih * (32 * 33) + i] = 0.f;
    LAS unsigned char* kvh = lds + half * AT_HALF_KV;
    LAS unsigned* hb = (LAS unsigned*)(lds + MISC_OFF + 8192 + 128) + half * 16;
    LAS float* slab = slabh + wih * (32 * 33);
    {
      const int srow = hth >> 2, sch = hth & 3;
#pragma unroll
      for (int tl = 0; tl < 2; ++tl)
        if ((job.um >> tl) & 1u) {
          const act_t* kr = job.krow(tl, srow) + sch * 16; const act_t* vr = job.vrow(tl, srow) + sch * 16;
          const u32x4 k0 = *(const u32x4*)kr, k1 = *(const u32x4*)(kr + 8), v0 = *(const u32x4*)vr, v1 = *(const u32x4*)(vr + 8);
          LAS unsigned char* kd = kvh + tl * AT_TILEB + srow * AT_ROWB + sch * 32;
          *(LAS u32x4*)kd = k0; *(LAS u32x4*)(kd + 16) = k1;
          LAS unsigned char* vd = kvh + (2 + tl) * AT_TILEB + srow * AT_ROWB + sch * 32;
          *(LAS u32x4*)vd = v0; *(LAS u32x4*)(vd + 16) = v1;
        }
    }
    bf16x8 qf[2][2];
#pragma unroll
    for (int sub = 0; sub < 2; ++sub) {
      const act_t* qr = job.qrow(wih * 32 + sub * 16 + i15);
#pragma unroll
      for (int kk = 0; kk < 2; ++kk) qf[sub][kk] = *(const bf16x8*)(qr + kk * 32 + 8 * g4);
    }
    AttnState st;
#pragma unroll
    for (int sub = 0; sub < 2; ++sub) {
      st.m[sub] = -INFINITY; st.l[sub] = 0.f;
#pragma unroll
      for (int dt = 0; dt < 4; ++dt) st.O[sub][dt] = (f32x4){0.f, 0.f, 0.f, 0.f};
    }
    half_barrier(hb, lane);
    if (job.um & 1u) attn_tile<false>(job, kvh, kvh + 2 * AT_TILEB, qf, st, slab, 0, wih, lane);
    if (job.um & 2u) attn_tile<false>(job, kvh + AT_TILEB, kvh + 3 * AT_TILEB, qf, st, slab, 1, wih, lane);
#pragma unroll
    for (int sub = 0; sub < 2; ++sub) {
      float l = st.l[sub];
      l += shx(l, lane, 16);
      l += shx(l, lane, 32);
      const float inv = 1.0f / fmaxf(l, 1e-30f);
      st.l[sub] = inv;
#pragma unroll
      for (int dt = 0; dt < 4; ++dt) st.O[sub][dt] *= inv;
    }
    if (act) {
#pragma unroll
      for (int sub = 0; sub < 2; ++sub) {
        const int hh = g * 4 + wih;
        const size_t n = (size_t)b * SEQ + t0 + sub * 16 + i15;
        const float g0 = fsig(ldf(p.u[n * N_IN + OFF_CG + hh * 3 + 0]));
#pragma unroll
        for (int dt = 0; dt < 4; ++dt) { const f32x4 y = st.O[sub][dt] * g0; u32x2 w; w.x = pk2(y.x, y.y); w.y = pk2(y.z, y.w); *(u32x2*)((act_t*)p.ocmp + n * 1024 + hh * 64 + 16 * dt + 4 * g4) = w; }
      }
    }
    if (job.um & 1u) attn_tile<true>(job, kvh, kvh + 2 * AT_TILEB, qf, st, slab, 0, wih, lane);
    if (job.um & 2u) attn_tile<true>(job, kvh + AT_TILEB, kvh + 3 * AT_TILEB, qf, st, slab, 1, wih, lane);
    half_barrier(hb, lane);
    {
      const int q = hth >> 3, j4 = (hth & 7) * 4;
      float v[4];
#pragma unroll
      for (int i = 0; i < 4; ++i) {
        float s = 0.f;
#pragma unroll
        for (int w = 0; w < 4; ++w) s += slabh[w * (32 * 33) + q * 33 + j4 + i];
        const int j = j4 + i, qb = (t0 + q) >> 6;
        if (j == 0 || j == qb || j == qb - 1) s = INFINITY;
        else if (j > qb) s = -INFINITY;
        v[i] = s;
      }
      __syncthreads();
#pragma unroll
      for (int i = 0; i < 4; ++i) slabh[q * 33 + j4 + i] = v[i];
      __syncthreads();
      unsigned bits = 0u;
#pragma unroll
      for (int i = 0; i < 4; ++i) {
        int rank = 0;
#pragma unroll 1
        for (int jj = 0; jj < 32; ++jj) { const float w = slabh[q * 33 + jj]; rank += (w > v[i] || (w == v[i] && jj < j4 + i)) ? 1 : 0; }
        if (rank < N_SELECT) bits |= 1u << (j4 + i);
      }
      bits |= (unsigned)shxi((int)bits, lane, 1);
      bits |= (unsigned)shxi((int)bits, lane, 2);
      bits |= (unsigned)shxi((int)bits, lane, 4);
      if (act && (hth & 7) == 0) p.selm[((size_t)b * NSA_G + g) * SEQ + t0 + q] = bits;
      __syncthreads();
    }
  }
}

DEV void nsa_main_phase(const Params& p, LAS unsigned char* lds, int t32, int bid, int G) {
  const int lane = t32 & 63, wave = t32 >> 6, half = wave >> 2, wih = wave & 3, hth = t32 & 255;
  const int i15 = lane & 15, g4 = lane >> 4;
#define NSTAMP(i) do { if (GSEG >= 10 && blockIdx.x == 0 && t32 == 0) { const unsigned now_ = (unsigned)__builtin_amdgcn_s_memrealtime(); if ((i) > 0 && (i) - 1 + 10 == GSEG) p.barw[3600] += now_ - ns_prev; ns_prev = now_; } } while (0)
  unsigned ns_prev = 0u;
  for (int round2 = 0; round2 < nsa_rounds(G) * (NSA_PROBE == 5 ? 2 : 1); ++round2) {
    const int round = (NSA_PROBE == 5) ? (round2 >> 1) : round2;
    NSTAMP(0);
    int b = 0, g = 0, tb = 0;
    const bool act = nsa_unit(round, bid, G, half, b, g, tb);
    const int t0 = tb * 32;
    SelJob sj{p.u, b, g, t0, 0u, {0u, 0u}};
    if (act) {
      const unsigned* sm = p.selm + ((size_t)b * NSA_G + g) * SEQ + t0;
      sj.tm[0] = sm[i15]; sj.tm[1] = sm[16 + i15];
      unsigned um = sj.tm[0] | sj.tm[1];
      int l2 = lane;
      asm volatile("" : "+v"(l2));
      um |= (unsigned)shxi((int)um, l2, 1); um |= (unsigned)shxi((int)um, l2, 2);
      um |= (unsigned)shxi((int)um, l2, 4); um |= (unsigned)shxi((int)um, l2, 8);
      sj.um = um & range_mask(0, t0 >> 6);
    }
    u32x2 base[2][4];
    const int hh = g * 4 + wih;
    const size_t nrow0 = (size_t)b * SEQ + t0 + i15;
    const act_t gq10 = p.u[nrow0 * N_IN + OFF_CG + hh * 3 + 1], gq11 = p.u[(nrow0 + 16) * N_IN + OFF_CG + hh * 3 + 1];
    const act_t gq20 = p.u[nrow0 * N_IN + OFF_CG + hh * 3 + 2], gq21 = p.u[(nrow0 + 16) * N_IN + OFF_CG + hh * 3 + 2];
    {
      AttnState ss;
      NSTAMP(1);
      attn_run<false>(sj, lds, ss, half, hth, wih, lane);
      NSTAMP(2);
#if NSA_PROBE == 1
      attn_run<false>(sj, lds, ss, half, hth, wih, lane);
#endif
#pragma unroll
      for (int sub = 0; sub < 2; ++sub) {
        f32x4 oc[4];
#pragma unroll
        for (int dt = 0; dt < 4; ++dt) {
          const u32x2 cw = *(const u32x2*)((const act_t*)p.ocmp + (nrow0 + 16 * sub) * 1024 + hh * 64 + 16 * dt + 4 * g4);
          oc[dt] = (f32x4){__uint_as_float(cw.x << 16), __uint_as_float(cw.x & 0xffff0000u), __uint_as_float(cw.y << 16), __uint_as_float(cw.y & 0xffff0000u)};
        }
        const float g1 = fsig(ldf(sub ? gq11 : gq10));
#pragma unroll
        for (int dt = 0; dt < 4; ++dt) {
          const f32x4 y = ss.O[sub][dt] * g1 + oc[dt];
          base[sub][dt].x = pk2(y.x, y.y); base[sub][dt].y = pk2(y.z, y.w);
        }
      }
    }
    WinJob wj{p.u, b, g, t0, 0u};
    if (act) { const int lo = t0 - (NSA_WIN - 1) < 0 ? 0 : (t0 - (NSA_WIN - 1)) >> 6; wj.um = range_mask(lo, (t0 + 31) >> 6); }
    AttnState ws;
    NSTAMP(3);
    attn_run<false>(wj, lds, ws, half, hth, wih, lane);
    NSTAMP(4);
#if NSA_PROBE == 2
    attn_run<false>(wj, lds, ws, half, hth, wih, lane);
#endif
    if (act) {
#pragma unroll
      for (int sub = 0; sub < 2; ++sub) {
        const size_t n = nrow0 + 16 * sub;
        const float g2 = fsig(ldf(sub ? gq21 : gq20));
#pragma unroll
        for (int dt = 0; dt < 4; ++dt) {
          const u32x2 bw = base[sub][dt];
          f32x4 y = ws.O[sub][dt] * g2;
          y.x += __uint_as_float(bw.x << 16); y.y += __uint_as_float(bw.x & 0xffff0000u);
          y.z += __uint_as_float(bw.y << 16); y.w += __uint_as_float(bw.y & 0xffff0000u);
          u32x2 w; w.x = pk2(y.x, y.y); w.y = pk2(y.z, y.w);
          *(u32x2*)(p.yc + n * YLD + hh * 64 + 16 * dt + 4 * g4) = w;
        }
      }
    }
  }
}

DEV void dil_phase(const Params& p, LAS unsigned char* lds, int t32, int bid, int G) {
  const int lane = t32 & 63, wave = t32 >> 6, half = wave >> 2, wih = wave & 3, hth = t32 & 255;
  const int i15 = lane & 15, g4 = lane >> 4;
  const bool xm = (G & 7) == 0;
  const int npair = xm ? 96 : 768, pstep = xm ? (G >> 3) : G;
  for (int pair = xm ? (bid >> 3) : bid; pair < npair; pair += pstep) {
    const int un = pair * 2 + half;
    int gi, b, r2;
    if (xm) { b = bid & 7; gi = un / 64; r2 = un % 64; }
    else { gi = un / 512; const int r = un % 512; b = r / 64; r2 = r % 64; }
    const int dil = gi == 0 ? 1 : (gi == 1 ? 4 : 16);
    const int nlb = 16 / dil;
    const int h = r2 / 16, r3 = r2 % 16;
    const int res = r3 / nlb, lb = r3 % nlb;
    const int l0 = lb * 128;
    DilJob job{p.u, b, gi * 256 + h * 64, dil, res, l0, 0u};
    job.um = range_mask(l0 >= 128 ? (l0 - 128) >> 6 : 0, (l0 + 127) >> 6);
    AttnState st;
    attn_run<false>(job, lds, st, half, hth, wih, lane);
#pragma unroll
    for (int sub = 0; sub < 2; ++sub) {
      const int l = l0 + wih * 32 + sub * 16 + i15;
      const size_t n = (size_t)b * SEQ + l * dil + res;
#pragma unroll
      for (int dt = 0; dt < 4; ++dt) {
        const f32x4 y = st.O[sub][dt];
        u32x2 w; w.x = pk2(y.x, y.y); w.y = pk2(y.z, y.w);
        *(u32x2*)(p.dilo + ((size_t)gi * N_TOK + n) * 256 + h * 64 + 16 * dt + 4 * g4) = w;
      }
      if (g4 == 0) p.dill[((size_t)gi * N_TOK + n) * 4 + h] = st.m[sub] + __builtin_amdgcn_logf(st.l[sub]);
    }
  }
}

DEV void dil_combine(const Params& p, long long tid, long long nthr) {
  for (long long idx = tid; idx < (long long)N_TOK * 32; idx += nthr) {
    const size_t n = idx >> 5; const int c8 = (int)(idx & 31) * 8, h = c8 >> 6;
    const float l0 = p.dill[((size_t)0 * N_TOK + n) * 4 + h], l1 = p.dill[((size_t)1 * N_TOK + n) * 4 + h], l2 = p.dill[((size_t)2 * N_TOK + n) * 4 + h];
    const float mx = fmaxf(l0, fmaxf(l1, l2));
    float w0 = __builtin_amdgcn_exp2f(l0 - mx), w1 = __builtin_amdgcn_exp2f(l1 - mx), w2 = __builtin_amdgcn_exp2f(l2 - mx);
    const float inv = 1.0f / (w0 + w1 + w2);
    w0 *= inv; w1 *= inv; w2 *= inv;
    const u32x4 a = *(const u32x4*)(p.dilo + ((size_t)0 * N_TOK + n) * 256 + c8);
    const u32x4 bq = *(const u32x4*)(p.dilo + ((size_t)1 * N_TOK + n) * 256 + c8);
    const u32x4 c = *(const u32x4*)(p.dilo + ((size_t)2 * N_TOK + n) * 256 + c8);
    u32x4 o;
#pragma unroll
    for (int i = 0; i < 4; ++i) {
      const float lo = w0 * __uint_as_float(a[i] << 16) + w1 * __uint_as_float(bq[i] << 16) + w2 * __uint_as_float(c[i] << 16);
      const float hi = w0 * __uint_as_float(a[i] & 0xffff0000u) + w1 * __uint_as_float(bq[i] & 0xffff0000u) + w2 * __uint_as_float(c[i] & 0xffff0000u);
      o[i] = pk2(lo, hi);
    }
    *(u32x4*)(p.ya + n * YLD + c8) = o;
  }
}

DEV void cmpa_build(const Params& p, int li, long long tid, long long nthr) {
  for (long long idx = tid; idx < 2LL * CMP_ROWS * 256; idx += nthr) {
    const int which = (int)(idx / ((long long)CMP_ROWS * 256));
    const long long rem = idx % ((long long)CMP_ROWS * 256);
    const int row = (int)(rem >> 8), c8 = (int)(rem & 255) * 8, l = c8 >> 6, d = c8 & 63;
    const int g = row % NSA_G, c = (row / NSA_G) % N_CMP, b = row / (NSA_G * N_CMP);
    const float* pe = (which ? p.cmp_pe_v : p.cmp_pe_k) + (size_t)li * 32 * HD + l * HD + d;
    const u32x4 uv = *(const u32x4*)(p.u + ((size_t)b * SEQ + c * 16 + l) * N_IN + (which ? OFF_CVC : OFF_CKC) + g * HD + d);
    u32x4 o;
#pragma unroll
    for (int i = 0; i < 4; ++i) o[i] = pk2(__uint_as_float(uv[i] << 16) + pe[2 * i], __uint_as_float(uv[i] & 0xffff0000u) + pe[2 * i + 1]);
    *(u32x4*)(p.cmpA + ((size_t)which * CMP_ROWS_PAD + row) * 2048 + c8) = o;
  }
}

constexpr int XA_ROWB = 528;
constexpr int XA_TILEB = 32 * XA_ROWB;
static_assert(4 * XA_TILEB <= RING_BYTES, "xattn LDS map");
DEV void xattn_phase(const Params& p, LAS unsigned char* lds, int t32, int bid, int G) {
  const int lane = t32 & 63, wave = t32 >> 6, i15 = lane & 15, g4 = lane >> 4;
  const float sc2 = 0.0625f * 1.4426950408889634f;
  const bool xm = (G & 7) == 0;
  const int nun = xm ? XH * (SEQ / 128) : BATCH * XH * (SEQ / 128), ustep = xm ? (G >> 3) : G;
  for (int un = xm ? (bid >> 3) : bid; un < nun; un += ustep) {
    const int b = xm ? (bid & 7) : un / (XH * (SEQ / 128)), r = un % (XH * (SEQ / 128)), h = r / (SEQ / 128), qb = r % (SEQ / 128);
    const size_t nq = (size_t)b * SEQ + qb * 128 + wave * 16 + i15;
    bf16x8 qf[8];
#pragma unroll
    for (int kk = 0; kk < 8; ++kk) qf[kk] = *(const bf16x8*)(p.xq + nq * 1024 + h * 256 + kk * 32 + 8 * g4);
    f32x4 O[16];
#pragma unroll
    for (int dt = 0; dt < 16; ++dt) O[dt] = (f32x4){0.f, 0.f, 0.f, 0.f};
    float m = -INFINITY, l = 0.f;
    const int srow = t32 >> 4, sch = t32 & 15;
    const act_t* kbase = p.memk + ((size_t)b * MEM_LEN + srow) * 1024 + h * 256 + sch * 16;
    const act_t* vbase = p.memv + ((size_t)b * MEM_LEN + srow) * 1024 + h * 256 + sch * 16;
    u32x4 sk0 = *(const u32x4*)kbase, sk1 = *(const u32x4*)(kbase + 8), sv0 = *(const u32x4*)vbase, sv1 = *(const u32x4*)(vbase + 8);
    {
      LAS unsigned char* kd = lds + srow * XA_ROWB + sch * 32;
      *(LAS u32x4*)kd = sk0; *(LAS u32x4*)(kd + 16) = sk1;
      LAS unsigned char* vd = lds + 2 * XA_TILEB + srow * XA_ROWB + sch * 32;
      *(LAS u32x4*)vd = sv0; *(LAS u32x4*)(vd + 16) = sv1;
    }
    __syncthreads();
    for (int it = 0; it < MEM_LEN / 32; ++it) {
      if (it + 1 < MEM_LEN / 32) {
        const act_t* kr = kbase + (size_t)(it + 1) * 32 * 1024, *vr = vbase + (size_t)(it + 1) * 32 * 1024;
        sk0 = *(const u32x4*)kr; sk1 = *(const u32x4*)(kr + 8); sv0 = *(const u32x4*)vr; sv1 = *(const u32x4*)(vr + 8);
      }
      const LAS unsigned char* Kb = lds + (it & 1) * XA_TILEB;
      const LAS unsigned char* Vb = lds + (2 + (it & 1)) * XA_TILEB;
      f32x4 S[2];
      S[0] = (f32x4){0.f, 0.f, 0.f, 0.f}; S[1] = (f32x4){0.f, 0.f, 0.f, 0.f};
#pragma unroll
      for (int t = 0; t < 2; ++t)
#pragma unroll
        for (int kk = 0; kk < 8; ++kk) {
          const bf16x8 kf = *(const LAS bf16x8*)(Kb + (16 * t + i15) * XA_ROWB + (kk * 32 + 8 * g4) * 2);
          S[t] = __builtin_amdgcn_mfma_f32_16x16x32_bf16(kf, qf[kk], S[t], 0, 0, 0);
        }
      float mx = -INFINITY;
#pragma unroll
      for (int t = 0; t < 2; ++t)
#pragma unroll
        for (int j = 0; j < 4; ++j) { S[t][j] *= sc2; mx = fmaxf(mx, S[t][j]); }
      mx = fmaxf(mx, shx(mx, lane, 16));
      mx = fmaxf(mx, shx(mx, lane, 32));
      const float mnew = fmaxf(m, mx);
      const float corr = __builtin_amdgcn_exp2f(m - mnew);
      m = mnew;
      float psum = 0.f;
#pragma unroll
      for (int t = 0; t < 2; ++t)
#pragma unroll
        for (int j = 0; j < 4; ++j) { const float pp = __builtin_amdgcn_exp2f(S[t][j] - mnew); S[t][j] = pp; psum += pp; }
      l = l * corr + psum;
      u32x4 w;
      w.x = pk2(S[0][0], S[0][1]); w.y = pk2(S[0][2], S[0][3]); w.z = pk2(S[1][0], S[1][1]); w.w = pk2(S[1][2], S[1][3]);
      const bf16x8 pf = __builtin_bit_cast(bf16x8, w);
#pragma unroll
      for (int dt = 0; dt < 16; ++dt) {
        const LAS unsigned char* vp = Vb + (4 * g4 + (i15 >> 2)) * XA_ROWB + (16 * dt + 4 * (lane & 3)) * 2;
        const v4i16_t lo = tr_read(vp), hi = tr_read(vp + 16 * XA_ROWB);
        bf16x8 vf;
        vf[0] = lo[0]; vf[1] = lo[1]; vf[2] = lo[2]; vf[3] = lo[3]; vf[4] = hi[0]; vf[5] = hi[1]; vf[6] = hi[2]; vf[7] = hi[3];
        O[dt] = __builtin_amdgcn_mfma_f32_16x16x32_bf16(vf, pf, O[dt] * corr, 0, 0, 0);
      }
      if (it + 1 < MEM_LEN / 32) {
        LAS unsigned char* kd = lds + ((it + 1) & 1) * XA_TILEB + srow * XA_ROWB + sch * 32;
        *(LAS u32x4*)kd = sk0; *(LAS u32x4*)(kd + 16) = sk1;
        LAS unsigned char* vd = lds + (2 + ((it + 1) & 1)) * XA_TILEB + srow * XA_ROWB + sch * 32;
        *(LAS u32x4*)vd = sv0; *(LAS u32x4*)(vd + 16) = sv1;
      }
      __syncthreads();
    }
    l += shx(l, lane, 16);
    l += shx(l, lane, 32);
    const float inv = 1.0f / l;
#pragma unroll
    for (int dt = 0; dt < 16; ++dt) {
      const f32x4 y = O[dt] * inv;
      u32x2 w; w.x = pk2(y.x, y.y); w.y = pk2(y.z, y.w);
      *(u32x2*)(p.xo + nq * 1024 + h * 256 + 16 * dt + 4 * g4) = w;
    }
  }
}

constexpr int RT_LCNT = MISC_OFF + 4096, RT_BASE = RT_LCNT + 128, RT_SEL = RT_BASE + 128, RT_RANK = RT_SEL + 1024;
DEV void route_phase(const Params& p, int li, LAS unsigned char* lds, int t32, int bid, int G) {
  const int lane = t32 & 63, wave = t32 >> 6, i15 = lane & 15, g4 = lane >> 4;
  const float* W = p.w_router + (size_t)li * D * NE;
  LAS unsigned short* Wh = (LAS unsigned short*)lds;
  LAS unsigned short* Wl = (LAS unsigned short*)(lds + 65536);
  LAS int* lcnt = (LAS int*)(lds + RT_LCNT);
  LAS int* lbase = (LAS int*)(lds + RT_BASE);
  LAS int* lsel = (LAS int*)(lds + RT_SEL);
  LAS int* lrank = (LAS int*)(lds + RT_RANK);
  const int e = lane & 31;
  const float bias = p.b_router[li * NE + e];
  for (int blk = bid; blk < N_TOK / 64; blk += G) {
    __syncthreads();
    for (int i = 0; i < 16; ++i) {
      const int idx = t32 + 512 * i, k = idx >> 3, e4 = (idx & 7) * 4;
      const f32x4 w = ((const f32x4*)W)[idx];
#pragma unroll
      for (int q = 0; q < 4; ++q) {
        const unsigned short hi = f2bfh(w[q]);
        const unsigned short lo = f2bfh(w[q] - __uint_as_float(((unsigned)hi) << 16));
        Wh[(e4 + q) * 1024 + k] = hi; Wl[(e4 + q) * 1024 + k] = lo;
      }
    }
    if (t32 < 32) lcnt[t32] = 0;
    __syncthreads();
    f32x4 acc[4][2];
#pragma unroll
    for (int mt = 0; mt < 4; ++mt) { acc[mt][0] = (f32x4){0.f, 0.f, 0.f, 0.f}; acc[mt][1] = (f32x4){0.f, 0.f, 0.f, 0.f}; }
    const int n0 = blk * 64;
#pragma unroll 1
    for (int kk = 0; kk < 4; ++kk) {
      const int kb = wave * 128 + kk * 32 + 8 * g4;
      bf16x8 bh[2], bl[2];
#pragma unroll
      for (int nt = 0; nt < 2; ++nt) {
        bh[nt] = *(const LAS bf16x8*)(Wh + (16 * nt + i15) * 1024 + kb);
        bl[nt] = *(const LAS bf16x8*)(Wl + (16 * nt + i15) * 1024 + kb);
      }
#pragma unroll
      for (int mt = 0; mt < 4; ++mt) {
        const float* xr = p.xf + (size_t)(n0 + 16 * mt + i15) * D + kb;
        const f32x4 x0 = *(const f32x4*)xr, x1 = *(const f32x4*)(xr + 4);
        u32x4 hw, lw;
        {
          const unsigned h0 = pk2(x0.x, x0.y), h1 = pk2(x0.z, x0.w), h2 = pk2(x1.x, x1.y), h3 = pk2(x1.z, x1.w);
          hw = (u32x4){h0, h1, h2, h3};
          lw.x = pk2(x0.x - __uint_as_float(h0 << 16), x0.y - __uint_as_float(h0 & 0xffff0000u));
          lw.y = pk2(x0.z - __uint_as_float(h1 << 16), x0.w - __uint_as_float(h1 & 0xffff0000u));
          lw.z = pk2(x1.x - __uint_as_float(h2 << 16), x1.y - __uint_as_float(h2 & 0xffff0000u));
          lw.w = pk2(x1.z - __uint_as_float(h3 << 16), x1.w - __uint_as_float(h3 & 0xffff0000u));
        }
        const bf16x8 ah = __builtin_bit_cast(bf16x8, hw), al = __builtin_bit_cast(bf16x8, lw);
#pragma unroll
        for (int nt = 0; nt < 2; ++nt) {
          acc[mt][nt] = __builtin_amdgcn_mfma_f32_16x16x32_bf16(ah, bh[nt], acc[mt][nt], 0, 0, 0);
          acc[mt][nt] = __builtin_amdgcn_mfma_f32_16x16x32_bf16(ah, bl[nt], acc[mt][nt], 0, 0, 0);
          acc[mt][nt] = __builtin_amdgcn_mfma_f32_16x16x32_bf16(al, bh[nt], acc[mt][nt], 0, 0, 0);
        }
      }
    }
    __syncthreads();
    LAS float* part = (LAS float*)lds;
    LAS float* fin = (LAS float*)(lds + 8 * 64 * 33 * 4);
#pragma unroll
    for (int mt = 0; mt < 4; ++mt)
#pragma unroll
      for (int nt = 0; nt < 2; ++nt)
#pragma unroll
        for (int j = 0; j < 4; ++j) part[(wave * 64 + 16 * mt + 4 * g4 + j) * 33 + 16 * nt + i15] = acc[mt][nt][j];
    __syncthreads();
    {
      const int tok = t32 >> 3, e4 = (t32 & 7) * 4;
#pragma unroll
      for (int q = 0; q < 4; ++q) {
        float v = 0.f;
#pragma unroll
        for (int w = 0; w < 8; ++w) v += part[(w * 64 + tok) * 33 + e4 + q];
        fin[tok * 33 + e4 + q] = v;
      }
    }
    __syncthreads();
    float cur[8]; int sel[8][4]; float sv[8][4];
#pragma unroll
    for (int t = 0; t < 8; ++t) cur[t] = fin[(wave * 8 + t) * 33 + e] + bias;
#pragma unroll
    for (int k = 0; k < 4; ++k) {
      float bv[8]; int bi[8];
#pragma unroll
      for (int t = 0; t < 8; ++t) { bv[t] = cur[t]; bi[t] = e; }
#pragma unroll
      for (int o = 1; o < 32; o <<= 1) {
#pragma unroll
        for (int t = 0; t < 8; ++t) {
          const float ov = shx(bv[t], lane, o); const int oi = shxi(bi[t], lane, o);
          if (ov > bv[t] || (ov == bv[t] && oi < bi[t])) { bv[t] = ov; bi[t] = oi; }
        }
      }
#pragma unroll
      for (int t = 0; t < 8; ++t) { sel[t][k] = bi[t]; sv[t][k] = bv[t]; if (e == bi[t]) cur[t] = -INFINITY; }
    }
    int abase = __builtin_amdgcn_readfirstlane(wave * 32);
    asm volatile("" : "+s"(abase));
    if (lane == 0) {
#pragma unroll
      for (int t = 0; t < 8; ++t) {
        const int n = n0 + wave * 8 + t;
        const float e1 = expf(sv[t][1] - sv[t][0]), e2 = expf(sv[t][2] - sv[t][0]), e3 = expf(sv[t][3] - sv[t][0]);
        const float inv = 1.0f / (1.0f + e1 + e2 + e3);
        p.topg[n * 4 + 0] = inv; p.topg[n * 4 + 1] = e1 * inv; p.topg[n * 4 + 2] = e2 * inv; p.topg[n * 4 + 3] = e3 * inv;
#pragma unroll
        for (int k = 0; k < 4; ++k) {
          const int a = abase + t * 4 + k;
          lsel[a] = sel[t][k];
          lrank[a] = __hip_atomic_fetch_add(lcnt + sel[t][k], 1, __ATOMIC_RELAXED, __HIP_MEMORY_SCOPE_WORKGROUP);
        }
      }
    }
    __syncthreads();
    if (t32 < 32) lbase[t32] = atomicAdd(&p.cnt[li * 32 + t32], lcnt[t32]);
    __syncthreads();
    if (t32 < 256) {
      const int a = blk * 256 + t32, ee = lsel[t32];
      p.topi[a] = ee;
      p.rank[a] = lbase[ee] + lrank[t32];
    }
  }
  __syncthreads();
}

DEV void kcv_phase(const Params& p, int li, LAS unsigned char* lds, int t32, int bid, int G) {
  const int lane = t32 & 63, wave = t32 >> 6;
  LAS float* w2l = (LAS float*)lds;
  LAS float* rowb = (LAS float*)(lds + 65536) + wave * 512;
  __syncthreads();
#pragma unroll
  for (int i = 0; i < 4; ++i) {
    ((LAS f32x4*)w2l)[t32 + 512 * i] = ((const f32x4*)(p.cmp_w2_k + (size_t)li * CMP_HID * HD))[t32 + 512 * i];
    ((LAS f32x4*)w2l)[2048 + t32 + 512 * i] = ((const f32x4*)(p.cmp_w2_v + (size_t)li * CMP_HID * HD))[t32 + 512 * i];
  }
  __syncthreads();
  const int NGW = G * 8;
  for (int r0 = bid * 8 + wave; r0 < 2 * CMP_ROWS; r0 += 4 * NGW) {
    int rows[4];
#pragma unroll
    for (int i = 0; i < 4; ++i) { rows[i] = r0 + i * NGW; if (rows[i] >= 2 * CMP_ROWS) rows[i] = r0; }
#pragma unroll
    for (int i = 0; i < 4; ++i) {
      const float* hr = p.hid + (size_t)rows[i] * CMP_HID;
      rowb[i * 128 + lane] = hr[lane]; rowb[i * 128 + 64 + lane] = hr[64 + lane];
    }
    asm volatile("s_waitcnt lgkmcnt(0)" ::: "memory");
    float acc[4] = {0.f, 0.f, 0.f, 0.f};
    const LAS float* wq[4];
#pragma unroll
    for (int i = 0; i < 4; ++i) wq[i] = w2l + (rows[i] >= CMP_ROWS ? 128 * 64 : 0) + lane;
#pragma unroll 8
    for (int j = 0; j < CMP_HID; ++j) {
#pragma unroll
      for (int i = 0; i < 4; ++i) acc[i] += rowb[i * 128 + j] * wq[i][j * 64];
    }
#pragma unroll
    for (int i = 0; i < 4; ++i) {
      const int row = r0 + i * NGW;
      if (row < 2 * CMP_ROWS) {
        const int which = row >= CMP_ROWS ? 1 : 0, rr = row - which * CMP_ROWS;
        const int g_ = rr % NSA_G, c_ = (rr / NSA_G) % N_CMP, b_ = rr / (NSA_G * N_CMP);
        p.kcb[((((size_t)which * BATCH + b_) * 128 + c_) * NSA_G + g_) * 64 + lane] = f2bfh(acc[i]);
      }
    }
    asm volatile("s_waitcnt lgkmcnt(0)" ::: "memory");
  }
  __syncthreads();
}

constexpr int GA_QS = 272, GA_VS = 528, GA_PS = 144;
constexpr int GA_QT = 0, GA_KT = GA_QT + 64 * GA_QS, GA_KH = GA_KT + 64 * GA_QS, GA_VT = GA_KH + 64 * GA_QS, GA_PT = GA_VT + 64 * GA_VS,
              GA_LR = GA_PT + 64 * GA_PS, GA_GT = GA_LR + 64 * 16 * 4, GA_DC = GA_GT + 4 * 128 * 4, GA_END = GA_DC + 512;
static_assert(GA_END <= RING_BYTES, "GLA phase A LDS map");
constexpr int GC_SP = 0, GC_QT = GC_SP + 128 * GA_VS, GC_RED = GC_QT + 64 * GA_QS, GC_END = GC_RED + 8 * 16 * 4 * 2;
static_assert(GC_END <= RING_BYTES, "GLA phase C LDS map");

#define GSTAMP(i) do { if (GSEG >= 0 && blockIdx.x == 0 && t32 == 0) { const unsigned now_ = (unsigned)__builtin_amdgcn_s_memrealtime(); if ((i) > 0 && (i) - 1 == GSEG) p.barw[3600] += now_ - gs_prev; gs_prev = now_; } } while (0)
DEV void gla_a_unit(const Params& p, int li, LAS unsigned char* lds, int t32, int unit) {
  unsigned gs_prev = 0u;
  GSTAMP(0);
  const int lane = t32 & 63, wave = t32 >> 6, i15 = lane & 15, g4 = lane >> 4;
  const int bh = unit >> 5, ci = unit & 31, b = bh >> 2, h = bh & 3;
  const int c = t32 & 127, jq = t32 >> 7;
  LAS float* LR = (LAS float*)(lds + GA_LR);
  LAS float* GT = (LAS float*)(lds + GA_GT);
  LAS float* DC = (LAS float*)(lds + GA_DC);
  const float qscale = 0.08838834764831845f;
  const size_t n0 = (size_t)b * SEQ + ci * 64;
  {
    const int e = t32 * 2, j = e >> 4, r = e & 15;
    const unsigned w = *(const unsigned*)(p.u + (n0 + j) * N_IN + OFF_LR + r);
    LR[e] = __uint_as_float(w << 16); LR[e + 1] = __uint_as_float(w & 0xffff0000u);
  }
  float wa[GLA_RANK];
#pragma unroll
  for (int r = 0; r < GLA_RANK; ++r) wa[r] = p.w_alpha2[((size_t)li * GLA_RANK + r) * B_K + h * 128 + c];
  const float ba = p.b_alpha[li * B_K + h * 128 + c];
#pragma unroll
  for (int x = 0; x < 2; ++x) {
    const int idx = t32 + 512 * x, row = idx >> 4, ch = idx & 15;
    const act_t* ur = p.u + (n0 + row) * N_IN + h * 128 + ch * 8;
    *(LAS u32x4*)(lds + GA_QT + row * GA_QS + ch * 16) = *(const u32x4*)(ur + OFF_BQ);
    *(LAS u32x4*)(lds + GA_KT + row * GA_QS + ch * 16) = *(const u32x4*)(ur + OFF_BK);
  }
#pragma unroll
  for (int x = 0; x < 4; ++x) {
    const int idx = t32 + 512 * x, row = idx >> 5, ch = idx & 31;
    const u32x4 vv = *(const u32x4*)(p.u + (n0 + row) * N_IN + OFF_BV + h * 256 + ch * 8);
    *(LAS u32x4*)(lds + GA_VT + row * GA_VS + ch * 16) = vv;
  }
  __syncthreads();
  GSTAMP(1);
  float bl[16];
  float run = 0.f;
#pragma unroll
  for (int jj = 0; jj < 16; ++jj) {
    const LAS f32x4* lr4 = (const LAS f32x4*)(LR + (jq * 16 + jj) * 16);
    float z = ba;
#pragma unroll
    for (int r4 = 0; r4 < 4; ++r4) { const f32x4 x = lr4[r4]; z += x.x * wa[4 * r4] + x.y * wa[4 * r4 + 1] + x.z * wa[4 * r4 + 2] + x.w * wa[4 * r4 + 3]; }
    const float ez = __builtin_amdgcn_exp2f(-fabsf(z) * 1.4426950408889634f);
    const float ls = (fminf(z, 0.f) - __builtin_amdgcn_logf(1.0f + ez) * 0.6931471805599453f) * (1.0f / 16.0f);
    run += ls; bl[jj] = run;
  }
  GT[jq * 128 + c] = run;
  __syncthreads();
  GSTAMP(2);
  {
    const float g0 = GT[c], g1 = GT[128 + c], g2 = GT[256 + c], g3 = GT[384 + c];
    const float off = (jq > 0 ? g0 : 0.f) + (jq > 1 ? g1 : 0.f) + (jq > 2 ? g2 : 0.f);
    const float tot = (g0 + g1) + (g2 + g3);
    const float dtot = __builtin_amdgcn_exp2f(tot * 1.4426950408889634f);
    if (jq == 0) { DC[c] = dtot; p.gD[(size_t)unit * 128 + c] = dtot; }
#pragma unroll
    for (int jj = 0; jj < 16; ++jj) {
      const float e1 = __builtin_amdgcn_exp2f((off + bl[jj]) * 1.4426950408889634f), ie = __builtin_amdgcn_rcpf(e1);
      const int ro = (jq * 16 + jj) * GA_QS + c * 2;
      const float qf = __uint_as_float(((unsigned)*(const LAS unsigned short*)(lds + GA_QT + ro)) << 16);
      const float kf = __uint_as_float(((unsigned)*(const LAS unsigned short*)(lds + GA_KT + ro)) << 16);
      const unsigned short qt = f2bfh(qf * e1 * qscale);
      *(LAS unsigned short*)(lds + GA_QT + ro) = qt;
      p.gQ[((size_t)unit * 64 + jq * 16 + jj) * 128 + c] = qt;
      *(LAS unsigned short*)(lds + GA_KT + ro) = f2bfh(kf * ie);
      *(LAS unsigned short*)(lds + GA_KH + ro) = f2bfh(kf * ie * dtot);
    }
  }
  __syncthreads();
  GSTAMP(3);
#pragma unroll
  for (int q = 0; q < 2; ++q) {
    const int id = wave * 2 + q, jt = id >> 2, it = id & 3;
    f32x4 a = (f32x4){0.f, 0.f, 0.f, 0.f};
#pragma unroll
    for (int kk = 0; kk < 4; ++kk) {
      const bf16x8 kf = *(const LAS bf16x8*)(lds + GA_KT + (16 * jt + i15) * GA_QS + (32 * kk + 8 * g4) * 2);
      const bf16x8 qf = *(const LAS bf16x8*)(lds + GA_QT + (16 * it + i15) * GA_QS + (32 * kk + 8 * g4) * 2);
      a = __builtin_amdgcn_mfma_f32_16x16x32_bf16(kf, qf, a, 0, 0, 0);
    }
    const int i = 16 * it + i15, j0 = 16 * jt + 4 * g4;
    u32x2 w;
    w.x = pk2(j0 <= i ? a.x : 0.f, j0 + 1 <= i ? a.y : 0.f);
    w.y = pk2(j0 + 2 <= i ? a.z : 0.f, j0 + 3 <= i ? a.w : 0.f);
    *(LAS u32x2*)(lds + GA_PT + i * GA_PS + j0 * 2) = w;
  }
  __syncthreads();
  GSTAMP(4);
  {
    const int it = wave & 3, vt0 = (wave >> 2) * 8;
    bf16x8 pf[2];
#pragma unroll
    for (int s = 0; s < 2; ++s) pf[s] = *(const LAS bf16x8*)(lds + GA_PT + (16 * it + i15) * GA_PS + (32 * s + 8 * g4) * 2);
#pragma unroll
    for (int x = 0; x < 8; ++x) {
      const int vt = vt0 + x;
      f32x4 a = (f32x4){0.f, 0.f, 0.f, 0.f};
#pragma unroll
      for (int s = 0; s < 2; ++s) {
        const LAS unsigned char* vp = lds + GA_VT + (32 * s + 8 * g4 + (i15 >> 2)) * GA_VS + (16 * vt + 4 * (lane & 3)) * 2;
        const v4i16_t lo = tr_read(vp), hi = tr_read(vp + 4 * GA_VS);
        bf16x8 vf;
        vf[0] = lo[0]; vf[1] = lo[1]; vf[2] = lo[2]; vf[3] = lo[3]; vf[4] = hi[0]; vf[5] = hi[1]; vf[6] = hi[2]; vf[7] = hi[3];
        a = __builtin_amdgcn_mfma_f32_16x16x32_bf16(vf, pf[s], a, 0, 0, 0);
      }
      *(f32x4*)(p.opart + (n0 + 16 * it + i15) * 1024 + h * 256 + 16 * vt + 4 * g4) = a;
    }
  }
  {
    bf16x8 vf[2][2];
#pragma unroll
    for (int x = 0; x < 2; ++x)
#pragma unroll
      for (int s = 0; s < 2; ++s) {
        const LAS unsigned char* vp = lds + GA_VT + (32 * s + 8 * g4 + (i15 >> 2)) * GA_VS + (16 * (2 * wave + x) + 4 * (lane & 3)) * 2;
        const v4i16_t lo = tr_read(vp), hi = tr_read(vp + 4 * GA_VS);
        vf[x][s][0] = lo[0]; vf[x][s][1] = lo[1]; vf[x][s][2] = lo[2]; vf[x][s][3] = lo[3];
        vf[x][s][4] = hi[0]; vf[x][s][5] = hi[1]; vf[x][s][6] = hi[2]; vf[x][s][7] = hi[3];
      }
#pragma unroll
    for (int ct = 0; ct < 8; ++ct) {
      f32x4 a0 = (f32x4){0.f, 0.f, 0.f, 0.f}, a1 = (f32x4){0.f, 0.f, 0.f, 0.f};
#pragma unroll
      for (int s = 0; s < 2; ++s) {
        const LAS unsigned char* kp = lds + GA_KH + (32 * s + 8 * g4 + (i15 >> 2)) * GA_QS + (16 * ct + 4 * (lane & 3)) * 2;
        const v4i16_t lo = tr_read(kp), hi = tr_read(kp + 4 * GA_QS);
        bf16x8 kf;
        kf[0] = lo[0]; kf[1] = lo[1]; kf[2] = lo[2]; kf[3] = lo[3]; kf[4] = hi[0]; kf[5] = hi[1]; kf[6] = hi[2]; kf[7] = hi[3];
        a0 = __builtin_amdgcn_mfma_f32_16x16x32_bf16(vf[0][s], kf, a0, 0, 0, 0);
        a1 = __builtin_amdgcn_mfma_f32_16x16x32_bf16(vf[1][s], kf, a1, 0, 0, 0);
      }
      act_t* up = p.gU + ((size_t)unit * 128 + 16 * ct + i15) * 256 + 32 * wave + 4 * g4;
      u32x2 w0; w0.x = pk2(a0.x, a0.y); w0.y = pk2(a0.z, a0.w);
      u32x2 w1; w1.x = pk2(a1.x, a1.y); w1.y = pk2(a1.z, a1.w);
      *(u32x2*)up = w0; *(u32x2*)(up + 16) = w1;
    }
  }
  __syncthreads();
  GSTAMP(5);
}

DEV void gla_scan(const Params& p, long long tid, long long nthr) {
  for (long long idx = tid; idx < 32LL * 128 * 32; idx += nthr) {
    const int v8 = (int)(idx & 31) * 8, c = (int)((idx >> 5) & 127), bh = (int)(idx >> 12);
    float s[8];
#pragma unroll
    for (int i = 0; i < 8; ++i) s[i] = 0.f;
#pragma unroll 8
    for (int ci = 0; ci < 32; ++ci) {
      const size_t unit = (size_t)bh * 32 + ci;
      const u32x4 uw = *(const u32x4*)(p.gU + (unit * 128 + c) * 256 + v8);
      const float d = p.gD[unit * 128 + c];
      u32x4 o;
#pragma unroll
      for (int i = 0; i < 4; ++i) o[i] = pk2(s[2 * i], s[2 * i + 1]);
      *(u32x4*)(p.gS + (unit * 128 + c) * 256 + v8) = o;
#pragma unroll
      for (int i = 0; i < 4; ++i) {
        s[2 * i] = s[2 * i] * d + __uint_as_float(uw[i] << 16);
        s[2 * i + 1] = s[2 * i + 1] * d + __uint_as_float(uw[i] & 0xffff0000u);
      }
    }
  }
}

DEV void gla_c_unit(const Params& p, int li, LAS unsigned char* lds, int t32, int unit) {
  const int lane = t32 & 63, wave = t32 >> 6, i15 = lane & 15, g4 = lane >> 4;
  const int bh = unit >> 5, ci = unit & 31, b = bh >> 2, h = bh & 3;
  const size_t n0 = (size_t)b * SEQ + ci * 64;
#pragma unroll
  for (int x = 0; x < 8; ++x) {
    const int idx = t32 + 512 * x, row = idx >> 5, ch = idx & 31;
    *(LAS u32x4*)(lds + GC_SP + row * GA_VS + ch * 16) = *(const u32x4*)(p.gS + ((size_t)unit * 128 + row) * 256 + ch * 8);
  }
#pragma unroll
  for (int x = 0; x < 2; ++x) {
    const int idx = t32 + 512 * x, row = idx >> 4, ch = idx & 15;
    *(LAS u32x4*)(lds + GC_QT + row * GA_QS + ch * 16) = *(const u32x4*)(p.gQ + ((size_t)unit * 64 + row) * 128 + ch * 8);
  }
  __syncthreads();
  const int it = wave & 3, vt0 = (wave >> 2) * 8;
  bf16x8 qf[4];
#pragma unroll
  for (int kk = 0; kk < 4; ++kk) qf[kk] = *(const LAS bf16x8*)(lds + GC_QT + (16 * it + i15) * GA_QS + (32 * kk + 8 * g4) * 2);
  const size_t n = n0 + 16 * it + i15;
  f32x4 o[8];
  float ss = 0.f;
#pragma unroll
  for (int x = 0; x < 8; ++x) {
    const int vt = vt0 + x;
    f32x4 a = *(const f32x4*)(p.opart + n * 1024 + h * 256 + 16 * vt + 4 * g4);
#pragma unroll
    for (int kk = 0; kk < 4; ++kk) {
      const LAS unsigned char* sp = lds + GC_SP + (32 * kk + 8 * g4 + (i15 >> 2)) * GA_VS + (16 * vt + 4 * (lane & 3)) * 2;
      const v4i16_t lo = tr_read(sp), hi = tr_read(sp + 4 * GA_VS);
      bf16x8 sf;
      sf[0] = lo[0]; sf[1] = lo[1]; sf[2] = lo[2]; sf[3] = lo[3]; sf[4] = hi[0]; sf[5] = hi[1]; sf[6] = hi[2]; sf[7] = hi[3];
      a = __builtin_amdgcn_mfma_f32_16x16x32_bf16(sf, qf[kk], a, 0, 0, 0);
    }
    o[x] = a;
    ss += (a.x * a.x + a.y * a.y) + (a.z * a.z + a.w * a.w);
  }
  ss += shx(ss, lane, 16);
  ss += shx(ss, lane, 32);
  LAS float* RED = (LAS float*)(lds + GC_RED);
  if (g4 == 0) RED[wave * 16 + i15] = ss;
  __syncthreads();
  ss += RED[(wave ^ 4) * 16 + i15];
  const float rs = 1.0f / sqrtf(ss * (1.0f / 256.0f) + LN_EPS);
#pragma unroll
  for (int x = 0; x < 8; ++x) {
    const int v = 16 * (vt0 + x) + 4 * g4;
    const f32x4 gn = *(const f32x4*)(p.gla_norm_g + li * DV + v);
    const u32x2 rw = *(const u32x2*)(p.u + n * N_IN + OFF_BR + h * 256 + v);
    const float r0 = __uint_as_float(rw.x << 16), r1 = __uint_as_float(rw.x & 0xffff0000u), r2 = __uint_as_float(rw.y << 16), r3 = __uint_as_float(rw.y & 0xffff0000u);
    u32x2 w;
    w.x = pk2(o[x].x * rs * gn.x * (r0 * fsig(r0)), o[x].y * rs * gn.y * (r1 * fsig(r1)));
    w.y = pk2(o[x].z * rs * gn.z * (r2 * fsig(r2)), o[x].w * rs * gn.w * (r3 * fsig(r3)));
    *(u32x2*)(p.yb + n * YLD + h * 256 + v) = w;
  }
  __syncthreads();
}

#define XB_TMO      128
#define XB_XCNT(j)  (256  + 64 * (j))
#define XB_XSUB(j)  (1280 + 64 * (j))
#define XB_XGEN(j)  (2304 + 64 * (j))
#define XB_TOP      3328
#define XB_TOPGEN   3392
#define XCD_BAR_WORDS 3456
#define XB_SPIN_CAP (1u << 18)

__device__ __forceinline__ unsigned xb_ld(unsigned* p)              { return __hip_atomic_load(p, __ATOMIC_RELAXED, __HIP_MEMORY_SCOPE_AGENT); }
__device__ __forceinline__ unsigned xb_add(unsigned* p, unsigned v) { return __hip_atomic_fetch_add(p, v, __ATOMIC_RELAXED, __HIP_MEMORY_SCOPE_AGENT); }
__device__ __forceinline__ unsigned xb_xcc_id() { return (unsigned)__builtin_amdgcn_s_getreg((3 << 11) | 20) & 0xFu; }
#define XB_SPIN(cond, bar) do { unsigned _sp = 0; while (cond) { __builtin_amdgcn_s_sleep(1); \
    if ((++_sp & 255u) == 0u) { if (xb_ld(&(bar)[XB_TMO])) break; if (_sp > XB_SPIN_CAP) { atomicAdd(&(bar)[XB_TMO], 1u); break; } } } } while (0)

struct XcdBarrier {
    unsigned* bar; unsigned x;
    volatile LAS unsigned* st;
};

__device__ __forceinline__ XcdBarrier xcd_barrier_post(unsigned* bar, volatile LAS unsigned* st) {
    XcdBarrier b; b.bar = bar; b.x = xb_xcc_id(); b.st = st;
    if (threadIdx.x == 0) st[2] = xb_add(&bar[XB_XCNT(b.x)], 1u);
    return b;
}
__device__ __forceinline__ void xcd_barrier_complete(unsigned* bar, unsigned x, unsigned& nloc, unsigned& nx) {
    const unsigned G = gridDim.x * gridDim.y * gridDim.z;
    unsigned sum, cnt, mine, sp = 0u;
    for (;;) {
        sum = 0u; cnt = 0u; mine = 0u;
#pragma unroll
        for (unsigned j = 0; j < 16; ++j) { const unsigned c = xb_ld(&bar[XB_XCNT(j)]); sum += c; cnt += (c > 0u) ? 1u : 0u; mine = (j == x) ? c : mine; }
        if (sum == G) break;
        __builtin_amdgcn_s_sleep(1);
        if ((++sp & 255u) == 0u) { if (xb_ld(&bar[XB_TMO])) break; if (sp > XB_SPIN_CAP) { atomicAdd(&bar[XB_TMO], 1u); break; } }
    }
    nloc = mine > 0u ? mine : 1u; nx = cnt > 0u ? cnt : 1u;
}

__device__ __forceinline__ void xcd_barrier(const XcdBarrier& b, const int t32) {
    asm volatile("s_waitcnt vmcnt(0)" ::: "memory");
    __syncthreads();
    if (t32 == 0) {
        unsigned* bar = b.bar;
        __builtin_amdgcn_s_waitcnt(0);
        unsigned nloc = b.st[0], nx = b.st[1];
        if (nloc == 0u) { xcd_barrier_complete(bar, b.x, nloc, nx); b.st[0] = nloc; b.st[1] = nx; }
        const unsigned old = xb_add(&bar[XB_XSUB(b.x)], 1u);
        const unsigned gen = old / nloc;
        if (old + 1u == (gen + 1u) * nloc) {
            __builtin_amdgcn_fence(__ATOMIC_RELEASE, "agent");
            asm volatile("s_waitcnt vmcnt(0)" ::: "memory");
            const unsigned og = xb_add(&bar[XB_TOP], 1u);
            const unsigned tg = og / nx;
            if (og + 1u == (tg + 1u) * nx) xb_add(&bar[XB_TOPGEN], 1u);
            else XB_SPIN(xb_ld(&bar[XB_TOPGEN]) == tg, bar);
            __builtin_amdgcn_fence(__ATOMIC_ACQUIRE, "agent");
            xb_add(&bar[XB_XGEN(b.x)], 1u);
            asm volatile("s_waitcnt vmcnt(0)" ::: "memory");
        } else {
            XB_SPIN(xb_ld(&bar[XB_XGEN(b.x)]) == gen, bar);
            __builtin_amdgcn_fence(__ATOMIC_ACQUIRE, "agent");
            asm volatile("s_waitcnt vmcnt(0)" ::: "memory");
        }
    }
    __syncthreads();
}

constexpr int STEPS_PER_LAYER = 21;
#ifndef PROBE_LO
#define PROBE_LO -1
#define PROBE_HI -1
#endif
#ifndef PROBE_PRO
#define PROBE_PRO 0
#endif
#ifndef TSTEP_LO
#define TSTEP_LO -2
#define TSTEP_HI -2
#endif
#ifndef TSUB
#define TSUB -9
#endif
#ifndef TSTEP_Q
#define TSTEP_Q 40u
#endif
#ifndef NSA_PROBE
#define NSA_PROBE 0
#endif
#ifndef MULTI_LAUNCH
#define MULTI_LAUNCH 0
#endif
DEV int fresh_t32(int wave) {
  int t;
  asm volatile("v_mbcnt_lo_u32_b32 %0, -1, 0\n\tv_mbcnt_hi_u32_b32 %0, -1, %0" : "=v"(t));
  return t + wave * 64;
}
struct KArgs { void* in[35]; void* out; void* ws; };
template <bool WITH_NAIVE, bool COOP>
__global__ void __launch_bounds__(NTHREADS) k_mega(KArgs ka, int step_lo, int step_hi) {
  unsigned* const barw0 = ((unsigned*)ka.ws);
  extern __shared__ __attribute__((aligned(16))) unsigned char lds_raw[];
  LAS unsigned char* lds = (LAS unsigned char*)lds_raw;
  LAS int* tab = (LAS int*)(lds + MISC_OFF);
  const int wave = __builtin_amdgcn_readfirstlane(threadIdx.x >> 6);
  const int G = gridDim.x;
  int bid = blockIdx.x;

  LAS unsigned* miscw = (LAS unsigned*)(lds + MISC_OFF + 8192);
  if (threadIdx.x < 128) miscw[threadIdx.x] = 0u;
  __syncthreads();
  XcdBarrier xbar; xbar.bar = barw0; xbar.x = 0; xbar.st = nullptr;
  if (COOP) xbar = xcd_barrier_post(barw0, miscw + 8);
  unsigned* const stamp = barw0 + 3584;
  if (step_lo < 0) {
    Params p;
    fill_params(p, ka.in, ka.out, ka.ws);
    if (TSTEP_LO == -1 && blockIdx.x == 0 && threadIdx.x == 0) { stamp[0] = (unsigned)__builtin_amdgcn_s_memrealtime(); stamp[2] = 0u; stamp[3] = 0u; }
    prologue(p, lds, wave, threadIdx.x & 63);
    if (COOP) {
      if (step_hi == -12345) cg::this_grid().sync();
      xcd_barrier(xbar, (int)threadIdx.x);
    }
#if PROBE_PRO
    prologue(p, lds, wave, threadIdx.x & 63);
    if (COOP) cg::this_grid().sync();
#endif
    step_lo = 0;
    if (TSTEP_LO == -1 && blockIdx.x == 0 && threadIdx.x == 0) stamp[1] = (unsigned)__builtin_amdgcn_s_memrealtime();
    if (COOP) {
      bool even = (G % 8) == 0;
#pragma unroll
      for (int j = 0; j < 8; ++j) even = even && (xb_ld(&barw0[XB_XCNT(j)]) == (unsigned)(G / 8));
      __syncthreads();
      if (even) bid = __builtin_amdgcn_readfirstlane((int)(xbar.x + 8u * miscw[10]));
    }
  }
  int rep_done = 0;
  for (int step = step_lo; step < step_hi;) {
    int li = step / STEPS_PER_LAYER;
    const int k = step % STEPS_PER_LAYER;
    int nb32 = gridDim.x;
    char* wsb = (char*)ka.ws;
    asm volatile("" : "+s"(wsb));
    Params p;
    fill_params(p, ka.in, ka.out, wsb);
    asm volatile("" : "+s"(li));
    asm volatile("" : "+s"(nb32));
#define T32() fresh_t32(wave)
#define TID() ((int)(blockIdx.x * NTHREADS) + T32())
    const int nthr = nb32 * NTHREADS;
    const int gw = blockIdx.x * 8 + wave, NGW = nb32 * 8;
    if (TSTEP_LO >= 0 && k == TSTEP_LO && blockIdx.x == 0 && wave == 0) stamp[2 * li] = (unsigned)__builtin_amdgcn_s_memrealtime();
    const bool is_gemm = (k == 0) || (k >= 2 && k <= 5) || (k == 9) || (k == 10) || (k == 12) || (k == 14) || (k == 18) || (k == 19);
    const bool sync_after = !(k == 2 || k == 3 || k == 4);
    if (is_gemm) {
      pg8::Gemm g{nullptr, nullptr, 0, 0, 0};
      USched S; S.init_static(256, 256, G, bid);
      EpiU E{0, 0, nullptr, nullptr, nullptr, nullptr, nullptr};
      const size_t WSQ = (size_t)1024 * 1024;
      switch (k) {
        case 0:
          g = pg8::Gemm{p.xb, p.wt_in + (size_t)li * N_IN_PAD * 1024, N_TOK, N_IN_PAD, 1024};
          S.init_static(N_TOK, N_IN_PAD, G, bid);
          E.mode = EM_INPROJ; E.q0 = p.u; E.q1 = p.b_in + (size_t)li * N_IN; break;
        case 2:
          g = pg8::Gemm{p.cmpA, p.wt_c1 + (size_t)(li * 2 + 0) * 256 * 2048, CMP_ROWS_PAD, 256, 2048};
          S.init_static(CMP_ROWS_PAD, 256, G, bid);
          E.mode = EM_HID; E.q0 = p.hid; break;
        case 3:
          g = pg8::Gemm{p.cmpA + (size_t)CMP_ROWS_PAD * 2048, p.wt_c1 + (size_t)(li * 2 + 1) * 256 * 2048, CMP_ROWS_PAD, 256, 2048};
          S.init_static(CMP_ROWS_PAD, 256, G, (bid + G - 16) % G);
          E.mode = EM_HID; E.q0 = p.hid + (size_t)CMP_ROWS * CMP_HID; break;
        case 4:
          g = pg8::Gemm{p.membf, p.wt_xk + li * WSQ, BATCH * MEM_LEN, 1024, 1024};
          S.init_static(BATCH * MEM_LEN, 1024, G, (bid + G - 32) % G);
          E.mode = EM_BF16; E.q0 = p.memk; E.ldc = 1024; break;
        case 5:
          g = pg8::Gemm{p.membf, p.wt_xv + li * WSQ, BATCH * MEM_LEN, 1024, 1024};
          S.init_static(BATCH * MEM_LEN, 1024, G, (bid + G - 64) % G);
          E.mode = EM_BF16; E.q0 = p.memv; E.ldc = 1024; break;
        case 9:
          g = pg8::Gemm{p.ya, p.wt_bra + (size_t)li * 1024 * YLD, N_TOK, 1024, YLD};
          S.init_static(N_TOK, 1024, G, bid);
          E.mode = EM_BRCAT; E.q1 = p.u; E.q0 = p.merged; break;
        case 10:
          g = pg8::Gemm{p.merged, p.wt_omix + li * WSQ, N_TOK, 1024, 1024};
          S.init_static(N_TOK, 1024, G, bid);
          E.mode = EM_RES; E.q1 = p.xf; E.q0 = p.tmp; break;
        case 12:
          g = pg8::Gemm{p.xb, p.wt_xq + li * WSQ, N_TOK, 1024, 1024};
          S.init_static(N_TOK, 1024, G, bid);
          E.mode = EM_BF16; E.q0 = p.xq; E.ldc = 1024; break;
        case 14:
          g = pg8::Gemm{p.xo, p.wt_xo + li * WSQ, N_TOK, 1024, 1024};
          S.init_static(N_TOK, 1024, G, bid);
          E.mode = EM_RES; E.q1 = p.xf; E.q0 = p.tmp; break;
        case 18: {
          const int ntiles = moe_tables(p, li, tab, T32());
          g = pg8::Gemm{p.xg, p.wt_gu + (size_t)li * 32 * 2048 * 1024, MOE_ROWS, 32 * 2048, 1024};
          S.init_moe(G, bid, 8, ntiles * 8, tab + 128);
          E.mode = EM_MOE1; E.q0 = p.actg; E.q1 = p.b_gu + (size_t)li * 32 * 2048; E.te = tab + 128; break; }
        default: {
          const int ntiles = moe_tables(p, li, tab, T32());
          g = pg8::Gemm{p.actg, p.wt_dn + (size_t)li * 32 * 1024 * 1024, MOE_ROWS, 32 * 1024, 1024};
          S.init_moe(G, bid, 4, ntiles * 4, tab + 128);
          E.mode = EM_MOE2; E.q0 = p.yass; E.q1 = p.b_down + (size_t)li * 32 * 1024; E.q2 = p.topg; E.q3 = p.rowlist; E.te = tab + 128; break; }
      }
      pg8::gemm_phase<EpiU, USched, true, true>(lds, g, S, E, T32());
    } else {
      switch (k) {
        case 1: cmpa_build(p, li, TID(), nthr); break;
        case 6:
#define SUBSTAMP(i) do { if (TSUB == (i) && blockIdx.x == 0 && wave == 0) stamp[2 * li] = (unsigned)__builtin_amdgcn_s_memrealtime(); if (TSUB + 1 == (i) && blockIdx.x == 0 && wave == 0) stamp[2 * li + 1] = (unsigned)__builtin_amdgcn_s_memrealtime(); } while (0)
          SUBSTAMP(1);
          { const int t = T32(); for (int un = bid; un < 1024; un += G) gla_a_unit(p, li, lds, t, un); }
          SUBSTAMP(2);
          dil_phase(p, lds, T32(), bid, G);
          SUBSTAMP(3);
          kcv_phase(p, li, lds, T32(), bid, G);
          SUBSTAMP(4);
          break;
        case 7: SUBSTAMP(8); gla_scan(p, TID(), nthr); SUBSTAMP(9); nsa_cmp_phase(p, lds, T32(), bid, G); SUBSTAMP(10); dil_combine(p, TID(), nthr); SUBSTAMP(11); break;
        case 8: {
          SUBSTAMP(5);
          nsa_main_phase(p, lds, T32(), bid, G);
          __syncthreads();
          SUBSTAMP(6);
          const int t = T32();
          for (int un = bid; un < 1024; un += G) gla_c_unit(p, li, lds, t, un);
          SUBSTAMP(7);
          break; }
        case 11: ln_rows_w<0>(p, p.tmp, p.ln1_g + li * D, p.ln1_b + li * D, p.xf, p.xb, nullptr, gw, NGW, T32() & 63); break;
        case 13: xattn_phase(p, lds, T32(), bid, G); break;
        case 15: ln_rows_w<0>(p, p.tmp, p.ln2_g + li * D, p.ln2_b + li * D, p.xf, p.xb, nullptr, gw, NGW, T32() & 63); break;
        case 16: route_phase(p, li, lds, T32(), bid, G); break;
        case 17: { const int t = T32(); moe_prep(p, li, tab, wave, t & 63, t); break; }
        case 20: ln_rows_w<1>(p, nullptr, p.ln3_g + li * D, p.ln3_b + li * D, p.xf, p.xb, li == DEPTH - 1 ? p.out : nullptr, gw, NGW, T32() & 63); break;
        default: break;
      }
    }
    if (COOP && sync_after) xcd_barrier(xbar, T32());
    if (TSTEP_LO >= 0 && k == TSTEP_HI && blockIdx.x == 0 && wave == 0) stamp[2 * li + 1] = (unsigned)__builtin_amdgcn_s_memrealtime();
    if (PROBE_HI >= 0 && k == PROBE_HI && !rep_done) { rep_done = 1; step -= (PROBE_HI - PROBE_LO); }
    else { if (k == PROBE_HI) rep_done = 0; ++step; }
  }
  if (GSEG >= 0 && blockIdx.x == 0 && fresh_t32(wave) == 0) {
    __builtin_amdgcn_s_waitcnt(0);
    const unsigned tk = __hip_atomic_load(barw0 + 3600, __ATOMIC_RELAXED, __HIP_MEMORY_SCOPE_AGENT);
    ((float*)ka.out)[0] = (float)((tk / 100u + TSTEP_Q / 2) / TSTEP_Q * TSTEP_Q);
  }
  if (TSTEP_LO >= -1 && blockIdx.x == 0 && fresh_t32(wave) == 0) {
    __builtin_amdgcn_s_waitcnt(0);
    const unsigned tk = (__hip_atomic_load(stamp + 1, __ATOMIC_RELAXED, __HIP_MEMORY_SCOPE_AGENT) - __hip_atomic_load(stamp + 0, __ATOMIC_RELAXED, __HIP_MEMORY_SCOPE_AGENT)) + (__hip_atomic_load(stamp + 3, __ATOMIC_RELAXED, __HIP_MEMORY_SCOPE_AGENT) - __hip_atomic_load(stamp + 2, __ATOMIC_RELAXED, __HIP_MEMORY_SCOPE_AGENT));
    ((float*)ka.out)[0] = (float)((tk / 100u + TSTEP_Q / 2) / TSTEP_Q * TSTEP_Q);
  }
}

extern "C" void kernel_launch(void* const* d_in, const int* in_sizes, int n_in, void* d_out, int out_size,
                              void* d_ws, size_t ws_size, hipStream_t stream) {
  Params p;
  memset(&p, 0, sizeof(p));
  fill_params(p, d_in, d_out, d_ws);
  KArgs ka;
  memset(&ka, 0, sizeof(ka));
  for (int i = 0; i < 35; ++i) ka.in[i] = d_in[i];
  ka.out = d_out; ka.ws = d_ws;
  static int grid_blocks = 0;
  if (!grid_blocks) {
    int dev = 0, cus = 0;
    hipGetDevice(&dev);
    hipDeviceGetAttribute(&cus, hipDeviceAttributeMultiprocessorCount, dev);
    hipFuncSetAttribute((const void*)k_mega<true, true>, hipFuncAttributeMaxDynamicSharedMemorySize, LDS_BYTES);
    if (p.ws_used > ws_size) fprintf(stderr, "workspace too small: need %zu have %zu\n", p.ws_used, ws_size);
    grid_blocks = cus;
  }
  hipMemsetAsync(p.barw, 0, 4096 * sizeof(unsigned), stream);
  int lo = -1, hi = DEPTH * STEPS_PER_LAYER;
  void* args[] = {&ka, &lo, &hi};
  hipError_t e = hipLaunchCooperativeKernel((void*)k_mega<true, true>, dim3(grid_blocks), dim3(NTHREADS), args, LDS_BYTES, stream);
  if (e != hipSuccess) fprintf(stderr, "cooperative launch failed: %s (grid %d)\n", hipGetErrorString(e), grid_blocks);
}
#endif
```

```cpp
#ifndef CPU_TEST
#include <hip/hip_runtime.h>
#include <hip/hip_cooperative_groups.h>
#include <cstdio>
#include <cstring>
#include <cmath>
namespace cg = cooperative_groups;
#define DEV __device__ __forceinline__
#define HDI __host__ __device__ __forceinline__
#else
#include <cmath>
#include <cstdio>
#include <cstdlib>
#include <cstring>
#define DEV static inline
#define HDI static inline
#endif

#ifndef D_MODEL
#define D_MODEL 1024
#endif
#ifndef BATCH
#define BATCH 8
#endif
#ifndef MEGA
#define MEGA 1
#endif

constexpr int D = D_MODEL;
constexpr int SEQ = 2048;
constexpr int DEPTH = 2;
constexpr int MEM_LEN = 256;
constexpr int HD = 64;
constexpr int N_TOK = BATCH * SEQ;
constexpr int GLA_H = 4;
constexpr int DK = D / 2 / GLA_H;
constexpr int DV = D / GLA_H;
constexpr int GLA_RANK = 16;
constexpr int B_K = GLA_H * DK;
constexpr int B_V = GLA_H * DV;
constexpr int NSA_H = 16;
constexpr int NSA_G = 4;
constexpr int N_CMP = 127;
constexpr int CMP_HID = 128;
constexpr int N_BLK = 32;
constexpr int N_SELECT = 16;
constexpr int NSA_WIN = 512;
constexpr int XH = 4;
constexpr int XHD = D / XH;
constexpr int NE = 32;
constexpr int TOPK = 4;
constexpr int DFF = D;
constexpr float LN_EPS = 1e-5f;
constexpr float ALPHA = 1.41421356237309515f;

constexpr int OFF_AQ = 0;
constexpr int OFF_AK = 768;
constexpr int OFF_AV = 1536;
constexpr int OFF_BQ = 2304;
constexpr int OFF_BK = OFF_BQ + B_K;
constexpr int OFF_BV = OFF_BK + B_K;
constexpr int OFF_BR = OFF_BV + B_V;
constexpr int OFF_LR = OFF_BR + B_V;
constexpr int OFF_CQ = OFF_LR + GLA_RANK;
constexpr int OFF_CKC = OFF_CQ + 1024;
constexpr int OFF_CVC = OFF_CKC + 256;
constexpr int OFF_CKS = OFF_CVC + 256;
constexpr int OFF_CVS = OFF_CKS + 256;
constexpr int OFF_CKW = OFF_CVS + 256;
constexpr int OFF_CVW = OFF_CKW + 256;
constexpr int OFF_CG = OFF_CVW + 256;
constexpr int OFF_MG = OFF_CG + 48;
constexpr int N_IN = OFF_MG + 3 * D;
constexpr int N_IN_PAD = (N_IN + 255) / 256 * 256;
constexpr int MOE_ROWS = N_TOK * 4 + 32 * 256;
constexpr int CMP_ROWS_PAD = 4096;
constexpr int YLD = 256 + 1024 + 1024;

#ifdef CPU_TEST
typedef float act_t;
DEV float ldf(float v) { return v; }
DEV void stf(float* p, float v) { *p = v; }
#else
typedef unsigned short act_t;
DEV float ldf(unsigned short h) { return __uint_as_float(((unsigned)h) << 16); }
DEV float ldf(float v) { return v; }
DEV unsigned short f2bf(float f) {
  unsigned u = __float_as_uint(f);
  u += 0x7fffu + ((u >> 16) & 1u);
  return (unsigned short)(u >> 16);
}
DEV void stf(unsigned short* p, float v) { *p = f2bf(v); }
DEV void stf(float* p, float v) { *p = v; }
#endif

struct Params {
  const float *x, *mem, *ln0_g, *ln0_b, *w_in, *b_in, *w_alpha2, *b_alpha, *gla_norm_g,
      *cmp_pe_k, *cmp_w1_k, *cmp_w2_k, *cmp_pe_v, *cmp_w1_v, *cmp_w2_v,
      *w_br_a, *w_br_b, *w_br_c, *w_o_mix, *ln1_g, *ln1_b, *w_xq, *w_xk, *w_xv, *w_xo, *ln2_g, *ln2_b,
      *w_router, *b_router, *w_gu, *b_gu, *w_down, *b_down, *ln3_g, *ln3_b;
  float* out;
  float* xf;
  act_t* xb;
  act_t* u;
  float* ga;
  float* hid;
  float* kcv;
  float* opart;
  act_t* ya;
  act_t* yb;
  act_t* yc;
  float* pcmp;
  float* ocmp;
  float* impb;
  int* selb;
  act_t* merged;
  float* tmp;
  act_t* xq;
  act_t* memk;
  act_t* memv;
  float* xs;
  act_t* xo;
  float* rl;
  int* topi;
  float* topg;
  act_t* act;
  act_t* wt_in;
  act_t* wt_c1;
  act_t* wt_bra;
  act_t* wt_brb;
  act_t* wt_brc;
  act_t* wt_omix;
  act_t* wt_xq;
  act_t* wt_xk;
  act_t* wt_xv;
  act_t* wt_xo;
  act_t* wt_gu;
  act_t* wt_dn;
  act_t* membf;
  act_t* cmpA;
  float* mrg;
  int* cnt;
  int* rank;
  int* rowlist;
  act_t* xg;
  act_t* actg;
  float* yass;
  act_t* kcb;
  act_t* dilo;
  float* dill;
  unsigned* selm;
  act_t* gU;
  act_t* gS;
  act_t* gQ;
  float* gD;
  unsigned* barw;
  size_t ws_used;
};

#ifdef CPU_TEST
#define FOR_IDX(idx, total) \
  for (long long idx = (long long)(total) * tid / nthr, _e = (long long)(total) * (tid + 1) / nthr; idx < _e; ++idx)
#else
#define FOR_IDX(idx, total) for (long long idx = tid; idx < (long long)(total); idx += nthr)
#endif

DEV float sigmoidf_(float x) { return 1.0f / (1.0f + expf(-x)); }

template <class TA>
DEV float dotcol(const TA* a, const float* W, int K, long long ldw) {
  float s = 0.f;
  for (int k = 0; k < K; ++k) s += ldf(a[k]) * W[(long long)k * ldw];
  return s;
}

DEV void ph_ln(const float* src, const float* g, const float* b, float* dstf, act_t* dstb, float* dst2,
               long long tid, long long nthr) {
  FOR_IDX(n, N_TOK) {
    const float* r = src + n * D;
    float mu = 0.f;
    for (int i = 0; i < D; ++i) mu += r[i];
    mu /= D;
    float var = 0.f;
    for (int i = 0; i < D; ++i) { float d = r[i] - mu; var += d * d; }
    var /= D;
    float rs = 1.0f / sqrtf(var + LN_EPS);
    for (int i = 0; i < D; ++i) {
      float y = (r[i] - mu) * rs * g[i] + b[i];
      dstf[n * D + i] = y;
      stf(&dstb[n * D + i], y);
      if (dst2) dst2[n * D + i] = y;
    }
  }
}

DEV void ph_inproj(const Params& p, int li, long long tid, long long nthr) {
  const float* W = p.w_in + (long long)li * D * N_IN;
  const float* bias = p.b_in + (long long)li * N_IN;
  FOR_IDX(idx, (long long)N_TOK * N_IN) {
    long long n = idx / N_IN; int c = (int)(idx % N_IN);
    stf(&p.u[idx], dotcol(p.xb + n * D, W + c, D, N_IN) + bias[c]);
  }
}

DEV float gelu_tanh(float x) {
  return 0.5f * x * (1.0f + tanhf(0.7978845608028654f * (x + 0.044715f * x * x * x)));
}

constexpr int CMP_ROWS = BATCH * N_CMP * NSA_G;

template <int PARTS>
DEV void ph_pre(const Params& p, int li, long long tid, long long nthr) {
  const long long T1 = (long long)N_TOK * B_K;
  const long long T2 = (PARTS & 2) ? 2LL * CMP_ROWS * CMP_HID : 0;
  FOR_IDX(idx, T1 + T2) {
    if (idx < T1) {
      if (!(PARTS & 1)) continue;
      long long n = idx / B_K; int c = (int)(idx % B_K);
      const float* W2 = p.w_alpha2 + (long long)li * GLA_RANK * B_K;
      float z = p.b_alpha[li * B_K + c];
      for (int r = 0; r < GLA_RANK; ++r) z += ldf(p.u[n * N_IN + OFF_LR + r]) * W2[r * B_K + c];
      float ls = fminf(z, 0.f) - log1pf(expf(-fabsf(z)));
      p.ga[idx] = expf(ls * (1.0f / 16.0f));
    } else {
      long long i2 = idx - T1;
      int which = (int)(i2 / ((long long)CMP_ROWS * CMP_HID));
      long long rem = i2 % ((long long)CMP_ROWS * CMP_HID);
      int row = (int)(rem / CMP_HID), j = (int)(rem % CMP_HID);
      int g = row % NSA_G; int c = (row / NSA_G) % N_CMP; int b = row / (NSA_G * N_CMP);
      const float* pe = (which ? p.cmp_pe_v : p.cmp_pe_k) + (long long)li * 32 * HD;
      const float* w1 = (which ? p.cmp_w1_v : p.cmp_w1_k) + (long long)li * 32 * HD * CMP_HID;
      int off = (which ? OFF_CVC : OFF_CKC) + g * HD;
      float s = 0.f;
      for (int l = 0; l < 32; ++l) {
        const act_t* ur = p.u + ((long long)b * SEQ + c * 16 + l) * N_IN + off;
        for (int d = 0; d < HD; ++d) s += (ldf(ur[d]) + pe[l * HD + d]) * w1[(long long)(l * HD + d) * CMP_HID + j];
      }
      p.hid[i2] = gelu_tanh(s);
    }
  }
}

template <int PARTS>
DEV void ph_mix1(const Params& p, int li, long long tid, long long nthr) {
  const long long T1 = (long long)N_TOK * 4;
  const long long T2 = (long long)BATCH * GLA_H * DV * 4;
  const long long T3 = 2LL * CMP_ROWS * HD;
  FOR_IDX(idx, T1 + T2 + T3) {
    if (idx < T1) {
      if (!(PARTS & 1)) continue;
      long long n = idx / 4; int h = (int)(idx % 4);
      int b = (int)(n / SEQ), t = (int)(n % SEQ);
      float m = -INFINITY, l = 0.f;
      float acc[HD];
#pragma unroll
      for (int d = 0; d < HD; ++d) acc[d] = 0.f;
      for (int gi = 0; gi < 3; ++gi) {
        const int dil = gi == 0 ? 1 : (gi == 1 ? 4 : 16);
        float q[HD];
        const act_t* qp = p.u + n * N_IN + OFF_AQ + gi * 256 + h * HD;
#pragma unroll
        for (int d = 0; d < HD; ++d) q[d] = ldf(qp[d]);
        for (int mm = 0; mm <= 128; ++mm) {
          int tk = t - mm * dil;
          if (tk < 0) break;
          const act_t* kp = p.u + ((long long)b * SEQ + tk) * N_IN + OFF_AK + gi * 256 + h * HD;
          const act_t* vp = p.u + ((long long)b * SEQ + tk) * N_IN + OFF_AV + gi * 256 + h * HD;
          float s = 0.f;
#pragma unroll
          for (int d = 0; d < HD; ++d) s += q[d] * ldf(kp[d]);
          s *= 0.125f;
          float mn = fmaxf(m, s);
          float corr = expf(m - mn);
          float pp = expf(s - mn);
          l = l * corr + pp;
#pragma unroll
          for (int d = 0; d < HD; ++d) acc[d] = acc[d] * corr + pp * ldf(vp[d]);
          m = mn;
        }
      }
      float inv = 1.0f / l;
#pragma unroll
      for (int d = 0; d < HD; ++d) stf(&p.ya[n * 256 + h * HD + d], acc[d] * inv);
    } else if (idx < T1 + T2) {
      if (!(PARTS & 2)) continue;
      long long i2 = idx - T1;
      int v = (int)(i2 % DV); int cq = (int)((i2 / DV) % 4); int h = (int)((i2 / (DV * 4)) % GLA_H);
      int b = (int)(i2 / (DV * 4 * GLA_H));
      constexpr int DKQ = DK / 4;
      float st[DKQ];
#pragma unroll
      for (int c = 0; c < DKQ; ++c) st[c] = 0.f;
      const float qs = 1.0f / sqrtf((float)DK);
      for (int t = 0; t < SEQ; ++t) {
        long long n = (long long)b * SEQ + t;
        const act_t* ur = p.u + n * N_IN;
        float vt = ldf(ur[OFF_BV + h * DV + v]);
        const float* gar = p.ga + n * B_K + h * DK + cq * DKQ;
        const act_t* kr = ur + OFF_BK + h * DK + cq * DKQ;
        const act_t* qr = ur + OFF_BQ + h * DK + cq * DKQ;
        float o = 0.f;
#pragma unroll
        for (int c = 0; c < DKQ; ++c) {
          st[c] = gar[c] * st[c] + ldf(kr[c]) * vt;
          o += ldf(qr[c]) * st[c];
        }
        p.opart[((long long)cq * N_TOK + n) * B_V + h * DV + v] = o * qs;
      }
    } else {
      long long i2 = idx - T1 - T2;
      int which = (int)(i2 / ((long long)CMP_ROWS * HD));
      long long rem = i2 % ((long long)CMP_ROWS * HD);
      int row = (int)(rem / HD), d = (int)(rem % HD);
      const float* w2 = (which ? p.cmp_w2_v : p.cmp_w2_k) + (long long)li * CMP_HID * HD;
      const float* hr = p.hid + ((long long)which * CMP_ROWS + row) * CMP_HID;
      float s = 0.f;
      if (!(PARTS & 4)) continue;
      for (int j = 0; j < CMP_HID; ++j) s += hr[j] * w2[j * HD + d];
      p.kcv[i2] = s;
#ifndef CPU_TEST
      {
        const int g_ = row % NSA_G, c_ = (row / NSA_G) % N_CMP, b_ = row / (NSA_G * N_CMP);
        stf(&p.kcb[((((size_t)which * BATCH + b_) * 128 + c_) * NSA_G + g_) * 64 + d], s);
      }
#endif
    }
  }
}

template <int PARTS>
DEV void ph_nsa1(const Params& p, int li, long long tid, long long nthr) {
  const long long T1 = (long long)N_TOK * GLA_H;
  const long long T2 = (PARTS & 2) ? (long long)N_TOK * NSA_H : 0;
  FOR_IDX(idx, T1 + T2) {
    if (idx < T1) {
      long long n = idx / GLA_H; int h = (int)(idx % GLA_H);
      float ss = 0.f;
      for (int v = 0; v < DV; ++v) {
        float o = 0.f;
        for (int cq = 0; cq < 4; ++cq) o += p.opart[((long long)cq * N_TOK + n) * B_V + h * DV + v];
        ss += o * o;
      }
      float rs = 1.0f / sqrtf(ss / DV + LN_EPS);
      for (int v = 0; v < DV; ++v) {
        float o = 0.f;
        for (int cq = 0; cq < 4; ++cq) o += p.opart[((long long)cq * N_TOK + n) * B_V + h * DV + v];
        float r = ldf(p.u[n * N_IN + OFF_BR + h * DV + v]);
        float y = o * rs * p.gla_norm_g[li * DV + v] * (r * sigmoidf_(r));
        stf(&p.yb[n * B_V + h * DV + v], y);
      }
    } else {
      long long i2 = idx - T1;
      long long n = i2 / NSA_H; int hh = (int)(i2 % NSA_H);
      int b = (int)(n / SEQ), t = (int)(n % SEQ);
      int g = hh / 4;
      int nv = t >= 31 ? (t - 31) / 16 + 1 : 0;
      if (nv > N_CMP) nv = N_CMP;
      float q[HD];
      const act_t* qp = p.u + n * N_IN + OFF_CQ + hh * HD;
#pragma unroll
      for (int d = 0; d < HD; ++d) q[d] = ldf(qp[d]);
      float* prow = p.pcmp + (((long long)b * NSA_H + hh) * SEQ + t) * 128;
      float m = -INFINITY;
      for (int c = 0; c < nv; ++c) {
        const float* kp = p.kcv + (((long long)b * N_CMP + c) * NSA_G + g) * HD;
        float s = 0.f;
#pragma unroll
        for (int d = 0; d < HD; ++d) s += q[d] * kp[d];
        s *= 0.125f;
        prow[c] = s;
        m = fmaxf(m, s);
      }
      float acc[HD];
#pragma unroll
      for (int d = 0; d < HD; ++d) acc[d] = 0.f;
      float l = 0.f;
      for (int c = 0; c < nv; ++c) {
        const float* vp = p.kcv + (((long long)CMP_ROWS) + ((long long)b * N_CMP + c) * NSA_G + g) * HD;
        float pp = expf(prow[c] - m);
        l += pp;
        prow[c] = pp;
#pragma unroll
        for (int d = 0; d < HD; ++d) acc[d] += pp * vp[d];
      }
      float inv = 1.0f / fmaxf(l, 1e-30f);
      for (int c = 0; c < 128; ++c) prow[c] = c < nv ? prow[c] * inv : 0.f;
#pragma unroll
      for (int d = 0; d < HD; ++d) p.ocmp[n * 1024 + hh * HD + d] = acc[d] * inv;
    }
  }
}

DEV void ph_nsa2(const Params& p, int li, long long tid, long long nthr) {
  FOR_IDX(idx, (long long)BATCH * NSA_G * SEQ * N_BLK) {
    int j = (int)(idx % N_BLK); long long r = idx / N_BLK;
    int s = (int)(r % SEQ); int g = (int)((r / SEQ) % NSA_G); int b = (int)(r / ((long long)SEQ * NSA_G));
    int qb = s / 64;
    float imp;
    if (j == 0 || j == qb || j == qb - 1) imp = INFINITY;
    else if (j > qb) imp = -INFINITY;
    else {
      imp = 0.f;
      int c0 = 4 * j - 1; if (c0 < 0) c0 = 0;
      int c1 = 4 * j + 3; if (c1 > N_CMP - 1) c1 = N_CMP - 1;
      for (int rr = 0; rr < 4; ++rr) {
        const float* prow = p.pcmp + (((long long)b * NSA_H + g * 4 + rr) * SEQ + s) * 128;
        for (int c = c0; c <= c1; ++c) imp += prow[c];
      }
    }
    p.impb[idx] = imp;
  }
}

DEV void ph_nsa3(const Params& p, int li, long long tid, long long nthr) {
  FOR_IDX(idx, (long long)BATCH * NSA_G * SEQ * N_BLK) {
    int j = (int)(idx % N_BLK); long long r = idx / N_BLK;
    const float* ir = p.impb + r * N_BLK;
    float v = ir[j];
    int rank = 0;
    for (int jj = 0; jj < N_BLK; ++jj) {
      float w = ir[jj];
      if (w > v || (w == v && jj < j)) ++rank;
    }
    p.selb[idx] = rank < N_SELECT ? 1 : 0;
  }
}

DEV void ph_nsa4(const Params& p, int li, long long tid, long long nthr) {
  FOR_IDX(idx, (long long)N_TOK * NSA_H) {
    long long n = idx / NSA_H; int hh = (int)(idx % NSA_H);
    int b = (int)(n / SEQ), t = (int)(n % SEQ);
    int g = hh / 4;
    float q[HD];
    const act_t* qp = p.u + n * N_IN + OFF_CQ + hh * HD;
#pragma unroll
    for (int d = 0; d < HD; ++d) q[d] = ldf(qp[d]);
    float g0 = sigmoidf_(ldf(p.u[n * N_IN + OFF_CG + hh * 3 + 0]));
    float g1 = sigmoidf_(ldf(p.u[n * N_IN + OFF_CG + hh * 3 + 1]));
    float g2 = sigmoidf_(ldf(p.u[n * N_IN + OFF_CG + hh * 3 + 2]));
    float acc[HD];
    {
      float m = -INFINITY, l = 0.f;
#pragma unroll
      for (int d = 0; d < HD; ++d) acc[d] = 0.f;
      int qb = t / 64;
      const int* sr = p.selb + (((long long)b * NSA_G + g) * SEQ + t) * N_BLK;
      for (int j = 0; j <= qb; ++j) {
        if (!sr[j]) continue;
        int hi = j * 64 + 63; if (hi > t) hi = t;
        for (int tk = j * 64; tk <= hi; ++tk) {
          const act_t* kp = p.u + ((long long)b * SEQ + tk) * N_IN + OFF_CKS + g * HD;
          const act_t* vp = p.u + ((long long)b * SEQ + tk) * N_IN + OFF_CVS + g * HD;
          float s = 0.f;
#pragma unroll
          for (int d = 0; d < HD; ++d) s += q[d] * ldf(kp[d]);
          s *= 0.125f;
          float mn = fmaxf(m, s);
          float corr = expf(m - mn);
          float pp = expf(s - mn);
          l = l * corr + pp;
#pragma unroll
          for (int d = 0; d < HD; ++d) acc[d] = acc[d] * corr + pp * ldf(vp[d]);
          m = mn;
        }
      }
      float inv = 1.0f / l;
#pragma unroll
      for (int d = 0; d < HD; ++d) {
        float* oc = &p.ocmp[n * 1024 + hh * HD + d];
        *oc = g0 * (*oc) + g1 * acc[d] * inv;
      }
    }
    {
      float m = -INFINITY, l = 0.f;
#pragma unroll
      for (int d = 0; d < HD; ++d) acc[d] = 0.f;
      int lo = t - (NSA_WIN - 1); if (lo < 0) lo = 0;
      for (int tk = lo; tk <= t; ++tk) {
        const act_t* kp = p.u + ((long long)b * SEQ + tk) * N_IN + OFF_CKW + g * HD;
        const act_t* vp = p.u + ((long long)b * SEQ + tk) * N_IN + OFF_CVW + g * HD;
        float s = 0.f;
#pragma unroll
        for (int d = 0; d < HD; ++d) s += q[d] * ldf(kp[d]);
        s *= 0.125f;
        float mn = fmaxf(m, s);
        float corr = expf(m - mn);
        float pp = expf(s - mn);
        l = l * corr + pp;
#pragma unroll
        for (int d = 0; d < HD; ++d) acc[d] = acc[d] * corr + pp * ldf(vp[d]);
        m = mn;
      }
      float inv = 1.0f / l;
#pragma unroll
      for (int d = 0; d < HD; ++d)
        stf(&p.yc[n * 1024 + hh * HD + d], p.ocmp[n * 1024 + hh * HD + d] + g2 * acc[d] * inv);
    }
  }
}

DEV void ph_br(const Params& p, int li, long long tid, long long nthr) {
  const float* Wa = p.w_br_a + (long long)li * 256 * D;
  const float* Wb = p.w_br_b + (long long)li * B_V * D;
  const float* Wc = p.w_br_c + (long long)li * 1024 * D;
  FOR_IDX(idx, (long long)N_TOK * D) {
    long long n = idx / D; int d = (int)(idx % D);
    float s0 = dotcol(p.ya + n * 256, Wa + d, 256, D);
    float s1 = dotcol(p.yb + n * B_V, Wb + d, B_V, D);
    float s2 = dotcol(p.yc + n * 1024, Wc + d, 1024, D);
    const act_t* mg = p.u + n * N_IN + OFF_MG;
    float y = sigmoidf_(ldf(mg[d])) * s0 + sigmoidf_(ldf(mg[D + d])) * s1 + sigmoidf_(ldf(mg[2 * D + d])) * s2;
    stf(&p.merged[idx], y);
  }
}

DEV void ph_proj_res(const Params& p, const act_t* a, const float* W, long long tid, long long nthr) {
  FOR_IDX(idx, (long long)N_TOK * D) {
    long long n = idx / D; int d = (int)(idx % D);
    p.tmp[idx] = ALPHA * p.xf[idx] + dotcol(a + n * D, W + d, D, D);
  }
}

DEV void ph_xq(const Params& p, int li, long long tid, long long nthr) {
  const long long T1 = (long long)N_TOK * D;
  const long long T2 = 2LL * BATCH * MEM_LEN * D;
  const float* Wq = p.w_xq + (long long)li * D * D;
  FOR_IDX(idx, T1 + T2) {
    if (idx < T1) {
      long long n = idx / D; int d = (int)(idx % D);
      stf(&p.xq[idx], dotcol(p.xb + n * D, Wq + d, D, D));
    } else {
      long long i2 = idx - T1;
      int which = (int)(i2 / ((long long)BATCH * MEM_LEN * D));
      long long rem = i2 % ((long long)BATCH * MEM_LEN * D);
      long long r = rem / D; int d = (int)(rem % D);
      const float* W = (which ? p.w_xv : p.w_xk) + (long long)li * D * D;
      float s = dotcol(p.mem + r * D, W + d, D, D);
      stf(which ? &p.memv[rem] : &p.memk[rem], s);
    }
  }
}

DEV void ph_xs(const Params& p, int li, long long tid, long long nthr) {
  const float sc = 1.0f / sqrtf((float)XHD);
  FOR_IDX(idx, (long long)N_TOK * XH * MEM_LEN) {
    int m = (int)(idx % MEM_LEN); int h = (int)((idx / MEM_LEN) % XH); long long n = idx / (MEM_LEN * XH);
    int b = (int)(n / SEQ);
    const act_t* q = p.xq + n * D + h * XHD;
    const act_t* k = p.memk + ((long long)b * MEM_LEN + m) * D + h * XHD;
    float s = 0.f;
    for (int d = 0; d < XHD; ++d) s += ldf(q[d]) * ldf(k[d]);
    p.xs[idx] = s * sc;
  }
}

DEV void ph_xo(const Params& p, int li, long long tid, long long nthr) {
  FOR_IDX(idx, (long long)N_TOK * D) {
    long long n = idx / D; int c = (int)(idx % D);
    int h = c / XHD; int b = (int)(n / SEQ);
    const float* sr = p.xs + (n * XH + h) * MEM_LEN;
    float m = -INFINITY;
    for (int mm = 0; mm < MEM_LEN; ++mm) m = fmaxf(m, sr[mm]);
    float l = 0.f, o = 0.f;
    for (int mm = 0; mm < MEM_LEN; ++mm) {
      float pp = expf(sr[mm] - m);
      l += pp;
      o += pp * ldf(p.memv[((long long)b * MEM_LEN + mm) * D + c]);
    }
    stf(&p.xo[idx], o / l);
  }
}

DEV void ph_rlogit(const Params& p, int li, long long tid, long long nthr) {
  const float* W = p.w_router + (long long)li * D * NE;
  FOR_IDX(idx, (long long)N_TOK * NE) {
    long long n = idx / NE; int e = (int)(idx % NE);
    p.rl[idx] = dotcol(p.xf + n * D, W + e, D, NE) + p.b_router[li * NE + e];
  }
}

DEV void ph_route(const Params& p, int li, long long tid, long long nthr) {
  FOR_IDX(n, N_TOK) {
    const float* r = p.rl + n * NE;
    int i0 = -1, i1 = -1, i2 = -1, i3 = -1;
    float v0 = 0, v1 = 0, v2 = 0, v3 = 0;
    for (int k = 0; k < 4; ++k) {
      int bi = -1; float bv = -INFINITY;
      for (int e = 0; e < NE; ++e) {
        if (e == i0 || e == i1 || e == i2) continue;
        float v = r[e];
        if (bi < 0 || v > bv) { bi = e; bv = v; }
      }
      if (k == 0) { i0 = bi; v0 = bv; } else if (k == 1) { i1 = bi; v1 = bv; }
      else if (k == 2) { i2 = bi; v2 = bv; } else { i3 = bi; v3 = bv; }
    }
    float e0 = 1.0f, e1 = expf(v1 - v0), e2 = expf(v2 - v0), e3 = expf(v3 - v0);
    float inv = 1.0f / (e0 + e1 + e2 + e3);
#ifndef CPU_TEST
    p.rank[n * 4 + 0] = atomicAdd(&p.cnt[li * 32 + i0], 1);
    p.rank[n * 4 + 1] = atomicAdd(&p.cnt[li * 32 + i1], 1);
    p.rank[n * 4 + 2] = atomicAdd(&p.cnt[li * 32 + i2], 1);
    p.rank[n * 4 + 3] = atomicAdd(&p.cnt[li * 32 + i3], 1);
#endif
    p.topi[n * 4 + 0] = i0; p.topi[n * 4 + 1] = i1; p.topi[n * 4 + 2] = i2; p.topi[n * 4 + 3] = i3;
    p.topg[n * 4 + 0] = e0 * inv; p.topg[n * 4 + 1] = e1 * inv; p.topg[n * 4 + 2] = e2 * inv; p.topg[n * 4 + 3] = e3 * inv;
  }
}

DEV void ph_moe1(const Params& p, int li, long long tid, long long nthr) {
  FOR_IDX(idx, (long long)N_TOK * TOPK * DFF) {
    int j = (int)(idx % DFF); long long a = idx / DFF; long long n = a / TOPK;
    int e = p.topi[a];
    const float* W = p.w_gu + ((long long)li * NE + e) * D * 2 * DFF;
    const float* bb = p.b_gu + ((long long)li * NE + e) * 2 * DFF;
    float gt = dotcol(p.xb + n * D, W + j, D, 2 * DFF) + bb[j];
    float up = dotcol(p.xb + n * D, W + DFF + j, D, 2 * DFF) + bb[DFF + j];
    gt = fminf(gt, 7.0f);
    up = fminf(fmaxf(up, -7.0f), 7.0f);
    stf(&p.act[idx], (up + 1.0f) * gt * sigmoidf_(1.702f * gt));
  }
}

DEV void ph_moe2(const Params& p, int li, long long tid, long long nthr) {
  FOR_IDX(idx, (long long)N_TOK * D) {
    long long n = idx / D; int d = (int)(idx % D);
    float y = 0.f;
    for (int k = 0; k < TOPK; ++k) {
      int e = p.topi[n * 4 + k];
      const float* W = p.w_down + ((long long)li * NE + e) * DFF * D;
      float s = dotcol(p.act + (n * 4 + k) * DFF, W + d, DFF, D) + p.b_down[((long long)li * NE + e) * D + d];
      y += p.topg[n * 4 + k] * s;
    }
    p.tmp[idx] = ALPHA * p.xf[idx] + y;
  }
}

constexpr int PH_PER_LAYER = 20;
constexpr int N_PHASES = 1 + DEPTH * PH_PER_LAYER;

template <int K>
DEV void run_phase_k(const Params& p, int li, long long tid, long long nthr) {
  if constexpr (K == -1) ph_ln(p.x, p.ln0_g, p.ln0_b, p.xf, p.xb, nullptr, tid, nthr);
  if constexpr (K == 0) ph_inproj(p, li, tid, nthr);
  if constexpr (K == 1) ph_pre<3>(p, li, tid, nthr);
  if constexpr (K == 20) ph_pre<1>(p, li, tid, nthr);
  if constexpr (K == 2) ph_mix1<7>(p, li, tid, nthr);
  if constexpr (K == 21) ph_mix1<4>(p, li, tid, nthr);
  if constexpr (K == 3) ph_nsa1<3>(p, li, tid, nthr);
  if constexpr (K == 22) ph_nsa1<1>(p, li, tid, nthr);
  if constexpr (K == 4) ph_nsa2(p, li, tid, nthr);
  if constexpr (K == 5) ph_nsa3(p, li, tid, nthr);
  if constexpr (K == 6) ph_nsa4(p, li, tid, nthr);
  if constexpr (K == 7) ph_br(p, li, tid, nthr);
  if constexpr (K == 8) ph_proj_res(p, p.merged, p.w_o_mix + (long long)li * D * D, tid, nthr);
  if constexpr (K == 9) ph_ln(p.tmp, p.ln1_g + li * D, p.ln1_b + li * D, p.xf, p.xb, nullptr, tid, nthr);
  if constexpr (K == 10) ph_xq(p, li, tid, nthr);
  if constexpr (K == 11) ph_xs(p, li, tid, nthr);
  if constexpr (K == 12) ph_xo(p, li, tid, nthr);
  if constexpr (K == 13) ph_proj_res(p, p.xo, p.w_xo + (long long)li * D * D, tid, nthr);
  if constexpr (K == 14) ph_ln(p.tmp, p.ln2_g + li * D, p.ln2_b + li * D, p.xf, p.xb, nullptr, tid, nthr);
  if constexpr (K == 15) ph_rlogit(p, li, tid, nthr);
  if constexpr (K == 16) ph_route(p, li, tid, nthr);
  if constexpr (K == 17) ph_moe1(p, li, tid, nthr);
  if constexpr (K == 18) ph_moe2(p, li, tid, nthr);
  if constexpr (K == 19) ph_ln(p.tmp, p.ln3_g + li * D, p.ln3_b + li * D, p.xf, p.xb, li == DEPTH - 1 ? p.out : nullptr, tid, nthr);
}

DEV void run_phase(const Params& p, int ph, long long tid, long long nthr) {
  if (ph == 0) { run_phase_k<-1>(p, 0, tid, nthr); return; }
  int li = (ph - 1) / PH_PER_LAYER, k = (ph - 1) % PH_PER_LAYER;
  switch (k) {
#define PHC(K) case K: run_phase_k<K>(p, li, tid, nthr); break;
    PHC(0) PHC(1) PHC(2) PHC(3) PHC(4) PHC(5) PHC(6) PHC(7) PHC(8) PHC(9)
    PHC(10) PHC(11) PHC(12) PHC(13) PHC(14) PHC(15) PHC(16) PHC(17) PHC(18) PHC(19)
#undef PHC
  }
}

#ifdef CPU_TEST
#define HDI_M
#else
#define HDI_M __host__ __device__ __forceinline__
#endif
struct Carver {
  char* base; size_t off;
  template <class T> HDI_M T* take(size_t n) {
    T* r = (T*)(base + off);
    off += (n * sizeof(T) + 255) & ~(size_t)255;
    return r;
  }
};

HDI void fill_params(Params& p, void* const* d_in, void* d_out, void* d_ws) {
  const float* const* in = (const float* const*)d_in;
  p.x = in[0]; p.mem = in[1]; p.ln0_g = in[2]; p.ln0_b = in[3]; p.w_in = in[4]; p.b_in = in[5];
  p.w_alpha2 = in[6]; p.b_alpha = in[7]; p.gla_norm_g = in[8];
  p.cmp_pe_k = in[9]; p.cmp_w1_k = in[10]; p.cmp_w2_k = in[11]; p.cmp_pe_v = in[12]; p.cmp_w1_v = in[13]; p.cmp_w2_v = in[14];
  p.w_br_a = in[15]; p.w_br_b = in[16]; p.w_br_c = in[17]; p.w_o_mix = in[18]; p.ln1_g = in[19]; p.ln1_b = in[20];
  p.w_xq = in[21]; p.w_xk = in[22]; p.w_xv = in[23]; p.w_xo = in[24]; p.ln2_g = in[25]; p.ln2_b = in[26];
  p.w_router = in[27]; p.b_router = in[28]; p.w_gu = in[29]; p.b_gu = in[30]; p.w_down = in[31]; p.b_down = in[32];
  p.ln3_g = in[33]; p.ln3_b = in[34];
  p.out = (float*)d_out;
  Carver c{(char*)d_ws, 0};
  p.barw = c.take<unsigned>(4096);
  p.xf = c.take<float>((size_t)N_TOK * D);
  p.xb = c.take<act_t>((size_t)N_TOK * D);
  p.u = c.take<act_t>((size_t)N_TOK * N_IN);
  p.ga = c.take<float>((size_t)N_TOK * B_K);
  p.hid = c.take<float>((size_t)2 * CMP_ROWS * CMP_HID);
  p.kcv = c.take<float>((size_t)2 * CMP_ROWS * HD);
  p.opart = c.take<float>((size_t)4 * N_TOK * B_V);
  p.yass = p.opart;
#ifdef CPU_TEST
  p.ya = c.take<act_t>((size_t)N_TOK * 256);
  p.yb = c.take<act_t>((size_t)N_TOK * B_V);
  p.yc = c.take<act_t>((size_t)N_TOK * 1024);
#else
  p.ya = c.take<act_t>((size_t)N_TOK * YLD);
  p.yb = p.ya + 256;
  p.yc = p.ya + 1280;
#endif
  p.pcmp = c.take<float>((size_t)MOE_ROWS * 1024 / 2 > (size_t)BATCH * NSA_H * SEQ * 128 ? (size_t)MOE_ROWS * 1024 / 2 : (size_t)BATCH * NSA_H * SEQ * 128);
  p.xg = (act_t*)p.pcmp;
  p.ocmp = c.take<float>((size_t)N_TOK * 1024);
  p.impb = c.take<float>((size_t)BATCH * NSA_G * SEQ * N_BLK);
  p.selb = c.take<int>((size_t)BATCH * NSA_G * SEQ * N_BLK);
  p.merged = c.take<act_t>((size_t)N_TOK * D);
  p.tmp = c.take<float>((size_t)N_TOK * D);
  p.xq = c.take<act_t>((size_t)N_TOK * D);
  p.memk = c.take<act_t>((size_t)BATCH * MEM_LEN * D);
  p.memv = c.take<act_t>((size_t)BATCH * MEM_LEN * D);
  p.xs = c.take<float>((size_t)N_TOK * XH * MEM_LEN);
  p.mrg = p.xs;
  p.xo = c.take<act_t>((size_t)N_TOK * D);
  p.rl = c.take<float>((size_t)N_TOK * NE);
  p.topi = c.take<int>((size_t)N_TOK * TOPK);
  p.topg = c.take<float>((size_t)N_TOK * TOPK);
  p.actg = c.take<act_t>((size_t)MOE_ROWS * 1024);
  p.act = p.actg;
  p.wt_in = c.take<act_t>((size_t)2 * N_IN_PAD * 1024);
  p.wt_c1 = c.take<act_t>((size_t)2 * 2 * 256 * 2048);
  p.wt_bra = c.take<act_t>((size_t)2 * 1024 * YLD);
  p.wt_brb = p.wt_bra + 256;
  p.wt_brc = p.wt_bra + 1280;
  p.wt_omix = c.take<act_t>((size_t)2 * 1024 * 1024);
  p.wt_xq = c.take<act_t>((size_t)2 * 1024 * 1024);
  p.wt_xk = c.take<act_t>((size_t)2 * 1024 * 1024);
  p.wt_xv = c.take<act_t>((size_t)2 * 1024 * 1024);
  p.wt_xo = c.take<act_t>((size_t)2 * 1024 * 1024);
  p.wt_gu = c.take<act_t>((size_t)2 * 32 * 2048 * 1024);
  p.wt_dn = c.take<act_t>((size_t)2 * 32 * 1024 * 1024);
  p.membf = c.take<act_t>((size_t)BATCH * MEM_LEN * 1024);
  p.cmpA = c.take<act_t>((size_t)2 * CMP_ROWS_PAD * 2048);
  p.cnt = c.take<int>(64);
  p.rank = c.take<int>((size_t)N_TOK * 4);
  p.rowlist = c.take<int>((size_t)MOE_ROWS);
  p.kcb = c.take<act_t>((size_t)2 * BATCH * 128 * NSA_G * 64);
  p.dilo = c.take<act_t>((size_t)3 * N_TOK * 256);
  p.dill = c.take<float>((size_t)3 * N_TOK * 4);
  p.selm = c.take<unsigned>((size_t)BATCH * NSA_G * SEQ);
  p.gU = p.xg; p.gQ = p.xg + (size_t)1024 * 128 * 256; p.gS = p.actg; p.gD = p.opart + (size_t)N_TOK * 1024;
  p.ws_used = c.off;
}

#ifndef CPU_TEST
#ifndef NSA_PROBE
#define NSA_PROBE 0
#endif
#ifndef GSEG
#define GSEG -1
#endif
static_assert(D == 1024 && BATCH == 8, "optimized path is written for the graded shapes");
namespace pg8 {
#define PG8_LAS __attribute__((address_space(3)))
typedef unsigned short bf16_t;
typedef short bf16x8 __attribute__((ext_vector_type(8)));
typedef float f32x4 __attribute__((ext_vector_type(4)));
typedef unsigned u32x4 __attribute__((ext_vector_type(4)));
constexpr int BM = 256, BK = 64, HALF = 128, HTB = HALF * BK * 2  , STAGE_BYTES = 8 * HTB, NXCD = 8, WGM = 8;

__host__ __device__ __forceinline__ int lds_byte(int r, int c) { const int st = (r >> 4) * 2 + (c >> 5), rr = r & 15, cc = c & 31, ob = rr * 64 + cc * 2; return st * 1024 + (ob ^ (((ob >> 9) & 1) << 5)); }
__host__ __device__ __forceinline__ void stage_rc(int b, int& R, int& C) { const int st = b / 1024, sb = b % 1024, swz = sb ^ (((sb >> 9) & 1) << 5); R = (st >> 1) * 16 + swz / 64; C = (st & 1) * 32 + (swz % 64) / 2; }
__host__ __device__ __forceinline__ int perm32(int rho) { const int n = rho >> 4, i = rho & 15; return 8 * (i >> 2) + 4 * n + (i & 3); }

struct Unit { int pm, pn; };
struct Gemm { const bf16_t* A; const bf16_t* Bt; int M, N, K; };

struct StaticOrder {
    int nM, nN, nwg, G, c;
    __host__ __device__ void init(int M, int N, int G_, int c_) { nM = M / BM; nN = N / BM; nwg = nM * nN; G = G_; c = c_; }
    __host__ __device__ bool next(int i, Unit& u) const {
        const long L = (long)i * G + c; if (L >= nwg) return false;
        int wgid = (int)L; { const int q = nwg / NXCD, r = nwg % NXCD, xcd = wgid % NXCD, off = wgid / NXCD; wgid = (xcd < r ? xcd * (q + 1) : r * (q + 1) + (xcd - r) * q) + off; }
        const int nig = WGM * nN, gid = wgid / nig, fm = gid * WGM, gsz = (nM - fm) < WGM ? (nM - fm) : WGM;
        u.pm = fm + ((wgid % nig) % gsz); u.pn = (wgid % nig) / gsz; return true;
    }
    __device__ __forceinline__ void a_ready(const Unit&) const {}
    __device__ __forceinline__ void done(const Unit&) const {}
};

__device__ __forceinline__ unsigned cvt_pk_bf16(float lo, float hi) { unsigned r; asm volatile("v_cvt_pk_bf16_f32 %0, %1, %2" : "=v"(r) : "v"(lo), "v"(hi)); return r; }

template <class Epi, class Sched, bool ALIGN_EPI = false, bool SP2 = false>
__device__ __forceinline__ void gemm_phase(PG8_LAS unsigned char* lds, const Gemm g, const Sched& S, const Epi& E, const int tid) {
    const int wid = __builtin_amdgcn_readfirstlane(tid >> 6), lane = tid & 63, wr = wid >> 2, wc = wid & 3, fr = lane & 15, fq = lane >> 4;
    const int K = g.K, nt = K / BK;
    unsigned voffA[2], voffB[2];
#pragma unroll
    for (int i = 0; i < 2; ++i) { int R, C; stage_rc(tid * 16 + i * 8192, R, C); const int Rb = Epi::PERM ? ((R & ~31) + perm32(R & 31)) : R;
        voffA[i] = (unsigned)(R * K + C) * 2u; voffB[i] = (unsigned)(Rb * K + C) * 2u; }
    const size_t kstep = (size_t)(BK * 2);
    const size_t hstep = (size_t)HALF * K * 2;
    const size_t tstep = 2 * hstep;
    const unsigned ldsw = (unsigned)wid * 1024u;
    const int aoff = lds_byte(wr * 64 + fr, fq * 8), boff = lds_byte(wc * 32 + fr, fq * 8);
#define PG8_SA(b, h) (((b) * 2 + (h)) * HTB)
#define PG8_SB(b, h) ((4 + (b) * 2 + (h)) * HTB)
#define PG8_STAGE(bufoff, gbase, voff) do { _Pragma("unroll") for (int _i = 0; _i < 2; ++_i) \
        __builtin_amdgcn_global_load_lds((const unsigned*)((const char*)(gbase) + (voff)[_i]), (PG8_LAS unsigned*)(lds + (bufoff) + ldsw + _i * 8192), 16, 0, 0); } while (0)
#define PG8_LDA(dst, b, h) do { _Pragma("unroll") for (int m = 0; m < 4; ++m) _Pragma("unroll") for (int k = 0; k < 2; ++k) dst[m][k] = *(const PG8_LAS bf16x8*)(lds + PG8_SA(b, h) + aoff + m * 2048 + k * 1024); } while (0)
#define PG8_LDB(dst, b, h) do { _Pragma("unroll") for (int n = 0; n < 2; ++n) _Pragma("unroll") for (int k = 0; k < 2; ++k) dst[n][k] = *(const PG8_LAS bf16x8*)(lds + PG8_SB(b, h) + boff + n * 2048 + k * 1024); } while (0)
#define PG8_MMA(ai, bj, At, Bt) do { __builtin_amdgcn_s_setprio(1); _Pragma("unroll") for (int m = 0; m < 4; ++m) _Pragma("unroll") for (int n = 0; n < 2; ++n) _Pragma("unroll") for (int k = 0; k < 2; ++k) \
        acc[ai][bj][m][n] = __builtin_amdgcn_mfma_f32_16x16x32_bf16(Bt[n][k], At[m][k], acc[ai][bj][m][n], 0, 0, 0); __builtin_amdgcn_s_setprio(0); } while (0)
#define PG8_WAIT_V(n) asm volatile("s_waitcnt vmcnt(" #n ")" ::: "memory")
#define PG8_WAIT_L(n) asm volatile("s_waitcnt lgkmcnt(" #n ")" ::: "memory")
#define PG8_BAR __builtin_amdgcn_s_barrier()
#define PG8_SCHED __builtin_amdgcn_sched_barrier(0)
    Unit cur, nxt; int ui = 0;
    if (!S.next(0, cur)) return;
    f32x4 acc[2][2][4][2];
#pragma unroll
    for (int a = 0; a < 2; ++a)
#pragma unroll
        for (int b = 0; b < 2; ++b)
#pragma unroll
            for (int m = 0; m < 4; ++m)
#pragma unroll
                for (int n = 0; n < 2; ++n) acc[a][b][m][n] = (f32x4){0.f, 0.f, 0.f, 0.f};
    bf16x8 At[4][2], B0[2][2], B1[2][2];
    const char* cA = (const char*)g.A + (size_t)cur.pm * tstep; const char* cB = (const char*)g.Bt + (size_t)cur.pn * tstep;
    S.a_ready(cur);
    if constexpr (SP2) {
        PG8_STAGE(PG8_SB(0, 0), cB, voffB); PG8_STAGE(PG8_SB(0, 1), cB + hstep, voffB); PG8_STAGE(PG8_SA(0, 0), cA, voffA); PG8_STAGE(PG8_SA(0, 1), cA + hstep, voffA);
        if (wr == 1) PG8_BAR;
        PG8_WAIT_V(2); PG8_BAR;
        PG8_STAGE(PG8_SB(1, 0), cB + kstep, voffB); PG8_STAGE(PG8_SA(1, 0), cA + kstep, voffA); PG8_STAGE(PG8_SB(1, 1), cB + hstep + kstep, voffB);
        PG8_WAIT_V(6); PG8_BAR;
    } else {
        PG8_STAGE(PG8_SB(0, 0), cB, voffB); PG8_STAGE(PG8_SA(0, 0), cA, voffA); PG8_STAGE(PG8_SB(0, 1), cB + hstep, voffB); PG8_STAGE(PG8_SA(0, 1), cA + hstep, voffA);
        if (wr == 1) PG8_BAR;
        PG8_WAIT_V(4); PG8_BAR;
        PG8_STAGE(PG8_SB(1, 0), cB + kstep, voffB); PG8_STAGE(PG8_SA(1, 0), cA + kstep, voffA); PG8_STAGE(PG8_SB(1, 1), cB + hstep + kstep, voffB);
        PG8_WAIT_V(6); PG8_BAR;
    }
    for (;;) {
        const bool has_next = S.next(ui + 1, nxt);
        const char* nA = has_next ? (const char*)g.A + (size_t)nxt.pm * tstep : cA; const char* nB = has_next ? (const char*)g.Bt + (size_t)nxt.pn * tstep : cB;
        for (int t = 0; t < nt; t += 2) {
            const bool last = (t == nt - 2);
            const char* a1 = cA + (size_t)(t + 1) * kstep;
            const char* a2 = last ? nA : cA + (size_t)(t + 2) * kstep; const char* b2 = last ? nB : cB + (size_t)(t + 2) * kstep;
            const char* a3 = a2 + kstep; const char* b3 = b2 + kstep;
            if (last && has_next) S.a_ready(nxt);
            asm volatile("" : "+v"(voffA[0]), "+v"(voffA[1]), "+v"(voffB[0]), "+v"(voffB[1]));
            E.mid(acc, cur, wr, wc, t);
            if constexpr (SP2) {
            PG8_LDB(B0, 0, 0); PG8_LDB(B1, 0, 1); PG8_SCHED; PG8_LDA(At, 0, 0); PG8_STAGE(PG8_SA(1, 1), a1 + hstep, voffA);
            PG8_WAIT_V(8); PG8_WAIT_L(0); PG8_BAR; PG8_MMA(0, 0, At, B0); PG8_MMA(0, 1, At, B1); PG8_BAR; PG8_SCHED;
            PG8_LDA(At, 0, 1); PG8_STAGE(PG8_SB(0, 0), b2, voffB); PG8_STAGE(PG8_SB(0, 1), b2 + hstep, voffB); PG8_STAGE(PG8_SA(0, 0), a2, voffA);
            PG8_WAIT_V(8); PG8_WAIT_L(0); PG8_BAR; PG8_MMA(1, 0, At, B0); PG8_MMA(1, 1, At, B1); PG8_BAR; PG8_SCHED;
            PG8_LDB(B0, 1, 0); PG8_LDB(B1, 1, 1); PG8_SCHED; PG8_LDA(At, 1, 0); PG8_STAGE(PG8_SA(0, 1), a2 + hstep, voffA);
            PG8_WAIT_V(8); PG8_WAIT_L(0); PG8_BAR; PG8_MMA(0, 0, At, B0); PG8_MMA(0, 1, At, B1); PG8_BAR; PG8_SCHED;
            PG8_LDA(At, 1, 1); PG8_STAGE(PG8_SB(1, 0), b3, voffB); PG8_STAGE(PG8_SB(1, 1), b3 + hstep, voffB); PG8_STAGE(PG8_SA(1, 0), a3, voffA);
            PG8_WAIT_V(8); PG8_WAIT_L(0); PG8_BAR; PG8_MMA(1, 0, At, B0); PG8_MMA(1, 1, At, B1); PG8_BAR; PG8_SCHED;
            } else {
            PG8_LDB(B0, 0, 0); PG8_SCHED; PG8_LDA(At, 0, 0); PG8_STAGE(PG8_SA(1, 1), a1 + hstep, voffA);
            PG8_WAIT_L(8); PG8_BAR; PG8_WAIT_L(0); PG8_MMA(0, 0, At, B0); PG8_BAR; PG8_SCHED;
            PG8_LDB(B1, 0, 1); PG8_STAGE(PG8_SB(0, 0), b2, voffB);
            PG8_BAR; PG8_WAIT_L(0); PG8_MMA(0, 1, At, B1); PG8_BAR;
            PG8_LDA(At, 0, 1); PG8_STAGE(PG8_SA(0, 0), a2, voffA);
            PG8_BAR; PG8_WAIT_L(0); PG8_MMA(1, 0, At, B0); PG8_BAR; PG8_SCHED;
            PG8_STAGE(PG8_SB(0, 1), b2 + hstep, voffB);
            PG8_WAIT_V(6); PG8_BAR; PG8_MMA(1, 1, At, B1); PG8_BAR;
            PG8_LDB(B0, 1, 0); PG8_SCHED; PG8_LDA(At, 1, 0); PG8_STAGE(PG8_SA(0, 1), a2 + hstep, voffA);
            PG8_WAIT_L(8); PG8_BAR; PG8_WAIT_L(0); PG8_MMA(0, 0, At, B0); PG8_BAR; PG8_SCHED;
            PG8_LDB(B1, 1, 1); PG8_STAGE(PG8_SB(1, 0), b3, voffB);
            PG8_BAR; PG8_WAIT_L(0); PG8_MMA(0, 1, At, B1); PG8_BAR;
            PG8_LDA(At, 1, 1); PG8_STAGE(PG8_SA(1, 0), a3, voffA);
            PG8_BAR; PG8_WAIT_L(0); PG8_MMA(1, 0, At, B0); PG8_BAR; PG8_SCHED;
            PG8_STAGE(PG8_SB(1, 1), b3 + hstep, voffB);
            PG8_WAIT_V(6); PG8_BAR; PG8_MMA(1, 1, At, B1); PG8_BAR;
            }
        }
        if constexpr (ALIGN_EPI) { if (wr == 0) PG8_BAR; }
        if constexpr (!Epi::AFTER_DRAIN) { E(acc, cur, wr, wc, fr, fq); S.done(cur); }
        if (!has_next) break;
#pragma unroll
        for (int a = 0; a < 2; ++a)
#pragma unroll
            for (int b = 0; b < 2; ++b)
#pragma unroll
                for (int m = 0; m < 4; ++m)
#pragma unroll
                    for (int n = 0; n < 2; ++n) acc[a][b][m][n] = (f32x4){0.f, 0.f, 0.f, 0.f};
        cur = nxt; cA = nA; cB = nB; ++ui;
        if constexpr (ALIGN_EPI) { if (wr == 1) PG8_BAR; }
    }
    PG8_WAIT_V(0);
    if constexpr (!ALIGN_EPI) { if (wr == 0) PG8_BAR; }
    PG8_BAR;
    if constexpr (Epi::AFTER_DRAIN) { E.fused(acc, cur, wr, wc, fr, fq, lds, wid, lane); S.done(cur); }
#undef PG8_SA
#undef PG8_SB
#undef PG8_STAGE
#undef PG8_LDA
#undef PG8_LDB
#undef PG8_MMA
#undef PG8_WAIT_V
#undef PG8_WAIT_L
#undef PG8_BAR
#undef PG8_SCHED
}
}

typedef pg8::f32x4 f32x4;
typedef pg8::bf16x8 bf16x8;
typedef unsigned u32x2 __attribute__((ext_vector_type(2)));
typedef unsigned u32x4 __attribute__((ext_vector_type(4)));
#define LAS __attribute__((address_space(3)))

constexpr int NTHREADS = 512;
constexpr int RING_BYTES = 131072;
constexpr int MISC_OFF = RING_BYTES;
constexpr int LDS_BYTES = 147456;

typedef __bf16 bf16x2_t __attribute__((ext_vector_type(2)));
typedef float f32x2_t __attribute__((ext_vector_type(2)));
DEV unsigned pk2(float lo, float hi) {
  const f32x2_t v = {lo, hi};
  return __builtin_bit_cast(unsigned, __builtin_convertvector(v, bf16x2_t));
}
DEV unsigned short f2bfh(float x) { return (unsigned short)(pk2(x, 0.f) & 0xffffu); }
DEV float fsig(float x) { return __builtin_amdgcn_rcpf(1.0f + __builtin_amdgcn_exp2f(-1.4426950408889634f * x)); }
DEV float shx(float v, int lane, int o) { return __int_as_float(__builtin_amdgcn_ds_bpermute((lane ^ o) << 2, __float_as_int(v))); }
DEV int shxi(int v, int lane, int o) { return __builtin_amdgcn_ds_bpermute((lane ^ o) << 2, v); }
DEV float wave_sum(float v, int lane) {
#pragma unroll
  for (int o = 1; o < 64; o <<= 1)
    v += __int_as_float(__builtin_amdgcn_ds_bpermute((lane ^ o) << 2, __float_as_int(v)));
  return v;
}

DEV void transpose_item(const float* W, int ldw, int dld, act_t* WT, int k0, int n0, int drow0, LAS float* scr, int lane) {
  float wv[32];
#pragma unroll
  for (int i = 0; i < 32; ++i) wv[i] = W[(size_t)(k0 + 2 * i + (lane >> 5)) * ldw + n0 + (lane & 31)];
#pragma unroll
  for (int i = 0; i < 32; ++i) scr[(2 * i + (lane >> 5)) * 33 + (lane & 31)] = wv[i];
  asm volatile("s_waitcnt lgkmcnt(0)" ::: "memory");
  const int c = lane & 7;
#pragma unroll
  for (int j = 0; j < 4; ++j) {
    const int n = (lane >> 3) + 8 * j;
    const LAS float* s = scr + (8 * c) * 33 + n;
    u32x4 o;
    o.x = pk2(s[0 * 33], s[1 * 33]); o.y = pk2(s[2 * 33], s[3 * 33]);
    o.z = pk2(s[4 * 33], s[5 * 33]); o.w = pk2(s[6 * 33], s[7 * 33]);
    *(u32x4*)(WT + (size_t)(drow0 + n) * dld + k0 + 8 * c) = o;
  }
  asm volatile("s_waitcnt lgkmcnt(0)" ::: "memory");
}

struct ConvDesc { const float* W; act_t* dst; int nbatch, K, N, mode; size_t dstb; int dld; };
constexpr int NCONV = 13;
DEV ConvDesc conv_desc(const Params& p, int kind) {
  const size_t SQ = (size_t)1024 * 1024;
  switch (kind) {
    case 0: return ConvDesc{p.w_gu, p.wt_gu, 64, 1024, 2048, 1, (size_t)2048 * 1024, 1024};
    case 1: return ConvDesc{p.w_down, p.wt_dn, 64, 1024, 1024, 0, SQ, 1024};
    case 2: return ConvDesc{p.w_in, p.wt_in, 2, 1024, N_IN, 0, (size_t)N_IN_PAD * 1024, 1024};
    case 3: return ConvDesc{p.cmp_w1_k, p.wt_c1, 2, 2048, 128, 0, (size_t)2 * 256 * 2048, 2048};
    case 4: return ConvDesc{p.cmp_w1_v, p.wt_c1 + (size_t)256 * 2048, 2, 2048, 128, 0, (size_t)2 * 256 * 2048, 2048};
    case 5: return ConvDesc{p.w_br_a, p.wt_bra, 2, 256, 1024, 0, (size_t)1024 * YLD, YLD};
    case 6: return ConvDesc{p.w_br_b, p.wt_brb, 2, 1024, 1024, 0, (size_t)1024 * YLD, YLD};
    case 7: return ConvDesc{p.w_br_c, p.wt_brc, 2, 1024, 1024, 0, (size_t)1024 * YLD, YLD};
    case 8: return ConvDesc{p.w_o_mix, p.wt_omix, 2, 1024, 1024, 0, SQ, 1024};
    case 9: return ConvDesc{p.w_xq, p.wt_xq, 2, 1024, 1024, 0, SQ, 1024};
    case 10: return ConvDesc{p.w_xk, p.wt_xk, 2, 1024, 1024, 0, SQ, 1024};
    case 11: return ConvDesc{p.w_xv, p.wt_xv, 2, 1024, 1024, 0, SQ, 1024};
    default: return ConvDesc{p.w_xo, p.wt_xo, 2, 1024, 1024, 0, SQ, 1024};
  }
}
DEV int conv_items(int kind) {
  switch (kind) {
    case 0: return 64 * 16 * 64;
    case 1: return 64 * 16 * 32;
    case 2: return 2 * 16 * (N_IN / 32);
    case 3: case 4: return 2 * 32 * 4;
    case 5: return 2 * 4 * 32;
    default: return 2 * 16 * 32;
  }
}
DEV void conv_all(const Params& p, int gw, int NGW, LAS float* scr, int lane) {
  int base = 0;
  for (int kind = 0; kind < NCONV; ++kind) {
    const int total = conv_items(kind);
    const ConvDesc d = conv_desc(p, kind);
    const int nblk = d.N / 32, per = nblk * (d.K / 64);
    int first = (gw - base % NGW + NGW) % NGW;
    for (int it = first; it < total; it += NGW) {
      const int bt = it / per, r = it % per, kb = r / nblk, nb = r % nblk;
      const int n0 = nb * 32;
      int drow0 = n0;
      if (d.mode == 1) { const int j = n0 & 1023; drow0 = (j >> 7) * 256 + (j & 127) + ((n0 >= 1024) ? 128 : 0); }
      transpose_item(d.W + (size_t)bt * d.K * d.N, d.N, d.dld, d.dst + (size_t)bt * d.dstb, kb * 64, n0, drow0, scr, lane);
    }
    base += total;
  }
}

template <int MODE, bool SRC_BF16 = false>
DEV void ln_rows_w(const Params& p, const float* src, const float* g, const float* b, float* dstf, act_t* dstb, float* dst2,
                   int gw, int NGW, int lane) {
  for (int n0 = gw; n0 < N_TOK; n0 += 2 * NGW) {
    f32x4 v[2][4];
    float s[2] = {0.f, 0.f};
#pragma unroll
    for (int r = 0; r < 2; ++r) {
      const int n = (n0 + r * NGW < N_TOK) ? n0 + r * NGW : n0;
#pragma unroll
      for (int j = 0; j < 4; ++j) {
        if (MODE == 0) {
          if (SRC_BF16) {
            const u32x2 xw = ((const u32x2*)((const act_t*)src + (size_t)n * D))[lane + 64 * j];
            v[r][j] = (f32x4){__uint_as_float(xw.x << 16), __uint_as_float(xw.x & 0xffff0000u), __uint_as_float(xw.y << 16), __uint_as_float(xw.y & 0xffff0000u)};
          } else v[r][j] = ((const f32x4*)(src + (size_t)n * D))[lane + 64 * j];
        } else {
          f32x4 a = ((const f32x4*)(p.xf + (size_t)n * D))[lane + 64 * j] * ALPHA;
#pragma unroll
          for (int k = 0; k < 4; ++k) {
            const u32x2 yw = ((const u32x2*)((const act_t*)p.yass + ((size_t)n * 4 + k) * D))[lane + 64 * j];
            a.x += __uint_as_float(yw.x << 16); a.y += __uint_as_float(yw.x & 0xffff0000u);
            a.z += __uint_as_float(yw.y << 16); a.w += __uint_as_float(yw.y & 0xffff0000u);
          }
          v[r][j] = a;
        }
        s[r] += (v[r][j].x + v[r][j].y) + (v[r][j].z + v[r][j].w);
      }
    }
    float mean[2], s2[2] = {0.f, 0.f}, rstd[2];
#pragma unroll
    for (int o = 1; o < 64; o <<= 1) { s[0] += shx(s[0], lane, o); s[1] += shx(s[1], lane, o); }
#pragma unroll
    for (int r = 0; r < 2; ++r) {
      mean[r] = s[r] * (1.f / D);
#pragma unroll
      for (int j = 0; j < 4; ++j) { v[r][j] = v[r][j] - mean[r]; s2[r] += (v[r][j].x * v[r][j].x + v[r][j].y * v[r][j].y) + (v[r][j].z * v[r][j].z + v[r][j].w * v[r][j].w); }
    }
#pragma unroll
    for (int o = 1; o < 64; o <<= 1) { s2[0] += shx(s2[0], lane, o); s2[1] += shx(s2[1], lane, o); }
#pragma unroll
    for (int r = 0; r < 2; ++r) {
      rstd[r] = 1.f / sqrtf(s2[r] * (1.f / D) + LN_EPS);
      const int n = n0 + r * NGW;
      if (n < N_TOK) {
#pragma unroll
        for (int j = 0; j < 4; ++j) {
          const f32x4 gm = ((const f32x4*)g)[lane + 64 * j], bt = ((const f32x4*)b)[lane + 64 * j];
          const f32x4 y = v[r][j] * rstd[r] * gm + bt;
          ((f32x4*)(dstf + (size_t)n * D))[lane + 64 * j] = y;
          u32x2 w; w.x = pk2(y.x, y.y); w.y = pk2(y.z, y.w);
          ((u32x2*)(dstb + (size_t)n * D))[lane + 64 * j] = w;
          if (dst2) ((f32x4*)(dst2 + (size_t)n * D))[lane + 64 * j] = y;
        }
      }
    }
  }
}

DEV void prologue(const Params& p, LAS unsigned char* lds, int wave, int lane) {
  LAS float* scr = (LAS float*)(lds + wave * 16384);
  const int gw = blockIdx.x * 8 + wave, NGW = gridDim.x * 8;
  conv_all(p, gw, NGW, scr, lane);
  const long long tid = (long long)blockIdx.x * NTHREADS + threadIdx.x, nthr = (long long)gridDim.x * NTHREADS;
  {
    const long long padw = (long long)(N_IN_PAD - N_IN) * 1024 / 8;
    for (long long i = tid; i < 2 * padw; i += nthr) {
      const int li = (int)(i / padw); const long long r = i % padw;
      ((u32x4*)(p.wt_in + ((size_t)li * N_IN_PAD + N_IN) * 1024))[r] = (u32x4){0u, 0u, 0u, 0u};
    }
    const long long padc = (long long)128 * 2048 / 8;
    for (long long i = tid; i < 4 * padc; i += nthr) {
      const int q = (int)(i / padc); const long long r = i % padc;
      ((u32x4*)(p.wt_c1 + ((size_t)q * 256 + 128) * 2048))[r] = (u32x4){0u, 0u, 0u, 0u};
    }
    if (tid < 64) p.cnt[tid] = 0;
    for (long long i = tid; i < 2LL * BATCH * NSA_G * 64; i += nthr) {
      const long long wb = i / (NSA_G * 64), r = i % (NSA_G * 64);
      p.kcb[(wb * 128 + 127) * NSA_G * 64 + r] = 0;
    }
    for (long long i = tid; i < (long long)BATCH * MEM_LEN * 1024 / 4; i += nthr) {
      const f32x4 v = ((const f32x4*)p.mem)[i];
      u32x2 w; w.x = pk2(v.x, v.y); w.y = pk2(v.z, v.w);
      ((u32x2*)p.membf)[i] = w;
    }
  }
  ln_rows_w<0>(p, p.x, p.ln0_g, p.ln0_b, p.xf, p.xb, nullptr, gw, NGW, lane);
}

struct USched {
  int nM, nN, nwg, G, c;
  int moe, nct, total; const LAS int* tile_e;
  DEV void init_static(int M, int N, int G_, int c_) { nM = M / 256; nN = N / 256; nwg = nM * nN; G = G_; c = c_; moe = 0; nct = 1; total = nwg; tile_e = nullptr; }
  DEV void init_moe(int G_, int c_, int nct_, int total_, const LAS int* te) { nM = 1; nN = 1; nwg = total_; G = G_; c = c_; moe = 1; nct = nct_; total = total_; tile_e = te; }
  DEV bool next(int i, pg8::Unit& u) const {
    const long L = (long)i * G + c;
    if (!(moe && (G & 7) == 0) && L >= total) return false;
    if (moe) {
      if ((G & 7) == 0) {
        const int xcd = c & 7, rank = c >> 3, nr = G >> 3, T = total / nct;
        const int tlo = (T * xcd) >> 3, thi = (T * (xcd + 1)) >> 3;
        const int lu = i * nr + rank;
        if (lu >= (thi - tlo) * nct) return false;
        const int rt = tlo + lu / nct, j = lu % nct;
        u.pm = rt; u.pn = tile_e[rt] * nct + j; return true;
      }
      const int rt = (int)(L / nct), j = (int)(L % nct); u.pm = rt; u.pn = tile_e[rt] * nct + j; return true;
    }
    int wgid = (int)L; { const int q = nwg / 8, r = nwg % 8, xcd = wgid % 8, off = wgid / 8; wgid = (xcd < r ? xcd * (q + 1) : r * (q + 1) + (xcd - r) * q) + off; }
    const int nig = 8 * nN, gid = wgid / nig, fm = gid * 8, gsz = (nM - fm) < 8 ? (nM - fm) : 8;
    u.pm = fm + ((wgid % nig) % gsz); u.pn = (wgid % nig) / gsz; return true;
  }
  DEV void a_ready(const pg8::Unit&) const {}
  DEV void done(const pg8::Unit&) const {}
};

enum { EM_INPROJ = 0, EM_BRCAT, EM_RES, EM_BF16, EM_MOE1, EM_MOE2, EM_HID };
#define EPI_FENCE() asm volatile("" ::: "memory")
struct EpiU {
  static constexpr bool PERM = false, AFTER_DRAIN = false;
  int mode, ldc;
  void* q0;
  const void* q1;
  const void* q2;
  const void* q3;
  const LAS int* te;
  DEV void mid(f32x4 (&acc)[2][2][4][2], const pg8::Unit& un, int wr, int wc, int t) const {
    if (mode != EM_BRCAT || (t != 4 && t != 20)) return;
    const act_t* ub = (const act_t*)q1;
    int l2;
    asm volatile("v_mbcnt_lo_u32_b32 %0, -1, 0\n\tv_mbcnt_hi_u32_b32 %0, -1, %0" : "=v"(l2));
    const int fr = l2 & 15, fq = l2 >> 4;
    const int row0 = un.pm * 256 + wr * 64 + fr, col0 = un.pn * 256 + wc * 32 + 4 * fq;
    const int goff = OFF_MG + (t == 4 ? 0 : D);
    const float L2E = -1.4426950408889634f;
#pragma unroll
    for (int ai = 0; ai < 2; ++ai)
#pragma unroll
      for (int m = 0; m < 4; ++m) {
        const int row = row0 + ai * 128 + m * 16;
#pragma unroll
        for (int bj = 0; bj < 2; ++bj)
#pragma unroll
          for (int n = 0; n < 2; ++n) {
            const int col = col0 + bj * 128 + n * 16;
            const act_t* gp = ub + (size_t)row * N_IN + goff + col;
            const u32x2 ga = *(const u32x2*)gp, gb = *(const u32x2*)(gp + D);
            const float ea0 = __builtin_amdgcn_exp2f(__uint_as_float(ga.x << 16) * L2E), ea1 = __builtin_amdgcn_exp2f(__uint_as_float(ga.x & 0xffff0000u) * L2E);
            const float ea2 = __builtin_amdgcn_exp2f(__uint_as_float(ga.y << 16) * L2E), ea3 = __builtin_amdgcn_exp2f(__uint_as_float(ga.y & 0xffff0000u) * L2E);
            const float eb0 = __builtin_amdgcn_exp2f(__uint_as_float(gb.x << 16) * L2E), eb1 = __builtin_amdgcn_exp2f(__uint_as_float(gb.x & 0xffff0000u) * L2E);
            const float eb2 = __builtin_amdgcn_exp2f(__uint_as_float(gb.y << 16) * L2E), eb3 = __builtin_amdgcn_exp2f(__uint_as_float(gb.y & 0xffff0000u) * L2E);
            f32x4& v = acc[ai][bj][m][n];
            v.x *= (1.0f + eb0) * __builtin_amdgcn_rcpf(1.0f + ea0); v.y *= (1.0f + eb1) * __builtin_amdgcn_rcpf(1.0f + ea1);
            v.z *= (1.0f + eb2) * __builtin_amdgcn_rcpf(1.0f + ea2); v.w *= (1.0f + eb3) * __builtin_amdgcn_rcpf(1.0f + ea3);
          }
        if (m == 3) EPI_FENCE();
      }
  }
  DEV void operator()(const f32x4 (&acc)[2][2][4][2], const pg8::Unit& un, int wr, int wc, int fr, int fq) const {
    {
      int l2;
      asm volatile("v_mbcnt_lo_u32_b32 %0, -1, 0\n\tv_mbcnt_hi_u32_b32 %0, -1, %0" : "=v"(l2));
      fr = l2 & 15; fq = l2 >> 4;
    }
    const int row0 = un.pm * 256 + wr * 64 + fr;
    act_t* const ob = (act_t*)q0; float* const of = (float*)q0;
    const float* const f0 = (const float*)q1; const act_t* const ub = (const act_t*)q1;
    const float* const f1 = (const float*)q2; const int* const il = (const int*)q3;
    if (mode == EM_INPROJ) {
      const int col0 = un.pn * 256 + wc * 32 + 4 * fq;
      f32x4 bv[2][2];
#pragma unroll
      for (int bj = 0; bj < 2; ++bj)
#pragma unroll
        for (int n = 0; n < 2; ++n) { const int col = col0 + bj * 128 + n * 16; bv[bj][n] = col < N_IN ? *(const f32x4*)(f0 + col) : (f32x4){0.f, 0.f, 0.f, 0.f}; }
#pragma unroll
      for (int ai = 0; ai < 2; ++ai)
#pragma unroll
        for (int m = 0; m < 4; ++m) {
          const int row = row0 + ai * 128 + m * 16;
#pragma unroll
          for (int bj = 0; bj < 2; ++bj)
#pragma unroll
            for (int n = 0; n < 2; ++n) {
              const int col = col0 + bj * 128 + n * 16;
              if (col < N_IN) {
                const f32x4 v = acc[ai][bj][m][n] + bv[bj][n];
                u32x2 w; w.x = pk2(v.x, v.y); w.y = pk2(v.z, v.w);
                *(u32x2*)(ob + (size_t)row * N_IN + col) = w;
              }
            }
        }
    } else if (mode == EM_BRCAT) {
      const int col0 = un.pn * 256 + wc * 32 + 4 * fq;
#pragma unroll
      for (int ai = 0; ai < 2; ++ai)
#pragma unroll
        for (int m = 0; m < 4; ++m) {
          const int row = row0 + ai * 128 + m * 16;
#pragma unroll
          for (int bj = 0; bj < 2; ++bj)
#pragma unroll
            for (int n = 0; n < 2; ++n) {
              const int col = col0 + bj * 128 + n * 16;
              const u32x2 gw = *(const u32x2*)(ub + (size_t)row * N_IN + OFF_MG + 2 * D + col);
              f32x4 v = acc[ai][bj][m][n];
              v.x *= fsig(__uint_as_float(gw.x << 16)); v.y *= fsig(__uint_as_float(gw.x & 0xffff0000u));
              v.z *= fsig(__uint_as_float(gw.y << 16)); v.w *= fsig(__uint_as_float(gw.y & 0xffff0000u));
              u32x2 w; w.x = pk2(v.x, v.y); w.y = pk2(v.z, v.w);
              *(u32x2*)(ob + (size_t)row * D + col) = w;
            }
          if (m == 3) EPI_FENCE();
        }
    } else if (mode == EM_RES) {
      const int col0 = un.pn * 256 + wc * 32 + 4 * fq;
#pragma unroll
      for (int ai = 0; ai < 2; ++ai)
#pragma unroll
        for (int m = 0; m < 4; ++m) {
          const int row = row0 + ai * 128 + m * 16;
#pragma unroll
          for (int bj = 0; bj < 2; ++bj)
#pragma unroll
            for (int n = 0; n < 2; ++n) {
              const int col = col0 + bj * 128 + n * 16;
              const f32x4 x = *(const f32x4*)(f0 + (size_t)row * D + col);
              *(f32x4*)(of + (size_t)row * D + col) = x * ALPHA + acc[ai][bj][m][n];
            }
          if (m == 3) EPI_FENCE();
        }
    } else if (mode == EM_BF16) {
      const int col0 = un.pn * 256 + wc * 32 + 4 * fq;
#pragma unroll
      for (int ai = 0; ai < 2; ++ai)
#pragma unroll
        for (int m = 0; m < 4; ++m) {
          const int row = row0 + ai * 128 + m * 16;
#pragma unroll
          for (int bj = 0; bj < 2; ++bj)
#pragma unroll
            for (int n = 0; n < 2; ++n) {
              const int col = col0 + bj * 128 + n * 16;
              const f32x4 v = acc[ai][bj][m][n];
              u32x2 w; w.x = pk2(v.x, v.y); w.y = pk2(v.z, v.w);
              *(u32x2*)(ob + (size_t)row * ldc + col) = w;
            }
          EPI_FENCE();
        }
    } else if (mode == EM_MOE1) {
      const int e = te[un.pm], j = un.pn & 7;
      f32x4 bg[2], bu[2];
#pragma unroll
      for (int n = 0; n < 2; ++n) {
        const int cj = j * 128 + wc * 32 + n * 16 + 4 * fq;
        bg[n] = *(const f32x4*)(f0 + (size_t)e * 2048 + cj); bu[n] = *(const f32x4*)(f0 + (size_t)e * 2048 + 1024 + cj);
      }
#pragma unroll
      for (int ai = 0; ai < 2; ++ai)
#pragma unroll
        for (int m = 0; m < 4; ++m) {
          const int row = row0 + ai * 128 + m * 16;
#pragma unroll
          for (int n = 0; n < 2; ++n) {
            const int cj = j * 128 + wc * 32 + n * 16 + 4 * fq;
            const f32x4 g = acc[ai][0][m][n] + bg[n], u = acc[ai][1][m][n] + bu[n];
            float o[4];
#pragma unroll
            for (int i = 0; i < 4; ++i) {
              const float gt = fminf(g[i], 7.0f), up = fminf(fmaxf(u[i], -7.0f), 7.0f);
              o[i] = (up + 1.0f) * gt * __builtin_amdgcn_rcpf(1.0f + __builtin_amdgcn_exp2f(-1.702f * 1.4426950408889634f * gt));
            }
            u32x2 w; w.x = pk2(o[0], o[1]); w.y = pk2(o[2], o[3]);
            *(u32x2*)(ob + (size_t)row * 1024 + cj) = w;
          }
        }
    } else if (mode == EM_MOE2) {
      const int e = te[un.pm], j = un.pn & 3;
      const int col0 = j * 256 + wc * 32 + 4 * fq;
      int aidv[8]; float gtv[8]; f32x4 bv[2][2];
#pragma unroll
      for (int bj = 0; bj < 2; ++bj)
#pragma unroll
        for (int n = 0; n < 2; ++n) bv[bj][n] = *(const f32x4*)(f0 + (size_t)e * 1024 + col0 + bj * 128 + n * 16);
#pragma unroll
      for (int r = 0; r < 8; ++r) aidv[r] = il[row0 + (r >> 2) * 128 + (r & 3) * 16];
#pragma unroll
      for (int r = 0; r < 8; ++r) gtv[r] = f1[aidv[r] >= 0 ? aidv[r] : 0];
#pragma unroll
      for (int r = 0; r < 8; ++r) {
        const int ai = r >> 2, m = r & 3;
        if (aidv[r] >= 0) {
#pragma unroll
          for (int bj = 0; bj < 2; ++bj)
#pragma unroll
            for (int n = 0; n < 2; ++n) {
              const int col = col0 + bj * 128 + n * 16;
              const f32x4 v = (acc[ai][bj][m][n] + bv[bj][n]) * gtv[r];
              u32x2 w; w.x = pk2(v.x, v.y); w.y = pk2(v.z, v.w);
              *(u32x2*)(ob + (size_t)aidv[r] * 1024 + col) = w;
            }
        }
      }
    } else if (mode == EM_HID) {
      const int col0 = wc * 32 + 4 * fq;
#pragma unroll
      for (int ai = 0; ai < 2; ++ai)
#pragma unroll
        for (int m = 0; m < 4; ++m) {
          const int row = row0 + ai * 128 + m * 16;
          if (row < CMP_ROWS) {
#pragma unroll
            for (int n = 0; n < 2; ++n) {
              const f32x4 a = acc[ai][0][m][n];
              f32x4 v;
              v.x = a.x * fsig(1.5957691216057308f * (a.x + 0.044715f * a.x * a.x * a.x)); v.y = a.y * fsig(1.5957691216057308f * (a.y + 0.044715f * a.y * a.y * a.y));
              v.z = a.z * fsig(1.5957691216057308f * (a.z + 0.044715f * a.z * a.z * a.z)); v.w = a.w * fsig(1.5957691216057308f * (a.w + 0.044715f * a.w * a.w * a.w));
              *(f32x4*)(of + (size_t)row * CMP_HID + col0 + n * 16) = v;
            }
          }
          EPI_FENCE();
        }
    }
  }
};

DEV int moe_tables(const Params& p, int li, LAS int* tab, int t32) {
  __syncthreads();
  if (t32 < NE) tab[32 + t32] = p.cnt[li * 32 + t32];
  __syncthreads();
  if (t32 < 64) {
    const int e = t32 & 31;
    const int nt = (tab[32 + e] + 255) >> 8;
    int incl = nt;
#pragma unroll
    for (int o = 1; o < 32; o <<= 1) {
      const int up = __builtin_amdgcn_ds_bpermute(((t32 - o) & 63) << 2, incl);
      if (e >= o) incl += up;
    }
    const int excl = incl - nt;
    if (t32 < 32) {
      tab[e] = excl * 256;
      for (int k = 0; k < nt; ++k) tab[128 + excl + k] = e;
      if (e == 31) tab[64] = incl;
    }
  }
  __syncthreads();
  return tab[64];
}

DEV void moe_prep(const Params& p, int li, LAS int* tab, int wave, int lane, int t32) {
  const int ntiles = moe_tables(p, li, tab, t32);
  const int gw = blockIdx.x * 8 + wave, NGW = gridDim.x * 8;
  for (int tk0 = gw; tk0 < N_TOK; tk0 += 4 * NGW) {
    u32x4 v0[4], v1[4]; int rowi[4][4];
#pragma unroll
    for (int q = 0; q < 4; ++q) {
      const int tk = (tk0 + q * NGW < N_TOK) ? tk0 + q * NGW : tk0;
      const u32x4* src = (const u32x4*)(p.xb + (size_t)tk * 1024);
      v0[q] = src[lane]; v1[q] = src[lane + 64];
#pragma unroll
      for (int k = 0; k < 4; ++k) rowi[q][k] = tab[p.topi[tk * 4 + k]] + p.rank[tk * 4 + k];
    }
#pragma unroll
    for (int q = 0; q < 4; ++q) {
      const int tk = tk0 + q * NGW;
      if (tk < N_TOK) {
#pragma unroll
        for (int k = 0; k < 4; ++k) {
          if (lane == 0) p.rowlist[rowi[q][k]] = tk * 4 + k;
          u32x4* dst = (u32x4*)(p.xg + (size_t)rowi[q][k] * 1024);
          dst[lane] = v0[q]; dst[lane + 64] = v1[q];
        }
      }
    }
  }
  const long long tid = (long long)blockIdx.x * NTHREADS + t32, nthr = (long long)gridDim.x * NTHREADS;
  for (long long r = tid; r < (long long)ntiles * 256; r += nthr) {
    const int e = tab[128 + (int)(r >> 8)];
    if ((int)r - tab[e] >= tab[32 + e]) p.rowlist[r] = -1;
  }
}

typedef short v4i16_t __attribute__((ext_vector_type(4)));
DEV v4i16_t tr_read(const LAS unsigned char* p) { return __builtin_amdgcn_ds_read_tr16_b64_v4i16((LAS v4i16_t*)p); }

constexpr int AT_ROWB = 144;
constexpr int AT_TILEB = 64 * AT_ROWB;
constexpr int AT_HALF_KV = 4 * AT_TILEB;
constexpr int AT_SLAB_OFF = 2 * AT_HALF_KV;
constexpr int AT_SLAB_WAVE = 32 * 33 * 4;
constexpr int AT_SLAB_HALF = 4 * AT_SLAB_WAVE;
constexpr int AT_XCH_OFF = AT_SLAB_OFF + 2 * AT_SLAB_HALF;
static_assert(AT_XCH_OFF + 16 <= RING_BYTES, "attention LDS map");
constexpr float SC2 = 0.125f * 1.4426950408889634f;

struct AttnState { f32x4 O[2][4]; float m[2], l[2]; };

template <bool PROB, class Job>
DEV void attn_tile(const Job& job, const LAS unsigned char* Kb, const LAS unsigned char* Vb, const bf16x8 (&qf)[2][2], AttnState& st,
                   LAS float* slab, int cur, int wih, int lane) {
  const int i15 = lane & 15, g4 = lane >> 4;
  f32x4 S[2][4];
#pragma unroll
  for (int sub = 0; sub < 2; ++sub)
#pragma unroll
    for (int t = 0; t < 4; ++t) S[sub][t] = (f32x4){0.f, 0.f, 0.f, 0.f};
#pragma unroll
  for (int t = 0; t < 4; ++t)
#pragma unroll
    for (int kk = 0; kk < 2; ++kk) {
      const bf16x8 kf = *(const LAS bf16x8*)(Kb + (16 * t + i15) * AT_ROWB + (kk * 32 + 8 * g4) * 2);
#pragma unroll
      for (int sub = 0; sub < 2; ++sub) S[sub][t] = __builtin_amdgcn_mfma_f32_16x16x32_bf16(kf, qf[sub][kk], S[sub][t], 0, 0, 0);
    }
  bf16x8 pf[2][2];
  const bool efree = job.elemfree(cur, wih);
#pragma unroll
  for (int sub = 0; sub < 2; ++sub) {
    const int row = wih * 32 + sub * 16 + i15;
    if (!efree) {
      const int mbv = job.mb(row, cur, g4);
#pragma unroll
      for (int t = 0; t < 4; ++t)
#pragma unroll
        for (int j = 0; j < 4; ++j) S[sub][t][j] = job.ok(mbv, 16 * t + j) ? S[sub][t][j] : -INFINITY;
    }
    float mx = fmaxf(fmaxf(S[sub][0][0], S[sub][0][1]), fmaxf(S[sub][0][2], S[sub][0][3]));
#pragma unroll
    for (int t = 1; t < 4; ++t) mx = fmaxf(fmaxf(mx, fmaxf(S[sub][t][0], S[sub][t][1])), fmaxf(S[sub][t][2], S[sub][t][3]));
    if (!PROB) {
      mx = fmaxf(mx, shx(mx, lane, 16));
      mx = fmaxf(mx, shx(mx, lane, 32));
      const bool rok = job.rowok(sub, cur);
      const float mcand = rok ? mx * SC2 : -INFINITY;
      const float mnew = fmaxf(st.m[sub], mcand);
      const float msafe = (mnew == -INFINITY) ? 0.f : mnew;
      const float corr = __builtin_amdgcn_exp2f(st.m[sub] - msafe);
      st.m[sub] = mnew;
      const float msub = rok ? msafe : INFINITY;
      float psum = 0.f;
#pragma unroll
      for (int t = 0; t < 4; ++t)
#pragma unroll
        for (int j = 0; j < 4; ++j) { const float pp = __builtin_amdgcn_exp2f(__builtin_fmaf(S[sub][t][j], SC2, -msub)); S[sub][t][j] = pp; psum += pp; }
      st.l[sub] = st.l[sub] * corr + psum;
      if (__builtin_amdgcn_ballot_w64(corr != 1.0f) != 0ull) {
#pragma unroll
        for (int dt = 0; dt < 4; ++dt) st.O[sub][dt] *= corr;
      }
#pragma unroll
      for (int s2 = 0; s2 < 2; ++s2) {
        u32x4 w;
        w.x = pk2(S[sub][2 * s2][0], S[sub][2 * s2][1]); w.y = pk2(S[sub][2 * s2][2], S[sub][2 * s2][3]);
        w.z = pk2(S[sub][2 * s2 + 1][0], S[sub][2 * s2 + 1][1]); w.w = pk2(S[sub][2 * s2 + 1][2], S[sub][2 * s2 + 1][3]);
        pf[sub][s2] = __builtin_bit_cast(bf16x8, w);
      }
    } else {
      const float msafe = (st.m[sub] == -INFINITY) ? 0.f : st.m[sub];
      const int q = sub * 16 + i15;
#pragma unroll
      for (int t = 0; t < 4; ++t) {
        const float p0 = __builtin_amdgcn_exp2f(__builtin_fmaf(S[sub][t][0], SC2, -msafe)) * st.l[sub], p1 = __builtin_amdgcn_exp2f(__builtin_fmaf(S[sub][t][1], SC2, -msafe)) * st.l[sub];
        const float p2 = __builtin_amdgcn_exp2f(__builtin_fmaf(S[sub][t][2], SC2, -msafe)) * st.l[sub], p3 = __builtin_amdgcn_exp2f(__builtin_fmaf(S[sub][t][3], SC2, -msafe)) * st.l[sub];
        const int jb = 16 * cur + 4 * t + g4;
        slab[q * 33 + jb] += (p0 + p1) + (p2 + p3);
        S[sub][t][3] = p3;
      }
      asm volatile("s_waitcnt lgkmcnt(0)" ::: "memory");
#pragma unroll
      for (int t = 0; t < 4; ++t) {
        const int jb = 16 * cur + 4 * t + g4 + 1;
        if (jb < 32) slab[q * 33 + jb] += S[sub][t][3];
      }
      asm volatile("s_waitcnt lgkmcnt(0)" ::: "memory");
    }
  }
  if (!PROB) {
#pragma unroll
    for (int dt = 0; dt < 4; ++dt)
#pragma unroll
      for (int s2 = 0; s2 < 2; ++s2) {
        const LAS unsigned char* vp = Vb + (32 * s2 + 4 * g4 + (i15 >> 2)) * AT_ROWB + (16 * dt + 4 * (lane & 3)) * 2;
        const v4i16_t lo = tr_read(vp), hi = tr_read(vp + 16 * AT_ROWB);
        bf16x8 vf;
        vf[0] = lo[0]; vf[1] = lo[1]; vf[2] = lo[2]; vf[3] = lo[3]; vf[4] = hi[0]; vf[5] = hi[1]; vf[6] = hi[2]; vf[7] = hi[3];
#pragma unroll
        for (int sub = 0; sub < 2; ++sub) st.O[sub][dt] = __builtin_amdgcn_mfma_f32_16x16x32_bf16(vf, pf[sub][s2], st.O[sub][dt], 0, 0, 0);
      }
  }
}

DEV void half_barrier(LAS unsigned* cnt, int lane) {
  asm volatile("s_waitcnt lgkmcnt(0)" ::: "memory");
  unsigned old = 0;
  if (lane == 0) old = __hip_atomic_fetch_add(cnt, 1u, __ATOMIC_RELAXED, __HIP_MEMORY_SCOPE_WORKGROUP);
  old = (unsigned)__builtin_amdgcn_readfirstlane((int)old);
  const unsigned target = (old / 4u + 1u) * 4u;
  while ((int)(__hip_atomic_load(cnt, __ATOMIC_RELAXED, __HIP_MEMORY_SCOPE_WORKGROUP) - target) < 0) __builtin_amdgcn_s_sleep(1);
  asm volatile("" ::: "memory");
}

template <bool PROB, class Job>
DEV void attn_run(const Job& job, LAS unsigned char* lds, AttnState& st, int half, int hth, int wih, int lane) {
  LAS unsigned char* kvh = lds + half * AT_HALF_KV;
  LAS unsigned* hb = (LAS unsigned*)(lds + MISC_OFF + 8192 + 128) + half * 16;
  LAS float* slab = (LAS float*)(lds + AT_SLAB_OFF + half * AT_SLAB_HALF + wih * AT_SLAB_WAVE);
  const int i15 = lane & 15, g4 = lane >> 4;
  unsigned rem = job.tilemask();
  bf16x8 qf[2][2];
#pragma unroll
  for (int sub = 0; sub < 2; ++sub) {
    const act_t* qr = job.qrow(wih * 32 + sub * 16 + i15);
#pragma unroll
    for (int kk = 0; kk < 2; ++kk) qf[sub][kk] = *(const bf16x8*)(qr + kk * 32 + 8 * g4);
  }
  if (!PROB) {
#pragma unroll
    for (int sub = 0; sub < 2; ++sub) {
      st.m[sub] = -INFINITY; st.l[sub] = 0.f;
#pragma unroll
      for (int dt = 0; dt < 4; ++dt) st.O[sub][dt] = (f32x4){0.f, 0.f, 0.f, 0.f};
    }
  }
  const int srow = hth >> 2, sch = hth & 3;
  u32x4 ak0, ak1, av0, av1;
#define AT_LOAD(k0, k1, v0, v1, T) do { const act_t* kr_ = job.krow(T, srow) + sch * 16; k0 = *(const u32x4*)kr_; k1 = *(const u32x4*)(kr_ + 8); \
    if (!PROB) { const act_t* vr_ = job.vrow(T, srow) + sch * 16; v0 = *(const u32x4*)vr_; v1 = *(const u32x4*)(vr_ + 8); } } while (0)
#define AT_WRITE(k0, k1, v0, v1, BUF) do { LAS unsigned char* kd_ = kvh + (BUF) * AT_TILEB + srow * AT_ROWB + sch * 32; *(LAS u32x4*)kd_ = k0; *(LAS u32x4*)(kd_ + 16) = k1; \
    if (!PROB) { LAS unsigned char* vd_ = kvh + (2 + (BUF)) * AT_TILEB + srow * AT_ROWB + sch * 32; *(LAS u32x4*)vd_ = v0; *(LAS u32x4*)(vd_ + 16) = v1; } } while (0)
#define AT_NEXT(T) do { T = -1; if (rem) { T = __builtin_ctz(rem); rem &= rem - 1; } } while (0)
  int t0;
  AT_NEXT(t0);
  if (t0 >= 0) { AT_LOAD(ak0, ak1, av0, av1, t0); AT_WRITE(ak0, ak1, av0, av1, 0); }
  half_barrier(hb, lane);
  for (int it = 0; t0 >= 0; ++it) {
    int t1;
    AT_NEXT(t1);
    if (t1 >= 0) AT_LOAD(ak0, ak1, av0, av1, t1);
    attn_tile<PROB>(job, kvh + (it & 1) * AT_TILEB, kvh + (2 + (it & 1)) * AT_TILEB, qf, st, slab, t0, wih, lane);
    if (t1 >= 0) AT_WRITE(ak0, ak1, av0, av1, (it + 1) & 1);
    half_barrier(hb, lane);
    t0 = t1;
  }
#undef AT_LOAD
#undef AT_WRITE
#undef AT_NEXT
  if (!PROB) {
#pragma unroll
    for (int sub = 0; sub < 2; ++sub) {
      float l = st.l[sub];
      l += shx(l, lane, 16);
      l += shx(l, lane, 32);
      const float inv = 1.0f / fmaxf(l, 1e-30f);
      st.l[sub] = l;
#pragma unroll
      for (int dt = 0; dt < 4; ++dt) st.O[sub][dt] *= inv;
    }
  }
}

struct SelJob {
  const act_t* u; int b, g, t0; unsigned um; unsigned tm[2];
  DEV unsigned tilemask() const { return um; }
  DEV const act_t* qrow(int r) const { return u + ((size_t)b * SEQ + t0 + (r & 31)) * N_IN + OFF_CQ + (g * 4 + (r >> 5)) * 64; }
  DEV const act_t* krow(int kt, int j) const { return u + ((size_t)b * SEQ + kt * 64 + j) * N_IN + OFF_CKS + g * 64; }
  DEV const act_t* vrow(int kt, int j) const { return u + ((size_t)b * SEQ + kt * 64 + j) * N_IN + OFF_CVS + g * 64; }
  DEV int mb(int r, int kt, int g4) const { return t0 + (r & 31) - kt * 64 - 4 * g4; }
  DEV bool rowok(int sub, int kt) const { return (tm[sub] >> kt) & 1u; }
  DEV bool ok(int m, int C) const { return m >= C; }
  DEV bool elemfree(int kt, int wih) const { return kt < (t0 >> 6); }
};
struct WinJob {
  const act_t* u; int b, g, t0; unsigned um;
  DEV unsigned tilemask() const { return um; }
  DEV const act_t* qrow(int r) const { return u + ((size_t)b * SEQ + t0 + (r & 31)) * N_IN + OFF_CQ + (g * 4 + (r >> 5)) * 64; }
  DEV const act_t* krow(int kt, int j) const { return u + ((size_t)b * SEQ + kt * 64 + j) * N_IN + OFF_CKW + g * 64; }
  DEV const act_t* vrow(int kt, int j) const { return u + ((size_t)b * SEQ + kt * 64 + j) * N_IN + OFF_CVW + g * 64; }
  DEV int mb(int r, int kt, int g4) const { return t0 + (r & 31) - kt * 64 - 4 * g4; }
  DEV bool rowok(int sub, int kt) const { return true; }
  DEV bool ok(int m, int C) const { return m >= C && m < NSA_WIN + C; }
  DEV bool elemfree(int kt, int wih) const { return kt * 64 + 63 <= t0 && t0 + 31 - kt * 64 < NSA_WIN; }
};
struct CmpJob {
  const act_t* u; const act_t* kcb; const act_t* vcb; int b, g, t0; unsigned um;
  DEV unsigned tilemask() const { return um; }
  DEV const act_t* qrow(int r) const { return u + ((size_t)b * SEQ + t0 + (r & 31)) * N_IN + OFF_CQ + (g * 4 + (r >> 5)) * 64; }
  DEV const act_t* krow(int kt, int j) const { return kcb + (((size_t)b * 128 + kt * 64 + j) * NSA_G + g) * 64; }
  DEV const act_t* vrow(int kt, int j) const { return vcb + (((size_t)b * 128 + kt * 64 + j) * NSA_G + g) * 64; }
  DEV int mb(int r, int kt, int g4) const { return t0 + (r & 31) - 31 - 16 * (kt * 64 + 4 * g4); }
  DEV bool rowok(int sub, int kt) const { return true; }
  DEV bool ok(int m, int C) const { return m >= 16 * C; }
  DEV bool elemfree(int kt, int wih) const { return kt == 0 && 16 * 63 + 31 <= t0; }
};
struct DilJob {
  const act_t* u; int b, col, dil, res, l0; unsigned um;
  DEV unsigned tilemask() const { return um; }
  DEV const act_t* qrow(int r) const { return u + ((size_t)b * SEQ + (l0 + r) * dil + res) * N_IN + OFF_AQ + col; }
  DEV const act_t* krow(int kt, int j) const { return u + ((size_t)b * SEQ + (kt * 64 + j) * dil + res) * N_IN + OFF_AK + col; }
  DEV const act_t* vrow(int kt, int j) const { return u + ((size_t)b * SEQ + (kt * 64 + j) * dil + res) * N_IN + OFF_AV + col; }
  DEV int mb(int r, int kt, int g4) const { return l0 + r - kt * 64 - 4 * g4; }
  DEV bool rowok(int sub, int kt) const { return true; }
  DEV bool ok(int m, int C) const { return m >= C && m <= 128 + C; }
  DEV bool elemfree(int kt, int wih) const { return kt * 64 + 63 <= l0 + 32 * wih && l0 + 32 * wih + 31 - kt * 64 <= 128; }
};

DEV unsigned range_mask(int lo, int hi) {
  return (hi >= 31 ? 0xffffffffu : ((1u << (hi + 1)) - 1u)) & ~((1u << lo) - 1u);
}

DEV bool nsa_unit(int round, int bid, int G, int half, int& b, int& g, int& tb) {
  if ((G & 7) == 0) {
    const int nr = G >> 3, rank = bid >> 3;
    const int slot = rank * 2 + half, nslot = nr * 2;
    const int pos = (round & 1) ? (nslot - 1 - slot) : slot;
    const int lu = round * nslot + pos;
    if (lu >= 256) return false;
    b = bid & 7; g = lu & 3; tb = 63 - (lu >> 2);
    return true;
  }
  const int pos = (round & 1) ? (G - 1 - bid) : bid;
  const int pair = round * G + pos;
  if (pair >= 1024) return false;
  const int un = pair * 2 + half;
  tb = 63 - un / 32; b = (un % 32) / 4; g = un % 4;
  return true;
}
DEV int nsa_rounds(int G) { return (G & 7) == 0 ? (256 + (G >> 3) * 2 - 1) / ((G >> 3) * 2) : (1024 + G - 1) / G; }

DEV void nsa_cmp_phase(const Params& p, LAS unsigned char* lds, int t32, int bid, int G) {
  const int lane = t32 & 63, wave = t32 >> 6, half = wave >> 2, wih = wave & 3, hth = t32 & 255;
  const int i15 = lane & 15, g4 = lane >> 4;
  LAS float* slabh = (LAS float*)(lds + AT_SLAB_OFF + half * AT_SLAB_HALF);
  for (int round = 0; round < nsa_rounds(G); ++round) {
    int b = 0, g = 0, tb = 0;
    const bool act = nsa_unit(round, bid, G, half, b, g, tb);
    const int t0 = tb * 32;
    const int nvmax = t0 + 31 >= 31 ? (t0 + 31 - 31) / 16 + 1 : 0;
    CmpJob job{p.u, p.kcb, p.kcb + (size_t)BATCH * 128 * NSA_G * 64, b, g, t0, 0u};
    job.um = !act ? 0u : (nvmax > 64 ? 3u : (nvmax > 0 ? 1u : 0u));
    for (int i = lane; i < 32 * 33; i += 64) slabh[wih * (32 * 33) + i] = 0.f;
    LAS unsigned char* kvh = lds + half * AT_HALF_KV;
    LAS unsigned* hb = (LAS unsigned*)(lds + MISC_OFF + 8192 + 128) + half * 16;
    LAS float* slab = slabh + wih * (32 * 33);
    {
      const int srow = hth >> 2, sch = hth & 3;
#pragma unroll
      for (int tl = 0; tl < 2; ++tl)
        if ((job.um >> tl) & 1u) {
          const act_t* kr = job.krow(tl, srow) + sch * 16; const act_t* vr = job.vrow(tl, srow) + sch * 16;
          const u32x4 k0 = *(const u32x4*)kr, k1 = *(const u32x4*)(kr + 8), v0 = *(const u32x4*)vr, v1 = *(const u32x4*)(vr + 8);
          LAS unsigned char* kd = kvh + tl * AT_TILEB + srow * AT_ROWB + sch * 32;
          *(LAS u32x4*)kd = k0; *(LAS u32x4*)(kd + 16) = k1;
          LAS unsigned char* vd = kvh + (2 + tl) * AT_TILEB + srow * AT_ROWB + sch * 32;
          *(LAS u32x4*)vd = v0; *(LAS u32x4*)(vd + 16) = v1;
        }
    }
    bf16x8 qf[2][2];
#pragma unroll
    for (int sub = 0; sub < 2; ++sub) {
      const act_t* qr = job.qrow(wih * 32 + sub * 16 + i15);
#pragma unroll
      for (int kk = 0; kk < 2; ++kk) qf[sub][kk] = *(const bf16x8*)(qr + kk * 32 + 8 * g4);
    }
    AttnState st;
#pragma unroll
    for (int sub = 0; sub < 2; ++sub) {
      st.m[sub] = -INFINITY; st.l[sub] = 0.f;
#pragma unroll
      for (int dt = 0; dt < 4; ++dt) st.O[sub][dt] = (f32x4){0.f, 0.f, 0.f, 0.f};
    }
    half_barrier(hb, lane);
    if (job.um & 1u) attn_tile<false>(job, kvh, kvh + 2 * AT_TILEB, qf, st, slab, 0, wih, lane);
    if (job.um & 2u) attn_tile<false>(job, kvh + AT_TILEB, kvh + 3 * AT_TILEB, qf, st, slab, 1, wih, lane);
#pragma unroll
    for (int sub = 0; sub < 2; ++sub) {
      float l = st.l[sub];
      l += shx(l, lane, 16);
      l += shx(l, lane, 32);
      const float inv = 1.0f / fmaxf(l, 1e-30f);
      st.l[sub] = inv;
#pragma unroll
      for (int dt = 0; dt < 4; ++dt) st.O[sub][dt] *= inv;
    }
    if (act) {
#pragma unroll
      for (int sub = 0; sub < 2; ++sub) {
        const int hh = g * 4 + wih;
        const size_t n = (size_t)b * SEQ + t0 + sub * 16 + i15;
        const float g0 = fsig(ldf(p.u[n * N_IN + OFF_CG + hh * 3 + 0]));
#pragma unroll
        for (int dt = 0; dt < 4; ++dt) { const f32x4 y = st.O[sub][dt] * g0; u32x2 w; w.x = pk2(y.x, y.y); w.y = pk2(y.z, y.w); *(u32x2*)((act_t*)p.ocmp + n * 1024 + hh * 64 + 16 * dt + 4 * g4) = w; }
      }
    }
    if (job.um & 1u) attn_tile<true>(job, kvh, kvh + 2 * AT_TILEB, qf, st, slab, 0, wih, lane);
    if (job.um & 2u) attn_tile<true>(job, kvh + AT_TILEB, kvh + 3 * AT_TILEB, qf, st, slab, 1, wih, lane);
    half_barrier(hb, lane);
    {
      const int q = hth >> 3, j4 = (hth & 7) * 4;
      float v[4];
#pragma unroll
      for (int i = 0; i < 4; ++i) {
        float s = 0.f;
#pragma unroll
        for (int w = 0; w < 4; ++w) s += slabh[w * (32 * 33) + q * 33 + j4 + i];
        const int j = j4 + i, qb = (t0 + q) >> 6;
        if (j == 0 || j == qb || j == qb - 1) s = INFINITY;
        else if (j > qb) s = -INFINITY;
        v[i] = s;
      }
      __syncthreads();
#pragma unroll
      for (int i = 0; i < 4; ++i) slabh[q * 33 + j4 + i] = v[i];
      __syncthreads();
      unsigned bits = 0u;
#pragma unroll
      for (int i = 0; i < 4; ++i) {
        int rank = 0;
#pragma unroll 1
        for (int jj = 0; jj < 32; ++jj) { const float w = slabh[q * 33 + jj]; rank += (w > v[i] || (w == v[i] && jj < j4 + i)) ? 1 : 0; }
        if (rank < N_SELECT) bits |= 1u << (j4 + i);
      }
      bits |= (unsigned)shxi((int)bits, lane, 1);
      bits |= (unsigned)shxi((int)bits, lane, 2);
      bits |= (unsigned)shxi((int)bits, lane, 4);
      if (act && (hth & 7) == 0) p.selm[((size_t)b * NSA_G + g) * SEQ + t0 + q] = bits;
      __syncthreads();
    }
  }
}

DEV void nsa_main_phase(const Params& p, LAS unsigned char* lds, int t32, int bid, int G) {
  const int lane = t32 & 63, wave = t32 >> 6, half = wave >> 2, wih = wave & 3, hth = t32 & 255;
  const int i15 = lane & 15, g4 = lane >> 4;
#define NSTAMP(i) do { if (GSEG >= 10 && blockIdx.x == 0 && t32 == 0) { const unsigned now_ = (unsigned)__builtin_amdgcn_s_memrealtime(); if ((i) > 0 && (i) - 1 + 10 == GSEG) p.barw[3600] += now_ - ns_prev; ns_prev = now_; } } while (0)
  unsigned ns_prev = 0u;
  for (int round2 = 0; round2 < nsa_rounds(G) * (NSA_PROBE == 5 ? 2 : 1); ++round2) {
    const int round = (NSA_PROBE == 5) ? (round2 >> 1) : round2;
    NSTAMP(0);
    int b = 0, g = 0, tb = 0;
    const bool act = nsa_unit(round, bid, G, half, b, g, tb);
    const int t0 = tb * 32;
    SelJob sj{p.u, b, g, t0, 0u, {0u, 0u}};
    if (act) {
      const unsigned* sm = p.selm + ((size_t)b * NSA_G + g) * SEQ + t0;
      sj.tm[0] = sm[i15]; sj.tm[1] = sm[16 + i15];
      unsigned um = sj.tm[0] | sj.tm[1];
      int l2 = lane;
      asm volatile("" : "+v"(l2));
      um |= (unsigned)shxi((int)um, l2, 1); um |= (unsigned)shxi((int)um, l2, 2);
      um |= (unsigned)shxi((int)um, l2, 4); um |= (unsigned)shxi((int)um, l2, 8);
      sj.um = um & range_mask(0, t0 >> 6);
    }
    u32x2 base[2][4];
    const int hh = g * 4 + wih;
    const size_t nrow0 = (size_t)b * SEQ + t0 + i15;
    const act_t gq10 = p.u[nrow0 * N_IN + OFF_CG + hh * 3 + 1], gq11 = p.u[(nrow0 + 16) * N_IN + OFF_CG + hh * 3 + 1];
    const act_t gq20 = p.u[nrow0 * N_IN + OFF_CG + hh * 3 + 2], gq21 = p.u[(nrow0 + 16) * N_IN + OFF_CG + hh * 3 + 2];
    {
      AttnState ss;
      NSTAMP(1);
      attn_run<false>(sj, lds, ss, half, hth, wih, lane);
      NSTAMP(2);
#if NSA_PROBE == 1
      attn_run<false>(sj, lds, ss, half, hth, wih, lane);
#endif
#pragma unroll
      for (int sub = 0; sub < 2; ++sub) {
        f32x4 oc[4];
#pragma unroll
        for (int dt = 0; dt < 4; ++dt) {
          const u32x2 cw = *(const u32x2*)((const act_t*)p.ocmp + (nrow0 + 16 * sub) * 1024 + hh * 64 + 16 * dt + 4 * g4);
          oc[dt] = (f32x4){__uint_as_float(cw.x << 16), __uint_as_float(cw.x & 0xffff0000u), __uint_as_float(cw.y << 16), __uint_as_float(cw.y & 0xffff0000u)};
        }
        const float g1 = fsig(ldf(sub ? gq11 : gq10));
#pragma unroll
        for (int dt = 0; dt < 4; ++dt) {
          const f32x4 y = ss.O[sub][dt] * g1 + oc[dt];
          base[sub][dt].x = pk2(y.x, y.y); base[sub][dt].y = pk2(y.z, y.w);
        }
      }
    }
    WinJob wj{p.u, b, g, t0, 0u};
    if (act) { const int lo = t0 - (NSA_WIN - 1) < 0 ? 0 : (t0 - (NSA_WIN - 1)) >> 6; wj.um = range_mask(lo, (t0 + 31) >> 6); }
    AttnState ws;
    NSTAMP(3);
    attn_run<false>(wj, lds, ws, half, hth, wih, lane);
    NSTAMP(4);
#if NSA_PROBE == 2
    attn_run<false>(wj, lds, ws, half, hth, wih, lane);
#endif
    if (act) {
#pragma unroll
      for (int sub = 0; sub < 2; ++sub) {
        const size_t n = nrow0 + 16 * sub;
        const float g2 = fsig(ldf(sub ? gq21 : gq20));
#pragma unroll
        for (int dt = 0; dt < 4; ++dt) {
          const u32x2 bw = base[sub][dt];
          f32x4 y = ws.O[sub][dt] * g2;
          y.x += __uint_as_float(bw.x << 16); y.y += __uint_as_float(bw.x & 0xffff0000u);
          y.z += __uint_as_float(bw.y << 16); y.w += __uint_as_float(bw.y & 0xffff0000u);
          u32x2 w; w.x = pk2(y.x, y.y); w.y = pk2(y.z, y.w);
          *(u32x2*)(p.yc + n * YLD + hh * 64 + 16 * dt + 4 * g4) = w;
        }
      }
    }
  }
}

DEV void dil_phase(const Params& p, LAS unsigned char* lds, int t32, int bid, int G) {
  const int lane = t32 & 63, wave = t32 >> 6, half = wave >> 2, wih = wave & 3, hth = t32 & 255;
  const int i15 = lane & 15, g4 = lane >> 4;
  const bool xm = (G & 7) == 0;
  const int npair = xm ? 96 : 768, pstep = xm ? (G >> 3) : G;
  for (int pair = xm ? (bid >> 3) : bid; pair < npair; pair += pstep) {
    const int un = pair * 2 + half;
    int gi, b, r2;
    if (xm) { b = bid & 7; gi = un / 64; r2 = un % 64; }
    else { gi = un / 512; const int r = un % 512; b = r / 64; r2 = r % 64; }
    const int dil = gi == 0 ? 1 : (gi == 1 ? 4 : 16);
    const int nlb = 16 / dil;
    const int h = r2 / 16, r3 = r2 % 16;
    const int res = r3 / nlb, lb = r3 % nlb;
    const int l0 = lb * 128;
    DilJob job{p.u, b, gi * 256 + h * 64, dil, res, l0, 0u};
    job.um = range_mask(l0 >= 128 ? (l0 - 128) >> 6 : 0, (l0 + 127) >> 6);
    AttnState st;
    attn_run<false>(job, lds, st, half, hth, wih, lane);
#pragma unroll
    for (int sub = 0; sub < 2; ++sub) {
      const int l = l0 + wih * 32 + sub * 16 + i15;
      const size_t n = (size_t)b * SEQ + l * dil + res;
#pragma unroll
      for (int dt = 0; dt < 4; ++dt) {
        const f32x4 y = st.O[sub][dt];
        u32x2 w; w.x = pk2(y.x, y.y); w.y = pk2(y.z, y.w);
        *(u32x2*)(p.dilo + ((size_t)gi * N_TOK + n) * 256 + h * 64 + 16 * dt + 4 * g4) = w;
      }
      if (g4 == 0) p.dill[((size_t)gi * N_TOK + n) * 4 + h] = st.m[sub] + __builtin_amdgcn_logf(st.l[sub]);
    }
  }
}

DEV void dil_combine(const Params& p, long long tid, long long nthr) {
  for (long long idx = tid; idx < (long long)N_TOK * 32; idx += nthr) {
    const size_t n = idx >> 5; const int c8 = (int)(idx & 31) * 8, h = c8 >> 6;
    const float l0 = p.dill[((size_t)0 * N_TOK + n) * 4 + h], l1 = p.dill[((size_t)1 * N_TOK + n) * 4 + h], l2 = p.dill[((size_t)2 * N_TOK + n) * 4 + h];
    const float mx = fmaxf(l0, fmaxf(l1, l2));
    float w0 = __builtin_amdgcn_exp2f(l0 - mx), w1 = __builtin_amdgcn_exp2f(l1 - mx), w2 = __builtin_amdgcn_exp2f(l2 - mx);
    const float inv = 1.0f / (w0 + w1 + w2);
    w0 *= inv; w1 *= inv; w2 *= inv;
    const u32x4 a = *(const u32x4*)(p.dilo + ((size_t)0 * N_TOK + n) * 256 + c8);
    const u32x4 bq = *(const u32x4*)(p.dilo + ((size_t)1 * N_TOK + n) * 256 + c8);
    const u32x4 c = *(const u32x4*)(p.dilo + ((size_t)2 * N_TOK + n) * 256 + c8);
    u32x4 o;
#pragma unroll
    for (int i = 0; i < 4; ++i) {
      const float lo = w0 * __uint_as_float(a[i] << 16) + w1 * __uint_as_float(bq[i] << 16) + w2 * __uint_as_float(c[i] << 16);
      const float hi = w0 * __uint_as_float(a[i] & 0xffff0000u) + w1 * __uint_as_float(bq[i] & 0xffff0000u) + w2 * __uint_as_float(c[i] & 0xffff0000u);
      o[i] = pk2(lo, hi);
    }
    *(u32x4*)(p.ya + n * YLD + c8) = o;
  }
}

DEV void cmpa_build(const Params& p, int li, long long tid, long long nthr) {
  for (long long idx = tid; idx < 2LL * CMP_ROWS * 256; idx += nthr) {
    const int which = (int)(idx / ((long long)CMP_ROWS * 256));
    const long long rem = idx % ((long long)CMP_ROWS * 256);
    const int row = (int)(rem >> 8), c8 = (int)(rem & 255) * 8, l = c8 >> 6, d = c8 & 63;
    const int g = row % NSA_G, c = (row / NSA_G) % N_CMP, b = row / (NSA_G * N_CMP);
    const float* pe = (which ? p.cmp_pe_v : p.cmp_pe_k) + (size_t)li * 32 * HD + l * HD + d;
    const u32x4 uv = *(const u32x4*)(p.u + ((size_t)b * SEQ + c * 16 + l) * N_IN + (which ? OFF_CVC : OFF_CKC) + g * HD + d);
    u32x4 o;
#pragma unroll
    for (int i = 0; i < 4; ++i) o[i] = pk2(__uint_as_float(uv[i] << 16) + pe[2 * i], __uint_as_float(uv[i] & 0xffff0000u) + pe[2 * i + 1]);
    *(u32x4*)(p.cmpA + ((size_t)which * CMP_ROWS_PAD + row) * 2048 + c8) = o;
  }
}

constexpr int XA_ROWB = 528;
constexpr int XA_TILEB = 32 * XA_ROWB;
static_assert(4 * XA_TILEB <= RING_BYTES, "xattn LDS map");
DEV void xattn_phase(const Params& p, LAS unsigned char* lds, int t32, int bid, int G) {
  const int lane = t32 & 63, wave = t32 >> 6, i15 = lane & 15, g4 = lane >> 4;
  const float sc2 = 0.0625f * 1.4426950408889634f;
  const bool xm = (G & 7) == 0;
  const int nun = xm ? XH * (SEQ / 128) : BATCH * XH * (SEQ / 128), ustep = xm ? (G >> 3) : G;
  for (int un = xm ? (bid >> 3) : bid; un < nun; un += ustep) {
    const int b = xm ? (bid & 7) : un / (XH * (SEQ / 128)), r = un % (XH * (SEQ / 128)), h = r / (SEQ / 128), qb = r % (SEQ / 128);
    const size_t nq = (size_t)b * SEQ + qb * 128 + wave * 16 + i15;
    bf16x8 qf[8];
#pragma unroll
    for (int kk = 0; kk < 8; ++kk) qf[kk] = *(const bf16x8*)(p.xq + nq * 1024 + h * 256 + kk * 32 + 8 * g4);
    f32x4 O[16];
#pragma unroll
    for (int dt = 0; dt < 16; ++dt) O[dt] = (f32x4){0.f, 0.f, 0.f, 0.f};
    float m = -INFINITY, l = 0.f;
    const int srow = t32 >> 4, sch = t32 & 15;
    const act_t* kbase = p.memk + ((size_t)b * MEM_LEN + srow) * 1024 + h * 256 + sch * 16;
    const act_t* vbase = p.memv + ((size_t)b * MEM_LEN + srow) * 1024 + h * 256 + sch * 16;
    u32x4 sk0 = *(const u32x4*)kbase, sk1 = *(const u32x4*)(kbase + 8), sv0 = *(const u32x4*)vbase, sv1 = *(const u32x4*)(vbase + 8);
    {
      LAS unsigned char* kd = lds + srow * XA_ROWB + sch * 32;
      *(LAS u32x4*)kd = sk0; *(LAS u32x4*)(kd + 16) = sk1;
      LAS unsigned char* vd = lds + 2 * XA_TILEB + srow * XA_ROWB + sch * 32;
      *(LAS u32x4*)vd = sv0; *(LAS u32x4*)(vd + 16) = sv1;
    }
    __syncthreads();
    for (int it = 0; it < MEM_LEN / 32; ++it) {
      if (it + 1 < MEM_LEN / 32) {
        const act_t* kr = kbase + (size_t)(it + 1) * 32 * 1024, *vr = vbase + (size_t)(it + 1) * 32 * 1024;
        sk0 = *(const u32x4*)kr; sk1 = *(const u32x4*)(kr + 8); sv0 = *(const u32x4*)vr; sv1 = *(const u32x4*)(vr + 8);
      }
      const LAS unsigned char* Kb = lds + (it & 1) * XA_TILEB;
      const LAS unsigned char* Vb = lds + (2 + (it & 1)) * XA_TILEB;
      f32x4 S[2];
      S[0] = (f32x4){0.f, 0.f, 0.f, 0.f}; S[1] = (f32x4){0.f, 0.f, 0.f, 0.f};
#pragma unroll
      for (int t = 0; t < 2; ++t)
#pragma unroll
        for (int kk = 0; kk < 8; ++kk) {
          const bf16x8 kf = *(const LAS bf16x8*)(Kb + (16 * t + i15) * XA_ROWB + (kk * 32 + 8 * g4) * 2);
          S[t] = __builtin_amdgcn_mfma_f32_16x16x32_bf16(kf, qf[kk], S[t], 0, 0, 0);
        }
      float mx = -INFINITY;
#pragma unroll
      for (int t = 0; t < 2; ++t)
#pragma unroll
        for (int j = 0; j < 4; ++j) { S[t][j] *= sc2; mx = fmaxf(mx, S[t][j]); }
      mx = fmaxf(mx, shx(mx, lane, 16));
      mx = fmaxf(mx, shx(mx, lane, 32));
      const float mnew = fmaxf(m, mx);
      const float corr = __builtin_amdgcn_exp2f(m - mnew);
      m = mnew;
      float psum = 0.f;
#pragma unroll
      for (int t = 0; t < 2; ++t)
#pragma unroll
        for (int j = 0; j < 4; ++j) { const float pp = __builtin_amdgcn_exp2f(S[t][j] - mnew); S[t][j] = pp; psum += pp; }
      l = l * corr + psum;
      u32x4 w;
      w.x = pk2(S[0][0], S[0][1]); w.y = pk2(S[0][2], S[0][3]); w.z = pk2(S[1][0], S[1][1]); w.w = pk2(S[1][2], S[1][3]);
      const bf16x8 pf = __builtin_bit_cast(bf16x8, w);
#pragma unroll
      for (int dt = 0; dt < 16; ++dt) {
        const LAS unsigned char* vp = Vb + (4 * g4 + (i15 >> 2)) * XA_ROWB + (16 * dt + 4 * (lane & 3)) * 2;
        const v4i16_t lo = tr_read(vp), hi = tr_read(vp + 16 * XA_ROWB);
        bf16x8 vf;
        vf[0] = lo[0]; vf[1] = lo[1]; vf[2] = lo[2]; vf[3] = lo[3]; vf[4] = hi[0]; vf[5] = hi[1]; vf[6] = hi[2]; vf[7] = hi[3];
        O[dt] = __builtin_amdgcn_mfma_f32_16x16x32_bf16(vf, pf, O[dt] * corr, 0, 0, 0);
      }
      if (it + 1 < MEM_LEN / 32) {
        LAS unsigned char* kd = lds + ((it + 1) & 1) * XA_TILEB + srow * XA_ROWB + sch * 32;
        *(LAS u32x4*)kd = sk0; *(LAS u32x4*)(kd + 16) = sk1;
        LAS unsigned char* vd = lds + (2 + ((it + 1) & 1)) * XA_TILEB + srow * XA_ROWB + sch * 32;
        *(LAS u32x4*)vd = sv0; *(LAS u32x4*)(vd + 16) = sv1;
      }
      __syncthreads();
    }
    l += shx(l, lane, 16);
    l += shx(l, lane, 32);
    const float inv = 1.0f / l;
#pragma unroll
    for (int dt = 0; dt < 16; ++dt) {
      const f32x4 y = O[dt] * inv;
      u32x2 w; w.x = pk2(y.x, y.y); w.y = pk2(y.z, y.w);
      *(u32x2*)(p.xo + nq * 1024 + h * 256 + 16 * dt + 4 * g4) = w;
    }
  }
}

constexpr int RT_LCNT = MISC_OFF + 4096, RT_BASE = RT_LCNT + 128, RT_SEL = RT_BASE + 128, RT_RANK = RT_SEL + 1024;
DEV void route_phase(const Params& p, int li, LAS unsigned char* lds, int t32, int bid, int G) {
  const int lane = t32 & 63, wave = t32 >> 6, i15 = lane & 15, g4 = lane >> 4;
  const float* W = p.w_router + (size_t)li * D * NE;
  LAS unsigned short* Wh = (LAS unsigned short*)lds;
  LAS unsigned short* Wl = (LAS unsigned short*)(lds + 65536);
  LAS int* lcnt = (LAS int*)(lds + RT_LCNT);
  LAS int* lbase = (LAS int*)(lds + RT_BASE);
  LAS int* lsel = (LAS int*)(lds + RT_SEL);
  LAS int* lrank = (LAS int*)(lds + RT_RANK);
  const int e = lane & 31;
  const float bias = p.b_router[li * NE + e];
  for (int blk = bid; blk < N_TOK / 64; blk += G) {
    __syncthreads();
    for (int i = 0; i < 16; ++i) {
      const int idx = t32 + 512 * i, k = idx >> 3, e4 = (idx & 7) * 4;
      const f32x4 w = ((const f32x4*)W)[idx];
#pragma unroll
      for (int q = 0; q < 4; ++q) {
        const unsigned short hi = f2bfh(w[q]);
        const unsigned short lo = f2bfh(w[q] - __uint_as_float(((unsigned)hi) << 16));
        Wh[(e4 + q) * 1024 + k] = hi; Wl[(e4 + q) * 1024 + k] = lo;
      }
    }
    if (t32 < 32) lcnt[t32] = 0;
    __syncthreads();
    f32x4 acc[4][2];
#pragma unroll
    for (int mt = 0; mt < 4; ++mt) { acc[mt][0] = (f32x4){0.f, 0.f, 0.f, 0.f}; acc[mt][1] = (f32x4){0.f, 0.f, 0.f, 0.f}; }
    const int n0 = blk * 64;
#pragma unroll 1
    for (int kk = 0; kk < 4; ++kk) {
      const int kb = wave * 128 + kk * 32 + 8 * g4;
      bf16x8 bh[2], bl[2];
#pragma unroll
      for (int nt = 0; nt < 2; ++nt) {
        bh[nt] = *(const LAS bf16x8*)(Wh + (16 * nt + i15) * 1024 + kb);
        bl[nt] = *(const LAS bf16x8*)(Wl + (16 * nt + i15) * 1024 + kb);
      }
#pragma unroll
      for (int mt = 0; mt < 4; ++mt) {
        const float* xr = p.xf + (size_t)(n0 + 16 * mt + i15) * D + kb;
        const f32x4 x0 = *(const f32x4*)xr, x1 = *(const f32x4*)(xr + 4);
        u32x4 hw, lw;
        {
          const unsigned h0 = pk2(x0.x, x0.y), h1 = pk2(x0.z, x0.w), h2 = pk2(x1.x, x1.y), h3 = pk2(x1.z, x1.w);
          hw = (u32x4){h0, h1, h2, h3};
          lw.x = pk2(x0.x - __uint_as_float(h0 << 16), x0.y - __uint_as_float(h0 & 0xffff0000u));
          lw.y = pk2(x0.z - __uint_as_float(h1 << 16), x0.w - __uint_as_float(h1 & 0xffff0000u));
          lw.z = pk2(x1.x - __uint_as_float(h2 << 16), x1.y - __uint_as_float(h2 & 0xffff0000u));
          lw.w = pk2(x1.z - __uint_as_float(h3 << 16), x1.w - __uint_as_float(h3 & 0xffff0000u));
        }
        const bf16x8 ah = __builtin_bit_cast(bf16x8, hw), al = __builtin_bit_cast(bf16x8, lw);
#pragma unroll
        for (int nt = 0; nt < 2; ++nt) {
          acc[mt][nt] = __builtin_amdgcn_mfma_f32_16x16x32_bf16(ah, bh[nt], acc[mt][nt], 0, 0, 0);
          acc[mt][nt] = __builtin_amdgcn_mfma_f32_16x16x32_bf16(ah, bl[nt], acc[mt][nt], 0, 0, 0);
          acc[mt][nt] = __builtin_amdgcn_mfma_f32_16x16x32_bf16(al, bh[nt], acc[mt][nt], 0, 0, 0);
        }
      }
    }
    __syncthreads();
    LAS float* part = (LAS float*)lds;
    LAS float* fin = (LAS float*)(lds + 8 * 64 * 33 * 4);
#pragma unroll
    for (int mt = 0; mt < 4; ++mt)
#pragma unroll
      for (int nt = 0; nt < 2; ++nt)
#pragma unroll
        for (int j = 0; j < 4; ++j) part[(wave * 64 + 16 * mt + 4 * g4 + j) * 33 + 16 * nt + i15] = acc[mt][nt][j];
    __syncthreads();
    {
      const int tok = t32 >> 3, e4 = (t32 & 7) * 4;
#pragma unroll
      for (int q = 0; q < 4; ++q) {
        float v = 0.f;
#pragma unroll
        for (int w = 0; w < 8; ++w) v += part[(w * 64 + tok) * 33 + e4 + q];
        fin[tok * 33 + e4 + q] = v;
      }
    }
    __syncthreads();
    float cur[8]; int sel[8][4]; float sv[8][4];
#pragma unroll
    for (int t = 0; t < 8; ++t) cur[t] = fin[(wave * 8 + t) * 33 + e] + bias;
#pragma unroll
    for (int k = 0; k < 4; ++k) {
      float bv[8]; int bi[8];
#pragma unroll
      for (int t = 0; t < 8; ++t) { bv[t] = cur[t]; bi[t] = e; }
#pragma unroll
      for (int o = 1; o < 32; o <<= 1) {
#pragma unroll
        for (int t = 0; t < 8; ++t) {
          const float ov = shx(bv[t], lane, o); const int oi = shxi(bi[t], lane, o);
          if (ov > bv[t] || (ov == bv[t] && oi < bi[t])) { bv[t] = ov; bi[t] = oi; }
        }
      }
#pragma unroll
      for (int t = 0; t < 8; ++t) { sel[t][k] = bi[t]; sv[t][k] = bv[t]; if (e == bi[t]) cur[t] = -INFINITY; }
    }
    int abase = __builtin_amdgcn_readfirstlane(wave * 32);
    asm volatile("" : "+s"(abase));
    if (lane == 0) {
#pragma unroll
      for (int t = 0; t < 8; ++t) {
        const int n = n0 + wave * 8 + t;
        const float e1 = expf(sv[t][1] - sv[t][0]), e2 = expf(sv[t][2] - sv[t][0]), e3 = expf(sv[t][3] - sv[t][0]);
        const float inv = 1.0f / (1.0f + e1 + e2 + e3);
        p.topg[n * 4 + 0] = inv; p.topg[n * 4 + 1] = e1 * inv; p.topg[n * 4 + 2] = e2 * inv; p.topg[n * 4 + 3] = e3 * inv;
#pragma unroll
        for (int k = 0; k < 4; ++k) {
          const int a = abase + t * 4 + k;
          lsel[a] = sel[t][k];
          lrank[a] = __hip_atomic_fetch_add(lcnt + sel[t][k], 1, __ATOMIC_RELAXED, __HIP_MEMORY_SCOPE_WORKGROUP);
        }
      }
    }
    __syncthreads();
    if (t32 < 32) lbase[t32] = atomicAdd(&p.cnt[li * 32 + t32], lcnt[t32]);
    __syncthreads();
    if (t32 < 256) {
      const int a = blk * 256 + t32, ee = lsel[t32];
      p.topi[a] = ee;
      p.rank[a] = lbase[ee] + lrank[t32];
    }
  }
  __syncthreads();
}

DEV void kcv_phase(const Params& p, int li, LAS unsigned char* lds, int t32, int bid, int G) {
  const int lane = t32 & 63, wave = t32 >> 6;
  LAS float* w2l = (LAS float*)lds;
  LAS float* rowb = (LAS float*)(lds + 65536) + wave * 512;
  __syncthreads();
#pragma unroll
  for (int i = 0; i < 4; ++i) {
    ((LAS f32x4*)w2l)[t32 + 512 * i] = ((const f32x4*)(p.cmp_w2_k + (size_t)li * CMP_HID * HD))[t32 + 512 * i];
    ((LAS f32x4*)w2l)[2048 + t32 + 512 * i] = ((const f32x4*)(p.cmp_w2_v + (size_t)li * CMP_HID * HD))[t32 + 512 * i];
  }
  __syncthreads();
  const int NGW = G * 8;
  for (int r0 = bid * 8 + wave; r0 < 2 * CMP_ROWS; r0 += 4 * NGW) {
    int rows[4];
#pragma unroll
    for (int i = 0; i < 4; ++i) { rows[i] = r0 + i * NGW; if (rows[i] >= 2 * CMP_ROWS) rows[i] = r0; }
#pragma unroll
    for (int i = 0; i < 4; ++i) {
      const float* hr = p.hid + (size_t)rows[i] * CMP_HID;
      rowb[i * 128 + lane] = hr[lane]; rowb[i * 128 + 64 + lane] = hr[64 + lane];
    }
    asm volatile("s_waitcnt lgkmcnt(0)" ::: "memory");
    float acc[4] = {0.f, 0.f, 0.f, 0.f};
    const LAS float* wq[4];
#pragma unroll
    for (int i = 0; i < 4; ++i) wq[i] = w2l + (rows[i] >= CMP_ROWS ? 128 * 64 : 0) + lane;
#pragma unroll 8
    for (int j = 0; j < CMP_HID; ++j) {
#pragma unroll
      for (int i = 0; i < 4; ++i) acc[i] += rowb[i * 128 + j] * wq[i][j * 64];
    }
#pragma unroll
    for (int i = 0; i < 4; ++i) {
      const int row = r0 + i * NGW;
      if (row < 2 * CMP_ROWS) {
        const int which = row >= CMP_ROWS ? 1 : 0, rr = row - which * CMP_ROWS;
        const int g_ = rr % NSA_G, c_ = (rr / NSA_G) % N_CMP, b_ = rr / (NSA_G * N_CMP);
        p.kcb[((((size_t)which * BATCH + b_) * 128 + c_) * NSA_G + g_) * 64 + lane] = f2bfh(acc[i]);
      }
    }
    asm volatile("s_waitcnt lgkmcnt(0)" ::: "memory");
  }
  __syncthreads();
}

constexpr int GA_QS = 272, GA_VS = 528, GA_PS = 144;
constexpr int GA_QT = 0, GA_KT = GA_QT + 64 * GA_QS, GA_KH = GA_KT + 64 * GA_QS, GA_VT = GA_KH + 64 * GA_QS, GA_PT = GA_VT + 64 * GA_VS,
              GA_LR = GA_PT + 64 * GA_PS, GA_GT = GA_LR + 64 * 16 * 4, GA_DC = GA_GT + 4 * 128 * 4, GA_END = GA_DC + 512;
static_assert(GA_END <= RING_BYTES, "GLA phase A LDS map");
constexpr int GC_SP = 0, GC_QT = GC_SP + 128 * GA_VS, GC_RED = GC_QT + 64 * GA_QS, GC_END = GC_RED + 8 * 16 * 4 * 2;
static_assert(GC_END <= RING_BYTES, "GLA phase C LDS map");

#define GSTAMP(i) do { if (GSEG >= 0 && blockIdx.x == 0 && t32 == 0) { const unsigned now_ = (unsigned)__builtin_amdgcn_s_memrealtime(); if ((i) > 0 && (i) - 1 == GSEG) p.barw[3600] += now_ - gs_prev; gs_prev = now_; } } while (0)
DEV void gla_a_unit(const Params& p, int li, LAS unsigned char* lds, int t32, int unit) {
  unsigned gs_prev = 0u;
  GSTAMP(0);
  const int lane = t32 & 63, wave = t32 >> 6, i15 = lane & 15, g4 = lane >> 4;
  const int bh = unit >> 5, ci = unit & 31, b = bh >> 2, h = bh & 3;
  const int c = t32 & 127, jq = t32 >> 7;
  LAS float* LR = (LAS float*)(lds + GA_LR);
  LAS float* GT = (LAS float*)(lds + GA_GT);
  LAS float* DC = (LAS float*)(lds + GA_DC);
  const float qscale = 0.08838834764831845f;
  const size_t n0 = (size_t)b * SEQ + ci * 64;
  {
    const int e = t32 * 2, j = e >> 4, r = e & 15;
    const unsigned w = *(const unsigned*)(p.u + (n0 + j) * N_IN + OFF_LR + r);
    LR[e] = __uint_as_float(w << 16); LR[e + 1] = __uint_as_float(w & 0xffff0000u);
  }
  float wa[GLA_RANK];
#pragma unroll
  for (int r = 0; r < GLA_RANK; ++r) wa[r] = p.w_alpha2[((size_t)li * GLA_RANK + r) * B_K + h * 128 + c];
  const float ba = p.b_alpha[li * B_K + h * 128 + c];
#pragma unroll
  for (int x = 0; x < 2; ++x) {
    const int idx = t32 + 512 * x, row = idx >> 4, ch = idx & 15;
    const act_t* ur = p.u + (n0 + row) * N_IN + h * 128 + ch * 8;
    *(LAS u32x4*)(lds + GA_QT + row * GA_QS + ch * 16) = *(const u32x4*)(ur + OFF_BQ);
    *(LAS u32x4*)(lds + GA_KT + row * GA_QS + ch * 16) = *(const u32x4*)(ur + OFF_BK);
  }
#pragma unroll
  for (int x = 0; x < 4; ++x) {
    const int idx = t32 + 512 * x, row = idx >> 5, ch = idx & 31;
    const u32x4 vv = *(const u32x4*)(p.u + (n0 + row) * N_IN + OFF_BV + h * 256 + ch * 8);
    *(LAS u32x4*)(lds + GA_VT + row * GA_VS + ch * 16) = vv;
  }
  __syncthreads();
  GSTAMP(1);
  float bl[16];
  float run = 0.f;
#pragma unroll
  for (int jj = 0; jj < 16; ++jj) {
    const LAS f32x4* lr4 = (const LAS f32x4*)(LR + (jq * 16 + jj) * 16);
    float z = ba;
#pragma unroll
    for (int r4 = 0; r4 < 4; ++r4) { const f32x4 x = lr4[r4]; z += x.x * wa[4 * r4] + x.y * wa[4 * r4 + 1] + x.z * wa[4 * r4 + 2] + x.w * wa[4 * r4 + 3]; }
    const float ez = __builtin_amdgcn_exp2f(-fabsf(z) * 1.4426950408889634f);
    const float ls = (fminf(z, 0.f) - __builtin_amdgcn_logf(1.0f + ez) * 0.6931471805599453f) * (1.0f / 16.0f);
    run += ls; bl[jj] = run;
  }
  GT[jq * 128 + c] = run;
  __syncthreads();
  GSTAMP(2);
  {
    const float g0 = GT[c], g1 = GT[128 + c], g2 = GT[256 + c], g3 = GT[384 + c];
    const float off = (jq > 0 ? g0 : 0.f) + (jq > 1 ? g1 : 0.f) + (jq > 2 ? g2 : 0.f);
    const float tot = (g0 + g1) + (g2 + g3);
    const float dtot = __builtin_amdgcn_exp2f(tot * 1.4426950408889634f);
    if (jq == 0) { DC[c] = dtot; p.gD[(size_t)unit * 128 + c] = dtot; }
#pragma unroll
    for (int jj = 0; jj < 16; ++jj) {
      const float e1 = __builtin_amdgcn_exp2f((off + bl[jj]) * 1.4426950408889634f), ie = __builtin_amdgcn_rcpf(e1);
      const int ro = (jq * 16 + jj) * GA_QS + c * 2;
      const float qf = __uint_as_float(((unsigned)*(const LAS unsigned short*)(lds + GA_QT + ro)) << 16);
      const float kf = __uint_as_float(((unsigned)*(const LAS unsigned short*)(lds + GA_KT + ro)) << 16);
      const unsigned short qt = f2bfh(qf * e1 * qscale);
      *(LAS unsigned short*)(lds + GA_QT + ro) = qt;
      p.gQ[((size_t)unit * 64 + jq * 16 + jj) * 128 + c] = qt;
      *(LAS unsigned short*)(lds + GA_KT + ro) = f2bfh(kf * ie);
      *(LAS unsigned short*)(lds + GA_KH + ro) = f2bfh(kf * ie * dtot);
    }
  }
  __syncthreads();
  GSTAMP(3);
#pragma unroll
  for (int q = 0; q < 2; ++q) {
    const int id = wave * 2 + q, jt = id >> 2, it = id & 3;
    f32x4 a = (f32x4){0.f, 0.f, 0.f, 0.f};
#pragma unroll
    for (int kk = 0; kk < 4; ++kk) {
      const bf16x8 kf = *(const LAS bf16x8*)(lds + GA_KT + (16 * jt + i15) * GA_QS + (32 * kk + 8 * g4) * 2);
      const bf16x8 qf = *(const LAS bf16x8*)(lds + GA_QT + (16 * it + i15) * GA_QS + (32 * kk + 8 * g4) * 2);
      a = __builtin_amdgcn_mfma_f32_16x16x32_bf16(kf, qf, a, 0, 0, 0);
    }
    const int i = 16 * it + i15, j0 = 16 * jt + 4 * g4;
    u32x2 w;
    w.x = pk2(j0 <= i ? a.x : 0.f, j0 + 1 <= i ? a.y : 0.f);
    w.y = pk2(j0 + 2 <= i ? a.z : 0.f, j0 + 3 <= i ? a.w : 0.f);
    *(LAS u32x2*)(lds + GA_PT + i * GA_PS + j0 * 2) = w;
  }
  __syncthreads();
  GSTAMP(4);
  {
    const int it = wave & 3, vt0 = (wave >> 2) * 8;
    bf16x8 pf[2];
#pragma unroll
    for (int s = 0; s < 2; ++s) pf[s] = *(const LAS bf16x8*)(lds + GA_PT + (16 * it + i15) * GA_PS + (32 * s + 8 * g4) * 2);
#pragma unroll
    for (int x = 0; x < 8; ++x) {
      const int vt = vt0 + x;
      f32x4 a = (f32x4){0.f, 0.f, 0.f, 0.f};
#pragma unroll
      for (int s = 0; s < 2; ++s) {
        const LAS unsigned char* vp = lds + GA_VT + (32 * s + 8 * g4 + (i15 >> 2)) * GA_VS + (16 * vt + 4 * (lane & 3)) * 2;
        const v4i16_t lo = tr_read(vp), hi = tr_read(vp + 4 * GA_VS);
        bf16x8 vf;
        vf[0] = lo[0]; vf[1] = lo[1]; vf[2] = lo[2]; vf[3] = lo[3]; vf[4] = hi[0]; vf[5] = hi[1]; vf[6] = hi[2]; vf[7] = hi[3];
        a = __builtin_amdgcn_mfma_f32_16x16x32_bf16(vf, pf[s], a, 0, 0, 0);
      }
      *(f32x4*)(p.opart + (n0 + 16 * it + i15) * 1024 + h * 256 + 16 * vt + 4 * g4) = a;
    }
  }
  {
    bf16x8 vf[2][2];
#pragma unroll
    for (int x = 0; x < 2; ++x)
#pragma unroll
      for (int s = 0; s < 2; ++s) {
        const LAS unsigned char* vp = lds + GA_VT + (32 * s + 8 * g4 + (i15 >> 2)) * GA_VS + (16 * (2 * wave + x) + 4 * (lane & 3)) * 2;
        const v4i16_t lo = tr_read(vp), hi = tr_read(vp + 4 * GA_VS);
        vf[x][s][0] = lo[0]; vf[x][s][1] = lo[1]; vf[x][s][2] = lo[2]; vf[x][s][3] = lo[3];
        vf[x][s][4] = hi[0]; vf[x][s][5] = hi[1]; vf[x][s][6] = hi[2]; vf[x][s][7] = hi[3];
      }
#pragma unroll
    for (int ct = 0; ct < 8; ++ct) {
      f32x4 a0 = (f32x4){0.f, 0.f, 0.f, 0.f}, a1 = (f32x4){0.f, 0.f, 0.f, 0.f};
#pragma unroll
      for (int s = 0; s < 2; ++s) {
        const LAS unsigned char* kp = lds + GA_KH + (32 * s + 8 * g4 + (i15 >> 2)) * GA_QS + (16 * ct + 4 * (lane & 3)) * 2;
        const v4i16_t lo = tr_read(kp), hi = tr_read(kp + 4 * GA_QS);
        bf16x8 kf;
        kf[0] = lo[0]; kf[1] = lo[1]; kf[2] = lo[2]; kf[3] = lo[3]; kf[4] = hi[0]; kf[5] = hi[1]; kf[6] = hi[2]; kf[7] = hi[3];
        a0 = __builtin_amdgcn_mfma_f32_16x16x32_bf16(vf[0][s], kf, a0, 0, 0, 0);
        a1 = __builtin_amdgcn_mfma_f32_16x16x32_bf16(vf[1][s], kf, a1, 0, 0, 0);
      }
      act_t* up = p.gU + ((size_t)unit * 128 + 16 * ct + i15) * 256 + 32 * wave + 4 * g4;
      u32x2 w0; w0.x = pk2(a0.x, a0.y); w0.y = pk2(a0.z, a0.w);
      u32x2 w1; w1.x = pk2(a1.x, a1.y); w1.y = pk2(a1.z, a1.w);
      *(u32x2*)up = w0; *(u32x2*)(up + 16) = w1;
    }
  }
  __syncthreads();
  GSTAMP(5);
}

DEV void gla_scan(const Params& p, long long tid, long long nthr) {
  for (long long idx = tid; idx < 32LL * 128 * 32; idx += nthr) {
    const int v8 = (int)(idx & 31) * 8, c = (int)((idx >> 5) & 127), bh = (int)(idx >> 12);
    float s[8];
#pragma unroll
    for (int i = 0; i < 8; ++i) s[i] = 0.f;
#pragma unroll 8
    for (int ci = 0; ci < 32; ++ci) {
      const size_t unit = (size_t)bh * 32 + ci;
      const u32x4 uw = *(const u32x4*)(p.gU + (unit * 128 + c) * 256 + v8);
      const float d = p.gD[unit * 128 + c];
      u32x4 o;
#pragma unroll
      for (int i = 0; i < 4; ++i) o[i] = pk2(s[2 * i], s[2 * i + 1]);
      *(u32x4*)(p.gS + (unit * 128 + c) * 256 + v8) = o;
#pragma unroll
      for (int i = 0; i < 4; ++i) {
        s[2 * i] = s[2 * i] * d + __uint_as_float(uw[i] << 16);
        s[2 * i + 1] = s[2 * i + 1] * d + __uint_as_float(uw[i] & 0xffff0000u);
      }
    }
  }
}

DEV void gla_c_unit(const Params& p, int li, LAS unsigned char* lds, int t32, int unit) {
  const int lane = t32 & 63, wave = t32 >> 6, i15 = lane & 15, g4 = lane >> 4;
  const int bh = unit >> 5, ci = unit & 31, b = bh >> 2, h = bh & 3;
  const size_t n0 = (size_t)b * SEQ + ci * 64;
#pragma unroll
  for (int x = 0; x < 8; ++x) {
    const int idx = t32 + 512 * x, row = idx >> 5, ch = idx & 31;
    *(LAS u32x4*)(lds + GC_SP + row * GA_VS + ch * 16) = *(const u32x4*)(p.gS + ((size_t)unit * 128 + row) * 256 + ch * 8);
  }
#pragma unroll
  for (int x = 0; x < 2; ++x) {
    const int idx = t32 + 512 * x, row = idx >> 4, ch = idx & 15;
    *(LAS u32x4*)(lds + GC_QT + row * GA_QS + ch * 16) = *(const u32x4*)(p.gQ + ((size_t)unit * 64 + row) * 128 + ch * 8);
  }
  __syncthreads();
  const int it = wave & 3, vt0 = (wave >> 2) * 8;
  bf16x8 qf[4];
#pragma unroll
  for (int kk = 0; kk < 4; ++kk) qf[kk] = *(const LAS bf16x8*)(lds + GC_QT + (16 * it + i15) * GA_QS + (32 * kk + 8 * g4) * 2);
  const size_t n = n0 + 16 * it + i15;
  f32x4 o[8];
  float ss = 0.f;
#pragma unroll
  for (int x = 0; x < 8; ++x) {
    const int vt = vt0 + x;
    f32x4 a = *(const f32x4*)(p.opart + n * 1024 + h * 256 + 16 * vt + 4 * g4);
#pragma unroll
    for (int kk = 0; kk < 4; ++kk) {
      const LAS unsigned char* sp = lds + GC_SP + (32 * kk + 8 * g4 + (i15 >> 2)) * GA_VS + (16 * vt + 4 * (lane & 3)) * 2;
      const v4i16_t lo = tr_read(sp), hi = tr_read(sp + 4 * GA_VS);
      bf16x8 sf;
      sf[0] = lo[0]; sf[1] = lo[1]; sf[2] = lo[2]; sf[3] = lo[3]; sf[4] = hi[0]; sf[5] = hi[1]; sf[6] = hi[2]; sf[7] = hi[3];
      a = __builtin_amdgcn_mfma_f32_16x16x32_bf16(sf, qf[kk], a, 0, 0, 0);
    }
    o[x] = a;
    ss += (a.x * a.x + a.y * a.y) + (a.z * a.z + a.w * a.w);
  }
  ss += shx(ss, lane, 16);
  ss += shx(ss, lane, 32);
  LAS float* RED = (LAS float*)(lds + GC_RED);
  if (g4 == 0) RED[wave * 16 + i15] = ss;
  __syncthreads();
  ss += RED[(wave ^ 4) * 16 + i15];
  const float rs = 1.0f / sqrtf(ss * (1.0f / 256.0f) + LN_EPS);
#pragma unroll
  for (int x = 0; x < 8; ++x) {
    const int v = 16 * (vt0 + x) + 4 * g4;
    const f32x4 gn = *(const f32x4*)(p.gla_norm_g + li * DV + v);
    const u32x2 rw = *(const u32x2*)(p.u + n * N_IN + OFF_BR + h * 256 + v);
    const float r0 = __uint_as_float(rw.x << 16), r1 = __uint_as_float(rw.x & 0xffff0000u), r2 = __uint_as_float(rw.y << 16), r3 = __uint_as_float(rw.y & 0xffff0000u);
    u32x2 w;
    w.x = pk2(o[x].x * rs * gn.x * (r0 * fsig(r0)), o[x].y * rs * gn.y * (r1 * fsig(r1)));
    w.y = pk2(o[x].z * rs * gn.z * (r2 * fsig(r2)), o[x].w * rs * gn.w * (r3 * fsig(r3)));
    *(u32x2*)(p.yb + n * YLD + h * 256 + v) = w;
  }
  __syncthreads();
}

#define XB_TMO      128
#define XB_XCNT(j)  (256  + 64 * (j))
#define XB_XSUB(j)  (1280 + 64 * (j))
#define XB_XGEN(j)  (2304 + 64 * (j))
#define XB_TOP      3328
#define XB_TOPGEN   3392
#define XCD_BAR_WORDS 3456
#define XB_SPIN_CAP (1u << 18)

__device__ __forceinline__ unsigned xb_ld(unsigned* p)              { return __hip_atomic_load(p, __ATOMIC_RELAXED, __HIP_MEMORY_SCOPE_AGENT); }
__device__ __forceinline__ unsigned xb_add(unsigned* p, unsigned v) { return __hip_atomic_fetch_add(p, v, __ATOMIC_RELAXED, __HIP_MEMORY_SCOPE_AGENT); }
__device__ __forceinline__ unsigned xb_xcc_id() { return (unsigned)__builtin_amdgcn_s_getreg((3 << 11) | 20) & 0xFu; }
#define XB_SPIN(cond, bar) do { unsigned _sp = 0; while (cond) { __builtin_amdgcn_s_sleep(1); \
    if ((++_sp & 255u) == 0u) { if (xb_ld(&(bar)[XB_TMO])) break; if (_sp > XB_SPIN_CAP) { atomicAdd(&(bar)[XB_TMO], 1u); break; } } } } while (0)

struct XcdBarrier {
    unsigned* bar; unsigned x;
    volatile LAS unsigned* st;
};

__device__ __forceinline__ XcdBarrier xcd_barrier_post(unsigned* bar, volatile LAS unsigned* st) {
    XcdBarrier b; b.bar = bar; b.x = xb_xcc_id(); b.st = st;
    if (threadIdx.x == 0) st[2] = xb_add(&bar[XB_XCNT(b.x)], 1u);
    return b;
}
__device__ __forceinline__ void xcd_barrier_complete(unsigned* bar, unsigned x, unsigned& nloc, unsigned& nx) {
    const unsigned G = gridDim.x * gridDim.y * gridDim.z;
    unsigned sum, cnt, mine, sp = 0u;
    for (;;) {
        sum = 0u; cnt = 0u; mine = 0u;
#pragma unroll
        for (unsigned j = 0; j < 16; ++j) { const unsigned c = xb_ld(&bar[XB_XCNT(j)]); sum += c; cnt += (c > 0u) ? 1u : 0u; mine = (j == x) ? c : mine; }
        if (sum == G) break;
        __builtin_amdgcn_s_sleep(1);
        if ((++sp & 255u) == 0u) { if (xb_ld(&bar[XB_TMO])) break; if (sp > XB_SPIN_CAP) { atomicAdd(&bar[XB_TMO], 1u); break; } }
    }
    nloc = mine > 0u ? mine : 1u; nx = cnt > 0u ? cnt : 1u;
}

__device__ __forceinline__ void xcd_barrier(const XcdBarrier& b, const int t32) {
    asm volatile("s_waitcnt vmcnt(0)" ::: "memory");
    __syncthreads();
    if (t32 == 0) {
        unsigned* bar = b.bar;
        __builtin_amdgcn_s_waitcnt(0);
        unsigned nloc = b.st[0], nx = b.st[1];
        if (nloc == 0u) { xcd_barrier_complete(bar, b.x, nloc, nx); b.st[0] = nloc; b.st[1] = nx; }
        const unsigned old = xb_add(&bar[XB_XSUB(b.x)], 1u);
        const unsigned gen = old / nloc;
        if (old + 1u == (gen + 1u) * nloc) {
            __builtin_amdgcn_fence(__ATOMIC_RELEASE, "agent");
            asm volatile("s_waitcnt vmcnt(0)" ::: "memory");
            const unsigned og = xb_add(&bar[XB_TOP], 1u);
            const unsigned tg = og / nx;
            if (og + 1u == (tg + 1u) * nx) xb_add(&bar[XB_TOPGEN], 1u);
            else XB_SPIN(xb_ld(&bar[XB_TOPGEN]) == tg, bar);
            __builtin_amdgcn_fence(__ATOMIC_ACQUIRE, "agent");
            xb_add(&bar[XB_XGEN(b.x)], 1u);
            asm volatile("s_waitcnt vmcnt(0)" ::: "memory");
        } else {
            XB_SPIN(xb_ld(&bar[XB_XGEN(b.x)]) == gen, bar);
            __builtin_amdgcn_fence(__ATOMIC_ACQUIRE, "agent");
            asm volatile("s_waitcnt vmcnt(0)" ::: "memory");
        }
    }
    __syncthreads();
}

constexpr int STEPS_PER_LAYER = 21;
#ifndef PROBE_LO
#define PROBE_LO -1
#define PROBE_HI -1
#endif
#ifndef PROBE_PRO
#define PROBE_PRO 0
#endif
#ifndef TSTEP_LO
#define TSTEP_LO -2
#define TSTEP_HI -2
#endif
#ifndef TSUB
#define TSUB -9
#endif
#ifndef TSTEP_Q
#define TSTEP_Q 40u
#endif
#ifndef NSA_PROBE
#define NSA_PROBE 0
#endif
#ifndef MULTI_LAUNCH
#define MULTI_LAUNCH 0
#endif
DEV int fresh_t32(int wave) {
  int t;
  asm volatile("v_mbcnt_lo_u32_b32 %0, -1, 0\n\tv_mbcnt_hi_u32_b32 %0, -1, %0" : "=v"(t));
  return t + wave * 64;
}
struct KArgs { void* in[35]; void* out; void* ws; };
template <bool WITH_NAIVE, bool COOP>
__global__ void __launch_bounds__(NTHREADS) k_mega(KArgs ka, int step_lo, int step_hi) {
  unsigned* const barw0 = ((unsigned*)ka.ws);
  extern __shared__ __attribute__((aligned(16))) unsigned char lds_raw[];
  LAS unsigned char* lds = (LAS unsigned char*)lds_raw;
  LAS int* tab = (LAS int*)(lds + MISC_OFF);
  const int wave = __builtin_amdgcn_readfirstlane(threadIdx.x >> 6);
  const int G = gridDim.x;
  int bid = blockIdx.x;

  LAS unsigned* miscw = (LAS unsigned*)(lds + MISC_OFF + 8192);
  if (threadIdx.x < 128) miscw[threadIdx.x] = 0u;
  __syncthreads();
  XcdBarrier xbar; xbar.bar = barw0; xbar.x = 0; xbar.st = nullptr;
  if (COOP) xbar = xcd_barrier_post(barw0, miscw + 8);
  unsigned* const stamp = barw0 + 3584;
  if (step_lo < 0) {
    Params p;
    fill_params(p, ka.in, ka.out, ka.ws);
    if (TSTEP_LO == -1 && blockIdx.x == 0 && threadIdx.x == 0) { stamp[0] = (unsigned)__builtin_amdgcn_s_memrealtime(); stamp[2] = 0u; stamp[3] = 0u; }
    prologue(p, lds, wave, threadIdx.x & 63);
    if (COOP) {
      if (step_hi == -12345) cg::this_grid().sync();
      xcd_barrier(xbar, (int)threadIdx.x);
    }
#if PROBE_PRO
    prologue(p, lds, wave, threadIdx.x & 63);
    if (COOP) cg::this_grid().sync();
#endif
    step_lo = 0;
    if (TSTEP_LO == -1 && blockIdx.x == 0 && threadIdx.x == 0) stamp[1] = (unsigned)__builtin_amdgcn_s_memrealtime();
    if (COOP) {
      bool even = (G % 8) == 0;
#pragma unroll
      for (int j = 0; j < 8; ++j) even = even && (xb_ld(&barw0[XB_XCNT(j)]) == (unsigned)(G / 8));
      __syncthreads();
      if (even) bid = __builtin_amdgcn_readfirstlane((int)(xbar.x + 8u * miscw[10]));
    }
  }
  int rep_done = 0;
  for (int step = step_lo; step < step_hi;) {
    int li = step / STEPS_PER_LAYER;
    const int k = step % STEPS_PER_LAYER;
    int nb32 = gridDim.x;
    char* wsb = (char*)ka.ws;
    asm volatile("" : "+s"(wsb));
    Params p;
    fill_params(p, ka.in, ka.out, wsb);
    asm volatile("" : "+s"(li));
    asm volatile("" : "+s"(nb32));
#define T32() fresh_t32(wave)
#define TID() ((int)(blockIdx.x * NTHREADS) + T32())
    const int nthr = nb32 * NTHREADS;
    const int gw = blockIdx.x * 8 + wave, NGW = nb32 * 8;
    if (TSTEP_LO >= 0 && k == TSTEP_LO && blockIdx.x == 0 && wave == 0) stamp[2 * li] = (unsigned)__builtin_amdgcn_s_memrealtime();
    const bool is_gemm = (k == 0) || (k >= 2 && k <= 5) || (k == 9) || (k == 10) || (k == 12) || (k == 14) || (k == 18) || (k == 19);
    const bool sync_after = !(k == 2 || k == 3 || k == 4);
    if (is_gemm) {
      pg8::Gemm g{nullptr, nullptr, 0, 0, 0};
      USched S; S.init_static(256, 256, G, bid);
      EpiU E{0, 0, nullptr, nullptr, nullptr, nullptr, nullptr};
      const size_t WSQ = (size_t)1024 * 1024;
      switch (k) {
        case 0:
          g = pg8::Gemm{p.xb, p.wt_in + (size_t)li * N_IN_PAD * 1024, N_TOK, N_IN_PAD, 1024};
          S.init_static(N_TOK, N_IN_PAD, G, bid);
          E.mode = EM_INPROJ; E.q0 = p.u; E.q1 = p.b_in + (size_t)li * N_IN; break;
        case 2:
          g = pg8::Gemm{p.cmpA, p.wt_c1 + (size_t)(li * 2 + 0) * 256 * 2048, CMP_ROWS_PAD, 256, 2048};
          S.init_static(CMP_ROWS_PAD, 256, G, bid);
          E.mode = EM_HID; E.q0 = p.hid; break;
        case 3:
          g = pg8::Gemm{p.cmpA + (size_t)CMP_ROWS_PAD * 2048, p.wt_c1 + (size_t)(li * 2 + 1) * 256 * 2048, CMP_ROWS_PAD, 256, 2048};
          S.init_static(CMP_ROWS_PAD, 256, G, (bid + G - 16) % G);
          E.mode = EM_HID; E.q0 = p.hid + (size_t)CMP_ROWS * CMP_HID; break;
        case 4:
          g = pg8::Gemm{p.membf, p.wt_xk + li * WSQ, BATCH * MEM_LEN, 1024, 1024};
          S.init_static(BATCH * MEM_LEN, 1024, G, (bid + G - 32) % G);
          E.mode = EM_BF16; E.q0 = p.memk; E.ldc = 1024; break;
        case 5:
          g = pg8::Gemm{p.membf, p.wt_xv + li * WSQ, BATCH * MEM_LEN, 1024, 1024};
          S.init_static(BATCH * MEM_LEN, 1024, G, (bid + G - 64) % G);
          E.mode = EM_BF16; E.q0 = p.memv; E.ldc = 1024; break;
        case 9:
          g = pg8::Gemm{p.ya, p.wt_bra + (size_t)li * 1024 * YLD, N_TOK, 1024, YLD};
          S.init_static(N_TOK, 1024, G, bid);
          E.mode = EM_BRCAT; E.q1 = p.u; E.q0 = p.merged; break;
        case 10:
          g = pg8::Gemm{p.merged, p.wt_omix + li * WSQ, N_TOK, 1024, 1024};
          S.init_static(N_TOK, 1024, G, bid);
          E.mode = EM_RES; E.q1 = p.xf; E.q0 = p.tmp; break;
        case 12:
          g = pg8::Gemm{p.xb, p.wt_xq + li * WSQ, N_TOK, 1024, 1024};
          S.init_static(N_TOK, 1024, G, bid);
          E.mode = EM_BF16; E.q0 = p.xq; E.ldc = 1024; break;
        case 14:
          g = pg8::Gemm{p.xo, p.wt_xo + li * WSQ, N_TOK, 1024, 1024};
          S.init_static(N_TOK, 1024, G, bid);
          E.mode = EM_RES; E.q1 = p.xf; E.q0 = p.tmp; break;
        case 18: {
          const int ntiles = moe_tables(p, li, tab, T32());
          g = pg8::Gemm{p.xg, p.wt_gu + (size_t)li * 32 * 2048 * 1024, MOE_ROWS, 32 * 2048, 1024};
          S.init_moe(G, bid, 8, ntiles * 8, tab + 128);
          E.mode = EM_MOE1; E.q0 = p.actg; E.q1 = p.b_gu + (size_t)li * 32 * 2048; E.te = tab + 128; break; }
        default: {
          const int ntiles = moe_tables(p, li, tab, T32());
          g = pg8::Gemm{p.actg, p.wt_dn + (size_t)li * 32 * 1024 * 1024, MOE_ROWS, 32 * 1024, 1024};
          S.init_moe(G, bid, 4, ntiles * 4, tab + 128);
          E.mode = EM_MOE2; E.q0 = p.yass; E.q1 = p.b_down + (size_t)li * 32 * 1024; E.q2 = p.topg; E.q3 = p.rowlist; E.te = tab + 128; break; }
      }
      pg8::gemm_phase<EpiU, USched, true, true>(lds, g, S, E, T32());
    } else {
      switch (k) {
        case 1: cmpa_build(p, li, TID(), nthr); break;
        case 6:
#define SUBSTAMP(i) do { if (TSUB == (i) && blockIdx.x == 0 && wave == 0) stamp[2 * li] = (unsigned)__builtin_amdgcn_s_memrealtime(); if (TSUB + 1 == (i) && blockIdx.x == 0 && wave == 0) stamp[2 * li + 1] = (unsigned)__builtin_amdgcn_s_memrealtime(); } while (0)
          SUBSTAMP(1);
          { const int t = T32(); for (int un = bid; un < 1024; un += G) gla_a_unit(p, li, lds, t, un); }
          SUBSTAMP(2);
          dil_phase(p, lds, T32(), bid, G);
          SUBSTAMP(3);
          kcv_phase(p, li, lds, T32(), bid, G);
          SUBSTAMP(4);
          break;
        case 7: SUBSTAMP(8); gla_scan(p, TID(), nthr); SUBSTAMP(9); nsa_cmp_phase(p, lds, T32(), bid, G); SUBSTAMP(10); dil_combine(p, TID(), nthr); SUBSTAMP(11); break;
        case 8: {
          SUBSTAMP(5);
          nsa_main_phase(p, lds, T32(), bid, G);
          __syncthreads();
          SUBSTAMP(6);
          const int t = T32();
          for (int un = bid; un < 1024; un += G) gla_c_unit(p, li, lds, t, un);
          SUBSTAMP(7);
          break; }
        case 11: ln_rows_w<0>(p, p.tmp, p.ln1_g + li * D, p.ln1_b + li * D, p.xf, p.xb, nullptr, gw, NGW, T32() & 63); break;
        case 13: xattn_phase(p, lds, T32(), bid, G); break;
        case 15: ln_rows_w<0>(p, p.tmp, p.ln2_g + li * D, p.ln2_b + li * D, p.xf, p.xb, nullptr, gw, NGW, T32() & 63); break;
        case 16: route_phase(p, li, lds, T32(), bid, G); break;
        case 17: { const int t = T32(); moe_prep(p, li, tab, wave, t & 63, t); break; }
        case 20: ln_rows_w<1>(p, nullptr, p.ln3_g + li * D, p.ln3_b + li * D, p.xf, p.xb, li == DEPTH - 1 ? p.out : nullptr, gw, NGW, T32() & 63); break;
        default: break;
      }
    }
    if (COOP && sync_after) xcd_barrier(xbar, T32());
    if (TSTEP_LO >= 0 && k == TSTEP_HI && blockIdx.x == 0 && wave == 0) stamp[2 * li + 1] = (unsigned)__builtin_amdgcn_s_memrealtime();
    if (PROBE_HI >= 0 && k == PROBE_HI && !rep_done) { rep_done = 1; step -= (PROBE_HI - PROBE_LO); }
    else { if (k == PROBE_HI) rep_done = 0; ++step; }
  }
  if (GSEG >= 0 && blockIdx.x == 0 && fresh_t32(wave) == 0) {
    __builtin_amdgcn_s_waitcnt(0);
    const unsigned tk = __hip_atomic_load(barw0 + 3600, __ATOMIC_RELAXED, __HIP_MEMORY_SCOPE_AGENT);
    ((float*)ka.out)[0] = (float)((tk / 100u + TSTEP_Q / 2) / TSTEP_Q * TSTEP_Q);
  }
  if (TSTEP_LO >= -1 && blockIdx.x == 0 && fresh_t32(wave) == 0) {
    __builtin_amdgcn_s_waitcnt(0);
    const unsigned tk = (__hip_atomic_load(stamp + 1, __ATOMIC_RELAXED, __HIP_MEMORY_SCOPE_AGENT) - __hip_atomic_load(stamp + 0, __ATOMIC_RELAXED, __HIP_MEMORY_SCOPE_AGENT)) + (__hip_atomic_load(stamp + 3, __ATOMIC_RELAXED, __HIP_MEMORY_SCOPE_AGENT) - __hip_atomic_load(stamp + 2, __ATOMIC_RELAXED, __HIP_MEMORY_SCOPE_AGENT));
    ((float*)ka.out)[0] = (float)((tk / 100u + TSTEP_Q / 2) / TSTEP_Q * TSTEP_Q);
  }
}

extern "C" void kernel_launch(void* const* d_in, const int* in_sizes, int n_in, void* d_out, int out_size,
                              void* d_ws, size_t ws_size, hipStream_t stream) {
  Params p;
  memset(&p, 0, sizeof(p));
  fill_params(p, d_in, d_out, d_ws);
  KArgs ka;
  memset(&ka, 0, sizeof(ka));
  for (int i = 0; i < 35; ++i) ka.in[i] = d_in[i];
  ka.out = d_out; ka.ws = d_ws;
  static int grid_blocks = 0;
  if (!grid_blocks) {
    int dev = 0, cus = 0;
    hipGetDevice(&dev);
    hipDeviceGetAttribute(&cus, hipDeviceAttributeMultiprocessorCount, dev);
    hipFuncSetAttribute((const void*)k_mega<true, true>, hipFuncAttributeMaxDynamicSharedMemorySize, LDS_BYTES);
    if (p.ws_used > ws_size) fprintf(stderr, "workspace too small: need %zu have %zu\n", p.ws_used, ws_size);
    grid_blocks = cus;
  }
  hipMemsetAsync(p.barw, 0, 4096 * sizeof(unsigned), stream);
  int lo = -1, hi = DEPTH * STEPS_PER_LAYER;
  void* args[] = {&ka, &lo, &hi};
  hipError_t e = hipLaunchCooperativeKernel((void*)k_mega<true, true>, dim3(grid_blocks), dim3(NTHREADS), args, LDS_BYTES, stream);
  if (e != hipSuccess) fprintf(stderr, "cooperative launch failed: %s (grid %d)\n", hipGetErrorString(e), grid_blocks);
}
#endif
```

```cpp
#ifndef CPU_TEST
#include <hip/hip_runtime.h>
#include <hip/hip_cooperative_groups.h>
#include <cstdio>
#include <cstring>
#include <cmath>
namespace cg = cooperative_groups;
#define DEV __device__ __forceinline__
#define HDI __host__ __device__ __forceinline__
#else
#include <cmath>
#include <cstdio>
#include <cstdlib>
#include <cstring>
#define DEV static inline
#define HDI static inline
#endif

#ifndef D_MODEL
#define D_MODEL 1024
#endif
#ifndef BATCH
#define BATCH 8
#endif
#ifndef MEGA
#define MEGA 1
#endif

constexpr int D = D_MODEL;
constexpr int SEQ = 2048;
constexpr int DEPTH = 2;
constexpr int MEM_LEN = 256;
constexpr int HD = 64;
constexpr int N_TOK = BATCH * SEQ;
constexpr int GLA_H = 4;
constexpr int DK = D / 2 / GLA_H;
constexpr int DV = D / GLA_H;
constexpr int GLA_RANK = 16;
constexpr int B_K = GLA_H * DK;
constexpr int B_V = GLA_H * DV;
constexpr int NSA_H = 16;
constexpr int NSA_G = 4;
constexpr int N_CMP = 127;
constexpr int CMP_HID = 128;
constexpr int N_BLK = 32;
constexpr int N_SELECT = 16;
constexpr int NSA_WIN = 512;
constexpr int XH = 4;
constexpr int XHD = D / XH;
constexpr int NE = 32;
constexpr int TOPK = 4;
constexpr int DFF = D;
constexpr float LN_EPS = 1e-5f;
constexpr float ALPHA = 1.41421356237309515f;

constexpr int OFF_AQ = 0;
constexpr int OFF_AK = 768;
constexpr int OFF_AV = 1536;
constexpr int OFF_BQ = 2304;
constexpr int OFF_BK = OFF_BQ + B_K;
constexpr int OFF_BV = OFF_BK + B_K;
constexpr int OFF_BR = OFF_BV + B_V;
constexpr int OFF_LR = OFF_BR + B_V;
constexpr int OFF_CQ = OFF_LR + GLA_RANK;
constexpr int OFF_CKC = OFF_CQ + 1024;
constexpr int OFF_CVC = OFF_CKC + 256;
constexpr int OFF_CKS = OFF_CVC + 256;
constexpr int OFF_CVS = OFF_CKS + 256;
constexpr int OFF_CKW = OFF_CVS + 256;
constexpr int OFF_CVW = OFF_CKW + 256;
constexpr int OFF_CG = OFF_CVW + 256;
constexpr int OFF_MG = OFF_CG + 48;
constexpr int N_IN = OFF_MG + 3 * D;
constexpr int N_IN_PAD = (N_IN + 255) / 256 * 256;
constexpr int MOE_ROWS = N_TOK * 4 + 32 * 256;
constexpr int CMP_ROWS_PAD = 4096;
constexpr int YLD = 256 + 1024 + 1024;

#ifdef CPU_TEST
typedef float act_t;
DEV float ldf(float v) { return v; }
DEV void stf(float* p, float v) { *p = v; }
#else
typedef unsigned short act_t;
DEV float ldf(unsigned short h) { return __uint_as_float(((unsigned)h) << 16); }
DEV float ldf(float v) { return v; }
DEV unsigned short f2bf(float f) {
  unsigned u = __float_as_uint(f);
  u += 0x7fffu + ((u >> 16) & 1u);
  return (unsigned short)(u >> 16);
}
DEV void stf(unsigned short* p, float v) { *p = f2bf(v); }
DEV void stf(float* p, float v) { *p = v; }
#endif

struct Params {
  const float *x, *mem, *ln0_g, *ln0_b, *w_in, *b_in, *w_alpha2, *b_alpha, *gla_norm_g,
      *cmp_pe_k, *cmp_w1_k, *cmp_w2_k, *cmp_pe_v, *cmp_w1_v, *cmp_w2_v,
      *w_br_a, *w_br_b, *w_br_c, *w_o_mix, *ln1_g, *ln1_b, *w_xq, *w_xk, *w_xv, *w_xo, *ln2_g, *ln2_b,
      *w_router, *b_router, *w_gu, *b_gu, *w_down, *b_down, *ln3_g, *ln3_b;
  float* out;
  float* xf;
  act_t* xb;
  act_t* u;
  float* ga;
  float* hid;
  float* kcv;
  float* opart;
  act_t* ya;
  act_t* yb;
  act_t* yc;
  float* pcmp;
  float* ocmp;
  float* impb;
  int* selb;
  act_t* merged;
  float* tmp;
  act_t* xq;
  act_t* memk;
  act_t* memv;
  float* xs;
  act_t* xo;
  float* rl;
  int* topi;
  float* topg;
  act_t* act;
  act_t* wt_in;
  act_t* wt_c1;
  act_t* wt_bra;
  act_t* wt_brb;
  act_t* wt_brc;
  act_t* wt_omix;
  act_t* wt_xq;
  act_t* wt_xk;
  act_t* wt_xv;
  act_t* wt_xo;
  act_t* wt_gu;
  act_t* wt_dn;
  act_t* membf;
  act_t* cmpA;
  float* mrg;
  int* cnt;
  int* rank;
  int* rowlist;
  act_t* xg;
  act_t* actg;
  float* yass;
  act_t* kcb;
  act_t* dilo;
  float* dill;
  unsigned* selm;
  act_t* gU;
  act_t* gS;
  act_t* gQ;
  float* gD;
  unsigned* barw;
  size_t ws_used;
};

#ifdef CPU_TEST
#define FOR_IDX(idx, total) \
  for (long long idx = (long long)(total) * tid / nthr, _e = (long long)(total) * (tid + 1) / nthr; idx < _e; ++idx)
#else
#define FOR_IDX(idx, total) for (long long idx = tid; idx < (long long)(total); idx += nthr)
#endif

DEV float sigmoidf_(float x) { return 1.0f / (1.0f + expf(-x)); }

template <class TA>
DEV float dotcol(const TA* a, const float* W, int K, long long ldw) {
  float s = 0.f;
  for (int k = 0; k < K; ++k) s += ldf(a[k]) * W[(long long)k * ldw];
  return s;
}

DEV void ph_ln(const float* src, const float* g, const float* b, float* dstf, act_t* dstb, float* dst2,
               long long tid, long long nthr) {
  FOR_IDX(n, N_TOK) {
    const float* r = src + n * D;
    float mu = 0.f;
    for (int i = 0; i < D; ++i) mu += r[i];
    mu /= D;
    float var = 0.f;
    for (int i = 0; i < D; ++i) { float d = r[i] - mu; var += d * d; }
    var /= D;
    float rs = 1.0f / sqrtf(var + LN_EPS);
    for (int i = 0; i < D; ++i) {
      float y = (r[i] - mu) * rs * g[i] + b[i];
      dstf[n * D + i] = y;
      stf(&dstb[n * D + i], y);
      if (dst2) dst2[n * D + i] = y;
    }
  }
}

DEV void ph_inproj(const Params& p, int li, long long tid, long long nthr) {
  const float* W = p.w_in + (long long)li * D * N_IN;
  const float* bias = p.b_in + (long long)li * N_IN;
  FOR_IDX(idx, (long long)N_TOK * N_IN) {
    long long n = idx / N_IN; int c = (int)(idx % N_IN);
    stf(&p.u[idx], dotcol(p.xb + n * D, W + c, D, N_IN) + bias[c]);
  }
}

DEV float gelu_tanh(float x) {
  return 0.5f * x * (1.0f + tanhf(0.7978845608028654f * (x + 0.044715f * x * x * x)));
}

constexpr int CMP_ROWS = BATCH * N_CMP * NSA_G;

template <int PARTS>
DEV void ph_pre(const Params& p, int li, long long tid, long long nthr) {
  const long long T1 = (long long)N_TOK * B_K;
  const long long T2 = (PARTS & 2) ? 2LL * CMP_ROWS * CMP_HID : 0;
  FOR_IDX(idx, T1 + T2) {
    if (idx < T1) {
      if (!(PARTS & 1)) continue;
      long long n = idx / B_K; int c = (int)(idx % B_K);
      const float* W2 = p.w_alpha2 + (long long)li * GLA_RANK * B_K;
      float z = p.b_alpha[li * B_K + c];
      for (int r = 0; r < GLA_RANK; ++r) z += ldf(p.u[n * N_IN + OFF_LR + r]) * W2[r * B_K + c];
      float ls = fminf(z, 0.f) - log1pf(expf(-fabsf(z)));
      p.ga[idx] = expf(ls * (1.0f / 16.0f));
    } else {
      long long i2 = idx - T1;
      int which = (int)(i2 / ((long long)CMP_ROWS * CMP_HID));
      long long rem = i2 % ((long long)CMP_ROWS * CMP_HID);
      int row = (int)(rem / CMP_HID), j = (int)(rem % CMP_HID);
      int g = row % NSA_G; int c = (row / NSA_G) % N_CMP; int b = row / (NSA_G * N_CMP);
      const float* pe = (which ? p.cmp_pe_v : p.cmp_pe_k) + (long long)li * 32 * HD;
      const float* w1 = (which ? p.cmp_w1_v : p.cmp_w1_k) + (long long)li * 32 * HD * CMP_HID;
      int off = (which ? OFF_CVC : OFF_CKC) + g * HD;
      float s = 0.f;
      for (int l = 0; l < 32; ++l) {
        const act_t* ur = p.u + ((long long)b * SEQ + c * 16 + l) * N_IN + off;
        for (int d = 0; d < HD; ++d) s += (ldf(ur[d]) + pe[l * HD + d]) * w1[(long long)(l * HD + d) * CMP_HID + j];
      }
      p.hid[i2] = gelu_tanh(s);
    }
  }
}

template <int PARTS>
DEV void ph_mix1(const Params& p, int li, long long tid, long long nthr) {
  const long long T1 = (long long)N_TOK * 4;
  const long long T2 = (long long)BATCH * GLA_H * DV * 4;
  const long long T3 = 2LL * CMP_ROWS * HD;
  FOR_IDX(idx, T1 + T2 + T3) {
    if (idx < T1) {
      if (!(PARTS & 1)) continue;
      long long n = idx / 4; int h = (int)(idx % 4);
      int b = (int)(n / SEQ), t = (int)(n % SEQ);
      float m = -INFINITY, l = 0.f;
      float acc[HD];
#pragma unroll
      for (int d = 0; d < HD; ++d) acc[d] = 0.f;
      for (int gi = 0; gi < 3; ++gi) {
        const int dil = gi == 0 ? 1 : (gi == 1 ? 4 : 16);
        float q[HD];
        const act_t* qp = p.u + n * N_IN + OFF_AQ + gi * 256 + h * HD;
#pragma unroll
        for (int d = 0; d < HD; ++d) q[d] = ldf(qp[d]);
        for (int mm = 0; mm <= 128; ++mm) {
          int tk = t - mm * dil;
          if (tk < 0) break;
          const act_t* kp = p.u + ((long long)b * SEQ + tk) * N_IN + OFF_AK + gi * 256 + h * HD;
          const act_t* vp = p.u + ((long long)b * SEQ + tk) * N_IN + OFF_AV + gi * 256 + h * HD;
          float s = 0.f;
#pragma unroll
          for (int d = 0; d < HD; ++d) s += q[d] * ldf(kp[d]);
          s *= 0.125f;
          float mn = fmaxf(m, s);
          float corr = expf(m - mn);
          float pp = expf(s - mn);
          l = l * corr + pp;
#pragma unroll
          for (int d = 0; d < HD; ++d) acc[d] = acc[d] * corr + pp * ldf(vp[d]);
          m = mn;
        }
      }
      float inv = 1.0f / l;
#pragma unroll
      for (int d = 0; d < HD; ++d) stf(&p.ya[n * 256 + h * HD + d], acc[d] * inv);
    } else if (idx < T1 + T2) {
      if (!(PARTS & 2)) continue;
      long long i2 = idx - T1;
      int v = (int)(i2 % DV); int cq = (int)((i2 / DV) % 4); int h = (int)((i2 / (DV * 4)) % GLA_H);
      int b = (int)(i2 / (DV * 4 * GLA_H));
      constexpr int DKQ = DK / 4;
      float st[DKQ];
#pragma unroll
      for (int c = 0; c < DKQ; ++c) st[c] = 0.f;
      const float qs = 1.0f / sqrtf((float)DK);
      for (int t = 0; t < SEQ; ++t) {
        long long n = (long long)b * SEQ + t;
        const act_t* ur = p.u + n * N_IN;
        float vt = ldf(ur[OFF_BV + h * DV + v]);
        const float* gar = p.ga + n * B_K + h * DK + cq * DKQ;
        const act_t* kr = ur + OFF_BK + h * DK + cq * DKQ;
        const act_t* qr = ur + OFF_BQ + h * DK + cq * DKQ;
        float o = 0.f;
#pragma unroll
        for (int c = 0; c < DKQ; ++c) {
          st[c] = gar[c] * st[c] + ldf(kr[c]) * vt;
          o += ldf(qr[c]) * st[c];
        }
        p.opart[((long long)cq * N_TOK + n) * B_V + h * DV + v] = o * qs;
      }
    } else {
      long long i2 = idx - T1 - T2;
      int which = (int)(i2 / ((long long)CMP_ROWS * HD));
      long long rem = i2 % ((long long)CMP_ROWS * HD);
      int row = (int)(rem / HD), d = (int)(rem % HD);
      const float* w2 = (which ? p.cmp_w2_v : p.cmp_w2_k) + (long long)li * CMP_HID * HD;
      const float* hr = p.hid + ((long long)which * CMP_ROWS + row) * CMP_HID;
      float s = 0.f;
      if (!(PARTS & 4)) continue;
      for (int j = 0; j < CMP_HID; ++j) s += hr[j] * w2[j * HD + d];
      p.kcv[i2] = s;
#ifndef CPU_TEST
      {
        const int g_ = row % NSA_G, c_ = (row / NSA_G) % N_CMP, b_ = row / (NSA_G * N_CMP);
        stf(&p.kcb[((((size_t)which * BATCH + b_) * 128 + c_) * NSA_G + g_) * 64 + d], s);
      }
#endif
    }
  }
}

template <int PARTS>
DEV void ph_nsa1(const Params& p, int li, long long tid, long long nthr) {
  const long long T1 = (long long)N_TOK * GLA_H;
  const long long T2 = (PARTS & 2) ? (long long)N_TOK * NSA_H : 0;
  FOR_IDX(idx, T1 + T2) {
    if (idx < T1) {
      long long n = idx / GLA_H; int h = (int)(idx % GLA_H);
      float ss = 0.f;
      for (int v = 0; v < DV; ++v) {
        float o = 0.f;
        for (int cq = 0; cq < 4; ++cq) o += p.opart[((long long)cq * N_TOK + n) * B_V + h * DV + v];
        ss += o * o;
      }
      float rs = 1.0f / sqrtf(ss / DV + LN_EPS);
      for (int v = 0; v < DV; ++v) {
        float o = 0.f;
        for (int cq = 0; cq < 4; ++cq) o += p.opart[((long long)cq * N_TOK + n) * B_V + h * DV + v];
        float r = ldf(p.u[n * N_IN + OFF_BR + h * DV + v]);
        float y = o * rs * p.gla_norm_g[li * DV + v] * (r * sigmoidf_(r));
        stf(&p.yb[n * B_V + h * DV + v], y);
      }
    } else {
      long long i2 = idx - T1;
      long long n = i2 / NSA_H; int hh = (int)(i2 % NSA_H);
      int b = (int)(n / SEQ), t = (int)(n % SEQ);
      int g = hh / 4;
      int nv = t >= 31 ? (t - 31) / 16 + 1 : 0;
      if (nv > N_CMP) nv = N_CMP;
      float q[HD];
      const act_t* qp = p.u + n * N_IN + OFF_CQ + hh * HD;
#pragma unroll
      for (int d = 0; d < HD; ++d) q[d] = ldf(qp[d]);
      float* prow = p.pcmp + (((long long)b * NSA_H + hh) * SEQ + t) * 128;
      float m = -INFINITY;
      for (int c = 0; c < nv; ++c) {
        const float* kp = p.kcv + (((long long)b * N_CMP + c) * NSA_G + g) * HD;
        float s = 0.f;
#pragma unroll
        for (int d = 0; d < HD; ++d) s += q[d] * kp[d];
        s *= 0.125f;
        prow[c] = s;
        m = fmaxf(m, s);
      }
      float acc[HD];
#pragma unroll
      for (int d = 0; d < HD; ++d) acc[d] = 0.f;
      float l = 0.f;
      for (int c = 0; c < nv; ++c) {
        const float* vp = p.kcv + (((long long)CMP_ROWS) + ((long long)b * N_CMP + c) * NSA_G + g) * HD;
        float pp = expf(prow[c] - m);
        l += pp;
        prow[c] = pp;
#pragma unroll
        for (int d = 0; d < HD; ++d) acc[d] += pp * vp[d];
      }
      float inv = 1.0f / fmaxf(l, 1e-30f);
      for (int c = 0; c < 128; ++c) prow[c] = c < nv ? prow[c] * inv : 0.f;
#pragma unroll
      for (int d = 0; d < HD; ++d) p.ocmp[n * 1024 + hh * HD + d] = acc[d] * inv;
    }
  }
}

DEV void ph_nsa2(const Params& p, int li, long long tid, long long nthr) {
  FOR_IDX(idx, (long long)BATCH * NSA_G * SEQ * N_BLK) {
    int j = (int)(idx % N_BLK); long long r = idx / N_BLK;
    int s = (int)(r % SEQ); int g = (int)((r / SEQ) % NSA_G); int b = (int)(r / ((long long)SEQ * NSA_G));
    int qb = s / 64;
    float imp;
    if (j == 0 || j == qb || j == qb - 1) imp = INFINITY;
    else if (j > qb) imp = -INFINITY;
    else {
      imp = 0.f;
      int c0 = 4 * j - 1; if (c0 < 0) c0 = 0;
      int c1 = 4 * j + 3; if (c1 > N_CMP - 1) c1 = N_CMP - 1;
      for (int rr = 0; rr < 4; ++rr) {
        const float* prow = p.pcmp + (((long long)b * NSA_H + g * 4 + rr) * SEQ + s) * 128;
        for (int c = c0; c <= c1; ++c) imp += prow[c];
      }
    }
    p.impb[idx] = imp;
  }
}

DEV void ph_nsa3(const Params& p, int li, long long tid, long long nthr) {
  FOR_IDX(idx, (long long)BATCH * NSA_G * SEQ * N_BLK) {
    int j = (int)(idx % N_BLK); long long r = idx / N_BLK;
    const float* ir = p.impb + r * N_BLK;
    float v = ir[j];
    int rank = 0;
    for (int jj = 0; jj < N_BLK; ++jj) {
      float w = ir[jj];
      if (w > v || (w == v && jj < j)) ++rank;
    }
    p.selb[idx] = rank < N_SELECT ? 1 : 0;
  }
}

DEV void ph_nsa4(const Params& p, int li, long long tid, long long nthr) {
  FOR_IDX(idx, (long long)N_TOK * NSA_H) {
    long long n = idx / NSA_H; int hh = (int)(idx % NSA_H);
    int b = (int)(n / SEQ), t = (int)(n % SEQ);
    int g = hh / 4;
    float q[HD];
    const act_t* qp = p.u + n * N_IN + OFF_CQ + hh * HD;
#pragma unroll
    for (int d = 0; d < HD; ++d) q[d] = ldf(qp[d]);
    float g0 = sigmoidf_(ldf(p.u[n * N_IN + OFF_CG + hh * 3 + 0]));
    float g1 = sigmoidf_(ldf(p.u[n * N_IN + OFF_CG + hh * 3 + 1]));
    float g2 = sigmoidf_(ldf(p.u[n * N_IN + OFF_CG + hh * 3 + 2]));
    float acc[HD];
    {
      float m = -INFINITY, l = 0.f;
#pragma unroll
      for (int d = 0; d < HD; ++d) acc[d] = 0.f;
      int qb = t / 64;
      const int* sr = p.selb + (((long long)b * NSA_G + g) * SEQ + t) * N_BLK;
      for (int j = 0; j <= qb; ++j) {
        if (!sr[j]) continue;
        int hi = j * 64 + 63; if (hi > t) hi = t;
        for (int tk = j * 64; tk <= hi; ++tk) {
          const act_t* kp = p.u + ((long long)b * SEQ + tk) * N_IN + OFF_CKS + g * HD;
          const act_t* vp = p.u + ((long long)b * SEQ + tk) * N_IN + OFF_CVS + g * HD;
          float s = 0.f;
#pragma unroll
          for (int d = 0; d < HD; ++d) s += q[d] * ldf(kp[d]);
          s *= 0.125f;
          float mn = fmaxf(m, s);
          float corr = expf(m - mn);
          float pp = expf(s - mn);
          l = l * corr + pp;
#pragma unroll
          for (int d = 0; d < HD; ++d) acc[d] = acc[d] * corr + pp * ldf(vp[d]);
          m = mn;
        }
      }
      float inv = 1.0f / l;
#pragma unroll
      for (int d = 0; d < HD; ++d) {
        float* oc = &p.ocmp[n * 1024 + hh * HD + d];
        *oc = g0 * (*oc) + g1 * acc[d] * inv;
      }
    }
    {
      float m = -INFINITY, l = 0.f;
#pragma unroll
      for (int d = 0; d < HD; ++d) acc[d] = 0.f;
      int lo = t - (NSA_WIN - 1); if (lo < 0) lo = 0;
      for (int tk = lo; tk <= t; ++tk) {
        const act_t* kp = p.u + ((long long)b * SEQ + tk) * N_IN + OFF_CKW + g * HD;
        const act_t* vp = p.u + ((long long)b * SEQ + tk) * N_IN + OFF_CVW + g * HD;
        float s = 0.f;
#pragma unroll
        for (int d = 0; d < HD; ++d) s += q[d] * ldf(kp[d]);
        s *= 0.125f;
        float mn = fmaxf(m, s);
        float corr = expf(m - mn);
        float pp = expf(s - mn);
        l = l * corr + pp;
#pragma unroll
        for (int d = 0; d < HD; ++d) acc[d] = acc[d] * corr + pp * ldf(vp[d]);
        m = mn;
      }
      float inv = 1.0f / l;
#pragma unroll
      for (int d = 0; d < HD; ++d)
        stf(&p.yc[n * 1024 + hh * HD + d], p.ocmp[n * 1024 + hh * HD + d] + g2 * acc[d] * inv);
    }
  }
}

DEV void ph_br(const Params& p, int li, long long tid, long long nthr) {
  const float* Wa = p.w_br_a + (long long)li * 256 * D;
  const float* Wb = p.w_br_b + (long long)li * B_V * D;
  const float* Wc = p.w_br_c + (long long)li * 1024 * D;
  FOR_IDX(idx, (long long)N_TOK * D) {
    long long n = idx / D; int d = (int)(idx % D);
    float s0 = dotcol(p.ya + n * 256, Wa + d, 256, D);
    float s1 = dotcol(p.yb + n * B_V, Wb + d, B_V, D);
    float s2 = dotcol(p.yc + n * 1024, Wc + d, 1024, D);
    const act_t* mg = p.u + n * N_IN + OFF_MG;
    float y = sigmoidf_(ldf(mg[d])) * s0 + sigmoidf_(ldf(mg[D + d])) * s1 + sigmoidf_(ldf(mg[2 * D + d])) * s2;
    stf(&p.merged[idx], y);
  }
}

DEV void ph_proj_res(const Params& p, const act_t* a, const float* W, long long tid, long long nthr) {
  FOR_IDX(idx, (long long)N_TOK * D) {
    long long n = idx / D; int d = (int)(idx % D);
    p.tmp[idx] = ALPHA * p.xf[idx] + dotcol(a + n * D, W + d, D, D);
  }
}

DEV void ph_xq(const Params& p, int li, long long tid, long long nthr) {
  const long long T1 = (long long)N_TOK * D;
  const long long T2 = 2LL * BATCH * MEM_LEN * D;
  const float* Wq = p.w_xq + (long long)li * D * D;
  FOR_IDX(idx, T1 + T2) {
    if (idx < T1) {
      long long n = idx / D; int d = (int)(idx % D);
      stf(&p.xq[idx], dotcol(p.xb + n * D, Wq + d, D, D));
    } else {
      long long i2 = idx - T1;
      int which = (int)(i2 / ((long long)BATCH * MEM_LEN * D));
      long long rem = i2 % ((long long)BATCH * MEM_LEN * D);
      long long r = rem / D; int d = (int)(rem % D);
      const float* W = (which ? p.w_xv : p.w_xk) + (long long)li * D * D;
      float s = dotcol(p.mem + r * D, W + d, D, D);
      stf(which ? &p.memv[rem] : &p.memk[rem], s);
    }
  }
}

DEV void ph_xs(const Params& p, int li, long long tid, long long nthr) {
  const float sc = 1.0f / sqrtf((float)XHD);
  FOR_IDX(idx, (long long)N_TOK * XH * MEM_LEN) {
    int m = (int)(idx % MEM_LEN); int h = (int)((idx / MEM_LEN) % XH); long long n = idx / (MEM_LEN * XH);
    int b = (int)(n / SEQ);
    const act_t* q = p.xq + n * D + h * XHD;
    const act_t* k = p.memk + ((long long)b * MEM_LEN + m) * D + h * XHD;
    float s = 0.f;
    for (int d = 0; d < XHD; ++d) s += ldf(q[d]) * ldf(k[d]);
    p.xs[idx] = s * sc;
  }
}

DEV void ph_xo(const Params& p, int li, long long tid, long long nthr) {
  FOR_IDX(idx, (long long)N_TOK * D) {
    long long n = idx / D; int c = (int)(idx % D);
    int h = c / XHD; int b = (int)(n / SEQ);
    const float* sr = p.xs + (n * XH + h) * MEM_LEN;
    float m = -INFINITY;
    for (int mm = 0; mm < MEM_LEN; ++mm) m = fmaxf(m, sr[mm]);
    float l = 0.f, o = 0.f;
    for (int mm = 0; mm < MEM_LEN; ++mm) {
      float pp = expf(sr[mm] - m);
      l += pp;
      o += pp * ldf(p.memv[((long long)b * MEM_LEN + mm) * D + c]);
    }
    stf(&p.xo[idx], o / l);
  }
}

DEV void ph_rlogit(const Params& p, int li, long long tid, long long nthr) {
  const float* W = p.w_router + (long long)li * D * NE;
  FOR_IDX(idx, (long long)N_TOK * NE) {
    long long n = idx / NE; int e = (int)(idx % NE);
    p.rl[idx] = dotcol(p.xf + n * D, W + e, D, NE) + p.b_router[li * NE + e];
  }
}

DEV void ph_route(const Params& p, int li, long long tid, long long nthr) {
  FOR_IDX(n, N_TOK) {
    const float* r = p.rl + n * NE;
    int i0 = -1, i1 = -1, i2 = -1, i3 = -1;
    float v0 = 0, v1 = 0, v2 = 0, v3 = 0;
    for (int k = 0; k < 4; ++k) {
      int bi = -1; float bv = -INFINITY;
      for (int e = 0; e < NE; ++e) {
        if (e == i0 || e == i1 || e == i2) continue;
        float v = r[e];
        if (bi < 0 || v > bv) { bi = e; bv = v; }
      }
      if (k == 0) { i0 = bi; v0 = bv; } else if (k == 1) { i1 = bi; v1 = bv; }
      else if (k == 2) { i2 = bi; v2 = bv; } else { i3 = bi; v3 = bv; }
    }
    float e0 = 1.0f, e1 = expf(v1 - v0), e2 = expf(v2 - v0), e3 = expf(v3 - v0);
    float inv = 1.0f / (e0 + e1 + e2 + e3);
#ifndef CPU_TEST
    p.rank[n * 4 + 0] = atomicAdd(&p.cnt[li * 32 + i0], 1);
    p.rank[n * 4 + 1] = atomicAdd(&p.cnt[li * 32 + i1], 1);
    p.rank[n * 4 + 2] = atomicAdd(&p.cnt[li * 32 + i2], 1);
    p.rank[n * 4 + 3] = atomicAdd(&p.cnt[li * 32 + i3], 1);
#endif
    p.topi[n * 4 + 0] = i0; p.topi[n * 4 + 1] = i1; p.topi[n * 4 + 2] = i2; p.topi[n * 4 + 3] = i3;
    p.topg[n * 4 + 0] = e0 * inv; p.topg[n * 4 + 1] = e1 * inv; p.topg[n * 4 + 2] = e2 * inv; p.topg[n * 4 + 3] = e3 * inv;
  }
}

DEV void ph_moe1(const Params& p, int li, long long tid, long long nthr) {
  FOR_IDX(idx, (long long)N_TOK * TOPK * DFF) {
    int j = (int)(idx % DFF); long long a = idx / DFF; long long n = a / TOPK;
    int e = p.topi[a];
    const float* W = p.w_gu + ((long long)li * NE + e) * D * 2 * DFF;
    const float* bb = p.b_gu + ((long long)li * NE + e) * 2 * DFF;
    float gt = dotcol(p.xb + n * D, W + j, D, 2 * DFF) + bb[j];
    float up = dotcol(p.xb + n * D, W + DFF + j, D, 2 * DFF) + bb[DFF + j];
    gt = fminf(gt, 7.0f);
    up = fminf(fmaxf(up, -7.0f), 7.0f);
    stf(&p.act[idx], (up + 1.0f) * gt * sigmoidf_(1.702f * gt));
  }
}

DEV void ph_moe2(const Params& p, int li, long long tid, long long nthr) {
  FOR_IDX(idx, (long long)N_TOK * D) {
    long long n = idx / D; int d = (int)(idx % D);
    float y = 0.f;
    for (int k = 0; k < TOPK; ++k) {
      int e = p.topi[n * 4 + k];
      const float* W = p.w_down + ((long long)li * NE + e) * DFF * D;
      float s = dotcol(p.act + (n * 4 + k) * DFF, W + d, DFF, D) + p.b_down[((long long)li * NE + e) * D + d];
      y += p.topg[n * 4 + k] * s;
    }
    p.tmp[idx] = ALPHA * p.xf[idx] + y;
  }
}

constexpr int PH_PER_LAYER = 20;
constexpr int N_PHASES = 1 + DEPTH * PH_PER_LAYER;

template <int K>
DEV void run_phase_k(const Params& p, int li, long long tid, long long nthr) {
  if constexpr (K == -1) ph_ln(p.x, p.ln0_g, p.ln0_b, p.xf, p.xb, nullptr, tid, nthr);
  if constexpr (K == 0) ph_inproj(p, li, tid, nthr);
  if constexpr (K == 1) ph_pre<3>(p, li, tid, nthr);
  if constexpr (K == 20) ph_pre<1>(p, li, tid, nthr);
  if constexpr (K == 2) ph_mix1<7>(p, li, tid, nthr);
  if constexpr (K == 21) ph_mix1<4>(p, li, tid, nthr);
  if constexpr (K == 3) ph_nsa1<3>(p, li, tid, nthr);
  if constexpr (K == 22) ph_nsa1<1>(p, li, tid, nthr);
  if constexpr (K == 4) ph_nsa2(p, li, tid, nthr);
  if constexpr (K == 5) ph_nsa3(p, li, tid, nthr);
  if constexpr (K == 6) ph_nsa4(p, li, tid, nthr);
  if constexpr (K == 7) ph_br(p, li, tid, nthr);
  if constexpr (K == 8) ph_proj_res(p, p.merged, p.w_o_mix + (long long)li * D * D, tid, nthr);
  if constexpr (K == 9) ph_ln(p.tmp, p.ln1_g + li * D, p.ln1_b + li * D, p.xf, p.xb, nullptr, tid, nthr);
  if constexpr (K == 10) ph_xq(p, li, tid, nthr);
  if constexpr (K == 11) ph_xs(p, li, tid, nthr);
  if constexpr (K == 12) ph_xo(p, li, tid, nthr);
  if constexpr (K == 13) ph_proj_res(p, p.xo, p.w_xo + (long long)li * D * D, tid, nthr);
  if constexpr (K == 14) ph_ln(p.tmp, p.ln2_g + li * D, p.ln2_b + li * D, p.xf, p.xb, nullptr, tid, nthr);
  if constexpr (K == 15) ph_rlogit(p, li, tid, nthr);
  if constexpr (K == 16) ph_route(p, li, tid, nthr);
  if constexpr (K == 17) ph_moe1(p, li, tid, nthr);
  if constexpr (K == 18) ph_moe2(p, li, tid, nthr);
  if constexpr (K == 19) ph_ln(p.tmp, p.ln3_g + li * D, p.ln3_b + li * D, p.xf, p.xb, li == DEPTH - 1 ? p.out : nullptr, tid, nthr);
}

DEV void run_phase(const Params& p, int ph, long long tid, long long nthr) {
  if (ph == 0) { run_phase_k<-1>(p, 0, tid, nthr); return; }
  int li = (ph - 1) / PH_PER_LAYER, k = (ph - 1) % PH_PER_LAYER;
  switch (k) {
#define PHC(K) case K: run_phase_k<K>(p, li, tid, nthr); break;
    PHC(0) PHC(1) PHC(2) PHC(3) PHC(4) PHC(5) PHC(6) PHC(7) PHC(8) PHC(9)
    PHC(10) PHC(11) PHC(12) PHC(13) PHC(14) PHC(15) PHC(16) PHC(17) PHC(18) PHC(19)
#undef PHC
  }
}

#ifdef CPU_TEST
#define HDI_M
#else
#define HDI_M __host__ __device__ __forceinline__
#endif
struct Carver {
  char* base; size_t off;
  template <class T> HDI_M T* take(size_t n) {
    T* r = (T*)(base + off);
    off += (n * sizeof(T) + 255) & ~(size_t)255;
    return r;
  }
};

HDI void fill_params(Params& p, void* const* d_in, void* d_out, void* d_ws) {
  const float* const* in = (const float* const*)d_in;
  p.x = in[0]; p.mem = in[1]; p.ln0_g = in[2]; p.ln0_b = in[3]; p.w_in = in[4]; p.b_in = in[5];
  p.w_alpha2 = in[6]; p.b_alpha = in[7]; p.gla_norm_g = in[8];
  p.cmp_pe_k = in[9]; p.cmp_w1_k = in[10]; p.cmp_w2_k = in[11]; p.cmp_pe_v = in[12]; p.cmp_w1_v = in[13]; p.cmp_w2_v = in[14];
  p.w_br_a = in[15]; p.w_br_b = in[16]; p.w_br_c = in[17]; p.w_o_mix = in[18]; p.ln1_g = in[19]; p.ln1_b = in[20];
  p.w_xq = in[21]; p.w_xk = in[22]; p.w_xv = in[23]; p.w_xo = in[24]; p.ln2_g = in[25]; p.ln2_b = in[26];
  p.w_router = in[27]; p.b_router = in[28]; p.w_gu = in[29]; p.b_gu = in[30]; p.w_down = in[31]; p.b_down = in[32];
  p.ln3_g = in[33]; p.ln3_b = in[34];
  p.out = (float*)d_out;
  Carver c{(char*)d_ws, 0};
  p.barw = c.take<unsigned>(4096);
  p.xf = c.take<float>((size_t)N_TOK * D);
  p.xb = c.take<act_t>((size_t)N_TOK * D);
  p.u = c.take<act_t>((size_t)N_TOK * N_IN);
  p.ga = c.take<float>((size_t)N_TOK * B_K);
  p.hid = c.take<float>((size_t)2 * CMP_ROWS * CMP_HID);
  p.kcv = c.take<float>((size_t)2 * CMP_ROWS * HD);
  p.opart = c.take<float>((size_t)4 * N_TOK * B_V);
  p.yass = p.opart;
#ifdef CPU_TEST
  p.ya = c.take<act_t>((size_t)N_TOK * 256);
  p.yb = c.take<act_t>((size_t)N_TOK * B_V);
  p.yc = c.take<act_t>((size_t)N_TOK * 1024);
#else
  p.ya = c.take<act_t>((size_t)N_TOK * YLD);
  p.yb = p.ya + 256;
  p.yc = p.ya + 1280;
#endif
  p.pcmp = c.take<float>((size_t)MOE_ROWS * 1024 / 2 > (size_t)BATCH * NSA_H * SEQ * 128 ? (size_t)MOE_ROWS * 1024 / 2 : (size_t)BATCH * NSA_H * SEQ * 128);
  p.xg = (act_t*)p.pcmp;
  p.ocmp = c.take<float>((size_t)N_TOK * 1024);
  p.impb = c.take<float>((size_t)BATCH * NSA_G * SEQ * N_BLK);
  p.selb = c.take<int>((size_t)BATCH * NSA_G * SEQ * N_BLK);
  p.merged = c.take<act_t>((size_t)N_TOK * D);
  p.tmp = c.take<float>((size_t)N_TOK * D);
  p.xq = c.take<act_t>((size_t)N_TOK * D);
  p.memk = c.take<act_t>((size_t)BATCH * MEM_LEN * D);
  p.memv = c.take<act_t>((size_t)BATCH * MEM_LEN * D);
  p.xs = c.take<float>((size_t)N_TOK * XH * MEM_LEN);
  p.mrg = p.xs;
  p.xo = c.take<act_t>((size_t)N_TOK * D);
  p.rl = c.take<float>((size_t)N_TOK * NE);
  p.topi = c.take<int>((size_t)N_TOK * TOPK);
  p.topg = c.take<float>((size_t)N_TOK * TOPK);
  p.actg = c.take<act_t>((size_t)MOE_ROWS * 1024);
  p.act = p.actg;
  p.wt_in = c.take<act_t>((size_t)2 * N_IN_PAD * 1024);
  p.wt_c1 = c.take<act_t>((size_t)2 * 2 * 256 * 2048);
  p.wt_bra = c.take<act_t>((size_t)2 * 1024 * YLD);
  p.wt_brb = p.wt_bra + 256;
  p.wt_brc = p.wt_bra + 1280;
  p.wt_omix = c.take<act_t>((size_t)2 * 1024 * 1024);
  p.wt_xq = c.take<act_t>((size_t)2 * 1024 * 1024);
  p.wt_xk = c.take<act_t>((size_t)2 * 1024 * 1024);
  p.wt_xv = c.take<act_t>((size_t)2 * 1024 * 1024);
  p.wt_xo = c.take<act_t>((size_t)2 * 1024 * 1024);
  p.wt_gu = c.take<act_t>((size_t)2 * 32 * 2048 * 1024);
  p.wt_dn = c.take<act_t>((size_t)2 * 32 * 1024 * 1024);
  p.membf = c.take<act_t>((size_t)BATCH * MEM_LEN * 1024);
  p.cmpA = c.take<act_t>((size_t)2 * CMP_ROWS_PAD * 2048);
  p.cnt = c.take<int>(64);
  p.rank = c.take<int>((size_t)N_TOK * 4);
  p.rowlist = c.take<int>((size_t)MOE_ROWS);
  p.kcb = c.take<act_t>((size_t)2 * BATCH * 128 * NSA_G * 64);
  p.dilo = c.take<act_t>((size_t)3 * N_TOK * 256);
  p.dill = c.take<float>((size_t)3 * N_TOK * 4);
  p.selm = c.take<unsigned>((size_t)BATCH * NSA_G * SEQ);
  p.gU = p.xg; p.gQ = p.xg + (size_t)1024 * 128 * 256; p.gS = p.actg; p.gD = p.opart + (size_t)N_TOK * 1024;
  p.ws_used = c.off;
}

#ifndef CPU_TEST
#ifndef NSA_PROBE
#define NSA_PROBE 0
#endif
#ifndef GSEG
#define GSEG -1
#endif
static_assert(D == 1024 && BATCH == 8, "optimized path is written for the graded shapes");
namespace pg8 {
#define PG8_LAS __attribute__((address_space(3)))
typedef unsigned short bf16_t;
typedef short bf16x8 __attribute__((ext_vector_type(8)));
typedef float f32x4 __attribute__((ext_vector_type(4)));
typedef unsigned u32x4 __attribute__((ext_vector_type(4)));
constexpr int BM = 256, BK = 64, HALF = 128, HTB = HALF * BK * 2  , STAGE_BYTES = 8 * HTB, NXCD = 8, WGM = 8;

__host__ __device__ __forceinline__ int lds_byte(int r, int c) { const int st = (r >> 4) * 2 + (c >> 5), rr = r & 15, cc = c & 31, ob = rr * 64 + cc * 2; return st * 1024 + (ob ^ (((ob >> 9) & 1) << 5)); }
__host__ __device__ __forceinline__ void stage_rc(int b, int& R, int& C) { const int st = b / 1024, sb = b % 1024, swz = sb ^ (((sb >> 9) & 1) << 5); R = (st >> 1) * 16 + swz / 64; C = (st & 1) * 32 + (swz % 64) / 2; }
__host__ __device__ __forceinline__ int perm32(int rho) { const int n = rho >> 4, i = rho & 15; return 8 * (i >> 2) + 4 * n + (i & 3); }

struct Unit { int pm, pn; };
struct Gemm { const bf16_t* A; const bf16_t* Bt; int M, N, K; };

struct StaticOrder {
    int nM, nN, nwg, G, c;
    __host__ __device__ void init(int M, int N, int G_, int c_) { nM = M / BM; nN = N / BM; nwg = nM * nN; G = G_; c = c_; }
    __host__ __device__ bool next(int i, Unit& u) const {
        const long L = (long)i * G + c; if (L >= nwg) return false;
        int wgid = (int)L; { const int q = nwg / NXCD, r = nwg % NXCD, xcd = wgid % NXCD, off = wgid / NXCD; wgid = (xcd < r ? xcd * (q + 1) : r * (q + 1) + (xcd - r) * q) + off; }
        const int nig = WGM * nN, gid = wgid / nig, fm = gid * WGM, gsz = (nM - fm) < WGM ? (nM - fm) : WGM;
        u.pm = fm + ((wgid % nig) % gsz); u.pn = (wgid % nig) / gsz; return true;
    }
    __device__ __forceinline__ void a_ready(const Unit&) const {}
    __device__ __forceinline__ void done(const Unit&) const {}
};

__device__ __forceinline__ unsigned cvt_pk_bf16(float lo, float hi) { unsigned r; asm volatile("v_cvt_pk_bf16_f32 %0, %1, %2" : "=v"(r) : "v"(lo), "v"(hi)); return r; }

template <class Epi, class Sched, bool ALIGN_EPI = false, bool SP2 = false>
__device__ __forceinline__ void gemm_phase(PG8_LAS unsigned char* lds, const Gemm g, const Sched& S, const Epi& E, const int tid) {
    const int wid = __builtin_amdgcn_readfirstlane(tid >> 6), lane = tid & 63, wr = wid >> 2, wc = wid & 3, fr = lane & 15, fq = lane >> 4;
    const int K = g.K, nt = K / BK;
    unsigned voffA[2], voffB[2];
#pragma unroll
    for (int i = 0; i < 2; ++i) { int R, C; stage_rc(tid * 16 + i * 8192, R, C); const int Rb = Epi::PERM ? ((R & ~31) + perm32(R & 31)) : R;
        voffA[i] = (unsigned)(R * K + C) * 2u; voffB[i] = (unsigned)(Rb * K + C) * 2u; }
    const size_t kstep = (size_t)(BK * 2);
    const size_t hstep = (size_t)HALF * K * 2;
    const size_t tstep = 2 * hstep;
    const unsigned ldsw = (unsigned)wid * 1024u;
    const int aoff = lds_byte(wr * 64 + fr, fq * 8), boff = lds_byte(wc * 32 + fr, fq * 8);
#define PG8_SA(b, h) (((b) * 2 + (h)) * HTB)
#define PG8_SB(b, h) ((4 + (b) * 2 + (h)) * HTB)
#define PG8_STAGE(bufoff, gbase, voff) do { _Pragma("unroll") for (int _i = 0; _i < 2; ++_i) \
        __builtin_amdgcn_global_load_lds((const unsigned*)((const char*)(gbase) + (voff)[_i]), (PG8_LAS unsigned*)(lds + (bufoff) + ldsw + _i * 8192), 16, 0, 0); } while (0)
#define PG8_LDA(dst, b, h) do { _Pragma("unroll") for (int m = 0; m < 4; ++m) _Pragma("unroll") for (int k = 0; k < 2; ++k) dst[m][k] = *(const PG8_LAS bf16x8*)(lds + PG8_SA(b, h) + aoff + m * 2048 + k * 1024); } while (0)
#define PG8_LDB(dst, b, h) do { _Pragma("unroll") for (int n = 0; n < 2; ++n) _Pragma("unroll") for (int k = 0; k < 2; ++k) dst[n][k] = *(const PG8_LAS bf16x8*)(lds + PG8_SB(b, h) + boff + n * 2048 + k * 1024); } while (0)
#define PG8_MMA(ai, bj, At, Bt) do { __builtin_amdgcn_s_setprio(1); _Pragma("unroll") for (int m = 0; m < 4; ++m) _Pragma("unroll") for (int n = 0; n < 2; ++n) _Pragma("unroll") for (int k = 0; k < 2; ++k) \
        acc[ai][bj][m][n] = __builtin_amdgcn_mfma_f32_16x16x32_bf16(Bt[n][k], At[m][k], acc[ai][bj][m][n], 0, 0, 0); __builtin_amdgcn_s_setprio(0); } while (0)
#define PG8_WAIT_V(n) asm volatile("s_waitcnt vmcnt(" #n ")" ::: "memory")
#define PG8_WAIT_L(n) asm volatile("s_waitcnt lgkmcnt(" #n ")" ::: "memory")
#define PG8_BAR __builtin_amdgcn_s_barrier()
#define PG8_SCHED __builtin_amdgcn_sched_barrier(0)
    Unit cur, nxt; int ui = 0;
    if (!S.next(0, cur)) return;
    f32x4 acc[2][2][4][2];
#pragma unroll
    for (int a = 0; a < 2; ++a)
#pragma unroll
        for (int b = 0; b < 2; ++b)
#pragma unroll
            for (int m = 0; m < 4; ++m)
#pragma unroll
                for (int n = 0; n < 2; ++n) acc[a][b][m][n] = (f32x4){0.f, 0.f, 0.f, 0.f};
    bf16x8 At[4][2], B0[2][2], B1[2][2];
    const char* cA = (const char*)g.A + (size_t)cur.pm * tstep; const char* cB = (const char*)g.Bt + (size_t)cur.pn * tstep;
    S.a_ready(cur);
    if constexpr (SP2) {
        PG8_STAGE(PG8_SB(0, 0), cB, voffB); PG8_STAGE(PG8_SB(0, 1), cB + hstep, voffB); PG8_STAGE(PG8_SA(0, 0), cA, voffA); PG8_STAGE(PG8_SA(0, 1), cA + hstep, voffA);
        if (wr == 1) PG8_BAR;
        PG8_WAIT_V(2); PG8_BAR;
        PG8_STAGE(PG8_SB(1, 0), cB + kstep, voffB); PG8_STAGE(PG8_SA(1, 0), cA + kstep, voffA); PG8_STAGE(PG8_SB(1, 1), cB + hstep + kstep, voffB);
        PG8_WAIT_V(6); PG8_BAR;
    } else {
        PG8_STAGE(PG8_SB(0, 0), cB, voffB); PG8_STAGE(PG8_SA(0, 0), cA, voffA); PG8_STAGE(PG8_SB(0, 1), cB + hstep, voffB); PG8_STAGE(PG8_SA(0, 1), cA + hstep, voffA);
        if (wr == 1) PG8_BAR;
        PG8_WAIT_V(4); PG8_BAR;
        PG8_STAGE(PG8_SB(1, 0), cB + kstep, voffB); PG8_STAGE(PG8_SA(1, 0), cA + kstep, voffA); PG8_STAGE(PG8_SB(1, 1), cB + hstep + kstep, voffB);
        PG8_WAIT_V(6); PG8_BAR;
    }
    for (;;) {
        const bool has_next = S.next(ui + 1, nxt);
        const char* nA = has_next ? (const char*)g.A + (size_t)nxt.pm * tstep : cA; const char* nB = has_next ? (const char*)g.Bt + (size_t)nxt.pn * tstep : cB;
        for (int t = 0; t < nt; t += 2) {
            const bool last = (t == nt - 2);
            const char* a1 = cA + (size_t)(t + 1) * kstep;
            const char* a2 = last ? nA : cA + (size_t)(t + 2) * kstep; const char* b2 = last ? nB : cB + (size_t)(t + 2) * kstep;
            const char* a3 = a2 + kstep; const char* b3 = b2 + kstep;
            if (last && has_next) S.a_ready(nxt);
            asm volatile("" : "+v"(voffA[0]), "+v"(voffA[1]), "+v"(voffB[0]), "+v"(voffB[1]));
            E.mid(acc, cur, wr, wc, t);
            if constexpr (SP2) {
            PG8_LDB(B0, 0, 0); PG8_LDB(B1, 0, 1); PG8_SCHED; PG8_LDA(At, 0, 0); PG8_STAGE(PG8_SA(1, 1), a1 + hstep, voffA);
            PG8_WAIT_V(8); PG8_WAIT_L(0); PG8_BAR; PG8_MMA(0, 0, At, B0); PG8_MMA(0, 1, At, B1); PG8_BAR; PG8_SCHED;
            PG8_LDA(At, 0, 1); PG8_STAGE(PG8_SB(0, 0), b2, voffB); PG8_STAGE(PG8_SB(0, 1), b2 + hstep, voffB); PG8_STAGE(PG8_SA(0, 0), a2, voffA);
            PG8_WAIT_V(8); PG8_WAIT_L(0); PG8_BAR; PG8_MMA(1, 0, At, B0); PG8_MMA(1, 1, At, B1); PG8_BAR; PG8_SCHED;
            PG8_LDB(B0, 1, 0); PG8_LDB(B1, 1, 1); PG8_SCHED; PG8_LDA(At, 1, 0); PG8_STAGE(PG8_SA(0, 1), a2 + hstep, voffA);
            PG8_WAIT_V(8); PG8_WAIT_L(0); PG8_BAR; PG8_MMA(0, 0, At, B0); PG8_MMA(0, 1, At, B1); PG8_BAR; PG8_SCHED;
            PG8_LDA(At, 1, 1); PG8_STAGE(PG8_SB(1, 0), b3, voffB); PG8_STAGE(PG8_SB(1, 1), b3 + hstep, voffB); PG8_STAGE(PG8_SA(1, 0), a3, voffA);
            PG8_WAIT_V(8); PG8_WAIT_L(0); PG8_BAR; PG8_MMA(1, 0, At, B0); PG8_MMA(1, 1, At, B1); PG8_BAR; PG8_SCHED;
            } else {
            PG8_LDB(B0, 0, 0); PG8_SCHED; PG8_LDA(At, 0, 0); PG8_STAGE(PG8_SA(1, 1), a1 + hstep, voffA);
            PG8_WAIT_L(8); PG8_BAR; PG8_WAIT_L(0); PG8_MMA(0, 0, At, B0); PG8_BAR; PG8_SCHED;
            PG8_LDB(B1, 0, 1); PG8_STAGE(PG8_SB(0, 0), b2, voffB);
            PG8_BAR; PG8_WAIT_L(0); PG8_MMA(0, 1, At, B1); PG8_BAR;
            PG8_LDA(At, 0, 1); PG8_STAGE(PG8_SA(0, 0), a2, voffA);
            PG8_BAR; PG8_WAIT_L(0); PG8_MMA(1, 0, At, B0); PG8_BAR; PG8_SCHED;
            PG8_STAGE(PG8_SB(0, 1), b2 + hstep, voffB);
            PG8_WAIT_V(6); PG8_BAR; PG8_MMA(1, 1, At, B1); PG8_BAR;
            PG8_LDB(B0, 1, 0); PG8_SCHED; PG8_LDA(At, 1, 0); PG8_STAGE(PG8_SA(0, 1), a2 + hstep, voffA);
            PG8_WAIT_L(8); PG8_BAR; PG8_WAIT_L(0); PG8_MMA(0, 0, At, B0); PG8_BAR; PG8_SCHED;
            PG8_LDB(B1, 1, 1); PG8_STAGE(PG8_SB(1, 0), b3, voffB);
            PG8_BAR; PG8_WAIT_L(0); PG8_MMA(0, 1, At, B1); PG8_BAR;
            PG8_LDA(At, 1, 1); PG8_STAGE(PG8_SA(1, 0), a3, voffA);
            PG8_BAR; PG8_WAIT_L(0); PG8_MMA(1, 0, At, B0); PG8_BAR; PG8_SCHED;
            PG8_STAGE(PG8_SB(1, 1), b3 + hstep, voffB);
            PG8_WAIT_V(6); PG8_BAR; PG8_MMA(1, 1, At, B1); PG8_BAR;
            }
        }
        if constexpr (ALIGN_EPI) { if (wr == 0) PG8_BAR; }
        if constexpr (!Epi::AFTER_DRAIN) { E(acc, cur, wr, wc, fr, fq); S.done(cur); }
        if (!has_next) break;
#pragma unroll
        for (int a = 0; a < 2; ++a)
#pragma unroll
            for (int b = 0; b < 2; ++b)
#pragma unroll
                for (int m = 0; m < 4; ++m)
#pragma unroll
                    for (int n = 0; n < 2; ++n) acc[a][b][m][n] = (f32x4){0.f, 0.f, 0.f, 0.f};
        cur = nxt; cA = nA; cB = nB; ++ui;
        if constexpr (ALIGN_EPI) { if (wr == 1) PG8_BAR; }
    }
    PG8_WAIT_V(0);
    if constexpr (!ALIGN_EPI) { if (wr == 0) PG8_BAR; }
    PG8_BAR;
    if constexpr (Epi::AFTER_DRAIN) { E.fused(acc, cur, wr, wc, fr, fq, lds, wid, lane); S.done(cur); }
#undef PG8_SA
#undef PG8_SB
#undef PG8_STAGE
#undef PG8_LDA
#undef PG8_LDB
#undef PG8_MMA
#undef PG8_WAIT_V
#undef PG8_WAIT_L
#undef PG8_BAR
#undef PG8_SCHED
}
}

typedef pg8::f32x4 f32x4;
typedef pg8::bf16x8 bf16x8;
typedef unsigned u32x2 __attribute__((ext_vector_type(2)));
typedef unsigned u32x4 __attribute__((ext_vector_type(4)));
#define LAS __attribute__((address_space(3)))

constexpr int NTHREADS = 512;
constexpr int RING_BYTES = 131072;
constexpr int MISC_OFF = RING_BYTES;
constexpr int LDS_BYTES = 147456;

typedef __bf16 bf16x2_t __attribute__((ext_vector_type(2)));
typedef float f32x2_t __attribute__((ext_vector_type(2)));
DEV unsigned pk2(float lo, float hi) {
  const f32x2_t v = {lo, hi};
  return __builtin_bit_cast(unsigned, __builtin_convertvector(v, bf16x2_t));
}
DEV unsigned short f2bfh(float x) { return (unsigned short)(pk2(x, 0.f) & 0xffffu); }
DEV float fsig(float x) { return __builtin_amdgcn_rcpf(1.0f + __builtin_amdgcn_exp2f(-1.4426950408889634f * x)); }
DEV float shx(float v, int lane, int o) { return __int_as_float(__builtin_amdgcn_ds_bpermute((lane ^ o) << 2, __float_as_int(v))); }
DEV int shxi(int v, int lane, int o) { return __builtin_amdgcn_ds_bpermute((lane ^ o) << 2, v); }
DEV float wave_sum(float v, int lane) {
#pragma unroll
  for (int o = 1; o < 64; o <<= 1)
    v += __int_as_float(__builtin_amdgcn_ds_bpermute((lane ^ o) << 2, __float_as_int(v)));
  return v;
}

DEV void transpose_item(const float* W, int ldw, int dld, act_t* WT, int k0, int n0, int drow0, LAS float* scr, int lane) {
  float wv[32];
#pragma unroll
  for (int i = 0; i < 32; ++i) wv[i] = W[(size_t)(k0 + 2 * i + (lane >> 5)) * ldw + n0 + (lane & 31)];
#pragma unroll
  for (int i = 0; i < 32; ++i) scr[(2 * i + (lane >> 5)) * 33 + (lane & 31)] = wv[i];
  asm volatile("s_waitcnt lgkmcnt(0)" ::: "memory");
  const int c = lane & 7;
#pragma unroll
  for (int j = 0; j < 4; ++j) {
    const int n = (lane >> 3) + 8 * j;
    const LAS float* s = scr + (8 * c) * 33 + n;
    u32x4 o;
    o.x = pk2(s[0 * 33], s[1 * 33]); o.y = pk2(s[2 * 33], s[3 * 33]);
    o.z = pk2(s[4 * 33], s[5 * 33]); o.w = pk2(s[6 * 33], s[7 * 33]);
    *(u32x4*)(WT + (size_t)(drow0 + n) * dld + k0 + 8 * c) = o;
  }
  asm volatile("s_waitcnt lgkmcnt(0)" ::: "memory");
}

struct ConvDesc { const float* W; act_t* dst; int nbatch, K, N, mode; size_t dstb; int dld; };
constexpr int NCONV = 13;
DEV ConvDesc conv_desc(const Params& p, int kind) {
  const size_t SQ = (size_t)1024 * 1024;
  switch (kind) {
    case 0: return ConvDesc{p.w_gu, p.wt_gu, 64, 1024, 2048, 1, (size_t)2048 * 1024, 1024};
    case 1: return ConvDesc{p.w_down, p.wt_dn, 64, 1024, 1024, 0, SQ, 1024};
    case 2: return ConvDesc{p.w_in, p.wt_in, 2, 1024, N_IN, 0, (size_t)N_IN_PAD * 1024, 1024};
    case 3: return ConvDesc{p.cmp_w1_k, p.wt_c1, 2, 2048, 128, 0, (size_t)2 * 256 * 2048, 2048};
    case 4: return ConvDesc{p.cmp_w1_v, p.wt_c1 + (size_t)256 * 2048, 2, 2048, 128, 0, (size_t)2 * 256 * 2048, 2048};
    case 5: return ConvDesc{p.w_br_a, p.wt_bra, 2, 256, 1024, 0, (size_t)1024 * YLD, YLD};
    case 6: return ConvDesc{p.w_br_b, p.wt_brb, 2, 1024, 1024, 0, (size_t)1024 * YLD, YLD};
    case 7: return ConvDesc{p.w_br_c, p.wt_brc, 2, 1024, 1024, 0, (size_t)1024 * YLD, YLD};
    case 8: return ConvDesc{p.w_o_mix, p.wt_omix, 2, 1024, 1024, 0, SQ, 1024};
    case 9: return ConvDesc{p.w_xq, p.wt_xq, 2, 1024, 1024, 0, SQ, 1024};
    case 10: return ConvDesc{p.w_xk, p.wt_xk, 2, 1024, 1024, 0, SQ, 1024};
    case 11: return ConvDesc{p.w_xv, p.wt_xv, 2, 1024, 1024, 0, SQ, 1024};
    default: return ConvDesc{p.w_xo, p.wt_xo, 2, 1024, 1024, 0, SQ, 1024};
  }
}
DEV int conv_items(int kind) {
  switch (kind) {
    case 0: return 64 * 16 * 64;
    case 1: return 64 * 16 * 32;
    case 2: return 2 * 16 * (N_IN / 32);
    case 3: case 4: return 2 * 32 * 4;
    case 5: return 2 * 4 * 32;
    default: return 2 * 16 * 32;
  }
}
DEV void conv_all(const Params& p, int gw, int NGW, LAS float* scr, int lane) {
  int base = 0;
  for (int kind = 0; kind < NCONV; ++kind) {
    const int total = conv_items(kind);
    const ConvDesc d = conv_desc(p, kind);
    const int nblk = d.N / 32, per = nblk * (d.K / 64);
    int first = (gw - base % NGW + NGW) % NGW;
    for (int it = first; it < total; it += NGW) {
      const int bt = it / per, r = it % per, kb = r / nblk, nb = r % nblk;
      const int n0 = nb * 32;
      int drow0 = n0;
      if (d.mode == 1) { const int j = n0 & 1023; drow0 = (j >> 7) * 256 + (j & 127) + ((n0 >= 1024) ? 128 : 0); }
      transpose_item(d.W + (size_t)bt * d.K * d.N, d.N, d.dld, d.dst + (size_t)bt * d.dstb, kb * 64, n0, drow0, scr, lane);
    }
    base += total;
  }
}

template <int MODE, bool SRC_BF16 = false>
DEV void ln_rows_w(const Params& p, const float* src, const float* g, const float* b, float* dstf, act_t* dstb, float* dst2,
                   int gw, int NGW, int lane) {
  for (int n0 = gw; n0 < N_TOK; n0 += 2 * NGW) {
    f32x4 v[2][4];
    float s[2] = {0.f, 0.f};
#pragma unroll
    for (int r = 0; r < 2; ++r) {
      const int n = (n0 + r * NGW < N_TOK) ? n0 + r * NGW : n0;
#pragma unroll
      for (int j = 0; j < 4; ++j) {
        if (MODE == 0) {
          if (SRC_BF16) {
            const u32x2 xw = ((const u32x2*)((const act_t*)src + (size_t)n * D))[lane + 64 * j];
            v[r][j] = (f32x4){__uint_as_float(xw.x << 16), __uint_as_float(xw.x & 0xffff0000u), __uint_as_float(xw.y << 16), __uint_as_float(xw.y & 0xffff0000u)};
          } else v[r][j] = ((const f32x4*)(src + (size_t)n * D))[lane + 64 * j];
        } else {
          f32x4 a = ((const f32x4*)(p.xf + (size_t)n * D))[lane + 64 * j] * ALPHA;
#pragma unroll
          for (int k = 0; k < 4; ++k) {
            const u32x2 yw = ((const u32x2*)((const act_t*)p.yass + ((size_t)n * 4 + k) * D))[lane + 64 * j];
            a.x += __uint_as_float(yw.x << 16); a.y += __uint_as_float(yw.x & 0xffff0000u);
            a.z += __uint_as_float(yw.y << 16); a.w += __uint_as_float(yw.y & 0xffff0000u);
          }
          v[r][j] = a;
        }
        s[r] += (v[r][j].x + v[r][j].y) + (v[r][j].z + v[r][j].w);
      }
    }
    float mean[2], s2[2] = {0.f, 0.f}, rstd[2];
#pragma unroll
    for (int o = 1; o < 64; o <<= 1) { s[0] += shx(s[0], lane, o); s[1] += shx(s[1], lane, o); }
#pragma unroll
    for (int r = 0; r < 2; ++r) {
      mean[r] = s[r] * (1.f / D);
#pragma unroll
      for (int j = 0; j < 4; ++j) { v[r][j] = v[r][j] - mean[r]; s2[r] += (v[r][j].x * v[r][j].x + v[r][j].y * v[r][j].y) + (v[r][j].z * v[r][j].z + v[r][j].w * v[r][j].w); }
    }
#pragma unroll
    for (int o = 1; o < 64; o <<= 1) { s2[0] += shx(s2[0], lane, o); s2[1] += shx(s2[1], lane, o); }
#pragma unroll
    for (int r = 0; r < 2; ++r) {
      rstd[r] = 1.f / sqrtf(s2[r] * (1.f / D) + LN_EPS);
      const int n = n0 + r * NGW;
      if (n < N_TOK) {
#pragma unroll
        for (int j = 0; j < 4; ++j) {
          const f32x4 gm = ((const f32x4*)g)[lane + 64 * j], bt = ((const f32x4*)b)[lane + 64 * j];
          const f32x4 y = v[r][j] * rstd[r] * gm + bt;
          ((f32x4*)(dstf + (size_t)n * D))[lane + 64 * j] = y;
          u32x2 w; w.x = pk2(y.x, y.y); w.y = pk2(y.z, y.w);
          ((u32x2*)(dstb + (size_t)n * D))[lane + 64 * j] = w;
          if (dst2) ((f32x4*)(dst2 + (size_t)n * D))[lane + 64 * j] = y;
        }
      }
    }
  }
}

DEV void prologue(const Params& p, LAS unsigned char* lds, int wave, int lane) {
  LAS float* scr = (LAS float*)(lds + wave * 16384);
  const int gw = blockIdx.x * 8 + wave, NGW = gridDim.x * 8;
  conv_all(p, gw, NGW, scr, lane);
  const long long tid = (long long)blockIdx.x * NTHREADS + threadIdx.x, nthr = (long long)gridDim.x * NTHREADS;
  {
    const long long padw = (long long)(N_IN_PAD - N_IN) * 1024 / 8;
    for (long long i = tid; i < 2 * padw; i += nthr) {
      const int li = (int)(i / padw); const long long r = i % padw;
      ((u32x4*)(p.wt_in + ((size_t)li * N_IN_PAD + N_IN) * 1024))[r] = (u32x4){0u, 0u, 0u, 0u};
    }
    const long long padc = (long long)128 * 2048 / 8;
    for (long long i = tid; i < 4 * padc; i += nthr) {
      const int q = (int)(i / padc); const long long r = i % padc;
      ((u32x4*)(p.wt_c1 + ((size_t)q * 256 + 128) * 2048))[r] = (u32x4){0u, 0u, 0u, 0u};
    }
    if (tid < 64) p.cnt[tid] = 0;
    for (long long i = tid; i < 2LL * BATCH * NSA_G * 64; i += nthr) {
      const long long wb = i / (NSA_G * 64), r = i % (NSA_G * 64);
      p.kcb[(wb * 128 + 127) * NSA_G * 64 + r] = 0;
    }
    for (long long i = tid; i < (long long)BATCH * MEM_LEN * 1024 / 4; i += nthr) {
      const f32x4 v = ((const f32x4*)p.mem)[i];
      u32x2 w; w.x = pk2(v.x, v.y); w.y = pk2(v.z, v.w);
      ((u32x2*)p.membf)[i] = w;
    }
  }
  ln_rows_w<0>(p, p.x, p.ln0_g, p.ln0_b, p.xf, p.xb, nullptr, gw, NGW, lane);
}

struct USched {
  int nM, nN, nwg, G, c;
  int moe, nct, total; const LAS int* tile_e;
  DEV void init_static(int M, int N, int G_, int c_) { nM = M / 256; nN = N / 256; nwg = nM * nN; G = G_; c = c_; moe = 0; nct = 1; total = nwg; tile_e = nullptr; }
  DEV void init_moe(int G_, int c_, int nct_, int total_, const LAS int* te) { nM = 1; nN = 1; nwg = total_; G = G_; c = c_; moe = 1; nct = nct_; total = total_; tile_e = te; }
  DEV bool next(int i, pg8::Unit& u) const {
    const long L = (long)i * G + c;
    if (!(moe && (G & 7) == 0) && L >= total) return false;
    if (moe) {
      if ((G & 7) == 0) {
        const int xcd = c & 7, rank = c >> 3, nr = G >> 3, T = total / nct;
        const int tlo = (T * xcd) >> 3, thi = (T * (xcd + 1)) >> 3;
        const int lu = i * nr + rank;
        if (lu >= (thi - tlo) * nct) return false;
        const int rt = tlo + lu / nct, j = lu % nct;
        u.pm = rt; u.pn = tile_e[rt] * nct + j; return true;
      }
      const int rt = (int)(L / nct), j = (int)(L % nct); u.pm = rt; u.pn = tile_e[rt] * nct + j; return true;
    }
    int wgid = (int)L; { const int q = nwg / 8, r = nwg % 8, xcd = wgid % 8, off = wgid / 8; wgid = (xcd < r ? xcd * (q + 1) : r * (q + 1) + (xcd - r) * q) + off; }
    const int nig = 8 * nN, gid = wgid / nig, fm = gid * 8, gsz = (nM - fm) < 8 ? (nM - fm) : 8;
    u.pm = fm + ((wgid % nig) % gsz); u.pn = (wgid % nig) / gsz; return true;
  }
  DEV void a_ready(const pg8::Unit&) const {}
  DEV void done(const pg8::Unit&) const {}
};

enum { EM_INPROJ = 0, EM_BRCAT, EM_RES, EM_BF16, EM_MOE1, EM_MOE2, EM_HID };
#define EPI_FENCE() asm volatile("" ::: "memory")
struct EpiU {
  static constexpr bool PERM = false, AFTER_DRAIN = false;
  int mode, ldc;
  void* q0;
  const void* q1;
  const void* q2;
  const void* q3;
  const LAS int* te;
  DEV void mid(f32x4 (&acc)[2][2][4][2], const pg8::Unit& un, int wr, int wc, int t) const {
    if (mode != EM_BRCAT || (t != 4 && t != 20)) return;
    const act_t* ub = (const act_t*)q1;
    int l2;
    asm volatile("v_mbcnt_lo_u32_b32 %0, -1, 0\n\tv_mbcnt_hi_u32_b32 %0, -1, %0" : "=v"(l2));
    const int fr = l2 & 15, fq = l2 >> 4;
    const int row0 = un.pm * 256 + wr * 64 + fr, col0 = un.pn * 256 + wc * 32 + 4 * fq;
    const int goff = OFF_MG + (t == 4 ? 0 : D);
    const float L2E = -1.4426950408889634f;
#pragma unroll
    for (int ai = 0; ai < 2; ++ai)
#pragma unroll
      for (int m = 0; m < 4; ++m) {
        const int row = row0 + ai * 128 + m * 16;
#pragma unroll
        for (int bj = 0; bj < 2; ++bj)
#pragma unroll
          for (int n = 0; n < 2; ++n) {
            const int col = col0 + bj * 128 + n * 16;
            const act_t* gp = ub + (size_t)row * N_IN + goff + col;
            const u32x2 ga = *(const u32x2*)gp, gb = *(const u32x2*)(gp + D);
            const float ea0 = __builtin_amdgcn_exp2f(__uint_as_float(ga.x << 16) * L2E), ea1 = __builtin_amdgcn_exp2f(__uint_as_float(ga.x & 0xffff0000u) * L2E);
            const float ea2 = __builtin_amdgcn_exp2f(__uint_as_float(ga.y << 16) * L2E), ea3 = __builtin_amdgcn_exp2f(__uint_as_float(ga.y & 0xffff0000u) * L2E);
            const float eb0 = __builtin_amdgcn_exp2f(__uint_as_float(gb.x << 16) * L2E), eb1 = __builtin_amdgcn_exp2f(__uint_as_float(gb.x & 0xffff0000u) * L2E);
            const float eb2 = __builtin_amdgcn_exp2f(__uint_as_float(gb.y << 16) * L2E), eb3 = __builtin_amdgcn_exp2f(__uint_as_float(gb.y & 0xffff0000u) * L2E);
            f32x4& v = acc[ai][bj][m][n];
            v.x *= (1.0f + eb0) * __builtin_amdgcn_rcpf(1.0f + ea0); v.y *= (1.0f + eb1) * __builtin_amdgcn_rcpf(1.0f + ea1);
            v.z *= (1.0f + eb2) * __builtin_amdgcn_rcpf(1.0f + ea2); v.w *= (1.0f + eb3) * __builtin_amdgcn_rcpf(1.0f + ea3);
          }
        if (m == 3) EPI_FENCE();
      }
  }
  DEV void operator()(const f32x4 (&acc)[2][2][4][2], const pg8::Unit& un, int wr, int wc, int fr, int fq) const {
    {
      int l2;
      asm volatile("v_mbcnt_lo_u32_b32 %0, -1, 0\n\tv_mbcnt_hi_u32_b32 %0, -1, %0" : "=v"(l2));
      fr = l2 & 15; fq = l2 >> 4;
    }
    const int row0 = un.pm * 256 + wr * 64 + fr;
    act_t* const ob = (act_t*)q0; float* const of = (float*)q0;
    const float* const f0 = (const float*)q1; const act_t* const ub = (const act_t*)q1;
    const float* const f1 = (const float*)q2; const int* const il = (const int*)q3;
    if (mode == EM_INPROJ) {
      const int col0 = un.pn * 256 + wc * 32 + 4 * fq;
      f32x4 bv[2][2];
#pragma unroll
      for (int bj = 0; bj < 2; ++bj)
#pragma unroll
        for (int n = 0; n < 2; ++n) { const int col = col0 + bj * 128 + n * 16; bv[bj][n] = col < N_IN ? *(const f32x4*)(f0 + col) : (f32x4){0.f, 0.f, 0.f, 0.f}; }
#pragma unroll
      for (int ai = 0; ai < 2; ++ai)
#pragma unroll
        for (int m = 0; m < 4; ++m) {
          const int row = row0 + ai * 128 + m * 16;
#pragma unroll
          for (int bj = 0; bj < 2; ++bj)
#pragma unroll
            for (int n = 0; n < 2; ++n) {
              const int col = col0 + bj * 128 + n * 16;
              if (col < N_IN) {
                const f32x4 v = acc[ai][bj][m][n] + bv[bj][n];
                u32x2 w; w.x = pk2(v.x, v.y); w.y = pk2(v.z, v.w);
                *(u32x2*)(ob + (size_t)row * N_IN + col) = w;
              }
            }
        }
    } else if (mode == EM_BRCAT) {
      const int col0 = un.pn * 256 + wc * 32 + 4 * fq;
#pragma unroll
      for (int ai = 0; ai < 2; ++ai)
#pragma unroll
        for (int m = 0; m < 4; ++m) {
          const int row = row0 + ai * 128 + m * 16;
#pragma unroll
          for (int bj = 0; bj < 2; ++bj)
#pragma unroll
            for (int n = 0; n < 2; ++n) {
              const int col = col0 + bj * 128 + n * 16;
              const u32x2 gw = *(const u32x2*)(ub + (size_t)row * N_IN + OFF_MG + 2 * D + col);
              f32x4 v = acc[ai][bj][m][n];
              v.x *= fsig(__uint_as_float(gw.x << 16)); v.y *= fsig(__uint_as_float(gw.x & 0xffff0000u));
              v.z *= fsig(__uint_as_float(gw.y << 16)); v.w *= fsig(__uint_as_float(gw.y & 0xffff0000u));
              u32x2 w; w.x = pk2(v.x, v.y); w.y = pk2(v.z, v.w);
              *(u32x2*)(ob + (size_t)row * D + col) = w;
            }
          if (m == 3) EPI_FENCE();
        }
    } else if (mode == EM_RES) {
      const int col0 = un.pn * 256 + wc * 32 + 4 * fq;
#pragma unroll
      for (int ai = 0; ai < 2; ++ai)
#pragma unroll
        for (int m = 0; m < 4; ++m) {
          const int row = row0 + ai * 128 + m * 16;
#pragma unroll
          for (int bj = 0; bj < 2; ++bj)
#pragma unroll
            for (int n = 0; n < 2; ++n) {
              const int col = col0 + bj * 128 + n * 16;
              const f32x4 x = *(const f32x4*)(f0 + (size_t)row * D + col);
              *(f32x4*)(of + (size_t)row * D + col) = x * ALPHA + acc[ai][bj][m][n];
            }
          if (m == 3) EPI_FENCE();
        }
    } else if (mode == EM_BF16) {
      const int col0 = un.pn * 256 + wc * 32 + 4 * fq;
#pragma unroll
      for (int ai = 0; ai < 2; ++ai)
#pragma unroll
        for (int m = 0; m < 4; ++m) {
          const int row = row0 + ai * 128 + m * 16;
#pragma unroll
          for (int bj = 0; bj < 2; ++bj)
#pragma unroll
            for (int n = 0; n < 2; ++n) {
              const int col = col0 + bj * 128 + n * 16;
              const f32x4 v = acc[ai][bj][m][n];
              u32x2 w; w.x = pk2(v.x, v.y); w.y = pk2(v.z, v.w);
              *(u32x2*)(ob + (size_t)row * ldc + col) = w;
            }
          EPI_FENCE();
        }
    } else if (mode == EM_MOE1) {
      const int e = te[un.pm], j = un.pn & 7;
      f32x4 bg[2], bu[2];
#pragma unroll
      for (int n = 0; n < 2; ++n) {
        const int cj = j * 128 + wc * 32 + n * 16 + 4 * fq;
        bg[n] = *(const f32x4*)(f0 + (size_t)e * 2048 + cj); bu[n] = *(const f32x4*)(f0 + (size_t)e * 2048 + 1024 + cj);
      }
#pragma unroll
      for (int ai = 0; ai < 2; ++ai)
#pragma unroll
        for (int m = 0; m < 4; ++m) {
          const int row = row0 + ai * 128 + m * 16;
#pragma unroll
          for (int n = 0; n < 2; ++n) {
            const int cj = j * 128 + wc * 32 + n * 16 + 4 * fq;
            const f32x4 g = acc[ai][0][m][n] + bg[n], u = acc[ai][1][m][n] + bu[n];
            float o[4];
#pragma unroll
            for (int i = 0; i < 4; ++i) {
              const float gt = fminf(g[i], 7.0f), up = fminf(fmaxf(u[i], -7.0f), 7.0f);
              o[i] = (up + 1.0f) * gt * __builtin_amdgcn_rcpf(1.0f + __builtin_amdgcn_exp2f(-1.702f * 1.4426950408889634f * gt));
            }
            u32x2 w; w.x = pk2(o[0], o[1]); w.y = pk2(o[2], o[3]);
            *(u32x2*)(ob + (size_t)row * 1024 + cj) = w;
          }
        }
    } else if (mode == EM_MOE2) {
      const int e = te[un.pm], j = un.pn & 3;
      const int col0 = j * 256 + wc * 32 + 4 * fq;
      int aidv[8]; float gtv[8]; f32x4 bv[2][2];
#pragma unroll
      for (int bj = 0; bj < 2; ++bj)
#pragma unroll
        for (int n = 0; n < 2; ++n) bv[bj][n] = *(const f32x4*)(f0 + (size_t)e * 1024 + col0 + bj * 128 + n * 16);
#pragma unroll
      for (int r = 0; r < 8; ++r) aidv[r] = il[row0 + (r >> 2) * 128 + (r & 3) * 16];
#pragma unroll
      for (int r = 0; r < 8; ++r) gtv[r] = f1[aidv[r] >= 0 ? aidv[r] : 0];
#pragma unroll
      for (int r = 0; r < 8; ++r) {
        const int ai = r >> 2, m = r & 3;
        if (aidv[r] >= 0) {
#pragma unroll
          for (int bj = 0; bj < 2; ++bj)
#pragma unroll
            for (int n = 0; n < 2; ++n) {
              const int col = col0 + bj * 128 + n * 16;
              const f32x4 v = (acc[ai][bj][m][n] + bv[bj][n]) * gtv[r];
              u32x2 w; w.x = pk2(v.x, v.y); w.y = pk2(v.z, v.w);
              *(u32x2*)(ob + (size_t)aidv[r] * 1024 + col) = w;
            }
        }
      }
    } else if (mode == EM_HID) {
      const int col0 = wc * 32 + 4 * fq;
#pragma unroll
      for (int ai = 0; ai < 2; ++ai)
#pragma unroll
        for (int m = 0; m < 4; ++m) {
          const int row = row0 + ai * 128 + m * 16;
          if (row < CMP_ROWS) {
#pragma unroll
            for (int n = 0; n < 2; ++n) {
              const f32x4 a = acc[ai][0][m][n];
              f32x4 v;
              v.x = a.x * fsig(1.5957691216057308f * (a.x + 0.044715f * a.x * a.x * a.x)); v.y = a.y * fsig(1.5957691216057308f * (a.y + 0.044715f * a.y * a.y * a.y));
              v.z = a.z * fsig(1.5957691216057308f * (a.z + 0.044715f * a.z * a.z * a.z)); v.w = a.w * fsig(1.5957691216057308f * (a.w + 0.044715f * a.w * a.w * a.w));
              *(f32x4*)(of + (size_t)row * CMP_HID + col0 + n * 16) = v;
            }
          }
          EPI_FENCE();
        }
    }
  }
};

DEV int moe_tables(const Params& p, int li, LAS int* tab, int t32) {
  __syncthreads();
  if (t32 < NE) tab[32 + t32] = p.cnt[li * 32 + t32];
  __syncthreads();
  if (t32 < 64) {
    const int e = t32 & 31;
    const int nt = (tab[32 + e] + 255) >> 8;
    int incl = nt;
#pragma unroll
    for (int o = 1; o < 32; o <<= 1) {
      const int up = __builtin_amdgcn_ds_bpermute(((t32 - o) & 63) << 2, incl);
      if (e >= o) incl += up;
    }
    const int excl = incl - nt;
    if (t32 < 32) {
      tab[e] = excl * 256;
      for (int k = 0; k < nt; ++k) tab[128 + excl + k] = e;
      if (e == 31) tab[64] = incl;
    }
  }
  __syncthreads();
  return tab[64];
}

DEV void moe_prep(const Params& p, int li, LAS int* tab, int wave, int lane, int t32) {
  const int ntiles = moe_tables(p, li, tab, t32);
  const int gw = blockIdx.x * 8 + wave, NGW = gridDim.x * 8;
  for (int tk0 = gw; tk0 < N_TOK; tk0 += 4 * NGW) {
    u32x4 v0[4], v1[4]; int rowi[4][4];
#pragma unroll
    for (int q = 0; q < 4; ++q) {
      const int tk = (tk0 + q * NGW < N_TOK) ? tk0 + q * NGW : tk0;
      const u32x4* src = (const u32x4*)(p.xb + (size_t)tk * 1024);
      v0[q] = src[lane]; v1[q] = src[lane + 64];
#pragma unroll
      for (int k = 0; k < 4; ++k) rowi[q][k] = tab[p.topi[tk * 4 + k]] + p.rank[tk * 4 + k];
    }
#pragma unroll
    for (int q = 0; q < 4; ++q) {
      const int tk = tk0 + q * NGW;
      if (tk < N_TOK) {
#pragma unroll
        for (int k = 0; k < 4; ++k) {
          if (lane == 0) p.rowlist[rowi[q][k]] = tk * 4 + k;
          u32x4* dst = (u32x4*)(p.xg + (size_t)rowi[q][k] * 1024);
          dst[lane] = v0[q]; dst[lane + 64] = v1[q];
        }
      }
    }
  }
  const long long tid = (long long)blockIdx.x * NTHREADS + t32, nthr = (long long)gridDim.x * NTHREADS;
  for (long long r = tid; r < (long long)ntiles * 256; r += nthr) {
    const int e = tab[128 + (int)(r >> 8)];
    if ((int)r - tab[e] >= tab[32 + e]) p.rowlist[r] = -1;
  }
}

typedef short v4i16_t __attribute__((ext_vector_type(4)));
DEV v4i16_t tr_read(const LAS unsigned char* p) { return __builtin_amdgcn_ds_read_tr16_b64_v4i16((LAS v4i16_t*)p); }

constexpr int AT_ROWB = 144;
constexpr int AT_TILEB = 64 * AT_ROWB;
constexpr int AT_HALF_KV = 4 * AT_TILEB;
constexpr int AT_SLAB_OFF = 2 * AT_HALF_KV;
constexpr int AT_SLAB_WAVE = 32 * 33 * 4;
constexpr int AT_SLAB_HALF = 4 * AT_SLAB_WAVE;
constexpr int AT_XCH_OFF = AT_SLAB_OFF + 2 * AT_SLAB_HALF;
static_assert(AT_XCH_OFF + 16 <= RING_BYTES, "attention LDS map");
constexpr float SC2 = 0.125f * 1.4426950408889634f;

struct AttnState { f32x4 O[2][4]; float m[2], l[2]; };

template <bool PROB, class Job>
DEV void attn_tile(const Job& job, const LAS unsigned char* Kb, const LAS unsigned char* Vb, const bf16x8 (&qf)[2][2], AttnState& st,
                   LAS float* slab, int cur, int wih, int lane) {
  const int i15 = lane & 15, g4 = lane >> 4;
  f32x4 S[2][4];
#pragma unroll
  for (int sub = 0; sub < 2; ++sub)
#pragma unroll
    for (int t = 0; t < 4; ++t) S[sub][t] = (f32x4){0.f, 0.f, 0.f, 0.f};
#pragma unroll
  for (int t = 0; t < 4; ++t)
#pragma unroll
    for (int kk = 0; kk < 2; ++kk) {
      const bf16x8 kf = *(const LAS bf16x8*)(Kb + (16 * t + i15) * AT_ROWB + (kk * 32 + 8 * g4) * 2);
#pragma unroll
      for (int sub = 0; sub < 2; ++sub) S[sub][t] = __builtin_amdgcn_mfma_f32_16x16x32_bf16(kf, qf[sub][kk], S[sub][t], 0, 0, 0);
    }
  bf16x8 pf[2][2];
  const bool efree = job.elemfree(cur, wih);
#pragma unroll
  for (int sub = 0; sub < 2; ++sub) {
    const int row = wih * 32 + sub * 16 + i15;
    if (!efree) {
      const int mbv = job.mb(row, cur, g4);
#pragma unroll
      for (int t = 0; t < 4; ++t)
#pragma unroll
        for (int j = 0; j < 4; ++j) S[sub][t][j] = job.ok(mbv, 16 * t + j) ? S[sub][t][j] : -INFINITY;
    }
    float mx = fmaxf(fmaxf(S[sub][0][0], S[sub][0][1]), fmaxf(S[sub][0][2], S[sub][0][3]));
#pragma unroll
    for (int t = 1; t < 4; ++t) mx = fmaxf(fmaxf(mx, fmaxf(S[sub][t][0], S[sub][t][1])), fmaxf(S[sub][t][2], S[sub][t][3]));
    if (!PROB) {
      mx = fmaxf(mx, shx(mx, lane, 16));
      mx = fmaxf(mx, shx(mx, lane, 32));
      const bool rok = job.rowok(sub, cur);
      const float mcand = rok ? mx * SC2 : -INFINITY;
      const float mnew = fmaxf(st.m[sub], mcand);
      const float msafe = (mnew == -INFINITY) ? 0.f : mnew;
      const float corr = __builtin_amdgcn_exp2f(st.m[sub] - msafe);
      st.m[sub] = mnew;
      const float msub = rok ? msafe : INFINITY;
      float psum = 0.f;
#pragma unroll
      for (int t = 0; t < 4; ++t)
#pragma unroll
        for (int j = 0; j < 4; ++j) { const float pp = __builtin_amdgcn_exp2f(__builtin_fmaf(S[sub][t][j], SC2, -msub)); S[sub][t][j] = pp; psum += pp; }
      st.l[sub] = st.l[sub] * corr + psum;
      if (__builtin_amdgcn_ballot_w64(corr != 1.0f) != 0ull) {
#pragma unroll
        for (int dt = 0; dt < 4; ++dt) st.O[sub][dt] *= corr;
      }
#pragma unroll
      for (int s2 = 0; s2 < 2; ++s2) {
        u32x4 w;
        w.x = pk2(S[sub][2 * s2][0], S[sub][2 * s2][1]); w.y = pk2(S[sub][2 * s2][2], S[sub][2 * s2][3]);
        w.z = pk2(S[sub][2 * s2 + 1][0], S[sub][2 * s2 + 1][1]); w.w = pk2(S[sub][2 * s2 + 1][2], S[sub][2 * s2 + 1][3]);
        pf[sub][s2] = __builtin_bit_cast(bf16x8, w);
      }
    } else {
      const float msafe = (st.m[sub] == -INFINITY) ? 0.f : st.m[sub];
      const int q = sub * 16 + i15;
#pragma unroll
      for (int t = 0; t < 4; ++t) {
        const float p0 = __builtin_amdgcn_exp2f(__builtin_fmaf(S[sub][t][0], SC2, -msafe)) * st.l[sub], p1 = __builtin_amdgcn_exp2f(__builtin_fmaf(S[sub][t][1], SC2, -msafe)) * st.l[sub];
        const float p2 = __builtin_amdgcn_exp2f(__builtin_fmaf(S[sub][t][2], SC2, -msafe)) * st.l[sub], p3 = __builtin_amdgcn_exp2f(__builtin_fmaf(S[sub][t][3], SC2, -msafe)) * st.l[sub];
        const int jb = 16 * cur + 4 * t + g4;
        slab[q * 33 + jb] += (p0 + p1) + (p2 + p3);
        S[sub][t][3] = p3;
      }
      asm volatile("s_waitcnt lgkmcnt(0)" ::: "memory");
#pragma unroll
      for (int t = 0; t < 4; ++t) {
        const int jb = 16 * cur + 4 * t + g4 + 1;
        if (jb < 32) slab[q * 33 + jb] += S[sub][t][3];
      }
      asm volatile("s_waitcnt lgkmcnt(0)" ::: "memory");
    }
  }
  if (!PROB) {
#pragma unroll
    for (int dt = 0; dt < 4; ++dt)
#pragma unroll
      for (int s2 = 0; s2 < 2; ++s2) {
        const LAS unsigned char* vp = Vb + (32 * s2 + 4 * g4 + (i15 >> 2)) * AT_ROWB + (16 * dt + 4 * (lane & 3)) * 2;
        const v4i16_t lo = tr_read(vp), hi = tr_read(vp + 16 * AT_ROWB);
        bf16x8 vf;
        vf[0] = lo[0]; vf[1] = lo[1]; vf[2] = lo[2]; vf[3] = lo[3]; vf[4] = hi[0]; vf[5] = hi[1]; vf[6] = hi[2]; vf[7] = hi[3];
#pragma unroll
        for (int sub = 0; sub < 2; ++sub) st.O[sub][dt] = __builtin_amdgcn_mfma_f32_16x16x32_bf16(vf, pf[sub][s2], st.O[sub][dt], 0, 0, 0);
      }
  }
}

DEV void half_barrier(LAS unsigned* cnt, int lane) {
  asm volatile("s_waitcnt lgkmcnt(0)" ::: "memory");
  unsigned old = 0;
  if (lane == 0) old = __hip_atomic_fetch_add(cnt, 1u, __ATOMIC_RELAXED, __HIP_MEMORY_SCOPE_WORKGROUP);
  old = (unsigned)__builtin_amdgcn_readfirstlane((int)old);
  const unsigned target = (old / 4u + 1u) * 4u;
  while ((int)(__hip_atomic_load(cnt, __ATOMIC_RELAXED, __HIP_MEMORY_SCOPE_WORKGROUP) - target) < 0) __builtin_amdgcn_s_sleep(1);
  asm volatile("" ::: "memory");
}

template <bool PROB, class Job>
DEV void attn_run(const Job& job, LAS unsigned char* lds, AttnState& st, int half, int hth, int wih, int lane) {
  LAS unsigned char* kvh = lds + half * AT_HALF_KV;
  LAS unsigned* hb = (LAS unsigned*)(lds + MISC_OFF + 8192 + 128) + half * 16;
  LAS float* slab = (LAS float*)(lds + AT_SLAB_OFF + half * AT_SLAB_HALF + wih * AT_SLAB_WAVE);
  const int i15 = lane & 15, g4 = lane >> 4;
  unsigned rem = job.tilemask();
  bf16x8 qf[2][2];
#pragma unroll
  for (int sub = 0; sub < 2; ++sub) {
    const act_t* qr = job.qrow(wih * 32 + sub * 16 + i15);
#pragma unroll
    for (int kk = 0; kk < 2; ++kk) qf[sub][kk] = *(const bf16x8*)(qr + kk * 32 + 8 * g4);
  }
  if (!PROB) {
#pragma unroll
    for (int sub = 0; sub < 2; ++sub) {
      st.m[sub] = -INFINITY; st.l[sub] = 0.f;
#pragma unroll
      for (int dt = 0; dt < 4; ++dt) st.O[sub][dt] = (f32x4){0.f, 0.f, 0.f, 0.f};
    }
  }
  const int srow = hth >> 2, sch = hth & 3;
  u32x4 ak0, ak1, av0, av1;
#define AT_LOAD(k0, k1, v0, v1, T) do { const act_t* kr_ = job.krow(T, srow) + sch * 16; k0 = *(const u32x4*)kr_; k1 = *(const u32x4*)(kr_ + 8); \
    if (!PROB) { const act_t* vr_ = job.vrow(T, srow) + sch * 16; v0 = *(const u32x4*)vr_; v1 = *(const u32x4*)(vr_ + 8); } } while (0)
#define AT_WRITE(k0, k1, v0, v1, BUF) do { LAS unsigned char* kd_ = kvh + (BUF) * AT_TILEB + srow * AT_ROWB + sch * 32; *(LAS u32x4*)kd_ = k0; *(LAS u32x4*)(kd_ + 16) = k1; \
    if (!PROB) { LAS unsigned char* vd_ = kvh + (2 + (BUF)) * AT_TILEB + srow * AT_ROWB + sch * 32; *(LAS u32x4*)vd_ = v0; *(LAS u32x4*)(vd_ + 16) = v1; } } while (0)
#define AT_NEXT(T) do { T = -1; if (rem) { T = __builtin_ctz(rem); rem &= rem - 1; } } while (0)
  int t0;
  AT_NEXT(t0);
  if (t0 >= 0) { AT_LOAD(ak0, ak1, av0, av1, t0); AT_WRITE(ak0, ak1, av0, av1, 0); }
  half_barrier(hb, lane);
  for (int it = 0; t0 >= 0; ++it) {
    int t1;
    AT_NEXT(t1);
    if (t1 >= 0) AT_LOAD(ak0, ak1, av0, av1, t1);
    attn_tile<PROB>(job, kvh + (it & 1) * AT_TILEB, kvh + (2 + (it & 1)) * AT_TILEB, qf, st, slab, t0, wih, lane);
    if (t1 >= 0) AT_WRITE(ak0, ak1, av0, av1, (it + 1) & 1);
    half_barrier(hb, lane);
    t0 = t1;
  }
#undef AT_LOAD
#undef AT_WRITE
#undef AT_NEXT
  if (!PROB) {
#pragma unroll
    for (int sub = 0; sub < 2; ++sub) {
      float l = st.l[sub];
      l += shx(l, lane, 16);
      l += shx(l, lane, 32);
      const float inv = 1.0f / fmaxf(l, 1e-30f);
      st.l[sub] = l;
#pragma unroll
      for (int dt = 0; dt < 4; ++dt) st.O[sub][dt] *= inv;
    }
  }
}

struct SelJob {
  const act_t* u; int b, g, t0; unsigned um; unsigned tm[2];
  DEV unsigned tilemask() const { return um; }
  DEV const act_t* qrow(int r) const { return u + ((size_t)b * SEQ + t0 + (r & 31)) * N_IN + OFF_CQ + (g * 4 + (r >> 5)) * 64; }
  DEV const act_t* krow(int kt, int j) const { return u + ((size_t)b * SEQ + kt * 64 + j) * N_IN + OFF_CKS + g * 64; }
  DEV const act_t* vrow(int kt, int j) const { return u + ((size_t)b * SEQ + kt * 64 + j) * N_IN + OFF_CVS + g * 64; }
  DEV int mb(int r, int kt, int g4) const { return t0 + (r & 31) - kt * 64 - 4 * g4; }
  DEV bool rowok(int sub, int kt) const { return (tm[sub] >> kt) & 1u; }
  DEV bool ok(int m, int C) const { return m >= C; }
  DEV bool elemfree(int kt, int wih) const { return kt < (t0 >> 6); }
};
struct WinJob {
  const act_t* u; int b, g, t0; unsigned um;
  DEV unsigned tilemask() const { return um; }
  DEV const act_t* qrow(int r) const { return u + ((size_t)b * SEQ + t0 + (r & 31)) * N_IN + OFF_CQ + (g * 4 + (r >> 5)) * 64; }
  DEV const act_t* krow(int kt, int j) const { return u + ((size_t)b * SEQ + kt * 64 + j) * N_IN + OFF_CKW + g * 64; }
  DEV const act_t* vrow(int kt, int j) const { return u + ((size_t)b * SEQ + kt * 64 + j) * N_IN + OFF_CVW + g * 64; }
  DEV int mb(int r, int kt, int g4) const { return t0 + (r & 31) - kt * 64 - 4 * g4; }
  DEV bool rowok(int sub, int kt) const { return true; }
  DEV bool ok(int m, int C) const { return m >= C && m < NSA_WIN + C; }
  DEV bool elemfree(int kt, int wih) const { return kt * 64 + 63 <= t0 && t0 + 31 - kt * 64 < NSA_WIN; }
};
struct CmpJob {
  const act_t* u; const act_t* kcb; const act_t* vcb; int b, g, t0; unsigned um;
  DEV unsigned tilemask() const { return um; }
  DEV const act_t* qrow(int r) const { return u + ((size_t)b * SEQ + t0 + (r & 31)) * N_IN + OFF_CQ + (g * 4 + (r >> 5)) * 64; }
  DEV const act_t* krow(int kt, int j) const { return kcb + (((size_t)b * 128 + kt * 64 + j) * NSA_G + g) * 64; }
  DEV const act_t* vrow(int kt, int j) const { return vcb + (((size_t)b * 128 + kt * 64 + j) * NSA_G + g) * 64; }
  DEV int mb(int r, int kt, int g4) const { return t0 + (r & 31) - 31 - 16 * (kt * 64 + 4 * g4); }
  DEV bool rowok(int sub, int kt) const { return true; }
  DEV bool ok(int m, int C) const { return m >= 16 * C; }
  DEV bool elemfree(int kt, int wih) const { return kt == 0 && 16 * 63 + 31 <= t0; }
};
struct DilJob {
  const act_t* u; int b, col, dil, res, l0; unsigned um;
  DEV unsigned tilemask() const { return um; }
  DEV const act_t* qrow(int r) const { return u + ((size_t)b * SEQ + (l0 + r) * dil + res) * N_IN + OFF_AQ + col; }
  DEV const act_t* krow(int kt, int j) const { return u + ((size_t)b * SEQ + (kt * 64 + j) * dil + res) * N_IN + OFF_AK + col; }
  DEV const act_t* vrow(int kt, int j) const { return u + ((size_t)b * SEQ + (kt * 64 + j) * dil + res) * N_IN + OFF_AV + col; }
  DEV int mb(int r, int kt, int g4) const { return l0 + r - kt * 64 - 4 * g4; }
  DEV bool rowok(int sub, int kt) const { return true; }
  DEV bool ok(int m, int C) const { return m >= C && m <= 128 + C; }
  DEV bool elemfree(int kt, int wih) const { return kt * 64 + 63 <= l0 + 32 * wih && l0 + 32 * wih + 31 - kt * 64 <= 128; }
};

DEV unsigned range_mask(int lo, int hi) {
  return (hi >= 31 ? 0xffffffffu : ((1u << (hi + 1)) - 1u)) & ~((1u << lo) - 1u);
}

DEV bool nsa_unit(int round, int bid, int G, int half, int& b, int& g, int& tb) {
  if ((G & 7) == 0) {
    const int nr = G >> 3, rank = bid >> 3;
    const int slot = rank * 2 + half, nslot = nr * 2;
    const int pos = (round & 1) ? (nslot - 1 - slot) : slot;
    const int lu = round * nslot + pos;
    if (lu >= 256) return false;
    b = bid & 7; g = lu & 3; tb = 63 - (lu >> 2);
    return true;
  }
  const int pos = (round & 1) ? (G - 1 - bid) : bid;
  const int pair = round * G + pos;
  if (pair >= 1024) return false;
  const int un = pair * 2 + half;
  tb = 63 - un / 32; b = (un % 32) / 4; g = un % 4;
  return true;
}
DEV int nsa_rounds(int G) { return (G & 7) == 0 ? (256 + (G >> 3) * 2 - 1) / ((G >> 3) * 2) : (1024 + G - 1) / G; }

DEV void nsa_cmp_phase(const Params& p, LAS unsigned char* lds, int t32, int bid, int G) {
  const int lane = t32 & 63, wave = t32 >> 6, half = wave >> 2, wih = wave & 3, hth = t32 & 255;
  const int i15 = lane & 15, g4 = lane >> 4;
  LAS float* slabh = (LAS float*)(lds + AT_SLAB_OFF + half * AT_SLAB_HALF);
  for (int round = 0; round < nsa_rounds(G); ++round) {
    int b = 0, g = 0, tb = 0;
    const bool act = nsa_unit(round, bid, G, half, b, g, tb);
    const int t0 = tb * 32;
    const int nvmax = t0 + 31 >= 31 ? (t0 + 31 - 31) / 16 + 1 : 0;
    CmpJob job{p.u, p.kcb, p.kcb + (size_t)BATCH * 128 * NSA_G * 64, b, g, t0, 0u};
    job.um = !act ? 0u : (nvmax > 64 ? 3u : (nvmax > 0 ? 1u : 0u));
    for (int i = lane; i < 32 * 33; i += 64) slabh[wih * (32 * 33) + i] = 0.f;
    LAS unsigned char* kvh = lds + half * AT_HALF_KV;
    LAS unsigned* hb = (LAS unsigned*)(lds + MISC_OFF + 8192 + 128) + half * 16;
    LAS float* slab = slabh + wih * (32 * 33);
    {
      const int srow = hth >> 2, sch = hth & 3;
#pragma unroll
      for (int tl = 0; tl < 2; ++tl)
        if ((job.um >> tl) & 1u) {
          const act_t* kr = job.krow(tl, srow) + sch * 16; const act_t* vr = job.vrow(tl, srow) + sch * 16;
          const u32x4 k0 = *(const u32x4*)kr, k1 = *(const u32x4*)(kr + 8), v0 = *(const u32x4*)vr, v1 = *(const u32x4*)(vr + 8);
          LAS unsigned char* kd = kvh + tl * AT_TILEB + srow * AT_ROWB + sch * 32;
          *(LAS u32x4*)kd = k0; *(LAS u32x4*)(kd + 16) = k1;
          LAS unsigned char* vd = kvh + (2 + tl) * AT_TILEB + srow * AT_ROWB + sch * 32;
          *(LAS u32x4*)vd = v0; *(LAS u32x4*)(vd + 16) = v1;
        }
    }
    bf16x8 qf[2][2];
#pragma unroll
    for (int sub = 0; sub < 2; ++sub) {
      const act_t* qr = job.qrow(wih * 32 + sub * 16 + i15);
#pragma unroll
      for (int kk = 0; kk < 2; ++kk) qf[sub][kk] = *(const bf16x8*)(qr + kk * 32 + 8 * g4);
    }
    AttnState st;
#pragma unroll
    for (int sub = 0; sub < 2; ++sub) {
      st.m[sub] = -INFINITY; st.l[sub] = 0.f;
#pragma unroll
      for (int dt = 0; dt < 4; ++dt) st.O[sub][dt] = (f32x4){0.f, 0.f, 0.f, 0.f};
    }
    half_barrier(hb, lane);
    if (job.um & 1u) attn_tile<false>(job, kvh, kvh + 2 * AT_TILEB, qf, st, slab, 0, wih, lane);
    if (job.um & 2u) attn_tile<false>(job, kvh + AT_TILEB, kvh + 3 * AT_TILEB, qf, st, slab, 1, wih, lane);
#pragma unroll
    for (int sub = 0; sub < 2; ++sub) {
      float l = st.l[sub];
      l += shx(l, lane, 16);
      l += shx(l, lane, 32);
      const float inv = 1.0f / fmaxf(l, 1e-30f);
      st.l[sub] = inv;
#pragma unroll
      for (int dt = 0; dt < 4; ++dt) st.O[sub][dt] *= inv;
    }
    if (act) {
#pragma unroll
      for (int sub = 0; sub < 2; ++sub) {
        const int hh = g * 4 + wih;
        const size_t n = (size_t)b * SEQ + t0 + sub * 16 + i15;
        const float g0 = fsig(ldf(p.u[n * N_IN + OFF_CG + hh * 3 + 0]));
#pragma unroll
        for (int dt = 0; dt < 4; ++dt) { const f32x4 y = st.O[sub][dt] * g0; u32x2 w; w.x = pk2(y.x, y.y); w.y = pk2(y.z, y.w); *(u32x2*)((act_t*)p.ocmp + n * 1024 + hh * 64 + 16 * dt + 4 * g4) = w; }
      }
    }
    if (job.um & 1u) attn_tile<true>(job, kvh, kvh + 2 * AT_TILEB, qf, st, slab, 0, wih, lane);
    if (job.um & 2u) attn_tile<true>(job, kvh + AT_TILEB, kvh + 3 * AT_TILEB, qf, st, slab, 1, wih, lane);
    half_barrier(hb, lane);
    {
      const int q = hth >> 3, j4 = (hth & 7) * 4;
      float v[4];
#pragma unroll
      for (int i = 0; i < 4; ++i) {
        float s = 0.f;
#pragma unroll
        for (int w = 0; w < 4; ++w) s += slabh[w * (32 * 33) + q * 33 + j4 + i];
        const int j = j4 + i, qb = (t0 + q) >> 6;
        if (j == 0 || j == qb || j == qb - 1) s = INFINITY;
        else if (j > qb) s = -INFINITY;
        v[i] = s;
      }
      __syncthreads();
#pragma unroll
      for (int i = 0; i < 4; ++i) slabh[q * 33 + j4 + i] = v[i];
      __syncthreads();
      unsigned bits = 0u;
#pragma unroll
      for (int i = 0; i < 4; ++i) {
        int rank = 0;
#pragma unroll 8
        for (int jj = 0; jj < 32; ++jj) { const float w = slabh[q * 33 + jj]; rank += (w > v[i] || (w == v[i] && jj < j4 + i)) ? 1 : 0; }
        if (rank < N_SELECT) bits |= 1u << (j4 + i);
      }
      bits |= (unsigned)shxi((int)bits, lane, 1);
      bits |= (unsigned)shxi((int)bits, lane, 2);
      bits |= (unsigned)shxi((int)bits, lane, 4);
      if (act && (hth & 7) == 0) p.selm[((size_t)b * NSA_G + g) * SEQ + t0 + q] = bits;
      __syncthreads();
    }
  }
}

DEV void nsa_main_phase(const Params& p, LAS unsigned char* lds, int t32, int bid, int G) {
  const int lane = t32 & 63, wave = t32 >> 6, half = wave >> 2, wih = wave & 3, hth = t32 & 255;
  const int i15 = lane & 15, g4 = lane >> 4;
#define NSTAMP(i) do { if (GSEG >= 10 && blockIdx.x == 0 && t32 == 0) { const unsigned now_ = (unsigned)__builtin_amdgcn_s_memrealtime(); if ((i) > 0 && (i) - 1 + 10 == GSEG) p.barw[3600] += now_ - ns_prev; ns_prev = now_; } } while (0)
  unsigned ns_prev = 0u;
  for (int round2 = 0; round2 < nsa_rounds(G) * (NSA_PROBE == 5 ? 2 : 1); ++round2) {
    const int round = (NSA_PROBE == 5) ? (round2 >> 1) : round2;
    NSTAMP(0);
    int b = 0, g = 0, tb = 0;
    const bool act = nsa_unit(round, bid, G, half, b, g, tb);
    const int t0 = tb * 32;
    SelJob sj{p.u, b, g, t0, 0u, {0u, 0u}};
    if (act) {
      const unsigned* sm = p.selm + ((size_t)b * NSA_G + g) * SEQ + t0;
      sj.tm[0] = sm[i15]; sj.tm[1] = sm[16 + i15];
      unsigned um = sj.tm[0] | sj.tm[1];
      int l2 = lane;
      asm volatile("" : "+v"(l2));
      um |= (unsigned)shxi((int)um, l2, 1); um |= (unsigned)shxi((int)um, l2, 2);
      um |= (unsigned)shxi((int)um, l2, 4); um |= (unsigned)shxi((int)um, l2, 8);
      sj.um = um & range_mask(0, t0 >> 6);
    }
    u32x2 base[2][4];
    const int hh = g * 4 + wih;
    const size_t nrow0 = (size_t)b * SEQ + t0 + i15;
    const act_t gq10 = p.u[nrow0 * N_IN + OFF_CG + hh * 3 + 1], gq11 = p.u[(nrow0 + 16) * N_IN + OFF_CG + hh * 3 + 1];
    const act_t gq20 = p.u[nrow0 * N_IN + OFF_CG + hh * 3 + 2], gq21 = p.u[(nrow0 + 16) * N_IN + OFF_CG + hh * 3 + 2];
    {
      AttnState ss;
      NSTAMP(1);
      attn_run<false>(sj, lds, ss, half, hth, wih, lane);
      NSTAMP(2);
#if NSA_PROBE == 1
      attn_run<false>(sj, lds, ss, half, hth, wih, lane);
#endif
#pragma unroll
      for (int sub = 0; sub < 2; ++sub) {
        f32x4 oc[4];
#pragma unroll
        for (int dt = 0; dt < 4; ++dt) {
          const u32x2 cw = *(const u32x2*)((const act_t*)p.ocmp + (nrow0 + 16 * sub) * 1024 + hh * 64 + 16 * dt + 4 * g4);
          oc[dt] = (f32x4){__uint_as_float(cw.x << 16), __uint_as_float(cw.x & 0xffff0000u), __uint_as_float(cw.y << 16), __uint_as_float(cw.y & 0xffff0000u)};
        }
        const float g1 = fsig(ldf(sub ? gq11 : gq10));
#pragma unroll
        for (int dt = 0; dt < 4; ++dt) {
          const f32x4 y = ss.O[sub][dt] * g1 + oc[dt];
          base[sub][dt].x = pk2(y.x, y.y); base[sub][dt].y = pk2(y.z, y.w);
        }
      }
    }
    WinJob wj{p.u, b, g, t0, 0u};
    if (act) { const int lo = t0 - (NSA_WIN - 1) < 0 ? 0 : (t0 - (NSA_WIN - 1)) >> 6; wj.um = range_mask(lo, (t0 + 31) >> 6); }
    AttnState ws;
    NSTAMP(3);
    attn_run<false>(wj, lds, ws, half, hth, wih, lane);
    NSTAMP(4);
#if NSA_PROBE == 2
    attn_run<false>(wj, lds, ws, half, hth, wih, lane);
#endif
    if (act) {
#pragma unroll
      for (int sub = 0; sub < 2; ++sub) {
        const size_t n = nrow0 + 16 * sub;
        const float g2 = fsig(ldf(sub ? gq21 : gq20));
#pragma unroll
        for (int dt = 0; dt < 4; ++dt) {
          const u32x2 bw = base[sub][dt];
          f32x4 y = ws.O[sub][dt] * g2;
          y.x += __uint_as_float(bw.x << 16); y.y += __uint_as_float(bw.x & 0xffff0000u);
          y.z += __uint_as_float(bw.y << 16); y.w += __uint_as_float(bw.y & 0xffff0000u);
          u32x2 w; w.x = pk2(y.x, y.y); w.y = pk2(y.z, y.w);
          *(u32x2*)(p.yc + n * YLD + hh * 64 + 16 * dt + 4 * g4) = w;
        }
      }
    }
  }
}

DEV void dil_phase(const Params& p, LAS unsigned char* lds, int t32, int bid, int G) {
  const int lane = t32 & 63, wave = t32 >> 6, half = wave >> 2, wih = wave & 3, hth = t32 & 255;
  const int i15 = lane & 15, g4 = lane >> 4;
  const bool xm = (G & 7) == 0;
  const int npair = xm ? 96 : 768, pstep = xm ? (G >> 3) : G;
  for (int pair = xm ? (bid >> 3) : bid; pair < npair; pair += pstep) {
    const int un = pair * 2 + half;
    int gi, b, r2;
    if (xm) { b = bid & 7; gi = un / 64; r2 = un % 64; }
    else { gi = un / 512; const int r = un % 512; b = r / 64; r2 = r % 64; }
    const int dil = gi == 0 ? 1 : (gi == 1 ? 4 : 16);
    const int nlb = 16 / dil;
    const int h = r2 / 16, r3 = r2 % 16;
    const int res = r3 / nlb, lb = r3 % nlb;
    const int l0 = lb * 128;
    DilJob job{p.u, b, gi * 256 + h * 64, dil, res, l0, 0u};
    job.um = range_mask(l0 >= 128 ? (l0 - 128) >> 6 : 0, (l0 + 127) >> 6);
    AttnState st;
    attn_run<false>(job, lds, st, half, hth, wih, lane);
#pragma unroll
    for (int sub = 0; sub < 2; ++sub) {
      const int l = l0 + wih * 32 + sub * 16 + i15;
      const size_t n = (size_t)b * SEQ + l * dil + res;
#pragma unroll
      for (int dt = 0; dt < 4; ++dt) {
        const f32x4 y = st.O[sub][dt];
        u32x2 w; w.x = pk2(y.x, y.y); w.y = pk2(y.z, y.w);
        *(u32x2*)(p.dilo + ((size_t)gi * N_TOK + n) * 256 + h * 64 + 16 * dt + 4 * g4) = w;
      }
      if (g4 == 0) p.dill[((size_t)gi * N_TOK + n) * 4 + h] = st.m[sub] + __builtin_amdgcn_logf(st.l[sub]);
    }
  }
}

DEV void dil_combine(const Params& p, long long tid, long long nthr) {
  for (long long idx = tid; idx < (long long)N_TOK * 32; idx += nthr) {
    const size_t n = idx >> 5; const int c8 = (int)(idx & 31) * 8, h = c8 >> 6;
    const float l0 = p.dill[((size_t)0 * N_TOK + n) * 4 + h], l1 = p.dill[((size_t)1 * N_TOK + n) * 4 + h], l2 = p.dill[((size_t)2 * N_TOK + n) * 4 + h];
    const float mx = fmaxf(l0, fmaxf(l1, l2));
    float w0 = __builtin_amdgcn_exp2f(l0 - mx), w1 = __builtin_amdgcn_exp2f(l1 - mx), w2 = __builtin_amdgcn_exp2f(l2 - mx);
    const float inv = 1.0f / (w0 + w1 + w2);
    w0 *= inv; w1 *= inv; w2 *= inv;
    const u32x4 a = *(const u32x4*)(p.dilo + ((size_t)0 * N_TOK + n) * 256 + c8);
    const u32x4 bq = *(const u32x4*)(p.dilo + ((size_t)1 * N_TOK + n) * 256 + c8);
    const u32x4 c = *(const u32x4*)(p.dilo + ((size_t)2 * N_TOK + n) * 256 + c8);
    u32x4 o;
#pragma unroll
    for (int i = 0; i < 4; ++i) {
      const float lo = w0 * __uint_as_float(a[i] << 16) + w1 * __uint_as_float(bq[i] << 16) + w2 * __uint_as_float(c[i] << 16);
      const float hi = w0 * __uint_as_float(a[i] & 0xffff0000u) + w1 * __uint_as_float(bq[i] & 0xffff0000u) + w2 * __uint_as_float(c[i] & 0xffff0000u);
      o[i] = pk2(lo, hi);
    }
    *(u32x4*)(p.ya + n * YLD + c8) = o;
  }
}

DEV void cmpa_build(const Params& p, int li, long long tid, long long nthr) {
  for (long long idx = tid; idx < 2LL * CMP_ROWS * 256; idx += nthr) {
    const int which = (int)(idx / ((long long)CMP_ROWS * 256));
    const long long rem = idx % ((long long)CMP_ROWS * 256);
    const int row = (int)(rem >> 8), c8 = (int)(rem & 255) * 8, l = c8 >> 6, d = c8 & 63;
    const int g = row % NSA_G, c = (row / NSA_G) % N_CMP, b = row / (NSA_G * N_CMP);
    const float* pe = (which ? p.cmp_pe_v : p.cmp_pe_k) + (size_t)li * 32 * HD + l * HD + d;
    const u32x4 uv = *(const u32x4*)(p.u + ((size_t)b * SEQ + c * 16 + l) * N_IN + (which ? OFF_CVC : OFF_CKC) + g * HD + d);
    u32x4 o;
#pragma unroll
    for (int i = 0; i < 4; ++i) o[i] = pk2(__uint_as_float(uv[i] << 16) + pe[2 * i], __uint_as_float(uv[i] & 0xffff0000u) + pe[2 * i + 1]);
    *(u32x4*)(p.cmpA + ((size_t)which * CMP_ROWS_PAD + row) * 2048 + c8) = o;
  }
}

constexpr int XA_ROWB = 528;
constexpr int XA_TILEB = 32 * XA_ROWB;
static_assert(4 * XA_TILEB <= RING_BYTES, "xattn LDS map");
DEV void xattn_phase(const Params& p, LAS unsigned char* lds, int t32, int bid, int G) {
  const int lane = t32 & 63, wave = t32 >> 6, i15 = lane & 15, g4 = lane >> 4;
  const float sc2 = 0.0625f * 1.4426950408889634f;
  const bool xm = (G & 7) == 0;
  const int nun = xm ? XH * (SEQ / 128) : BATCH * XH * (SEQ / 128), ustep = xm ? (G >> 3) : G;
  for (int un = xm ? (bid >> 3) : bid; un < nun; un += ustep) {
    const int b = xm ? (bid & 7) : un / (XH * (SEQ / 128)), r = un % (XH * (SEQ / 128)), h = r / (SEQ / 128), qb = r % (SEQ / 128);
    const size_t nq = (size_t)b * SEQ + qb * 128 + wave * 16 + i15;
    bf16x8 qf[8];
#pragma unroll
    for (int kk = 0; kk < 8; ++kk) qf[kk] = *(const bf16x8*)(p.xq + nq * 1024 + h * 256 + kk * 32 + 8 * g4);
    f32x4 O[16];
#pragma unroll
    for (int dt = 0; dt < 16; ++dt) O[dt] = (f32x4){0.f, 0.f, 0.f, 0.f};
    float m = -INFINITY, l = 0.f;
    const int srow = t32 >> 4, sch = t32 & 15;
    const act_t* kbase = p.memk + ((size_t)b * MEM_LEN + srow) * 1024 + h * 256 + sch * 16;
    const act_t* vbase = p.memv + ((size_t)b * MEM_LEN + srow) * 1024 + h * 256 + sch * 16;
    u32x4 sk0 = *(const u32x4*)kbase, sk1 = *(const u32x4*)(kbase + 8), sv0 = *(const u32x4*)vbase, sv1 = *(const u32x4*)(vbase + 8);
    {
      LAS unsigned char* kd = lds + srow * XA_ROWB + sch * 32;
      *(LAS u32x4*)kd = sk0; *(LAS u32x4*)(kd + 16) = sk1;
      LAS unsigned char* vd = lds + 2 * XA_TILEB + srow * XA_ROWB + sch * 32;
      *(LAS u32x4*)vd = sv0; *(LAS u32x4*)(vd + 16) = sv1;
    }
    __syncthreads();
    for (int it = 0; it < MEM_LEN / 32; ++it) {
      if (it + 1 < MEM_LEN / 32) {
        const act_t* kr = kbase + (size_t)(it + 1) * 32 * 1024, *vr = vbase + (size_t)(it + 1) * 32 * 1024;
        sk0 = *(const u32x4*)kr; sk1 = *(const u32x4*)(kr + 8); sv0 = *(const u32x4*)vr; sv1 = *(const u32x4*)(vr + 8);
      }
      const LAS unsigned char* Kb = lds + (it & 1) * XA_TILEB;
      const LAS unsigned char* Vb = lds + (2 + (it & 1)) * XA_TILEB;
      f32x4 S[2];
      S[0] = (f32x4){0.f, 0.f, 0.f, 0.f}; S[1] = (f32x4){0.f, 0.f, 0.f, 0.f};
#pragma unroll
      for (int t = 0; t < 2; ++t)
#pragma unroll
        for (int kk = 0; kk < 8; ++kk) {
          const bf16x8 kf = *(const LAS bf16x8*)(Kb + (16 * t + i15) * XA_ROWB + (kk * 32 + 8 * g4) * 2);
          S[t] = __builtin_amdgcn_mfma_f32_16x16x32_bf16(kf, qf[kk], S[t], 0, 0, 0);
        }
      float mx = -INFINITY;
#pragma unroll
      for (int t = 0; t < 2; ++t)
#pragma unroll
        for (int j = 0; j < 4; ++j) { S[t][j] *= sc2; mx = fmaxf(mx, S[t][j]); }
      mx = fmaxf(mx, shx(mx, lane, 16));
      mx = fmaxf(mx, shx(mx, lane, 32));
      const float mnew = fmaxf(m, mx);
      const float corr = __builtin_amdgcn_exp2f(m - mnew);
      m = mnew;
      float psum = 0.f;
#pragma unroll
      for (int t = 0; t < 2; ++t)
#pragma unroll
        for (int j = 0; j < 4; ++j) { const float pp = __builtin_amdgcn_exp2f(S[t][j] - mnew); S[t][j] = pp; psum += pp; }
      l = l * corr + psum;
      u32x4 w;
      w.x = pk2(S[0][0], S[0][1]); w.y = pk2(S[0][2], S[0][3]); w.z = pk2(S[1][0], S[1][1]); w.w = pk2(S[1][2], S[1][3]);
      const bf16x8 pf = __builtin_bit_cast(bf16x8, w);
#pragma unroll
      for (int dt = 0; dt < 16; ++dt) {
        const LAS unsigned char* vp = Vb + (4 * g4 + (i15 >> 2)) * XA_ROWB + (16 * dt + 4 * (lane & 3)) * 2;
        const v4i16_t lo = tr_read(vp), hi = tr_read(vp + 16 * XA_ROWB);
        bf16x8 vf;
        vf[0] = lo[0]; vf[1] = lo[1]; vf[2] = lo[2]; vf[3] = lo[3]; vf[4] = hi[0]; vf[5] = hi[1]; vf[6] = hi[2]; vf[7] = hi[3];
        O[dt] = __builtin_amdgcn_mfma_f32_16x16x32_bf16(vf, pf, O[dt] * corr, 0, 0, 0);
      }
      if (it + 1 < MEM_LEN / 32) {
        LAS unsigned char* kd = lds + ((it + 1) & 1) * XA_TILEB + srow * XA_ROWB + sch * 32;
        *(LAS u32x4*)kd = sk0; *(LAS u32x4*)(kd + 16) = sk1;
        LAS unsigned char* vd = lds + (2 + ((it + 1) & 1)) * XA_TILEB + srow * XA_ROWB + sch * 32;
        *(LAS u32x4*)vd = sv0; *(LAS u32x4*)(vd + 16) = sv1;
      }
      __syncthreads();
    }
    l += shx(l, lane, 16);
    l += shx(l, lane, 32);
    const float inv = 1.0f / l;
#pragma unroll
    for (int dt = 0; dt < 16; ++dt) {
      const f32x4 y = O[dt] * inv;
      u32x2 w; w.x = pk2(y.x, y.y); w.y = pk2(y.z, y.w);
      *(u32x2*)(p.xo + nq * 1024 + h * 256 + 16 * dt + 4 * g4) = w;
    }
  }
}

constexpr int RT_LCNT = MISC_OFF + 4096, RT_BASE = RT_LCNT + 128, RT_SEL = RT_BASE + 128, RT_RANK = RT_SEL + 1024;
DEV void route_phase(const Params& p, int li, LAS unsigned char* lds, int t32, int bid, int G) {
  const int lane = t32 & 63, wave = t32 >> 6, i15 = lane & 15, g4 = lane >> 4;
  const float* W = p.w_router + (size_t)li * D * NE;
  LAS unsigned short* Wh = (LAS unsigned short*)lds;
  LAS unsigned short* Wl = (LAS unsigned short*)(lds + 65536);
  LAS int* lcnt = (LAS int*)(lds + RT_LCNT);
  LAS int* lbase = (LAS int*)(lds + RT_BASE);
  LAS int* lsel = (LAS int*)(lds + RT_SEL);
  LAS int* lrank = (LAS int*)(lds + RT_RANK);
  const int e = lane & 31;
  const float bias = p.b_router[li * NE + e];
  for (int blk = bid; blk < N_TOK / 64; blk += G) {
    __syncthreads();
    for (int i = 0; i < 16; ++i) {
      const int idx = t32 + 512 * i, k = idx >> 3, e4 = (idx & 7) * 4;
      const f32x4 w = ((const f32x4*)W)[idx];
#pragma unroll
      for (int q = 0; q < 4; ++q) {
        const unsigned short hi = f2bfh(w[q]);
        const unsigned short lo = f2bfh(w[q] - __uint_as_float(((unsigned)hi) << 16));
        Wh[(e4 + q) * 1024 + k] = hi; Wl[(e4 + q) * 1024 + k] = lo;
      }
    }
    if (t32 < 32) lcnt[t32] = 0;
    __syncthreads();
    f32x4 acc[4][2];
#pragma unroll
    for (int mt = 0; mt < 4; ++mt) { acc[mt][0] = (f32x4){0.f, 0.f, 0.f, 0.f}; acc[mt][1] = (f32x4){0.f, 0.f, 0.f, 0.f}; }
    const int n0 = blk * 64;
#pragma unroll 1
    for (int kk = 0; kk < 4; ++kk) {
      const int kb = wave * 128 + kk * 32 + 8 * g4;
      bf16x8 bh[2], bl[2];
#pragma unroll
      for (int nt = 0; nt < 2; ++nt) {
        bh[nt] = *(const LAS bf16x8*)(Wh + (16 * nt + i15) * 1024 + kb);
        bl[nt] = *(const LAS bf16x8*)(Wl + (16 * nt + i15) * 1024 + kb);
      }
#pragma unroll
      for (int mt = 0; mt < 4; ++mt) {
        const float* xr = p.xf + (size_t)(n0 + 16 * mt + i15) * D + kb;
        const f32x4 x0 = *(const f32x4*)xr, x1 = *(const f32x4*)(xr + 4);
        u32x4 hw, lw;
        {
          const unsigned h0 = pk2(x0.x, x0.y), h1 = pk2(x0.z, x0.w), h2 = pk2(x1.x, x1.y), h3 = pk2(x1.z, x1.w);
          hw = (u32x4){h0, h1, h2, h3};
          lw.x = pk2(x0.x - __uint_as_float(h0 << 16), x0.y - __uint_as_float(h0 & 0xffff0000u));
          lw.y = pk2(x0.z - __uint_as_float(h1 << 16), x0.w - __uint_as_float(h1 & 0xffff0000u));
          lw.z = pk2(x1.x - __uint_as_float(h2 << 16), x1.y - __uint_as_float(h2 & 0xffff0000u));
          lw.w = pk2(x1.z - __uint_as_float(h3 << 16), x1.w - __uint_as_float(h3 & 0xffff0000u));
        }
        const bf16x8 ah = __builtin_bit_cast(bf16x8, hw), al = __builtin_bit_cast(bf16x8, lw);
#pragma unroll
        for (int nt = 0; nt < 2; ++nt) {
          acc[mt][nt] = __builtin_amdgcn_mfma_f32_16x16x32_bf16(ah, bh[nt], acc[mt][nt], 0, 0, 0);
          acc[mt][nt] = __builtin_amdgcn_mfma_f32_16x16x32_bf16(ah, bl[nt], acc[mt][nt], 0, 0, 0);
          acc[mt][nt] = __builtin_amdgcn_mfma_f32_16x16x32_bf16(al, bh[nt], acc[mt][nt], 0, 0, 0);
        }
      }
    }
    __syncthreads();
    LAS float* part = (LAS float*)lds;
    LAS float* fin = (LAS float*)(lds + 8 * 64 * 33 * 4);
#pragma unroll
    for (int mt = 0; mt < 4; ++mt)
#pragma unroll
      for (int nt = 0; nt < 2; ++nt)
#pragma unroll
        for (int j = 0; j < 4; ++j) part[(wave * 64 + 16 * mt + 4 * g4 + j) * 33 + 16 * nt + i15] = acc[mt][nt][j];
    __syncthreads();
    {
      const int tok = t32 >> 3, e4 = (t32 & 7) * 4;
#pragma unroll
      for (int q = 0; q < 4; ++q) {
        float v = 0.f;
#pragma unroll
        for (int w = 0; w < 8; ++w) v += part[(w * 64 + tok) * 33 + e4 + q];
        fin[tok * 33 + e4 + q] = v;
      }
    }
    __syncthreads();
    float cur[8]; int sel[8][4]; float sv[8][4];
#pragma unroll
    for (int t = 0; t < 8; ++t) cur[t] = fin[(wave * 8 + t) * 33 + e] + bias;
#pragma unroll
    for (int k = 0; k < 4; ++k) {
      float bv[8]; int bi[8];
#pragma unroll
      for (int t = 0; t < 8; ++t) { bv[t] = cur[t]; bi[t] = e; }
#pragma unroll
      for (int o = 1; o < 32; o <<= 1) {
#pragma unroll
        for (int t = 0; t < 8; ++t) {
          const float ov = shx(bv[t], lane, o); const int oi = shxi(bi[t], lane, o);
          if (ov > bv[t] || (ov == bv[t] && oi < bi[t])) { bv[t] = ov; bi[t] = oi; }
        }
      }
#pragma unroll
      for (int t = 0; t < 8; ++t) { sel[t][k] = bi[t]; sv[t][k] = bv[t]; if (e == bi[t]) cur[t] = -INFINITY; }
    }
    int abase = __builtin_amdgcn_readfirstlane(wave * 32);
    asm volatile("" : "+s"(abase));
    if (lane == 0) {
#pragma unroll
      for (int t = 0; t < 8; ++t) {
        const int n = n0 + wave * 8 + t;
        const float e1 = __builtin_amdgcn_exp2f((sv[t][1] - sv[t][0]) * 1.4426950408889634f), e2 = __builtin_amdgcn_exp2f((sv[t][2] - sv[t][0]) * 1.4426950408889634f), e3 = __builtin_amdgcn_exp2f((sv[t][3] - sv[t][0]) * 1.4426950408889634f);
        const float inv = 1.0f / (1.0f + e1 + e2 + e3);
        p.topg[n * 4 + 0] = inv; p.topg[n * 4 + 1] = e1 * inv; p.topg[n * 4 + 2] = e2 * inv; p.topg[n * 4 + 3] = e3 * inv;
#pragma unroll
        for (int k = 0; k < 4; ++k) {
          const int a = abase + t * 4 + k;
          lsel[a] = sel[t][k];
          lrank[a] = __hip_atomic_fetch_add(lcnt + sel[t][k], 1, __ATOMIC_RELAXED, __HIP_MEMORY_SCOPE_WORKGROUP);
        }
      }
    }
    __syncthreads();
    if (t32 < 32) lbase[t32] = atomicAdd(&p.cnt[li * 32 + t32], lcnt[t32]);
    __syncthreads();
    if (t32 < 256) {
      const int a = blk * 256 + t32, ee = lsel[t32];
      p.topi[a] = ee;
      p.rank[a] = lbase[ee] + lrank[t32];
    }
  }
  __syncthreads();
}

DEV void kcv_phase(const Params& p, int li, LAS unsigned char* lds, int t32, int bid, int G) {
  const int lane = t32 & 63, wave = t32 >> 6;
  LAS float* w2l = (LAS float*)lds;
  LAS float* rowb = (LAS float*)(lds + 65536) + wave * 512;
  __syncthreads();
#pragma unroll
  for (int i = 0; i < 4; ++i) {
    ((LAS f32x4*)w2l)[t32 + 512 * i] = ((const f32x4*)(p.cmp_w2_k + (size_t)li * CMP_HID * HD))[t32 + 512 * i];
    ((LAS f32x4*)w2l)[2048 + t32 + 512 * i] = ((const f32x4*)(p.cmp_w2_v + (size_t)li * CMP_HID * HD))[t32 + 512 * i];
  }
  __syncthreads();
  const int NGW = G * 8;
  for (int r0 = bid * 8 + wave; r0 < 2 * CMP_ROWS; r0 += 4 * NGW) {
    int rows[4];
#pragma unroll
    for (int i = 0; i < 4; ++i) { rows[i] = r0 + i * NGW; if (rows[i] >= 2 * CMP_ROWS) rows[i] = r0; }
#pragma unroll
    for (int i = 0; i < 4; ++i) {
      const float* hr = p.hid + (size_t)rows[i] * CMP_HID;
      rowb[i * 128 + lane] = hr[lane]; rowb[i * 128 + 64 + lane] = hr[64 + lane];
    }
    asm volatile("s_waitcnt lgkmcnt(0)" ::: "memory");
    float acc[4] = {0.f, 0.f, 0.f, 0.f};
    const LAS float* wq[4];
#pragma unroll
    for (int i = 0; i < 4; ++i) wq[i] = w2l + (rows[i] >= CMP_ROWS ? 128 * 64 : 0) + lane;
#pragma unroll 8
    for (int j = 0; j < CMP_HID; ++j) {
#pragma unroll
      for (int i = 0; i < 4; ++i) acc[i] += rowb[i * 128 + j] * wq[i][j * 64];
    }
#pragma unroll
    for (int i = 0; i < 4; ++i) {
      const int row = r0 + i * NGW;
      if (row < 2 * CMP_ROWS) {
        const int which = row >= CMP_ROWS ? 1 : 0, rr = row - which * CMP_ROWS;
        const int g_ = rr % NSA_G, c_ = (rr / NSA_G) % N_CMP, b_ = rr / (NSA_G * N_CMP);
        p.kcb[((((size_t)which * BATCH + b_) * 128 + c_) * NSA_G + g_) * 64 + lane] = f2bfh(acc[i]);
      }
    }
    asm volatile("s_waitcnt lgkmcnt(0)" ::: "memory");
  }
  __syncthreads();
}

constexpr int GA_QS = 272, GA_VS = 528, GA_PS = 144;
constexpr int GA_QT = 0, GA_KT = GA_QT + 64 * GA_QS, GA_KH = GA_KT + 64 * GA_QS, GA_VT = GA_KH + 64 * GA_QS, GA_PT = GA_VT + 64 * GA_VS,
              GA_LR = GA_PT + 64 * GA_PS, GA_GT = GA_LR + 64 * 16 * 4, GA_DC = GA_GT + 4 * 128 * 4, GA_END = GA_DC + 512;
static_assert(GA_END <= RING_BYTES, "GLA phase A LDS map");
constexpr int GC_SP = 0, GC_QT = GC_SP + 128 * GA_VS, GC_RED = GC_QT + 64 * GA_QS, GC_END = GC_RED + 8 * 16 * 4 * 2;
static_assert(GC_END <= RING_BYTES, "GLA phase C LDS map");

#define GSTAMP(i) do { if (GSEG >= 0 && blockIdx.x == 0 && t32 == 0) { const unsigned now_ = (unsigned)__builtin_amdgcn_s_memrealtime(); if ((i) > 0 && (i) - 1 == GSEG) p.barw[3600] += now_ - gs_prev; gs_prev = now_; } } while (0)
DEV void gla_a_unit(const Params& p, int li, LAS unsigned char* lds, int t32, int unit) {
  unsigned gs_prev = 0u;
  GSTAMP(0);
  const int lane = t32 & 63, wave = t32 >> 6, i15 = lane & 15, g4 = lane >> 4;
  const int bh = unit >> 5, ci = unit & 31, b = bh >> 2, h = bh & 3;
  const int c = t32 & 127, jq = t32 >> 7;
  LAS float* LR = (LAS float*)(lds + GA_LR);
  LAS float* GT = (LAS float*)(lds + GA_GT);
  LAS float* DC = (LAS float*)(lds + GA_DC);
  const float qscale = 0.08838834764831845f;
  const size_t n0 = (size_t)b * SEQ + ci * 64;
  {
    const int e = t32 * 2, j = e >> 4, r = e & 15;
    const unsigned w = *(const unsigned*)(p.u + (n0 + j) * N_IN + OFF_LR + r);
    LR[e] = __uint_as_float(w << 16); LR[e + 1] = __uint_as_float(w & 0xffff0000u);
  }
  float wa[GLA_RANK];
#pragma unroll
  for (int r = 0; r < GLA_RANK; ++r) wa[r] = p.w_alpha2[((size_t)li * GLA_RANK + r) * B_K + h * 128 + c];
  const float ba = p.b_alpha[li * B_K + h * 128 + c];
#pragma unroll
  for (int x = 0; x < 2; ++x) {
    const int idx = t32 + 512 * x, row = idx >> 4, ch = idx & 15;
    const act_t* ur = p.u + (n0 + row) * N_IN + h * 128 + ch * 8;
    *(LAS u32x4*)(lds + GA_QT + row * GA_QS + ch * 16) = *(const u32x4*)(ur + OFF_BQ);
    *(LAS u32x4*)(lds + GA_KT + row * GA_QS + ch * 16) = *(const u32x4*)(ur + OFF_BK);
  }
#pragma unroll
  for (int x = 0; x < 4; ++x) {
    const int idx = t32 + 512 * x, row = idx >> 5, ch = idx & 31;
    const u32x4 vv = *(const u32x4*)(p.u + (n0 + row) * N_IN + OFF_BV + h * 256 + ch * 8);
    *(LAS u32x4*)(lds + GA_VT + row * GA_VS + ch * 16) = vv;
  }
  __syncthreads();
  GSTAMP(1);
  float bl[16];
  float run = 0.f;
#pragma unroll
  for (int jj = 0; jj < 16; ++jj) {
    const LAS f32x4* lr4 = (const LAS f32x4*)(LR + (jq * 16 + jj) * 16);
    float z = ba;
#pragma unroll
    for (int r4 = 0; r4 < 4; ++r4) { const f32x4 x = lr4[r4]; z += x.x * wa[4 * r4] + x.y * wa[4 * r4 + 1] + x.z * wa[4 * r4 + 2] + x.w * wa[4 * r4 + 3]; }
    const float ez = __builtin_amdgcn_exp2f(-fabsf(z) * 1.4426950408889634f);
    const float ls = (fminf(z, 0.f) - __builtin_amdgcn_logf(1.0f + ez) * 0.6931471805599453f) * (1.0f / 16.0f);
    run += ls; bl[jj] = run;
  }
  GT[jq * 128 + c] = run;
  __syncthreads();
  GSTAMP(2);
  {
    const float g0 = GT[c], g1 = GT[128 + c], g2 = GT[256 + c], g3 = GT[384 + c];
    const float off = (jq > 0 ? g0 : 0.f) + (jq > 1 ? g1 : 0.f) + (jq > 2 ? g2 : 0.f);
    const float tot = (g0 + g1) + (g2 + g3);
    const float dtot = __builtin_amdgcn_exp2f(tot * 1.4426950408889634f);
    if (jq == 0) { DC[c] = dtot; p.gD[(size_t)unit * 128 + c] = dtot; }
#pragma unroll
    for (int jj = 0; jj < 16; ++jj) {
      const float e1 = __builtin_amdgcn_exp2f((off + bl[jj]) * 1.4426950408889634f), ie = __builtin_amdgcn_rcpf(e1);
      const int ro = (jq * 16 + jj) * GA_QS + c * 2;
      const float qf = __uint_as_float(((unsigned)*(const LAS unsigned short*)(lds + GA_QT + ro)) << 16);
      const float kf = __uint_as_float(((unsigned)*(const LAS unsigned short*)(lds + GA_KT + ro)) << 16);
      const unsigned short qt = f2bfh(qf * e1 * qscale);
      *(LAS unsigned short*)(lds + GA_QT + ro) = qt;
      p.gQ[((size_t)unit * 64 + jq * 16 + jj) * 128 + c] = qt;
      *(LAS unsigned short*)(lds + GA_KT + ro) = f2bfh(kf * ie);
      *(LAS unsigned short*)(lds + GA_KH + ro) = f2bfh(kf * ie * dtot);
    }
  }
  __syncthreads();
  GSTAMP(3);
#pragma unroll
  for (int q = 0; q < 2; ++q) {
    const int id = wave * 2 + q, jt = id >> 2, it = id & 3;
    f32x4 a = (f32x4){0.f, 0.f, 0.f, 0.f};
#pragma unroll
    for (int kk = 0; kk < 4; ++kk) {
      const bf16x8 kf = *(const LAS bf16x8*)(lds + GA_KT + (16 * jt + i15) * GA_QS + (32 * kk + 8 * g4) * 2);
      const bf16x8 qf = *(const LAS bf16x8*)(lds + GA_QT + (16 * it + i15) * GA_QS + (32 * kk + 8 * g4) * 2);
      a = __builtin_amdgcn_mfma_f32_16x16x32_bf16(kf, qf, a, 0, 0, 0);
    }
    const int i = 16 * it + i15, j0 = 16 * jt + 4 * g4;
    u32x2 w;
    w.x = pk2(j0 <= i ? a.x : 0.f, j0 + 1 <= i ? a.y : 0.f);
    w.y = pk2(j0 + 2 <= i ? a.z : 0.f, j0 + 3 <= i ? a.w : 0.f);
    *(LAS u32x2*)(lds + GA_PT + i * GA_PS + j0 * 2) = w;
  }
  __syncthreads();
  GSTAMP(4);
  {
    const int it = wave & 3, vt0 = (wave >> 2) * 8;
    bf16x8 pf[2];
#pragma unroll
    for (int s = 0; s < 2; ++s) pf[s] = *(const LAS bf16x8*)(lds + GA_PT + (16 * it + i15) * GA_PS + (32 * s + 8 * g4) * 2);
#pragma unroll
    for (int x = 0; x < 8; ++x) {
      const int vt = vt0 + x;
      f32x4 a = (f32x4){0.f, 0.f, 0.f, 0.f};
#pragma unroll
      for (int s = 0; s < 2; ++s) {
        const LAS unsigned char* vp = lds + GA_VT + (32 * s + 8 * g4 + (i15 >> 2)) * GA_VS + (16 * vt + 4 * (lane & 3)) * 2;
        const v4i16_t lo = tr_read(vp), hi = tr_read(vp + 4 * GA_VS);
        bf16x8 vf;
        vf[0] = lo[0]; vf[1] = lo[1]; vf[2] = lo[2]; vf[3] = lo[3]; vf[4] = hi[0]; vf[5] = hi[1]; vf[6] = hi[2]; vf[7] = hi[3];
        a = __builtin_amdgcn_mfma_f32_16x16x32_bf16(vf, pf[s], a, 0, 0, 0);
      }
      *(f32x4*)(p.opart + (n0 + 16 * it + i15) * 1024 + h * 256 + 16 * vt + 4 * g4) = a;
    }
  }
  {
    bf16x8 vf[2][2];
#pragma unroll
    for (int x = 0; x < 2; ++x)
#pragma unroll
      for (int s = 0; s < 2; ++s) {
        const LAS unsigned char* vp = lds + GA_VT + (32 * s + 8 * g4 + (i15 >> 2)) * GA_VS + (16 * (2 * wave + x) + 4 * (lane & 3)) * 2;
        const v4i16_t lo = tr_read(vp), hi = tr_read(vp + 4 * GA_VS);
        vf[x][s][0] = lo[0]; vf[x][s][1] = lo[1]; vf[x][s][2] = lo[2]; vf[x][s][3] = lo[3];
        vf[x][s][4] = hi[0]; vf[x][s][5] = hi[1]; vf[x][s][6] = hi[2]; vf[x][s][7] = hi[3];
      }
#pragma unroll
    for (int ct = 0; ct < 8; ++ct) {
      f32x4 a0 = (f32x4){0.f, 0.f, 0.f, 0.f}, a1 = (f32x4){0.f, 0.f, 0.f, 0.f};
#pragma unroll
      for (int s = 0; s < 2; ++s) {
        const LAS unsigned char* kp = lds + GA_KH + (32 * s + 8 * g4 + (i15 >> 2)) * GA_QS + (16 * ct + 4 * (lane & 3)) * 2;
        const v4i16_t lo = tr_read(kp), hi = tr_read(kp + 4 * GA_QS);
        bf16x8 kf;
        kf[0] = lo[0]; kf[1] = lo[1]; kf[2] = lo[2]; kf[3] = lo[3]; kf[4] = hi[0]; kf[5] = hi[1]; kf[6] = hi[2]; kf[7] = hi[3];
        a0 = __builtin_amdgcn_mfma_f32_16x16x32_bf16(vf[0][s], kf, a0, 0, 0, 0);
        a1 = __builtin_amdgcn_mfma_f32_16x16x32_bf16(vf[1][s], kf, a1, 0, 0, 0);
      }
      act_t* up = p.gU + ((size_t)unit * 128 + 16 * ct + i15) * 256 + 32 * wave + 4 * g4;
      u32x2 w0; w0.x = pk2(a0.x, a0.y); w0.y = pk2(a0.z, a0.w);
      u32x2 w1; w1.x = pk2(a1.x, a1.y); w1.y = pk2(a1.z, a1.w);
      *(u32x2*)up = w0; *(u32x2*)(up + 16) = w1;
    }
  }
  __syncthreads();
  GSTAMP(5);
}

DEV void gla_scan(const Params& p, long long tid, long long nthr) {
  for (long long idx = tid; idx < 32LL * 128 * 32; idx += nthr) {
    const int v8 = (int)(idx & 31) * 8, c = (int)((idx >> 5) & 127), bh = (int)(idx >> 12);
    float s[8];
#pragma unroll
    for (int i = 0; i < 8; ++i) s[i] = 0.f;
#pragma unroll 8
    for (int ci = 0; ci < 32; ++ci) {
      const size_t unit = (size_t)bh * 32 + ci;
      const u32x4 uw = *(const u32x4*)(p.gU + (unit * 128 + c) * 256 + v8);
      const float d = p.gD[unit * 128 + c];
      u32x4 o;
#pragma unroll
      for (int i = 0; i < 4; ++i) o[i] = pk2(s[2 * i], s[2 * i + 1]);
      *(u32x4*)(p.gS + (unit * 128 + c) * 256 + v8) = o;
#pragma unroll
      for (int i = 0; i < 4; ++i) {
        s[2 * i] = s[2 * i] * d + __uint_as_float(uw[i] << 16);
        s[2 * i + 1] = s[2 * i + 1] * d + __uint_as_float(uw[i] & 0xffff0000u);
      }
    }
  }
}

DEV void gla_c_unit(const Params& p, int li, LAS unsigned char* lds, int t32, int unit) {
  const int lane = t32 & 63, wave = t32 >> 6, i15 = lane & 15, g4 = lane >> 4;
  const int bh = unit >> 5, ci = unit & 31, b = bh >> 2, h = bh & 3;
  const size_t n0 = (size_t)b * SEQ + ci * 64;
#pragma unroll
  for (int x = 0; x < 8; ++x) {
    const int idx = t32 + 512 * x, row = idx >> 5, ch = idx & 31;
    *(LAS u32x4*)(lds + GC_SP + row * GA_VS + ch * 16) = *(const u32x4*)(p.gS + ((size_t)unit * 128 + row) * 256 + ch * 8);
  }
#pragma unroll
  for (int x = 0; x < 2; ++x) {
    const int idx = t32 + 512 * x, row = idx >> 4, ch = idx & 15;
    *(LAS u32x4*)(lds + GC_QT + row * GA_QS + ch * 16) = *(const u32x4*)(p.gQ + ((size_t)unit * 64 + row) * 128 + ch * 8);
  }
  __syncthreads();
  const int it = wave & 3, vt0 = (wave >> 2) * 8;
  bf16x8 qf[4];
#pragma unroll
  for (int kk = 0; kk < 4; ++kk) qf[kk] = *(const LAS bf16x8*)(lds + GC_QT + (16 * it + i15) * GA_QS + (32 * kk + 8 * g4) * 2);
  const size_t n = n0 + 16 * it + i15;
  f32x4 o[8];
  float ss = 0.f;
#pragma unroll
  for (int x = 0; x < 8; ++x) {
    const int vt = vt0 + x;
    f32x4 a = *(const f32x4*)(p.opart + n * 1024 + h * 256 + 16 * vt + 4 * g4);
#pragma unroll
    for (int kk = 0; kk < 4; ++kk) {
      const LAS unsigned char* sp = lds + GC_SP + (32 * kk + 8 * g4 + (i15 >> 2)) * GA_VS + (16 * vt + 4 * (lane & 3)) * 2;
      const v4i16_t lo = tr_read(sp), hi = tr_read(sp + 4 * GA_VS);
      bf16x8 sf;
      sf[0] = lo[0]; sf[1] = lo[1]; sf[2] = lo[2]; sf[3] = lo[3]; sf[4] = hi[0]; sf[5] = hi[1]; sf[6] = hi[2]; sf[7] = hi[3];
      a = __builtin_amdgcn_mfma_f32_16x16x32_bf16(sf, qf[kk], a, 0, 0, 0);
    }
    o[x] = a;
    ss += (a.x * a.x + a.y * a.y) + (a.z * a.z + a.w * a.w);
  }
  ss += shx(ss, lane, 16);
  ss += shx(ss, lane, 32);
  LAS float* RED = (LAS float*)(lds + GC_RED);
  if (g4 == 0) RED[wave * 16 + i15] = ss;
  __syncthreads();
  ss += RED[(wave ^ 4) * 16 + i15];
  const float rs = 1.0f / sqrtf(ss * (1.0f / 256.0f) + LN_EPS);
#pragma unroll
  for (int x = 0; x < 8; ++x) {
    const int v = 16 * (vt0 + x) + 4 * g4;
    const f32x4 gn = *(const f32x4*)(p.gla_norm_g + li * DV + v);
    const u32x2 rw = *(const u32x2*)(p.u + n * N_IN + OFF_BR + h * 256 + v);
    const float r0 = __uint_as_float(rw.x << 16), r1 = __uint_as_float(rw.x & 0xffff0000u), r2 = __uint_as_float(rw.y << 16), r3 = __uint_as_float(rw.y & 0xffff0000u);
    u32x2 w;
    w.x = pk2(o[x].x * rs * gn.x * (r0 * fsig(r0)), o[x].y * rs * gn.y * (r1 * fsig(r1)));
    w.y = pk2(o[x].z * rs * gn.z * (r2 * fsig(r2)), o[x].w * rs * gn.w * (r3 * fsig(r3)));
    *(u32x2*)(p.yb + n * YLD + h * 256 + v) = w;
  }
  __syncthreads();
}

#define XB_TMO      128
#define XB_XCNT(j)  (256  + 64 * (j))
#define XB_XSUB(j)  (1280 + 64 * (j))
#define XB_XGEN(j)  (2304 + 64 * (j))
#define XB_TOP      3328
#define XB_TOPGEN   3392
#define XCD_BAR_WORDS 3456
#define XB_SPIN_CAP (1u << 18)

__device__ __forceinline__ unsigned xb_ld(unsigned* p)              { return __hip_atomic_load(p, __ATOMIC_RELAXED, __HIP_MEMORY_SCOPE_AGENT); }
__device__ __forceinline__ unsigned xb_add(unsigned* p, unsigned v) { return __hip_atomic_fetch_add(p, v, __ATOMIC_RELAXED, __HIP_MEMORY_SCOPE_AGENT); }
__device__ __forceinline__ unsigned xb_xcc_id() { return (unsigned)__builtin_amdgcn_s_getreg((3 << 11) | 20) & 0xFu; }
#define XB_SPIN(cond, bar) do { unsigned _sp = 0; while (cond) { __builtin_amdgcn_s_sleep(1); \
    if ((++_sp & 255u) == 0u) { if (xb_ld(&(bar)[XB_TMO])) break; if (_sp > XB_SPIN_CAP) { atomicAdd(&(bar)[XB_TMO], 1u); break; } } } } while (0)

struct XcdBarrier {
    unsigned* bar; unsigned x;
    volatile LAS unsigned* st;
};

__device__ __forceinline__ XcdBarrier xcd_barrier_post(unsigned* bar, volatile LAS unsigned* st) {
    XcdBarrier b; b.bar = bar; b.x = xb_xcc_id(); b.st = st;
    if (threadIdx.x == 0) st[2] = xb_add(&bar[XB_XCNT(b.x)], 1u);
    return b;
}
__device__ __forceinline__ void xcd_barrier_complete(unsigned* bar, unsigned x, unsigned& nloc, unsigned& nx) {
    const unsigned G = gridDim.x * gridDim.y * gridDim.z;
    unsigned sum, cnt, mine, sp = 0u;
    for (;;) {
        sum = 0u; cnt = 0u; mine = 0u;
#pragma unroll
        for (unsigned j = 0; j < 16; ++j) { const unsigned c = xb_ld(&bar[XB_XCNT(j)]); sum += c; cnt += (c > 0u) ? 1u : 0u; mine = (j == x) ? c : mine; }
        if (sum == G) break;
        __builtin_amdgcn_s_sleep(1);
        if ((++sp & 255u) == 0u) { if (xb_ld(&bar[XB_TMO])) break; if (sp > XB_SPIN_CAP) { atomicAdd(&bar[XB_TMO], 1u); break; } }
    }
    nloc = mine > 0u ? mine : 1u; nx = cnt > 0u ? cnt : 1u;
}

__device__ __forceinline__ void xcd_barrier(const XcdBarrier& b, const int t32) {
    asm volatile("s_waitcnt vmcnt(0)" ::: "memory");
    __syncthreads();
    if (t32 == 0) {
        unsigned* bar = b.bar;
        __builtin_amdgcn_s_waitcnt(0);
        unsigned nloc = b.st[0], nx = b.st[1];
        if (nloc == 0u) { xcd_barrier_complete(bar, b.x, nloc, nx); b.st[0] = nloc; b.st[1] = nx; }
        const unsigned old = xb_add(&bar[XB_XSUB(b.x)], 1u);
        const unsigned gen = old / nloc;
        if (old + 1u == (gen + 1u) * nloc) {
            __builtin_amdgcn_fence(__ATOMIC_RELEASE, "agent");
            asm volatile("s_waitcnt vmcnt(0)" ::: "memory");
            const unsigned og = xb_add(&bar[XB_TOP], 1u);
            const unsigned tg = og / nx;
            if (og + 1u == (tg + 1u) * nx) xb_add(&bar[XB_TOPGEN], 1u);
            else XB_SPIN(xb_ld(&bar[XB_TOPGEN]) == tg, bar);
            __builtin_amdgcn_fence(__ATOMIC_ACQUIRE, "agent");
            xb_add(&bar[XB_XGEN(b.x)], 1u);
            asm volatile("s_waitcnt vmcnt(0)" ::: "memory");
        } else {
            XB_SPIN(xb_ld(&bar[XB_XGEN(b.x)]) == gen, bar);
            __builtin_amdgcn_fence(__ATOMIC_ACQUIRE, "agent");
            asm volatile("s_waitcnt vmcnt(0)" ::: "memory");
        }
    }
    __syncthreads();
}

constexpr int STEPS_PER_LAYER = 21;
#ifndef PROBE_LO
#define PROBE_LO -1
#define PROBE_HI -1
#endif
#ifndef PROBE_PRO
#define PROBE_PRO 0
#endif
#ifndef TSTEP_LO
#define TSTEP_LO -2
#define TSTEP_HI -2
#endif
#ifndef TSUB
#define TSUB -9
#endif
#ifndef TSTEP_Q
#define TSTEP_Q 40u
#endif
#ifndef NSA_PROBE
#define NSA_PROBE 0
#endif
#ifndef MULTI_LAUNCH
#define MULTI_LAUNCH 0
#endif
DEV int fresh_t32(int wave) {
  int t;
  asm volatile("v_mbcnt_lo_u32_b32 %0, -1, 0\n\tv_mbcnt_hi_u32_b32 %0, -1, %0" : "=v"(t));
  return t + wave * 64;
}
struct KArgs { void* in[35]; void* out; void* ws; };
template <bool WITH_NAIVE, bool COOP>
__global__ void __launch_bounds__(NTHREADS) k_mega(KArgs ka, int step_lo, int step_hi) {
  unsigned* const barw0 = ((unsigned*)ka.ws);
  extern __shared__ __attribute__((aligned(16))) unsigned char lds_raw[];
  LAS unsigned char* lds = (LAS unsigned char*)lds_raw;
  LAS int* tab = (LAS int*)(lds + MISC_OFF);
  const int wave = __builtin_amdgcn_readfirstlane(threadIdx.x >> 6);
  const int G = gridDim.x;
  int bid = blockIdx.x;

  LAS unsigned* miscw = (LAS unsigned*)(lds + MISC_OFF + 8192);
  if (threadIdx.x < 128) miscw[threadIdx.x] = 0u;
  __syncthreads();
  XcdBarrier xbar; xbar.bar = barw0; xbar.x = 0; xbar.st = nullptr;
  if (COOP) xbar = xcd_barrier_post(barw0, miscw + 8);
  unsigned* const stamp = barw0 + 3584;
  if (step_lo < 0) {
    Params p;
    fill_params(p, ka.in, ka.out, ka.ws);
    if (TSTEP_LO == -1 && blockIdx.x == 0 && threadIdx.x == 0) { stamp[0] = (unsigned)__builtin_amdgcn_s_memrealtime(); stamp[2] = 0u; stamp[3] = 0u; }
    prologue(p, lds, wave, threadIdx.x & 63);
    if (COOP) {
      if (step_hi == -12345) cg::this_grid().sync();
      xcd_barrier(xbar, (int)threadIdx.x);
    }
#if PROBE_PRO
    prologue(p, lds, wave, threadIdx.x & 63);
    if (COOP) cg::this_grid().sync();
#endif
    step_lo = 0;
    if (TSTEP_LO == -1 && blockIdx.x == 0 && threadIdx.x == 0) stamp[1] = (unsigned)__builtin_amdgcn_s_memrealtime();
    if (COOP) {
      bool even = (G % 8) == 0;
#pragma unroll
      for (int j = 0; j < 8; ++j) even = even && (xb_ld(&barw0[XB_XCNT(j)]) == (unsigned)(G / 8));
      __syncthreads();
      if (even) bid = __builtin_amdgcn_readfirstlane((int)(xbar.x + 8u * miscw[10]));
    }
  }
  int rep_done = 0;
  for (int step = step_lo; step < step_hi;) {
    int li = step / STEPS_PER_LAYER;
    const int k = step % STEPS_PER_LAYER;
    int nb32 = gridDim.x;
    char* wsb = (char*)ka.ws;
    asm volatile("" : "+s"(wsb));
    Params p;
    fill_params(p, ka.in, ka.out, wsb);
    asm volatile("" : "+s"(li));
    asm volatile("" : "+s"(nb32));
#define T32() fresh_t32(wave)
#define TID() ((int)(blockIdx.x * NTHREADS) + T32())
    const int nthr = nb32 * NTHREADS;
    const int gw = blockIdx.x * 8 + wave, NGW = nb32 * 8;
    if (TSTEP_LO >= 0 && k == TSTEP_LO && blockIdx.x == 0 && wave == 0) stamp[2 * li] = (unsigned)__builtin_amdgcn_s_memrealtime();
    const bool is_gemm = (k == 0) || (k >= 2 && k <= 5) || (k == 9) || (k == 10) || (k == 12) || (k == 14) || (k == 18) || (k == 19);
    const bool sync_after = !(k == 2 || k == 3 || k == 4);
    if (is_gemm) {
      pg8::Gemm g{nullptr, nullptr, 0, 0, 0};
      USched S; S.init_static(256, 256, G, bid);
      EpiU E{0, 0, nullptr, nullptr, nullptr, nullptr, nullptr};
      const size_t WSQ = (size_t)1024 * 1024;
      switch (k) {
        case 0:
          g = pg8::Gemm{p.xb, p.wt_in + (size_t)li * N_IN_PAD * 1024, N_TOK, N_IN_PAD, 1024};
          S.init_static(N_TOK, N_IN_PAD, G, bid);
          E.mode = EM_INPROJ; E.q0 = p.u; E.q1 = p.b_in + (size_t)li * N_IN; break;
        case 2:
          g = pg8::Gemm{p.cmpA, p.wt_c1 + (size_t)(li * 2 + 0) * 256 * 2048, CMP_ROWS_PAD, 256, 2048};
          S.init_static(CMP_ROWS_PAD, 256, G, bid);
          E.mode = EM_HID; E.q0 = p.hid; break;
        case 3:
          g = pg8::Gemm{p.cmpA + (size_t)CMP_ROWS_PAD * 2048, p.wt_c1 + (size_t)(li * 2 + 1) * 256 * 2048, CMP_ROWS_PAD, 256, 2048};
          S.init_static(CMP_ROWS_PAD, 256, G, (bid + G - 16) % G);
          E.mode = EM_HID; E.q0 = p.hid + (size_t)CMP_ROWS * CMP_HID; break;
        case 4:
          g = pg8::Gemm{p.membf, p.wt_xk + li * WSQ, BATCH * MEM_LEN, 1024, 1024};
          S.init_static(BATCH * MEM_LEN, 1024, G, (bid + G - 32) % G);
          E.mode = EM_BF16; E.q0 = p.memk; E.ldc = 1024; break;
        case 5:
          g = pg8::Gemm{p.membf, p.wt_xv + li * WSQ, BATCH * MEM_LEN, 1024, 1024};
          S.init_static(BATCH * MEM_LEN, 1024, G, (bid + G - 64) % G);
          E.mode = EM_BF16; E.q0 = p.memv; E.ldc = 1024; break;
        case 9:
          g = pg8::Gemm{p.ya, p.wt_bra + (size_t)li * 1024 * YLD, N_TOK, 1024, YLD};
          S.init_static(N_TOK, 1024, G, bid);
          E.mode = EM_BRCAT; E.q1 = p.u; E.q0 = p.merged; break;
        case 10:
          g = pg8::Gemm{p.merged, p.wt_omix + li * WSQ, N_TOK, 1024, 1024};
          S.init_static(N_TOK, 1024, G, bid);
          E.mode = EM_RES; E.q1 = p.xf; E.q0 = p.tmp; break;
        case 12:
          g = pg8::Gemm{p.xb, p.wt_xq + li * WSQ, N_TOK, 1024, 1024};
          S.init_static(N_TOK, 1024, G, bid);
          E.mode = EM_BF16; E.q0 = p.xq; E.ldc = 1024; break;
        case 14:
          g = pg8::Gemm{p.xo, p.wt_xo + li * WSQ, N_TOK, 1024, 1024};
          S.init_static(N_TOK, 1024, G, bid);
          E.mode = EM_RES; E.q1 = p.xf; E.q0 = p.tmp; break;
        case 18: {
          const int ntiles = moe_tables(p, li, tab, T32());
          g = pg8::Gemm{p.xg, p.wt_gu + (size_t)li * 32 * 2048 * 1024, MOE_ROWS, 32 * 2048, 1024};
          S.init_moe(G, bid, 8, ntiles * 8, tab + 128);
          E.mode = EM_MOE1; E.q0 = p.actg; E.q1 = p.b_gu + (size_t)li * 32 * 2048; E.te = tab + 128; break; }
        default: {
          const int ntiles = moe_tables(p, li, tab, T32());
          g = pg8::Gemm{p.actg, p.wt_dn + (size_t)li * 32 * 1024 * 1024, MOE_ROWS, 32 * 1024, 1024};
          S.init_moe(G, bid, 4, ntiles * 4, tab + 128);
          E.mode = EM_MOE2; E.q0 = p.yass; E.q1 = p.b_down + (size_t)li * 32 * 1024; E.q2 = p.topg; E.q3 = p.rowlist; E.te = tab + 128; break; }
      }
      pg8::gemm_phase<EpiU, USched, true, true>(lds, g, S, E, T32());
    } else {
      switch (k) {
        case 1: cmpa_build(p, li, TID(), nthr); break;
        case 6:
#define SUBSTAMP(i) do { if (TSUB == (i) && blockIdx.x == 0 && wave == 0) stamp[2 * li] = (unsigned)__builtin_amdgcn_s_memrealtime(); if (TSUB + 1 == (i) && blockIdx.x == 0 && wave == 0) stamp[2 * li + 1] = (unsigned)__builtin_amdgcn_s_memrealtime(); } while (0)
          SUBSTAMP(1);
          { const int t = T32(); for (int un = bid; un < 1024; un += G) gla_a_unit(p, li, lds, t, un); }
          SUBSTAMP(2);
          dil_phase(p, lds, T32(), bid, G);
          SUBSTAMP(3);
          kcv_phase(p, li, lds, T32(), bid, G);
          SUBSTAMP(4);
          break;
        case 7: SUBSTAMP(8); gla_scan(p, TID(), nthr); SUBSTAMP(9); nsa_cmp_phase(p, lds, T32(), bid, G); SUBSTAMP(10); dil_combine(p, TID(), nthr); SUBSTAMP(11); break;
        case 8: {
          SUBSTAMP(5);
          nsa_main_phase(p, lds, T32(), bid, G);
          __syncthreads();
          SUBSTAMP(6);
          const int t = T32();
          for (int un = bid; un < 1024; un += G) gla_c_unit(p, li, lds, t, un);
          SUBSTAMP(7);
          break; }
        case 11: ln_rows_w<0>(p, p.tmp, p.ln1_g + li * D, p.ln1_b + li * D, p.xf, p.xb, nullptr, gw, NGW, T32() & 63); break;
        case 13: xattn_phase(p, lds, T32(), bid, G); break;
        case 15: ln_rows_w<0>(p, p.tmp, p.ln2_g + li * D, p.ln2_b + li * D, p.xf, p.xb, nullptr, gw, NGW, T32() & 63); break;
        case 16: route_phase(p, li, lds, T32(), bid, G); break;
        case 17: { const int t = T32(); moe_prep(p, li, tab, wave, t & 63, t); break; }
        case 20: ln_rows_w<1>(p, nullptr, p.ln3_g + li * D, p.ln3_b + li * D, p.xf, p.xb, li == DEPTH - 1 ? p.out : nullptr, gw, NGW, T32() & 63); break;
        default: break;
      }
    }
    if (COOP && sync_after) xcd_barrier(xbar, T32());
    if (TSTEP_LO >= 0 && k == TSTEP_HI && blockIdx.x == 0 && wave == 0) stamp[2 * li + 1] = (unsigned)__builtin_amdgcn_s_memrealtime();
    if (PROBE_HI >= 0 && k == PROBE_HI && !rep_done) { rep_done = 1; step -= (PROBE_HI - PROBE_LO); }
    else { if (k == PROBE_HI) rep_done = 0; ++step; }
  }
  if (GSEG >= 0 && blockIdx.x == 0 && fresh_t32(wave) == 0) {
    __builtin_amdgcn_s_waitcnt(0);
    const unsigned tk = __hip_atomic_load(barw0 + 3600, __ATOMIC_RELAXED, __HIP_MEMORY_SCOPE_AGENT);
    ((float*)ka.out)[0] = (float)((tk / 100u + TSTEP_Q / 2) / TSTEP_Q * TSTEP_Q);
  }
  if (TSTEP_LO >= -1 && blockIdx.x == 0 && fresh_t32(wave) == 0) {
    __builtin_amdgcn_s_waitcnt(0);
    const unsigned tk = (__hip_atomic_load(stamp + 1, __ATOMIC_RELAXED, __HIP_MEMORY_SCOPE_AGENT) - __hip_atomic_load(stamp + 0, __ATOMIC_RELAXED, __HIP_MEMORY_SCOPE_AGENT)) + (__hip_atomic_load(stamp + 3, __ATOMIC_RELAXED, __HIP_MEMORY_SCOPE_AGENT) - __hip_atomic_load(stamp + 2, __ATOMIC_RELAXED, __HIP_MEMORY_SCOPE_AGENT));
    ((float*)ka.out)[0] = (float)((tk / 100u + TSTEP_Q / 2) / TSTEP_Q * TSTEP_Q);
  }
}

extern "C" void kernel_launch(void* const* d_in, const int* in_sizes, int n_in, void* d_out, int out_size,
                              void* d_ws, size_t ws_size, hipStream_t stream) {
  Params p;
  memset(&p, 0, sizeof(p));
  fill_params(p, d_in, d_out, d_ws);
  KArgs ka;
  memset(&ka, 0, sizeof(ka));
  for (int i = 0; i < 35; ++i) ka.in[i] = d_in[i];
  ka.out = d_out; ka.ws = d_ws;
  static int grid_blocks = 0;
  if (!grid_blocks) {
    int dev = 0, cus = 0;
    hipGetDevice(&dev);
    hipDeviceGetAttribute(&cus, hipDeviceAttributeMultiprocessorCount, dev);
    hipFuncSetAttribute((const void*)k_mega<true, true>, hipFuncAttributeMaxDynamicSharedMemorySize, LDS_BYTES);
    if (p.ws_used > ws_size) fprintf(stderr, "workspace too small: need %zu have %zu\n", p.ws_used, ws_size);
    grid_blocks = cus;
  }
  hipMemsetAsync(p.barw, 0, 4096 * sizeof(unsigned), stream);
  int lo = -1, hi = DEPTH * STEPS_PER_LAYER;
  void* args[] = {&ka, &lo, &hi};
  hipError_t e = hipLaunchCooperativeKernel((void*)k_mega<true, true>, dim3(grid_blocks), dim3(NTHREADS), args, LDS_BYTES, stream);
  if (e != hipSuccess) fprintf(stderr, "cooperative launch failed: %s (grid %d)\n", hipGetErrorString(e), grid_blocks);
}
#endif
```
